# Optimizing an MI355X kernel written in HIP

```python
import jax, jax.numpy as jnp
from jax import lax
import numpy as np

D_MODEL = 1024
BATCH = 4
SEQ = 4096
DEPTH = 2

HEAD_DIM = 64
BLOCK = 128
A_Q_HEADS = 8
A_KV_HEADS = 2
A_GROUP = A_Q_HEADS // A_KV_HEADS
A_WINDOW = 128
B_HEADS = 8
C_HEADS = 16
C_PATTERNS = ((128, 1), (512, 4), (2048, 16))
MEM_LEN = 256
X_HEADS = 4
X_HEAD_DIM = D_MODEL // X_HEADS
D_FF = 2816
RMS_EPS = 1e-6

A_Q_W = A_Q_HEADS * HEAD_DIM
A_KV_W = A_KV_HEADS * HEAD_DIM
B_W = B_HEADS * HEAD_DIM
EVEN_IN = A_Q_W + 2 * A_KV_W + 3 * B_W
EVEN_MIX = A_Q_W + B_W
ODD_IN = 3 * C_HEADS * HEAD_DIM
ODD_MIX = C_HEADS * HEAD_DIM

kernel_name = 'hybrid_swa_stickbreak_dilated_block'


def rms_norm(x, g):
    xf = x.astype(jnp.float32)
    y = xf * lax.rsqrt(jnp.mean(xf * xf, axis=-1, keepdims=True) + RMS_EPS)
    return (y * g.astype(jnp.float32)).astype(x.dtype)


def alibi_slopes(n_heads):
    return jnp.asarray(2.0 ** (-8.0 * np.arange(1, n_heads + 1) / n_heads), dtype=jnp.float32)


def swiglu_ffn(x, w_gu, w_down):
    gate, up = jnp.split(x @ w_gu, 2, axis=-1)
    return (jax.nn.silu(gate) * up) @ w_down


def banded_attention(q, k, v, slopes, max_dist, step, sinks=None):
    b, l, hkv, g, dh = q.shape
    nb = -(-l // BLOCK)
    lp = nb * BLOCK
    pad = lp - l
    qb = jnp.pad(q, ((0, 0), (0, pad), (0, 0), (0, 0), (0, 0))).reshape(b, nb, BLOCK, hkv, g, dh)
    kv_pad = ((0, 0), (BLOCK, pad), (0, 0), (0, 0))
    k = jnp.pad(k, kv_pad).reshape(b, nb + 1, BLOCK, hkv, dh)
    v = jnp.pad(v, kv_pad).reshape(b, nb + 1, BLOCK, hkv, dh)
    kb = jnp.concatenate([k[:, :-1], k[:, 1:]], axis=2)
    vb = jnp.concatenate([v[:, :-1], v[:, 1:]], axis=2)
    s = jnp.einsum('bnqhgd,bnkhd->bnhgqk', qb, kb).astype(jnp.float32) * (dh ** -0.5)
    dist = jnp.arange(BLOCK)[:, None] + BLOCK - jnp.arange(2 * BLOCK)[None, :]
    kpos = jnp.arange(nb)[:, None] * BLOCK - BLOCK + jnp.arange(2 * BLOCK)[None, :]
    valid = (dist >= 0) & (dist <= max_dist) & (kpos[:, None, :] >= 0)
    bias = -(slopes.astype(jnp.float32) * step)[:, :, None, None] * dist.astype(jnp.float32)
    s = jnp.where(valid[None, :, None, None], s + bias[None, None], -jnp.inf)
    m = jnp.max(s, axis=-1)
    if sinks is not None:
        sk = sinks.astype(jnp.float32)[..., None]
        m = jnp.maximum(m, sk)
    p = jnp.exp(s - m[..., None])
    denom = jnp.sum(p, axis=-1)
    if sinks is not None:
        denom = denom + jnp.exp(sk - m)
    o = jnp.einsum('bnhgqk,bnkhd->bnqhgd', (p / denom[..., None]).astype(v.dtype), vb)
    lse = m + jnp.log(denom)
    o = o.reshape(b, lp, hkv, g, dh)[:, :l]
    lse = jnp.moveaxis(lse, -1, 2).reshape(b, lp, hkv, g)[:, :l]
    return o, lse


def stick_breaking_attention(q, k, v):
    b, s, h, dh = q.shape
    nb = s // BLOCK
    qb = q.reshape(b, nb, BLOCK, h, dh).transpose(1, 0, 2, 3, 4)
    spos = jnp.arange(s)
    scale = dh ** -0.5

    def one_block(args):
        i, qi = args
        z = jnp.einsum('bqhd,bkhd->bhqk', qi, k).astype(jnp.float32) * scale
        tpos = i * BLOCK + jnp.arange(BLOCK)
        strict = spos[None, :] < tpos[:, None]
        log_keep = jnp.where(strict, jax.nn.log_sigmoid(-z), 0.0)
        log_after = lax.cumsum(log_keep, axis=3, reverse=True) - log_keep
        a = jnp.where(strict, jnp.exp(jax.nn.log_sigmoid(z) + log_after), 0.0)
        return jnp.einsum('bhqk,bkhd->bqhd', a.astype(v.dtype), v)

    o = lax.map(one_block, (jnp.arange(nb), qb))
    return o.transpose(1, 0, 2, 3, 4).reshape(b, s, h, dh)


def dilated_attention(q, k, v, slopes):
    b, s, h, dh = q.shape
    outs, lses = [], []
    for window, dil in C_PATTERNS:
        sp = -(-s // dil) * dil
        ls = sp // dil

        def strided(t):
            t = jnp.pad(t, ((0, 0), (0, sp - s), (0, 0), (0, 0)))
            return t.reshape(b, ls, dil, h, dh).transpose(0, 2, 1, 3, 4).reshape(b * dil, ls, h, dh)

        o, lse = banded_attention(strided(q)[:, :, :, None], strided(k), strided(v),
                                  slopes[:, None], window // dil, dil)
        o = o[:, :, :, 0].reshape(b, dil, ls, h, dh).transpose(0, 2, 1, 3, 4).reshape(b, sp, h, dh)[:, :s]
        lse = lse[..., 0].reshape(b, dil, ls, h).transpose(0, 2, 1, 3).reshape(b, sp, h)[:, :s]
        outs.append(o)
        lses.append(lse)
    w = jax.nn.softmax(jnp.stack(lses), axis=0)
    o = jnp.sum(w[..., None] * jnp.stack(outs).astype(jnp.float32), axis=0)
    return o.astype(q.dtype)


def even_mixer(h, w_in, q_gain, k_gain, sinks, w_out):
    b, s, _ = h.shape
    cuts = np.cumsum([A_Q_W, A_KV_W, A_KV_W, B_W, B_W]).tolist()
    qa, ka, va, qb, kb, vb = jnp.split(h @ w_in, cuts, axis=-1)
    qa = rms_norm(qa.reshape(b, s, A_KV_HEADS, A_GROUP, HEAD_DIM), q_gain)
    ka = rms_norm(ka.reshape(b, s, A_KV_HEADS, HEAD_DIM), k_gain)
    va = va.reshape(b, s, A_KV_HEADS, HEAD_DIM)
    slopes_a = alibi_slopes(A_Q_HEADS).reshape(A_KV_HEADS, A_GROUP)
    o_a, _ = banded_attention(qa, ka, va, slopes_a, A_WINDOW - 1, 1,
                              sinks.reshape(A_KV_HEADS, A_GROUP))
    o_b = stick_breaking_attention(qb.reshape(b, s, B_HEADS, HEAD_DIM),
                                   kb.reshape(b, s, B_HEADS, HEAD_DIM),
                                   vb.reshape(b, s, B_HEADS, HEAD_DIM))
    o = jnp.concatenate([o_a.reshape(b, s, A_Q_W), o_b.reshape(b, s, B_W)], axis=-1)
    return o @ w_out


def odd_mixer(h, w_in, q_gain, k_gain, w_out):
    b, s, _ = h.shape
    qkv = (h @ w_in).reshape(b, s, 3, C_HEADS, HEAD_DIM)
    q = rms_norm(qkv[:, :, 0], q_gain)
    k = rms_norm(qkv[:, :, 1], k_gain)
    o = dilated_attention(q, k, qkv[:, :, 2], alibi_slopes(C_HEADS))
    return o.reshape(b, s, ODD_MIX) @ w_out


def memory_cross_attention(h, m, w_q, w_kv, q_gain, k_gain, w_o):
    b, s, _ = h.shape
    q = rms_norm((h @ w_q).reshape(b, s, X_HEADS, X_HEAD_DIM), q_gain)
    kv = (m @ w_kv).reshape(b, m.shape[1], 2, X_HEADS, X_HEAD_DIM)
    k = rms_norm(kv[:, :, 0], k_gain)
    v = kv[:, :, 1]
    sc = jnp.einsum('bqhd,bkhd->bhqk', q, k).astype(jnp.float32) * (X_HEAD_DIM ** -0.5)
    p = jax.nn.softmax(sc, axis=-1).astype(v.dtype)
    o = jnp.einsum('bhqk,bkhd->bqhd', p, v).reshape(b, s, X_HEADS * X_HEAD_DIM)
    return o @ w_o


def setup_inputs(seed: int = 0) -> dict:
    key = jax.random.key(seed)
    k = jax.random.split(key, 25)
    n_even = (DEPTH + 1) // 2
    n_odd = DEPTH // 2
    f32 = jnp.float32

    def dense(kk, shape, fan_in):
        return jax.random.normal(kk, shape, f32) * (fan_in ** -0.5)

    def gain(kk, shape):
        return 1.0 + 0.02 * jax.random.normal(kk, shape, f32)

    return {
        'x': jax.random.normal(k[0], (BATCH, SEQ, D_MODEL), f32),
        'mem': jax.random.normal(k[1], (BATCH, MEM_LEN, D_MODEL), f32),
        'ffn1_norm': gain(k[2], (DEPTH, D_MODEL)),
        'ffn1_w_gu': dense(k[3], (DEPTH, D_MODEL, 2 * D_FF), D_MODEL),
        'ffn1_w_down': dense(k[4], (DEPTH, D_FF, D_MODEL), D_FF),
        'mix_norm': gain(k[5], (DEPTH, D_MODEL)),
        'ev_w_in': dense(k[6], (n_even, D_MODEL, EVEN_IN), D_MODEL),
        'ev_q_gain': gain(k[7], (n_even, HEAD_DIM)),
        'ev_k_gain': gain(k[8], (n_even, HEAD_DIM)),
        'ev_sinks': 0.5 * jax.random.normal(k[9], (n_even, A_Q_HEADS), f32),
        'ev_w_out': dense(k[10], (n_even, EVEN_MIX, D_MODEL), EVEN_MIX),
        'od_w_in': dense(k[11], (n_odd, D_MODEL, ODD_IN), D_MODEL),
        'od_q_gain': gain(k[12], (n_odd, HEAD_DIM)),
        'od_k_gain': gain(k[13], (n_odd, HEAD_DIM)),
        'od_w_out': dense(k[14], (n_odd, ODD_MIX, D_MODEL), ODD_MIX),
        'xa_norm': gain(k[15], (DEPTH, D_MODEL)),
        'xa_mem_norm': gain(k[16], (DEPTH, D_MODEL)),
        'xa_w_q': dense(k[17], (DEPTH, D_MODEL, X_HEADS * X_HEAD_DIM), D_MODEL),
        'xa_w_kv': dense(k[18], (DEPTH, D_MODEL, 2 * X_HEADS * X_HEAD_DIM), D_MODEL),
        'xa_q_gain': gain(k[19], (DEPTH, X_HEAD_DIM)),
        'xa_k_gain': gain(k[20], (DEPTH, X_HEAD_DIM)),
        'xa_w_o': dense(k[21], (DEPTH, X_HEADS * X_HEAD_DIM, D_MODEL), X_HEADS * X_HEAD_DIM),
        'ffn2_norm': gain(k[22], (DEPTH, D_MODEL)),
        'ffn2_w_gu': dense(k[23], (DEPTH, D_MODEL, 2 * D_FF), D_MODEL),
        'ffn2_w_down': dense(k[24], (DEPTH, D_FF, D_MODEL), D_FF),
    }


def reference(x, mem, ffn1_norm, ffn1_w_gu, ffn1_w_down, mix_norm,
              ev_w_in, ev_q_gain, ev_k_gain, ev_sinks, ev_w_out,
              od_w_in, od_q_gain, od_k_gain, od_w_out,
              xa_norm, xa_mem_norm, xa_w_q, xa_w_kv, xa_q_gain, xa_k_gain, xa_w_o,
              ffn2_norm, ffn2_w_gu, ffn2_w_down):
    for layer in range(DEPTH):
        x = x + 0.5 * swiglu_ffn(rms_norm(x, ffn1_norm[layer]), ffn1_w_gu[layer], ffn1_w_down[layer])
        h = rms_norm(x, mix_norm[layer])
        if layer % 2 == 0:
            j = layer // 2
            x = x + even_mixer(h, ev_w_in[j], ev_q_gain[j], ev_k_gain[j], ev_sinks[j], ev_w_out[j])
        else:
            j = layer // 2
            x = x + odd_mixer(h, od_w_in[j], od_q_gain[j], od_k_gain[j], od_w_out[j])
        x = x + memory_cross_attention(rms_norm(x, xa_norm[layer]), rms_norm(mem, xa_mem_norm[layer]),
                                       xa_w_q[layer], xa_w_kv[layer], xa_q_gain[layer],
                                       xa_k_gain[layer], xa_w_o[layer])
        x = x + 0.5 * swiglu_ffn(rms_norm(x, ffn2_norm[layer]), ffn2_w_gu[layer], ffn2_w_down[layer])
    return x
```

```cpp
#include <hip/hip_runtime.h>
#include <hip/hip_cooperative_groups.h>
#include <cstdio>
#include <cstdint>
namespace cg = cooperative_groups;

#define DI __device__ __forceinline__
typedef unsigned short bf16_t;
typedef short bf16x8 __attribute__((ext_vector_type(8)));
typedef short s16x4 __attribute__((ext_vector_type(4)));
typedef float f32x16 __attribute__((ext_vector_type(16)));
typedef __bf16 bf2_t __attribute__((ext_vector_type(2)));
typedef float f2_t __attribute__((ext_vector_type(2)));
typedef short v4i16_t __attribute__((ext_vector_type(4)));
#define MFMA(a, b, c) __builtin_amdgcn_mfma_f32_32x32x16_bf16((a), (b), (c), 0, 0, 0)

constexpr int T = 16384, S = 4096, D = 1024, DFF = 2816, NGU = 5632;
constexpr float EPS = 1e-6f;
constexpr float LOG2E = 1.4426950408889634f;
constexpr float LN2 = 0.6931471805599453f;

constexpr size_t SZ_GU = (size_t)NGU * D * 2, SZ_DN = (size_t)D * DFF * 2, SZ_MM = (size_t)D * D * 2;
constexpr size_t OFF_GU1 = 0;
constexpr size_t OFF_DN1 = OFF_GU1 + 2 * SZ_GU;
constexpr size_t OFF_GU2 = OFF_DN1 + 2 * SZ_DN;
constexpr size_t OFF_DN2 = OFF_GU2 + 2 * SZ_GU;
constexpr size_t OFF_WQ = OFF_DN2 + 2 * SZ_DN;
constexpr size_t OFF_WKV = OFF_WQ + 2 * SZ_MM;
constexpr size_t OFF_WO = OFF_WKV + 4 * SZ_MM;
constexpr size_t OFF_EVIN = OFF_WO + 2 * SZ_MM;
constexpr size_t OFF_EVOUT = OFF_EVIN + (size_t)2304 * D * 2;
constexpr size_t OFF_ODIN = OFF_EVOUT + SZ_MM;
constexpr size_t OFF_ODOUT = OFF_ODIN + (size_t)3072 * D * 2;
constexpr size_t OFF_XB = OFF_ODOUT + SZ_MM;
constexpr size_t OFF_BIG = OFF_XB + (size_t)T * D * 2;
constexpr size_t OFF_MEMB = OFF_BIG + (size_t)T * 3072 * 2;
constexpr size_t OFF_KN = OFF_MEMB + SZ_MM;
constexpr size_t OFF_VT = OFF_KN + 2 * SZ_MM;
constexpr size_t OFF_SSQ = OFF_VT + 2 * SZ_MM;
constexpr size_t OFF_SSQM = OFF_SSQ + (size_t)9 * T * 4;
constexpr size_t WS_NEED = OFF_SSQM + 4096;

constexpr int LDS_BYTES = 73728;
constexpr int STAGE_B = 36864;
constexpr int OPB = 18432;

struct Params { const float* in[25]; float* out; char* ws; };

DI unsigned pk2(float a, float b) { f2_t v = {a, b}; bf2_t r = __builtin_convertvector(v, bf2_t); return __builtin_bit_cast(unsigned, r); }
DI float bflo(unsigned w) { return __uint_as_float(w << 16); }
DI float bfhi(unsigned w) { return __uint_as_float(w & 0xffff0000u); }
DI int otid() { int t = threadIdx.x; asm volatile("" : "+v"(t)); return t; }
DI int crow(int i, int h) { return (i & 3) + 8 * (i >> 2) + 4 * h; }
DI float fexp2(float x) { return __builtin_amdgcn_exp2f(x); }
DI float flog2(float x) { return __builtin_amdgcn_logf(x); }

struct WJob { const float* src; bf16_t* dst; const float* gain; int K, N, gu; };

DI int wjob_tiles(int j) {
    if (j < 14) {
        const int kind = j >> 1;
        switch (kind) {
            case 0: case 2: return 16 * 88;
            case 1: case 3: return 44 * 16;
            case 4: return 256;
            case 5: return 512;
            default: return 256;
        }
    }
    if (j == 14) return 16 * 36;
    if (j == 16) return 16 * 48;
    return 256;
}

DI WJob get_wjob(const Params& P, int j) {
    WJob w; w.gain = nullptr; w.gu = 0;
    bf16_t* wsb = (bf16_t*)P.ws;
    if (j < 14) {
        const int kind = j >> 1, l = j & 1;
        switch (kind) {
            case 0: w.src = P.in[3] + (size_t)l * D * NGU; w.dst = (bf16_t*)(P.ws + OFF_GU1 + l * SZ_GU); w.gain = P.in[2] + l * D; w.K = D; w.N = NGU; w.gu = 1; break;
            case 1: w.src = P.in[4] + (size_t)l * DFF * D; w.dst = (bf16_t*)(P.ws + OFF_DN1 + l * SZ_DN); w.K = DFF; w.N = D; break;
            case 2: w.src = P.in[23] + (size_t)l * D * NGU; w.dst = (bf16_t*)(P.ws + OFF_GU2 + l * SZ_GU); w.gain = P.in[22] + l * D; w.K = D; w.N = NGU; w.gu = 1; break;
            case 3: w.src = P.in[24] + (size_t)l * DFF * D; w.dst = (bf16_t*)(P.ws + OFF_DN2 + l * SZ_DN); w.K = DFF; w.N = D; break;
            case 4: w.src = P.in[17] + (size_t)l * D * D; w.dst = (bf16_t*)(P.ws + OFF_WQ + l * SZ_MM); w.gain = P.in[15] + l * D; w.K = D; w.N = D; break;
            case 5: w.src = P.in[18] + (size_t)l * D * 2048; w.dst = (bf16_t*)(P.ws + OFF_WKV + l * 2 * SZ_MM); w.gain = P.in[16] + l * D; w.K = D; w.N = 2048; break;
            default: w.src = P.in[21] + (size_t)l * D * D; w.dst = (bf16_t*)(P.ws + OFF_WO + l * SZ_MM); w.K = D; w.N = D; break;
        }
    } else if (j == 14) { w.src = P.in[6]; w.dst = (bf16_t*)(P.ws + OFF_EVIN); w.gain = P.in[5]; w.K = D; w.N = 2304; }
    else if (j == 15) { w.src = P.in[10]; w.dst = (bf16_t*)(P.ws + OFF_EVOUT); w.K = D; w.N = D; }
    else if (j == 16) { w.src = P.in[11]; w.dst = (bf16_t*)(P.ws + OFF_ODIN); w.gain = P.in[5] + D; w.K = D; w.N = 3072; }
    else { w.src = P.in[14]; w.dst = (bf16_t*)(P.ws + OFF_ODOUT); w.K = D; w.N = D; }
    (void)wsb;
    return w;
}

DI void wconv_tile(const WJob& w, int t, float* sm) {
    const int ntn = w.N >> 6; const int tk = t / ntn, tn = t - tk * ntn;
    const int tid = otid();
#pragma unroll
    for (int p = 0; p < 4; ++p) {
        const int kr = p * 16 + (tid >> 4);
        const float4 v = *(const float4*)(w.src + (size_t)(tk * 64 + kr) * w.N + tn * 64 + (tid & 15) * 4);
        const float g = w.gain ? w.gain[tk * 64 + kr] : 1.f;
        float* sp = sm + kr * 65 + (tid & 15) * 4;
        sp[0] = v.x * g; sp[1] = v.y * g; sp[2] = v.z * g; sp[3] = v.w * g;
    }
    __syncthreads();
    const int n = tid >> 2, kq = tid & 3; const int ng = tn * 64 + n;
    int drow = ng;
    if (w.gu) drow = ng < DFF ? ((ng >> 5) * 64 + (ng & 31)) : (((ng - DFF) >> 5) * 64 + 32 + ((ng - DFF) & 31));
    unsigned o[8];
#pragma unroll
    for (int e = 0; e < 8; ++e) o[e] = pk2(sm[(kq * 16 + 2 * e) * 65 + n], sm[(kq * 16 + 2 * e + 1) * 65 + n]);
    uint4* dp = (uint4*)(w.dst + (size_t)drow * w.K + tk * 64 + kq * 16);
    dp[0] = make_uint4(o[0], o[1], o[2], o[3]); dp[1] = make_uint4(o[4], o[5], o[6], o[7]);
    __syncthreads();
}

DI float wave_sum(float v) {
    v += __shfl_xor(v, 1); v += __shfl_xor(v, 2); v += __shfl_xor(v, 4); v += __shfl_xor(v, 8); v += __shfl_xor(v, 16); v += __shfl_xor(v, 32);
    return v;
}

DI void rowconv(const float* src, bf16_t* dst, float* ssq, int row, int lane) {
    const float* xr = src + (size_t)row * D;
    float ss = 0.f;
#pragma unroll
    for (int p = 0; p < 4; ++p) {
        const float4 v = *(const float4*)(xr + p * 256 + lane * 4);
        ss += v.x * v.x + v.y * v.y + v.z * v.z + v.w * v.w;
        *(uint2*)(dst + (size_t)row * D + p * 256 + lane * 4) = make_uint2(pk2(v.x, v.y), pk2(v.z, v.w));
    }
    ss = wave_sum(ss);
    if (lane == 0) ssq[row] = ss;
}

DI void phase0(const Params& P, char* smem) {
    const int tid = otid(), lane = tid & 63, wid = tid >> 6;
    float* ssq = (float*)(P.ws + OFF_SSQ);
    for (int i = blockIdx.x * 256 + tid; i < 8 * T; i += gridDim.x * 256) ssq[T + i] = 0.f;
    constexpr int NW = 12352, NX = T / 4, NM = 1024 / 4;
    for (int u = blockIdx.x; u < NW + NX + NM; u += gridDim.x) {
        if (u < NW) {
            int t = u, j = 0;
            for (; j < 17; ++j) { const int c = wjob_tiles(j); if (t < c) break; t -= c; }
            const WJob w = get_wjob(P, j);
            wconv_tile(w, t, (float*)smem);
        } else if (u < NW + NX) {
            rowconv(P.in[0], (bf16_t*)(P.ws + OFF_XB), ssq, (u - NW) * 4 + wid, lane);
        } else {
            rowconv(P.in[1], (bf16_t*)(P.ws + OFF_MEMB), (float*)(P.ws + OFF_SSQM), (u - NW - NX) * 4 + wid, lane);
        }
    }
}

struct GJob {
    const bf16_t* A; const bf16_t* W;
    int lda, ksplit, kextra, K, ntm, ntn, mode;
    const float* rs;
    bf16_t* O; int ldo;
    const float* xin; float* xout; bf16_t* xb; float* ssq_out; float alpha;
    const float* qg; const float* kg; int qn_end, kn_end;
    bf16_t* vt;
};

DI void gemm_tile(const GJob& J, int t, char* smem) {
    const int tid = otid(), lane = tid & 63, wid = tid >> 6, wr = wid >> 1, wc = wid & 1;
    const int r = lane & 31, h = lane >> 5;
    int tm, tn;
    { const int gsz = 32 * J.ntn; const int g = t / gsz; const int rem = t - g * gsz; const int rows = min(32, J.ntm - g * 32); tn = rem / rows; tm = g * 32 + (rem - tn * rows); }
    const int lrow = tid >> 3, lch = tid & 7;
    const bf16_t* Ag = J.A + (size_t)(tm * 128 + lrow) * J.lda + lch * 8;
    const bf16_t* Wg = J.W + (size_t)(tn * 128 + lrow) * J.K + lch * 8;
    const int nk = J.K >> 6;
    const size_t astr = (size_t)32 * J.lda, wstr = (size_t)32 * J.K;
    uint4 ra0, ra1, ra2, ra3, rw0, rw1, rw2, rw3;
#define GLOAD(kt) do { const int k0_ = (kt) * 64; const int ka_ = k0_ + (k0_ >= J.ksplit ? J.kextra : 0); \
        ra0 = *(const uint4*)(Ag + ka_); ra1 = *(const uint4*)(Ag + astr + ka_); ra2 = *(const uint4*)(Ag + 2 * astr + ka_); ra3 = *(const uint4*)(Ag + 3 * astr + ka_); \
        rw0 = *(const uint4*)(Wg + k0_); rw1 = *(const uint4*)(Wg + wstr + k0_); rw2 = *(const uint4*)(Wg + 2 * wstr + k0_); rw3 = *(const uint4*)(Wg + 3 * wstr + k0_); } while (0)
#define SWRITE(buf) do { char* sa_ = smem + (buf) * STAGE_B + lrow * 144 + lch * 16; char* sw_ = sa_ + OPB; \
        *(uint4*)(sa_) = ra0; *(uint4*)(sa_ + 32 * 144) = ra1; *(uint4*)(sa_ + 64 * 144) = ra2; *(uint4*)(sa_ + 96 * 144) = ra3; \
        *(uint4*)(sw_) = rw0; *(uint4*)(sw_ + 32 * 144) = rw1; *(uint4*)(sw_ + 64 * 144) = rw2; *(uint4*)(sw_ + 96 * 144) = rw3; } while (0)
    f32x16 acc[2][2];
#pragma unroll
    for (int a = 0; a < 2; ++a)
#pragma unroll
        for (int b = 0; b < 2; ++b)
#pragma unroll
            for (int i = 0; i < 16; ++i) acc[a][b][i] = 0.f;

    GLOAD(0); SWRITE(0); __syncthreads();
    for (int kt = 0; kt < nk; ++kt) {
        if (kt + 1 < nk) GLOAD(kt + 1);
        const char* sa = smem + (kt & 1) * STAGE_B; const char* sw = sa + OPB;
#pragma unroll
        for (int ks = 0; ks < 4; ++ks) {
            bf16x8 wf[2], xf[2];
#pragma unroll
            for (int fi = 0; fi < 2; ++fi) wf[fi] = *(const bf16x8*)(sw + (wr * 64 + fi * 32 + r) * 144 + ks * 32 + h * 16);
#pragma unroll
            for (int ti = 0; ti < 2; ++ti) xf[ti] = *(const bf16x8*)(sa + (wc * 64 + ti * 32 + r) * 144 + ks * 32 + h * 16);
#pragma unroll
            for (int fi = 0; fi < 2; ++fi)
#pragma unroll
                for (int ti = 0; ti < 2; ++ti) acc[fi][ti] = MFMA(wf[fi], xf[ti], acc[fi][ti]);
        }
        if (kt + 1 < nk) SWRITE((kt + 1) & 1);
        __syncthreads();
    }
#undef GLOAD
#undef SWRITE

    const int tokb = tm * 128 + wc * 64;
    const int fb = tn * 128 + wr * 64;
    float rsc[2];
#pragma unroll
    for (int ti = 0; ti < 2; ++ti) rsc[ti] = J.rs ? __builtin_amdgcn_rsqf(J.rs[tokb + ti * 32 + r] * (1.f / 1024.f) + EPS) : 1.f;

    if (J.mode == 0) {
        const int cb = fb >> 1;
#pragma unroll
        for (int ti = 0; ti < 2; ++ti) {
            const size_t tok = tokb + ti * 32 + r;
            bf16_t* op = J.O + tok * J.ldo + cb + 4 * h;
#pragma unroll
            for (int g = 0; g < 4; ++g) {
                float y[4];
#pragma unroll
                for (int j = 0; j < 4; ++j) {
                    const float ga = acc[0][ti][4 * g + j] * rsc[ti], up = acc[1][ti][4 * g + j] * rsc[ti];
                    y[j] = ga * up * __builtin_amdgcn_rcpf(1.f + fexp2(-ga * LOG2E));
                }
                *(uint2*)(op + 8 * g) = make_uint2(pk2(y[0], y[1]), pk2(y[2], y[3]));
            }
        }
    } else if (J.mode == 1) {
#pragma unroll
        for (int ti = 0; ti < 2; ++ti) {
            const size_t tok = tokb + ti * 32 + r;
            float ss = 0.f;
#pragma unroll
            for (int fi = 0; fi < 2; ++fi)
#pragma unroll
                for (int g = 0; g < 4; ++g) {
                    const int col = fb + fi * 32 + 8 * g + 4 * h;
                    const float4 xo = *(const float4*)(J.xin + tok * D + col);
                    float4 xn;
                    xn.x = xo.x + J.alpha * acc[fi][ti][4 * g + 0]; xn.y = xo.y + J.alpha * acc[fi][ti][4 * g + 1];
                    xn.z = xo.z + J.alpha * acc[fi][ti][4 * g + 2]; xn.w = xo.w + J.alpha * acc[fi][ti][4 * g + 3];
                    *(float4*)(J.xout + tok * D + col) = xn;
                    *(uint2*)(J.xb + tok * D + col) = make_uint2(pk2(xn.x, xn.y), pk2(xn.z, xn.w));
                    ss += xn.x * xn.x + xn.y * xn.y + xn.z * xn.z + xn.w * xn.w;
                }
            ss += __shfl_xor(ss, 32);
            if (h == 0) atomicAdd(J.ssq_out + tok, ss);
        }
    } else if (J.mode == 3 && fb >= 1024) {
#pragma unroll
        for (int ti = 0; ti < 2; ++ti) {
            const int tok = tokb + ti * 32 + r;
#pragma unroll
            for (int fi = 0; fi < 2; ++fi)
#pragma unroll
                for (int i = 0; i < 16; ++i) {
                    const int f = fb - 1024 + fi * 32 + crow(i, h);
                    J.vt[(((size_t)(tok >> 8) * 1024 + f) << 8) + (tok & 255)] = (bf16_t)(pk2(acc[fi][ti][i] * rsc[ti], 0.f) & 0xffffu);
                }
        }
    } else {
        const int nm = fb < J.qn_end ? 1 : (fb < J.kn_end ? 2 : 0);
        const float* gp = nm == 1 ? J.qg : J.kg;
#pragma unroll
        for (int ti = 0; ti < 2; ++ti) {
            const size_t tok = tokb + ti * 32 + r;
            float sc = rsc[ti];
            if (nm) {
                float ss = 0.f;
#pragma unroll
                for (int fi = 0; fi < 2; ++fi)
#pragma unroll
                    for (int i = 0; i < 16; ++i) { const float v = acc[fi][ti][i] * sc; ss += v * v; }
                ss += __shfl_xor(ss, 32);
                sc *= __builtin_amdgcn_rsqf(ss * (1.f / 64.f) + EPS);
            }
#pragma unroll
            for (int fi = 0; fi < 2; ++fi)
#pragma unroll
                for (int g = 0; g < 4; ++g) {
                    float4 gn = make_float4(1.f, 1.f, 1.f, 1.f);
                    if (nm) gn = *(const float4*)(gp + fi * 32 + 8 * g + 4 * h);
                    *(uint2*)(J.O + tok * J.ldo + fb + fi * 32 + 8 * g + 4 * h) =
                        make_uint2(pk2(acc[fi][ti][4 * g + 0] * sc * gn.x, acc[fi][ti][4 * g + 1] * sc * gn.y),
                                   pk2(acc[fi][ti][4 * g + 2] * sc * gn.z, acc[fi][ti][4 * g + 3] * sc * gn.w));
                }
        }
    }
}

DI void gemm_phase(const GJob& JA, int nA, int nB, const Params& P, char* smem) {
    for (int u = blockIdx.x; u < nA + nB; u += gridDim.x) {
        GJob J = JA; int t = u;
        if (u >= nA) {
            const int v = u - nA; const int layer = v >> 7; t = v & 127;
            J.A = (const bf16_t*)(P.ws + OFF_MEMB); J.lda = D; J.ksplit = 1 << 30; J.kextra = 0;
            J.W = (const bf16_t*)(P.ws + OFF_WKV + (size_t)layer * 2 * SZ_MM); J.K = D; J.ntm = 8; J.ntn = 16; J.mode = 3;
            J.rs = (const float*)(P.ws + OFF_SSQM); J.O = (bf16_t*)(P.ws + OFF_KN + (size_t)layer * SZ_MM); J.ldo = D;
            J.qn_end = 0; J.kn_end = 0; J.vt = (bf16_t*)(P.ws + OFF_VT + (size_t)layer * SZ_MM);
        }
        gemm_tile(J, t, smem);
    }
}

DI void v_stage(const bf16_t* base, int ld, size_t rowb, int vcol, int kb, int dil, int lane, char* vl) {
    const int kk = lane >> 3;
    const bf16_t* bp = base + vcol + (lane & 7) * 8;
    const uint4 v0 = *(const uint4*)(bp + (rowb + min(max(kb + dil * kk, 0), S - 1)) * ld);
    const uint4 v1 = *(const uint4*)(bp + (rowb + min(max(kb + dil * (kk + 8), 0), S - 1)) * ld);
    const uint4 v2 = *(const uint4*)(bp + (rowb + min(max(kb + dil * (kk + 16), 0), S - 1)) * ld);
    const uint4 v3 = *(const uint4*)(bp + (rowb + min(max(kb + dil * (kk + 24), 0), S - 1)) * ld);
    char* wp = vl + kk * 144 + (lane & 7) * 16;
    asm volatile("" ::: "memory");
    *(uint4*)(wp) = v0; *(uint4*)(wp + 8 * 144) = v1; *(uint4*)(wp + 16 * 144) = v2; *(uint4*)(wp + 24 * 144) = v3;
    asm volatile("" ::: "memory");
}

DI bf16x8 v_frag(const char* vbase, int s, int dt) {
    typedef __attribute__((address_space(3))) v4i16_t* lp_t;
    const char* a = vbase + s * (16 * 144) + dt * 64;
    const s16x4 lo = __builtin_bit_cast(s16x4, __builtin_amdgcn_ds_read_tr16_b64_v4i16((lp_t)(a)));
    const s16x4 hi = __builtin_bit_cast(s16x4, __builtin_amdgcn_ds_read_tr16_b64_v4i16((lp_t)(a + 8 * 144)));
    return __builtin_shufflevector(lo, hi, 0, 1, 2, 3, 4, 5, 6, 7);
}

template <int OFF> DI bf16x8 pack8v(const f32x16& p) {
    typedef unsigned u32x4 __attribute__((ext_vector_type(4)));
    u32x4 w; w[0] = pk2(p[OFF + 0], p[OFF + 1]); w[1] = pk2(p[OFF + 2], p[OFF + 3]); w[2] = pk2(p[OFF + 4], p[OFF + 5]); w[3] = pk2(p[OFF + 6], p[OFF + 7]);
    return __builtin_bit_cast(bf16x8, w);
}

DI void win_attn_wave(bf16_t* qkv, int ld, int b, int qcol, int kcol, int vcol, int tq0, int qstride,
                      float slope2, float m_init, float l_init, int mode, char* vl, int lane) {
    const int r = lane & 31, h = lane >> 5;
    const size_t rowb = (size_t)b * S;
    const int tq = tq0 + qstride * r;
    const int tqlast = tq0 + qstride * 31;
    bf16x8 qf[4];
    {
        const bf16_t* qp = qkv + (rowb + tq) * ld + qcol + h * 32;
#pragma unroll
        for (int ks = 0; ks < 4; ++ks) qf[ks] = *(const bf16x8*)(qp + ks * 8);
    }
    f32x16 o0, o1;
#pragma unroll
    for (int i = 0; i < 16; ++i) { o0[i] = 0.f; o1[i] = 0.f; }
    float m = m_init, l = (h == 0) ? l_init : 0.f;
    const float sc2 = 0.125f * LOG2E;
    const int i16 = lane & 15;
    const char* vbase = vl + (4 * h + (i16 >> 2)) * 144 + (16 * ((lane >> 4) & 1) + 4 * (i16 & 3)) * 2;
    const int npat = mode ? 3 : 1;
    for (int pi = 0; pi < npat; ++pi) {
        int dil, W, kfirst, nt;
        if (!mode) { dil = 1; W = 127; kfirst = tq0 - 128; nt = 5; }
        else if (pi == 0) { dil = 1; W = 128; kfirst = tq0 - 128; nt = 20; }
        else if (pi == 1) { dil = 4; W = 512; kfirst = tq0 - 512; nt = 8; }
        else { dil = 16; W = 2048; kfirst = tq0 - 2048; nt = 5; }
        for (int tile = 0; tile < nt; ++tile) {
            const int kb = kfirst + tile * 32 * dil;
            if (kb + 31 * dil < 0) continue;
            if (kb > tqlast) continue;
            bf16x8 kf[4];
            {
                const int tk = min(max(kb + dil * r, 0), S - 1);
                const bf16_t* kp = qkv + (rowb + tk) * ld + kcol + h * 32;
#pragma unroll
                for (int ks = 0; ks < 4; ++ks) kf[ks] = *(const bf16x8*)(kp + ks * 8);
            }
            v_stage(qkv, ld, rowb, vcol, kb, dil, lane, vl);
            f32x16 s;
#pragma unroll
            for (int i = 0; i < 16; ++i) s[i] = 0.f;
#pragma unroll
            for (int ks = 0; ks < 4; ++ks) s = MFMA(kf[ks], qf[ks], s);
            f32x16 sv; float mloc = -INFINITY;
#pragma unroll
            for (int i = 0; i < 16; ++i) {
                const int tki = kb + dil * crow(i, h);
                const int diff = tq - tki;
                const bool valid = (diff >= 0) && (diff <= W) && (tki >= 0);
                sv[i] = valid ? (s[i] * sc2 - slope2 * (float)diff) : -INFINITY;
                mloc = fmaxf(mloc, sv[i]);
            }
            mloc = fmaxf(mloc, __shfl_xor(mloc, 32));
            const float mn = fmaxf(m, mloc);
            const float alpha = fexp2(m - mn);
            m = mn;
            float ps = 0.f;
#pragma unroll
            for (int i = 0; i < 16; ++i) { sv[i] = fexp2(sv[i] - mn); ps += sv[i]; }
            l = l * alpha + ps;
#pragma unroll
            for (int i = 0; i < 16; ++i) { o0[i] *= alpha; o1[i] *= alpha; }
            const bf16x8 p0 = pack8v<0>(sv), p1 = pack8v<8>(sv);
            o0 = MFMA(v_frag(vbase, 0, 0), p0, o0);
            o0 = MFMA(v_frag(vbase, 1, 0), p1, o0);
            o1 = MFMA(v_frag(vbase, 0, 1), p0, o1);
            o1 = MFMA(v_frag(vbase, 1, 1), p1, o1);
            asm volatile("" ::: "memory");
        }
    }
    const float lt = l + __shfl_xor(l, 32);
    const float inv = 1.f / lt;
    bf16_t* op = qkv + (rowb + tq) * ld + qcol + 4 * h;
#pragma unroll
    for (int g = 0; g < 4; ++g) {
        *(uint2*)(op + 8 * g) = make_uint2(pk2(o0[4 * g] * inv, o0[4 * g + 1] * inv), pk2(o0[4 * g + 2] * inv, o0[4 * g + 3] * inv));
        *(uint2*)(op + 32 + 8 * g) = make_uint2(pk2(o1[4 * g] * inv, o1[4 * g + 1] * inv), pk2(o1[4 * g + 2] * inv, o1[4 * g + 3] * inv));
    }
}

DI void stick_wave(bf16_t* qkv, int ld, int b, int qcol, int kcol, int vcol, int qt, char* vl, int lane) {
    const int r = lane & 31, h = lane >> 5;
    const size_t rowb = (size_t)b * S;
    const int tq = qt * 32 + r;
    bf16x8 qf[4];
    {
        const bf16_t* qp = qkv + (rowb + tq) * ld + qcol + h * 32;
#pragma unroll
        for (int ks = 0; ks < 4; ++ks) qf[ks] = *(const bf16x8*)(qp + ks * 8);
    }
    f32x16 o0, o1;
#pragma unroll
    for (int i = 0; i < 16; ++i) { o0[i] = 0.f; o1[i] = 0.f; }
    float R = 0.f;
    const int i16 = lane & 15;
    const char* vbase = vl + (4 * h + (i16 >> 2)) * 144 + (16 * ((lane >> 4) & 1) + 4 * (i16 & 3)) * 2;
    for (int tile = qt; tile >= 0; --tile) {
        const int kb = tile * 32;
        bf16x8 kf[4];
        {
            const bf16_t* kp = qkv + (rowb + kb + r) * ld + kcol + h * 32;
#pragma unroll
            for (int ks = 0; ks < 4; ++ks) kf[ks] = *(const bf16x8*)(kp + ks * 8);
        }
        v_stage(qkv, ld, rowb, vcol, kb, 1, lane, vl);
        f32x16 s;
#pragma unroll
        for (int i = 0; i < 16; ++i) s[i] = 0.f;
#pragma unroll
        for (int ks = 0; ks < 4; ++ks) s = MFMA(kf[ks], qf[ks], s);
        const bool diag = (tile == qt);
        f32x16 z, lk;
#pragma unroll
        for (int i = 0; i < 16; ++i) {
            const float zz = s[i] * 0.125f;
            const bool strict = (!diag) || (crow(i, h) < r);
            const float e = fexp2(-fabsf(zz) * LOG2E);
            const float sp = fmaxf(zz, 0.f) + flog2(1.f + e) * LN2;
            z[i] = strict ? zz : -INFINITY;
            lk[i] = strict ? -sp : 0.f;
        }
        float G[4], PG[4], both[4];
#pragma unroll
        for (int g = 0; g < 4; ++g) { G[g] = (lk[4 * g] + lk[4 * g + 1]) + (lk[4 * g + 2] + lk[4 * g + 3]); PG[g] = __shfl_xor(G[g], 32); both[g] = G[g] + PG[g]; }
        float Sx[4];
        Sx[3] = 0.f; Sx[2] = both[3]; Sx[1] = both[3] + both[2]; Sx[0] = Sx[1] + both[1];
        f32x16 a;
#pragma unroll
        for (int g = 0; g < 4; ++g) {
            float la = R + Sx[g] + (h == 0 ? PG[g] : 0.f);
#pragma unroll
            for (int j = 3; j >= 0; --j) {
                a[4 * g + j] = fexp2((z[4 * g + j] + lk[4 * g + j] + la) * LOG2E);
                la += lk[4 * g + j];
            }
        }
        R += Sx[0] + both[0];
        const bf16x8 p0 = pack8v<0>(a), p1 = pack8v<8>(a);
        o0 = MFMA(v_frag(vbase, 0, 0), p0, o0);
        o0 = MFMA(v_frag(vbase, 1, 0), p1, o0);
        o1 = MFMA(v_frag(vbase, 0, 1), p0, o1);
        o1 = MFMA(v_frag(vbase, 1, 1), p1, o1);
        asm volatile("" ::: "memory");
    }
    bf16_t* op = qkv + (rowb + tq) * ld + qcol + 4 * h;
#pragma unroll
    for (int g = 0; g < 4; ++g) {
        *(uint2*)(op + 8 * g) = make_uint2(pk2(o0[4 * g], o0[4 * g + 1]), pk2(o0[4 * g + 2], o0[4 * g + 3]));
        *(uint2*)(op + 32 + 8 * g) = make_uint2(pk2(o1[4 * g], o1[4 * g + 1]), pk2(o1[4 * g + 2], o1[4 * g + 3]));
    }
}

DI void attn_even_phase(const Params& P, char* smem) {
    const int tid_ = otid(); const int lane = tid_ & 63, wid = tid_ >> 6;
    bf16_t* qkv = (bf16_t*)(P.ws + OFF_BIG);
    char* vl = smem + wid * 8192;
    for (int u = blockIdx.x; u < 512 + 1024; u += gridDim.x) {
        if (u < 512) {
            const int bh = u >> 4, j = u & 15; const int b = bh >> 3, head = bh & 7; const int p = j * 4 + wid;
            stick_wave(qkv, 2304, b, 768 + head * 64, 1280 + head * 64, 1792 + head * 64, 127 - p, vl, lane);
            stick_wave(qkv, 2304, b, 768 + head * 64, 1280 + head * 64, 1792 + head * 64, p, vl, lane);
        } else {
            const int v = u - 512; const int qt = v & 127; const int rest = v >> 7; const int b = rest >> 1, kvh = rest & 1;
            const int head = kvh * 4 + wid;
            const float slope = exp2f(-(float)(head + 1));
            const float sink = P.in[9][head];
            win_attn_wave(qkv, 2304, b, head * 64, 512 + kvh * 64, 640 + kvh * 64, qt * 32, 1, slope * LOG2E, sink * LOG2E, 1.f, 0, vl, lane);
        }
    }
}

DI void attn_odd_phase(const Params& P, char* smem) {
    const int tid_ = otid(); const int lane = tid_ & 63, wid = tid_ >> 6;
    bf16_t* qkv = (bf16_t*)(P.ws + OFF_BIG);
    char* vl = smem + wid * 8192;
    for (int u = blockIdx.x; u < 2048; u += gridDim.x) {
        const int u0 = (u & 7) * 32; const int res16 = ((u >> 3) & 3) * 4 + wid; const int head = (u >> 5) & 15; const int b = u >> 9;
        const float slope = exp2f(-0.5f * (float)(head + 1));
        win_attn_wave(qkv, 3072, b, head * 64, 1024 + head * 64, 2048 + head * 64, res16 + 16 * u0, 16, slope * LOG2E, -1e30f, 0.f, 1, vl, lane);
    }
}

DI void xattn_wave(bf16_t* qb, const bf16_t* Kn, const bf16_t* VT, const float* qg, int b, int head, int tok0, char* ql, int lane) {
    const int r = lane & 31, h = lane >> 5;
    const size_t token = (size_t)b * S + tok0 + r;
    bf16_t* qp = qb + token * D + head * 256 + h * 128;
    float ss = 0.f;
#pragma unroll
    for (int ks = 0; ks < 16; ++ks) {
        const uint4 v = *(const uint4*)(qp + ks * 8);
        const unsigned w[4] = {v.x, v.y, v.z, v.w};
#pragma unroll
        for (int e = 0; e < 4; ++e) { const float a = bflo(w[e]), c = bfhi(w[e]); ss += a * a + c * c; }
    }
    ss += __shfl_xor(ss, 32);
    const float inv = __builtin_amdgcn_rsqf(ss * (1.f / 256.f) + EPS);
#pragma unroll
    for (int ks = 0; ks < 16; ++ks) {
        const uint4 v = *(const uint4*)(qp + ks * 8);
        const float4 g0 = *(const float4*)(qg + h * 128 + ks * 8), g1 = *(const float4*)(qg + h * 128 + ks * 8 + 4);
        uint4 o;
        o.x = pk2(bflo(v.x) * inv * g0.x, bfhi(v.x) * inv * g0.y); o.y = pk2(bflo(v.y) * inv * g0.z, bfhi(v.y) * inv * g0.w);
        o.z = pk2(bflo(v.z) * inv * g1.x, bfhi(v.z) * inv * g1.y); o.w = pk2(bflo(v.w) * inv * g1.z, bfhi(v.w) * inv * g1.w);
        *(uint4*)(ql + (ks * 64 + lane) * 16) = o;
    }
    asm volatile("" ::: "memory");
    const float sc2 = 0.0625f * LOG2E;
    const bf16_t* kp0 = Kn + ((size_t)b * 256 + r) * D + head * 256 + h * 128;
    float m = -INFINITY;
#pragma unroll 1
    for (int tile = 0; tile < 8; ++tile) {
        f32x16 s;
#pragma unroll
        for (int i = 0; i < 16; ++i) s[i] = 0.f;
        const bf16_t* kp = kp0 + (size_t)tile * 32 * D;
#pragma unroll
        for (int ks = 0; ks < 16; ++ks) {
            const bf16x8 kf = *(const bf16x8*)(kp + ks * 8);
            const bf16x8 qf = *(const bf16x8*)(ql + (ks * 64 + lane) * 16);
            s = MFMA(kf, qf, s);
        }
#pragma unroll
        for (int i = 0; i < 16; ++i) m = fmaxf(m, s[i]);
    }
    m = fmaxf(m, __shfl_xor(m, 32));
    float l = 0.f;
    bf16x8 pf[8][2];
#pragma unroll
    for (int tile = 0; tile < 8; ++tile) {
        f32x16 s;
#pragma unroll
        for (int i = 0; i < 16; ++i) s[i] = 0.f;
        const bf16_t* kp = kp0 + (size_t)tile * 32 * D;
#pragma unroll
        for (int ks = 0; ks < 16; ++ks) {
            const bf16x8 kf = *(const bf16x8*)(kp + ks * 8);
            const bf16x8 qf = *(const bf16x8*)(ql + (ks * 64 + lane) * 16);
            s = MFMA(kf, qf, s);
        }
#pragma unroll
        for (int i = 0; i < 16; ++i) { s[i] = fexp2((s[i] - m) * sc2); l += s[i]; }
        pf[tile][0] = pack8v<0>(s); pf[tile][1] = pack8v<8>(s);
    }
    l += __shfl_xor(l, 32);
    const float il = 1.f / l;
    bf16_t* op = qb + token * D + head * 256 + 4 * h;
#pragma unroll 1
    for (int dt = 0; dt < 8; ++dt) {
        f32x16 o;
#pragma unroll
        for (int i = 0; i < 16; ++i) o[i] = 0.f;
        const bf16_t* vp = VT + (((size_t)b * 4 + head) * 256 + dt * 32 + r) * 256 + 4 * h;
#pragma unroll
        for (int tile = 0; tile < 8; ++tile)
#pragma unroll
            for (int s2 = 0; s2 < 2; ++s2) {
                const s16x4 lo = *(const s16x4*)(vp + tile * 32 + 16 * s2);
                const s16x4 hi = *(const s16x4*)(vp + tile * 32 + 16 * s2 + 8);
                o = MFMA(__builtin_shufflevector(lo, hi, 0, 1, 2, 3, 4, 5, 6, 7), pf[tile][s2], o);
            }
#pragma unroll
        for (int g = 0; g < 4; ++g)
            *(uint2*)(op + dt * 32 + 8 * g) = make_uint2(pk2(o[4 * g] * il, o[4 * g + 1] * il), pk2(o[4 * g + 2] * il, o[4 * g + 3] * il));
    }
}

DI void xattn_phase(const Params& P, int l, char* smem) {
    const int tid_ = otid(); const int lane = tid_ & 63, wid = tid_ >> 6;
    bf16_t* qb = (bf16_t*)(P.ws + OFF_BIG);
    const bf16_t* Kn = (const bf16_t*)(P.ws + OFF_KN + (size_t)l * SZ_MM);
    const bf16_t* VT = (const bf16_t*)(P.ws + OFF_VT + (size_t)l * SZ_MM);
    const float* qg = P.in[19] + l * 256;
    char* ql = smem + wid * 16384;
    for (int u = blockIdx.x; u < 512; u += gridDim.x) {
        const int qt = u & 31, head = (u >> 5) & 3, b = u >> 7;
        xattn_wave(qb, Kn, VT, qg, b, head, qt * 128 + wid * 32, ql, lane);
    }
}

DI void knorm_phase(const Params& P) {
    const int tid_ = otid(); const int lane = tid_ & 63, wid = tid_ >> 6;
    for (int u = blockIdx.x * 4 + wid; u < 8192; u += gridDim.x * 4) {
        const int l = u >> 12, row = (u >> 2) & 1023, head = u & 3;
        bf16_t* kp = (bf16_t*)(P.ws + OFF_KN + (size_t)l * SZ_MM) + (size_t)row * D + head * 256 + lane * 4;
        const uint2 v = *(const uint2*)kp;
        const float a0 = bflo(v.x), a1 = bfhi(v.x), a2 = bflo(v.y), a3 = bfhi(v.y);
        float ss = a0 * a0 + a1 * a1 + a2 * a2 + a3 * a3;
        ss = wave_sum(ss);
        const float inv = __builtin_amdgcn_rsqf(ss * (1.f / 256.f) + EPS);
        const float4 g = *(const float4*)(P.in[20] + l * 256 + lane * 4);
        *(uint2*)kp = make_uint2(pk2(a0 * inv * g.x, a1 * inv * g.y), pk2(a2 * inv * g.z, a3 * inv * g.w));
    }
}

__global__ void __launch_bounds__(256, 2) fwd_megakernel(Params P) {
    extern __shared__ __attribute__((aligned(16))) char smem[];
    cg::grid_group grid = cg::this_grid();
#pragma unroll 1
    for (int ph = 0; ph < 21; ++ph) {
        float* ssq = (float*)(P.ws + OFF_SSQ);
        bf16_t* xb = (bf16_t*)(P.ws + OFF_XB);
        bf16_t* big = (bf16_t*)(P.ws + OFF_BIG);
        if (ph == 0) {
            phase0(P, smem);
        } else {
            const int l = (ph - 1) / 10, s = (ph - 1) % 10;
            if (s == 3) {
                if (l == 0) attn_even_phase(P, smem); else attn_odd_phase(P, smem);
            } else if (s == 6) {
                xattn_phase(P, l, smem);
            } else {
                GJob J;
                J.A = xb; J.lda = D; J.ksplit = 1 << 30; J.kextra = 0; J.K = D; J.ntm = 128; J.mode = 1; J.rs = nullptr;
                J.O = big; J.ldo = D; J.xin = P.out; J.xout = P.out; J.xb = xb; J.ssq_out = ssq; J.alpha = 1.f;
                J.qg = nullptr; J.kg = nullptr; J.qn_end = 0; J.kn_end = 0; J.vt = nullptr; J.W = nullptr; J.ntn = 8;
                int nB = 0;
                if (s == 0 || s == 8) {
                    J.W = (const bf16_t*)(P.ws + (s == 0 ? OFF_GU1 : OFF_GU2) + (size_t)l * SZ_GU);
                    J.ntn = NGU / 128; J.mode = 0; J.rs = ssq + (size_t)(4 * l + (s == 0 ? 0 : 3)) * T; J.ldo = DFF;
                    if (ph == 1) nB = 256;
                } else if (s == 1 || s == 9) {
                    J.A = big; J.lda = DFF; J.K = DFF;
                    J.W = (const bf16_t*)(P.ws + (s == 1 ? OFF_DN1 : OFF_DN2) + (size_t)l * SZ_DN);
                    J.alpha = 0.5f; J.ssq_out = ssq + (size_t)(4 * l + (s == 1 ? 1 : 4)) * T;
                    if (ph == 2) J.xin = P.in[0];
                } else if (s == 2) {
                    J.mode = 2; J.rs = ssq + (size_t)(4 * l + 1) * T;
                    if (l == 0) { J.W = (const bf16_t*)(P.ws + OFF_EVIN); J.ntn = 18; J.ldo = 2304; J.qg = P.in[7]; J.kg = P.in[8]; J.qn_end = 512; J.kn_end = 640; }
                    else { J.W = (const bf16_t*)(P.ws + OFF_ODIN); J.ntn = 24; J.ldo = 3072; J.qg = P.in[12]; J.kg = P.in[13]; J.qn_end = 1024; J.kn_end = 2048; }
                } else if (s == 4) {
                    J.A = big;
                    if (l == 0) { J.W = (const bf16_t*)(P.ws + OFF_EVOUT); J.lda = 2304; J.ksplit = 512; J.kextra = 256; }
                    else { J.W = (const bf16_t*)(P.ws + OFF_ODOUT); J.lda = 3072; }
                    J.ssq_out = ssq + (size_t)(4 * l + 2) * T;
                } else if (s == 5) {
                    J.W = (const bf16_t*)(P.ws + OFF_WQ + (size_t)l * SZ_MM); J.mode = 2; J.rs = ssq + (size_t)(4 * l + 2) * T; J.ldo = D;
                } else {
                    J.A = big; J.W = (const bf16_t*)(P.ws + OFF_WO + (size_t)l * SZ_MM); J.ssq_out = ssq + (size_t)(4 * l + 3) * T;
                }
                gemm_phase(J, J.ntm * J.ntn, nB, P, smem);
                if (ph == 2) knorm_phase(P);
            }
        }
        grid.sync();
    }
}

extern "C" void kernel_launch(void* const* d_in, const int* in_sizes, int n_in, void* d_out, int out_size, void* d_ws, size_t ws_size,
                              hipStream_t stream) {
    static int grid_blocks = 0;
    if (!grid_blocks) {
        int dev = 0, cus = 0, per_cu = 0;
        hipGetDevice(&dev);
        hipDeviceGetAttribute(&cus, hipDeviceAttributeMultiprocessorCount, dev);
        hipFuncSetAttribute((const void*)fwd_megakernel, hipFuncAttributeMaxDynamicSharedMemorySize, LDS_BYTES);
        hipOccupancyMaxActiveBlocksPerMultiprocessor(&per_cu, fwd_megakernel, 256, LDS_BYTES);
        if (per_cu < 1) per_cu = 1;
        if (per_cu > 2) per_cu = 2;
        grid_blocks = cus * per_cu;
    }
    if (ws_size < WS_NEED) { fprintf(stderr, "workspace too small: %zu < %zu\n", ws_size, (size_t)WS_NEED); return; }
    Params p{};
    for (int i = 0; i < 25; ++i) p.in[i] = (const float*)d_in[i];
    p.out = (float*)d_out; p.ws = (char*)d_ws;
    void* args[] = {&p};
    hipError_t e = hipLaunchCooperativeKernel((void*)fwd_megakernel, dim3(grid_blocks), dim3(256), args, LDS_BYTES, stream);
    if (e != hipSuccess) fprintf(stderr, "cooperative launch failed: %s (grid %d)\n", hipGetErrorString(e), grid_blocks);
}
```

```cpp
#include <hip/hip_runtime.h>
#include <hip/hip_cooperative_groups.h>
#include <cstdio>
#include <cstdint>
namespace cg = cooperative_groups;

#define DI __device__ __forceinline__
typedef unsigned short bf16_t;
typedef short bf16x8 __attribute__((ext_vector_type(8)));
typedef short s16x4 __attribute__((ext_vector_type(4)));
typedef float f32x16 __attribute__((ext_vector_type(16)));
typedef __bf16 bf2_t __attribute__((ext_vector_type(2)));
typedef float f2_t __attribute__((ext_vector_type(2)));
typedef short v4i16_t __attribute__((ext_vector_type(4)));
#define MFMA(a, b, c) __builtin_amdgcn_mfma_f32_32x32x16_bf16((a), (b), (c), 0, 0, 0)

constexpr int T = 16384, S = 4096, D = 1024, DFF = 2816, NGU = 5632;
constexpr float EPS = 1e-6f;
constexpr float LOG2E = 1.4426950408889634f;
constexpr float LN2 = 0.6931471805599453f;

constexpr size_t SZ_GU = (size_t)NGU * D * 2, SZ_DN = (size_t)D * DFF * 2, SZ_MM = (size_t)D * D * 2;
constexpr size_t OFF_GU1 = 0;
constexpr size_t OFF_DN1 = OFF_GU1 + 2 * SZ_GU;
constexpr size_t OFF_GU2 = OFF_DN1 + 2 * SZ_DN;
constexpr size_t OFF_DN2 = OFF_GU2 + 2 * SZ_GU;
constexpr size_t OFF_WQ = OFF_DN2 + 2 * SZ_DN;
constexpr size_t OFF_WKV = OFF_WQ + 2 * SZ_MM;
constexpr size_t OFF_WO = OFF_WKV + 4 * SZ_MM;
constexpr size_t OFF_EVIN = OFF_WO + 2 * SZ_MM;
constexpr size_t OFF_EVOUT = OFF_EVIN + (size_t)2304 * D * 2;
constexpr size_t OFF_ODIN = OFF_EVOUT + SZ_MM;
constexpr size_t OFF_ODOUT = OFF_ODIN + (size_t)3072 * D * 2;
constexpr size_t OFF_XB = OFF_ODOUT + SZ_MM;
constexpr size_t OFF_BIG = OFF_XB + (size_t)T * D * 2;
constexpr size_t OFF_MEMB = OFF_BIG + (size_t)T * 3072 * 2;
constexpr size_t OFF_KN = OFF_MEMB + SZ_MM;
constexpr size_t OFF_VT = OFF_KN + 2 * SZ_MM;
constexpr size_t OFF_SSQ = OFF_VT + 2 * SZ_MM;
constexpr size_t OFF_SSQM = OFF_SSQ + (size_t)9 * T * 4;
constexpr size_t WS_NEED = OFF_SSQM + 4096;

#ifndef PROBE_MASK
#define PROBE_MASK 0
#endif
constexpr int NTHR = 512;
constexpr int LDS_BYTES = 131072;
constexpr int STAGE_B = 65536;
constexpr int OPB = 32768;

struct Params { const float* in[25]; float* out; char* ws; };

DI unsigned pk2(float a, float b) { f2_t v = {a, b}; bf2_t r = __builtin_convertvector(v, bf2_t); return __builtin_bit_cast(unsigned, r); }
DI float bflo(unsigned w) { return __uint_as_float(w << 16); }
DI float bfhi(unsigned w) { return __uint_as_float(w & 0xffff0000u); }
DI int otid() { int t = threadIdx.x; asm volatile("" : "+v"(t)); return t; }
DI int crow(int i, int h) { return (i & 3) + 8 * (i >> 2) + 4 * h; }
DI float fexp2(float x) { return __builtin_amdgcn_exp2f(x); }
DI float flog2(float x) { return __builtin_amdgcn_logf(x); }

struct WJob { const float* src; bf16_t* dst; const float* gain; int K, N, gu; };

DI int wjob_tiles(int j) {
    if (j < 14) {
        const int kind = j >> 1;
        switch (kind) {
            case 0: case 2: return 16 * 88;
            case 1: case 3: return 44 * 16;
            case 4: return 256;
            case 5: return 512;
            default: return 256;
        }
    }
    if (j == 14) return 16 * 36;
    if (j == 16) return 16 * 48;
    return 256;
}

DI WJob get_wjob(const Params& P, int j) {
    WJob w; w.gain = nullptr; w.gu = 0;
    bf16_t* wsb = (bf16_t*)P.ws;
    if (j < 14) {
        const int kind = j >> 1, l = j & 1;
        switch (kind) {
            case 0: w.src = P.in[3] + (size_t)l * D * NGU; w.dst = (bf16_t*)(P.ws + OFF_GU1 + l * SZ_GU); w.gain = P.in[2] + l * D; w.K = D; w.N = NGU; w.gu = 1; break;
            case 1: w.src = P.in[4] + (size_t)l * DFF * D; w.dst = (bf16_t*)(P.ws + OFF_DN1 + l * SZ_DN); w.K = DFF; w.N = D; break;
            case 2: w.src = P.in[23] + (size_t)l * D * NGU; w.dst = (bf16_t*)(P.ws + OFF_GU2 + l * SZ_GU); w.gain = P.in[22] + l * D; w.K = D; w.N = NGU; w.gu = 1; break;
            case 3: w.src = P.in[24] + (size_t)l * DFF * D; w.dst = (bf16_t*)(P.ws + OFF_DN2 + l * SZ_DN); w.K = DFF; w.N = D; break;
            case 4: w.src = P.in[17] + (size_t)l * D * D; w.dst = (bf16_t*)(P.ws + OFF_WQ + l * SZ_MM); w.gain = P.in[15] + l * D; w.K = D; w.N = D; break;
            case 5: w.src = P.in[18] + (size_t)l * D * 2048; w.dst = (bf16_t*)(P.ws + OFF_WKV + l * 2 * SZ_MM); w.gain = P.in[16] + l * D; w.K = D; w.N = 2048; break;
            default: w.src = P.in[21] + (size_t)l * D * D; w.dst = (bf16_t*)(P.ws + OFF_WO + l * SZ_MM); w.K = D; w.N = D; break;
        }
    } else if (j == 14) { w.src = P.in[6]; w.dst = (bf16_t*)(P.ws + OFF_EVIN); w.gain = P.in[5]; w.K = D; w.N = 2304; }
    else if (j == 15) { w.src = P.in[10]; w.dst = (bf16_t*)(P.ws + OFF_EVOUT); w.K = D; w.N = D; }
    else if (j == 16) { w.src = P.in[11]; w.dst = (bf16_t*)(P.ws + OFF_ODIN); w.gain = P.in[5] + D; w.K = D; w.N = 3072; }
    else { w.src = P.in[14]; w.dst = (bf16_t*)(P.ws + OFF_ODOUT); w.K = D; w.N = D; }
    (void)wsb;
    return w;
}

DI void wconv_tile(const WJob& w, int t, float* sm, int tid, bool act) {
    const int ntn = w.N >> 6; const int tk = t / ntn, tn = t - tk * ntn;
    if (act) {
#pragma unroll
        for (int p = 0; p < 4; ++p) {
            const int kr = p * 16 + (tid >> 4);
            const float4 v = *(const float4*)(w.src + (size_t)(tk * 64 + kr) * w.N + tn * 64 + (tid & 15) * 4);
            const float g = w.gain ? w.gain[tk * 64 + kr] : 1.f;
            float* sp = sm + kr * 65 + (tid & 15) * 4;
            sp[0] = v.x * g; sp[1] = v.y * g; sp[2] = v.z * g; sp[3] = v.w * g;
        }
    }
    __syncthreads();
    if (act) {
        const int n = tid >> 2, kq = tid & 3; const int ng = tn * 64 + n;
        int drow = ng;
        if (w.gu) drow = ng < DFF ? ((ng >> 5) * 64 + (ng & 31)) : (((ng - DFF) >> 5) * 64 + 32 + ((ng - DFF) & 31));
        unsigned o[8];
#pragma unroll
        for (int e = 0; e < 8; ++e) o[e] = pk2(sm[(kq * 16 + 2 * e) * 65 + n], sm[(kq * 16 + 2 * e + 1) * 65 + n]);
        uint4* dp = (uint4*)(w.dst + (size_t)drow * w.K + tk * 64 + kq * 16);
        dp[0] = make_uint4(o[0], o[1], o[2], o[3]); dp[1] = make_uint4(o[4], o[5], o[6], o[7]);
    }
    __syncthreads();
}

DI float wave_sum(float v) {
    v += __shfl_xor(v, 1); v += __shfl_xor(v, 2); v += __shfl_xor(v, 4); v += __shfl_xor(v, 8); v += __shfl_xor(v, 16); v += __shfl_xor(v, 32);
    return v;
}

DI void rowconv(const float* src, bf16_t* dst, float* ssq, int row, int lane) {
    const float* xr = src + (size_t)row * D;
    float ss = 0.f;
#pragma unroll
    for (int p = 0; p < 4; ++p) {
        const float4 v = *(const float4*)(xr + p * 256 + lane * 4);
        ss += v.x * v.x + v.y * v.y + v.z * v.z + v.w * v.w;
        *(uint2*)(dst + (size_t)row * D + p * 256 + lane * 4) = make_uint2(pk2(v.x, v.y), pk2(v.z, v.w));
    }
    ss = wave_sum(ss);
    if (lane == 0) ssq[row] = ss;
}

DI void phase0(const Params& P, char* smem) {
    const int tid = otid(), lane = tid & 63, wid = tid >> 6;
    float* ssq = (float*)(P.ws + OFF_SSQ);
    for (int i = blockIdx.x * NTHR + tid; i < 8 * T; i += gridDim.x * NTHR) ssq[T + i] = 0.f;
    constexpr int NW = 12352 / 2, NX = T / 8, NM = 1024 / 8;
    for (int u = blockIdx.x; u < NW + NX + NM; u += gridDim.x) {
        if (u < NW) {
            const int half = tid >> 8;
            int t = 2 * u + half, j = 0;
            for (; j < 17; ++j) { const int c = wjob_tiles(j); if (t < c) break; t -= c; }
            const WJob w = get_wjob(P, j);
            wconv_tile(w, t, (float*)smem + half * (64 * 65), tid & 255, true);
        } else if (u < NW + NX) {
            rowconv(P.in[0], (bf16_t*)(P.ws + OFF_XB), ssq, (u - NW) * 8 + wid, lane);
        } else {
            rowconv(P.in[1], (bf16_t*)(P.ws + OFF_MEMB), (float*)(P.ws + OFF_SSQM), (u - NW - NX) * 8 + wid, lane);
        }
    }
}

struct GJob {
    const bf16_t* A; const bf16_t* W;
    int lda, ksplit, kextra, K, ntm, ntn, mode;
    const float* rs;
    bf16_t* O; int ldo;
    const float* xin; float* xout; bf16_t* xb; float* ssq_out; float alpha;
    const float* qg; const float* kg; int qn_end, kn_end;
    bf16_t* vt;
};

typedef __attribute__((address_space(3))) unsigned* ldsu_t;
typedef const __attribute__((address_space(1))) unsigned* glbu_t;
DI void glds16(const bf16_t* g, char* l) { __builtin_amdgcn_global_load_lds((glbu_t)(const void*)g, (ldsu_t)(void*)l, 16, 0, 0); }

DI void gemm_tile(const GJob& J, int t, char* smem, bool dry) {
    const int tid = otid(), lane = tid & 63, wid = tid >> 6, wr = wid >> 2, wc = wid & 3;
    const int r = lane & 31, h = lane >> 5;
    int tm, tn;
    { const int gsz = 32 * J.ntn; const int g = t / gsz; const int rem = t - g * gsz; const int rows = min(32, J.ntm - g * 32); tn = rem / rows; tm = g * 32 + (rem - tn * rows); }
    const int lrow = wid * 8 + (lane >> 3);
    const int csw = ((lane & 7) ^ ((wid * 4 + (lane >> 4)) & 7)) * 8;
    const bf16_t* Ag = J.A + (size_t)(tm * 256 + lrow) * J.lda + csw;
    const bf16_t* Wg = J.W + (size_t)(tn * 256 + lrow) * J.K + csw;
    const size_t astr = (size_t)64 * J.lda, wstr = (size_t)64 * J.K;
    char* lb = smem + tid * 16;
    const int nk = J.K >> 6;
#define GLDS(kt, buf) do { const int k0_ = (kt) * 64; const int ka_ = k0_ + (k0_ >= J.ksplit ? J.kextra : 0); char* l_ = lb + (buf) * STAGE_B; \
        glds16(Ag + ka_, l_); glds16(Ag + astr + ka_, l_ + 8192); glds16(Ag + 2 * astr + ka_, l_ + 16384); glds16(Ag + 3 * astr + ka_, l_ + 24576); \
        glds16(Wg + k0_, l_ + OPB); glds16(Wg + wstr + k0_, l_ + OPB + 8192); glds16(Wg + 2 * wstr + k0_, l_ + OPB + 16384); glds16(Wg + 3 * wstr + k0_, l_ + OPB + 24576); } while (0)
    f32x16 acc[4][2];
#pragma unroll
    for (int a = 0; a < 4; ++a)
#pragma unroll
        for (int b = 0; b < 2; ++b)
#pragma unroll
            for (int i = 0; i < 16; ++i) acc[a][b][i] = 0.f;
    const int fr = (r >> 1) & 7;
    const int xrow = (wc * 64 + r) * 128, wrow = OPB + (wr * 128 + r) * 128;

    __syncthreads();
    GLDS(0, 0);
    for (int kt = 0; kt < nk; ++kt) {
        asm volatile("s_waitcnt vmcnt(0)" ::: "memory");
        __syncthreads();
        if (kt + 1 < nk) GLDS(kt + 1, (kt + 1) & 1);
        const char* sb = smem + (kt & 1) * STAGE_B;
#pragma unroll
        for (int ks = 0; ks < 4; ++ks) {
            const int co = ((2 * ks + h) ^ fr) * 16;
            bf16x8 wf[4], xf[2];
#pragma unroll
            for (int fi = 0; fi < 4; ++fi) wf[fi] = *(const bf16x8*)(sb + wrow + fi * 4096 + co);
#pragma unroll
            for (int ti = 0; ti < 2; ++ti) xf[ti] = *(const bf16x8*)(sb + xrow + ti * 4096 + co);
#pragma unroll
            for (int fi = 0; fi < 4; ++fi)
#pragma unroll
                for (int ti = 0; ti < 2; ++ti) acc[fi][ti] = MFMA(wf[fi], xf[ti], acc[fi][ti]);
        }
    }
#undef GLDS
    __syncthreads();

    if (dry) { if (acc[0][0][0] + acc[1][1][0] + acc[2][0][0] + acc[3][1][0] == 12345.678f) J.O[0] = 1; return; }
    const int tokb = tm * 256 + wc * 64;
    const int fb = tn * 256 + wr * 128;
    float rsc[2];
#pragma unroll
    for (int ti = 0; ti < 2; ++ti) rsc[ti] = J.rs ? __builtin_amdgcn_rsqf(J.rs[tokb + ti * 32 + r] * (1.f / 1024.f) + EPS) : 1.f;

    if (J.mode == 3 && fb >= 1024) {
#pragma unroll
        for (int ti = 0; ti < 2; ++ti) {
            const int tok = tokb + ti * 32 + r;
#pragma unroll
            for (int fi = 0; fi < 4; ++fi)
#pragma unroll
                for (int i = 0; i < 16; ++i) {
                    const int f = fb - 1024 + fi * 32 + crow(i, h);
                    J.vt[(((size_t)(tok >> 8) * 1024 + f) << 8) + (tok & 255)] = (bf16_t)(pk2(acc[fi][ti][i] * rsc[ti], 0.f) & 0xffffu);
                }
        }
        return;
    }
    char* wl = smem + wid * 16384;
#pragma unroll
    for (int ti = 0; ti < 2; ++ti) {
#pragma unroll
        for (int fp = 0; fp < 2; ++fp) {
            const float sc = (J.mode == 1) ? J.alpha : rsc[ti];
#pragma unroll
            for (int fi2 = 0; fi2 < 2; ++fi2)
#pragma unroll
                for (int g = 0; g < 4; ++g) {
                    float4 v;
                    v.x = acc[2 * fp + fi2][ti][4 * g + 0] * sc; v.y = acc[2 * fp + fi2][ti][4 * g + 1] * sc;
                    v.z = acc[2 * fp + fi2][ti][4 * g + 2] * sc; v.w = acc[2 * fp + fi2][ti][4 * g + 3] * sc;
                    *(float4*)(wl + r * 272 + (fi2 * 32 + 8 * g + 4 * h) * 4) = v;
                }
            const int tok0 = tokb + ti * 32, f0 = fb + fp * 64;
            if (J.mode == 0) {
                const int c4 = (lane & 7) * 4;
#pragma unroll
                for (int p = 0; p < 4; ++p) {
                    const int row = p * 8 + (lane >> 3);
                    const float4 ga = *(const float4*)(wl + row * 272 + c4 * 4);
                    const float4 up = *(const float4*)(wl + row * 272 + (32 + c4) * 4);
                    float y0 = ga.x * up.x * __builtin_amdgcn_rcpf(1.f + fexp2(-ga.x * LOG2E));
                    float y1 = ga.y * up.y * __builtin_amdgcn_rcpf(1.f + fexp2(-ga.y * LOG2E));
                    float y2 = ga.z * up.z * __builtin_amdgcn_rcpf(1.f + fexp2(-ga.z * LOG2E));
                    float y3 = ga.w * up.w * __builtin_amdgcn_rcpf(1.f + fexp2(-ga.w * LOG2E));
                    *(uint2*)(J.O + (size_t)(tok0 + row) * J.ldo + (f0 >> 1) + c4) = make_uint2(pk2(y0, y1), pk2(y2, y3));
                }
            } else if (J.mode == 1) {
                const int c4 = (lane & 15) * 4;
#pragma unroll
                for (int p = 0; p < 8; ++p) {
                    const int row = p * 4 + (lane >> 4);
                    const size_t tok = tok0 + row;
                    const float4 v = *(const float4*)(wl + row * 272 + c4 * 4);
                    const float4 xo = *(const float4*)(J.xin + tok * D + f0 + c4);
                    float4 xn; xn.x = xo.x + v.x; xn.y = xo.y + v.y; xn.z = xo.z + v.z; xn.w = xo.w + v.w;
                    *(float4*)(J.xout + tok * D + f0 + c4) = xn;
                    *(uint2*)(J.xb + tok * D + f0 + c4) = make_uint2(pk2(xn.x, xn.y), pk2(xn.z, xn.w));
                    float ss = xn.x * xn.x + xn.y * xn.y + xn.z * xn.z + xn.w * xn.w;
                    ss += __shfl_xor(ss, 1); ss += __shfl_xor(ss, 2); ss += __shfl_xor(ss, 4); ss += __shfl_xor(ss, 8);
                    if ((lane & 15) == 0) atomicAdd(J.ssq_out + tok, ss);
                }
            } else {
                const int nm = f0 < J.qn_end ? 1 : (f0 < J.kn_end ? 2 : 0);
                const float* gp = nm == 1 ? J.qg : J.kg;
                const int c4 = (lane & 15) * 4;
                float4 gn = make_float4(1.f, 1.f, 1.f, 1.f);
                if (nm) gn = *(const float4*)(gp + c4);
#pragma unroll
                for (int p = 0; p < 8; ++p) {
                    const int row = p * 4 + (lane >> 4);
                    float4 v = *(const float4*)(wl + row * 272 + c4 * 4);
                    if (nm) {
                        float ss = v.x * v.x + v.y * v.y + v.z * v.z + v.w * v.w;
                        ss += __shfl_xor(ss, 1); ss += __shfl_xor(ss, 2); ss += __shfl_xor(ss, 4); ss += __shfl_xor(ss, 8);
                        const float inv = __builtin_amdgcn_rsqf(ss * (1.f / 64.f) + EPS);
                        v.x *= inv * gn.x; v.y *= inv * gn.y; v.z *= inv * gn.z; v.w *= inv * gn.w;
                    }
                    *(uint2*)(J.O + (size_t)(tok0 + row) * J.ldo + f0 + c4) = make_uint2(pk2(v.x, v.y), pk2(v.z, v.w));
                }
            }
        }
    }
}

DI void gemm_phase(const GJob& JA, int nA, int nB, const Params& P, char* smem, bool dry) {
    for (int u = blockIdx.x; u < nA + nB; u += gridDim.x) {
        GJob J = JA; int t = u;
        if (u >= nA) {
            const int v = u - nA; const int layer = v >> 5; t = v & 31;
            J.A = (const bf16_t*)(P.ws + OFF_MEMB); J.lda = D; J.ksplit = 1 << 30; J.kextra = 0;
            J.W = (const bf16_t*)(P.ws + OFF_WKV + (size_t)layer * 2 * SZ_MM); J.K = D; J.ntm = 4; J.ntn = 8; J.mode = 3;
            J.rs = (const float*)(P.ws + OFF_SSQM); J.O = (bf16_t*)(P.ws + OFF_KN + (size_t)layer * SZ_MM); J.ldo = D;
            J.qn_end = 0; J.kn_end = 0; J.vt = (bf16_t*)(P.ws + OFF_VT + (size_t)layer * SZ_MM);
        }
        gemm_tile(J, t, smem, dry);
    }
}

DI void v_stage(const bf16_t* base, int ld, size_t rowb, int vcol, int kb, int dil, int lane, char* vl) {
    const int kk = lane >> 3;
    const bf16_t* bp = base + vcol + (lane & 7) * 8;
    const uint4 v0 = *(const uint4*)(bp + (rowb + min(max(kb + dil * kk, 0), S - 1)) * ld);
    const uint4 v1 = *(const uint4*)(bp + (rowb + min(max(kb + dil * (kk + 8), 0), S - 1)) * ld);
    const uint4 v2 = *(const uint4*)(bp + (rowb + min(max(kb + dil * (kk + 16), 0), S - 1)) * ld);
    const uint4 v3 = *(const uint4*)(bp + (rowb + min(max(kb + dil * (kk + 24), 0), S - 1)) * ld);
    char* wp = vl + kk * 144 + (lane & 7) * 16;
    asm volatile("" ::: "memory");
    *(uint4*)(wp) = v0; *(uint4*)(wp + 8 * 144) = v1; *(uint4*)(wp + 16 * 144) = v2; *(uint4*)(wp + 24 * 144) = v3;
    asm volatile("" ::: "memory");
}

DI bf16x8 v_frag(const char* vbase, int s, int dt) {
    typedef __attribute__((address_space(3))) v4i16_t* lp_t;
    const char* a = vbase + s * (16 * 144) + dt * 64;
    const s16x4 lo = __builtin_bit_cast(s16x4, __builtin_amdgcn_ds_read_tr16_b64_v4i16((lp_t)(a)));
    const s16x4 hi = __builtin_bit_cast(s16x4, __builtin_amdgcn_ds_read_tr16_b64_v4i16((lp_t)(a + 8 * 144)));
    return __builtin_shufflevector(lo, hi, 0, 1, 2, 3, 4, 5, 6, 7);
}

template <int OFF> DI bf16x8 pack8v(const f32x16& p) {
    typedef unsigned u32x4 __attribute__((ext_vector_type(4)));
    u32x4 w; w[0] = pk2(p[OFF + 0], p[OFF + 1]); w[1] = pk2(p[OFF + 2], p[OFF + 3]); w[2] = pk2(p[OFF + 4], p[OFF + 5]); w[3] = pk2(p[OFF + 6], p[OFF + 7]);
    return __builtin_bit_cast(bf16x8, w);
}

DI void win_attn_wave(bf16_t* qkv, int ld, int b, int qcol, int kcol, int vcol, int tq0, int qstride,
                      float slope2, float m_init, float l_init, int mode, char* vl, int lane, bool dry) {
    const int r = lane & 31, h = lane >> 5;
    const size_t rowb = (size_t)b * S;
    const int tq = tq0 + qstride * r;
    const int tqlast = tq0 + qstride * 31;
    bf16x8 qf[4];
    {
        const bf16_t* qp = qkv + (rowb + tq) * ld + qcol + h * 32;
#pragma unroll
        for (int ks = 0; ks < 4; ++ks) qf[ks] = *(const bf16x8*)(qp + ks * 8);
    }
    f32x16 o0, o1;
#pragma unroll
    for (int i = 0; i < 16; ++i) { o0[i] = 0.f; o1[i] = 0.f; }
    float m = m_init, l = (h == 0) ? l_init : 0.f;
    const float sc2 = 0.125f * LOG2E;
    const int i16 = lane & 15;
    const char* vbase = vl + (4 * h + (i16 >> 2)) * 144 + (16 * ((lane >> 4) & 1) + 4 * (i16 & 3)) * 2;
    const int npat = mode ? 3 : 1;
    for (int pi = 0; pi < npat; ++pi) {
        int dil, W, kfirst, nt;
        if (!mode) { dil = 1; W = 127; kfirst = tq0 - 128; nt = 5; }
        else if (pi == 0) { dil = 1; W = 128; kfirst = tq0 - 128; nt = 20; }
        else if (pi == 1) { dil = 4; W = 512; kfirst = tq0 - 512; nt = 8; }
        else { dil = 16; W = 2048; kfirst = tq0 - 2048; nt = 5; }
        for (int tile = 0; tile < nt; ++tile) {
            const int kb = kfirst + tile * 32 * dil;
            if (kb + 31 * dil < 0) continue;
            if (kb > tqlast) continue;
            bf16x8 kf[4];
            {
                const int tk = min(max(kb + dil * r, 0), S - 1);
                const bf16_t* kp = qkv + (rowb + tk) * ld + kcol + h * 32;
#pragma unroll
                for (int ks = 0; ks < 4; ++ks) kf[ks] = *(const bf16x8*)(kp + ks * 8);
            }
            v_stage(qkv, ld, rowb, vcol, kb, dil, lane, vl);
            f32x16 s;
#pragma unroll
            for (int i = 0; i < 16; ++i) s[i] = 0.f;
#pragma unroll
            for (int ks = 0; ks < 4; ++ks) s = MFMA(kf[ks], qf[ks], s);
            f32x16 sv; float mloc = -INFINITY;
#pragma unroll
            for (int i = 0; i < 16; ++i) {
                const int tki = kb + dil * crow(i, h);
                const int diff = tq - tki;
                const bool valid = (diff >= 0) && (diff <= W) && (tki >= 0);
                sv[i] = valid ? (s[i] * sc2 - slope2 * (float)diff) : -INFINITY;
                mloc = fmaxf(mloc, sv[i]);
            }
            mloc = fmaxf(mloc, __shfl_xor(mloc, 32));
            const float mn = fmaxf(m, mloc);
            const float alpha = fexp2(m - mn);
            m = mn;
            float ps = 0.f;
#pragma unroll
            for (int i = 0; i < 16; ++i) { sv[i] = fexp2(sv[i] - mn); ps += sv[i]; }
            l = l * alpha + ps;
#pragma unroll
            for (int i = 0; i < 16; ++i) { o0[i] *= alpha; o1[i] *= alpha; }
            const bf16x8 p0 = pack8v<0>(sv), p1 = pack8v<8>(sv);
            o0 = MFMA(v_frag(vbase, 0, 0), p0, o0);
            o0 = MFMA(v_frag(vbase, 1, 0), p1, o0);
            o1 = MFMA(v_frag(vbase, 0, 1), p0, o1);
            o1 = MFMA(v_frag(vbase, 1, 1), p1, o1);
            asm volatile("" ::: "memory");
        }
    }
    const float lt = l + __shfl_xor(l, 32);
    const float inv = 1.f / lt;
    if (dry) { if (o0[0] + o1[0] + lt == 12345.678f) qkv[0] = 1; return; }
    bf16_t* op = qkv + (rowb + tq) * ld + qcol + 4 * h;
#pragma unroll
    for (int g = 0; g < 4; ++g) {
        *(uint2*)(op + 8 * g) = make_uint2(pk2(o0[4 * g] * inv, o0[4 * g + 1] * inv), pk2(o0[4 * g + 2] * inv, o0[4 * g + 3] * inv));
        *(uint2*)(op + 32 + 8 * g) = make_uint2(pk2(o1[4 * g] * inv, o1[4 * g + 1] * inv), pk2(o1[4 * g + 2] * inv, o1[4 * g + 3] * inv));
    }
}

DI void stick_wave(bf16_t* qkv, int ld, int b, int qcol, int kcol, int vcol, int qt, char* vl, int lane, bool dry) {
    const int r = lane & 31, h = lane >> 5;
    const size_t rowb = (size_t)b * S;
    const int tq = qt * 32 + r;
    bf16x8 qf[4];
    {
        const bf16_t* qp = qkv + (rowb + tq) * ld + qcol + h * 32;
#pragma unroll
        for (int ks = 0; ks < 4; ++ks) qf[ks] = *(const bf16x8*)(qp + ks * 8);
    }
    f32x16 o0, o1;
#pragma unroll
    for (int i = 0; i < 16; ++i) { o0[i] = 0.f; o1[i] = 0.f; }
    float R = 0.f;
    const int i16 = lane & 15;
    const char* vbase = vl + (4 * h + (i16 >> 2)) * 144 + (16 * ((lane >> 4) & 1) + 4 * (i16 & 3)) * 2;
    for (int tile = qt; tile >= 0; --tile) {
        const int kb = tile * 32;
        bf16x8 kf[4];
        {
            const bf16_t* kp = qkv + (rowb + kb + r) * ld + kcol + h * 32;
#pragma unroll
            for (int ks = 0; ks < 4; ++ks) kf[ks] = *(const bf16x8*)(kp + ks * 8);
        }
        v_stage(qkv, ld, rowb, vcol, kb, 1, lane, vl);
        f32x16 s;
#pragma unroll
        for (int i = 0; i < 16; ++i) s[i] = 0.f;
#pragma unroll
        for (int ks = 0; ks < 4; ++ks) s = MFMA(kf[ks], qf[ks], s);
        const bool diag = (tile == qt);
        f32x16 z, lk;
#pragma unroll
        for (int i = 0; i < 16; ++i) {
            const float zz = s[i] * 0.125f;
            const bool strict = (!diag) || (crow(i, h) < r);
            const float e = fexp2(-fabsf(zz) * LOG2E);
            const float sp = fmaxf(zz, 0.f) + flog2(1.f + e) * LN2;
            z[i] = strict ? zz : -INFINITY;
            lk[i] = strict ? -sp : 0.f;
        }
        float G[4], PG[4], both[4];
#pragma unroll
        for (int g = 0; g < 4; ++g) { G[g] = (lk[4 * g] + lk[4 * g + 1]) + (lk[4 * g + 2] + lk[4 * g + 3]); PG[g] = __shfl_xor(G[g], 32); both[g] = G[g] + PG[g]; }
        float Sx[4];
        Sx[3] = 0.f; Sx[2] = both[3]; Sx[1] = both[3] + both[2]; Sx[0] = Sx[1] + both[1];
        f32x16 a;
#pragma unroll
        for (int g = 0; g < 4; ++g) {
            float la = R + Sx[g] + (h == 0 ? PG[g] : 0.f);
#pragma unroll
            for (int j = 3; j >= 0; --j) {
                a[4 * g + j] = fexp2((z[4 * g + j] + lk[4 * g + j] + la) * LOG2E);
                la += lk[4 * g + j];
            }
        }
        R += Sx[0] + both[0];
        const bf16x8 p0 = pack8v<0>(a), p1 = pack8v<8>(a);
        o0 = MFMA(v_frag(vbase, 0, 0), p0, o0);
        o0 = MFMA(v_frag(vbase, 1, 0), p1, o0);
        o1 = MFMA(v_frag(vbase, 0, 1), p0, o1);
        o1 = MFMA(v_frag(vbase, 1, 1), p1, o1);
        asm volatile("" ::: "memory");
    }
    if (dry) { if (o0[0] + o1[0] == 12345.678f) qkv[0] = 1; return; }
    bf16_t* op = qkv + (rowb + tq) * ld + qcol + 4 * h;
#pragma unroll
    for (int g = 0; g < 4; ++g) {
        *(uint2*)(op + 8 * g) = make_uint2(pk2(o0[4 * g], o0[4 * g + 1]), pk2(o0[4 * g + 2], o0[4 * g + 3]));
        *(uint2*)(op + 32 + 8 * g) = make_uint2(pk2(o1[4 * g], o1[4 * g + 1]), pk2(o1[4 * g + 2], o1[4 * g + 3]));
    }
}

DI void attn_even_phase(const Params& P, char* smem, bool dry) {
    const int tid_ = otid(); const int lane = tid_ & 63, wid = tid_ >> 6;
    bf16_t* qkv = (bf16_t*)(P.ws + OFF_BIG);
    char* vl = smem + wid * 8192;
    for (int it = blockIdx.x * 8 + wid; it < 2048 + 4096; it += gridDim.x * 8) {
        if (it < 2048) {
            const int bh = it >> 6, p = it & 63; const int b = bh >> 3, head = bh & 7;
            stick_wave(qkv, 2304, b, 768 + head * 64, 1280 + head * 64, 1792 + head * 64, 127 - p, vl, lane, dry);
            stick_wave(qkv, 2304, b, 768 + head * 64, 1280 + head * 64, 1792 + head * 64, p, vl, lane, dry);
        } else {
            const int v = it - 2048; const int g = v & 3; const int qt = (v >> 2) & 127; const int rest = v >> 9; const int b = rest >> 1, kvh = rest & 1;
            const int head = kvh * 4 + g;
            const float slope = exp2f(-(float)(head + 1));
            const float sink = P.in[9][head];
            win_attn_wave(qkv, 2304, b, head * 64, 512 + kvh * 64, 640 + kvh * 64, qt * 32, 1, slope * LOG2E, sink * LOG2E, 1.f, 0, vl, lane, dry);
        }
    }
}

DI void attn_odd_phase(const Params& P, char* smem, bool dry) {
    const int tid_ = otid(); const int lane = tid_ & 63, wid = tid_ >> 6;
    bf16_t* qkv = (bf16_t*)(P.ws + OFF_BIG);
    char* vl = smem + wid * 8192;
    for (int it = blockIdx.x * 8 + wid; it < 8192; it += gridDim.x * 8) {
        const int res16 = it & 15; const int u0 = ((it >> 4) & 7) * 32; const int head = (it >> 7) & 15; const int b = it >> 11;
        const float slope = exp2f(-0.5f * (float)(head + 1));
        win_attn_wave(qkv, 3072, b, head * 64, 1024 + head * 64, 2048 + head * 64, res16 + 16 * u0, 16, slope * LOG2E, -1e30f, 0.f, 1, vl, lane, dry);
    }
}

DI void xattn_wave(bf16_t* qb, const bf16_t* Kn, const bf16_t* VT, const float* qg, int b, int head, int tok0, char* ql, int lane, bool dry) {
    const int r = lane & 31, h = lane >> 5;
    const size_t token = (size_t)b * S + tok0 + r;
    bf16_t* qp = qb + token * D + head * 256 + h * 128;
    float ss = 0.f;
#pragma unroll
    for (int ks = 0; ks < 16; ++ks) {
        const uint4 v = *(const uint4*)(qp + ks * 8);
        const unsigned w[4] = {v.x, v.y, v.z, v.w};
#pragma unroll
        for (int e = 0; e < 4; ++e) { const float a = bflo(w[e]), c = bfhi(w[e]); ss += a * a + c * c; }
    }
    ss += __shfl_xor(ss, 32);
    const float inv = __builtin_amdgcn_rsqf(ss * (1.f / 256.f) + EPS);
#pragma unroll
    for (int ks = 0; ks < 16; ++ks) {
        const uint4 v = *(const uint4*)(qp + ks * 8);
        const float4 g0 = *(const float4*)(qg + h * 128 + ks * 8), g1 = *(const float4*)(qg + h * 128 + ks * 8 + 4);
        uint4 o;
        o.x = pk2(bflo(v.x) * inv * g0.x, bfhi(v.x) * inv * g0.y); o.y = pk2(bflo(v.y) * inv * g0.z, bfhi(v.y) * inv * g0.w);
        o.z = pk2(bflo(v.z) * inv * g1.x, bfhi(v.z) * inv * g1.y); o.w = pk2(bflo(v.w) * inv * g1.z, bfhi(v.w) * inv * g1.w);
        *(uint4*)(ql + (ks * 64 + lane) * 16) = o;
    }
    asm volatile("" ::: "memory");
    const float sc2 = 0.0625f * LOG2E;
    const bf16_t* kp0 = Kn + ((size_t)b * 256 + r) * D + head * 256 + h * 128;
    float m = -INFINITY;
#pragma unroll 1
    for (int tile = 0; tile < 8; ++tile) {
        f32x16 s;
#pragma unroll
        for (int i = 0; i < 16; ++i) s[i] = 0.f;
        const bf16_t* kp = kp0 + (size_t)tile * 32 * D;
#pragma unroll
        for (int ks = 0; ks < 16; ++ks) {
            const bf16x8 kf = *(const bf16x8*)(kp + ks * 8);
            const bf16x8 qf = *(const bf16x8*)(ql + (ks * 64 + lane) * 16);
            s = MFMA(kf, qf, s);
        }
#pragma unroll
        for (int i = 0; i < 16; ++i) m = fmaxf(m, s[i]);
    }
    m = fmaxf(m, __shfl_xor(m, 32));
    float l = 0.f;
    bf16x8 pf[8][2];
#pragma unroll
    for (int tile = 0; tile < 8; ++tile) {
        f32x16 s;
#pragma unroll
        for (int i = 0; i < 16; ++i) s[i] = 0.f;
        const bf16_t* kp = kp0 + (size_t)tile * 32 * D;
#pragma unroll
        for (int ks = 0; ks < 16; ++ks) {
            const bf16x8 kf = *(const bf16x8*)(kp + ks * 8);
            const bf16x8 qf = *(const bf16x8*)(ql + (ks * 64 + lane) * 16);
            s = MFMA(kf, qf, s);
        }
#pragma unroll
        for (int i = 0; i < 16; ++i) { s[i] = fexp2((s[i] - m) * sc2); l += s[i]; }
        pf[tile][0] = pack8v<0>(s); pf[tile][1] = pack8v<8>(s);
    }
    l += __shfl_xor(l, 32);
    const float il = 1.f / l;
    bf16_t* op = qb + token * D + head * 256 + 4 * h;
#pragma unroll 1
    for (int dt = 0; dt < 8; ++dt) {
        f32x16 o;
#pragma unroll
        for (int i = 0; i < 16; ++i) o[i] = 0.f;
        const bf16_t* vp = VT + (((size_t)b * 4 + head) * 256 + dt * 32 + r) * 256 + 4 * h;
#pragma unroll
        for (int tile = 0; tile < 8; ++tile)
#pragma unroll
            for (int s2 = 0; s2 < 2; ++s2) {
                const s16x4 lo = *(const s16x4*)(vp + tile * 32 + 16 * s2);
                const s16x4 hi = *(const s16x4*)(vp + tile * 32 + 16 * s2 + 8);
                o = MFMA(__builtin_shufflevector(lo, hi, 0, 1, 2, 3, 4, 5, 6, 7), pf[tile][s2], o);
            }
#pragma unroll
        for (int g = 0; g < 4; ++g)
            if (dry) { if (o[4 * g] == 12345.678f) qb[0] = 1; } else *(uint2*)(op + dt * 32 + 8 * g) = make_uint2(pk2(o[4 * g] * il, o[4 * g + 1] * il), pk2(o[4 * g + 2] * il, o[4 * g + 3] * il));
    }
}

DI void xattn_phase(const Params& P, int l, char* smem, bool dry) {
    const int tid_ = otid(); const int lane = tid_ & 63, wid = tid_ >> 6;
    bf16_t* qb = (bf16_t*)(P.ws + OFF_BIG);
    const bf16_t* Kn = (const bf16_t*)(P.ws + OFF_KN + (size_t)l * SZ_MM);
    const bf16_t* VT = (const bf16_t*)(P.ws + OFF_VT + (size_t)l * SZ_MM);
    const float* qg = P.in[19] + l * 256;
    char* ql = smem + wid * 16384;
    for (int it = blockIdx.x * 8 + wid; it < 2048; it += gridDim.x * 8) {
        const int qt = it & 127, head = (it >> 7) & 3, b = it >> 9;
        xattn_wave(qb, Kn, VT, qg, b, head, qt * 32, ql, lane, dry);
    }
}

DI void knorm_phase(const Params& P) {
    const int tid_ = otid(); const int lane = tid_ & 63, wid = tid_ >> 6;
    for (int u = blockIdx.x * 8 + wid; u < 8192; u += gridDim.x * 8) {
        const int l = u >> 12, row = (u >> 2) & 1023, head = u & 3;
        bf16_t* kp = (bf16_t*)(P.ws + OFF_KN + (size_t)l * SZ_MM) + (size_t)row * D + head * 256 + lane * 4;
        const uint2 v = *(const uint2*)kp;
        const float a0 = bflo(v.x), a1 = bfhi(v.x), a2 = bflo(v.y), a3 = bfhi(v.y);
        float ss = a0 * a0 + a1 * a1 + a2 * a2 + a3 * a3;
        ss = wave_sum(ss);
        const float inv = __builtin_amdgcn_rsqf(ss * (1.f / 256.f) + EPS);
        const float4 g = *(const float4*)(P.in[20] + l * 256 + lane * 4);
        *(uint2*)kp = make_uint2(pk2(a0 * inv * g.x, a1 * inv * g.y), pk2(a2 * inv * g.z, a3 * inv * g.w));
    }
}

__global__ void __launch_bounds__(512) fwd_megakernel(Params P) {
    extern __shared__ __attribute__((aligned(16))) char smem[];
    cg::grid_group grid = cg::this_grid();
#pragma unroll 1
    for (int ph = 0; ph < 21; ++ph) {
        float* ssq = (float*)(P.ws + OFF_SSQ);
        bf16_t* xb = (bf16_t*)(P.ws + OFF_XB);
        bf16_t* big = (bf16_t*)(P.ws + OFF_BIG);
        int nrep = 1;
        if (ph > 0) { const int s_ = (ph - 1) % 10; const int kind = (s_ == 3) ? 2 : (s_ == 6) ? 4 : 1; if (PROBE_MASK & kind) nrep = 2; }
        for (int rep = 0; rep < nrep; ++rep) {
        const bool dry = rep + 1 < nrep;
        if (ph == 0) {
            phase0(P, smem);
        } else {
            const int l = (ph - 1) / 10, s = (ph - 1) % 10;
            if (s == 3) {
                if (l == 0) attn_even_phase(P, smem, dry); else attn_odd_phase(P, smem, dry);
            } else if (s == 6) {
                xattn_phase(P, l, smem, dry);
            } else {
                GJob J;
                J.A = xb; J.lda = D; J.ksplit = 1 << 30; J.kextra = 0; J.K = D; J.ntm = 64; J.mode = 1; J.rs = nullptr;
                J.O = big; J.ldo = D; J.xin = P.out; J.xout = P.out; J.xb = xb; J.ssq_out = ssq; J.alpha = 1.f;
                J.qg = nullptr; J.kg = nullptr; J.qn_end = 0; J.kn_end = 0; J.vt = nullptr; J.W = nullptr; J.ntn = 4;
                int nB = 0;
                if (s == 0 || s == 8) {
                    J.W = (const bf16_t*)(P.ws + (s == 0 ? OFF_GU1 : OFF_GU2) + (size_t)l * SZ_GU);
                    J.ntn = NGU / 256; J.mode = 0; J.rs = ssq + (size_t)(4 * l + (s == 0 ? 0 : 3)) * T; J.ldo = DFF;
                    if (ph == 1) nB = 64;
                } else if (s == 1 || s == 9) {
                    J.A = big; J.lda = DFF; J.K = DFF;
                    J.W = (const bf16_t*)(P.ws + (s == 1 ? OFF_DN1 : OFF_DN2) + (size_t)l * SZ_DN);
                    J.alpha = 0.5f; J.ssq_out = ssq + (size_t)(4 * l + (s == 1 ? 1 : 4)) * T;
                    if (ph == 2) J.xin = P.in[0];
                } else if (s == 2) {
                    J.mode = 2; J.rs = ssq + (size_t)(4 * l + 1) * T;
                    if (l == 0) { J.W = (const bf16_t*)(P.ws + OFF_EVIN); J.ntn = 9; J.ldo = 2304; J.qg = P.in[7]; J.kg = P.in[8]; J.qn_end = 512; J.kn_end = 640; }
                    else { J.W = (const bf16_t*)(P.ws + OFF_ODIN); J.ntn = 12; J.ldo = 3072; J.qg = P.in[12]; J.kg = P.in[13]; J.qn_end = 1024; J.kn_end = 2048; }
                } else if (s == 4) {
                    J.A = big;
                    if (l == 0) { J.W = (const bf16_t*)(P.ws + OFF_EVOUT); J.lda = 2304; J.ksplit = 512; J.kextra = 256; }
                    else { J.W = (const bf16_t*)(P.ws + OFF_ODOUT); J.lda = 3072; }
                    J.ssq_out = ssq + (size_t)(4 * l + 2) * T;
                } else if (s == 5) {
                    J.W = (const bf16_t*)(P.ws + OFF_WQ + (size_t)l * SZ_MM); J.mode = 2; J.rs = ssq + (size_t)(4 * l + 2) * T; J.ldo = D;
                } else {
                    J.A = big; J.W = (const bf16_t*)(P.ws + OFF_WO + (size_t)l * SZ_MM); J.ssq_out = ssq + (size_t)(4 * l + 3) * T;
                }
                gemm_phase(J, J.ntm * J.ntn, nB, P, smem, dry);
                if (ph == 2 && !dry) knorm_phase(P);
            }
        }
        grid.sync();
        }
    }
}

extern "C" void kernel_launch(void* const* d_in, const int* in_sizes, int n_in, void* d_out, int out_size, void* d_ws, size_t ws_size,
                              hipStream_t stream) {
    static int grid_blocks = 0;
    if (!grid_blocks) {
        int dev = 0, cus = 0, per_cu = 0;
        hipGetDevice(&dev);
        hipDeviceGetAttribute(&cus, hipDeviceAttributeMultiprocessorCount, dev);
        hipFuncSetAttribute((const void*)fwd_megakernel, hipFuncAttributeMaxDynamicSharedMemorySize, LDS_BYTES);
        hipOccupancyMaxActiveBlocksPerMultiprocessor(&per_cu, fwd_megakernel, NTHR, LDS_BYTES);
        if (per_cu < 1) per_cu = 1;
        if (per_cu > 1) per_cu = 1;
        grid_blocks = cus * per_cu;
    }
    if (ws_size < WS_NEED) { fprintf(stderr, "workspace too small: %zu < %zu\n", ws_size, (size_t)WS_NEED); return; }
    Params p{};
    for (int i = 0; i < 25; ++i) p.in[i] = (const float*)d_in[i];
    p.out = (float*)d_out; p.ws = (char*)d_ws;
    void* args[] = {&p};
    hipError_t e = hipLaunchCooperativeKernel((void*)fwd_megakernel, dim3(grid_blocks), dim3(NTHR), args, LDS_BYTES, stream);
    if (e != hipSuccess) fprintf(stderr, "cooperative launch failed: %s (grid %d)\n", hipGetErrorString(e), grid_blocks);
}
```

```cpp
#include <hip/hip_runtime.h>
#include <hip/hip_cooperative_groups.h>
#include <cstdio>
#include <cstdint>
namespace cg = cooperative_groups;

#define DI __device__ __forceinline__
typedef unsigned short bf16_t;
typedef short bf16x8 __attribute__((ext_vector_type(8)));
typedef short s16x4 __attribute__((ext_vector_type(4)));
typedef float f32x16 __attribute__((ext_vector_type(16)));
typedef __bf16 bf2_t __attribute__((ext_vector_type(2)));
typedef float f2_t __attribute__((ext_vector_type(2)));
typedef short v4i16_t __attribute__((ext_vector_type(4)));
#define MFMA(a, b, c) __builtin_amdgcn_mfma_f32_32x32x16_bf16((a), (b), (c), 0, 0, 0)

constexpr int T = 16384, S = 4096, D = 1024, DFF = 2816, NGU = 5632;
constexpr float EPS = 1e-6f;
constexpr float LOG2E = 1.4426950408889634f;
constexpr float LN2 = 0.6931471805599453f;

constexpr size_t SZ_GU = (size_t)NGU * D * 2, SZ_DN = (size_t)D * DFF * 2, SZ_MM = (size_t)D * D * 2;
constexpr size_t OFF_GU1 = 0;
constexpr size_t OFF_DN1 = OFF_GU1 + 2 * SZ_GU;
constexpr size_t OFF_GU2 = OFF_DN1 + 2 * SZ_DN;
constexpr size_t OFF_DN2 = OFF_GU2 + 2 * SZ_GU;
constexpr size_t OFF_WQ = OFF_DN2 + 2 * SZ_DN;
constexpr size_t OFF_WKV = OFF_WQ + 2 * SZ_MM;
constexpr size_t OFF_WO = OFF_WKV + 4 * SZ_MM;
constexpr size_t OFF_EVIN = OFF_WO + 2 * SZ_MM;
constexpr size_t OFF_EVOUT = OFF_EVIN + (size_t)2304 * D * 2;
constexpr size_t OFF_ODIN = OFF_EVOUT + SZ_MM;
constexpr size_t OFF_ODOUT = OFF_ODIN + (size_t)3072 * D * 2;
constexpr size_t OFF_XB = OFF_ODOUT + SZ_MM;
constexpr size_t OFF_BIG = OFF_XB + (size_t)T * D * 2;
constexpr size_t OFF_MEMB = OFF_BIG + (size_t)T * 3072 * 2;
constexpr size_t OFF_KN = OFF_MEMB + SZ_MM;
constexpr size_t OFF_VT = OFF_KN + 2 * SZ_MM;
constexpr size_t OFF_SSQ = OFF_VT + 2 * SZ_MM;
constexpr size_t OFF_SSQM = OFF_SSQ + (size_t)9 * T * 4;
constexpr size_t OFF_KF = OFF_SSQM + 4096;
constexpr size_t WS_NEED = OFF_KF + 2 * SZ_MM;

#ifndef PROBE_MASK
#define PROBE_MASK 0
#endif
constexpr int NTHR = 512;
constexpr int NST = 4;
constexpr int STAGE_B = 32768;
constexpr int OPB = 16384;
constexpr int LDS_BYTES = 131072;

struct Params { const float* in[25]; float* out; char* ws; };

DI unsigned pk2(float a, float b) { f2_t v = {a, b}; bf2_t r = __builtin_convertvector(v, bf2_t); return __builtin_bit_cast(unsigned, r); }
DI float bflo(unsigned w) { return __uint_as_float(w << 16); }
DI float bfhi(unsigned w) { return __uint_as_float(w & 0xffff0000u); }
DI int otid() { int t = threadIdx.x; asm volatile("" : "+v"(t)); return t; }
DI int crow(int i, int h) { return (i & 3) + 8 * (i >> 2) + 4 * h; }
DI float fexp2(float x) { return __builtin_amdgcn_exp2f(x); }
DI float flog2(float x) { return __builtin_amdgcn_logf(x); }

struct WJob { const float* src; bf16_t* dst; const float* gain; int K, N, gu; };

DI int wjob_tiles(int j) {
    if (j < 14) {
        const int kind = j >> 1;
        switch (kind) {
            case 0: case 2: return 16 * 88;
            case 1: case 3: return 44 * 16;
            case 4: return 256;
            case 5: return 512;
            default: return 256;
        }
    }
    if (j == 14) return 16 * 36;
    if (j == 16) return 16 * 48;
    return 256;
}

DI WJob get_wjob(const Params& P, int j) {
    WJob w; w.gain = nullptr; w.gu = 0;
    bf16_t* wsb = (bf16_t*)P.ws;
    if (j < 14) {
        const int kind = j >> 1, l = j & 1;
        switch (kind) {
            case 0: w.src = P.in[3] + (size_t)l * D * NGU; w.dst = (bf16_t*)(P.ws + OFF_GU1 + l * SZ_GU); w.gain = P.in[2] + l * D; w.K = D; w.N = NGU; w.gu = 1; break;
            case 1: w.src = P.in[4] + (size_t)l * DFF * D; w.dst = (bf16_t*)(P.ws + OFF_DN1 + l * SZ_DN); w.K = DFF; w.N = D; break;
            case 2: w.src = P.in[23] + (size_t)l * D * NGU; w.dst = (bf16_t*)(P.ws + OFF_GU2 + l * SZ_GU); w.gain = P.in[22] + l * D; w.K = D; w.N = NGU; w.gu = 1; break;
            case 3: w.src = P.in[24] + (size_t)l * DFF * D; w.dst = (bf16_t*)(P.ws + OFF_DN2 + l * SZ_DN); w.K = DFF; w.N = D; break;
            case 4: w.src = P.in[17] + (size_t)l * D * D; w.dst = (bf16_t*)(P.ws + OFF_WQ + l * SZ_MM); w.gain = P.in[15] + l * D; w.K = D; w.N = D; break;
            case 5: w.src = P.in[18] + (size_t)l * D * 2048; w.dst = (bf16_t*)(P.ws + OFF_WKV + l * 2 * SZ_MM); w.gain = P.in[16] + l * D; w.K = D; w.N = 2048; break;
            default: w.src = P.in[21] + (size_t)l * D * D; w.dst = (bf16_t*)(P.ws + OFF_WO + l * SZ_MM); w.K = D; w.N = D; break;
        }
    } else if (j == 14) { w.src = P.in[6]; w.dst = (bf16_t*)(P.ws + OFF_EVIN); w.gain = P.in[5]; w.K = D; w.N = 2304; }
    else if (j == 15) { w.src = P.in[10]; w.dst = (bf16_t*)(P.ws + OFF_EVOUT); w.K = D; w.N = D; }
    else if (j == 16) { w.src = P.in[11]; w.dst = (bf16_t*)(P.ws + OFF_ODIN); w.gain = P.in[5] + D; w.K = D; w.N = 3072; }
    else { w.src = P.in[14]; w.dst = (bf16_t*)(P.ws + OFF_ODOUT); w.K = D; w.N = D; }
    (void)wsb;
    return w;
}

DI void wconv_tile(const WJob& w, int t, float* sm, int tid, bool act) {
    const int ntn = w.N >> 6; const int tk = t / ntn, tn = t - tk * ntn;
    if (act) {
#pragma unroll
        for (int p = 0; p < 4; ++p) {
            const int kr = p * 16 + (tid >> 4);
            const float4 v = *(const float4*)(w.src + (size_t)(tk * 64 + kr) * w.N + tn * 64 + (tid & 15) * 4);
            const float g = w.gain ? w.gain[tk * 64 + kr] : 1.f;
            float* sp = sm + kr * 65 + (tid & 15) * 4;
            sp[0] = v.x * g; sp[1] = v.y * g; sp[2] = v.z * g; sp[3] = v.w * g;
        }
    }
    __syncthreads();
    if (act) {
        const int n = tid >> 2, kq = tid & 3; const int ng = tn * 64 + n;
        int drow = ng;
        if (w.gu) drow = ng < DFF ? ((ng >> 5) * 64 + (ng & 31)) : (((ng - DFF) >> 5) * 64 + 32 + ((ng - DFF) & 31));
        unsigned o[8];
#pragma unroll
        for (int e = 0; e < 8; ++e) o[e] = pk2(sm[(kq * 16 + 2 * e) * 65 + n], sm[(kq * 16 + 2 * e + 1) * 65 + n]);
        uint4* dp = (uint4*)(w.dst + (size_t)drow * w.K + tk * 64 + kq * 16);
        dp[0] = make_uint4(o[0], o[1], o[2], o[3]); dp[1] = make_uint4(o[4], o[5], o[6], o[7]);
    }
    __syncthreads();
}

DI float wave_sum(float v) {
    v += __shfl_xor(v, 1); v += __shfl_xor(v, 2); v += __shfl_xor(v, 4); v += __shfl_xor(v, 8); v += __shfl_xor(v, 16); v += __shfl_xor(v, 32);
    return v;
}

DI void rowconv(const float* src, bf16_t* dst, float* ssq, int row, int lane) {
    const float* xr = src + (size_t)row * D;
    float ss = 0.f;
#pragma unroll
    for (int p = 0; p < 4; ++p) {
        const float4 v = *(const float4*)(xr + p * 256 + lane * 4);
        ss += v.x * v.x + v.y * v.y + v.z * v.z + v.w * v.w;
        *(uint2*)(dst + (size_t)row * D + p * 256 + lane * 4) = make_uint2(pk2(v.x, v.y), pk2(v.z, v.w));
    }
    ss = wave_sum(ss);
    if (lane == 0) ssq[row] = ss;
}

DI void phase0(const Params& P, char* smem) {
    const int tid = otid(), lane = tid & 63, wid = tid >> 6;
    float* ssq = (float*)(P.ws + OFF_SSQ);
    for (int i = blockIdx.x * NTHR + tid; i < 8 * T; i += gridDim.x * NTHR) ssq[T + i] = 0.f;
    constexpr int NW = 12352 / 2, NX = T / 8, NM = 1024 / 8;
    for (int u = blockIdx.x; u < NW + NX + NM; u += gridDim.x) {
        if (u < NW) {
            const int half = tid >> 8;
            int t = 2 * u + half, j = 0;
            for (; j < 17; ++j) { const int c = wjob_tiles(j); if (t < c) break; t -= c; }
            const WJob w = get_wjob(P, j);
            wconv_tile(w, t, (float*)smem + half * (64 * 65), tid & 255, true);
        } else if (u < NW + NX) {
            rowconv(P.in[0], (bf16_t*)(P.ws + OFF_XB), ssq, (u - NW) * 8 + wid, lane);
        } else {
            rowconv(P.in[1], (bf16_t*)(P.ws + OFF_MEMB), (float*)(P.ws + OFF_SSQM), (u - NW - NX) * 8 + wid, lane);
        }
    }
}

struct GJob {
    const bf16_t* A; const bf16_t* W;
    int lda, ksplit, kextra, K, ntm, ntn, mode;
    const float* rs;
    bf16_t* O; int ldo;
    const float* xin; float* xout; bf16_t* xb; float* ssq_out; float alpha;
    const float* qg; const float* kg; int qn_end, kn_end;
    bf16_t* vt;
};

typedef __attribute__((address_space(3))) unsigned* ldsu_t;
typedef const __attribute__((address_space(1))) unsigned* glbu_t;
DI void glds16(const bf16_t* g, char* l) { __builtin_amdgcn_global_load_lds((glbu_t)(const void*)g, (ldsu_t)(void*)l, 16, 0, 0); }

DI void gemm_tile(const GJob& J, int t, char* smem, bool dry) {
    const int tid = otid(), lane = tid & 63, wid = tid >> 6, wr = wid >> 2, wc = wid & 3;
    const int r = lane & 31, h = lane >> 5;
    int tm, tn;
    { const int gsz = 32 * J.ntn; const int g = t / gsz; const int rem = t - g * gsz; const int rows = min(32, J.ntm - g * 32); tn = rem / rows; tm = g * 32 + (rem - tn * rows); }
    const int lrow = wid * 16 + (lane >> 2);
    const int csw = ((lane & 3) ^ ((lane >> 4) & 3)) * 8;
    const bf16_t* Ag = J.A + (size_t)(tm * 256 + lrow) * J.lda + csw;
    const bf16_t* Wg = J.W + (size_t)(tn * 256 + lrow) * J.K + csw;
    const size_t astr = (size_t)128 * J.lda, wstr = (size_t)128 * J.K;
    char* lb = smem + tid * 16;
    const int nk = J.K >> 5;
#define GLDS(kt, buf) do { const int k0_ = (kt) * 32; const int ka_ = k0_ + (k0_ >= J.ksplit ? J.kextra : 0); char* l_ = lb + (buf) * STAGE_B; \
        glds16(Ag + ka_, l_); glds16(Ag + astr + ka_, l_ + 8192); glds16(Wg + k0_, l_ + OPB); glds16(Wg + wstr + k0_, l_ + OPB + 8192); } while (0)
    f32x16 acc[4][2];
#pragma unroll
    for (int a = 0; a < 4; ++a)
#pragma unroll
        for (int b = 0; b < 2; ++b)
#pragma unroll
            for (int i = 0; i < 16; ++i) acc[a][b][i] = 0.f;
    const int fr = (r >> 2) & 3;
    const int xrow = (wc * 64 + r) * 64, wrow = OPB + (wr * 128 + r) * 64;
    const int co0 = ((0 + h) ^ fr) * 16, co1 = ((2 + h) ^ fr) * 16;

    __syncthreads();
    GLDS(0, 0); GLDS(1, 1); GLDS(2, 2);
    asm volatile("s_waitcnt vmcnt(8)" ::: "memory");
    __builtin_amdgcn_s_barrier();
    bf16x8 w0[4], x0[2], w1[4], x1[2];
#define LOADF(W_, X_, sb_, co_) do { _Pragma("unroll") for (int ti = 0; ti < 2; ++ti) X_[ti] = *(const bf16x8*)((sb_) + xrow + ti * 2048 + (co_)); \
        _Pragma("unroll") for (int fi = 0; fi < 4; ++fi) W_[fi] = *(const bf16x8*)((sb_) + wrow + fi * 2048 + (co_)); } while (0)
#define MFMA8(W_, X_) do { __builtin_amdgcn_s_setprio(1); _Pragma("unroll") for (int fi = 0; fi < 4; ++fi) _Pragma("unroll") for (int ti = 0; ti < 2; ++ti) \
        acc[fi][ti] = MFMA(W_[fi], X_[ti], acc[fi][ti]); __builtin_amdgcn_s_setprio(0); } while (0)
    LOADF(w0, x0, smem, co0);
    __builtin_amdgcn_s_waitcnt(0xC07F);
    int buf = 0;
    for (int kt = 0; kt < nk; ++kt) {
        const char* sb = smem + buf * STAGE_B;
        LOADF(w1, x1, sb, co1);
        __builtin_amdgcn_sched_barrier(0);
        MFMA8(w0, x0);
        __builtin_amdgcn_s_waitcnt(0xC07F);
        __builtin_amdgcn_sched_barrier(0);
        const int nb = (buf + 1 == NST) ? 0 : buf + 1;
        if (kt + 1 < nk) {
            if (kt + 2 < nk) asm volatile("s_waitcnt vmcnt(4)" ::: "memory"); else asm volatile("s_waitcnt vmcnt(0)" ::: "memory");
            __builtin_amdgcn_s_barrier();
            if (kt + 3 < nk) { const int fb_ = (buf + 3 >= NST) ? buf + 3 - NST : buf + 3; GLDS(kt + 3, fb_); }
        }
        LOADF(w0, x0, smem + nb * STAGE_B, co0);
        __builtin_amdgcn_sched_barrier(0);
        MFMA8(w1, x1);
        __builtin_amdgcn_s_waitcnt(0xC07F);
        __builtin_amdgcn_sched_barrier(0);
        buf = nb;
    }
#undef LOADF
#undef MFMA8
#undef GLDS
    __syncthreads();

    if (dry) { if (acc[0][0][0] + acc[1][1][0] + acc[2][0][0] + acc[3][1][0] == 12345.678f) J.O[0] = 1; return; }
    const int tokb = tm * 256 + wc * 64;
    const int fb = tn * 256 + wr * 128;
    float rsc[2];
#pragma unroll
    for (int ti = 0; ti < 2; ++ti) rsc[ti] = J.rs ? __builtin_amdgcn_rsqf(J.rs[tokb + ti * 32 + r] * (1.f / 1024.f) + EPS) : 1.f;

    if (J.mode == 3 && fb >= 1024) {
#pragma unroll
        for (int ti = 0; ti < 2; ++ti) {
            const int tok = tokb + ti * 32 + r;
#pragma unroll
            for (int fi = 0; fi < 4; ++fi)
#pragma unroll
                for (int i = 0; i < 16; ++i) {
                    const int f = fb - 1024 + fi * 32 + crow(i, h);
                    const int bh_ = (tok >> 8) * 4 + (f >> 8), d_ = f & 255, key_ = tok & 255, k16 = key_ & 15;
                    const int ln_ = ((k16 >> 2) & 1) * 32 + (d_ & 31), e_ = ((k16 >> 3) << 2) | (k16 & 3);
                    J.vt[((((((size_t)bh_ * 8 + (d_ >> 5)) * 8 + (key_ >> 5)) * 2 + ((key_ >> 4) & 1)) * 64 + ln_) << 3) + e_] = (bf16_t)(pk2(acc[fi][ti][i] * rsc[ti], 0.f) & 0xffffu);
                }
        }
        return;
    }
    char* wl = smem + wid * 16384;
#pragma unroll
    for (int ti = 0; ti < 2; ++ti) {
#pragma unroll
        for (int fp = 0; fp < 2; ++fp) {
            const float sc = (J.mode == 1) ? J.alpha : rsc[ti];
#pragma unroll
            for (int fi2 = 0; fi2 < 2; ++fi2)
#pragma unroll
                for (int g = 0; g < 4; ++g) {
                    float4 v;
                    v.x = acc[2 * fp + fi2][ti][4 * g + 0] * sc; v.y = acc[2 * fp + fi2][ti][4 * g + 1] * sc;
                    v.z = acc[2 * fp + fi2][ti][4 * g + 2] * sc; v.w = acc[2 * fp + fi2][ti][4 * g + 3] * sc;
                    *(float4*)(wl + r * 272 + (fi2 * 32 + 8 * g + 4 * h) * 4) = v;
                }
            const int tok0 = tokb + ti * 32, f0 = fb + fp * 64;
            if (J.mode == 0) {
                const int c4 = (lane & 7) * 4;
#pragma unroll
                for (int p = 0; p < 4; ++p) {
                    const int row = p * 8 + (lane >> 3);
                    const float4 ga = *(const float4*)(wl + row * 272 + c4 * 4);
                    const float4 up = *(const float4*)(wl + row * 272 + (32 + c4) * 4);
                    float y0 = ga.x * up.x * __builtin_amdgcn_rcpf(1.f + fexp2(-ga.x * LOG2E));
                    float y1 = ga.y * up.y * __builtin_amdgcn_rcpf(1.f + fexp2(-ga.y * LOG2E));
                    float y2 = ga.z * up.z * __builtin_amdgcn_rcpf(1.f + fexp2(-ga.z * LOG2E));
                    float y3 = ga.w * up.w * __builtin_amdgcn_rcpf(1.f + fexp2(-ga.w * LOG2E));
                    *(uint2*)(J.O + (size_t)(tok0 + row) * J.ldo + (f0 >> 1) + c4) = make_uint2(pk2(y0, y1), pk2(y2, y3));
                }
            } else if (J.mode == 1) {
                const int c4 = (lane & 15) * 4;
#pragma unroll
                for (int p = 0; p < 8; ++p) {
                    const int row = p * 4 + (lane >> 4);
                    const size_t tok = tok0 + row;
                    const float4 v = *(const float4*)(wl + row * 272 + c4 * 4);
                    const float4 xo = *(const float4*)(J.xin + tok * D + f0 + c4);
                    float4 xn; xn.x = xo.x + v.x; xn.y = xo.y + v.y; xn.z = xo.z + v.z; xn.w = xo.w + v.w;
                    *(float4*)(J.xout + tok * D + f0 + c4) = xn;
                    *(uint2*)(J.xb + tok * D + f0 + c4) = make_uint2(pk2(xn.x, xn.y), pk2(xn.z, xn.w));
                    float ss = xn.x * xn.x + xn.y * xn.y + xn.z * xn.z + xn.w * xn.w;
                    ss += __shfl_xor(ss, 1); ss += __shfl_xor(ss, 2); ss += __shfl_xor(ss, 4); ss += __shfl_xor(ss, 8);
                    if ((lane & 15) == 0) atomicAdd(J.ssq_out + tok, ss);
                }
            } else {
                const int nm = f0 < J.qn_end ? 1 : (f0 < J.kn_end ? 2 : 0);
                const float* gp = nm == 1 ? J.qg : J.kg;
                const int c4 = (lane & 15) * 4;
                float4 gn = make_float4(1.f, 1.f, 1.f, 1.f);
                if (nm) gn = *(const float4*)(gp + c4);
#pragma unroll
                for (int p = 0; p < 8; ++p) {
                    const int row = p * 4 + (lane >> 4);
                    float4 v = *(const float4*)(wl + row * 272 + c4 * 4);
                    if (nm) {
                        float ss = v.x * v.x + v.y * v.y + v.z * v.z + v.w * v.w;
                        ss += __shfl_xor(ss, 1); ss += __shfl_xor(ss, 2); ss += __shfl_xor(ss, 4); ss += __shfl_xor(ss, 8);
                        const float inv = __builtin_amdgcn_rsqf(ss * (1.f / 64.f) + EPS);
                        v.x *= inv * gn.x; v.y *= inv * gn.y; v.z *= inv * gn.z; v.w *= inv * gn.w;
                    }
                    *(uint2*)(J.O + (size_t)(tok0 + row) * J.ldo + f0 + c4) = make_uint2(pk2(v.x, v.y), pk2(v.z, v.w));
                }
            }
        }
    }
}

DI void gemm_phase(const GJob& JA, int nA, int nB, const Params& P, char* smem, bool dry) {
    for (int u = blockIdx.x; u < nA + nB; u += gridDim.x) {
        GJob J = JA; int t = u;
        if (u >= nA) {
            const int v = u - nA; const int layer = v >> 5; t = v & 31;
            J.A = (const bf16_t*)(P.ws + OFF_MEMB); J.lda = D; J.ksplit = 1 << 30; J.kextra = 0;
            J.W = (const bf16_t*)(P.ws + OFF_WKV + (size_t)layer * 2 * SZ_MM); J.K = D; J.ntm = 4; J.ntn = 8; J.mode = 3;
            J.rs = (const float*)(P.ws + OFF_SSQM); J.O = (bf16_t*)(P.ws + OFF_KN + (size_t)layer * SZ_MM); J.ldo = D;
            J.qn_end = 0; J.kn_end = 0; J.vt = (bf16_t*)(P.ws + OFF_VT + (size_t)layer * SZ_MM);
        }
        gemm_tile(J, t, smem, dry);
    }
}

#define KV_DECL uint4 rk0, rk1, rk2, rk3, rv0, rv1, rv2, rv3
#define KV_LOAD(kb_, dil_) do { const int kk_ = lane >> 3; \
    const bf16_t* p0_ = qkv + (rowb + min(max((kb_) + (dil_) * kk_, 0), S - 1)) * ld + (lane & 7) * 8; \
    const bf16_t* p1_ = qkv + (rowb + min(max((kb_) + (dil_) * (kk_ + 8), 0), S - 1)) * ld + (lane & 7) * 8; \
    const bf16_t* p2_ = qkv + (rowb + min(max((kb_) + (dil_) * (kk_ + 16), 0), S - 1)) * ld + (lane & 7) * 8; \
    const bf16_t* p3_ = qkv + (rowb + min(max((kb_) + (dil_) * (kk_ + 24), 0), S - 1)) * ld + (lane & 7) * 8; \
    rk0 = *(const uint4*)(p0_ + kcol); rk1 = *(const uint4*)(p1_ + kcol); rk2 = *(const uint4*)(p2_ + kcol); rk3 = *(const uint4*)(p3_ + kcol); \
    rv0 = *(const uint4*)(p0_ + vcol); rv1 = *(const uint4*)(p1_ + vcol); rv2 = *(const uint4*)(p2_ + vcol); rv3 = *(const uint4*)(p3_ + vcol); } while (0)
#define KV_STORE() do { char* wp_ = vl + (lane >> 3) * 144 + (lane & 7) * 16; \
    *(uint4*)(wp_) = rk0; *(uint4*)(wp_ + 8 * 144) = rk1; *(uint4*)(wp_ + 16 * 144) = rk2; *(uint4*)(wp_ + 24 * 144) = rk3; \
    *(uint4*)(wp_ + 4608) = rv0; *(uint4*)(wp_ + 4608 + 8 * 144) = rv1; *(uint4*)(wp_ + 4608 + 16 * 144) = rv2; *(uint4*)(wp_ + 4608 + 24 * 144) = rv3; } while (0)

DI bf16x8 v_frag(const char* vbase, int s, int dt) {
    typedef __attribute__((address_space(3))) v4i16_t* lp_t;
    const char* a = vbase + s * (16 * 144) + dt * 64;
    const s16x4 lo = __builtin_bit_cast(s16x4, __builtin_amdgcn_ds_read_tr16_b64_v4i16((lp_t)(a)));
    const s16x4 hi = __builtin_bit_cast(s16x4, __builtin_amdgcn_ds_read_tr16_b64_v4i16((lp_t)(a + 8 * 144)));
    return __builtin_shufflevector(lo, hi, 0, 1, 2, 3, 4, 5, 6, 7);
}

template <int OFF> DI bf16x8 pack8v(const f32x16& p) {
    typedef unsigned u32x4 __attribute__((ext_vector_type(4)));
    u32x4 w; w[0] = pk2(p[OFF + 0], p[OFF + 1]); w[1] = pk2(p[OFF + 2], p[OFF + 3]); w[2] = pk2(p[OFF + 4], p[OFF + 5]); w[3] = pk2(p[OFF + 6], p[OFF + 7]);
    return __builtin_bit_cast(bf16x8, w);
}

DI void win_attn_wave(bf16_t* qkv, int ld, int b, int qcol, int kcol, int vcol, int tq0, int qstride,
                      float slope2, float m_init, float l_init, int mode, char* vl, int lane, bool dry) {
    const int r = lane & 31, h = lane >> 5;
    const size_t rowb = (size_t)b * S;
    const int tq = tq0 + qstride * r;
    const int tqlast = tq0 + qstride * 31;
    bf16x8 qf[4];
    {
        const bf16_t* qp = qkv + (rowb + tq) * ld + qcol + h * 32;
#pragma unroll
        for (int ks = 0; ks < 4; ++ks) qf[ks] = *(const bf16x8*)(qp + ks * 8);
    }
    f32x16 o0, o1;
#pragma unroll
    for (int i = 0; i < 16; ++i) { o0[i] = 0.f; o1[i] = 0.f; }
    float m = m_init, l = (h == 0) ? l_init : 0.f;
    const float sc2 = 0.125f * LOG2E;
    const int i16 = lane & 15;
    const char* vbase = vl + 4608 + (4 * h + (i16 >> 2)) * 144 + (16 * ((lane >> 4) & 1) + 4 * (i16 & 3)) * 2;
    const int npat = mode ? 3 : 1;
    const char* kfp = vl + r * 144 + h * 64;
    KV_DECL;
    for (int pi = 0; pi < npat; ++pi) {
        int dil, W, kfirst, nt;
        if (!mode) { dil = 1; W = 127; kfirst = tq0 - 128; nt = 5; }
        else if (pi == 0) { dil = 1; W = 128; kfirst = tq0 - 128; nt = 20; }
        else if (pi == 1) { dil = 4; W = 512; kfirst = tq0 - 512; nt = 8; }
        else { dil = 16; W = 2048; kfirst = tq0 - 2048; nt = 5; }
        const int step = 32 * dil;
        int t0 = 0;
        { const int need = -kfirst - 31 * dil; if (need > 0) t0 = (need + step - 1) / step; }
        if (t0 >= nt) continue;
        KV_LOAD(kfirst + t0 * step, dil);
        for (int tile = t0; tile < nt; ++tile) {
            const int kb = kfirst + tile * step;
            KV_STORE();
            asm volatile("" ::: "memory");
            if (tile + 1 < nt) KV_LOAD(kb + step, dil);
            f32x16 s;
#pragma unroll
            for (int i = 0; i < 16; ++i) s[i] = 0.f;
#pragma unroll
            for (int ks = 0; ks < 4; ++ks) s = MFMA(*(const bf16x8*)(kfp + ks * 16), qf[ks], s);
            f32x16 sv; float mloc = -INFINITY;
            const int d0 = tq - kb - 4 * h * dil;
            const unsigned wlim = (unsigned)min(W, tq);
#pragma unroll
            for (int i = 0; i < 16; ++i) {
                const int diff = d0 - dil * crow(i, 0);
                const float sb = s[i] * sc2 - slope2 * (float)diff;
                sv[i] = ((unsigned)diff <= wlim) ? sb : -INFINITY;
                mloc = fmaxf(mloc, sv[i]);
            }
            mloc = fmaxf(mloc, __shfl_xor(mloc, 32));
            const float mn = fmaxf(m, mloc);
            float ps = 0.f;
#pragma unroll
            for (int i = 0; i < 16; ++i) { sv[i] = fexp2(sv[i] - mn); ps += sv[i]; }
            if (__builtin_amdgcn_ballot_w64(mn != m) != 0) {
                const float alpha = fexp2(m - mn);
                l *= alpha;
#pragma unroll
                for (int i = 0; i < 16; ++i) { o0[i] *= alpha; o1[i] *= alpha; }
                m = mn;
            }
            l += ps;
            const bf16x8 p0 = pack8v<0>(sv), p1 = pack8v<8>(sv);
            o0 = MFMA(v_frag(vbase, 0, 0), p0, o0);
            o0 = MFMA(v_frag(vbase, 1, 0), p1, o0);
            o1 = MFMA(v_frag(vbase, 0, 1), p0, o1);
            o1 = MFMA(v_frag(vbase, 1, 1), p1, o1);
            asm volatile("" ::: "memory");
        }
    }
    const float lt = l + __shfl_xor(l, 32);
    const float inv = 1.f / lt;
    if (dry) { if (o0[0] + o1[0] + lt == 12345.678f) qkv[0] = 1; return; }
    bf16_t* op = qkv + (rowb + tq) * ld + qcol + 4 * h;
#pragma unroll
    for (int g = 0; g < 4; ++g) {
        *(uint2*)(op + 8 * g) = make_uint2(pk2(o0[4 * g] * inv, o0[4 * g + 1] * inv), pk2(o0[4 * g + 2] * inv, o0[4 * g + 3] * inv));
        *(uint2*)(op + 32 + 8 * g) = make_uint2(pk2(o1[4 * g] * inv, o1[4 * g + 1] * inv), pk2(o1[4 * g + 2] * inv, o1[4 * g + 3] * inv));
    }
}

DI void stick_wave(bf16_t* qkv, int ld, int b, int qcol, int kcol, int vcol, int qt, char* vl, int lane, bool dry) {
    const int r = lane & 31, h = lane >> 5;
    const size_t rowb = (size_t)b * S;
    const int tq = qt * 32 + r;
    bf16x8 qf[4];
    {
        const bf16_t* qp = qkv + (rowb + tq) * ld + qcol + h * 32;
#pragma unroll
        for (int ks = 0; ks < 4; ++ks) qf[ks] = *(const bf16x8*)(qp + ks * 8);
    }
    f32x16 o0, o1;
#pragma unroll
    for (int i = 0; i < 16; ++i) { o0[i] = 0.f; o1[i] = 0.f; }
    float R = 1.f;
    const int i16 = lane & 15;
    const char* vbase = vl + 4608 + (4 * h + (i16 >> 2)) * 144 + (16 * ((lane >> 4) & 1) + 4 * (i16 & 3)) * 2;
    const char* kfp = vl + r * 144 + h * 64;
    KV_DECL;
    KV_LOAD(qt * 32, 1);
    for (int tile = qt; tile >= 0; --tile) {
        KV_STORE();
        asm volatile("" ::: "memory");
        if (tile > 0) KV_LOAD((tile - 1) * 32, 1);
        f32x16 s;
#pragma unroll
        for (int i = 0; i < 16; ++i) s[i] = 0.f;
#pragma unroll
        for (int ks = 0; ks < 4; ++ks) s = MFMA(*(const bf16x8*)(kfp + ks * 16), qf[ks], s);
        const bool diag = (tile == qt);
        f32x16 sg, kp;
#pragma unroll
        for (int i = 0; i < 16; ++i) {
            const float z2 = fminf(s[i] * (0.125f * LOG2E), 80.f);
            const float t = fexp2(z2);
            const float k = __builtin_amdgcn_rcpf(1.f + t);
            kp[i] = k; sg[i] = t * k;
        }
        if (diag) {
#pragma unroll
            for (int i = 0; i < 16; ++i) { const bool strict = crow(i, h) < r; kp[i] = strict ? kp[i] : 1.f; sg[i] = strict ? sg[i] : 0.f; }
        }
        float G[4], PG[4], both[4];
#pragma unroll
        for (int g = 0; g < 4; ++g) { G[g] = (kp[4 * g] * kp[4 * g + 1]) * (kp[4 * g + 2] * kp[4 * g + 3]); PG[g] = __shfl_xor(G[g], 32); both[g] = G[g] * PG[g]; }
        float Sx[4];
        Sx[3] = 1.f; Sx[2] = both[3]; Sx[1] = both[3] * both[2]; Sx[0] = Sx[1] * both[1];
        f32x16 a;
#pragma unroll
        for (int g = 0; g < 4; ++g) {
            float la = R * Sx[g] * (h == 0 ? PG[g] : 1.f);
#pragma unroll
            for (int j = 3; j >= 0; --j) {
                a[4 * g + j] = sg[4 * g + j] * la;
                la *= kp[4 * g + j];
            }
        }
        R *= Sx[0] * both[0];
        const bf16x8 p0 = pack8v<0>(a), p1 = pack8v<8>(a);
        o0 = MFMA(v_frag(vbase, 0, 0), p0, o0);
        o0 = MFMA(v_frag(vbase, 1, 0), p1, o0);
        o1 = MFMA(v_frag(vbase, 0, 1), p0, o1);
        o1 = MFMA(v_frag(vbase, 1, 1), p1, o1);
        asm volatile("" ::: "memory");
        if (__builtin_amdgcn_ballot_w64(R >= 1.17549435e-38f) == 0) break;
    }
    if (dry) { if (o0[0] + o1[0] == 12345.678f) qkv[0] = 1; return; }
    bf16_t* op = qkv + (rowb + tq) * ld + qcol + 4 * h;
#pragma unroll
    for (int g = 0; g < 4; ++g) {
        *(uint2*)(op + 8 * g) = make_uint2(pk2(o0[4 * g], o0[4 * g + 1]), pk2(o0[4 * g + 2], o0[4 * g + 3]));
        *(uint2*)(op + 32 + 8 * g) = make_uint2(pk2(o1[4 * g], o1[4 * g + 1]), pk2(o1[4 * g + 2], o1[4 * g + 3]));
    }
}

DI void attn_even_phase(const Params& P, char* smem, bool dry) {
    const int tid_ = otid(); const int lane = tid_ & 63, wid = tid_ >> 6;
    bf16_t* qkv = (bf16_t*)(P.ws + OFF_BIG);
    char* vl = smem + wid * 9216;
    for (int it = blockIdx.x * 8 + wid; it < 2048 + 4096; it += gridDim.x * 8) {
        if (it < 2048) {
            const int bh = it >> 6, p = it & 63; const int b = bh >> 3, head = bh & 7;
            stick_wave(qkv, 2304, b, 768 + head * 64, 1280 + head * 64, 1792 + head * 64, 127 - p, vl, lane, dry);
            stick_wave(qkv, 2304, b, 768 + head * 64, 1280 + head * 64, 1792 + head * 64, p, vl, lane, dry);
        } else {
            const int v = it - 2048; const int g = v & 3; const int qt = (v >> 2) & 127; const int rest = v >> 9; const int b = rest >> 1, kvh = rest & 1;
            const int head = kvh * 4 + g;
            const float slope = exp2f(-(float)(head + 1));
            const float sink = P.in[9][head];
            win_attn_wave(qkv, 2304, b, head * 64, 512 + kvh * 64, 640 + kvh * 64, qt * 32, 1, slope * LOG2E, sink * LOG2E, 1.f, 0, vl, lane, dry);
        }
    }
}

DI void attn_odd_phase(const Params& P, char* smem, bool dry) {
    const int tid_ = otid(); const int lane = tid_ & 63, wid = tid_ >> 6;
    bf16_t* qkv = (bf16_t*)(P.ws + OFF_BIG);
    char* vl = smem + wid * 9216;
    for (int it = blockIdx.x * 8 + wid; it < 8192; it += gridDim.x * 8) {
        const int res16 = it & 15; const int u0 = ((it >> 4) & 7) * 32; const int head = (it >> 7) & 15; const int b = it >> 11;
        const float slope = exp2f(-0.5f * (float)(head + 1));
        win_attn_wave(qkv, 3072, b, head * 64, 1024 + head * 64, 2048 + head * 64, res16 + 16 * u0, 16, slope * LOG2E, -1e30f, 0.f, 1, vl, lane, dry);
    }
}

DI void xattn_wave(bf16_t* qb, const bf16_t* Kn, const bf16_t* VT, const float* qg, int b, int head, int tok0, char* ql, int lane, bool dry) {
    const int r = lane & 31, h = lane >> 5;
    const size_t token = (size_t)b * S + tok0 + r;
    bf16_t* qp = qb + token * D + head * 256 + h * 128;
    float ss = 0.f;
#pragma unroll
    for (int ks = 0; ks < 16; ++ks) {
        const uint4 v = *(const uint4*)(qp + ks * 8);
        const unsigned w[4] = {v.x, v.y, v.z, v.w};
#pragma unroll
        for (int e = 0; e < 4; ++e) { const float a = bflo(w[e]), c = bfhi(w[e]); ss += a * a + c * c; }
    }
    ss += __shfl_xor(ss, 32);
    const float inv = __builtin_amdgcn_rsqf(ss * (1.f / 256.f) + EPS);
#pragma unroll
    for (int ks = 0; ks < 16; ++ks) {
        const uint4 v = *(const uint4*)(qp + ks * 8);
        const float4 g0 = *(const float4*)(qg + h * 128 + ks * 8), g1 = *(const float4*)(qg + h * 128 + ks * 8 + 4);
        uint4 o;
        o.x = pk2(bflo(v.x) * inv * g0.x, bfhi(v.x) * inv * g0.y); o.y = pk2(bflo(v.y) * inv * g0.z, bfhi(v.y) * inv * g0.w);
        o.z = pk2(bflo(v.z) * inv * g1.x, bfhi(v.z) * inv * g1.y); o.w = pk2(bflo(v.w) * inv * g1.z, bfhi(v.w) * inv * g1.w);
        *(uint4*)(ql + (ks * 64 + lane) * 16) = o;
    }
    asm volatile("" ::: "memory");
    const float sc2 = 0.0625f * LOG2E;
    const bf16_t* kp0 = Kn + ((size_t)(b * 4 + head) * 8 * 16 * 64 + lane) * 8;
    float m = -INFINITY;
#pragma unroll 1
    for (int tile = 0; tile < 8; ++tile) {
        f32x16 s;
#pragma unroll
        for (int i = 0; i < 16; ++i) s[i] = 0.f;
        const bf16_t* kp = kp0 + (size_t)tile * 16 * 512;
#pragma unroll
        for (int ks = 0; ks < 16; ++ks) {
            const bf16x8 kf = *(const bf16x8*)(kp + ks * 512);
            const bf16x8 qf = *(const bf16x8*)(ql + (ks * 64 + lane) * 16);
            s = MFMA(kf, qf, s);
        }
#pragma unroll
        for (int i = 0; i < 16; ++i) m = fmaxf(m, s[i]);
    }
    m = fmaxf(m, __shfl_xor(m, 32));
    float l = 0.f;
    bf16x8 pf[8][2];
#pragma unroll
    for (int tile = 0; tile < 8; ++tile) {
        f32x16 s;
#pragma unroll
        for (int i = 0; i < 16; ++i) s[i] = 0.f;
        const bf16_t* kp = kp0 + (size_t)tile * 16 * 512;
#pragma unroll
        for (int ks = 0; ks < 16; ++ks) {
            const bf16x8 kf = *(const bf16x8*)(kp + ks * 512);
            const bf16x8 qf = *(const bf16x8*)(ql + (ks * 64 + lane) * 16);
            s = MFMA(kf, qf, s);
        }
#pragma unroll
        for (int i = 0; i < 16; ++i) { s[i] = fexp2((s[i] - m) * sc2); l += s[i]; }
        pf[tile][0] = pack8v<0>(s); pf[tile][1] = pack8v<8>(s);
    }
    l += __shfl_xor(l, 32);
    const float il = 1.f / l;
    bf16_t* op = qb + token * D + head * 256 + 4 * h;
#pragma unroll 1
    for (int dt = 0; dt < 8; ++dt) {
        f32x16 o;
#pragma unroll
        for (int i = 0; i < 16; ++i) o[i] = 0.f;
        const bf16_t* vp = VT + ((((size_t)(b * 4 + head) * 8 + dt) * 8 * 2 * 64) + lane) * 8;
#pragma unroll
        for (int tile = 0; tile < 8; ++tile)
#pragma unroll
            for (int s2 = 0; s2 < 2; ++s2) {
                const bf16x8 va = *(const bf16x8*)(vp + (tile * 2 + s2) * 512);
                o = MFMA(va, pf[tile][s2], o);
            }
#pragma unroll
        for (int g = 0; g < 4; ++g)
            if (dry) { if (o[4 * g] == 12345.678f) qb[0] = 1; } else *(uint2*)(op + dt * 32 + 8 * g) = make_uint2(pk2(o[4 * g] * il, o[4 * g + 1] * il), pk2(o[4 * g + 2] * il, o[4 * g + 3] * il));
    }
}

DI void xattn_phase(const Params& P, int l, char* smem, bool dry) {
    const int tid_ = otid(); const int lane = tid_ & 63, wid = tid_ >> 6;
    bf16_t* qb = (bf16_t*)(P.ws + OFF_BIG);
    const bf16_t* Kn = (const bf16_t*)(P.ws + OFF_KF + (size_t)l * SZ_MM);
    const bf16_t* VT = (const bf16_t*)(P.ws + OFF_VT + (size_t)l * SZ_MM);
    const float* qg = P.in[19] + l * 256;
    char* ql = smem + wid * 16384;
    for (int it = blockIdx.x * 8 + wid; it < 2048; it += gridDim.x * 8) {
        const int qt = it & 127, head = (it >> 7) & 3, b = it >> 9;
        xattn_wave(qb, Kn, VT, qg, b, head, qt * 32, ql, lane, dry);
    }
}

DI void knorm_phase(const Params& P) {
    const int tid_ = otid(); const int lane = tid_ & 63, wid = tid_ >> 6;
    for (int u = blockIdx.x * 8 + wid; u < 8192; u += gridDim.x * 8) {
        const int l = u >> 12, row = (u >> 2) & 1023, head = u & 3;
        const bf16_t* kp = (const bf16_t*)(P.ws + OFF_KN + (size_t)l * SZ_MM) + (size_t)row * D + head * 256 + lane * 4;
        const uint2 v = *(const uint2*)kp;
        const float a0 = bflo(v.x), a1 = bfhi(v.x), a2 = bflo(v.y), a3 = bfhi(v.y);
        float ss = a0 * a0 + a1 * a1 + a2 * a2 + a3 * a3;
        ss = wave_sum(ss);
        const float inv = __builtin_amdgcn_rsqf(ss * (1.f / 256.f) + EPS);
        const float4 g = *(const float4*)(P.in[20] + l * 256 + lane * 4);
        const int b = row >> 8, key = row & 255;
        const int h = lane >> 5, ks = (lane & 31) >> 1, j0 = (lane & 1) * 4;
        bf16_t* dp = (bf16_t*)(P.ws + OFF_KF + (size_t)l * SZ_MM) + ((((((size_t)(b * 4 + head) * 8 + (key >> 5)) * 16 + ks) * 64) + h * 32 + (key & 31)) << 3) + j0;
        *(uint2*)dp = make_uint2(pk2(a0 * inv * g.x, a1 * inv * g.y), pk2(a2 * inv * g.z, a3 * inv * g.w));
    }
}

__global__ void __launch_bounds__(512) fwd_megakernel(Params P) {
    extern __shared__ __attribute__((aligned(16))) char smem[];
    cg::grid_group grid = cg::this_grid();
#pragma unroll 1
    for (int ph = 0; ph < 21; ++ph) {
        float* ssq = (float*)(P.ws + OFF_SSQ);
        bf16_t* xb = (bf16_t*)(P.ws + OFF_XB);
        bf16_t* big = (bf16_t*)(P.ws + OFF_BIG);
        int nrep = 1;
        if (ph > 0) { const int s_ = (ph - 1) % 10; const int kind = (s_ == 3) ? 2 : (s_ == 6) ? 4 : 1; if (PROBE_MASK & kind) nrep = 2; }
        for (int rep = 0; rep < nrep; ++rep) {
        const bool dry = rep + 1 < nrep;
        if (ph == 0) {
            phase0(P, smem);
        } else {
            const int l = (ph - 1) / 10, s = (ph - 1) % 10;
            if (s == 3) {
                if (l == 0) attn_even_phase(P, smem, dry); else attn_odd_phase(P, smem, dry);
            } else if (s == 6) {
                xattn_phase(P, l, smem, dry);
            } else {
                GJob J;
                J.A = xb; J.lda = D; J.ksplit = 1 << 30; J.kextra = 0; J.K = D; J.ntm = 64; J.mode = 1; J.rs = nullptr;
                J.O = big; J.ldo = D; J.xin = P.out; J.xout = P.out; J.xb = xb; J.ssq_out = ssq; J.alpha = 1.f;
                J.qg = nullptr; J.kg = nullptr; J.qn_end = 0; J.kn_end = 0; J.vt = nullptr; J.W = nullptr; J.ntn = 4;
                int nB = 0;
                if (s == 0 || s == 8) {
                    J.W = (const bf16_t*)(P.ws + (s == 0 ? OFF_GU1 : OFF_GU2) + (size_t)l * SZ_GU);
                    J.ntn = NGU / 256; J.mode = 0; J.rs = ssq + (size_t)(4 * l + (s == 0 ? 0 : 3)) * T; J.ldo = DFF;
                    if (ph == 1) nB = 64;
                } else if (s == 1 || s == 9) {
                    J.A = big; J.lda = DFF; J.K = DFF;
                    J.W = (const bf16_t*)(P.ws + (s == 1 ? OFF_DN1 : OFF_DN2) + (size_t)l * SZ_DN);
                    J.alpha = 0.5f; J.ssq_out = ssq + (size_t)(4 * l + (s == 1 ? 1 : 4)) * T;
                    if (ph == 2) J.xin = P.in[0];
                } else if (s == 2) {
                    J.mode = 2; J.rs = ssq + (size_t)(4 * l + 1) * T;
                    if (l == 0) { J.W = (const bf16_t*)(P.ws + OFF_EVIN); J.ntn = 9; J.ldo = 2304; J.qg = P.in[7]; J.kg = P.in[8]; J.qn_end = 512; J.kn_end = 640; }
                    else { J.W = (const bf16_t*)(P.ws + OFF_ODIN); J.ntn = 12; J.ldo = 3072; J.qg = P.in[12]; J.kg = P.in[13]; J.qn_end = 1024; J.kn_end = 2048; }
                } else if (s == 4) {
                    J.A = big;
                    if (l == 0) { J.W = (const bf16_t*)(P.ws + OFF_EVOUT); J.lda = 2304; J.ksplit = 512; J.kextra = 256; }
                    else { J.W = (const bf16_t*)(P.ws + OFF_ODOUT); J.lda = 3072; }
                    J.ssq_out = ssq + (size_t)(4 * l + 2) * T;
                } else if (s == 5) {
                    J.W = (const bf16_t*)(P.ws + OFF_WQ + (size_t)l * SZ_MM); J.mode = 2; J.rs = ssq + (size_t)(4 * l + 2) * T; J.ldo = D;
                } else {
                    J.A = big; J.W = (const bf16_t*)(P.ws + OFF_WO + (size_t)l * SZ_MM); J.ssq_out = ssq + (size_t)(4 * l + 3) * T;
                }
                gemm_phase(J, J.ntm * J.ntn, nB, P, smem, dry);
                if (ph == 2 && !dry) knorm_phase(P);
            }
        }
        grid.sync();
        }
    }
}

extern "C" void kernel_launch(void* const* d_in, const int* in_sizes, int n_in, void* d_out, int out_size, void* d_ws, size_t ws_size,
                              hipStream_t stream) {
    static int grid_blocks = 0;
    if (!grid_blocks) {
        int dev = 0, cus = 0, per_cu = 0;
        hipGetDevice(&dev);
        hipDeviceGetAttribute(&cus, hipDeviceAttributeMultiprocessorCount, dev);
        hipFuncSetAttribute((const void*)fwd_megakernel, hipFuncAttributeMaxDynamicSharedMemorySize, LDS_BYTES);
        hipOccupancyMaxActiveBlocksPerMultiprocessor(&per_cu, fwd_megakernel, NTHR, LDS_BYTES);
        if (per_cu < 1) per_cu = 1;
        if (per_cu > 1) per_cu = 1;
        grid_blocks = cus * per_cu;
    }
    if (ws_size < WS_NEED) { fprintf(stderr, "workspace too small: %zu < %zu\n", ws_size, (size_t)WS_NEED); return; }
    Params p{};
    for (int i = 0; i < 25; ++i) p.in[i] = (const float*)d_in[i];
    p.out = (float*)d_out; p.ws = (char*)d_ws;
    void* args[] = {&p};
    hipError_t e = hipLaunchCooperativeKernel((void*)fwd_megakernel, dim3(grid_blocks), dim3(NTHR), args, LDS_BYTES, stream);
    if (e != hipSuccess) fprintf(stderr, "cooperative launch failed: %s (grid %d)\n", hipGetErrorString(e), grid_blocks);
}
```

```cpp
#include <hip/hip_runtime.h>
#include <hip/hip_cooperative_groups.h>
#include <cstdio>
#include <cstdint>
namespace cg = cooperative_groups;

#define DI __device__ __forceinline__
typedef unsigned short bf16_t;
typedef short bf16x8 __attribute__((ext_vector_type(8)));
typedef short s16x4 __attribute__((ext_vector_type(4)));
typedef float f32x16 __attribute__((ext_vector_type(16)));
typedef __bf16 bf2_t __attribute__((ext_vector_type(2)));
typedef float f2_t __attribute__((ext_vector_type(2)));
typedef short v4i16_t __attribute__((ext_vector_type(4)));
#define MFMA(a, b, c) __builtin_amdgcn_mfma_f32_32x32x16_bf16((a), (b), (c), 0, 0, 0)

constexpr int T = 16384, S = 4096, D = 1024, DFF = 2816, NGU = 5632;
constexpr float EPS = 1e-6f;
constexpr float LOG2E = 1.4426950408889634f;
constexpr float LN2 = 0.6931471805599453f;

constexpr size_t SZ_GU = (size_t)NGU * D * 2, SZ_DN = (size_t)D * DFF * 2, SZ_MM = (size_t)D * D * 2;
constexpr size_t OFF_GU1 = 0;
constexpr size_t OFF_DN1 = OFF_GU1 + 2 * SZ_GU;
constexpr size_t OFF_GU2 = OFF_DN1 + 2 * SZ_DN;
constexpr size_t OFF_DN2 = OFF_GU2 + 2 * SZ_GU;
constexpr size_t OFF_WQ = OFF_DN2 + 2 * SZ_DN;
constexpr size_t OFF_WKV = OFF_WQ + 2 * SZ_MM;
constexpr size_t OFF_WO = OFF_WKV + 4 * SZ_MM;
constexpr size_t OFF_EVIN = OFF_WO + 2 * SZ_MM;
constexpr size_t OFF_EVOUT = OFF_EVIN + (size_t)2304 * D * 2;
constexpr size_t OFF_ODIN = OFF_EVOUT + SZ_MM;
constexpr size_t OFF_ODOUT = OFF_ODIN + (size_t)3072 * D * 2;
constexpr size_t OFF_XB = OFF_ODOUT + SZ_MM;
constexpr size_t OFF_BIG = OFF_XB + (size_t)T * D * 2;
constexpr size_t OFF_MEMB = OFF_BIG + (size_t)T * 3072 * 2;
constexpr size_t OFF_KN = OFF_MEMB + SZ_MM;
constexpr size_t OFF_VT = OFF_KN + 2 * SZ_MM;
constexpr size_t OFF_SSQ = OFF_VT + 2 * SZ_MM;
constexpr size_t OFF_SSQM = OFF_SSQ + (size_t)9 * T * 4;
constexpr size_t OFF_KMAX = OFF_SSQM + 4096;
constexpr size_t OFF_KF = OFF_KMAX + 256;
constexpr size_t WS_NEED = OFF_KF + 2 * SZ_MM;

#ifndef PROBE_MASK
#define PROBE_MASK 0
#endif
constexpr int NTHR = 512;
constexpr int NST = 4;
constexpr int STAGE_B = 32768;
constexpr int OPB = 16384;
constexpr int LDS_BYTES = 131072;

struct Params { const float* in[25]; float* out; char* ws; };

DI unsigned pk2(float a, float b) { f2_t v = {a, b}; bf2_t r = __builtin_convertvector(v, bf2_t); return __builtin_bit_cast(unsigned, r); }
DI float bflo(unsigned w) { return __uint_as_float(w << 16); }
DI float bfhi(unsigned w) { return __uint_as_float(w & 0xffff0000u); }
DI int otid() { int t = threadIdx.x; asm volatile("" : "+v"(t)); return t; }
DI int crow(int i, int h) { return (i & 3) + 8 * (i >> 2) + 4 * h; }
DI float fexp2(float x) { return __builtin_amdgcn_exp2f(x); }
DI float flog2(float x) { return __builtin_amdgcn_logf(x); }

struct WJob { const float* src; bf16_t* dst; const float* gain; int K, N, gu; };

DI int wjob_tiles(int j) {
    if (j < 14) {
        const int kind = j >> 1;
        switch (kind) {
            case 0: case 2: return 16 * 88;
            case 1: case 3: return 44 * 16;
            case 4: return 256;
            case 5: return 512;
            default: return 256;
        }
    }
    if (j == 14) return 16 * 36;
    if (j == 16) return 16 * 48;
    return 256;
}

DI WJob get_wjob(const Params& P, int j) {
    WJob w; w.gain = nullptr; w.gu = 0;
    bf16_t* wsb = (bf16_t*)P.ws;
    if (j < 14) {
        const int kind = j >> 1, l = j & 1;
        switch (kind) {
            case 0: w.src = P.in[3] + (size_t)l * D * NGU; w.dst = (bf16_t*)(P.ws + OFF_GU1 + l * SZ_GU); w.gain = P.in[2] + l * D; w.K = D; w.N = NGU; w.gu = 1; break;
            case 1: w.src = P.in[4] + (size_t)l * DFF * D; w.dst = (bf16_t*)(P.ws + OFF_DN1 + l * SZ_DN); w.K = DFF; w.N = D; break;
            case 2: w.src = P.in[23] + (size_t)l * D * NGU; w.dst = (bf16_t*)(P.ws + OFF_GU2 + l * SZ_GU); w.gain = P.in[22] + l * D; w.K = D; w.N = NGU; w.gu = 1; break;
            case 3: w.src = P.in[24] + (size_t)l * DFF * D; w.dst = (bf16_t*)(P.ws + OFF_DN2 + l * SZ_DN); w.K = DFF; w.N = D; break;
            case 4: w.src = P.in[17] + (size_t)l * D * D; w.dst = (bf16_t*)(P.ws + OFF_WQ + l * SZ_MM); w.gain = P.in[15] + l * D; w.K = D; w.N = D; break;
            case 5: w.src = P.in[18] + (size_t)l * D * 2048; w.dst = (bf16_t*)(P.ws + OFF_WKV + l * 2 * SZ_MM); w.gain = P.in[16] + l * D; w.K = D; w.N = 2048; break;
            default: w.src = P.in[21] + (size_t)l * D * D; w.dst = (bf16_t*)(P.ws + OFF_WO + l * SZ_MM); w.K = D; w.N = D; break;
        }
    } else if (j == 14) { w.src = P.in[6]; w.dst = (bf16_t*)(P.ws + OFF_EVIN); w.gain = P.in[5]; w.K = D; w.N = 2304; }
    else if (j == 15) { w.src = P.in[10]; w.dst = (bf16_t*)(P.ws + OFF_EVOUT); w.K = D; w.N = D; }
    else if (j == 16) { w.src = P.in[11]; w.dst = (bf16_t*)(P.ws + OFF_ODIN); w.gain = P.in[5] + D; w.K = D; w.N = 3072; }
    else { w.src = P.in[14]; w.dst = (bf16_t*)(P.ws + OFF_ODOUT); w.K = D; w.N = D; }
    (void)wsb;
    return w;
}

DI void wconv_tile(const WJob& w, int t, float* sm, int tid, bool act) {
    const int ntn = w.N >> 6; const int tk = t / ntn, tn = t - tk * ntn;
    if (act) {
#pragma unroll
        for (int p = 0; p < 4; ++p) {
            const int kr = p * 16 + (tid >> 4);
            const float4 v = *(const float4*)(w.src + (size_t)(tk * 64 + kr) * w.N + tn * 64 + (tid & 15) * 4);
            const float g = w.gain ? w.gain[tk * 64 + kr] : 1.f;
            float* sp = sm + kr * 65 + (tid & 15) * 4;
            sp[0] = v.x * g; sp[1] = v.y * g; sp[2] = v.z * g; sp[3] = v.w * g;
        }
    }
    __syncthreads();
    if (act) {
        const int n = tid >> 2, kq = tid & 3; const int ng = tn * 64 + n;
        int drow = ng;
        if (w.gu) drow = ng < DFF ? ((ng >> 5) * 64 + (ng & 31)) : (((ng - DFF) >> 5) * 64 + 32 + ((ng - DFF) & 31));
        unsigned o[8];
#pragma unroll
        for (int e = 0; e < 8; ++e) o[e] = pk2(sm[(kq * 16 + 2 * e) * 65 + n], sm[(kq * 16 + 2 * e + 1) * 65 + n]);
        uint4* dp = (uint4*)(w.dst + (size_t)drow * w.K + tk * 64 + kq * 16);
        dp[0] = make_uint4(o[0], o[1], o[2], o[3]); dp[1] = make_uint4(o[4], o[5], o[6], o[7]);
    }
    __syncthreads();
}

DI float wave_sum(float v) {
    v += __shfl_xor(v, 1); v += __shfl_xor(v, 2); v += __shfl_xor(v, 4); v += __shfl_xor(v, 8); v += __shfl_xor(v, 16); v += __shfl_xor(v, 32);
    return v;
}

DI void rowconv(const float* src, bf16_t* dst, float* ssq, int row, int lane) {
    const float* xr = src + (size_t)row * D;
    float ss = 0.f;
#pragma unroll
    for (int p = 0; p < 4; ++p) {
        const float4 v = *(const float4*)(xr + p * 256 + lane * 4);
        ss += v.x * v.x + v.y * v.y + v.z * v.z + v.w * v.w;
        *(uint2*)(dst + (size_t)row * D + p * 256 + lane * 4) = make_uint2(pk2(v.x, v.y), pk2(v.z, v.w));
    }
    ss = wave_sum(ss);
    if (lane == 0) ssq[row] = ss;
}

DI void phase0(const Params& P, char* smem) {
    const int tid = otid(), lane = tid & 63, wid = tid >> 6;
    float* ssq = (float*)(P.ws + OFF_SSQ);
    for (int i = blockIdx.x * NTHR + tid; i < 8 * T; i += gridDim.x * NTHR) ssq[T + i] = 0.f;
    if (blockIdx.x == 0 && tid < 32) ((unsigned*)(P.ws + OFF_KMAX))[tid] = 0u;
    constexpr int NW = 12352 / 2, NX = T / 8, NM = 1024 / 8;
    for (int u = blockIdx.x; u < NW + NX + NM; u += gridDim.x) {
        if (u < NW) {
            const int half = tid >> 8;
            int t = 2 * u + half, j = 0;
            for (; j < 17; ++j) { const int c = wjob_tiles(j); if (t < c) break; t -= c; }
            const WJob w = get_wjob(P, j);
            wconv_tile(w, t, (float*)smem + half * (64 * 65), tid & 255, true);
        } else if (u < NW + NX) {
            rowconv(P.in[0], (bf16_t*)(P.ws + OFF_XB), ssq, (u - NW) * 8 + wid, lane);
        } else {
            rowconv(P.in[1], (bf16_t*)(P.ws + OFF_MEMB), (float*)(P.ws + OFF_SSQM), (u - NW - NX) * 8 + wid, lane);
        }
    }
}

struct GJob {
    const bf16_t* A; const bf16_t* W;
    int lda, ksplit, kextra, K, ntm, ntn, mode;
    const float* rs;
    bf16_t* O; int ldo;
    const float* xin; float* xout; bf16_t* xb; float* ssq_out; float alpha;
    const float* qg; const float* kg; int qn_end, kn_end;
    bf16_t* vt;
};

typedef __attribute__((address_space(3))) unsigned* ldsu_t;
typedef const __attribute__((address_space(1))) unsigned* glbu_t;
DI void glds16(const bf16_t* g, char* l) { __builtin_amdgcn_global_load_lds((glbu_t)(const void*)g, (ldsu_t)(void*)l, 16, 0, 0); }

DI void gemm_tile(const GJob& J, int t, char* smem, bool dry) {
    const int tid = otid(), lane = tid & 63, wid = tid >> 6, wr = wid >> 2, wc = wid & 3;
    const int r = lane & 31, h = lane >> 5;
    int tm, tn;
    { const int gsz = 32 * J.ntn; const int g = t / gsz; const int rem = t - g * gsz; const int rows = min(32, J.ntm - g * 32); tn = rem / rows; tm = g * 32 + (rem - tn * rows); }
    const int lrow = wid * 16 + (lane >> 2);
    const int csw = ((lane & 3) ^ ((lane >> 4) & 3)) * 8;
    const bf16_t* Ag = J.A + (size_t)(tm * 256 + lrow) * J.lda + csw;
    const bf16_t* Wg = J.W + (size_t)(tn * 256 + lrow) * J.K + csw;
    const size_t astr = (size_t)128 * J.lda, wstr = (size_t)128 * J.K;
    char* lb = smem + tid * 16;
    const int nk = J.K >> 5;
#define GLDS(kt, buf) do { const int k0_ = (kt) * 32; const int ka_ = k0_ + (k0_ >= J.ksplit ? J.kextra : 0); char* l_ = lb + (buf) * STAGE_B; \
        glds16(Ag + ka_, l_); glds16(Ag + astr + ka_, l_ + 8192); glds16(Wg + k0_, l_ + OPB); glds16(Wg + wstr + k0_, l_ + OPB + 8192); } while (0)
    f32x16 acc[4][2];
#pragma unroll
    for (int a = 0; a < 4; ++a)
#pragma unroll
        for (int b = 0; b < 2; ++b)
#pragma unroll
            for (int i = 0; i < 16; ++i) acc[a][b][i] = 0.f;
    const int fr = (r >> 2) & 3;
    const int xrow = (wc * 64 + r) * 64, wrow = OPB + (wr * 128 + r) * 64;
    const int co0 = ((0 + h) ^ fr) * 16, co1 = ((2 + h) ^ fr) * 16;

    __syncthreads();
    GLDS(0, 0); GLDS(1, 1); GLDS(2, 2);
    asm volatile("s_waitcnt vmcnt(8)" ::: "memory");
    __builtin_amdgcn_s_barrier();
    bf16x8 w0[4], x0[2], w1[4], x1[2];
#define LOADF(W_, X_, sb_, co_) do { _Pragma("unroll") for (int ti = 0; ti < 2; ++ti) X_[ti] = *(const bf16x8*)((sb_) + xrow + ti * 2048 + (co_)); \
        _Pragma("unroll") for (int fi = 0; fi < 4; ++fi) W_[fi] = *(const bf16x8*)((sb_) + wrow + fi * 2048 + (co_)); } while (0)
#define MFMA8(W_, X_) do { __builtin_amdgcn_s_setprio(1); _Pragma("unroll") for (int fi = 0; fi < 4; ++fi) _Pragma("unroll") for (int ti = 0; ti < 2; ++ti) \
        acc[fi][ti] = MFMA(W_[fi], X_[ti], acc[fi][ti]); __builtin_amdgcn_s_setprio(0); } while (0)
    LOADF(w0, x0, smem, co0);
    __builtin_amdgcn_s_waitcnt(0xC07F);
    int buf = 0;
    for (int kt = 0; kt < nk; ++kt) {
        const char* sb = smem + buf * STAGE_B;
        LOADF(w1, x1, sb, co1);
        __builtin_amdgcn_sched_barrier(0);
        MFMA8(w0, x0);
        __builtin_amdgcn_s_waitcnt(0xC07F);
        __builtin_amdgcn_sched_barrier(0);
        const int nb = (buf + 1 == NST) ? 0 : buf + 1;
        if (kt + 1 < nk) {
            if (kt + 2 < nk) asm volatile("s_waitcnt vmcnt(4)" ::: "memory"); else asm volatile("s_waitcnt vmcnt(0)" ::: "memory");
            __builtin_amdgcn_s_barrier();
            if (kt + 3 < nk) { const int fb_ = (buf + 3 >= NST) ? buf + 3 - NST : buf + 3; GLDS(kt + 3, fb_); }
        }
        LOADF(w0, x0, smem + nb * STAGE_B, co0);
        __builtin_amdgcn_sched_barrier(0);
        MFMA8(w1, x1);
        __builtin_amdgcn_s_waitcnt(0xC07F);
        __builtin_amdgcn_sched_barrier(0);
        buf = nb;
    }
#undef LOADF
#undef MFMA8
#undef GLDS
    __syncthreads();

    if (dry) { if (acc[0][0][0] + acc[1][1][0] + acc[2][0][0] + acc[3][1][0] == 12345.678f) J.O[0] = 1; return; }
    const int tokb = tm * 256 + wc * 64;
    const int fb = tn * 256 + wr * 128;
    float rsc[2];
#pragma unroll
    for (int ti = 0; ti < 2; ++ti) rsc[ti] = J.rs ? __builtin_amdgcn_rsqf(J.rs[tokb + ti * 32 + r] * (1.f / 1024.f) + EPS) : 1.f;

    if (J.mode == 3 && fb >= 1024) {
#pragma unroll
        for (int ti = 0; ti < 2; ++ti) {
            const int tok = tokb + ti * 32 + r;
#pragma unroll
            for (int fi = 0; fi < 4; ++fi)
#pragma unroll
                for (int i = 0; i < 16; ++i) {
                    const int f = fb - 1024 + fi * 32 + crow(i, h);
                    const int bh_ = (tok >> 8) * 4 + (f >> 8), d_ = f & 255, key_ = tok & 255, k16 = key_ & 15;
                    const int ln_ = ((k16 >> 2) & 1) * 32 + (d_ & 31), e_ = ((k16 >> 3) << 2) | (k16 & 3);
                    J.vt[((((((size_t)bh_ * 8 + (d_ >> 5)) * 8 + (key_ >> 5)) * 2 + ((key_ >> 4) & 1)) * 64 + ln_) << 3) + e_] = (bf16_t)(pk2(acc[fi][ti][i] * rsc[ti], 0.f) & 0xffffu);
                }
        }
        return;
    }
    char* wl = smem + wid * 16384;
#pragma unroll
    for (int ti = 0; ti < 2; ++ti) {
#pragma unroll
        for (int fp = 0; fp < 2; ++fp) {
            const float sc = (J.mode == 1) ? J.alpha : rsc[ti];
#pragma unroll
            for (int fi2 = 0; fi2 < 2; ++fi2)
#pragma unroll
                for (int g = 0; g < 4; ++g) {
                    float4 v;
                    v.x = acc[2 * fp + fi2][ti][4 * g + 0] * sc; v.y = acc[2 * fp + fi2][ti][4 * g + 1] * sc;
                    v.z = acc[2 * fp + fi2][ti][4 * g + 2] * sc; v.w = acc[2 * fp + fi2][ti][4 * g + 3] * sc;
                    *(float4*)(wl + r * 272 + (fi2 * 32 + 8 * g + 4 * h) * 4) = v;
                }
            const int tok0 = tokb + ti * 32, f0 = fb + fp * 64;
            if (J.mode == 0) {
                const int c4 = (lane & 7) * 4;
#pragma unroll
                for (int p = 0; p < 4; ++p) {
                    const int row = p * 8 + (lane >> 3);
                    const float4 ga = *(const float4*)(wl + row * 272 + c4 * 4);
                    const float4 up = *(const float4*)(wl + row * 272 + (32 + c4) * 4);
                    float y0 = ga.x * up.x * __builtin_amdgcn_rcpf(1.f + fexp2(-ga.x * LOG2E));
                    float y1 = ga.y * up.y * __builtin_amdgcn_rcpf(1.f + fexp2(-ga.y * LOG2E));
                    float y2 = ga.z * up.z * __builtin_amdgcn_rcpf(1.f + fexp2(-ga.z * LOG2E));
                    float y3 = ga.w * up.w * __builtin_amdgcn_rcpf(1.f + fexp2(-ga.w * LOG2E));
                    *(uint2*)(J.O + (size_t)(tok0 + row) * J.ldo + (f0 >> 1) + c4) = make_uint2(pk2(y0, y1), pk2(y2, y3));
                }
            } else if (J.mode == 1) {
                const int c4 = (lane & 15) * 4;
#pragma unroll
                for (int p = 0; p < 8; ++p) {
                    const int row = p * 4 + (lane >> 4);
                    const size_t tok = tok0 + row;
                    const float4 v = *(const float4*)(wl + row * 272 + c4 * 4);
                    const float4 xo = *(const float4*)(J.xin + tok * D + f0 + c4);
                    float4 xn; xn.x = xo.x + v.x; xn.y = xo.y + v.y; xn.z = xo.z + v.z; xn.w = xo.w + v.w;
                    *(float4*)(J.xout + tok * D + f0 + c4) = xn;
                    *(uint2*)(J.xb + tok * D + f0 + c4) = make_uint2(pk2(xn.x, xn.y), pk2(xn.z, xn.w));
                    float ss = xn.x * xn.x + xn.y * xn.y + xn.z * xn.z + xn.w * xn.w;
                    ss += __shfl_xor(ss, 1); ss += __shfl_xor(ss, 2); ss += __shfl_xor(ss, 4); ss += __shfl_xor(ss, 8);
                    if ((lane & 15) == 0) atomicAdd(J.ssq_out + tok, ss);
                }
            } else {
                const int nm = f0 < J.qn_end ? 1 : (f0 < J.kn_end ? 2 : 0);
                const float* gp = nm == 1 ? J.qg : J.kg;
                const int c4 = (lane & 15) * 4;
                float4 gn = make_float4(1.f, 1.f, 1.f, 1.f);
                if (nm) gn = *(const float4*)(gp + c4);
#pragma unroll
                for (int p = 0; p < 8; ++p) {
                    const int row = p * 4 + (lane >> 4);
                    float4 v = *(const float4*)(wl + row * 272 + c4 * 4);
                    if (nm) {
                        float ss = v.x * v.x + v.y * v.y + v.z * v.z + v.w * v.w;
                        ss += __shfl_xor(ss, 1); ss += __shfl_xor(ss, 2); ss += __shfl_xor(ss, 4); ss += __shfl_xor(ss, 8);
                        const float inv = __builtin_amdgcn_rsqf(ss * (1.f / 64.f) + EPS);
                        v.x *= inv * gn.x; v.y *= inv * gn.y; v.z *= inv * gn.z; v.w *= inv * gn.w;
                    }
                    *(uint2*)(J.O + (size_t)(tok0 + row) * J.ldo + f0 + c4) = make_uint2(pk2(v.x, v.y), pk2(v.z, v.w));
                }
            }
        }
    }
}

DI void gemm_phase(const GJob& JA, int nA, int nB, const Params& P, char* smem, bool dry) {
    for (int u = blockIdx.x; u < nA + nB; u += gridDim.x) {
        GJob J = JA; int t = u;
        if (u >= nA) {
            const int v = u - nA; const int layer = v >> 5; t = v & 31;
            J.A = (const bf16_t*)(P.ws + OFF_MEMB); J.lda = D; J.ksplit = 1 << 30; J.kextra = 0;
            J.W = (const bf16_t*)(P.ws + OFF_WKV + (size_t)layer * 2 * SZ_MM); J.K = D; J.ntm = 4; J.ntn = 8; J.mode = 3;
            J.rs = (const float*)(P.ws + OFF_SSQM); J.O = (bf16_t*)(P.ws + OFF_KN + (size_t)layer * SZ_MM); J.ldo = D;
            J.qn_end = 0; J.kn_end = 0; J.vt = (bf16_t*)(P.ws + OFF_VT + (size_t)layer * SZ_MM);
        }
        gemm_tile(J, t, smem, dry);
    }
}

#define KV_DECL uint4 rk0, rk1, rk2, rk3, rv0, rv1, rv2, rv3
#define KV_LOAD(kb_, dil_) do { const int kk_ = lane >> 3; \
    const bf16_t* p0_ = qkv + (rowb + min(max((kb_) + (dil_) * kk_, 0), S - 1)) * ld + (lane & 7) * 8; \
    const bf16_t* p1_ = qkv + (rowb + min(max((kb_) + (dil_) * (kk_ + 8), 0), S - 1)) * ld + (lane & 7) * 8; \
    const bf16_t* p2_ = qkv + (rowb + min(max((kb_) + (dil_) * (kk_ + 16), 0), S - 1)) * ld + (lane & 7) * 8; \
    const bf16_t* p3_ = qkv + (rowb + min(max((kb_) + (dil_) * (kk_ + 24), 0), S - 1)) * ld + (lane & 7) * 8; \
    rk0 = *(const uint4*)(p0_ + kcol); rk1 = *(const uint4*)(p1_ + kcol); rk2 = *(const uint4*)(p2_ + kcol); rk3 = *(const uint4*)(p3_ + kcol); \
    rv0 = *(const uint4*)(p0_ + vcol); rv1 = *(const uint4*)(p1_ + vcol); rv2 = *(const uint4*)(p2_ + vcol); rv3 = *(const uint4*)(p3_ + vcol); } while (0)
#define KV_STORE() do { char* wp_ = vl + (lane >> 3) * 144 + (lane & 7) * 16; \
    *(uint4*)(wp_) = rk0; *(uint4*)(wp_ + 8 * 144) = rk1; *(uint4*)(wp_ + 16 * 144) = rk2; *(uint4*)(wp_ + 24 * 144) = rk3; \
    *(uint4*)(wp_ + 4608) = rv0; *(uint4*)(wp_ + 4608 + 8 * 144) = rv1; *(uint4*)(wp_ + 4608 + 16 * 144) = rv2; *(uint4*)(wp_ + 4608 + 24 * 144) = rv3; } while (0)

DI bf16x8 v_frag(const char* vbase, int s, int dt) {
    typedef __attribute__((address_space(3))) v4i16_t* lp_t;
    const char* a = vbase + s * (16 * 144) + dt * 64;
    const s16x4 lo = __builtin_bit_cast(s16x4, __builtin_amdgcn_ds_read_tr16_b64_v4i16((lp_t)(a)));
    const s16x4 hi = __builtin_bit_cast(s16x4, __builtin_amdgcn_ds_read_tr16_b64_v4i16((lp_t)(a + 8 * 144)));
    return __builtin_shufflevector(lo, hi, 0, 1, 2, 3, 4, 5, 6, 7);
}

template <int OFF> DI bf16x8 pack8v(const f32x16& p) {
    typedef unsigned u32x4 __attribute__((ext_vector_type(4)));
    u32x4 w; w[0] = pk2(p[OFF + 0], p[OFF + 1]); w[1] = pk2(p[OFF + 2], p[OFF + 3]); w[2] = pk2(p[OFF + 4], p[OFF + 5]); w[3] = pk2(p[OFF + 6], p[OFF + 7]);
    return __builtin_bit_cast(bf16x8, w);
}

DI void win_attn_wave(bf16_t* qkv, int ld, int b, int qcol, int kcol, int vcol, int tq0, int qstride,
                      float slope2, float m_init, float l_init, int mode, char* vl, int lane, bool dry) {
    const int r = lane & 31, h = lane >> 5;
    const size_t rowb = (size_t)b * S;
    const int tq = tq0 + qstride * r;
    const int tqlast = tq0 + qstride * 31;
    bf16x8 qf[4];
    {
        const bf16_t* qp = qkv + (rowb + tq) * ld + qcol + h * 32;
#pragma unroll
        for (int ks = 0; ks < 4; ++ks) qf[ks] = *(const bf16x8*)(qp + ks * 8);
    }
    f32x16 o0, o1;
#pragma unroll
    for (int i = 0; i < 16; ++i) { o0[i] = 0.f; o1[i] = 0.f; }
    float m = m_init, l = (h == 0) ? l_init : 0.f;
    const float sc2 = 0.125f * LOG2E;
    const int i16 = lane & 15;
    const char* vbase = vl + 4608 + (4 * h + (i16 >> 2)) * 144 + (16 * ((lane >> 4) & 1) + 4 * (i16 & 3)) * 2;
    const int npat = mode ? 3 : 1;
    const char* kfp = vl + r * 144 + h * 64;
    KV_DECL;
    for (int pi = 0; pi < npat; ++pi) {
        int dil, W, kfirst, nt;
        if (!mode) { dil = 1; W = 127; kfirst = tq0 - 128; nt = 5; }
        else if (pi == 0) { dil = 1; W = 128; kfirst = tq0 - 128; nt = 20; }
        else if (pi == 1) { dil = 4; W = 512; kfirst = tq0 - 512; nt = 8; }
        else { dil = 16; W = 2048; kfirst = tq0 - 2048; nt = 5; }
        const int step = 32 * dil;
        int t0 = 0;
        { const int need = -kfirst - 31 * dil; if (need > 0) t0 = (need + step - 1) / step; }
        if (t0 >= nt) continue;
        KV_LOAD(kfirst + t0 * step, dil);
        for (int tile = t0; tile < nt; ++tile) {
            const int kb = kfirst + tile * step;
            KV_STORE();
            asm volatile("" ::: "memory");
            if (tile + 1 < nt) KV_LOAD(kb + step, dil);
            f32x16 s;
#pragma unroll
            for (int i = 0; i < 16; ++i) s[i] = 0.f;
#pragma unroll
            for (int ks = 0; ks < 4; ++ks) s = MFMA(*(const bf16x8*)(kfp + ks * 16), qf[ks], s);
            f32x16 sv; float mloc = -INFINITY;
            const int d0 = tq - kb - 4 * h * dil;
            const unsigned wlim = (unsigned)min(W, tq);
#pragma unroll
            for (int i = 0; i < 16; ++i) {
                const int diff = d0 - dil * crow(i, 0);
                const float sb = s[i] * sc2 - slope2 * (float)diff;
                sv[i] = ((unsigned)diff <= wlim) ? sb : -INFINITY;
                mloc = fmaxf(mloc, sv[i]);
            }
            mloc = fmaxf(mloc, __shfl_xor(mloc, 32));
            const float mn = fmaxf(m, mloc);
            float ps = 0.f;
#pragma unroll
            for (int i = 0; i < 16; ++i) { sv[i] = fexp2(sv[i] - mn); ps += sv[i]; }
            if (__builtin_amdgcn_ballot_w64(mn != m) != 0) {
                const float alpha = fexp2(m - mn);
                l *= alpha;
#pragma unroll
                for (int i = 0; i < 16; ++i) { o0[i] *= alpha; o1[i] *= alpha; }
                m = mn;
            }
            l += ps;
            const bf16x8 p0 = pack8v<0>(sv), p1 = pack8v<8>(sv);
            o0 = MFMA(v_frag(vbase, 0, 0), p0, o0);
            o0 = MFMA(v_frag(vbase, 1, 0), p1, o0);
            o1 = MFMA(v_frag(vbase, 0, 1), p0, o1);
            o1 = MFMA(v_frag(vbase, 1, 1), p1, o1);
            asm volatile("" ::: "memory");
        }
    }
    const float lt = l + __shfl_xor(l, 32);
    const float inv = 1.f / lt;
    if (dry) { if (o0[0] + o1[0] + lt == 12345.678f) qkv[0] = 1; return; }
    bf16_t* op = qkv + (rowb + tq) * ld + qcol + 4 * h;
#pragma unroll
    for (int g = 0; g < 4; ++g) {
        *(uint2*)(op + 8 * g) = make_uint2(pk2(o0[4 * g] * inv, o0[4 * g + 1] * inv), pk2(o0[4 * g + 2] * inv, o0[4 * g + 3] * inv));
        *(uint2*)(op + 32 + 8 * g) = make_uint2(pk2(o1[4 * g] * inv, o1[4 * g + 1] * inv), pk2(o1[4 * g + 2] * inv, o1[4 * g + 3] * inv));
    }
}

DI void stick_wave(bf16_t* qkv, int ld, int b, int qcol, int kcol, int vcol, int qt, char* vl, int lane, bool dry) {
    const int r = lane & 31, h = lane >> 5;
    const size_t rowb = (size_t)b * S;
    const int tq = qt * 32 + r;
    bf16x8 qf[4];
    {
        const bf16_t* qp = qkv + (rowb + tq) * ld + qcol + h * 32;
#pragma unroll
        for (int ks = 0; ks < 4; ++ks) qf[ks] = *(const bf16x8*)(qp + ks * 8);
    }
    f32x16 o0, o1;
#pragma unroll
    for (int i = 0; i < 16; ++i) { o0[i] = 0.f; o1[i] = 0.f; }
    float R = 1.f;
    const int i16 = lane & 15;
    const char* vbase = vl + 4608 + (4 * h + (i16 >> 2)) * 144 + (16 * ((lane >> 4) & 1) + 4 * (i16 & 3)) * 2;
    const char* kfp = vl + r * 144 + h * 64;
    KV_DECL;
    KV_LOAD(qt * 32, 1);
    for (int tile = qt; tile >= 0; --tile) {
        KV_STORE();
        asm volatile("" ::: "memory");
        if (tile > 0) KV_LOAD((tile - 1) * 32, 1);
        f32x16 s;
#pragma unroll
        for (int i = 0; i < 16; ++i) s[i] = 0.f;
#pragma unroll
        for (int ks = 0; ks < 4; ++ks) s = MFMA(*(const bf16x8*)(kfp + ks * 16), qf[ks], s);
        const bool diag = (tile == qt);
        f32x16 sg, kp;
#pragma unroll
        for (int i = 0; i < 16; ++i) {
            const float z2 = fminf(s[i] * (0.125f * LOG2E), 80.f);
            const float t = fexp2(z2);
            const float k = __builtin_amdgcn_rcpf(1.f + t);
            kp[i] = k; sg[i] = t * k;
        }
        if (diag) {
#pragma unroll
            for (int i = 0; i < 16; ++i) { const bool strict = crow(i, h) < r; kp[i] = strict ? kp[i] : 1.f; sg[i] = strict ? sg[i] : 0.f; }
        }
        float G[4], PG[4], both[4];
#pragma unroll
        for (int g = 0; g < 4; ++g) { G[g] = (kp[4 * g] * kp[4 * g + 1]) * (kp[4 * g + 2] * kp[4 * g + 3]); PG[g] = __shfl_xor(G[g], 32); both[g] = G[g] * PG[g]; }
        float Sx[4];
        Sx[3] = 1.f; Sx[2] = both[3]; Sx[1] = both[3] * both[2]; Sx[0] = Sx[1] * both[1];
        f32x16 a;
#pragma unroll
        for (int g = 0; g < 4; ++g) {
            float la = R * Sx[g] * (h == 0 ? PG[g] : 1.f);
#pragma unroll
            for (int j = 3; j >= 0; --j) {
                a[4 * g + j] = sg[4 * g + j] * la;
                la *= kp[4 * g + j];
            }
        }
        R *= Sx[0] * both[0];
        const bf16x8 p0 = pack8v<0>(a), p1 = pack8v<8>(a);
        o0 = MFMA(v_frag(vbase, 0, 0), p0, o0);
        o0 = MFMA(v_frag(vbase, 1, 0), p1, o0);
        o1 = MFMA(v_frag(vbase, 0, 1), p0, o1);
        o1 = MFMA(v_frag(vbase, 1, 1), p1, o1);
        asm volatile("" ::: "memory");
        if (__builtin_amdgcn_ballot_w64(R >= 1.17549435e-38f) == 0) break;
    }
    if (dry) { if (o0[0] + o1[0] == 12345.678f) qkv[0] = 1; return; }
    bf16_t* op = qkv + (rowb + tq) * ld + qcol + 4 * h;
#pragma unroll
    for (int g = 0; g < 4; ++g) {
        *(uint2*)(op + 8 * g) = make_uint2(pk2(o0[4 * g], o0[4 * g + 1]), pk2(o0[4 * g + 2], o0[4 * g + 3]));
        *(uint2*)(op + 32 + 8 * g) = make_uint2(pk2(o1[4 * g], o1[4 * g + 1]), pk2(o1[4 * g + 2], o1[4 * g + 3]));
    }
}

DI void attn_even_phase(const Params& P, char* smem, bool dry) {
    const int tid_ = otid(); const int lane = tid_ & 63, wid = tid_ >> 6;
    bf16_t* qkv = (bf16_t*)(P.ws + OFF_BIG);
    char* vl = smem + wid * 9216;
    for (int it = blockIdx.x * 8 + wid; it < 2048 + 4096; it += gridDim.x * 8) {
        if (it < 2048) {
            const int bh = it >> 6, p = it & 63; const int b = bh >> 3, head = bh & 7;
            stick_wave(qkv, 2304, b, 768 + head * 64, 1280 + head * 64, 1792 + head * 64, 127 - p, vl, lane, dry);
            stick_wave(qkv, 2304, b, 768 + head * 64, 1280 + head * 64, 1792 + head * 64, p, vl, lane, dry);
        } else {
            const int v = it - 2048; const int g = v & 3; const int qt = (v >> 2) & 127; const int rest = v >> 9; const int b = rest >> 1, kvh = rest & 1;
            const int head = kvh * 4 + g;
            const float slope = exp2f(-(float)(head + 1));
            const float sink = P.in[9][head];
            win_attn_wave(qkv, 2304, b, head * 64, 512 + kvh * 64, 640 + kvh * 64, qt * 32, 1, slope * LOG2E, sink * LOG2E, 1.f, 0, vl, lane, dry);
        }
    }
}

DI void attn_odd_phase(const Params& P, char* smem, bool dry) {
    const int tid_ = otid(); const int lane = tid_ & 63, wid = tid_ >> 6;
    bf16_t* qkv = (bf16_t*)(P.ws + OFF_BIG);
    char* vl = smem + wid * 9216;
    for (int it = blockIdx.x * 8 + wid; it < 8192; it += gridDim.x * 8) {
        const int res16 = it & 15; const int u0 = ((it >> 4) & 7) * 32; const int head = (it >> 7) & 15; const int b = it >> 11;
        const float slope = exp2f(-0.5f * (float)(head + 1));
        win_attn_wave(qkv, 3072, b, head * 64, 1024 + head * 64, 2048 + head * 64, res16 + 16 * u0, 16, slope * LOG2E, -1e30f, 0.f, 1, vl, lane, dry);
    }
}

DI void xattn_wave(bf16_t* qb, const bf16_t* Kn, const bf16_t* VT, const float* qg, float kmax2, int b, int head, int tok0, char* ql, int lane, bool dry) {
    const int r = lane & 31, h = lane >> 5;
    const size_t token = (size_t)b * S + tok0 + r;
    bf16_t* qp = qb + token * D + head * 256 + h * 128;
    float ss = 0.f;
#pragma unroll
    for (int ks = 0; ks < 16; ++ks) {
        const uint4 v = *(const uint4*)(qp + ks * 8);
        const unsigned w[4] = {v.x, v.y, v.z, v.w};
#pragma unroll
        for (int e = 0; e < 4; ++e) { const float a = bflo(w[e]), c = bfhi(w[e]); ss += a * a + c * c; }
    }
    ss += __shfl_xor(ss, 32);
    const float inv = __builtin_amdgcn_rsqf(ss * (1.f / 256.f) + EPS);
    float qq2 = 0.f;
#pragma unroll
    for (int ks = 0; ks < 16; ++ks) {
        const uint4 v = *(const uint4*)(qp + ks * 8);
        const float4 g0 = *(const float4*)(qg + h * 128 + ks * 8), g1 = *(const float4*)(qg + h * 128 + ks * 8 + 4);
        uint4 o;
        o.x = pk2(bflo(v.x) * inv * g0.x, bfhi(v.x) * inv * g0.y); o.y = pk2(bflo(v.y) * inv * g0.z, bfhi(v.y) * inv * g0.w);
        o.z = pk2(bflo(v.z) * inv * g1.x, bfhi(v.z) * inv * g1.y); o.w = pk2(bflo(v.w) * inv * g1.z, bfhi(v.w) * inv * g1.w);
        qq2 += bflo(o.x) * bflo(o.x) + bfhi(o.x) * bfhi(o.x) + bflo(o.y) * bflo(o.y) + bfhi(o.y) * bfhi(o.y)
             + bflo(o.z) * bflo(o.z) + bfhi(o.z) * bfhi(o.z) + bflo(o.w) * bflo(o.w) + bfhi(o.w) * bfhi(o.w);
        *(uint4*)(ql + (ks * 64 + lane) * 16) = o;
    }
    qq2 += __shfl_xor(qq2, 32);
    asm volatile("" ::: "memory");
    const float sc2 = 0.0625f * LOG2E;
    const bf16_t* kp0 = Kn + ((size_t)(b * 4 + head) * 8 * 16 * 64 + lane) * 8;
    const float m = __builtin_amdgcn_sqrtf(qq2 * kmax2) * 1.001f;
    float l = 0.f;
    bf16x8 pf[8][2];
    bf16x8 kc[16], kn[16];
#pragma unroll
    for (int ks = 0; ks < 16; ++ks) kc[ks] = *(const bf16x8*)(kp0 + ks * 512);
#pragma unroll
    for (int tile = 0; tile < 8; ++tile) {
        if (tile < 7) {
#pragma unroll
            for (int ks = 0; ks < 16; ++ks) kn[ks] = *(const bf16x8*)(kp0 + (size_t)(tile + 1) * 16 * 512 + ks * 512);
        }
        f32x16 s;
#pragma unroll
        for (int i = 0; i < 16; ++i) s[i] = 0.f;
#pragma unroll
        for (int ks = 0; ks < 16; ++ks) {
            const bf16x8 qf = *(const bf16x8*)(ql + (ks * 64 + lane) * 16);
            s = MFMA(kc[ks], qf, s);
        }
#pragma unroll
        for (int i = 0; i < 16; ++i) { s[i] = fexp2((s[i] - m) * sc2); l += s[i]; }
        pf[tile][0] = pack8v<0>(s); pf[tile][1] = pack8v<8>(s);
#pragma unroll
        for (int ks = 0; ks < 16; ++ks) kc[ks] = kn[ks];
    }
    l += __shfl_xor(l, 32);
    const float il = 1.f / l;
    bf16_t* op = qb + token * D + head * 256 + 4 * h;
    const bf16_t* vp0 = VT + (((size_t)(b * 4 + head) * 8 * 8 * 2 * 64) + lane) * 8;
    bf16x8 vc[16], vn[16];
#pragma unroll
    for (int e = 0; e < 16; ++e) vc[e] = *(const bf16x8*)(vp0 + e * 512);
#pragma unroll 1
    for (int dt = 0; dt < 8; ++dt) {
        const int dn = dt < 7 ? dt + 1 : 7;
#pragma unroll
        for (int e = 0; e < 16; ++e) vn[e] = *(const bf16x8*)(vp0 + (size_t)dn * 16 * 512 + e * 512);
        f32x16 o;
#pragma unroll
        for (int i = 0; i < 16; ++i) o[i] = 0.f;
#pragma unroll
        for (int tile = 0; tile < 8; ++tile)
#pragma unroll
            for (int s2 = 0; s2 < 2; ++s2) o = MFMA(vc[tile * 2 + s2], pf[tile][s2], o);
#pragma unroll
        for (int g = 0; g < 4; ++g)
            if (dry) { if (o[4 * g] == 12345.678f) qb[0] = 1; } else *(uint2*)(op + dt * 32 + 8 * g) = make_uint2(pk2(o[4 * g] * il, o[4 * g + 1] * il), pk2(o[4 * g + 2] * il, o[4 * g + 3] * il));
#pragma unroll
        for (int e = 0; e < 16; ++e) vc[e] = vn[e];
    }
}

DI void xattn_phase(const Params& P, int l, char* smem, bool dry) {
    const int tid_ = otid(); const int lane = tid_ & 63, wid = tid_ >> 6;
    bf16_t* qb = (bf16_t*)(P.ws + OFF_BIG);
    const bf16_t* Kn = (const bf16_t*)(P.ws + OFF_KF + (size_t)l * SZ_MM);
    const bf16_t* VT = (const bf16_t*)(P.ws + OFF_VT + (size_t)l * SZ_MM);
    const float* qg = P.in[19] + l * 256;
    char* ql = smem + wid * 16384;
    for (int it = blockIdx.x * 8 + wid; it < 2048; it += gridDim.x * 8) {
        const int qt = it & 127, head = (it >> 7) & 3, b = it >> 9;
        const float kmax2 = ((const float*)(P.ws + OFF_KMAX))[l * 16 + b * 4 + head];
        xattn_wave(qb, Kn, VT, qg, kmax2, b, head, qt * 32, ql, lane, dry);
    }
}

DI void knorm_phase(const Params& P) {
    const int tid_ = otid(); const int lane = tid_ & 63, wid = tid_ >> 6;
    for (int u = blockIdx.x * 8 + wid; u < 8192; u += gridDim.x * 8) {
        const int l = u >> 12, row = (u >> 2) & 1023, head = u & 3;
        const bf16_t* kp = (const bf16_t*)(P.ws + OFF_KN + (size_t)l * SZ_MM) + (size_t)row * D + head * 256 + lane * 4;
        const uint2 v = *(const uint2*)kp;
        const float a0 = bflo(v.x), a1 = bfhi(v.x), a2 = bflo(v.y), a3 = bfhi(v.y);
        float ss = a0 * a0 + a1 * a1 + a2 * a2 + a3 * a3;
        ss = wave_sum(ss);
        const float inv = __builtin_amdgcn_rsqf(ss * (1.f / 256.f) + EPS);
        const float4 g = *(const float4*)(P.in[20] + l * 256 + lane * 4);
        const int b = row >> 8, key = row & 255;
        const int h = lane >> 5, ks = (lane & 31) >> 1, j0 = (lane & 1) * 4;
        bf16_t* dp = (bf16_t*)(P.ws + OFF_KF + (size_t)l * SZ_MM) + ((((((size_t)(b * 4 + head) * 8 + (key >> 5)) * 16 + ks) * 64) + h * 32 + (key & 31)) << 3) + j0;
        const unsigned w0_ = pk2(a0 * inv * g.x, a1 * inv * g.y), w1_ = pk2(a2 * inv * g.z, a3 * inv * g.w);
        *(uint2*)dp = make_uint2(w0_, w1_);
        float kk2 = bflo(w0_) * bflo(w0_) + bfhi(w0_) * bfhi(w0_) + bflo(w1_) * bflo(w1_) + bfhi(w1_) * bfhi(w1_);
        kk2 = wave_sum(kk2);
        if (lane == 0) atomicMax((unsigned*)(P.ws + OFF_KMAX) + l * 16 + b * 4 + head, __float_as_uint(kk2));
    }
}

__global__ void __launch_bounds__(512) fwd_megakernel(Params P) {
    extern __shared__ __attribute__((aligned(16))) char smem[];
    cg::grid_group grid = cg::this_grid();
#pragma unroll 1
    for (int ph = 0; ph < 21; ++ph) {
        float* ssq = (float*)(P.ws + OFF_SSQ);
        bf16_t* xb = (bf16_t*)(P.ws + OFF_XB);
        bf16_t* big = (bf16_t*)(P.ws + OFF_BIG);
        int nrep = 1;
        if (ph > 0) { const int s_ = (ph - 1) % 10; const int kind = (s_ == 3) ? 2 : (s_ == 6) ? 4 : 1; if (PROBE_MASK & kind) nrep = 2; }
        for (int rep = 0; rep < nrep; ++rep) {
        const bool dry = rep + 1 < nrep;
        if (ph == 0) {
            phase0(P, smem);
        } else {
            const int l = (ph - 1) / 10, s = (ph - 1) % 10;
            if (s == 3) {
                if (l == 0) attn_even_phase(P, smem, dry); else attn_odd_phase(P, smem, dry);
            } else if (s == 6) {
                xattn_phase(P, l, smem, dry);
            } else {
                GJob J;
                J.A = xb; J.lda = D; J.ksplit = 1 << 30; J.kextra = 0; J.K = D; J.ntm = 64; J.mode = 1; J.rs = nullptr;
                J.O = big; J.ldo = D; J.xin = P.out; J.xout = P.out; J.xb = xb; J.ssq_out = ssq; J.alpha = 1.f;
                J.qg = nullptr; J.kg = nullptr; J.qn_end = 0; J.kn_end = 0; J.vt = nullptr; J.W = nullptr; J.ntn = 4;
                int nB = 0;
                if (s == 0 || s == 8) {
                    J.W = (const bf16_t*)(P.ws + (s == 0 ? OFF_GU1 : OFF_GU2) + (size_t)l * SZ_GU);
                    J.ntn = NGU / 256; J.mode = 0; J.rs = ssq + (size_t)(4 * l + (s == 0 ? 0 : 3)) * T; J.ldo = DFF;
                    if (ph == 1) nB = 64;
                } else if (s == 1 || s == 9) {
                    J.A = big; J.lda = DFF; J.K = DFF;
                    J.W = (const bf16_t*)(P.ws + (s == 1 ? OFF_DN1 : OFF_DN2) + (size_t)l * SZ_DN);
                    J.alpha = 0.5f; J.ssq_out = ssq + (size_t)(4 * l + (s == 1 ? 1 : 4)) * T;
                    if (ph == 2) J.xin = P.in[0];
                } else if (s == 2) {
                    J.mode = 2; J.rs = ssq + (size_t)(4 * l + 1) * T;
                    if (l == 0) { J.W = (const bf16_t*)(P.ws + OFF_EVIN); J.ntn = 9; J.ldo = 2304; J.qg = P.in[7]; J.kg = P.in[8]; J.qn_end = 512; J.kn_end = 640; }
                    else { J.W = (const bf16_t*)(P.ws + OFF_ODIN); J.ntn = 12; J.ldo = 3072; J.qg = P.in[12]; J.kg = P.in[13]; J.qn_end = 1024; J.kn_end = 2048; }
                } else if (s == 4) {
                    J.A = big;
                    if (l == 0) { J.W = (const bf16_t*)(P.ws + OFF_EVOUT); J.lda = 2304; J.ksplit = 512; J.kextra = 256; }
                    else { J.W = (const bf16_t*)(P.ws + OFF_ODOUT); J.lda = 3072; }
                    J.ssq_out = ssq + (size_t)(4 * l + 2) * T;
                } else if (s == 5) {
                    J.W = (const bf16_t*)(P.ws + OFF_WQ + (size_t)l * SZ_MM); J.mode = 2; J.rs = ssq + (size_t)(4 * l + 2) * T; J.ldo = D;
                } else {
                    J.A = big; J.W = (const bf16_t*)(P.ws + OFF_WO + (size_t)l * SZ_MM); J.ssq_out = ssq + (size_t)(4 * l + 3) * T;
                }
                gemm_phase(J, J.ntm * J.ntn, nB, P, smem, dry);
                if (ph == 2 && !dry) knorm_phase(P);
            }
        }
        grid.sync();
        }
    }
}

extern "C" void kernel_launch(void* const* d_in, const int* in_sizes, int n_in, void* d_out, int out_size, void* d_ws, size_t ws_size,
                              hipStream_t stream) {
    static int grid_blocks = 0;
    if (!grid_blocks) {
        int dev = 0, cus = 0, per_cu = 0;
        hipGetDevice(&dev);
        hipDeviceGetAttribute(&cus, hipDeviceAttributeMultiprocessorCount, dev);
        hipFuncSetAttribute((const void*)fwd_megakernel, hipFuncAttributeMaxDynamicSharedMemorySize, LDS_BYTES);
        hipOccupancyMaxActiveBlocksPerMultiprocessor(&per_cu, fwd_megakernel, NTHR, LDS_BYTES);
        if (per_cu < 1) per_cu = 1;
        if (per_cu > 1) per_cu = 1;
        grid_blocks = cus * per_cu;
    }
    if (ws_size < WS_NEED) { fprintf(stderr, "workspace too small: %zu < %zu\n", ws_size, (size_t)WS_NEED); return; }
    Params p{};
    for (int i = 0; i < 25; ++i) p.in[i] = (const float*)d_in[i];
    p.out = (float*)d_out; p.ws = (char*)d_ws;
    void* args[] = {&p};
    hipError_t e = hipLaunchCooperativeKernel((void*)fwd_megakernel, dim3(grid_blocks), dim3(NTHR), args, LDS_BYTES, stream);
    if (e != hipSuccess) fprintf(stderr, "cooperative launch failed: %s (grid %d)\n", hipGetErrorString(e), grid_blocks);
}
```

```cpp
#include <hip/hip_runtime.h>
#include <hip/hip_cooperative_groups.h>
#include <cstdio>
#include <cstdint>
namespace cg = cooperative_groups;

#define DI __device__ __forceinline__
typedef unsigned short bf16_t;
typedef short bf16x8 __attribute__((ext_vector_type(8)));
typedef short s16x4 __attribute__((ext_vector_type(4)));
typedef float f32x16 __attribute__((ext_vector_type(16)));
typedef __bf16 bf2_t __attribute__((ext_vector_type(2)));
typedef float f2_t __attribute__((ext_vector_type(2)));
typedef short v4i16_t __attribute__((ext_vector_type(4)));
#define MFMA(a, b, c) __builtin_amdgcn_mfma_f32_32x32x16_bf16((a), (b), (c), 0, 0, 0)

constexpr int T = 16384, S = 4096, D = 1024, DFF = 2816, NGU = 5632;
constexpr float EPS = 1e-6f;
constexpr float LOG2E = 1.4426950408889634f;
constexpr float LN2 = 0.6931471805599453f;

constexpr size_t SZ_GU = (size_t)NGU * D * 2, SZ_DN = (size_t)D * DFF * 2, SZ_MM = (size_t)D * D * 2;
constexpr size_t OFF_GU1 = 0;
constexpr size_t OFF_DN1 = OFF_GU1 + 2 * SZ_GU;
constexpr size_t OFF_GU2 = OFF_DN1 + 2 * SZ_DN;
constexpr size_t OFF_DN2 = OFF_GU2 + 2 * SZ_GU;
constexpr size_t OFF_WQ = OFF_DN2 + 2 * SZ_DN;
constexpr size_t OFF_WKV = OFF_WQ + 2 * SZ_MM;
constexpr size_t OFF_WO = OFF_WKV + 4 * SZ_MM;
constexpr size_t OFF_EVIN = OFF_WO + 2 * SZ_MM;
constexpr size_t OFF_EVOUT = OFF_EVIN + (size_t)2304 * D * 2;
constexpr size_t OFF_ODIN = OFF_EVOUT + SZ_MM;
constexpr size_t OFF_ODOUT = OFF_ODIN + (size_t)3072 * D * 2;
constexpr size_t OFF_XB = OFF_ODOUT + SZ_MM;
constexpr size_t OFF_BIG = OFF_XB + (size_t)T * D * 2;
constexpr size_t OFF_MEMB = OFF_BIG + (size_t)T * 3072 * 2;
constexpr size_t OFF_KN = OFF_MEMB + SZ_MM;
constexpr size_t OFF_VT = OFF_KN + 2 * SZ_MM;
constexpr size_t OFF_SSQ = OFF_VT + 2 * SZ_MM;
constexpr size_t OFF_SSQM = OFF_SSQ + (size_t)9 * T * 4;
constexpr size_t OFF_KMAX = OFF_SSQM + 4096;
constexpr size_t OFF_BAR = OFF_KMAX + 256;
constexpr size_t OFF_KF = OFF_BAR + 256;
constexpr size_t WS_NEED = OFF_KF + 2 * SZ_MM;

#ifndef PROBE_MASK
#define PROBE_MASK 0
#endif
constexpr int NTHR = 512;
constexpr int NST = 4;
constexpr int STAGE_B = 32768;
constexpr int OPB = 16384;
constexpr int LDS_BYTES = 131072;

struct Params { const float* in[25]; float* out; char* ws; };

DI unsigned pk2(float a, float b) { f2_t v = {a, b}; bf2_t r = __builtin_convertvector(v, bf2_t); return __builtin_bit_cast(unsigned, r); }
DI float bflo(unsigned w) { return __uint_as_float(w << 16); }
DI float bfhi(unsigned w) { return __uint_as_float(w & 0xffff0000u); }
DI int otid() { int t = threadIdx.x; asm volatile("" : "+v"(t)); return t; }
DI int crow(int i, int h) { return (i & 3) + 8 * (i >> 2) + 4 * h; }
DI float fexp2(float x) { return __builtin_amdgcn_exp2f(x); }
DI float flog2(float x) { return __builtin_amdgcn_logf(x); }

struct WJob { const float* src; bf16_t* dst; const float* gain; int K, N, gu; };

DI int wjob_tiles(int j) {
    if (j < 14) {
        const int kind = j >> 1;
        switch (kind) {
            case 0: case 2: return 16 * 88;
            case 1: case 3: return 44 * 16;
            case 4: return 256;
            case 5: return 512;
            default: return 256;
        }
    }
    if (j == 14) return 16 * 36;
    if (j == 16) return 16 * 48;
    return 256;
}

DI WJob get_wjob(const Params& P, int j) {
    WJob w; w.gain = nullptr; w.gu = 0;
    bf16_t* wsb = (bf16_t*)P.ws;
    if (j < 14) {
        const int kind = j >> 1, l = j & 1;
        switch (kind) {
            case 0: w.src = P.in[3] + (size_t)l * D * NGU; w.dst = (bf16_t*)(P.ws + OFF_GU1 + l * SZ_GU); w.gain = P.in[2] + l * D; w.K = D; w.N = NGU; w.gu = 1; break;
            case 1: w.src = P.in[4] + (size_t)l * DFF * D; w.dst = (bf16_t*)(P.ws + OFF_DN1 + l * SZ_DN); w.K = DFF; w.N = D; break;
            case 2: w.src = P.in[23] + (size_t)l * D * NGU; w.dst = (bf16_t*)(P.ws + OFF_GU2 + l * SZ_GU); w.gain = P.in[22] + l * D; w.K = D; w.N = NGU; w.gu = 1; break;
            case 3: w.src = P.in[24] + (size_t)l * DFF * D; w.dst = (bf16_t*)(P.ws + OFF_DN2 + l * SZ_DN); w.K = DFF; w.N = D; break;
            case 4: w.src = P.in[17] + (size_t)l * D * D; w.dst = (bf16_t*)(P.ws + OFF_WQ + l * SZ_MM); w.gain = P.in[15] + l * D; w.K = D; w.N = D; break;
            case 5: w.src = P.in[18] + (size_t)l * D * 2048; w.dst = (bf16_t*)(P.ws + OFF_WKV + l * 2 * SZ_MM); w.gain = P.in[16] + l * D; w.K = D; w.N = 2048; break;
            default: w.src = P.in[21] + (size_t)l * D * D; w.dst = (bf16_t*)(P.ws + OFF_WO + l * SZ_MM); w.K = D; w.N = D; break;
        }
    } else if (j == 14) { w.src = P.in[6]; w.dst = (bf16_t*)(P.ws + OFF_EVIN); w.gain = P.in[5]; w.K = D; w.N = 2304; }
    else if (j == 15) { w.src = P.in[10]; w.dst = (bf16_t*)(P.ws + OFF_EVOUT); w.K = D; w.N = D; }
    else if (j == 16) { w.src = P.in[11]; w.dst = (bf16_t*)(P.ws + OFF_ODIN); w.gain = P.in[5] + D; w.K = D; w.N = 3072; }
    else { w.src = P.in[14]; w.dst = (bf16_t*)(P.ws + OFF_ODOUT); w.K = D; w.N = D; }
    (void)wsb;
    return w;
}

DI void wconv_tile(const WJob& w, int t, float* sm, int tid, bool act) {
    const int ntn = w.N >> 6; const int tk = t / ntn, tn = t - tk * ntn;
    if (act) {
#pragma unroll
        for (int p = 0; p < 4; ++p) {
            const int kr = p * 16 + (tid >> 4);
            const float4 v = *(const float4*)(w.src + (size_t)(tk * 64 + kr) * w.N + tn * 64 + (tid & 15) * 4);
            const float g = w.gain ? w.gain[tk * 64 + kr] : 1.f;
            float* sp = sm + kr * 65 + (tid & 15) * 4;
            sp[0] = v.x * g; sp[1] = v.y * g; sp[2] = v.z * g; sp[3] = v.w * g;
        }
    }
    __syncthreads();
    if (act) {
        const int n = tid >> 2, kq = tid & 3; const int ng = tn * 64 + n;
        int drow = ng;
        if (w.gu) drow = ng < DFF ? ((ng >> 5) * 64 + (ng & 31)) : (((ng - DFF) >> 5) * 64 + 32 + ((ng - DFF) & 31));
        unsigned o[8];
#pragma unroll
        for (int e = 0; e < 8; ++e) o[e] = pk2(sm[(kq * 16 + 2 * e) * 65 + n], sm[(kq * 16 + 2 * e + 1) * 65 + n]);
        uint4* dp = (uint4*)(w.dst + (size_t)drow * w.K + tk * 64 + kq * 16);
        dp[0] = make_uint4(o[0], o[1], o[2], o[3]); dp[1] = make_uint4(o[4], o[5], o[6], o[7]);
    }
    __syncthreads();
}

DI float wave_sum(float v) {
    v += __shfl_xor(v, 1); v += __shfl_xor(v, 2); v += __shfl_xor(v, 4); v += __shfl_xor(v, 8); v += __shfl_xor(v, 16); v += __shfl_xor(v, 32);
    return v;
}

DI void rowconv(const float* src, bf16_t* dst, float* ssq, int row, int lane) {
    const float* xr = src + (size_t)row * D;
    float ss = 0.f;
#pragma unroll
    for (int p = 0; p < 4; ++p) {
        const float4 v = *(const float4*)(xr + p * 256 + lane * 4);
        ss += v.x * v.x + v.y * v.y + v.z * v.z + v.w * v.w;
        *(uint2*)(dst + (size_t)row * D + p * 256 + lane * 4) = make_uint2(pk2(v.x, v.y), pk2(v.z, v.w));
    }
    ss = wave_sum(ss);
    if (lane == 0) ssq[row] = ss;
}

DI void phase0(const Params& P, char* smem) {
    const int tid = otid(), lane = tid & 63, wid = tid >> 6;
    float* ssq = (float*)(P.ws + OFF_SSQ);
    for (int i = blockIdx.x * NTHR + tid; i < 8 * T; i += gridDim.x * NTHR) ssq[T + i] = 0.f;
    if (blockIdx.x == 0 && tid < 32) ((unsigned*)(P.ws + OFF_KMAX))[tid] = 0u;
    constexpr int NW = 12352 / 2, NX = T / 8, NM = 1024 / 8;
    for (int u = blockIdx.x; u < NW + NX + NM; u += gridDim.x) {
        if (u < NW) {
            const int half = tid >> 8;
            int t = 2 * u + half, j = 0;
            for (; j < 17; ++j) { const int c = wjob_tiles(j); if (t < c) break; t -= c; }
            const WJob w = get_wjob(P, j);
            wconv_tile(w, t, (float*)smem + half * (64 * 65), tid & 255, true);
        } else if (u < NW + NX) {
            rowconv(P.in[0], (bf16_t*)(P.ws + OFF_XB), ssq, (u - NW) * 8 + wid, lane);
        } else {
            rowconv(P.in[1], (bf16_t*)(P.ws + OFF_MEMB), (float*)(P.ws + OFF_SSQM), (u - NW - NX) * 8 + wid, lane);
        }
    }
}

struct GJob {
    const bf16_t* A; const bf16_t* W;
    int lda, ksplit, kextra, K, ntm, ntn, mode;
    const float* rs;
    bf16_t* O; int ldo;
    const float* xin; float* xout; bf16_t* xb; float* ssq_out; float alpha;
    const float* qg; const float* kg; int qn_end, kn_end;
    bf16_t* vt;
};

typedef __attribute__((address_space(3))) unsigned* ldsu_t;
typedef const __attribute__((address_space(1))) unsigned* glbu_t;
DI void glds16(const bf16_t* g, char* l) { __builtin_amdgcn_global_load_lds((glbu_t)(const void*)g, (ldsu_t)(void*)l, 16, 0, 0); }

DI void gemm_tile(const GJob& J, int t, char* smem, bool dry) {
    const int tid = otid(), lane = tid & 63, wid = tid >> 6, wr = wid >> 2, wc = wid & 3;
    const int r = lane & 31, h = lane >> 5;
    int tm, tn;
    { const int gsz = 32 * J.ntn; const int g = t / gsz; const int rem = t - g * gsz; const int rows = min(32, J.ntm - g * 32); tn = rem / rows; tm = g * 32 + (rem - tn * rows); }
    const int lrow = wid * 16 + (lane >> 2);
    const int csw = ((lane & 3) ^ ((lane >> 4) & 3)) * 8;
    const bf16_t* Ag = J.A + (size_t)(tm * 256 + lrow) * J.lda + csw;
    const bf16_t* Wg = J.W + (size_t)(tn * 256 + lrow) * J.K + csw;
    const size_t astr = (size_t)128 * J.lda, wstr = (size_t)128 * J.K;
    char* lb = smem + tid * 16;
    const int nk = J.K >> 5;
#define GLDS(kt, buf) do { const int k0_ = (kt) * 32; const int ka_ = k0_ + (k0_ >= J.ksplit ? J.kextra : 0); char* l_ = lb + (buf) * STAGE_B; \
        glds16(Ag + ka_, l_); glds16(Ag + astr + ka_, l_ + 8192); glds16(Wg + k0_, l_ + OPB); glds16(Wg + wstr + k0_, l_ + OPB + 8192); } while (0)
    f32x16 acc[4][2];
#pragma unroll
    for (int a = 0; a < 4; ++a)
#pragma unroll
        for (int b = 0; b < 2; ++b)
#pragma unroll
            for (int i = 0; i < 16; ++i) acc[a][b][i] = 0.f;
    const int fr = (r >> 2) & 3;
    const int xrow = (wc * 64 + r) * 64, wrow = OPB + (wr * 128 + r) * 64;
    const int co0 = ((0 + h) ^ fr) * 16, co1 = ((2 + h) ^ fr) * 16;

    __syncthreads();
    GLDS(0, 0); GLDS(1, 1); GLDS(2, 2);
    asm volatile("s_waitcnt vmcnt(8)" ::: "memory");
    __builtin_amdgcn_s_barrier();
    bf16x8 w0[4], x0[2], w1[4], x1[2];
#define LOADF(W_, X_, sb_, co_) do { _Pragma("unroll") for (int ti = 0; ti < 2; ++ti) X_[ti] = *(const bf16x8*)((sb_) + xrow + ti * 2048 + (co_)); \
        _Pragma("unroll") for (int fi = 0; fi < 4; ++fi) W_[fi] = *(const bf16x8*)((sb_) + wrow + fi * 2048 + (co_)); } while (0)
#define MFMA8(W_, X_) do { __builtin_amdgcn_s_setprio(1); _Pragma("unroll") for (int fi = 0; fi < 4; ++fi) _Pragma("unroll") for (int ti = 0; ti < 2; ++ti) \
        acc[fi][ti] = MFMA(W_[fi], X_[ti], acc[fi][ti]); __builtin_amdgcn_s_setprio(0); } while (0)
    LOADF(w0, x0, smem, co0);
    __builtin_amdgcn_s_waitcnt(0xC07F);
    int buf = 0;
    for (int kt = 0; kt < nk; ++kt) {
        const char* sb = smem + buf * STAGE_B;
        LOADF(w1, x1, sb, co1);
        __builtin_amdgcn_sched_barrier(0);
        MFMA8(w0, x0);
        __builtin_amdgcn_s_waitcnt(0xC07F);
        __builtin_amdgcn_sched_barrier(0);
        const int nb = (buf + 1 == NST) ? 0 : buf + 1;
        if (kt + 1 < nk) {
            if (kt + 2 < nk) asm volatile("s_waitcnt vmcnt(4)" ::: "memory"); else asm volatile("s_waitcnt vmcnt(0)" ::: "memory");
            __builtin_amdgcn_s_barrier();
            if (kt + 3 < nk) { const int fb_ = (buf + 3 >= NST) ? buf + 3 - NST : buf + 3; GLDS(kt + 3, fb_); }
        }
        LOADF(w0, x0, smem + nb * STAGE_B, co0);
        __builtin_amdgcn_sched_barrier(0);
        MFMA8(w1, x1);
        __builtin_amdgcn_s_waitcnt(0xC07F);
        __builtin_amdgcn_sched_barrier(0);
        buf = nb;
    }
#undef LOADF
#undef MFMA8
#undef GLDS
    __syncthreads();

    if (dry) { if (acc[0][0][0] + acc[1][1][0] + acc[2][0][0] + acc[3][1][0] == 12345.678f) J.O[0] = 1; return; }
    const int tokb = tm * 256 + wc * 64;
    const int fb = tn * 256 + wr * 128;
    float rsc[2];
#pragma unroll
    for (int ti = 0; ti < 2; ++ti) rsc[ti] = J.rs ? __builtin_amdgcn_rsqf(J.rs[tokb + ti * 32 + r] * (1.f / 1024.f) + EPS) : 1.f;

    if (J.mode == 3 && fb >= 1024) {
#pragma unroll
        for (int ti = 0; ti < 2; ++ti) {
            const int tok = tokb + ti * 32 + r;
#pragma unroll
            for (int fi = 0; fi < 4; ++fi)
#pragma unroll
                for (int i = 0; i < 16; ++i) {
                    const int f = fb - 1024 + fi * 32 + crow(i, h);
                    const int bh_ = (tok >> 8) * 4 + (f >> 8), d_ = f & 255, key_ = tok & 255, k16 = key_ & 15;
                    const int ln_ = ((k16 >> 2) & 1) * 32 + (d_ & 31), e_ = ((k16 >> 3) << 2) | (k16 & 3);
                    J.vt[((((((size_t)bh_ * 8 + (d_ >> 5)) * 8 + (key_ >> 5)) * 2 + ((key_ >> 4) & 1)) * 64 + ln_) << 3) + e_] = (bf16_t)(pk2(acc[fi][ti][i] * rsc[ti], 0.f) & 0xffffu);
                }
        }
        return;
    }
    char* wl = smem + wid * 16384;
#pragma unroll
    for (int ti = 0; ti < 2; ++ti) {
#pragma unroll
        for (int fp = 0; fp < 2; ++fp) {
            const float sc = (J.mode == 1) ? J.alpha : rsc[ti];
#pragma unroll
            for (int fi2 = 0; fi2 < 2; ++fi2)
#pragma unroll
                for (int g = 0; g < 4; ++g) {
                    float4 v;
                    v.x = acc[2 * fp + fi2][ti][4 * g + 0] * sc; v.y = acc[2 * fp + fi2][ti][4 * g + 1] * sc;
                    v.z = acc[2 * fp + fi2][ti][4 * g + 2] * sc; v.w = acc[2 * fp + fi2][ti][4 * g + 3] * sc;
                    *(float4*)(wl + r * 272 + (fi2 * 32 + 8 * g + 4 * h) * 4) = v;
                }
            const int tok0 = tokb + ti * 32, f0 = fb + fp * 64;
            if (J.mode == 0) {
                const int c4 = (lane & 7) * 4;
#pragma unroll
                for (int p = 0; p < 4; ++p) {
                    const int row = p * 8 + (lane >> 3);
                    const float4 ga = *(const float4*)(wl + row * 272 + c4 * 4);
                    const float4 up = *(const float4*)(wl + row * 272 + (32 + c4) * 4);
                    float y0 = ga.x * up.x * __builtin_amdgcn_rcpf(1.f + fexp2(-ga.x * LOG2E));
                    float y1 = ga.y * up.y * __builtin_amdgcn_rcpf(1.f + fexp2(-ga.y * LOG2E));
                    float y2 = ga.z * up.z * __builtin_amdgcn_rcpf(1.f + fexp2(-ga.z * LOG2E));
                    float y3 = ga.w * up.w * __builtin_amdgcn_rcpf(1.f + fexp2(-ga.w * LOG2E));
                    *(uint2*)(J.O + (size_t)(tok0 + row) * J.ldo + (f0 >> 1) + c4) = make_uint2(pk2(y0, y1), pk2(y2, y3));
                }
            } else if (J.mode == 1) {
                const int c4 = (lane & 15) * 4;
#pragma unroll
                for (int p = 0; p < 8; ++p) {
                    const int row = p * 4 + (lane >> 4);
                    const size_t tok = tok0 + row;
                    const float4 v = *(const float4*)(wl + row * 272 + c4 * 4);
                    const float4 xo = *(const float4*)(J.xin + tok * D + f0 + c4);
                    float4 xn; xn.x = xo.x + v.x; xn.y = xo.y + v.y; xn.z = xo.z + v.z; xn.w = xo.w + v.w;
                    *(float4*)(J.xout + tok * D + f0 + c4) = xn;
                    *(uint2*)(J.xb + tok * D + f0 + c4) = make_uint2(pk2(xn.x, xn.y), pk2(xn.z, xn.w));
                    float ss = xn.x * xn.x + xn.y * xn.y + xn.z * xn.z + xn.w * xn.w;
                    ss += __shfl_xor(ss, 1); ss += __shfl_xor(ss, 2); ss += __shfl_xor(ss, 4); ss += __shfl_xor(ss, 8);
                    if ((lane & 15) == 0) atomicAdd(J.ssq_out + tok, ss);
                }
            } else {
                const int nm = f0 < J.qn_end ? 1 : (f0 < J.kn_end ? 2 : 0);
                const float* gp = nm == 1 ? J.qg : J.kg;
                const int c4 = (lane & 15) * 4;
                float4 gn = make_float4(1.f, 1.f, 1.f, 1.f);
                if (nm) gn = *(const float4*)(gp + c4);
#pragma unroll
                for (int p = 0; p < 8; ++p) {
                    const int row = p * 4 + (lane >> 4);
                    float4 v = *(const float4*)(wl + row * 272 + c4 * 4);
                    if (nm) {
                        float ss = v.x * v.x + v.y * v.y + v.z * v.z + v.w * v.w;
                        ss += __shfl_xor(ss, 1); ss += __shfl_xor(ss, 2); ss += __shfl_xor(ss, 4); ss += __shfl_xor(ss, 8);
                        const float inv = __builtin_amdgcn_rsqf(ss * (1.f / 64.f) + EPS);
                        v.x *= inv * gn.x; v.y *= inv * gn.y; v.z *= inv * gn.z; v.w *= inv * gn.w;
                    }
                    *(uint2*)(J.O + (size_t)(tok0 + row) * J.ldo + f0 + c4) = make_uint2(pk2(v.x, v.y), pk2(v.z, v.w));
                }
            }
        }
    }
}

DI void gemm_phase(const GJob& JA, int nA, int nB, const Params& P, char* smem, bool dry) {
    for (int u = blockIdx.x; u < nA + nB; u += gridDim.x) {
        GJob J = JA; int t = u;
        if (u >= nA) {
            const int v = u - nA; const int layer = v >> 5; t = v & 31;
            J.A = (const bf16_t*)(P.ws + OFF_MEMB); J.lda = D; J.ksplit = 1 << 30; J.kextra = 0;
            J.W = (const bf16_t*)(P.ws + OFF_WKV + (size_t)layer * 2 * SZ_MM); J.K = D; J.ntm = 4; J.ntn = 8; J.mode = 3;
            J.rs = (const float*)(P.ws + OFF_SSQM); J.O = (bf16_t*)(P.ws + OFF_KN + (size_t)layer * SZ_MM); J.ldo = D;
            J.qn_end = 0; J.kn_end = 0; J.vt = (bf16_t*)(P.ws + OFF_VT + (size_t)layer * SZ_MM);
        }
        gemm_tile(J, t, smem, dry);
    }
}

#define KV_DECL uint4 rk0, rk1, rk2, rk3, rv0, rv1, rv2, rv3
#define KV_LOAD(kb_, dil_) do { const int kk_ = lane >> 3; \
    const bf16_t* p0_ = qkv + (rowb + min(max((kb_) + (dil_) * kk_, 0), S - 1)) * ld + (lane & 7) * 8; \
    const bf16_t* p1_ = qkv + (rowb + min(max((kb_) + (dil_) * (kk_ + 8), 0), S - 1)) * ld + (lane & 7) * 8; \
    const bf16_t* p2_ = qkv + (rowb + min(max((kb_) + (dil_) * (kk_ + 16), 0), S - 1)) * ld + (lane & 7) * 8; \
    const bf16_t* p3_ = qkv + (rowb + min(max((kb_) + (dil_) * (kk_ + 24), 0), S - 1)) * ld + (lane & 7) * 8; \
    rk0 = *(const uint4*)(p0_ + kcol); rk1 = *(const uint4*)(p1_ + kcol); rk2 = *(const uint4*)(p2_ + kcol); rk3 = *(const uint4*)(p3_ + kcol); \
    rv0 = *(const uint4*)(p0_ + vcol); rv1 = *(const uint4*)(p1_ + vcol); rv2 = *(const uint4*)(p2_ + vcol); rv3 = *(const uint4*)(p3_ + vcol); } while (0)
#define KV_STORE() do { char* wp_ = vl + (lane >> 3) * 144 + (lane & 7) * 16; \
    *(uint4*)(wp_) = rk0; *(uint4*)(wp_ + 8 * 144) = rk1; *(uint4*)(wp_ + 16 * 144) = rk2; *(uint4*)(wp_ + 24 * 144) = rk3; \
    *(uint4*)(wp_ + 4608) = rv0; *(uint4*)(wp_ + 4608 + 8 * 144) = rv1; *(uint4*)(wp_ + 4608 + 16 * 144) = rv2; *(uint4*)(wp_ + 4608 + 24 * 144) = rv3; } while (0)

DI bf16x8 v_frag(const char* vbase, int s, int dt) {
    typedef __attribute__((address_space(3))) v4i16_t* lp_t;
    const char* a = vbase + s * (16 * 144) + dt * 64;
    const s16x4 lo = __builtin_bit_cast(s16x4, __builtin_amdgcn_ds_read_tr16_b64_v4i16((lp_t)(a)));
    const s16x4 hi = __builtin_bit_cast(s16x4, __builtin_amdgcn_ds_read_tr16_b64_v4i16((lp_t)(a + 8 * 144)));
    return __builtin_shufflevector(lo, hi, 0, 1, 2, 3, 4, 5, 6, 7);
}

template <int OFF> DI bf16x8 pack8v(const f32x16& p) {
    typedef unsigned u32x4 __attribute__((ext_vector_type(4)));
    u32x4 w; w[0] = pk2(p[OFF + 0], p[OFF + 1]); w[1] = pk2(p[OFF + 2], p[OFF + 3]); w[2] = pk2(p[OFF + 4], p[OFF + 5]); w[3] = pk2(p[OFF + 6], p[OFF + 7]);
    return __builtin_bit_cast(bf16x8, w);
}

DI void win_attn_wave(bf16_t* qkv, int ld, int b, int qcol, int kcol, int vcol, int tq0, int qstride,
                      float slope2, float m_init, float l_init, int mode, char* vl, int lane, bool dry) {
    const int r = lane & 31, h = lane >> 5;
    const size_t rowb = (size_t)b * S;
    const int tq = tq0 + qstride * r;
    const int tqlast = tq0 + qstride * 31;
    bf16x8 qf[4];
    {
        const bf16_t* qp = qkv + (rowb + tq) * ld + qcol + h * 32;
#pragma unroll
        for (int ks = 0; ks < 4; ++ks) qf[ks] = *(const bf16x8*)(qp + ks * 8);
    }
    f32x16 o0, o1;
#pragma unroll
    for (int i = 0; i < 16; ++i) { o0[i] = 0.f; o1[i] = 0.f; }
    float m = m_init, l = (h == 0) ? l_init : 0.f;
    const float sc2 = 0.125f * LOG2E;
    const int i16 = lane & 15;
    const char* vbase = vl + 4608 + (4 * h + (i16 >> 2)) * 144 + (16 * ((lane >> 4) & 1) + 4 * (i16 & 3)) * 2;
    const int npat = mode ? 3 : 1;
    const char* kfp = vl + r * 144 + h * 64;
    KV_DECL;
    for (int pi = 0; pi < npat; ++pi) {
        int dil, W, kfirst, nt;
        if (!mode) { dil = 1; W = 127; kfirst = tq0 - 128; nt = 5; }
        else if (pi == 0) { dil = 1; W = 128; kfirst = tq0 - 128; nt = 20; }
        else if (pi == 1) { dil = 4; W = 512; kfirst = tq0 - 512; nt = 8; }
        else { dil = 16; W = 2048; kfirst = tq0 - 2048; nt = 5; }
        const int step = 32 * dil;
        int t0 = 0;
        { const int need = -kfirst - 31 * dil; if (need > 0) t0 = (need + step - 1) / step; }
        if (t0 >= nt) continue;
        KV_LOAD(kfirst + t0 * step, dil);
        for (int tile = t0; tile < nt; ++tile) {
            const int kb = kfirst + tile * step;
            KV_STORE();
            asm volatile("" ::: "memory");
            if (tile + 1 < nt) KV_LOAD(kb + step, dil);
            f32x16 s;
#pragma unroll
            for (int i = 0; i < 16; ++i) s[i] = 0.f;
#pragma unroll
            for (int ks = 0; ks < 4; ++ks) s = MFMA(*(const bf16x8*)(kfp + ks * 16), qf[ks], s);
            f32x16 sv; float mloc = -INFINITY;
            const int d0 = tq - kb - 4 * h * dil;
            const unsigned wlim = (unsigned)min(W, tq);
#pragma unroll
            for (int i = 0; i < 16; ++i) {
                const int diff = d0 - dil * crow(i, 0);
                const float sb = s[i] * sc2 - slope2 * (float)diff;
                sv[i] = ((unsigned)diff <= wlim) ? sb : -INFINITY;
                mloc = fmaxf(mloc, sv[i]);
            }
            mloc = fmaxf(mloc, __shfl_xor(mloc, 32));
            const float mn = fmaxf(m, mloc);
            float ps = 0.f;
#pragma unroll
            for (int i = 0; i < 16; ++i) { sv[i] = fexp2(sv[i] - mn); ps += sv[i]; }
            if (__builtin_amdgcn_ballot_w64(mn != m) != 0) {
                const float alpha = fexp2(m - mn);
                l *= alpha;
#pragma unroll
                for (int i = 0; i < 16; ++i) { o0[i] *= alpha; o1[i] *= alpha; }
                m = mn;
            }
            l += ps;
            const bf16x8 p0 = pack8v<0>(sv), p1 = pack8v<8>(sv);
            o0 = MFMA(v_frag(vbase, 0, 0), p0, o0);
            o0 = MFMA(v_frag(vbase, 1, 0), p1, o0);
            o1 = MFMA(v_frag(vbase, 0, 1), p0, o1);
            o1 = MFMA(v_frag(vbase, 1, 1), p1, o1);
            asm volatile("" ::: "memory");
        }
    }
    const float lt = l + __shfl_xor(l, 32);
    const float inv = 1.f / lt;
    if (dry) { if (o0[0] + o1[0] + lt == 12345.678f) qkv[0] = 1; return; }
    bf16_t* op = qkv + (rowb + tq) * ld + qcol + 4 * h;
#pragma unroll
    for (int g = 0; g < 4; ++g) {
        *(uint2*)(op + 8 * g) = make_uint2(pk2(o0[4 * g] * inv, o0[4 * g + 1] * inv), pk2(o0[4 * g + 2] * inv, o0[4 * g + 3] * inv));
        *(uint2*)(op + 32 + 8 * g) = make_uint2(pk2(o1[4 * g] * inv, o1[4 * g + 1] * inv), pk2(o1[4 * g + 2] * inv, o1[4 * g + 3] * inv));
    }
}

DI void stick_wave(bf16_t* qkv, int ld, int b, int qcol, int kcol, int vcol, int qt, char* vl, int lane, bool dry) {
    const int r = lane & 31, h = lane >> 5;
    const size_t rowb = (size_t)b * S;
    const int tq = qt * 32 + r;
    bf16x8 qf[4];
    {
        const bf16_t* qp = qkv + (rowb + tq) * ld + qcol + h * 32;
#pragma unroll
        for (int ks = 0; ks < 4; ++ks) qf[ks] = *(const bf16x8*)(qp + ks * 8);
    }
    f32x16 o0, o1;
#pragma unroll
    for (int i = 0; i < 16; ++i) { o0[i] = 0.f; o1[i] = 0.f; }
    float R = 1.f;
    const int i16 = lane & 15;
    const char* vbase = vl + 4608 + (4 * h + (i16 >> 2)) * 144 + (16 * ((lane >> 4) & 1) + 4 * (i16 & 3)) * 2;
    const char* kfp = vl + r * 144 + h * 64;
    KV_DECL;
    KV_LOAD(qt * 32, 1);
    for (int tile = qt; tile >= 0; --tile) {
        KV_STORE();
        asm volatile("" ::: "memory");
        if (tile > 0) KV_LOAD((tile - 1) * 32, 1);
        f32x16 s;
#pragma unroll
        for (int i = 0; i < 16; ++i) s[i] = 0.f;
#pragma unroll
        for (int ks = 0; ks < 4; ++ks) s = MFMA(*(const bf16x8*)(kfp + ks * 16), qf[ks], s);
        const bool diag = (tile == qt);
        f32x16 sg, kp;
#pragma unroll
        for (int i = 0; i < 16; ++i) {
            const float z2 = fminf(s[i] * (0.125f * LOG2E), 80.f);
            const float t = fexp2(z2);
            const float k = __builtin_amdgcn_rcpf(1.f + t);
            kp[i] = k; sg[i] = t * k;
        }
        if (diag) {
#pragma unroll
            for (int i = 0; i < 16; ++i) { const bool strict = crow(i, h) < r; kp[i] = strict ? kp[i] : 1.f; sg[i] = strict ? sg[i] : 0.f; }
        }
        float G[4], PG[4], both[4];
#pragma unroll
        for (int g = 0; g < 4; ++g) { G[g] = (kp[4 * g] * kp[4 * g + 1]) * (kp[4 * g + 2] * kp[4 * g + 3]); PG[g] = __shfl_xor(G[g], 32); both[g] = G[g] * PG[g]; }
        float Sx[4];
        Sx[3] = 1.f; Sx[2] = both[3]; Sx[1] = both[3] * both[2]; Sx[0] = Sx[1] * both[1];
        f32x16 a;
#pragma unroll
        for (int g = 0; g < 4; ++g) {
            float la = R * Sx[g] * (h == 0 ? PG[g] : 1.f);
#pragma unroll
            for (int j = 3; j >= 0; --j) {
                a[4 * g + j] = sg[4 * g + j] * la;
                la *= kp[4 * g + j];
            }
        }
        R *= Sx[0] * both[0];
        const bf16x8 p0 = pack8v<0>(a), p1 = pack8v<8>(a);
        o0 = MFMA(v_frag(vbase, 0, 0), p0, o0);
        o0 = MFMA(v_frag(vbase, 1, 0), p1, o0);
        o1 = MFMA(v_frag(vbase, 0, 1), p0, o1);
        o1 = MFMA(v_frag(vbase, 1, 1), p1, o1);
        asm volatile("" ::: "memory");
        if (__builtin_amdgcn_ballot_w64(R >= 1.17549435e-38f) == 0) break;
    }
    if (dry) { if (o0[0] + o1[0] == 12345.678f) qkv[0] = 1; return; }
    bf16_t* op = qkv + (rowb + tq) * ld + qcol + 4 * h;
#pragma unroll
    for (int g = 0; g < 4; ++g) {
        *(uint2*)(op + 8 * g) = make_uint2(pk2(o0[4 * g], o0[4 * g + 1]), pk2(o0[4 * g + 2], o0[4 * g + 3]));
        *(uint2*)(op + 32 + 8 * g) = make_uint2(pk2(o1[4 * g], o1[4 * g + 1]), pk2(o1[4 * g + 2], o1[4 * g + 3]));
    }
}

DI void attn_even_phase(const Params& P, char* smem, bool dry) {
    const int tid_ = otid(); const int lane = tid_ & 63, wid = tid_ >> 6;
    bf16_t* qkv = (bf16_t*)(P.ws + OFF_BIG);
    char* vl = smem + wid * 9216;
    for (int it = blockIdx.x * 8 + wid; it < 2048 + 4096; it += gridDim.x * 8) {
        if (it < 2048) {
            const int bh = it >> 6, p = it & 63; const int b = bh >> 3, head = bh & 7;
            stick_wave(qkv, 2304, b, 768 + head * 64, 1280 + head * 64, 1792 + head * 64, 127 - p, vl, lane, dry);
            stick_wave(qkv, 2304, b, 768 + head * 64, 1280 + head * 64, 1792 + head * 64, p, vl, lane, dry);
        } else {
            const int v = it - 2048; const int g = v & 3; const int qt = (v >> 2) & 127; const int rest = v >> 9; const int b = rest >> 1, kvh = rest & 1;
            const int head = kvh * 4 + g;
            const float slope = exp2f(-(float)(head + 1));
            const float sink = P.in[9][head];
            win_attn_wave(qkv, 2304, b, head * 64, 512 + kvh * 64, 640 + kvh * 64, qt * 32, 1, slope * LOG2E, sink * LOG2E, 1.f, 0, vl, lane, dry);
        }
    }
}

DI void attn_odd_phase(const Params& P, char* smem, bool dry) {
    const int tid_ = otid(); const int lane = tid_ & 63, wid = tid_ >> 6;
    bf16_t* qkv = (bf16_t*)(P.ws + OFF_BIG);
    char* vl = smem + wid * 9216;
    for (int it = blockIdx.x * 8 + wid; it < 8192; it += gridDim.x * 8) {
        const int res16 = it & 15; const int u0 = ((it >> 4) & 7) * 32; const int head = (it >> 7) & 15; const int b = it >> 11;
        const float slope = exp2f(-0.5f * (float)(head + 1));
        win_attn_wave(qkv, 3072, b, head * 64, 1024 + head * 64, 2048 + head * 64, res16 + 16 * u0, 16, slope * LOG2E, -1e30f, 0.f, 1, vl, lane, dry);
    }
}

DI void xattn_wave(bf16_t* qb, const bf16_t* Kn, const bf16_t* VT, const float* qg, float kmax2, int b, int head, int tok0, char* ql, int lane, bool dry) {
    const int r = lane & 31, h = lane >> 5;
    const size_t token = (size_t)b * S + tok0 + r;
    bf16_t* qp = qb + token * D + head * 256 + h * 128;
    float ss = 0.f;
#pragma unroll
    for (int ks = 0; ks < 16; ++ks) {
        const uint4 v = *(const uint4*)(qp + ks * 8);
        const unsigned w[4] = {v.x, v.y, v.z, v.w};
#pragma unroll
        for (int e = 0; e < 4; ++e) { const float a = bflo(w[e]), c = bfhi(w[e]); ss += a * a + c * c; }
    }
    ss += __shfl_xor(ss, 32);
    const float inv = __builtin_amdgcn_rsqf(ss * (1.f / 256.f) + EPS);
    float qq2 = 0.f;
#pragma unroll
    for (int ks = 0; ks < 16; ++ks) {
        const uint4 v = *(const uint4*)(qp + ks * 8);
        const float4 g0 = *(const float4*)(qg + h * 128 + ks * 8), g1 = *(const float4*)(qg + h * 128 + ks * 8 + 4);
        uint4 o;
        o.x = pk2(bflo(v.x) * inv * g0.x, bfhi(v.x) * inv * g0.y); o.y = pk2(bflo(v.y) * inv * g0.z, bfhi(v.y) * inv * g0.w);
        o.z = pk2(bflo(v.z) * inv * g1.x, bfhi(v.z) * inv * g1.y); o.w = pk2(bflo(v.w) * inv * g1.z, bfhi(v.w) * inv * g1.w);
        qq2 += bflo(o.x) * bflo(o.x) + bfhi(o.x) * bfhi(o.x) + bflo(o.y) * bflo(o.y) + bfhi(o.y) * bfhi(o.y)
             + bflo(o.z) * bflo(o.z) + bfhi(o.z) * bfhi(o.z) + bflo(o.w) * bflo(o.w) + bfhi(o.w) * bfhi(o.w);
        *(uint4*)(ql + (ks * 64 + lane) * 16) = o;
    }
    qq2 += __shfl_xor(qq2, 32);
    asm volatile("" ::: "memory");
    const float sc2 = 0.0625f * LOG2E;
    const bf16_t* kp0 = Kn + ((size_t)(b * 4 + head) * 8 * 16 * 64 + lane) * 8;
    const float m = __builtin_amdgcn_sqrtf(qq2 * kmax2) * 1.001f;
    float l = 0.f;
    bf16x8 pf[8][2];
    bf16x8 kc[16], kn[16];
#pragma unroll
    for (int ks = 0; ks < 16; ++ks) kc[ks] = *(const bf16x8*)(kp0 + ks * 512);
#pragma unroll
    for (int tile = 0; tile < 8; ++tile) {
        if (tile < 7) {
#pragma unroll
            for (int ks = 0; ks < 16; ++ks) kn[ks] = *(const bf16x8*)(kp0 + (size_t)(tile + 1) * 16 * 512 + ks * 512);
        }
        f32x16 s;
#pragma unroll
        for (int i = 0; i < 16; ++i) s[i] = 0.f;
#pragma unroll
        for (int ks = 0; ks < 16; ++ks) {
            const bf16x8 qf = *(const bf16x8*)(ql + (ks * 64 + lane) * 16);
            s = MFMA(kc[ks], qf, s);
        }
#pragma unroll
        for (int i = 0; i < 16; ++i) { s[i] = fexp2((s[i] - m) * sc2); l += s[i]; }
        pf[tile][0] = pack8v<0>(s); pf[tile][1] = pack8v<8>(s);
#pragma unroll
        for (int ks = 0; ks < 16; ++ks) kc[ks] = kn[ks];
    }
    l += __shfl_xor(l, 32);
    const float il = 1.f / l;
    bf16_t* op = qb + token * D + head * 256 + 4 * h;
    const bf16_t* vp0 = VT + (((size_t)(b * 4 + head) * 8 * 8 * 2 * 64) + lane) * 8;
    bf16x8 vc[16], vn[16];
#pragma unroll
    for (int e = 0; e < 16; ++e) vc[e] = *(const bf16x8*)(vp0 + e * 512);
#pragma unroll 1
    for (int dt = 0; dt < 8; ++dt) {
        const int dn = dt < 7 ? dt + 1 : 7;
#pragma unroll
        for (int e = 0; e < 16; ++e) vn[e] = *(const bf16x8*)(vp0 + (size_t)dn * 16 * 512 + e * 512);
        f32x16 o;
#pragma unroll
        for (int i = 0; i < 16; ++i) o[i] = 0.f;
#pragma unroll
        for (int tile = 0; tile < 8; ++tile)
#pragma unroll
            for (int s2 = 0; s2 < 2; ++s2) o = MFMA(vc[tile * 2 + s2], pf[tile][s2], o);
#pragma unroll
        for (int g = 0; g < 4; ++g)
            if (dry) { if (o[4 * g] == 12345.678f) qb[0] = 1; } else *(uint2*)(op + dt * 32 + 8 * g) = make_uint2(pk2(o[4 * g] * il, o[4 * g + 1] * il), pk2(o[4 * g + 2] * il, o[4 * g + 3] * il));
#pragma unroll
        for (int e = 0; e < 16; ++e) vc[e] = vn[e];
    }
}

DI void xattn_phase(const Params& P, int l, char* smem, bool dry) {
    const int tid_ = otid(); const int lane = tid_ & 63, wid = tid_ >> 6;
    bf16_t* qb = (bf16_t*)(P.ws + OFF_BIG);
    const bf16_t* Kn = (const bf16_t*)(P.ws + OFF_KF + (size_t)l * SZ_MM);
    const bf16_t* VT = (const bf16_t*)(P.ws + OFF_VT + (size_t)l * SZ_MM);
    const float* qg = P.in[19] + l * 256;
    char* ql = smem + wid * 16384;
    for (int it = blockIdx.x * 8 + wid; it < 2048; it += gridDim.x * 8) {
        const int qt = it & 127, head = (it >> 7) & 3, b = it >> 9;
        const float kmax2 = ((const float*)(P.ws + OFF_KMAX))[l * 16 + b * 4 + head];
        xattn_wave(qb, Kn, VT, qg, kmax2, b, head, qt * 32, ql, lane, dry);
    }
}

DI void knorm_phase(const Params& P) {
    const int tid_ = otid(); const int lane = tid_ & 63, wid = tid_ >> 6;
    for (int u = blockIdx.x * 8 + wid; u < 8192; u += gridDim.x * 8) {
        const int l = u >> 12, row = (u >> 2) & 1023, head = u & 3;
        const bf16_t* kp = (const bf16_t*)(P.ws + OFF_KN + (size_t)l * SZ_MM) + (size_t)row * D + head * 256 + lane * 4;
        const uint2 v = *(const uint2*)kp;
        const float a0 = bflo(v.x), a1 = bfhi(v.x), a2 = bflo(v.y), a3 = bfhi(v.y);
        float ss = a0 * a0 + a1 * a1 + a2 * a2 + a3 * a3;
        ss = wave_sum(ss);
        const float inv = __builtin_amdgcn_rsqf(ss * (1.f / 256.f) + EPS);
        const float4 g = *(const float4*)(P.in[20] + l * 256 + lane * 4);
        const int b = row >> 8, key = row & 255;
        const int h = lane >> 5, ks = (lane & 31) >> 1, j0 = (lane & 1) * 4;
        bf16_t* dp = (bf16_t*)(P.ws + OFF_KF + (size_t)l * SZ_MM) + ((((((size_t)(b * 4 + head) * 8 + (key >> 5)) * 16 + ks) * 64) + h * 32 + (key & 31)) << 3) + j0;
        const unsigned w0_ = pk2(a0 * inv * g.x, a1 * inv * g.y), w1_ = pk2(a2 * inv * g.z, a3 * inv * g.w);
        *(uint2*)dp = make_uint2(w0_, w1_);
        float kk2 = bflo(w0_) * bflo(w0_) + bfhi(w0_) * bfhi(w0_) + bflo(w1_) * bflo(w1_) + bfhi(w1_) * bfhi(w1_);
        kk2 = wave_sum(kk2);
        if (lane == 0) atomicMax((unsigned*)(P.ws + OFF_KMAX) + l * 16 + b * 4 + head, __float_as_uint(kk2));
    }
}

DI void fast_grid_sync(unsigned* bar, unsigned target) {
    asm volatile("s_waitcnt vmcnt(0) lgkmcnt(0)" ::: "memory");
    __syncthreads();
    if (threadIdx.x == 0) {
        __builtin_amdgcn_fence(__ATOMIC_RELEASE, "agent");
        asm volatile("s_waitcnt vmcnt(0)" ::: "memory");
        __hip_atomic_fetch_add(bar, 1u, __ATOMIC_RELAXED, __HIP_MEMORY_SCOPE_AGENT);
        while (__hip_atomic_load(bar, __ATOMIC_RELAXED, __HIP_MEMORY_SCOPE_AGENT) < target) __builtin_amdgcn_s_sleep(2);
        __builtin_amdgcn_fence(__ATOMIC_ACQUIRE, "agent");
        asm volatile("s_waitcnt vmcnt(0)" ::: "memory");
    }
    __syncthreads();
}

__global__ void __launch_bounds__(512) fwd_megakernel(Params P) {
    extern __shared__ __attribute__((aligned(16))) char smem[];
    cg::grid_group grid = cg::this_grid();
    unsigned nbar = 0;
#pragma unroll 1
    for (int ph = 0; ph < 21; ++ph) {
        float* ssq = (float*)(P.ws + OFF_SSQ);
        bf16_t* xb = (bf16_t*)(P.ws + OFF_XB);
        bf16_t* big = (bf16_t*)(P.ws + OFF_BIG);
        int nrep = 1;
        if (ph > 0) { const int s_ = (ph - 1) % 10; const int kind = (s_ == 3) ? 2 : (s_ == 6) ? 4 : 1; if (PROBE_MASK & kind) nrep = 2; }
        for (int rep = 0; rep < nrep; ++rep) {
        const bool dry = rep + 1 < nrep;
        if (ph == 0) {
            phase0(P, smem);
        } else {
            const int l = (ph - 1) / 10, s = (ph - 1) % 10;
            if (s == 3) {
                if (l == 0) attn_even_phase(P, smem, dry); else attn_odd_phase(P, smem, dry);
            } else if (s == 6) {
                xattn_phase(P, l, smem, dry);
            } else {
                GJob J;
                J.A = xb; J.lda = D; J.ksplit = 1 << 30; J.kextra = 0; J.K = D; J.ntm = 64; J.mode = 1; J.rs = nullptr;
                J.O = big; J.ldo = D; J.xin = P.out; J.xout = P.out; J.xb = xb; J.ssq_out = ssq; J.alpha = 1.f;
                J.qg = nullptr; J.kg = nullptr; J.qn_end = 0; J.kn_end = 0; J.vt = nullptr; J.W = nullptr; J.ntn = 4;
                int nB = 0;
                if (s == 0 || s == 8) {
                    J.W = (const bf16_t*)(P.ws + (s == 0 ? OFF_GU1 : OFF_GU2) + (size_t)l * SZ_GU);
                    J.ntn = NGU / 256; J.mode = 0; J.rs = ssq + (size_t)(4 * l + (s == 0 ? 0 : 3)) * T; J.ldo = DFF;
                    if (ph == 1) nB = 64;
                } else if (s == 1 || s == 9) {
                    J.A = big; J.lda = DFF; J.K = DFF;
                    J.W = (const bf16_t*)(P.ws + (s == 1 ? OFF_DN1 : OFF_DN2) + (size_t)l * SZ_DN);
                    J.alpha = 0.5f; J.ssq_out = ssq + (size_t)(4 * l + (s == 1 ? 1 : 4)) * T;
                    if (ph == 2) J.xin = P.in[0];
                } else if (s == 2) {
                    J.mode = 2; J.rs = ssq + (size_t)(4 * l + 1) * T;
                    if (l == 0) { J.W = (const bf16_t*)(P.ws + OFF_EVIN); J.ntn = 9; J.ldo = 2304; J.qg = P.in[7]; J.kg = P.in[8]; J.qn_end = 512; J.kn_end = 640; }
                    else { J.W = (const bf16_t*)(P.ws + OFF_ODIN); J.ntn = 12; J.ldo = 3072; J.qg = P.in[12]; J.kg = P.in[13]; J.qn_end = 1024; J.kn_end = 2048; }
                } else if (s == 4) {
                    J.A = big;
                    if (l == 0) { J.W = (const bf16_t*)(P.ws + OFF_EVOUT); J.lda = 2304; J.ksplit = 512; J.kextra = 256; }
                    else { J.W = (const bf16_t*)(P.ws + OFF_ODOUT); J.lda = 3072; }
                    J.ssq_out = ssq + (size_t)(4 * l + 2) * T;
                } else if (s == 5) {
                    J.W = (const bf16_t*)(P.ws + OFF_WQ + (size_t)l * SZ_MM); J.mode = 2; J.rs = ssq + (size_t)(4 * l + 2) * T; J.ldo = D;
                } else {
                    J.A = big; J.W = (const bf16_t*)(P.ws + OFF_WO + (size_t)l * SZ_MM); J.ssq_out = ssq + (size_t)(4 * l + 3) * T;
                }
                gemm_phase(J, J.ntm * J.ntn, nB, P, smem, dry);
                if (ph == 2 && !dry) knorm_phase(P);
            }
        }
        if (ph == 0) grid.sync();
        else if (ph < 20) { ++nbar; fast_grid_sync((unsigned*)(P.ws + OFF_BAR), nbar * gridDim.x); }
        }
    }
}

extern "C" void kernel_launch(void* const* d_in, const int* in_sizes, int n_in, void* d_out, int out_size, void* d_ws, size_t ws_size,
                              hipStream_t stream) {
    static int grid_blocks = 0;
    if (!grid_blocks) {
        int dev = 0, cus = 0, per_cu = 0;
        hipGetDevice(&dev);
        hipDeviceGetAttribute(&cus, hipDeviceAttributeMultiprocessorCount, dev);
        hipFuncSetAttribute((const void*)fwd_megakernel, hipFuncAttributeMaxDynamicSharedMemorySize, LDS_BYTES);
        hipOccupancyMaxActiveBlocksPerMultiprocessor(&per_cu, fwd_megakernel, NTHR, LDS_BYTES);
        if (per_cu < 1) per_cu = 1;
        if (per_cu > 1) per_cu = 1;
        grid_blocks = cus * per_cu;
    }
    if (ws_size < WS_NEED) { fprintf(stderr, "workspace too small: %zu < %zu\n", ws_size, (size_t)WS_NEED); return; }
    Params p{};
    for (int i = 0; i < 25; ++i) p.in[i] = (const float*)d_in[i];
    p.out = (float*)d_out; p.ws = (char*)d_ws;
    hipMemsetAsync((char*)d_ws + OFF_BAR, 0, 256, stream);
    void* args[] = {&p};
    hipError_t e = hipLaunchCooperativeKernel((void*)fwd_megakernel, dim3(grid_blocks), dim3(NTHR), args, LDS_BYTES, stream);
    if (e != hipSuccess) fprintf(stderr, "cooperative launch failed: %s (grid %d)\n", hipGetErrorString(e), grid_blocks);
}
```

```cpp
#include <hip/hip_runtime.h>
#include <hip/hip_cooperative_groups.h>
#include <cstdio>
#include <cstdint>
namespace cg = cooperative_groups;

#define DI __device__ __forceinline__
typedef unsigned short bf16_t;
typedef short bf16x8 __attribute__((ext_vector_type(8)));
typedef short s16x4 __attribute__((ext_vector_type(4)));
typedef float f32x16 __attribute__((ext_vector_type(16)));
typedef __bf16 bf2_t __attribute__((ext_vector_type(2)));
typedef float f2_t __attribute__((ext_vector_type(2)));
typedef short v4i16_t __attribute__((ext_vector_type(4)));
#define MFMA(a, b, c) __builtin_amdgcn_mfma_f32_32x32x16_bf16((a), (b), (c), 0, 0, 0)

constexpr int T = 16384, S = 4096, D = 1024, DFF = 2816, NGU = 5632;
constexpr float EPS = 1e-6f;
constexpr float LOG2E = 1.4426950408889634f;
constexpr float LN2 = 0.6931471805599453f;

constexpr size_t SZ_GU = (size_t)NGU * D * 2, SZ_DN = (size_t)D * DFF * 2, SZ_MM = (size_t)D * D * 2;
constexpr size_t OFF_GU1 = 0;
constexpr size_t OFF_DN1 = OFF_GU1 + 2 * SZ_GU;
constexpr size_t OFF_GU2 = OFF_DN1 + 2 * SZ_DN;
constexpr size_t OFF_DN2 = OFF_GU2 + 2 * SZ_GU;
constexpr size_t OFF_WQ = OFF_DN2 + 2 * SZ_DN;
constexpr size_t OFF_WKV = OFF_WQ + 2 * SZ_MM;
constexpr size_t OFF_WO = OFF_WKV + 4 * SZ_MM;
constexpr size_t OFF_EVIN = OFF_WO + 2 * SZ_MM;
constexpr size_t OFF_EVOUT = OFF_EVIN + (size_t)2304 * D * 2;
constexpr size_t OFF_ODIN = OFF_EVOUT + SZ_MM;
constexpr size_t OFF_ODOUT = OFF_ODIN + (size_t)3072 * D * 2;
constexpr size_t OFF_XB = OFF_ODOUT + SZ_MM;
constexpr size_t OFF_BIG = OFF_XB + (size_t)T * D * 2;
constexpr size_t OFF_MEMB = OFF_BIG + (size_t)T * 3072 * 2;
constexpr size_t OFF_KN = OFF_MEMB + SZ_MM;
constexpr size_t OFF_VT = OFF_KN + 2 * SZ_MM;
constexpr size_t OFF_SSQ = OFF_VT + 2 * SZ_MM;
constexpr size_t OFF_SSQM = OFF_SSQ + (size_t)9 * T * 4;
constexpr size_t OFF_KMAX = OFF_SSQM + 4096;
constexpr size_t OFF_BAR = OFF_KMAX + 256;
constexpr size_t OFF_KF = OFF_BAR + 256;
constexpr size_t WS_NEED = OFF_KF + 2 * SZ_MM;

#ifndef PROBE_MASK
#define PROBE_MASK 0
#endif
constexpr int NTHR = 512;
constexpr int NST = 4;
constexpr int STAGE_B = 32768;
constexpr int OPB = 16384;
constexpr int LDS_BYTES = 131072;

struct Params { const float* in[25]; float* out; char* ws; };

DI unsigned pk2(float a, float b) { f2_t v = {a, b}; bf2_t r = __builtin_convertvector(v, bf2_t); return __builtin_bit_cast(unsigned, r); }
DI float bflo(unsigned w) { return __uint_as_float(w << 16); }
DI float bfhi(unsigned w) { return __uint_as_float(w & 0xffff0000u); }
DI int otid() { int t = threadIdx.x; asm volatile("" : "+v"(t)); return t; }
DI int crow(int i, int h) { return (i & 3) + 8 * (i >> 2) + 4 * h; }
DI float fexp2(float x) { return __builtin_amdgcn_exp2f(x); }
DI float flog2(float x) { return __builtin_amdgcn_logf(x); }

struct WJob { const float* src; bf16_t* dst; const float* gain; int K, N, gu; };

DI int wjob_tiles(int j) {
    if (j < 14) {
        const int kind = j >> 1;
        switch (kind) {
            case 0: case 2: return 16 * 88;
            case 1: case 3: return 44 * 16;
            case 4: return 256;
            case 5: return 512;
            default: return 256;
        }
    }
    if (j == 14) return 16 * 36;
    if (j == 16) return 16 * 48;
    return 256;
}

DI WJob get_wjob(const Params& P, int j) {
    WJob w; w.gain = nullptr; w.gu = 0;
    bf16_t* wsb = (bf16_t*)P.ws;
    if (j < 14) {
        const int kind = j >> 1, l = j & 1;
        switch (kind) {
            case 0: w.src = P.in[3] + (size_t)l * D * NGU; w.dst = (bf16_t*)(P.ws + OFF_GU1 + l * SZ_GU); w.gain = P.in[2] + l * D; w.K = D; w.N = NGU; w.gu = 1; break;
            case 1: w.src = P.in[4] + (size_t)l * DFF * D; w.dst = (bf16_t*)(P.ws + OFF_DN1 + l * SZ_DN); w.K = DFF; w.N = D; break;
            case 2: w.src = P.in[23] + (size_t)l * D * NGU; w.dst = (bf16_t*)(P.ws + OFF_GU2 + l * SZ_GU); w.gain = P.in[22] + l * D; w.K = D; w.N = NGU; w.gu = 1; break;
            case 3: w.src = P.in[24] + (size_t)l * DFF * D; w.dst = (bf16_t*)(P.ws + OFF_DN2 + l * SZ_DN); w.K = DFF; w.N = D; break;
            case 4: w.src = P.in[17] + (size_t)l * D * D; w.dst = (bf16_t*)(P.ws + OFF_WQ + l * SZ_MM); w.gain = P.in[15] + l * D; w.K = D; w.N = D; break;
            case 5: w.src = P.in[18] + (size_t)l * D * 2048; w.dst = (bf16_t*)(P.ws + OFF_WKV + l * 2 * SZ_MM); w.gain = P.in[16] + l * D; w.K = D; w.N = 2048; break;
            default: w.src = P.in[21] + (size_t)l * D * D; w.dst = (bf16_t*)(P.ws + OFF_WO + l * SZ_MM); w.K = D; w.N = D; break;
        }
    } else if (j == 14) { w.src = P.in[6]; w.dst = (bf16_t*)(P.ws + OFF_EVIN); w.gain = P.in[5]; w.K = D; w.N = 2304; }
    else if (j == 15) { w.src = P.in[10]; w.dst = (bf16_t*)(P.ws + OFF_EVOUT); w.K = D; w.N = D; }
    else if (j == 16) { w.src = P.in[11]; w.dst = (bf16_t*)(P.ws + OFF_ODIN); w.gain = P.in[5] + D; w.K = D; w.N = 3072; }
    else { w.src = P.in[14]; w.dst = (bf16_t*)(P.ws + OFF_ODOUT); w.K = D; w.N = D; }
    (void)wsb;
    return w;
}

DI void wconv_tile(const WJob& w, int t, float* sm, int tid, bool act) {
    const int ntn = w.N >> 6; const int tk = t / ntn, tn = t - tk * ntn;
    if (act) {
#pragma unroll
        for (int p = 0; p < 4; ++p) {
            const int kr = p * 16 + (tid >> 4);
            const float4 v = *(const float4*)(w.src + (size_t)(tk * 64 + kr) * w.N + tn * 64 + (tid & 15) * 4);
            const float g = w.gain ? w.gain[tk * 64 + kr] : 1.f;
            float* sp = sm + kr * 65 + (tid & 15) * 4;
            sp[0] = v.x * g; sp[1] = v.y * g; sp[2] = v.z * g; sp[3] = v.w * g;
        }
    }
    __syncthreads();
    if (act) {
        const int n = tid >> 2, kq = tid & 3; const int ng = tn * 64 + n;
        int drow = ng;
        if (w.gu) drow = ng < DFF ? ((ng >> 5) * 64 + (ng & 31)) : (((ng - DFF) >> 5) * 64 + 32 + ((ng - DFF) & 31));
        unsigned o[8];
#pragma unroll
        for (int e = 0; e < 8; ++e) o[e] = pk2(sm[(kq * 16 + 2 * e) * 65 + n], sm[(kq * 16 + 2 * e + 1) * 65 + n]);
        uint4* dp = (uint4*)(w.dst + (size_t)drow * w.K + tk * 64 + kq * 16);
        dp[0] = make_uint4(o[0], o[1], o[2], o[3]); dp[1] = make_uint4(o[4], o[5], o[6], o[7]);
    }
    __syncthreads();
}

DI float wave_sum(float v) {
    v += __shfl_xor(v, 1); v += __shfl_xor(v, 2); v += __shfl_xor(v, 4); v += __shfl_xor(v, 8); v += __shfl_xor(v, 16); v += __shfl_xor(v, 32);
    return v;
}

DI void rowconv(const float* src, bf16_t* dst, float* ssq, int row, int lane) {
    const float* xr = src + (size_t)row * D;
    float ss = 0.f;
#pragma unroll
    for (int p = 0; p < 4; ++p) {
        const float4 v = *(const float4*)(xr + p * 256 + lane * 4);
        ss += v.x * v.x + v.y * v.y + v.z * v.z + v.w * v.w;
        *(uint2*)(dst + (size_t)row * D + p * 256 + lane * 4) = make_uint2(pk2(v.x, v.y), pk2(v.z, v.w));
    }
    ss = wave_sum(ss);
    if (lane == 0) ssq[row] = ss;
}

DI void phase0(const Params& P, char* smem) {
    const int tid = otid(), lane = tid & 63, wid = tid >> 6;
    float* ssq = (float*)(P.ws + OFF_SSQ);
    for (int i = blockIdx.x * NTHR + tid; i < 8 * T; i += gridDim.x * NTHR) ssq[T + i] = 0.f;
    if (blockIdx.x == 0 && tid < 32) ((unsigned*)(P.ws + OFF_KMAX))[tid] = 0u;
    constexpr int NW = 12352 / 2, NX = T / 8, NM = 1024 / 8;
    for (int u = blockIdx.x; u < NW + NX + NM; u += gridDim.x) {
        if (u < NW) {
            const int half = tid >> 8;
            int t = 2 * u + half, j = 0;
            for (; j < 17; ++j) { const int c = wjob_tiles(j); if (t < c) break; t -= c; }
            const WJob w = get_wjob(P, j);
            wconv_tile(w, t, (float*)smem + half * (64 * 65), tid & 255, true);
        } else if (u < NW + NX) {
            rowconv(P.in[0], (bf16_t*)(P.ws + OFF_XB), ssq, (u - NW) * 8 + wid, lane);
        } else {
            rowconv(P.in[1], (bf16_t*)(P.ws + OFF_MEMB), (float*)(P.ws + OFF_SSQM), (u - NW - NX) * 8 + wid, lane);
        }
    }
}

struct GJob {
    const bf16_t* A; const bf16_t* W;
    int lda, ksplit, kextra, K, ntm, ntn, mode;
    const float* rs;
    bf16_t* O; int ldo;
    const float* xin; float* xout; bf16_t* xb; float* ssq_out; float alpha;
    const float* qg; const float* kg; int qn_end, kn_end;
    bf16_t* vt;
};

typedef __attribute__((address_space(3))) unsigned* ldsu_t;
typedef const __attribute__((address_space(1))) unsigned* glbu_t;
DI void glds16(const bf16_t* g, char* l) { __builtin_amdgcn_global_load_lds((glbu_t)(const void*)g, (ldsu_t)(void*)l, 16, 0, 0); }

DI void gemm_tile(const GJob& J, int t, char* smem, bool dry) {
    const int tid = otid(), lane = tid & 63, wid = tid >> 6, wr = wid >> 2, wc = wid & 3;
    const int r = lane & 31, h = lane >> 5;
    int tm, tn;
    { const int gsz = 32 * J.ntn; const int g = t / gsz; const int rem = t - g * gsz; const int rows = min(32, J.ntm - g * 32); tn = rem / rows; tm = g * 32 + (rem - tn * rows); }
    const int lrow = wid * 16 + (lane >> 2);
    const int csw = ((lane & 3) ^ ((lane >> 4) & 3)) * 8;
    const bf16_t* Ag = J.A + (size_t)(tm * 256 + lrow) * J.lda + csw;
    const bf16_t* Wg = J.W + (size_t)(tn * 256 + lrow) * J.K + csw;
    const size_t astr = (size_t)128 * J.lda, wstr = (size_t)128 * J.K;
    char* lb = smem + tid * 16;
    const int nk = J.K >> 5;
#define GLDS(kt, buf) do { const int k0_ = (kt) * 32; const int ka_ = k0_ + (k0_ >= J.ksplit ? J.kextra : 0); char* l_ = lb + (buf) * STAGE_B; \
        glds16(Ag + ka_, l_); glds16(Ag + astr + ka_, l_ + 8192); glds16(Wg + k0_, l_ + OPB); glds16(Wg + wstr + k0_, l_ + OPB + 8192); } while (0)
    f32x16 acc[4][2];
#pragma unroll
    for (int a = 0; a < 4; ++a)
#pragma unroll
        for (int b = 0; b < 2; ++b)
#pragma unroll
            for (int i = 0; i < 16; ++i) acc[a][b][i] = 0.f;
    const int fr = (r >> 2) & 3;
    const int xrow = (wc * 64 + r) * 64, wrow = OPB + (wr * 128 + r) * 64;
    const int co0 = ((0 + h) ^ fr) * 16, co1 = ((2 + h) ^ fr) * 16;

    __syncthreads();
    GLDS(0, 0); GLDS(1, 1); GLDS(2, 2);
    asm volatile("s_waitcnt vmcnt(8)" ::: "memory");
    __builtin_amdgcn_s_barrier();
    bf16x8 w0[4], x0[2], w1[4], x1[2];
#define LOADF(W_, X_, sb_, co_) do { _Pragma("unroll") for (int ti = 0; ti < 2; ++ti) X_[ti] = *(const bf16x8*)((sb_) + xrow + ti * 2048 + (co_)); \
        _Pragma("unroll") for (int fi = 0; fi < 4; ++fi) W_[fi] = *(const bf16x8*)((sb_) + wrow + fi * 2048 + (co_)); } while (0)
#define MFMA8(W_, X_) do { __builtin_amdgcn_s_setprio(1); _Pragma("unroll") for (int fi = 0; fi < 4; ++fi) _Pragma("unroll") for (int ti = 0; ti < 2; ++ti) \
        acc[fi][ti] = MFMA(W_[fi], X_[ti], acc[fi][ti]); __builtin_amdgcn_s_setprio(0); } while (0)
    LOADF(w0, x0, smem, co0);
    __builtin_amdgcn_s_waitcnt(0xC07F);
    int buf = 0;
    for (int kt = 0; kt < nk; ++kt) {
        const char* sb = smem + buf * STAGE_B;
        LOADF(w1, x1, sb, co1);
        __builtin_amdgcn_sched_barrier(0);
        MFMA8(w0, x0);
        __builtin_amdgcn_s_waitcnt(0xC07F);
        __builtin_amdgcn_sched_barrier(0);
        const int nb = (buf + 1 == NST) ? 0 : buf + 1;
        if (kt + 1 < nk) {
            if (kt + 2 < nk) asm volatile("s_waitcnt vmcnt(4)" ::: "memory"); else asm volatile("s_waitcnt vmcnt(0)" ::: "memory");
            __builtin_amdgcn_s_barrier();
            if (kt + 3 < nk) { const int fb_ = (buf + 3 >= NST) ? buf + 3 - NST : buf + 3; GLDS(kt + 3, fb_); }
        }
        LOADF(w0, x0, smem + nb * STAGE_B, co0);
        __builtin_amdgcn_sched_barrier(0);
        MFMA8(w1, x1);
        __builtin_amdgcn_s_waitcnt(0xC07F);
        __builtin_amdgcn_sched_barrier(0);
        buf = nb;
    }
#undef LOADF
#undef MFMA8
#undef GLDS
    __syncthreads();

    if (dry) { if (acc[0][0][0] + acc[1][1][0] + acc[2][0][0] + acc[3][1][0] == 12345.678f) J.O[0] = 1; return; }
    const int tokb = tm * 256 + wc * 64;
    const int fb = tn * 256 + wr * 128;
    float rsc[2];
#pragma unroll
    for (int ti = 0; ti < 2; ++ti) rsc[ti] = J.rs ? __builtin_amdgcn_rsqf(J.rs[tokb + ti * 32 + r] * (1.f / 1024.f) + EPS) : 1.f;

    if (J.mode == 3 && fb >= 1024) {
#pragma unroll
        for (int ti = 0; ti < 2; ++ti) {
            const int tok = tokb + ti * 32 + r;
#pragma unroll
            for (int fi = 0; fi < 4; ++fi)
#pragma unroll
                for (int i = 0; i < 16; ++i) {
                    const int f = fb - 1024 + fi * 32 + crow(i, h);
                    const int bh_ = (tok >> 8) * 4 + (f >> 8), d_ = f & 255, key_ = tok & 255, k16 = key_ & 15;
                    const int ln_ = ((k16 >> 2) & 1) * 32 + (d_ & 31), e_ = ((k16 >> 3) << 2) | (k16 & 3);
                    J.vt[((((((size_t)bh_ * 8 + (d_ >> 5)) * 8 + (key_ >> 5)) * 2 + ((key_ >> 4) & 1)) * 64 + ln_) << 3) + e_] = (bf16_t)(pk2(acc[fi][ti][i] * rsc[ti], 0.f) & 0xffffu);
                }
        }
        return;
    }
    char* wl = smem + wid * 16384;
#pragma unroll
    for (int ti = 0; ti < 2; ++ti) {
#pragma unroll
        for (int fp = 0; fp < 2; ++fp) {
            const float sc = (J.mode == 1) ? J.alpha : rsc[ti];
#pragma unroll
            for (int fi2 = 0; fi2 < 2; ++fi2)
#pragma unroll
                for (int g = 0; g < 4; ++g) {
                    float4 v;
                    v.x = acc[2 * fp + fi2][ti][4 * g + 0] * sc; v.y = acc[2 * fp + fi2][ti][4 * g + 1] * sc;
                    v.z = acc[2 * fp + fi2][ti][4 * g + 2] * sc; v.w = acc[2 * fp + fi2][ti][4 * g + 3] * sc;
                    *(float4*)(wl + r * 272 + (fi2 * 32 + 8 * g + 4 * h) * 4) = v;
                }
            const int tok0 = tokb + ti * 32, f0 = fb + fp * 64;
            if (J.mode == 0) {
                const int c4 = (lane & 7) * 4;
#pragma unroll
                for (int p = 0; p < 4; ++p) {
                    const int row = p * 8 + (lane >> 3);
                    const float4 ga = *(const float4*)(wl + row * 272 + c4 * 4);
                    const float4 up = *(const float4*)(wl + row * 272 + (32 + c4) * 4);
                    float y0 = ga.x * up.x * __builtin_amdgcn_rcpf(1.f + fexp2(-ga.x * LOG2E));
                    float y1 = ga.y * up.y * __builtin_amdgcn_rcpf(1.f + fexp2(-ga.y * LOG2E));
                    float y2 = ga.z * up.z * __builtin_amdgcn_rcpf(1.f + fexp2(-ga.z * LOG2E));
                    float y3 = ga.w * up.w * __builtin_amdgcn_rcpf(1.f + fexp2(-ga.w * LOG2E));
                    *(uint2*)(J.O + (size_t)(tok0 + row) * J.ldo + (f0 >> 1) + c4) = make_uint2(pk2(y0, y1), pk2(y2, y3));
                }
            } else if (J.mode == 1) {
                const int c4 = (lane & 15) * 4;
#pragma unroll
                for (int p = 0; p < 8; ++p) {
                    const int row = p * 4 + (lane >> 4);
                    const size_t tok = tok0 + row;
                    const float4 v = *(const float4*)(wl + row * 272 + c4 * 4);
                    const float4 xo = *(const float4*)(J.xin + tok * D + f0 + c4);
                    float4 xn; xn.x = xo.x + v.x; xn.y = xo.y + v.y; xn.z = xo.z + v.z; xn.w = xo.w + v.w;
                    *(float4*)(J.xout + tok * D + f0 + c4) = xn;
                    if (J.xb) {
                        *(uint2*)(J.xb + tok * D + f0 + c4) = make_uint2(pk2(xn.x, xn.y), pk2(xn.z, xn.w));
                        float ss = xn.x * xn.x + xn.y * xn.y + xn.z * xn.z + xn.w * xn.w;
                        ss += __shfl_xor(ss, 1); ss += __shfl_xor(ss, 2); ss += __shfl_xor(ss, 4); ss += __shfl_xor(ss, 8);
                        if ((lane & 15) == 0) atomicAdd(J.ssq_out + tok, ss);
                    }
                }
            } else {
                const int nm = f0 < J.qn_end ? 1 : (f0 < J.kn_end ? 2 : 0);
                const float* gp = nm == 1 ? J.qg : J.kg;
                const int c4 = (lane & 15) * 4;
                float4 gn = make_float4(1.f, 1.f, 1.f, 1.f);
                if (nm) gn = *(const float4*)(gp + c4);
#pragma unroll
                for (int p = 0; p < 8; ++p) {
                    const int row = p * 4 + (lane >> 4);
                    float4 v = *(const float4*)(wl + row * 272 + c4 * 4);
                    if (nm) {
                        float ss = v.x * v.x + v.y * v.y + v.z * v.z + v.w * v.w;
                        ss += __shfl_xor(ss, 1); ss += __shfl_xor(ss, 2); ss += __shfl_xor(ss, 4); ss += __shfl_xor(ss, 8);
                        const float inv = __builtin_amdgcn_rsqf(ss * (1.f / 64.f) + EPS);
                        v.x *= inv * gn.x; v.y *= inv * gn.y; v.z *= inv * gn.z; v.w *= inv * gn.w;
                    }
                    *(uint2*)(J.O + (size_t)(tok0 + row) * J.ldo + f0 + c4) = make_uint2(pk2(v.x, v.y), pk2(v.z, v.w));
                }
            }
        }
    }
}

DI void gemm_phase(const GJob& JA, int nA, int nB, const Params& P, char* smem, bool dry) {
    for (int u = blockIdx.x; u < nA + nB; u += gridDim.x) {
        GJob J = JA; int t = u;
        if (u >= nA) {
            const int v = u - nA; const int layer = v >> 5; t = v & 31;
            J.A = (const bf16_t*)(P.ws + OFF_MEMB); J.lda = D; J.ksplit = 1 << 30; J.kextra = 0;
            J.W = (const bf16_t*)(P.ws + OFF_WKV + (size_t)layer * 2 * SZ_MM); J.K = D; J.ntm = 4; J.ntn = 8; J.mode = 3;
            J.rs = (const float*)(P.ws + OFF_SSQM); J.O = (bf16_t*)(P.ws + OFF_KN + (size_t)layer * SZ_MM); J.ldo = D;
            J.qn_end = 0; J.kn_end = 0; J.vt = (bf16_t*)(P.ws + OFF_VT + (size_t)layer * SZ_MM);
        }
        gemm_tile(J, t, smem, dry);
    }
}

#define KV_DECL uint4 rk0, rk1, rk2, rk3, rv0, rv1, rv2, rv3
#define KV_LOAD(kb_, dil_) do { const int kk_ = lane >> 3; \
    const bf16_t* p0_ = qkv + (rowb + min(max((kb_) + (dil_) * kk_, 0), S - 1)) * ld + (lane & 7) * 8; \
    const bf16_t* p1_ = qkv + (rowb + min(max((kb_) + (dil_) * (kk_ + 8), 0), S - 1)) * ld + (lane & 7) * 8; \
    const bf16_t* p2_ = qkv + (rowb + min(max((kb_) + (dil_) * (kk_ + 16), 0), S - 1)) * ld + (lane & 7) * 8; \
    const bf16_t* p3_ = qkv + (rowb + min(max((kb_) + (dil_) * (kk_ + 24), 0), S - 1)) * ld + (lane & 7) * 8; \
    rk0 = *(const uint4*)(p0_ + kcol); rk1 = *(const uint4*)(p1_ + kcol); rk2 = *(const uint4*)(p2_ + kcol); rk3 = *(const uint4*)(p3_ + kcol); \
    rv0 = *(const uint4*)(p0_ + vcol); rv1 = *(const uint4*)(p1_ + vcol); rv2 = *(const uint4*)(p2_ + vcol); rv3 = *(const uint4*)(p3_ + vcol); } while (0)
#define KV_STORE() do { char* wp_ = vl + (lane >> 3) * 144 + (lane & 7) * 16; \
    *(uint4*)(wp_) = rk0; *(uint4*)(wp_ + 8 * 144) = rk1; *(uint4*)(wp_ + 16 * 144) = rk2; *(uint4*)(wp_ + 24 * 144) = rk3; \
    *(uint4*)(wp_ + 4608) = rv0; *(uint4*)(wp_ + 4608 + 8 * 144) = rv1; *(uint4*)(wp_ + 4608 + 16 * 144) = rv2; *(uint4*)(wp_ + 4608 + 24 * 144) = rv3; } while (0)

DI bf16x8 v_frag(const char* vbase, int s, int dt) {
    typedef __attribute__((address_space(3))) v4i16_t* lp_t;
    const char* a = vbase + s * (16 * 144) + dt * 64;
    const s16x4 lo = __builtin_bit_cast(s16x4, __builtin_amdgcn_ds_read_tr16_b64_v4i16((lp_t)(a)));
    const s16x4 hi = __builtin_bit_cast(s16x4, __builtin_amdgcn_ds_read_tr16_b64_v4i16((lp_t)(a + 8 * 144)));
    return __builtin_shufflevector(lo, hi, 0, 1, 2, 3, 4, 5, 6, 7);
}

template <int OFF> DI bf16x8 pack8v(const f32x16& p) {
    typedef unsigned u32x4 __attribute__((ext_vector_type(4)));
    u32x4 w; w[0] = pk2(p[OFF + 0], p[OFF + 1]); w[1] = pk2(p[OFF + 2], p[OFF + 3]); w[2] = pk2(p[OFF + 4], p[OFF + 5]); w[3] = pk2(p[OFF + 6], p[OFF + 7]);
    return __builtin_bit_cast(bf16x8, w);
}

DI void win_attn_wave(bf16_t* qkv, int ld, int b, int qcol, int kcol, int vcol, int tq0, int qstride,
                      float slope2, float m_init, float l_init, int mode, char* vl, int lane, bool dry) {
    const int r = lane & 31, h = lane >> 5;
    const size_t rowb = (size_t)b * S;
    const int tq = tq0 + qstride * r;
    const int tqlast = tq0 + qstride * 31;
    bf16x8 qf[4];
    {
        const bf16_t* qp = qkv + (rowb + tq) * ld + qcol + h * 32;
#pragma unroll
        for (int ks = 0; ks < 4; ++ks) qf[ks] = *(const bf16x8*)(qp + ks * 8);
    }
    f32x16 o0, o1;
#pragma unroll
    for (int i = 0; i < 16; ++i) { o0[i] = 0.f; o1[i] = 0.f; }
    float m = m_init, l = (h == 0) ? l_init : 0.f;
    const float sc2 = 0.125f * LOG2E;
    const int i16 = lane & 15;
    const char* vbase = vl + 4608 + (4 * h + (i16 >> 2)) * 144 + (16 * ((lane >> 4) & 1) + 4 * (i16 & 3)) * 2;
    const int npat = mode ? 3 : 1;
    const char* kfp = vl + r * 144 + h * 64;
    KV_DECL;
    for (int pi = 0; pi < npat; ++pi) {
        int dil, W, kfirst, nt;
        if (!mode) { dil = 1; W = 127; kfirst = tq0 - 128; nt = 5; }
        else if (pi == 0) { dil = 1; W = 128; kfirst = tq0 - 128; nt = 20; }
        else if (pi == 1) { dil = 4; W = 512; kfirst = tq0 - 512; nt = 8; }
        else { dil = 16; W = 2048; kfirst = tq0 - 2048; nt = 5; }
        const int step = 32 * dil;
        int t0 = 0;
        { const int need = -kfirst - 31 * dil; if (need > 0) t0 = (need + step - 1) / step; }
        if (t0 >= nt) continue;
        KV_LOAD(kfirst + t0 * step, dil);
        for (int tile = t0; tile < nt; ++tile) {
            const int kb = kfirst + tile * step;
            KV_STORE();
            asm volatile("" ::: "memory");
            if (tile + 1 < nt) KV_LOAD(kb + step, dil);
            f32x16 s;
#pragma unroll
            for (int i = 0; i < 16; ++i) s[i] = 0.f;
#pragma unroll
            for (int ks = 0; ks < 4; ++ks) s = MFMA(*(const bf16x8*)(kfp + ks * 16), qf[ks], s);
            f32x16 sv; float mloc = -INFINITY;
            const int d0 = tq - kb - 4 * h * dil;
            const unsigned wlim = (unsigned)min(W, tq);
#pragma unroll
            for (int i = 0; i < 16; ++i) {
                const int diff = d0 - dil * crow(i, 0);
                const float sb = s[i] * sc2 - slope2 * (float)diff;
                sv[i] = ((unsigned)diff <= wlim) ? sb : -INFINITY;
                mloc = fmaxf(mloc, sv[i]);
            }
            mloc = fmaxf(mloc, __shfl_xor(mloc, 32));
            const float mn = fmaxf(m, mloc);
            float ps = 0.f;
#pragma unroll
            for (int i = 0; i < 16; ++i) { sv[i] = fexp2(sv[i] - mn); ps += sv[i]; }
            if (__builtin_amdgcn_ballot_w64(mn != m) != 0) {
                const float alpha = fexp2(m - mn);
                l *= alpha;
#pragma unroll
                for (int i = 0; i < 16; ++i) { o0[i] *= alpha; o1[i] *= alpha; }
                m = mn;
            }
            l += ps;
            const bf16x8 p0 = pack8v<0>(sv), p1 = pack8v<8>(sv);
            o0 = MFMA(v_frag(vbase, 0, 0), p0, o0);
            o0 = MFMA(v_frag(vbase, 1, 0), p1, o0);
            o1 = MFMA(v_frag(vbase, 0, 1), p0, o1);
            o1 = MFMA(v_frag(vbase, 1, 1), p1, o1);
            asm volatile("" ::: "memory");
        }
    }
    const float lt = l + __shfl_xor(l, 32);
    const float inv = 1.f / lt;
    if (dry) { if (o0[0] + o1[0] + lt == 12345.678f) qkv[0] = 1; return; }
    bf16_t* op = qkv + (rowb + tq) * ld + qcol + 4 * h;
#pragma unroll
    for (int g = 0; g < 4; ++g) {
        *(uint2*)(op + 8 * g) = make_uint2(pk2(o0[4 * g] * inv, o0[4 * g + 1] * inv), pk2(o0[4 * g + 2] * inv, o0[4 * g + 3] * inv));
        *(uint2*)(op + 32 + 8 * g) = make_uint2(pk2(o1[4 * g] * inv, o1[4 * g + 1] * inv), pk2(o1[4 * g + 2] * inv, o1[4 * g + 3] * inv));
    }
}

DI void stick_wave(bf16_t* qkv, int ld, int b, int qcol, int kcol, int vcol, int qt, char* vl, int lane, bool dry) {
    const int r = lane & 31, h = lane >> 5;
    const size_t rowb = (size_t)b * S;
    const int tq = qt * 32 + r;
    bf16x8 qf[4];
    {
        const bf16_t* qp = qkv + (rowb + tq) * ld + qcol + h * 32;
#pragma unroll
        for (int ks = 0; ks < 4; ++ks) qf[ks] = *(const bf16x8*)(qp + ks * 8);
    }
    f32x16 o0, o1;
#pragma unroll
    for (int i = 0; i < 16; ++i) { o0[i] = 0.f; o1[i] = 0.f; }
    float R = 1.f;
    const int i16 = lane & 15;
    const char* vbase = vl + 4608 + (4 * h + (i16 >> 2)) * 144 + (16 * ((lane >> 4) & 1) + 4 * (i16 & 3)) * 2;
    const char* kfp = vl + r * 144 + h * 64;
    KV_DECL;
    KV_LOAD(qt * 32, 1);
    for (int tile = qt; tile >= 0; --tile) {
        KV_STORE();
        asm volatile("" ::: "memory");
        if (tile > 0) KV_LOAD((tile - 1) * 32, 1);
        f32x16 s;
#pragma unroll
        for (int i = 0; i < 16; ++i) s[i] = 0.f;
#pragma unroll
        for (int ks = 0; ks < 4; ++ks) s = MFMA(*(const bf16x8*)(kfp + ks * 16), qf[ks], s);
        const bool diag = (tile == qt);
        f32x16 sg, kp;
#pragma unroll
        for (int i = 0; i < 16; ++i) {
            const float z2 = fminf(s[i] * (0.125f * LOG2E), 80.f);
            const float t = fexp2(z2);
            const float k = __builtin_amdgcn_rcpf(1.f + t);
            kp[i] = k; sg[i] = t * k;
        }
        if (diag) {
#pragma unroll
            for (int i = 0; i < 16; ++i) { const bool strict = crow(i, h) < r; kp[i] = strict ? kp[i] : 1.f; sg[i] = strict ? sg[i] : 0.f; }
        }
        float G[4], PG[4], both[4];
#pragma unroll
        for (int g = 0; g < 4; ++g) { G[g] = (kp[4 * g] * kp[4 * g + 1]) * (kp[4 * g + 2] * kp[4 * g + 3]); PG[g] = __shfl_xor(G[g], 32); both[g] = G[g] * PG[g]; }
        float Sx[4];
        Sx[3] = 1.f; Sx[2] = both[3]; Sx[1] = both[3] * both[2]; Sx[0] = Sx[1] * both[1];
        f32x16 a;
#pragma unroll
        for (int g = 0; g < 4; ++g) {
            float la = R * Sx[g] * (h == 0 ? PG[g] : 1.f);
#pragma unroll
            for (int j = 3; j >= 0; --j) {
                a[4 * g + j] = sg[4 * g + j] * la;
                la *= kp[4 * g + j];
            }
        }
        R *= Sx[0] * both[0];
        const bf16x8 p0 = pack8v<0>(a), p1 = pack8v<8>(a);
        o0 = MFMA(v_frag(vbase, 0, 0), p0, o0);
        o0 = MFMA(v_frag(vbase, 1, 0), p1, o0);
        o1 = MFMA(v_frag(vbase, 0, 1), p0, o1);
        o1 = MFMA(v_frag(vbase, 1, 1), p1, o1);
        asm volatile("" ::: "memory");
        if (__builtin_amdgcn_ballot_w64(R >= 1.17549435e-38f) == 0) break;
    }
    if (dry) { if (o0[0] + o1[0] == 12345.678f) qkv[0] = 1; return; }
    bf16_t* op = qkv + (rowb + tq) * ld + qcol + 4 * h;
#pragma unroll
    for (int g = 0; g < 4; ++g) {
        *(uint2*)(op + 8 * g) = make_uint2(pk2(o0[4 * g], o0[4 * g + 1]), pk2(o0[4 * g + 2], o0[4 * g + 3]));
        *(uint2*)(op + 32 + 8 * g) = make_uint2(pk2(o1[4 * g], o1[4 * g + 1]), pk2(o1[4 * g + 2], o1[4 * g + 3]));
    }
}

DI void attn_even_phase(const Params& P, char* smem, bool dry) {
    const int tid_ = otid(); const int lane = tid_ & 63, wid = tid_ >> 6;
    bf16_t* qkv = (bf16_t*)(P.ws + OFF_BIG);
    char* vl = smem + wid * 9216;
    for (int it = blockIdx.x * 8 + wid; it < 2048 + 4096; it += gridDim.x * 8) {
        if (it < 2048) {
            const int bh = it >> 6, p = it & 63; const int b = bh >> 3, head = bh & 7;
            stick_wave(qkv, 2304, b, 768 + head * 64, 1280 + head * 64, 1792 + head * 64, 127 - p, vl, lane, dry);
            stick_wave(qkv, 2304, b, 768 + head * 64, 1280 + head * 64, 1792 + head * 64, p, vl, lane, dry);
        } else {
            const int v = it - 2048; const int g = v & 3; const int qt = (v >> 2) & 127; const int rest = v >> 9; const int b = rest >> 1, kvh = rest & 1;
            const int head = kvh * 4 + g;
            const float slope = exp2f(-(float)(head + 1));
            const float sink = P.in[9][head];
            win_attn_wave(qkv, 2304, b, head * 64, 512 + kvh * 64, 640 + kvh * 64, qt * 32, 1, slope * LOG2E, sink * LOG2E, 1.f, 0, vl, lane, dry);
        }
    }
}

DI void attn_odd_phase(const Params& P, char* smem, bool dry) {
    const int tid_ = otid(); const int lane = tid_ & 63, wid = tid_ >> 6;
    bf16_t* qkv = (bf16_t*)(P.ws + OFF_BIG);
    char* vl = smem + wid * 9216;
    for (int it = blockIdx.x * 8 + wid; it < 8192; it += gridDim.x * 8) {
        const int res16 = it & 15; const int u0 = ((it >> 4) & 7) * 32; const int head = (it >> 7) & 15; const int b = it >> 11;
        const float slope = exp2f(-0.5f * (float)(head + 1));
        win_attn_wave(qkv, 3072, b, head * 64, 1024 + head * 64, 2048 + head * 64, res16 + 16 * u0, 16, slope * LOG2E, -1e30f, 0.f, 1, vl, lane, dry);
    }
}

DI void xattn_wave(bf16_t* qb, const bf16_t* Kn, const bf16_t* VT, const float* qg, float kmax2, int b, int head, int tok0, char* ql, int lane, bool dry) {
    const int r = lane & 31, h = lane >> 5;
    const size_t token = (size_t)b * S + tok0 + r;
    bf16_t* qp = qb + token * D + head * 256 + h * 128;
    float ss = 0.f;
#pragma unroll
    for (int ks = 0; ks < 16; ++ks) {
        const uint4 v = *(const uint4*)(qp + ks * 8);
        const unsigned w[4] = {v.x, v.y, v.z, v.w};
#pragma unroll
        for (int e = 0; e < 4; ++e) { const float a = bflo(w[e]), c = bfhi(w[e]); ss += a * a + c * c; }
    }
    ss += __shfl_xor(ss, 32);
    const float inv = __builtin_amdgcn_rsqf(ss * (1.f / 256.f) + EPS);
    float qq2 = 0.f;
#pragma unroll
    for (int ks = 0; ks < 16; ++ks) {
        const uint4 v = *(const uint4*)(qp + ks * 8);
        const float4 g0 = *(const float4*)(qg + h * 128 + ks * 8), g1 = *(const float4*)(qg + h * 128 + ks * 8 + 4);
        uint4 o;
        o.x = pk2(bflo(v.x) * inv * g0.x, bfhi(v.x) * inv * g0.y); o.y = pk2(bflo(v.y) * inv * g0.z, bfhi(v.y) * inv * g0.w);
        o.z = pk2(bflo(v.z) * inv * g1.x, bfhi(v.z) * inv * g1.y); o.w = pk2(bflo(v.w) * inv * g1.z, bfhi(v.w) * inv * g1.w);
        qq2 += bflo(o.x) * bflo(o.x) + bfhi(o.x) * bfhi(o.x) + bflo(o.y) * bflo(o.y) + bfhi(o.y) * bfhi(o.y)
             + bflo(o.z) * bflo(o.z) + bfhi(o.z) * bfhi(o.z) + bflo(o.w) * bflo(o.w) + bfhi(o.w) * bfhi(o.w);
        *(uint4*)(ql + (ks * 64 + lane) * 16) = o;
    }
    qq2 += __shfl_xor(qq2, 32);
    asm volatile("" ::: "memory");
    const float sc2 = 0.0625f * LOG2E;
    const bf16_t* kp0 = Kn + ((size_t)(b * 4 + head) * 8 * 16 * 64 + lane) * 8;
    const float m = __builtin_amdgcn_sqrtf(qq2 * kmax2) * 1.001f;
    float l = 0.f;
    bf16x8 pf[8][2];
    bf16x8 kc[16], kn[16];
#pragma unroll
    for (int ks = 0; ks < 16; ++ks) kc[ks] = *(const bf16x8*)(kp0 + ks * 512);
#pragma unroll
    for (int tile = 0; tile < 8; ++tile) {
        if (tile < 7) {
#pragma unroll
            for (int ks = 0; ks < 16; ++ks) kn[ks] = *(const bf16x8*)(kp0 + (size_t)(tile + 1) * 16 * 512 + ks * 512);
        }
        f32x16 s;
#pragma unroll
        for (int i = 0; i < 16; ++i) s[i] = 0.f;
#pragma unroll
        for (int ks = 0; ks < 16; ++ks) {
            const bf16x8 qf = *(const bf16x8*)(ql + (ks * 64 + lane) * 16);
            s = MFMA(kc[ks], qf, s);
        }
#pragma unroll
        for (int i = 0; i < 16; ++i) { s[i] = fexp2((s[i] - m) * sc2); l += s[i]; }
        pf[tile][0] = pack8v<0>(s); pf[tile][1] = pack8v<8>(s);
#pragma unroll
        for (int ks = 0; ks < 16; ++ks) kc[ks] = kn[ks];
    }
    l += __shfl_xor(l, 32);
    const float il = 1.f / l;
    bf16_t* op = qb + token * D + head * 256 + 4 * h;
    const bf16_t* vp0 = VT + (((size_t)(b * 4 + head) * 8 * 8 * 2 * 64) + lane) * 8;
    bf16x8 vc[16], vn[16];
#pragma unroll
    for (int e = 0; e < 16; ++e) vc[e] = *(const bf16x8*)(vp0 + e * 512);
#pragma unroll 1
    for (int dt = 0; dt < 8; ++dt) {
        const int dn = dt < 7 ? dt + 1 : 7;
#pragma unroll
        for (int e = 0; e < 16; ++e) vn[e] = *(const bf16x8*)(vp0 + (size_t)dn * 16 * 512 + e * 512);
        f32x16 o;
#pragma unroll
        for (int i = 0; i < 16; ++i) o[i] = 0.f;
#pragma unroll
        for (int tile = 0; tile < 8; ++tile)
#pragma unroll
            for (int s2 = 0; s2 < 2; ++s2) o = MFMA(vc[tile * 2 + s2], pf[tile][s2], o);
#pragma unroll
        for (int g = 0; g < 4; ++g)
            if (dry) { if (o[4 * g] == 12345.678f) qb[0] = 1; } else *(uint2*)(op + dt * 32 + 8 * g) = make_uint2(pk2(o[4 * g] * il, o[4 * g + 1] * il), pk2(o[4 * g + 2] * il, o[4 * g + 3] * il));
#pragma unroll
        for (int e = 0; e < 16; ++e) vc[e] = vn[e];
    }
}

DI void xattn_phase(const Params& P, int l, char* smem, bool dry) {
    const int tid_ = otid(); const int lane = tid_ & 63, wid = tid_ >> 6;
    bf16_t* qb = (bf16_t*)(P.ws + OFF_BIG);
    const bf16_t* Kn = (const bf16_t*)(P.ws + OFF_KF + (size_t)l * SZ_MM);
    const bf16_t* VT = (const bf16_t*)(P.ws + OFF_VT + (size_t)l * SZ_MM);
    const float* qg = P.in[19] + l * 256;
    char* ql = smem + wid * 16384;
    for (int it = blockIdx.x * 8 + wid; it < 2048; it += gridDim.x * 8) {
        const int qt = it & 127, head = (it >> 7) & 3, b = it >> 9;
        const float kmax2 = ((const float*)(P.ws + OFF_KMAX))[l * 16 + b * 4 + head];
        xattn_wave(qb, Kn, VT, qg, kmax2, b, head, qt * 32, ql, lane, dry);
    }
}

DI void knorm_phase(const Params& P) {
    const int tid_ = otid(); const int lane = tid_ & 63, wid = tid_ >> 6;
    for (int u = blockIdx.x * 8 + wid; u < 8192; u += gridDim.x * 8) {
        const int l = u >> 12, row = (u >> 2) & 1023, head = u & 3;
        const bf16_t* kp = (const bf16_t*)(P.ws + OFF_KN + (size_t)l * SZ_MM) + (size_t)row * D + head * 256 + lane * 4;
        const uint2 v = *(const uint2*)kp;
        const float a0 = bflo(v.x), a1 = bfhi(v.x), a2 = bflo(v.y), a3 = bfhi(v.y);
        float ss = a0 * a0 + a1 * a1 + a2 * a2 + a3 * a3;
        ss = wave_sum(ss);
        const float inv = __builtin_amdgcn_rsqf(ss * (1.f / 256.f) + EPS);
        const float4 g = *(const float4*)(P.in[20] + l * 256 + lane * 4);
        const int b = row >> 8, key = row & 255;
        const int h = lane >> 5, ks = (lane & 31) >> 1, j0 = (lane & 1) * 4;
        bf16_t* dp = (bf16_t*)(P.ws + OFF_KF + (size_t)l * SZ_MM) + ((((((size_t)(b * 4 + head) * 8 + (key >> 5)) * 16 + ks) * 64) + h * 32 + (key & 31)) << 3) + j0;
        const unsigned w0_ = pk2(a0 * inv * g.x, a1 * inv * g.y), w1_ = pk2(a2 * inv * g.z, a3 * inv * g.w);
        *(uint2*)dp = make_uint2(w0_, w1_);
        float kk2 = bflo(w0_) * bflo(w0_) + bfhi(w0_) * bfhi(w0_) + bflo(w1_) * bflo(w1_) + bfhi(w1_) * bfhi(w1_);
        kk2 = wave_sum(kk2);
        if (lane == 0) atomicMax((unsigned*)(P.ws + OFF_KMAX) + l * 16 + b * 4 + head, __float_as_uint(kk2));
    }
}

DI void fast_grid_sync(unsigned* bar, unsigned target) {
    asm volatile("s_waitcnt vmcnt(0) lgkmcnt(0)" ::: "memory");
    __syncthreads();
    if (threadIdx.x == 0) {
        __builtin_amdgcn_fence(__ATOMIC_RELEASE, "agent");
        asm volatile("s_waitcnt vmcnt(0)" ::: "memory");
        __hip_atomic_fetch_add(bar, 1u, __ATOMIC_RELAXED, __HIP_MEMORY_SCOPE_AGENT);
        while (__hip_atomic_load(bar, __ATOMIC_RELAXED, __HIP_MEMORY_SCOPE_AGENT) < target) __builtin_amdgcn_s_sleep(2);
        __builtin_amdgcn_fence(__ATOMIC_ACQUIRE, "agent");
        asm volatile("s_waitcnt vmcnt(0)" ::: "memory");
    }
    __syncthreads();
}

__global__ void __launch_bounds__(512) fwd_megakernel(Params P) {
    extern __shared__ __attribute__((aligned(16))) char smem[];
    cg::grid_group grid = cg::this_grid();
    unsigned nbar = 0;
#pragma unroll 1
    for (int ph = 0; ph < 21; ++ph) {
        float* ssq = (float*)(P.ws + OFF_SSQ);
        bf16_t* xb = (bf16_t*)(P.ws + OFF_XB);
        bf16_t* big = (bf16_t*)(P.ws + OFF_BIG);
        int nrep = 1;
        if (ph > 0) { const int s_ = (ph - 1) % 10; const int kind = (s_ == 3) ? 2 : (s_ == 6) ? 4 : 1; if (PROBE_MASK & kind) nrep = 2; }
        for (int rep = 0; rep < nrep; ++rep) {
        const bool dry = rep + 1 < nrep;
        if (ph == 0) {
            phase0(P, smem);
        } else {
            const int l = (ph - 1) / 10, s = (ph - 1) % 10;
            if (s == 3) {
                if (l == 0) attn_even_phase(P, smem, dry); else attn_odd_phase(P, smem, dry);
            } else if (s == 6) {
                xattn_phase(P, l, smem, dry);
            } else {
                GJob J;
                J.A = xb; J.lda = D; J.ksplit = 1 << 30; J.kextra = 0; J.K = D; J.ntm = 64; J.mode = 1; J.rs = nullptr;
                J.O = big; J.ldo = D; J.xin = P.out; J.xout = P.out; J.xb = xb; J.ssq_out = ssq; J.alpha = 1.f;
                J.qg = nullptr; J.kg = nullptr; J.qn_end = 0; J.kn_end = 0; J.vt = nullptr; J.W = nullptr; J.ntn = 4;
                int nB = 0;
                if (s == 0 || s == 8) {
                    J.W = (const bf16_t*)(P.ws + (s == 0 ? OFF_GU1 : OFF_GU2) + (size_t)l * SZ_GU);
                    J.ntn = NGU / 256; J.mode = 0; J.rs = ssq + (size_t)(4 * l + (s == 0 ? 0 : 3)) * T; J.ldo = DFF;
                    if (ph == 1) nB = 64;
                } else if (s == 1 || s == 9) {
                    J.A = big; J.lda = DFF; J.K = DFF;
                    J.W = (const bf16_t*)(P.ws + (s == 1 ? OFF_DN1 : OFF_DN2) + (size_t)l * SZ_DN);
                    J.alpha = 0.5f; J.ssq_out = ssq + (size_t)(4 * l + (s == 1 ? 1 : 4)) * T;
                    if (ph == 2) J.xin = P.in[0];
                    if (ph == 20) J.xb = nullptr;
                } else if (s == 2) {
                    J.mode = 2; J.rs = ssq + (size_t)(4 * l + 1) * T;
                    if (l == 0) { J.W = (const bf16_t*)(P.ws + OFF_EVIN); J.ntn = 9; J.ldo = 2304; J.qg = P.in[7]; J.kg = P.in[8]; J.qn_end = 512; J.kn_end = 640; }
                    else { J.W = (const bf16_t*)(P.ws + OFF_ODIN); J.ntn = 12; J.ldo = 3072; J.qg = P.in[12]; J.kg = P.in[13]; J.qn_end = 1024; J.kn_end = 2048; }
                } else if (s == 4) {
                    J.A = big;
                    if (l == 0) { J.W = (const bf16_t*)(P.ws + OFF_EVOUT); J.lda = 2304; J.ksplit = 512; J.kextra = 256; }
                    else { J.W = (const bf16_t*)(P.ws + OFF_ODOUT); J.lda = 3072; }
                    J.ssq_out = ssq + (size_t)(4 * l + 2) * T;
                } else if (s == 5) {
                    J.W = (const bf16_t*)(P.ws + OFF_WQ + (size_t)l * SZ_MM); J.mode = 2; J.rs = ssq + (size_t)(4 * l + 2) * T; J.ldo = D;
                } else {
                    J.A = big; J.W = (const bf16_t*)(P.ws + OFF_WO + (size_t)l * SZ_MM); J.ssq_out = ssq + (size_t)(4 * l + 3) * T;
                }
                gemm_phase(J, J.ntm * J.ntn, nB, P, smem, dry);
                if (ph == 2 && !dry) knorm_phase(P);
            }
        }
        if (ph == 0) grid.sync();
        else if (ph < 20) { ++nbar; fast_grid_sync((unsigned*)(P.ws + OFF_BAR), nbar * gridDim.x); }
        }
    }
}

extern "C" void kernel_launch(void* const* d_in, const int* in_sizes, int n_in, void* d_out, int out_size, void* d_ws, size_t ws_size,
                              hipStream_t stream) {
    static int grid_blocks = 0;
    if (!grid_blocks) {
        int dev = 0, cus = 0, per_cu = 0;
        hipGetDevice(&dev);
        hipDeviceGetAttribute(&cus, hipDeviceAttributeMultiprocessorCount, dev);
        hipFuncSetAttribute((const void*)fwd_megakernel, hipFuncAttributeMaxDynamicSharedMemorySize, LDS_BYTES);
        hipOccupancyMaxActiveBlocksPerMultiprocessor(&per_cu, fwd_megakernel, NTHR, LDS_BYTES);
        if (per_cu < 1) per_cu = 1;
        if (per_cu > 1) per_cu = 1;
        grid_blocks = cus * per_cu;
    }
    if (ws_size < WS_NEED) { fprintf(stderr, "workspace too small: %zu < %zu\n", ws_size, (size_t)WS_NEED); return; }
    Params p{};
    for (int i = 0; i < 25; ++i) p.in[i] = (const float*)d_in[i];
    p.out = (float*)d_out; p.ws = (char*)d_ws;
    hipMemsetAsync((char*)d_ws + OFF_BAR, 0, 256, stream);
    void* args[] = {&p};
    hipError_t e = hipLaunchCooperativeKernel((void*)fwd_megakernel, dim3(grid_blocks), dim3(NTHR), args, LDS_BYTES, stream);
    if (e != hipSuccess) fprintf(stderr, "cooperative launch failed: %s (grid %d)\n", hipGetErrorString(e), grid_blocks);
}
```

```cpp
#include <hip/hip_runtime.h>
#include <hip/hip_cooperative_groups.h>
#include <cstdio>
#include <cstdint>
namespace cg = cooperative_groups;

#define DI __device__ __forceinline__
typedef unsigned short bf16_t;
typedef short bf16x8 __attribute__((ext_vector_type(8)));
typedef short s16x4 __attribute__((ext_vector_type(4)));
typedef float f32x16 __attribute__((ext_vector_type(16)));
typedef __bf16 bf2_t __attribute__((ext_vector_type(2)));
typedef float f2_t __attribute__((ext_vector_type(2)));
typedef short v4i16_t __attribute__((ext_vector_type(4)));
#define MFMA(a, b, c) __builtin_amdgcn_mfma_f32_32x32x16_bf16((a), (b), (c), 0, 0, 0)

constexpr int T = 16384, S = 4096, D = 1024, DFF = 2816, NGU = 5632;
constexpr float EPS = 1e-6f;
constexpr float LOG2E = 1.4426950408889634f;
constexpr float LN2 = 0.6931471805599453f;

constexpr size_t SZ_GU = (size_t)NGU * D * 2, SZ_DN = (size_t)D * DFF * 2, SZ_MM = (size_t)D * D * 2;
constexpr size_t OFF_GU1 = 0;
constexpr size_t OFF_DN1 = OFF_GU1 + 2 * SZ_GU;
constexpr size_t OFF_GU2 = OFF_DN1 + 2 * SZ_DN;
constexpr size_t OFF_DN2 = OFF_GU2 + 2 * SZ_GU;
constexpr size_t OFF_WQ = OFF_DN2 + 2 * SZ_DN;
constexpr size_t OFF_WKV = OFF_WQ + 2 * SZ_MM;
constexpr size_t OFF_WO = OFF_WKV + 4 * SZ_MM;
constexpr size_t OFF_EVIN = OFF_WO + 2 * SZ_MM;
constexpr size_t OFF_EVOUT = OFF_EVIN + (size_t)2304 * D * 2;
constexpr size_t OFF_ODIN = OFF_EVOUT + SZ_MM;
constexpr size_t OFF_ODOUT = OFF_ODIN + (size_t)3072 * D * 2;
constexpr size_t OFF_XB = OFF_ODOUT + SZ_MM;
constexpr size_t OFF_BIG = OFF_XB + (size_t)T * D * 2;
constexpr size_t OFF_MEMB = OFF_BIG + (size_t)T * 3072 * 2;
constexpr size_t OFF_KN = OFF_MEMB + SZ_MM;
constexpr size_t OFF_VT = OFF_KN + 2 * SZ_MM;
constexpr size_t OFF_SSQ = OFF_VT + 2 * SZ_MM;
constexpr size_t OFF_SSQM = OFF_SSQ + (size_t)9 * T * 4;
constexpr size_t OFF_KMAX = OFF_SSQM + 4096;
constexpr size_t OFF_BAR = OFF_KMAX + 256;
constexpr size_t OFF_KF = OFF_BAR + 256;
constexpr size_t WS_NEED = OFF_KF + 2 * SZ_MM;

#ifndef PROBE_MASK
#define PROBE_MASK 0
#endif
constexpr int NTHR = 512;
constexpr int NST = 4;
constexpr int STAGE_B = 32768;
constexpr int OPB = 16384;
constexpr int LDS_BYTES = 131072;

struct Params { const float* in[25]; float* out; char* ws; };

DI unsigned pk2(float a, float b) { f2_t v = {a, b}; bf2_t r = __builtin_convertvector(v, bf2_t); return __builtin_bit_cast(unsigned, r); }
DI float bflo(unsigned w) { return __uint_as_float(w << 16); }
DI float bfhi(unsigned w) { return __uint_as_float(w & 0xffff0000u); }
DI int otid() { int t = threadIdx.x; asm volatile("" : "+v"(t)); return t; }
DI int crow(int i, int h) { return (i & 3) + 8 * (i >> 2) + 4 * h; }
DI float fexp2(float x) { return __builtin_amdgcn_exp2f(x); }
DI float flog2(float x) { return __builtin_amdgcn_logf(x); }

struct WJob { const float* src; bf16_t* dst; const float* gain; int K, N, gu; };

DI int wjob_tiles(int j) {
    if (j < 14) {
        const int kind = j >> 1;
        switch (kind) {
            case 0: case 2: return 16 * 88;
            case 1: case 3: return 44 * 16;
            case 4: return 256;
            case 5: return 512;
            default: return 256;
        }
    }
    if (j == 14) return 16 * 36;
    if (j == 16) return 16 * 48;
    return 256;
}

DI WJob get_wjob(const Params& P, int j) {
    WJob w; w.gain = nullptr; w.gu = 0;
    bf16_t* wsb = (bf16_t*)P.ws;
    if (j < 14) {
        const int kind = j >> 1, l = j & 1;
        switch (kind) {
            case 0: w.src = P.in[3] + (size_t)l * D * NGU; w.dst = (bf16_t*)(P.ws + OFF_GU1 + l * SZ_GU); w.gain = P.in[2] + l * D; w.K = D; w.N = NGU; w.gu = 1; break;
            case 1: w.src = P.in[4] + (size_t)l * DFF * D; w.dst = (bf16_t*)(P.ws + OFF_DN1 + l * SZ_DN); w.K = DFF; w.N = D; w.gu = 2; break;
            case 2: w.src = P.in[23] + (size_t)l * D * NGU; w.dst = (bf16_t*)(P.ws + OFF_GU2 + l * SZ_GU); w.gain = P.in[22] + l * D; w.K = D; w.N = NGU; w.gu = 1; break;
            case 3: w.src = P.in[24] + (size_t)l * DFF * D; w.dst = (bf16_t*)(P.ws + OFF_DN2 + l * SZ_DN); w.K = DFF; w.N = D; w.gu = 2; break;
            case 4: w.src = P.in[17] + (size_t)l * D * D; w.dst = (bf16_t*)(P.ws + OFF_WQ + l * SZ_MM); w.gain = P.in[15] + l * D; w.K = D; w.N = D; w.gu = 2; break;
            case 5: w.src = P.in[18] + (size_t)l * D * 2048; w.dst = (bf16_t*)(P.ws + OFF_WKV + l * 2 * SZ_MM); w.gain = P.in[16] + l * D; w.K = D; w.N = 2048; break;
            default: w.src = P.in[21] + (size_t)l * D * D; w.dst = (bf16_t*)(P.ws + OFF_WO + l * SZ_MM); w.K = D; w.N = D; w.gu = 2; break;
        }
    } else if (j == 14) { w.src = P.in[6]; w.dst = (bf16_t*)(P.ws + OFF_EVIN); w.gain = P.in[5]; w.K = D; w.N = 2304; w.gu = 3; }
    else if (j == 15) { w.src = P.in[10]; w.dst = (bf16_t*)(P.ws + OFF_EVOUT); w.K = D; w.N = D; w.gu = 2; }
    else if (j == 16) { w.src = P.in[11]; w.dst = (bf16_t*)(P.ws + OFF_ODIN); w.gain = P.in[5] + D; w.K = D; w.N = 3072; w.gu = 2; }
    else { w.src = P.in[14]; w.dst = (bf16_t*)(P.ws + OFF_ODOUT); w.K = D; w.N = D; w.gu = 2; }
    (void)wsb;
    return w;
}

DI void wconv_tile(const WJob& w, int t, float* sm, int tid, bool act) {
    const int ntn = w.N >> 6; const int tk = t / ntn, tn = t - tk * ntn;
    if (act) {
#pragma unroll
        for (int p = 0; p < 4; ++p) {
            const int kr = p * 16 + (tid >> 4);
            const float4 v = *(const float4*)(w.src + (size_t)(tk * 64 + kr) * w.N + tn * 64 + (tid & 15) * 4);
            const float g = w.gain ? w.gain[tk * 64 + kr] : 1.f;
            float* sp = sm + kr * 65 + (tid & 15) * 4;
            sp[0] = v.x * g; sp[1] = v.y * g; sp[2] = v.z * g; sp[3] = v.w * g;
        }
    }
    __syncthreads();
    if (act) {
        const int n = tid >> 2, kq = tid & 3; const int ng = tn * 64 + n;
        int drow = ng;
        if (w.gu == 1) drow = ng < DFF ? ((ng >> 7) * 256 + (ng & 127)) : (((ng - DFF) >> 7) * 256 + 128 + ((ng - DFF) & 127));
        else if (w.gu >= 2) {
            int a = ng;
            if (w.gu == 3) a = ng < 512 ? ng : ng < 768 ? ng + 512 : ng < 1280 ? ng - 256 : ng;
            drow = (a & ~255) + (((a >> 5) & 1) << 7) + (((a >> 6) & 3) << 5) + (a & 31);
        }
        unsigned o[8];
#pragma unroll
        for (int e = 0; e < 8; ++e) o[e] = pk2(sm[(kq * 16 + 2 * e) * 65 + n], sm[(kq * 16 + 2 * e + 1) * 65 + n]);
        uint4* dp = (uint4*)(w.dst + (size_t)drow * w.K + tk * 64 + kq * 16);
        dp[0] = make_uint4(o[0], o[1], o[2], o[3]); dp[1] = make_uint4(o[4], o[5], o[6], o[7]);
    }
    __syncthreads();
}

DI float wave_sum(float v) {
    v += __shfl_xor(v, 1); v += __shfl_xor(v, 2); v += __shfl_xor(v, 4); v += __shfl_xor(v, 8); v += __shfl_xor(v, 16); v += __shfl_xor(v, 32);
    return v;
}

DI void rowconv(const float* src, bf16_t* dst, float* ssq, int row, int lane) {
    const float* xr = src + (size_t)row * D;
    float ss = 0.f;
#pragma unroll
    for (int p = 0; p < 4; ++p) {
        const float4 v = *(const float4*)(xr + p * 256 + lane * 4);
        ss += v.x * v.x + v.y * v.y + v.z * v.z + v.w * v.w;
        *(uint2*)(dst + (size_t)row * D + p * 256 + lane * 4) = make_uint2(pk2(v.x, v.y), pk2(v.z, v.w));
    }
    ss = wave_sum(ss);
    if (lane == 0) ssq[row] = ss;
}

DI void phase0(const Params& P, char* smem) {
    const int tid = otid(), lane = tid & 63, wid = tid >> 6;
    float* ssq = (float*)(P.ws + OFF_SSQ);
    for (int i = blockIdx.x * NTHR + tid; i < 8 * T; i += gridDim.x * NTHR) ssq[T + i] = 0.f;
    if (blockIdx.x == 0 && tid < 32) ((unsigned*)(P.ws + OFF_KMAX))[tid] = 0u;
    constexpr int NW = 12352 / 2, NX = T / 8, NM = 1024 / 8;
    for (int u = blockIdx.x; u < NW + NX + NM; u += gridDim.x) {
        if (u < NW) {
            const int half = tid >> 8;
            int t = 2 * u + half, j = 0;
            for (; j < 17; ++j) { const int c = wjob_tiles(j); if (t < c) break; t -= c; }
            const WJob w = get_wjob(P, j);
            wconv_tile(w, t, (float*)smem + half * (64 * 65), tid & 255, true);
        } else if (u < NW + NX) {
            rowconv(P.in[0], (bf16_t*)(P.ws + OFF_XB), ssq, (u - NW) * 8 + wid, lane);
        } else {
            rowconv(P.in[1], (bf16_t*)(P.ws + OFF_MEMB), (float*)(P.ws + OFF_SSQM), (u - NW - NX) * 8 + wid, lane);
        }
    }
}

struct GJob {
    const bf16_t* A; const bf16_t* W;
    int lda, ksplit, kextra, K, ntm, ntn, mode;
    const float* rs;
    bf16_t* O; int ldo;
    const float* xin; float* xout; bf16_t* xb; float* ssq_out; float alpha;
    const float* qg; const float* kg; int qn_end, kn_end;
    bf16_t* vt;
};

typedef __attribute__((address_space(3))) unsigned* ldsu_t;
typedef const __attribute__((address_space(1))) unsigned* glbu_t;
DI void glds16(const bf16_t* g, char* l) { __builtin_amdgcn_global_load_lds((glbu_t)(const void*)g, (ldsu_t)(void*)l, 16, 0, 0); }

DI void gemm_tile(const GJob& J, int t, char* smem, bool dry) {
    const int tid = otid(), lane = tid & 63, wid = tid >> 6, wr = wid >> 2, wc = wid & 3;
    const int r = lane & 31, h = lane >> 5;
    int tm, tn;
    { const int gsz = 32 * J.ntn; const int g = t / gsz; const int rem = t - g * gsz; const int rows = min(32, J.ntm - g * 32); tn = rem / rows; tm = g * 32 + (rem - tn * rows); }
    const int lrow = wid * 16 + (lane >> 2);
    const int csw = ((lane & 3) ^ ((lane >> 4) & 3)) * 8;
    const bf16_t* Ag = J.A + (size_t)(tm * 256 + lrow) * J.lda + csw;
    const bf16_t* Wg = J.W + (size_t)(tn * 256 + lrow) * J.K + csw;
    const size_t astr = (size_t)128 * J.lda, wstr = (size_t)128 * J.K;
    char* lb = smem + tid * 16;
    const int nk = J.K >> 5;
#define GLDS(kt, buf) do { const int k0_ = (kt) * 32; const int ka_ = k0_ + (k0_ >= J.ksplit ? J.kextra : 0); char* l_ = lb + (buf) * STAGE_B; \
        glds16(Ag + ka_, l_); glds16(Ag + astr + ka_, l_ + 8192); glds16(Wg + k0_, l_ + OPB); glds16(Wg + wstr + k0_, l_ + OPB + 8192); } while (0)
    f32x16 acc[4][2];
#pragma unroll
    for (int a = 0; a < 4; ++a)
#pragma unroll
        for (int b = 0; b < 2; ++b)
#pragma unroll
            for (int i = 0; i < 16; ++i) acc[a][b][i] = 0.f;
    const int fr = (r >> 2) & 3;
    const int xrow = (wc * 64 + r) * 64, wrow = OPB + (wr * 128 + r) * 64;
    const int co0 = ((0 + h) ^ fr) * 16, co1 = ((2 + h) ^ fr) * 16;

    __syncthreads();
    GLDS(0, 0); GLDS(1, 1); GLDS(2, 2);
    asm volatile("s_waitcnt vmcnt(8)" ::: "memory");
    __builtin_amdgcn_s_barrier();
    bf16x8 w0[4], x0[2], w1[4], x1[2];
#define LOADF(W_, X_, sb_, co_) do { _Pragma("unroll") for (int ti = 0; ti < 2; ++ti) X_[ti] = *(const bf16x8*)((sb_) + xrow + ti * 2048 + (co_)); \
        _Pragma("unroll") for (int fi = 0; fi < 4; ++fi) W_[fi] = *(const bf16x8*)((sb_) + wrow + fi * 2048 + (co_)); } while (0)
#define MFMA8(W_, X_) do { __builtin_amdgcn_s_setprio(1); _Pragma("unroll") for (int fi = 0; fi < 4; ++fi) _Pragma("unroll") for (int ti = 0; ti < 2; ++ti) \
        acc[fi][ti] = MFMA(W_[fi], X_[ti], acc[fi][ti]); __builtin_amdgcn_s_setprio(0); } while (0)
    LOADF(w0, x0, smem, co0);
    __builtin_amdgcn_s_waitcnt(0xC07F);
    int buf = 0;
    for (int kt = 0; kt < nk; ++kt) {
        const char* sb = smem + buf * STAGE_B;
        LOADF(w1, x1, sb, co1);
        __builtin_amdgcn_sched_barrier(0);
        MFMA8(w0, x0);
        __builtin_amdgcn_s_waitcnt(0xC07F);
        __builtin_amdgcn_sched_barrier(0);
        const int nb = (buf + 1 == NST) ? 0 : buf + 1;
        if (kt + 1 < nk) {
            if (kt + 2 < nk) asm volatile("s_waitcnt vmcnt(4)" ::: "memory"); else asm volatile("s_waitcnt vmcnt(0)" ::: "memory");
            __builtin_amdgcn_s_barrier();
            if (kt + 3 < nk) { const int fb_ = (buf + 3 >= NST) ? buf + 3 - NST : buf + 3; GLDS(kt + 3, fb_); }
        }
        LOADF(w0, x0, smem + nb * STAGE_B, co0);
        __builtin_amdgcn_sched_barrier(0);
        MFMA8(w1, x1);
        __builtin_amdgcn_s_waitcnt(0xC07F);
        __builtin_amdgcn_sched_barrier(0);
        buf = nb;
    }
#undef LOADF
#undef MFMA8
#undef GLDS
    __syncthreads();

    if (dry) { if (acc[0][0][0] + acc[1][1][0] + acc[2][0][0] + acc[3][1][0] == 12345.678f) J.O[0] = 1; return; }
    const int tokb = tm * 256 + wc * 64;
    const int fb = tn * 256 + wr * 128;
    float rsc[2];
#pragma unroll
    for (int ti = 0; ti < 2; ++ti) rsc[ti] = J.rs ? __builtin_amdgcn_rsqf(J.rs[tokb + ti * 32 + r] * (1.f / 1024.f) + EPS) : 1.f;

    if (J.mode == 3 && fb >= 1024) {
#pragma unroll
        for (int ti = 0; ti < 2; ++ti) {
            const int tok = tokb + ti * 32 + r;
#pragma unroll
            for (int fi = 0; fi < 4; ++fi)
#pragma unroll
                for (int i = 0; i < 16; ++i) {
                    const int f = fb - 1024 + fi * 32 + crow(i, h);
                    const int bh_ = (tok >> 8) * 4 + (f >> 8), d_ = f & 255, key_ = tok & 255, k16 = key_ & 15;
                    const int ln_ = ((k16 >> 2) & 1) * 32 + (d_ & 31), e_ = ((k16 >> 3) << 2) | (k16 & 3);
                    J.vt[((((((size_t)bh_ * 8 + (d_ >> 5)) * 8 + (key_ >> 5)) * 2 + ((key_ >> 4) & 1)) * 64 + ln_) << 3) + e_] = (bf16_t)(pk2(acc[fi][ti][i] * rsc[ti], 0.f) & 0xffffu);
                }
        }
        return;
    }
    char* wl = smem + wid * 16384;
#pragma unroll
    for (int ti = 0; ti < 2; ++ti) {
#pragma unroll
        for (int fp = 0; fp < 2; ++fp) {
            const float sc = (J.mode == 1) ? J.alpha : rsc[ti];
#pragma unroll
            for (int fi2 = 0; fi2 < 2; ++fi2)
#pragma unroll
                for (int g = 0; g < 4; ++g) {
                    float4 v;
                    v.x = acc[2 * fp + fi2][ti][4 * g + 0] * sc; v.y = acc[2 * fp + fi2][ti][4 * g + 1] * sc;
                    v.z = acc[2 * fp + fi2][ti][4 * g + 2] * sc; v.w = acc[2 * fp + fi2][ti][4 * g + 3] * sc;
                    *(float4*)(wl + r * 272 + (fi2 * 32 + 8 * g + 4 * h) * 4) = v;
                }
            const int tok0 = tokb + ti * 32, f0 = fb + fp * 64;
            if (J.mode == 0) {
                const int c4 = (lane & 7) * 4;
#pragma unroll
                for (int p = 0; p < 4; ++p) {
                    const int row = p * 8 + (lane >> 3);
                    const float4 ga = *(const float4*)(wl + row * 272 + c4 * 4);
                    const float4 up = *(const float4*)(wl + row * 272 + (32 + c4) * 4);
                    float y0 = ga.x * up.x * __builtin_amdgcn_rcpf(1.f + fexp2(-ga.x * LOG2E));
                    float y1 = ga.y * up.y * __builtin_amdgcn_rcpf(1.f + fexp2(-ga.y * LOG2E));
                    float y2 = ga.z * up.z * __builtin_amdgcn_rcpf(1.f + fexp2(-ga.z * LOG2E));
                    float y3 = ga.w * up.w * __builtin_amdgcn_rcpf(1.f + fexp2(-ga.w * LOG2E));
                    *(uint2*)(J.O + (size_t)(tok0 + row) * J.ldo + (f0 >> 1) + c4) = make_uint2(pk2(y0, y1), pk2(y2, y3));
                }
            } else if (J.mode == 1) {
                const int c4 = (lane & 15) * 4;
#pragma unroll
                for (int p = 0; p < 8; ++p) {
                    const int row = p * 4 + (lane >> 4);
                    const size_t tok = tok0 + row;
                    const float4 v = *(const float4*)(wl + row * 272 + c4 * 4);
                    const float4 xo = *(const float4*)(J.xin + tok * D + f0 + c4);
                    float4 xn; xn.x = xo.x + v.x; xn.y = xo.y + v.y; xn.z = xo.z + v.z; xn.w = xo.w + v.w;
                    *(float4*)(J.xout + tok * D + f0 + c4) = xn;
                    if (J.xb) {
                        *(uint2*)(J.xb + tok * D + f0 + c4) = make_uint2(pk2(xn.x, xn.y), pk2(xn.z, xn.w));
                        float ss = xn.x * xn.x + xn.y * xn.y + xn.z * xn.z + xn.w * xn.w;
                        ss += __shfl_xor(ss, 1); ss += __shfl_xor(ss, 2); ss += __shfl_xor(ss, 4); ss += __shfl_xor(ss, 8);
                        if ((lane & 15) == 0) atomicAdd(J.ssq_out + tok, ss);
                    }
                }
            } else {
                const int nm = f0 < J.qn_end ? 1 : (f0 < J.kn_end ? 2 : 0);
                const float* gp = nm == 1 ? J.qg : J.kg;
                const int c4 = (lane & 15) * 4;
                float4 gn = make_float4(1.f, 1.f, 1.f, 1.f);
                if (nm) gn = *(const float4*)(gp + c4);
#pragma unroll
                for (int p = 0; p < 8; ++p) {
                    const int row = p * 4 + (lane >> 4);
                    float4 v = *(const float4*)(wl + row * 272 + c4 * 4);
                    if (nm) {
                        float ss = v.x * v.x + v.y * v.y + v.z * v.z + v.w * v.w;
                        ss += __shfl_xor(ss, 1); ss += __shfl_xor(ss, 2); ss += __shfl_xor(ss, 4); ss += __shfl_xor(ss, 8);
                        const float inv = __builtin_amdgcn_rsqf(ss * (1.f / 64.f) + EPS);
                        v.x *= inv * gn.x; v.y *= inv * gn.y; v.z *= inv * gn.z; v.w *= inv * gn.w;
                    }
                    *(uint2*)(J.O + (size_t)(tok0 + row) * J.ldo + f0 + c4) = make_uint2(pk2(v.x, v.y), pk2(v.z, v.w));
                }
            }
        }
    }
}

DI void gemm_phase(const GJob& JA, int nA, int nB, const Params& P, char* smem, bool dry) {
    for (int u = blockIdx.x; u < nA + nB; u += gridDim.x) {
        GJob J = JA; int t = u;
        if (u >= nA) {
            const int v = u - nA; const int layer = v >> 5; t = v & 31;
            J.A = (const bf16_t*)(P.ws + OFF_MEMB); J.lda = D; J.ksplit = 1 << 30; J.kextra = 0;
            J.W = (const bf16_t*)(P.ws + OFF_WKV + (size_t)layer * 2 * SZ_MM); J.K = D; J.ntm = 4; J.ntn = 8; J.mode = 3;
            J.rs = (const float*)(P.ws + OFF_SSQM); J.O = (bf16_t*)(P.ws + OFF_KN + (size_t)layer * SZ_MM); J.ldo = D;
            J.qn_end = 0; J.kn_end = 0; J.vt = (bf16_t*)(P.ws + OFF_VT + (size_t)layer * SZ_MM);
        }
        gemm_tile(J, t, smem, dry);
    }
}

namespace pg8 {
#define PG8_LAS __attribute__((address_space(3)))
typedef float f32x4 __attribute__((ext_vector_type(4)));
typedef unsigned u32x4 __attribute__((ext_vector_type(4)));
constexpr int BM = 256, BK = 64, HALF = 128, HTB = HALF * BK * 2, STAGE_BYTES = 8 * HTB, NXCD = 8, WGM = 8;
DI int lds_byte(int r, int c) { const int st = (r >> 4) * 2 + (c >> 5), rr = r & 15, cc = c & 31, ob = rr * 64 + cc * 2; return st * 1024 + (ob ^ (((ob >> 9) & 1) << 5)); }
DI void stage_rc(int b, int& R, int& C) { const int st = b / 1024, sb = b % 1024, swz = sb ^ (((sb >> 9) & 1) << 5); R = (st >> 1) * 16 + swz / 64; C = (st & 1) * 32 + (swz % 64) / 2; }
DI int perm32(int rho) { const int n = rho >> 4, i = rho & 15; return 8 * (i >> 2) + 4 * n + (i & 3); }
struct Unit { int pm, pn; };
struct Gemm { const bf16_t* A; const bf16_t* Bt; int M, N, K, lda; };
struct StaticOrder {
    int nM, nN, nwg, G, c;
    DI void init(int M, int N, int G_, int c_) { nM = M / BM; nN = N / BM; nwg = nM * nN; G = G_; c = c_; }
    DI bool next(int i, Unit& u) const {
        const long L = (long)i * G + c; if (L >= nwg) return false;
        int wgid = (int)L; { const int q = nwg / NXCD, r = nwg % NXCD, xcd = wgid % NXCD, off = wgid / NXCD; wgid = (xcd < r ? xcd * (q + 1) : r * (q + 1) + (xcd - r) * q) + off; }
        const int nig = WGM * nN, gid = wgid / nig, fm = gid * WGM, gsz = (nM - fm) < WGM ? (nM - fm) : WGM;
        u.pm = fm + ((wgid % nig) % gsz); u.pn = (wgid % nig) / gsz; return true;
    }
    DI void a_ready(const Unit&) const {}
    DI void done(const Unit&) const {}
};

struct Epi {
    static constexpr bool PERM = true, AFTER_DRAIN = false;
    int mode;
    const float* rs;
    bf16_t* O; int ldo;
    const float* xin; float* xout; bf16_t* xb; float* ssq_out; float alpha;
    const float* qg; const float* kg; int qn_end, kn_beg, kn_end;
    DI void operator()(const f32x4 (&acc)[2][2][4][2], const Unit& u, int wr, int wc, int fr, int fq) const {
        const int row0 = u.pm * BM + wr * 64 + fr;
        if (mode == 0) {
            const int col = u.pn * 128 + wc * 32 + 8 * fq;
#pragma unroll
            for (int ai = 0; ai < 2; ++ai)
#pragma unroll
                for (int m = 0; m < 4; ++m) {
                    const size_t tok = row0 + ai * HALF + m * 16;
                    const float sc = __builtin_amdgcn_rsqf(rs[tok] * (1.f / 1024.f) + EPS);
                    float y[8];
#pragma unroll
                    for (int n = 0; n < 2; ++n)
#pragma unroll
                        for (int j = 0; j < 4; ++j) {
                            const float ga = acc[ai][0][m][n][j] * sc, up = acc[ai][1][m][n][j] * sc;
                            y[4 * n + j] = ga * up * __builtin_amdgcn_rcpf(1.f + fexp2(-ga * LOG2E));
                        }
                    *(uint4*)(O + tok * ldo + col) = make_uint4(pk2(y[0], y[1]), pk2(y[2], y[3]), pk2(y[4], y[5]), pk2(y[6], y[7]));
                }
        } else if (mode == 1) {
#pragma unroll
            for (int ai = 0; ai < 2; ++ai)
#pragma unroll
                for (int m = 0; m < 4; ++m) {
                    const size_t tok = row0 + ai * HALF + m * 16;
                    float ss = 0.f;
#pragma unroll
                    for (int bj = 0; bj < 2; ++bj) {
                        const int col = u.pn * BM + wc * 64 + bj * 32 + 8 * fq;
                        const float4 x0 = *(const float4*)(xin + tok * D + col), x1 = *(const float4*)(xin + tok * D + col + 4);
                        float4 n0, n1;
                        n0.x = x0.x + alpha * acc[ai][bj][m][0][0]; n0.y = x0.y + alpha * acc[ai][bj][m][0][1]; n0.z = x0.z + alpha * acc[ai][bj][m][0][2]; n0.w = x0.w + alpha * acc[ai][bj][m][0][3];
                        n1.x = x1.x + alpha * acc[ai][bj][m][1][0]; n1.y = x1.y + alpha * acc[ai][bj][m][1][1]; n1.z = x1.z + alpha * acc[ai][bj][m][1][2]; n1.w = x1.w + alpha * acc[ai][bj][m][1][3];
                        *(float4*)(xout + tok * D + col) = n0; *(float4*)(xout + tok * D + col + 4) = n1;
                        if (xb) {
                            *(uint4*)(xb + tok * D + col) = make_uint4(pk2(n0.x, n0.y), pk2(n0.z, n0.w), pk2(n1.x, n1.y), pk2(n1.z, n1.w));
                            ss += n0.x * n0.x + n0.y * n0.y + n0.z * n0.z + n0.w * n0.w + n1.x * n1.x + n1.y * n1.y + n1.z * n1.z + n1.w * n1.w;
                        }
                    }
                    if (xb) {
                        ss += __shfl_xor(ss, 16); ss += __shfl_xor(ss, 32);
                        if (fq == 0) atomicAdd(ssq_out + tok, ss);
                    }
                }
        } else {
            const int f0 = u.pn * BM + wc * 64;
            const int nm = f0 < qn_end ? 1 : ((f0 >= kn_beg && f0 < kn_end) ? 2 : 0);
            const float* gp = nm == 1 ? qg : kg;
            float4 g4[2][2];
#pragma unroll
            for (int bj = 0; bj < 2; ++bj)
#pragma unroll
                for (int n = 0; n < 2; ++n) g4[bj][n] = nm ? *(const float4*)(gp + bj * 32 + 8 * fq + 4 * n) : make_float4(1.f, 1.f, 1.f, 1.f);
#pragma unroll
            for (int ai = 0; ai < 2; ++ai)
#pragma unroll
                for (int m = 0; m < 4; ++m) {
                    const size_t tok = row0 + ai * HALF + m * 16;
                    float sc = rs ? __builtin_amdgcn_rsqf(rs[tok] * (1.f / 1024.f) + EPS) : 1.f;
                    if (nm) {
                        float ss = 0.f;
#pragma unroll
                        for (int bj = 0; bj < 2; ++bj)
#pragma unroll
                            for (int n = 0; n < 2; ++n)
#pragma unroll
                                for (int j = 0; j < 4; ++j) { const float v = acc[ai][bj][m][n][j] * sc; ss += v * v; }
                        ss += __shfl_xor(ss, 16); ss += __shfl_xor(ss, 32);
                        sc *= __builtin_amdgcn_rsqf(ss * (1.f / 64.f) + EPS);
                    }
#pragma unroll
                    for (int bj = 0; bj < 2; ++bj) {
                        const f32x4 a0 = acc[ai][bj][m][0], a1 = acc[ai][bj][m][1];
                        *(uint4*)(O + tok * ldo + f0 + bj * 32 + 8 * fq) =
                            make_uint4(pk2(a0[0] * sc * g4[bj][0].x, a0[1] * sc * g4[bj][0].y), pk2(a0[2] * sc * g4[bj][0].z, a0[3] * sc * g4[bj][0].w),
                                       pk2(a1[0] * sc * g4[bj][1].x, a1[1] * sc * g4[bj][1].y), pk2(a1[2] * sc * g4[bj][1].z, a1[3] * sc * g4[bj][1].w));
                    }
                }
        }
    }
};

template <class Epi, class Sched, bool ALIGN_EPI = false, bool SP2 = false>
__device__ __forceinline__ void gemm_phase(PG8_LAS unsigned char* lds, const Gemm g, const Sched& S, const Epi& E) {
    const int tid = otid(), wid = __builtin_amdgcn_readfirstlane(tid >> 6), lane = tid & 63, wr = wid >> 2, wc = wid & 3, fr = lane & 15, fq = lane >> 4;
    const int K = g.K, nt = K / BK;
    unsigned voffA[2], voffB[2];
#pragma unroll
    for (int i = 0; i < 2; ++i) { int R, C; stage_rc(tid * 16 + i * 8192, R, C); const int Rb = Epi::PERM ? ((R & ~31) + perm32(R & 31)) : R;
        voffA[i] = (unsigned)(R * g.lda + C) * 2u; voffB[i] = (unsigned)(Rb * K + C) * 2u; }
    const size_t kstep = (size_t)(BK * 2);
    const size_t hstepA = (size_t)HALF * g.lda * 2, hstepB = (size_t)HALF * K * 2;
    const size_t tstepA = 2 * hstepA, tstepB = 2 * hstepB;
    const unsigned ldsw = (unsigned)wid * 1024u;
    const int aoff = lds_byte(wr * 64 + fr, fq * 8), boff = lds_byte(wc * 32 + fr, fq * 8);
#define PG8_SA(b, h) (((b) * 2 + (h)) * HTB)
#define PG8_SB(b, h) ((4 + (b) * 2 + (h)) * HTB)
#define PG8_STAGE(bufoff, gbase, voff) do { _Pragma("unroll") for (int _i = 0; _i < 2; ++_i) \
        __builtin_amdgcn_global_load_lds((const unsigned*)((const char*)(gbase) + (voff)[_i]), (PG8_LAS unsigned*)(lds + (bufoff) + ldsw + _i * 8192), 16, 0, 0); } while (0)
#define PG8_LDA(dst, b, h) do { _Pragma("unroll") for (int m = 0; m < 4; ++m) _Pragma("unroll") for (int k = 0; k < 2; ++k) dst[m][k] = *(const PG8_LAS bf16x8*)(lds + PG8_SA(b, h) + aoff + m * 2048 + k * 1024); } while (0)
#define PG8_LDB(dst, b, h) do { _Pragma("unroll") for (int n = 0; n < 2; ++n) _Pragma("unroll") for (int k = 0; k < 2; ++k) dst[n][k] = *(const PG8_LAS bf16x8*)(lds + PG8_SB(b, h) + boff + n * 2048 + k * 1024); } while (0)
#define PG8_MMA(ai, bj, At, Bt) do { __builtin_amdgcn_s_setprio(1); _Pragma("unroll") for (int m = 0; m < 4; ++m) _Pragma("unroll") for (int n = 0; n < 2; ++n) _Pragma("unroll") for (int k = 0; k < 2; ++k) \
        acc[ai][bj][m][n] = __builtin_amdgcn_mfma_f32_16x16x32_bf16(Bt[n][k], At[m][k], acc[ai][bj][m][n], 0, 0, 0); __builtin_amdgcn_s_setprio(0); } while (0)
#define PG8_WAIT_V(n) asm volatile("s_waitcnt vmcnt(" #n ")" ::: "memory")
#define PG8_WAIT_L(n) asm volatile("s_waitcnt lgkmcnt(" #n ")" ::: "memory")
#define PG8_BAR __builtin_amdgcn_s_barrier()
#define PG8_SCHED __builtin_amdgcn_sched_barrier(0)
    Unit cur, nxt; int ui = 0;
    if (!S.next(0, cur)) return;
    f32x4 acc[2][2][4][2];
#pragma unroll
    for (int a = 0; a < 2; ++a)
#pragma unroll
        for (int b = 0; b < 2; ++b)
#pragma unroll
            for (int m = 0; m < 4; ++m)
#pragma unroll
                for (int n = 0; n < 2; ++n) acc[a][b][m][n] = (f32x4){0.f, 0.f, 0.f, 0.f};
    bf16x8 At[4][2], B0[2][2], B1[2][2];
    const char* cA = (const char*)g.A + (size_t)cur.pm * tstepA; const char* cB = (const char*)g.Bt + (size_t)cur.pn * tstepB;
    S.a_ready(cur);
    if constexpr (SP2) {
        PG8_STAGE(PG8_SB(0, 0), cB, voffB); PG8_STAGE(PG8_SB(0, 1), cB + hstepB, voffB); PG8_STAGE(PG8_SA(0, 0), cA, voffA); PG8_STAGE(PG8_SA(0, 1), cA + hstepA, voffA);
        if (wr == 1) PG8_BAR;
        PG8_WAIT_V(2); PG8_BAR;
        PG8_STAGE(PG8_SB(1, 0), cB + kstep, voffB); PG8_STAGE(PG8_SA(1, 0), cA + kstep, voffA); PG8_STAGE(PG8_SB(1, 1), cB + hstepB + kstep, voffB);
        PG8_WAIT_V(6); PG8_BAR;
    } else {
        PG8_STAGE(PG8_SB(0, 0), cB, voffB); PG8_STAGE(PG8_SA(0, 0), cA, voffA); PG8_STAGE(PG8_SB(0, 1), cB + hstepB, voffB); PG8_STAGE(PG8_SA(0, 1), cA + hstepA, voffA);
        if (wr == 1) PG8_BAR;
        PG8_WAIT_V(4); PG8_BAR;
        PG8_STAGE(PG8_SB(1, 0), cB + kstep, voffB); PG8_STAGE(PG8_SA(1, 0), cA + kstep, voffA); PG8_STAGE(PG8_SB(1, 1), cB + hstepB + kstep, voffB);
        PG8_WAIT_V(6); PG8_BAR;
    }
    for (;;) {
        const bool has_next = S.next(ui + 1, nxt);
        const char* nA = has_next ? (const char*)g.A + (size_t)nxt.pm * tstepA : cA; const char* nB = has_next ? (const char*)g.Bt + (size_t)nxt.pn * tstepB : cB;
        for (int t = 0; t < nt; t += 2) {
            const bool last = (t == nt - 2);
            const char* a1 = cA + (size_t)(t + 1) * kstep;
            const char* a2 = last ? nA : cA + (size_t)(t + 2) * kstep; const char* b2 = last ? nB : cB + (size_t)(t + 2) * kstep;
            const char* a3 = a2 + kstep; const char* b3 = b2 + kstep;
            if (last && has_next) S.a_ready(nxt);
            if constexpr (SP2) {
            PG8_LDB(B0, 0, 0); PG8_LDB(B1, 0, 1); PG8_SCHED; PG8_LDA(At, 0, 0); PG8_STAGE(PG8_SA(1, 1), a1 + hstepA, voffA);
            PG8_WAIT_V(8); PG8_WAIT_L(0); PG8_BAR; PG8_MMA(0, 0, At, B0); PG8_MMA(0, 1, At, B1); PG8_BAR; PG8_SCHED;
            PG8_LDA(At, 0, 1); PG8_STAGE(PG8_SB(0, 0), b2, voffB); PG8_STAGE(PG8_SB(0, 1), b2 + hstepB, voffB); PG8_STAGE(PG8_SA(0, 0), a2, voffA);
            PG8_WAIT_V(8); PG8_WAIT_L(0); PG8_BAR; PG8_MMA(1, 0, At, B0); PG8_MMA(1, 1, At, B1); PG8_BAR; PG8_SCHED;
            PG8_LDB(B0, 1, 0); PG8_LDB(B1, 1, 1); PG8_SCHED; PG8_LDA(At, 1, 0); PG8_STAGE(PG8_SA(0, 1), a2 + hstepA, voffA);
            PG8_WAIT_V(8); PG8_WAIT_L(0); PG8_BAR; PG8_MMA(0, 0, At, B0); PG8_MMA(0, 1, At, B1); PG8_BAR; PG8_SCHED;
            PG8_LDA(At, 1, 1); PG8_STAGE(PG8_SB(1, 0), b3, voffB); PG8_STAGE(PG8_SB(1, 1), b3 + hstepB, voffB); PG8_STAGE(PG8_SA(1, 0), a3, voffA);
            PG8_WAIT_V(8); PG8_WAIT_L(0); PG8_BAR; PG8_MMA(1, 0, At, B0); PG8_MMA(1, 1, At, B1); PG8_BAR; PG8_SCHED;
            } else {
            PG8_LDB(B0, 0, 0); PG8_SCHED; PG8_LDA(At, 0, 0); PG8_STAGE(PG8_SA(1, 1), a1 + hstepA, voffA);
            PG8_WAIT_L(8); PG8_BAR; PG8_WAIT_L(0); PG8_MMA(0, 0, At, B0); PG8_BAR; PG8_SCHED;
            PG8_LDB(B1, 0, 1); PG8_STAGE(PG8_SB(0, 0), b2, voffB);
            PG8_BAR; PG8_WAIT_L(0); PG8_MMA(0, 1, At, B1); PG8_BAR;
            PG8_LDA(At, 0, 1); PG8_STAGE(PG8_SA(0, 0), a2, voffA);
            PG8_BAR; PG8_WAIT_L(0); PG8_MMA(1, 0, At, B0); PG8_BAR; PG8_SCHED;
            PG8_STAGE(PG8_SB(0, 1), b2 + hstepB, voffB);
            PG8_WAIT_V(6); PG8_BAR; PG8_MMA(1, 1, At, B1); PG8_BAR;
            PG8_LDB(B0, 1, 0); PG8_SCHED; PG8_LDA(At, 1, 0); PG8_STAGE(PG8_SA(0, 1), a2 + hstepA, voffA);
            PG8_WAIT_L(8); PG8_BAR; PG8_WAIT_L(0); PG8_MMA(0, 0, At, B0); PG8_BAR; PG8_SCHED;
            PG8_LDB(B1, 1, 1); PG8_STAGE(PG8_SB(1, 0), b3, voffB);
            PG8_BAR; PG8_WAIT_L(0); PG8_MMA(0, 1, At, B1); PG8_BAR;
            PG8_LDA(At, 1, 1); PG8_STAGE(PG8_SA(1, 0), a3, voffA);
            PG8_BAR; PG8_WAIT_L(0); PG8_MMA(1, 0, At, B0); PG8_BAR; PG8_SCHED;
            PG8_STAGE(PG8_SB(1, 1), b3 + hstepB, voffB);
            PG8_WAIT_V(6); PG8_BAR; PG8_MMA(1, 1, At, B1); PG8_BAR;
            }
        }
        if constexpr (ALIGN_EPI) { if (wr == 0) PG8_BAR; }
        if constexpr (!Epi::AFTER_DRAIN) { E(acc, cur, wr, wc, fr, fq); S.done(cur); }
        if (!has_next) break;
#pragma unroll
        for (int a = 0; a < 2; ++a)
#pragma unroll
            for (int b = 0; b < 2; ++b)
#pragma unroll
                for (int m = 0; m < 4; ++m)
#pragma unroll
                    for (int n = 0; n < 2; ++n) acc[a][b][m][n] = (f32x4){0.f, 0.f, 0.f, 0.f};
        cur = nxt; cA = nA; cB = nB; ++ui;
        if constexpr (ALIGN_EPI) { if (wr == 1) PG8_BAR; }
    }
    PG8_WAIT_V(0);
    if constexpr (!ALIGN_EPI) { if (wr == 0) PG8_BAR; }
    PG8_BAR;
    if constexpr (Epi::AFTER_DRAIN) { E.fused(acc, cur, wr, wc, fr, fq, lds, wid, lane); S.done(cur); }
#undef PG8_SA
#undef PG8_SB
#undef PG8_STAGE
#undef PG8_LDA
#undef PG8_LDB
#undef PG8_MMA
#undef PG8_WAIT_V
#undef PG8_WAIT_L
#undef PG8_BAR
#undef PG8_SCHED
}
}

#define KV_DECL uint4 rk0, rk1, rk2, rk3, rv0, rv1, rv2, rv3
#define KV_LOAD(kb_, dil_) do { const int kk_ = lane >> 3; \
    const bf16_t* p0_ = qkv + (rowb + min(max((kb_) + (dil_) * kk_, 0), S - 1)) * ld + (lane & 7) * 8; \
    const bf16_t* p1_ = qkv + (rowb + min(max((kb_) + (dil_) * (kk_ + 8), 0), S - 1)) * ld + (lane & 7) * 8; \
    const bf16_t* p2_ = qkv + (rowb + min(max((kb_) + (dil_) * (kk_ + 16), 0), S - 1)) * ld + (lane & 7) * 8; \
    const bf16_t* p3_ = qkv + (rowb + min(max((kb_) + (dil_) * (kk_ + 24), 0), S - 1)) * ld + (lane & 7) * 8; \
    rk0 = *(const uint4*)(p0_ + kcol); rk1 = *(const uint4*)(p1_ + kcol); rk2 = *(const uint4*)(p2_ + kcol); rk3 = *(const uint4*)(p3_ + kcol); \
    rv0 = *(const uint4*)(p0_ + vcol); rv1 = *(const uint4*)(p1_ + vcol); rv2 = *(const uint4*)(p2_ + vcol); rv3 = *(const uint4*)(p3_ + vcol); } while (0)
#define KV_STORE() do { char* wp_ = vl + (lane >> 3) * 144 + (lane & 7) * 16; \
    *(uint4*)(wp_) = rk0; *(uint4*)(wp_ + 8 * 144) = rk1; *(uint4*)(wp_ + 16 * 144) = rk2; *(uint4*)(wp_ + 24 * 144) = rk3; \
    *(uint4*)(wp_ + 4608) = rv0; *(uint4*)(wp_ + 4608 + 8 * 144) = rv1; *(uint4*)(wp_ + 4608 + 16 * 144) = rv2; *(uint4*)(wp_ + 4608 + 24 * 144) = rv3; } while (0)

DI bf16x8 v_frag(const char* vbase, int s, int dt) {
    typedef __attribute__((address_space(3))) v4i16_t* lp_t;
    const char* a = vbase + s * (16 * 144) + dt * 64;
    const s16x4 lo = __builtin_bit_cast(s16x4, __builtin_amdgcn_ds_read_tr16_b64_v4i16((lp_t)(a)));
    const s16x4 hi = __builtin_bit_cast(s16x4, __builtin_amdgcn_ds_read_tr16_b64_v4i16((lp_t)(a + 8 * 144)));
    return __builtin_shufflevector(lo, hi, 0, 1, 2, 3, 4, 5, 6, 7);
}

template <int OFF> DI bf16x8 pack8v(const f32x16& p) {
    typedef unsigned u32x4 __attribute__((ext_vector_type(4)));
    u32x4 w; w[0] = pk2(p[OFF + 0], p[OFF + 1]); w[1] = pk2(p[OFF + 2], p[OFF + 3]); w[2] = pk2(p[OFF + 4], p[OFF + 5]); w[3] = pk2(p[OFF + 6], p[OFF + 7]);
    return __builtin_bit_cast(bf16x8, w);
}

DI void win_attn_wave(bf16_t* qkv, int ld, int b, int qcol, int kcol, int vcol, int tq0, int qstride,
                      float slope2, float m_init, float l_init, int mode, char* vl, int lane, bool dry) {
    const int r = lane & 31, h = lane >> 5;
    const size_t rowb = (size_t)b * S;
    const int tq = tq0 + qstride * r;
    const int tqlast = tq0 + qstride * 31;
    bf16x8 qf[4];
    {
        const bf16_t* qp = qkv + (rowb + tq) * ld + qcol + h * 32;
#pragma unroll
        for (int ks = 0; ks < 4; ++ks) qf[ks] = *(const bf16x8*)(qp + ks * 8);
    }
    f32x16 o0, o1;
#pragma unroll
    for (int i = 0; i < 16; ++i) { o0[i] = 0.f; o1[i] = 0.f; }
    float m = m_init, l = (h == 0) ? l_init : 0.f;
    const float sc2 = 0.125f * LOG2E;
    const int i16 = lane & 15;
    const char* vbase = vl + 4608 + (4 * h + (i16 >> 2)) * 144 + (16 * ((lane >> 4) & 1) + 4 * (i16 & 3)) * 2;
    const int npat = mode ? 3 : 1;
    const char* kfp = vl + r * 144 + h * 64;
    KV_DECL;
    for (int pi = 0; pi < npat; ++pi) {
        int dil, W, kfirst, nt;
        if (!mode) { dil = 1; W = 127; kfirst = tq0 - 128; nt = 5; }
        else if (pi == 0) { dil = 1; W = 128; kfirst = tq0 - 128; nt = 20; }
        else if (pi == 1) { dil = 4; W = 512; kfirst = tq0 - 512; nt = 8; }
        else { dil = 16; W = 2048; kfirst = tq0 - 2048; nt = 5; }
        const int step = 32 * dil;
        int t0 = 0;
        { const int need = -kfirst - 31 * dil; if (need > 0) t0 = (need + step - 1) / step; }
        if (t0 >= nt) continue;
        KV_LOAD(kfirst + t0 * step, dil);
        for (int tile = t0; tile < nt; ++tile) {
            const int kb = kfirst + tile * step;
            KV_STORE();
            asm volatile("" ::: "memory");
            if (tile + 1 < nt) KV_LOAD(kb + step, dil);
            f32x16 s;
#pragma unroll
            for (int i = 0; i < 16; ++i) s[i] = 0.f;
#pragma unroll
            for (int ks = 0; ks < 4; ++ks) s = MFMA(*(const bf16x8*)(kfp + ks * 16), qf[ks], s);
            f32x16 sv; float mloc = -INFINITY;
            const int d0 = tq - kb - 4 * h * dil;
            const unsigned wlim = (unsigned)min(W, tq);
#pragma unroll
            for (int i = 0; i < 16; ++i) {
                const int diff = d0 - dil * crow(i, 0);
                const float sb = s[i] * sc2 - slope2 * (float)diff;
                sv[i] = ((unsigned)diff <= wlim) ? sb : -INFINITY;
                mloc = fmaxf(mloc, sv[i]);
            }
            mloc = fmaxf(mloc, __shfl_xor(mloc, 32));
            const float mn = fmaxf(m, mloc);
            float ps = 0.f;
#pragma unroll
            for (int i = 0; i < 16; ++i) { sv[i] = fexp2(sv[i] - mn); ps += sv[i]; }
            if (__builtin_amdgcn_ballot_w64(mn != m) != 0) {
                const float alpha = fexp2(m - mn);
                l *= alpha;
#pragma unroll
                for (int i = 0; i < 16; ++i) { o0[i] *= alpha; o1[i] *= alpha; }
                m = mn;
            }
            l += ps;
            const bf16x8 p0 = pack8v<0>(sv), p1 = pack8v<8>(sv);
            o0 = MFMA(v_frag(vbase, 0, 0), p0, o0);
            o0 = MFMA(v_frag(vbase, 1, 0), p1, o0);
            o1 = MFMA(v_frag(vbase, 0, 1), p0, o1);
            o1 = MFMA(v_frag(vbase, 1, 1), p1, o1);
            asm volatile("" ::: "memory");
        }
    }
    const float lt = l + __shfl_xor(l, 32);
    const float inv = 1.f / lt;
    if (dry) { if (o0[0] + o1[0] + lt == 12345.678f) qkv[0] = 1; return; }
    bf16_t* op = qkv + (rowb + tq) * ld + qcol + 4 * h;
#pragma unroll
    for (int g = 0; g < 4; ++g) {
        *(uint2*)(op + 8 * g) = make_uint2(pk2(o0[4 * g] * inv, o0[4 * g + 1] * inv), pk2(o0[4 * g + 2] * inv, o0[4 * g + 3] * inv));
        *(uint2*)(op + 32 + 8 * g) = make_uint2(pk2(o1[4 * g] * inv, o1[4 * g + 1] * inv), pk2(o1[4 * g + 2] * inv, o1[4 * g + 3] * inv));
    }
}

DI void stick_wave(bf16_t* qkv, int ld, int b, int qcol, int kcol, int vcol, int qt, char* vl, int lane, bool dry) {
    const int r = lane & 31, h = lane >> 5;
    const size_t rowb = (size_t)b * S;
    const int tq = qt * 32 + r;
    bf16x8 qf[4];
    {
        const bf16_t* qp = qkv + (rowb + tq) * ld + qcol + h * 32;
#pragma unroll
        for (int ks = 0; ks < 4; ++ks) qf[ks] = *(const bf16x8*)(qp + ks * 8);
    }
    f32x16 o0, o1;
#pragma unroll
    for (int i = 0; i < 16; ++i) { o0[i] = 0.f; o1[i] = 0.f; }
    float R = 1.f;
    const int i16 = lane & 15;
    const char* vbase = vl + 4608 + (4 * h + (i16 >> 2)) * 144 + (16 * ((lane >> 4) & 1) + 4 * (i16 & 3)) * 2;
    const char* kfp = vl + r * 144 + h * 64;
    KV_DECL;
    KV_LOAD(qt * 32, 1);
    for (int tile = qt; tile >= 0; --tile) {
        KV_STORE();
        asm volatile("" ::: "memory");
        if (tile > 0) KV_LOAD((tile - 1) * 32, 1);
        f32x16 s;
#pragma unroll
        for (int i = 0; i < 16; ++i) s[i] = 0.f;
#pragma unroll
        for (int ks = 0; ks < 4; ++ks) s = MFMA(*(const bf16x8*)(kfp + ks * 16), qf[ks], s);
        const bool diag = (tile == qt);
        f32x16 sg, kp;
#pragma unroll
        for (int i = 0; i < 16; ++i) {
            const float z2 = fminf(s[i] * (0.125f * LOG2E), 80.f);
            const float t = fexp2(z2);
            const float k = __builtin_amdgcn_rcpf(1.f + t);
            kp[i] = k; sg[i] = t * k;
        }
        if (diag) {
#pragma unroll
            for (int i = 0; i < 16; ++i) { const bool strict = crow(i, h) < r; kp[i] = strict ? kp[i] : 1.f; sg[i] = strict ? sg[i] : 0.f; }
        }
        float G[4], PG[4], both[4];
#pragma unroll
        for (int g = 0; g < 4; ++g) { G[g] = (kp[4 * g] * kp[4 * g + 1]) * (kp[4 * g + 2] * kp[4 * g + 3]); PG[g] = __shfl_xor(G[g], 32); both[g] = G[g] * PG[g]; }
        float Sx[4];
        Sx[3] = 1.f; Sx[2] = both[3]; Sx[1] = both[3] * both[2]; Sx[0] = Sx[1] * both[1];
        f32x16 a;
#pragma unroll
        for (int g = 0; g < 4; ++g) {
            float la = R * Sx[g] * (h == 0 ? PG[g] : 1.f);
#pragma unroll
            for (int j = 3; j >= 0; --j) {
                a[4 * g + j] = sg[4 * g + j] * la;
                la *= kp[4 * g + j];
            }
        }
        R *= Sx[0] * both[0];
        const bf16x8 p0 = pack8v<0>(a), p1 = pack8v<8>(a);
        o0 = MFMA(v_frag(vbase, 0, 0), p0, o0);
        o0 = MFMA(v_frag(vbase, 1, 0), p1, o0);
        o1 = MFMA(v_frag(vbase, 0, 1), p0, o1);
        o1 = MFMA(v_frag(vbase, 1, 1), p1, o1);
        asm volatile("" ::: "memory");
        if (__builtin_amdgcn_ballot_w64(R >= 1.17549435e-38f) == 0) break;
    }
    if (dry) { if (o0[0] + o1[0] == 12345.678f) qkv[0] = 1; return; }
    bf16_t* op = qkv + (rowb + tq) * ld + qcol + 4 * h;
#pragma unroll
    for (int g = 0; g < 4; ++g) {
        *(uint2*)(op + 8 * g) = make_uint2(pk2(o0[4 * g], o0[4 * g + 1]), pk2(o0[4 * g + 2], o0[4 * g + 3]));
        *(uint2*)(op + 32 + 8 * g) = make_uint2(pk2(o1[4 * g], o1[4 * g + 1]), pk2(o1[4 * g + 2], o1[4 * g + 3]));
    }
}

DI void attn_even_phase(const Params& P, char* smem, bool dry) {
    const int tid_ = otid(); const int lane = tid_ & 63, wid = tid_ >> 6;
    bf16_t* qkv = (bf16_t*)(P.ws + OFF_BIG);
    char* vl = smem + wid * 9216;
    for (int it = blockIdx.x * 8 + wid; it < 2048 + 4096; it += gridDim.x * 8) {
        if (it < 2048) {
            const int bh = it >> 6, p = it & 63; const int b = bh >> 3, head = bh & 7;
            stick_wave(qkv, 2304, b, 512 + head * 64, 1280 + head * 64, 1792 + head * 64, 127 - p, vl, lane, dry);
            stick_wave(qkv, 2304, b, 512 + head * 64, 1280 + head * 64, 1792 + head * 64, p, vl, lane, dry);
        } else {
            const int v = it - 2048; const int g = v & 3; const int qt = (v >> 2) & 127; const int rest = v >> 9; const int b = rest >> 1, kvh = rest & 1;
            const int head = kvh * 4 + g;
            const float slope = exp2f(-(float)(head + 1));
            const float sink = P.in[9][head];
            win_attn_wave(qkv, 2304, b, head * 64, 1024 + kvh * 64, 1152 + kvh * 64, qt * 32, 1, slope * LOG2E, sink * LOG2E, 1.f, 0, vl, lane, dry);
        }
    }
}

DI void attn_odd_phase(const Params& P, char* smem, bool dry) {
    const int tid_ = otid(); const int lane = tid_ & 63, wid = tid_ >> 6;
    bf16_t* qkv = (bf16_t*)(P.ws + OFF_BIG);
    char* vl = smem + wid * 9216;
    for (int it = blockIdx.x * 8 + wid; it < 8192; it += gridDim.x * 8) {
        const int res16 = it & 15; const int u0 = ((it >> 4) & 7) * 32; const int head = (it >> 7) & 15; const int b = it >> 11;
        const float slope = exp2f(-0.5f * (float)(head + 1));
        win_attn_wave(qkv, 3072, b, head * 64, 1024 + head * 64, 2048 + head * 64, res16 + 16 * u0, 16, slope * LOG2E, -1e30f, 0.f, 1, vl, lane, dry);
    }
}

DI void xattn_wave(bf16_t* qb, const bf16_t* Kn, const bf16_t* VT, const float* qg, float kmax2, int b, int head, int tok0, char* ql, int lane, bool dry) {
    const int r = lane & 31, h = lane >> 5;
    const size_t token = (size_t)b * S + tok0 + r;
    bf16_t* qp = qb + token * D + head * 256 + h * 128;
    float ss = 0.f;
#pragma unroll
    for (int ks = 0; ks < 16; ++ks) {
        const uint4 v = *(const uint4*)(qp + ks * 8);
        const unsigned w[4] = {v.x, v.y, v.z, v.w};
#pragma unroll
        for (int e = 0; e < 4; ++e) { const float a = bflo(w[e]), c = bfhi(w[e]); ss += a * a + c * c; }
    }
    ss += __shfl_xor(ss, 32);
    const float inv = __builtin_amdgcn_rsqf(ss * (1.f / 256.f) + EPS);
    float qq2 = 0.f;
#pragma unroll
    for (int ks = 0; ks < 16; ++ks) {
        const uint4 v = *(const uint4*)(qp + ks * 8);
        const float4 g0 = *(const float4*)(qg + h * 128 + ks * 8), g1 = *(const float4*)(qg + h * 128 + ks * 8 + 4);
        uint4 o;
        o.x = pk2(bflo(v.x) * inv * g0.x, bfhi(v.x) * inv * g0.y); o.y = pk2(bflo(v.y) * inv * g0.z, bfhi(v.y) * inv * g0.w);
        o.z = pk2(bflo(v.z) * inv * g1.x, bfhi(v.z) * inv * g1.y); o.w = pk2(bflo(v.w) * inv * g1.z, bfhi(v.w) * inv * g1.w);
        qq2 += bflo(o.x) * bflo(o.x) + bfhi(o.x) * bfhi(o.x) + bflo(o.y) * bflo(o.y) + bfhi(o.y) * bfhi(o.y)
             + bflo(o.z) * bflo(o.z) + bfhi(o.z) * bfhi(o.z) + bflo(o.w) * bflo(o.w) + bfhi(o.w) * bfhi(o.w);
        *(uint4*)(ql + (ks * 64 + lane) * 16) = o;
    }
    qq2 += __shfl_xor(qq2, 32);
    asm volatile("" ::: "memory");
    const float sc2 = 0.0625f * LOG2E;
    const bf16_t* kp0 = Kn + ((size_t)(b * 4 + head) * 8 * 16 * 64 + lane) * 8;
    const float m = __builtin_amdgcn_sqrtf(qq2 * kmax2) * 1.001f;
    float l = 0.f;
    bf16x8 pf[8][2];
    bf16x8 kc[16], kn[16];
#pragma unroll
    for (int ks = 0; ks < 16; ++ks) kc[ks] = *(const bf16x8*)(kp0 + ks * 512);
#pragma unroll
    for (int tile = 0; tile < 8; ++tile) {
        if (tile < 7) {
#pragma unroll
            for (int ks = 0; ks < 16; ++ks) kn[ks] = *(const bf16x8*)(kp0 + (size_t)(tile + 1) * 16 * 512 + ks * 512);
        }
        f32x16 s;
#pragma unroll
        for (int i = 0; i < 16; ++i) s[i] = 0.f;
#pragma unroll
        for (int ks = 0; ks < 16; ++ks) {
            const bf16x8 qf = *(const bf16x8*)(ql + (ks * 64 + lane) * 16);
            s = MFMA(kc[ks], qf, s);
        }
#pragma unroll
        for (int i = 0; i < 16; ++i) { s[i] = fexp2((s[i] - m) * sc2); l += s[i]; }
        pf[tile][0] = pack8v<0>(s); pf[tile][1] = pack8v<8>(s);
#pragma unroll
        for (int ks = 0; ks < 16; ++ks) kc[ks] = kn[ks];
    }
    l += __shfl_xor(l, 32);
    const float il = 1.f / l;
    bf16_t* op = qb + token * D + head * 256 + 4 * h;
    const bf16_t* vp0 = VT + (((size_t)(b * 4 + head) * 8 * 8 * 2 * 64) + lane) * 8;
    bf16x8 vc[16], vn[16];
#pragma unroll
    for (int e = 0; e < 16; ++e) vc[e] = *(const bf16x8*)(vp0 + e * 512);
#pragma unroll 1
    for (int dt = 0; dt < 8; ++dt) {
        const int dn = dt < 7 ? dt + 1 : 7;
#pragma unroll
        for (int e = 0; e < 16; ++e) vn[e] = *(const bf16x8*)(vp0 + (size_t)dn * 16 * 512 + e * 512);
        f32x16 o;
#pragma unroll
        for (int i = 0; i < 16; ++i) o[i] = 0.f;
#pragma unroll
        for (int tile = 0; tile < 8; ++tile)
#pragma unroll
            for (int s2 = 0; s2 < 2; ++s2) o = MFMA(vc[tile * 2 + s2], pf[tile][s2], o);
#pragma unroll
        for (int g = 0; g < 4; ++g)
            if (dry) { if (o[4 * g] == 12345.678f) qb[0] = 1; } else *(uint2*)(op + dt * 32 + 8 * g) = make_uint2(pk2(o[4 * g] * il, o[4 * g + 1] * il), pk2(o[4 * g + 2] * il, o[4 * g + 3] * il));
#pragma unroll
        for (int e = 0; e < 16; ++e) vc[e] = vn[e];
    }
}

DI void xattn_phase(const Params& P, int l, char* smem, bool dry) {
    const int tid_ = otid(); const int lane = tid_ & 63, wid = tid_ >> 6;
    bf16_t* qb = (bf16_t*)(P.ws + OFF_BIG);
    const bf16_t* Kn = (const bf16_t*)(P.ws + OFF_KF + (size_t)l * SZ_MM);
    const bf16_t* VT = (const bf16_t*)(P.ws + OFF_VT + (size_t)l * SZ_MM);
    const float* qg = P.in[19] + l * 256;
    char* ql = smem + wid * 16384;
    for (int it = blockIdx.x * 8 + wid; it < 2048; it += gridDim.x * 8) {
        const int qt = it & 127, head = (it >> 7) & 3, b = it >> 9;
        const float kmax2 = ((const float*)(P.ws + OFF_KMAX))[l * 16 + b * 4 + head];
        xattn_wave(qb, Kn, VT, qg, kmax2, b, head, qt * 32, ql, lane, dry);
    }
}

DI void knorm_phase(const Params& P) {
    const int tid_ = otid(); const int lane = tid_ & 63, wid = tid_ >> 6;
    for (int u = blockIdx.x * 8 + wid; u < 8192; u += gridDim.x * 8) {
        const int l = u >> 12, row = (u >> 2) & 1023, head = u & 3;
        const bf16_t* kp = (const bf16_t*)(P.ws + OFF_KN + (size_t)l * SZ_MM) + (size_t)row * D + head * 256 + lane * 4;
        const uint2 v = *(const uint2*)kp;
        const float a0 = bflo(v.x), a1 = bfhi(v.x), a2 = bflo(v.y), a3 = bfhi(v.y);
        float ss = a0 * a0 + a1 * a1 + a2 * a2 + a3 * a3;
        ss = wave_sum(ss);
        const float inv = __builtin_amdgcn_rsqf(ss * (1.f / 256.f) + EPS);
        const float4 g = *(const float4*)(P.in[20] + l * 256 + lane * 4);
        const int b = row >> 8, key = row & 255;
        const int h = lane >> 5, ks = (lane & 31) >> 1, j0 = (lane & 1) * 4;
        bf16_t* dp = (bf16_t*)(P.ws + OFF_KF + (size_t)l * SZ_MM) + ((((((size_t)(b * 4 + head) * 8 + (key >> 5)) * 16 + ks) * 64) + h * 32 + (key & 31)) << 3) + j0;
        const unsigned w0_ = pk2(a0 * inv * g.x, a1 * inv * g.y), w1_ = pk2(a2 * inv * g.z, a3 * inv * g.w);
        *(uint2*)dp = make_uint2(w0_, w1_);
        float kk2 = bflo(w0_) * bflo(w0_) + bfhi(w0_) * bfhi(w0_) + bflo(w1_) * bflo(w1_) + bfhi(w1_) * bfhi(w1_);
        kk2 = wave_sum(kk2);
        if (lane == 0) atomicMax((unsigned*)(P.ws + OFF_KMAX) + l * 16 + b * 4 + head, __float_as_uint(kk2));
    }
}

DI void fast_grid_sync(unsigned* bar, unsigned target) {
    asm volatile("s_waitcnt vmcnt(0) lgkmcnt(0)" ::: "memory");
    __syncthreads();
    if (threadIdx.x == 0) {
        __builtin_amdgcn_fence(__ATOMIC_RELEASE, "agent");
        asm volatile("s_waitcnt vmcnt(0)" ::: "memory");
        __hip_atomic_fetch_add(bar, 1u, __ATOMIC_RELAXED, __HIP_MEMORY_SCOPE_AGENT);
        while (__hip_atomic_load(bar, __ATOMIC_RELAXED, __HIP_MEMORY_SCOPE_AGENT) < target) __builtin_amdgcn_s_sleep(2);
        __builtin_amdgcn_fence(__ATOMIC_ACQUIRE, "agent");
        asm volatile("s_waitcnt vmcnt(0)" ::: "memory");
    }
    __syncthreads();
}

__global__ void __launch_bounds__(512) fwd_megakernel(Params P) {
    extern __shared__ __attribute__((aligned(16))) char smem[];
    cg::grid_group grid = cg::this_grid();
    unsigned nbar = 0;
#pragma unroll 1
    for (int ph = 0; ph < 21; ++ph) {
        float* ssq = (float*)(P.ws + OFF_SSQ);
        bf16_t* xb = (bf16_t*)(P.ws + OFF_XB);
        bf16_t* big = (bf16_t*)(P.ws + OFF_BIG);
        int nrep = 1;
        if (ph > 0) { const int s_ = (ph - 1) % 10; const int kind = (s_ == 3) ? 2 : (s_ == 6) ? 4 : 1; if (PROBE_MASK & kind) nrep = 2; }
        for (int rep = 0; rep < nrep; ++rep) {
        const bool dry = rep + 1 < nrep;
        if (ph == 0) {
            phase0(P, smem);
        } else {
            const int l = (ph - 1) / 10, s = (ph - 1) % 10;
            if (s == 3) {
                if (l == 0) attn_even_phase(P, smem, dry); else attn_odd_phase(P, smem, dry);
            } else if (s == 6) {
                xattn_phase(P, l, smem, dry);
            } else {
                pg8::Gemm g; pg8::Epi E;
                g.A = xb; g.lda = D; g.K = D; g.M = T; g.N = D; g.Bt = nullptr;
                E.mode = 1; E.rs = nullptr; E.O = big; E.ldo = D; E.xin = P.out; E.xout = P.out; E.xb = xb; E.ssq_out = ssq; E.alpha = 1.f;
                E.qg = nullptr; E.kg = nullptr; E.qn_end = 0; E.kn_beg = 0; E.kn_end = 0;
                if (s == 0 || s == 8) {
                    g.Bt = (const bf16_t*)(P.ws + (s == 0 ? OFF_GU1 : OFF_GU2) + (size_t)l * SZ_GU); g.N = NGU;
                    E.mode = 0; E.rs = ssq + (size_t)(4 * l + (s == 0 ? 0 : 3)) * T; E.ldo = DFF;
                } else if (s == 1 || s == 9) {
                    g.A = big; g.lda = DFF; g.K = DFF;
                    g.Bt = (const bf16_t*)(P.ws + (s == 1 ? OFF_DN1 : OFF_DN2) + (size_t)l * SZ_DN);
                    E.alpha = 0.5f; E.ssq_out = ssq + (size_t)(4 * l + (s == 1 ? 1 : 4)) * T;
                    if (ph == 2) E.xin = P.in[0];
                    if (ph == 20) E.xb = nullptr;
                } else if (s == 2) {
                    E.mode = 2; E.rs = ssq + (size_t)(4 * l + 1) * T;
                    if (l == 0) { g.Bt = (const bf16_t*)(P.ws + OFF_EVIN); g.N = 2304; E.ldo = 2304; E.qg = P.in[7]; E.kg = P.in[8]; E.qn_end = 512; E.kn_beg = 1024; E.kn_end = 1152; }
                    else { g.Bt = (const bf16_t*)(P.ws + OFF_ODIN); g.N = 3072; E.ldo = 3072; E.qg = P.in[12]; E.kg = P.in[13]; E.qn_end = 1024; E.kn_beg = 1024; E.kn_end = 2048; }
                } else if (s == 4) {
                    g.A = big;
                    if (l == 0) { g.Bt = (const bf16_t*)(P.ws + OFF_EVOUT); g.lda = 2304; }
                    else { g.Bt = (const bf16_t*)(P.ws + OFF_ODOUT); g.lda = 3072; }
                    E.ssq_out = ssq + (size_t)(4 * l + 2) * T;
                } else if (s == 5) {
                    g.Bt = (const bf16_t*)(P.ws + OFF_WQ + (size_t)l * SZ_MM); E.mode = 2; E.rs = ssq + (size_t)(4 * l + 2) * T; E.ldo = D;
                } else {
                    g.A = big; g.Bt = (const bf16_t*)(P.ws + OFF_WO + (size_t)l * SZ_MM); E.ssq_out = ssq + (size_t)(4 * l + 3) * T;
                }
                pg8::StaticOrder So; So.init(T, g.N, (int)gridDim.x, (int)blockIdx.x);
                __syncthreads();
                pg8::gemm_phase<pg8::Epi, pg8::StaticOrder, true, true>((PG8_LAS unsigned char*)smem, g, So, E);
                if (ph == 1) {
                    GJob J;
                    J.A = xb; J.lda = D; J.ksplit = 1 << 30; J.kextra = 0; J.K = D; J.ntm = 4; J.mode = 3; J.rs = nullptr;
                    J.O = big; J.ldo = D; J.xin = P.out; J.xout = P.out; J.xb = xb; J.ssq_out = ssq; J.alpha = 1.f;
                    J.qg = nullptr; J.kg = nullptr; J.qn_end = 0; J.kn_end = 0; J.vt = nullptr; J.W = nullptr; J.ntn = 8;
                    gemm_phase(J, 0, 64, P, smem, false);
                }
                if (ph == 2 && !dry) knorm_phase(P);
            }
        }
        if (ph == 0) grid.sync();
        else if (ph < 20) { ++nbar; fast_grid_sync((unsigned*)(P.ws + OFF_BAR), nbar * gridDim.x); }
        }
    }
}

extern "C" void kernel_launch(void* const* d_in, const int* in_sizes, int n_in, void* d_out, int out_size, void* d_ws, size_t ws_size,
                              hipStream_t stream) {
    static int grid_blocks = 0;
    if (!grid_blocks) {
        int dev = 0, cus = 0, per_cu = 0;
        hipGetDevice(&dev);
        hipDeviceGetAttribute(&cus, hipDeviceAttributeMultiprocessorCount, dev);
        hipFuncSetAttribute((const void*)fwd_megakernel, hipFuncAttributeMaxDynamicSharedMemorySize, LDS_BYTES);
        hipOccupancyMaxActiveBlocksPerMultiprocessor(&per_cu, fwd_megakernel, NTHR, LDS_BYTES);
        if (per_cu < 1) per_cu = 1;
        if (per_cu > 1) per_cu = 1;
        grid_blocks = cus * per_cu;
    }
    if (ws_size < WS_NEED) { fprintf(stderr, "workspace too small: %zu < %zu\n", ws_size, (size_t)WS_NEED); return; }
    Params p{};
    for (int i = 0; i < 25; ++i) p.in[i] = (const float*)d_in[i];
    p.out = (float*)d_out; p.ws = (char*)d_ws;
    hipMemsetAsync((char*)d_ws + OFF_BAR, 0, 256, stream);
    void* args[] = {&p};
    hipError_t e = hipLaunchCooperativeKernel((void*)fwd_megakernel, dim3(grid_blocks), dim3(NTHR), args, LDS_BYTES, stream);
    if (e != hipSuccess) fprintf(stderr, "cooperative launch failed: %s (grid %d)\n", hipGetErrorString(e), grid_blocks);
}
```

```cpp
#include <hip/hip_runtime.h>
#include <hip/hip_cooperative_groups.h>
#include <cstdio>
#include <cstdint>
namespace cg = cooperative_groups;

#define DI __device__ __forceinline__
typedef unsigned short bf16_t;
typedef short bf16x8 __attribute__((ext_vector_type(8)));
typedef short s16x4 __attribute__((ext_vector_type(4)));
typedef float f32x16 __attribute__((ext_vector_type(16)));
typedef __bf16 bf2_t __attribute__((ext_vector_type(2)));
typedef float f2_t __attribute__((ext_vector_type(2)));
typedef short v4i16_t __attribute__((ext_vector_type(4)));
#define MFMA(a, b, c) __builtin_amdgcn_mfma_f32_32x32x16_bf16((a), (b), (c), 0, 0, 0)

constexpr int T = 16384, S = 4096, D = 1024, DFF = 2816, NGU = 5632;
constexpr float EPS = 1e-6f;
constexpr float LOG2E = 1.4426950408889634f;
constexpr float LN2 = 0.6931471805599453f;

constexpr size_t SZ_GU = (size_t)NGU * D * 2, SZ_DN = (size_t)D * DFF * 2, SZ_MM = (size_t)D * D * 2;
constexpr size_t OFF_GU1 = 0;
constexpr size_t OFF_DN1 = OFF_GU1 + 2 * SZ_GU;
constexpr size_t OFF_GU2 = OFF_DN1 + 2 * SZ_DN;
constexpr size_t OFF_DN2 = OFF_GU2 + 2 * SZ_GU;
constexpr size_t OFF_WQ = OFF_DN2 + 2 * SZ_DN;
constexpr size_t OFF_WKV = OFF_WQ + 2 * SZ_MM;
constexpr size_t OFF_WO = OFF_WKV + 4 * SZ_MM;
constexpr size_t OFF_EVIN = OFF_WO + 2 * SZ_MM;
constexpr size_t OFF_EVOUT = OFF_EVIN + (size_t)2304 * D * 2;
constexpr size_t OFF_ODIN = OFF_EVOUT + SZ_MM;
constexpr size_t OFF_ODOUT = OFF_ODIN + (size_t)3072 * D * 2;
constexpr size_t OFF_XB = OFF_ODOUT + SZ_MM;
constexpr size_t OFF_BIG = OFF_XB + (size_t)T * D * 2;
constexpr size_t OFF_MEMB = OFF_BIG + (size_t)T * 3072 * 2;
constexpr size_t OFF_KN = OFF_MEMB + SZ_MM;
constexpr size_t OFF_VT = OFF_KN + 2 * SZ_MM;
constexpr size_t OFF_SSQ = OFF_VT + 2 * SZ_MM;
constexpr size_t OFF_SSQM = OFF_SSQ + (size_t)9 * T * 4;
constexpr size_t OFF_KMAX = OFF_SSQM + 4096;
constexpr size_t OFF_BAR = OFF_KMAX + 256;
constexpr size_t OFF_KF = OFF_BAR + 256;
constexpr size_t WS_NEED = OFF_KF + 2 * SZ_MM;

#ifndef PROBE_MASK
#define PROBE_MASK 0
#endif
#ifndef PROBE_GEMM
#define PROBE_GEMM 0
#endif
constexpr int NTHR = 512;
constexpr int NST = 4;
constexpr int STAGE_B = 32768;
constexpr int OPB = 16384;
constexpr int LDS_BYTES = 131072;

struct Params { const float* in[25]; float* out; char* ws; };

DI unsigned pk2(float a, float b) { f2_t v = {a, b}; bf2_t r = __builtin_convertvector(v, bf2_t); return __builtin_bit_cast(unsigned, r); }
DI float bflo(unsigned w) { return __uint_as_float(w << 16); }
DI float bfhi(unsigned w) { return __uint_as_float(w & 0xffff0000u); }
DI int otid() { int t = threadIdx.x; asm volatile("" : "+v"(t)); return t; }
DI int crow(int i, int h) { return (i & 3) + 8 * (i >> 2) + 4 * h; }
DI float fexp2(float x) { return __builtin_amdgcn_exp2f(x); }
DI float flog2(float x) { return __builtin_amdgcn_logf(x); }

struct WJob { const float* src; bf16_t* dst; const float* gain; int K, N, gu; };

DI int wjob_tiles(int j) {
    if (j < 14) {
        const int kind = j >> 1;
        switch (kind) {
            case 0: case 2: return 16 * 88;
            case 1: case 3: return 44 * 16;
            case 4: return 256;
            case 5: return 512;
            default: return 256;
        }
    }
    if (j == 14) return 16 * 36;
    if (j == 16) return 16 * 48;
    return 256;
}

DI WJob get_wjob(const Params& P, int j) {
    WJob w; w.gain = nullptr; w.gu = 0;
    bf16_t* wsb = (bf16_t*)P.ws;
    if (j < 14) {
        const int kind = j >> 1, l = j & 1;
        switch (kind) {
            case 0: w.src = P.in[3] + (size_t)l * D * NGU; w.dst = (bf16_t*)(P.ws + OFF_GU1 + l * SZ_GU); w.gain = P.in[2] + l * D; w.K = D; w.N = NGU; w.gu = 1; break;
            case 1: w.src = P.in[4] + (size_t)l * DFF * D; w.dst = (bf16_t*)(P.ws + OFF_DN1 + l * SZ_DN); w.K = DFF; w.N = D; w.gu = 2; break;
            case 2: w.src = P.in[23] + (size_t)l * D * NGU; w.dst = (bf16_t*)(P.ws + OFF_GU2 + l * SZ_GU); w.gain = P.in[22] + l * D; w.K = D; w.N = NGU; w.gu = 1; break;
            case 3: w.src = P.in[24] + (size_t)l * DFF * D; w.dst = (bf16_t*)(P.ws + OFF_DN2 + l * SZ_DN); w.K = DFF; w.N = D; w.gu = 2; break;
            case 4: w.src = P.in[17] + (size_t)l * D * D; w.dst = (bf16_t*)(P.ws + OFF_WQ + l * SZ_MM); w.gain = P.in[15] + l * D; w.K = D; w.N = D; w.gu = 2; break;
            case 5: w.src = P.in[18] + (size_t)l * D * 2048; w.dst = (bf16_t*)(P.ws + OFF_WKV + l * 2 * SZ_MM); w.gain = P.in[16] + l * D; w.K = D; w.N = 2048; break;
            default: w.src = P.in[21] + (size_t)l * D * D; w.dst = (bf16_t*)(P.ws + OFF_WO + l * SZ_MM); w.K = D; w.N = D; w.gu = 2; break;
        }
    } else if (j == 14) { w.src = P.in[6]; w.dst = (bf16_t*)(P.ws + OFF_EVIN); w.gain = P.in[5]; w.K = D; w.N = 2304; w.gu = 3; }
    else if (j == 15) { w.src = P.in[10]; w.dst = (bf16_t*)(P.ws + OFF_EVOUT); w.K = D; w.N = D; w.gu = 2; }
    else if (j == 16) { w.src = P.in[11]; w.dst = (bf16_t*)(P.ws + OFF_ODIN); w.gain = P.in[5] + D; w.K = D; w.N = 3072; w.gu = 2; }
    else { w.src = P.in[14]; w.dst = (bf16_t*)(P.ws + OFF_ODOUT); w.K = D; w.N = D; w.gu = 2; }
    (void)wsb;
    return w;
}

DI void wconv_tile(const WJob& w, int t, float* sm, int tid, bool act) {
    const int ntn = w.N >> 6; const int tk = t / ntn, tn = t - tk * ntn;
    if (act) {
#pragma unroll
        for (int p = 0; p < 4; ++p) {
            const int kr = p * 16 + (tid >> 4);
            const float4 v = *(const float4*)(w.src + (size_t)(tk * 64 + kr) * w.N + tn * 64 + (tid & 15) * 4);
            const float g = w.gain ? w.gain[tk * 64 + kr] : 1.f;
            float* sp = sm + kr * 65 + (tid & 15) * 4;
            sp[0] = v.x * g; sp[1] = v.y * g; sp[2] = v.z * g; sp[3] = v.w * g;
        }
    }
    __syncthreads();
    if (act) {
        const int n = tid >> 2, kq = tid & 3; const int ng = tn * 64 + n;
        int drow = ng;
        if (w.gu == 1) drow = ng < DFF ? ((ng >> 7) * 256 + (ng & 127)) : (((ng - DFF) >> 7) * 256 + 128 + ((ng - DFF) & 127));
        else if (w.gu >= 2) {
            int a = ng;
            if (w.gu == 3) a = ng < 512 ? ng : ng < 768 ? ng + 512 : ng < 1280 ? ng - 256 : ng;
            drow = (a & ~255) + (((a >> 5) & 1) << 7) + (((a >> 6) & 3) << 5) + (a & 31);
        }
        unsigned o[8];
#pragma unroll
        for (int e = 0; e < 8; ++e) o[e] = pk2(sm[(kq * 16 + 2 * e) * 65 + n], sm[(kq * 16 + 2 * e + 1) * 65 + n]);
        uint4* dp = (uint4*)(w.dst + (size_t)drow * w.K + tk * 64 + kq * 16);
        dp[0] = make_uint4(o[0], o[1], o[2], o[3]); dp[1] = make_uint4(o[4], o[5], o[6], o[7]);
    }
    __syncthreads();
}

DI float wave_sum(float v) {
    v += __shfl_xor(v, 1); v += __shfl_xor(v, 2); v += __shfl_xor(v, 4); v += __shfl_xor(v, 8); v += __shfl_xor(v, 16); v += __shfl_xor(v, 32);
    return v;
}

DI void rowconv(const float* src, bf16_t* dst, float* ssq, int row, int lane) {
    const float* xr = src + (size_t)row * D;
    float ss = 0.f;
#pragma unroll
    for (int p = 0; p < 4; ++p) {
        const float4 v = *(const float4*)(xr + p * 256 + lane * 4);
        ss += v.x * v.x + v.y * v.y + v.z * v.z + v.w * v.w;
        *(uint2*)(dst + (size_t)row * D + p * 256 + lane * 4) = make_uint2(pk2(v.x, v.y), pk2(v.z, v.w));
    }
    ss = wave_sum(ss);
    if (lane == 0) ssq[row] = ss;
}

DI void phase0(const Params& P, char* smem) {
    const int tid = otid(), lane = tid & 63, wid = tid >> 6;
    float* ssq = (float*)(P.ws + OFF_SSQ);
    for (int i = blockIdx.x * NTHR + tid; i < 8 * T; i += gridDim.x * NTHR) ssq[T + i] = 0.f;
    if (blockIdx.x == 0 && tid < 32) ((unsigned*)(P.ws + OFF_KMAX))[tid] = 0u;
    constexpr int NW = 12352 / 2, NX = T / 8, NM = 1024 / 8;
    for (int u = blockIdx.x; u < NW + NX + NM; u += gridDim.x) {
        if (u < NW) {
            const int half = tid >> 8;
            int t = 2 * u + half, j = 0;
            for (; j < 17; ++j) { const int c = wjob_tiles(j); if (t < c) break; t -= c; }
            const WJob w = get_wjob(P, j);
            wconv_tile(w, t, (float*)smem + half * (64 * 65), tid & 255, true);
        } else if (u < NW + NX) {
            rowconv(P.in[0], (bf16_t*)(P.ws + OFF_XB), ssq, (u - NW) * 8 + wid, lane);
        } else {
            rowconv(P.in[1], (bf16_t*)(P.ws + OFF_MEMB), (float*)(P.ws + OFF_SSQM), (u - NW - NX) * 8 + wid, lane);
        }
    }
}

struct GJob {
    const bf16_t* A; const bf16_t* W;
    int lda, ksplit, kextra, K, ntm, ntn, mode;
    const float* rs;
    bf16_t* O; int ldo;
    const float* xin; float* xout; bf16_t* xb; float* ssq_out; float alpha;
    const float* qg; const float* kg; int qn_end, kn_end;
    bf16_t* vt;
};

typedef __attribute__((address_space(3))) unsigned* ldsu_t;
typedef const __attribute__((address_space(1))) unsigned* glbu_t;
DI void glds16(const bf16_t* g, char* l) { __builtin_amdgcn_global_load_lds((glbu_t)(const void*)g, (ldsu_t)(void*)l, 16, 0, 0); }

DI void gemm_tile(const GJob& J, int t, char* smem, bool dry) {
    const int tid = otid(), lane = tid & 63, wid = tid >> 6, wr = wid >> 2, wc = wid & 3;
    const int r = lane & 31, h = lane >> 5;
    int tm, tn;
    { const int gsz = 32 * J.ntn; const int g = t / gsz; const int rem = t - g * gsz; const int rows = min(32, J.ntm - g * 32); tn = rem / rows; tm = g * 32 + (rem - tn * rows); }
    const int lrow = wid * 16 + (lane >> 2);
    const int csw = ((lane & 3) ^ ((lane >> 4) & 3)) * 8;
    const bf16_t* Ag = J.A + (size_t)(tm * 256 + lrow) * J.lda + csw;
    const bf16_t* Wg = J.W + (size_t)(tn * 256 + lrow) * J.K + csw;
    const size_t astr = (size_t)128 * J.lda, wstr = (size_t)128 * J.K;
    char* lb = smem + tid * 16;
    const int nk = J.K >> 5;
#define GLDS(kt, buf) do { const int k0_ = (kt) * 32; const int ka_ = k0_ + (k0_ >= J.ksplit ? J.kextra : 0); char* l_ = lb + (buf) * STAGE_B; \
        glds16(Ag + ka_, l_); glds16(Ag + astr + ka_, l_ + 8192); glds16(Wg + k0_, l_ + OPB); glds16(Wg + wstr + k0_, l_ + OPB + 8192); } while (0)
    f32x16 acc[4][2];
#pragma unroll
    for (int a = 0; a < 4; ++a)
#pragma unroll
        for (int b = 0; b < 2; ++b)
#pragma unroll
            for (int i = 0; i < 16; ++i) acc[a][b][i] = 0.f;
    const int fr = (r >> 2) & 3;
    const int xrow = (wc * 64 + r) * 64, wrow = OPB + (wr * 128 + r) * 64;
    const int co0 = ((0 + h) ^ fr) * 16, co1 = ((2 + h) ^ fr) * 16;

    __syncthreads();
    GLDS(0, 0); GLDS(1, 1); GLDS(2, 2);
    asm volatile("s_waitcnt vmcnt(8)" ::: "memory");
    __builtin_amdgcn_s_barrier();
    bf16x8 w0[4], x0[2], w1[4], x1[2];
#define LOADF(W_, X_, sb_, co_) do { _Pragma("unroll") for (int ti = 0; ti < 2; ++ti) X_[ti] = *(const bf16x8*)((sb_) + xrow + ti * 2048 + (co_)); \
        _Pragma("unroll") for (int fi = 0; fi < 4; ++fi) W_[fi] = *(const bf16x8*)((sb_) + wrow + fi * 2048 + (co_)); } while (0)
#define MFMA8(W_, X_) do { __builtin_amdgcn_s_setprio(1); _Pragma("unroll") for (int fi = 0; fi < 4; ++fi) _Pragma("unroll") for (int ti = 0; ti < 2; ++ti) \
        acc[fi][ti] = MFMA(W_[fi], X_[ti], acc[fi][ti]); __builtin_amdgcn_s_setprio(0); } while (0)
    LOADF(w0, x0, smem, co0);
    __builtin_amdgcn_s_waitcnt(0xC07F);
    int buf = 0;
    for (int kt = 0; kt < nk; ++kt) {
        const char* sb = smem + buf * STAGE_B;
        LOADF(w1, x1, sb, co1);
        __builtin_amdgcn_sched_barrier(0);
        MFMA8(w0, x0);
        __builtin_amdgcn_s_waitcnt(0xC07F);
        __builtin_amdgcn_sched_barrier(0);
        const int nb = (buf + 1 == NST) ? 0 : buf + 1;
        if (kt + 1 < nk) {
            if (kt + 2 < nk) asm volatile("s_waitcnt vmcnt(4)" ::: "memory"); else asm volatile("s_waitcnt vmcnt(0)" ::: "memory");
            __builtin_amdgcn_s_barrier();
            if (kt + 3 < nk) { const int fb_ = (buf + 3 >= NST) ? buf + 3 - NST : buf + 3; GLDS(kt + 3, fb_); }
        }
        LOADF(w0, x0, smem + nb * STAGE_B, co0);
        __builtin_amdgcn_sched_barrier(0);
        MFMA8(w1, x1);
        __builtin_amdgcn_s_waitcnt(0xC07F);
        __builtin_amdgcn_sched_barrier(0);
        buf = nb;
    }
#undef LOADF
#undef MFMA8
#undef GLDS
    __syncthreads();

    if (dry) { if (acc[0][0][0] + acc[1][1][0] + acc[2][0][0] + acc[3][1][0] == 12345.678f) J.O[0] = 1; return; }
    const int tokb = tm * 256 + wc * 64;
    const int fb = tn * 256 + wr * 128;
    float rsc[2];
#pragma unroll
    for (int ti = 0; ti < 2; ++ti) rsc[ti] = J.rs ? __builtin_amdgcn_rsqf(J.rs[tokb + ti * 32 + r] * (1.f / 1024.f) + EPS) : 1.f;

    if (J.mode == 3 && fb >= 1024) {
#pragma unroll
        for (int ti = 0; ti < 2; ++ti) {
            const int tok = tokb + ti * 32 + r;
#pragma unroll
            for (int fi = 0; fi < 4; ++fi)
#pragma unroll
                for (int i = 0; i < 16; ++i) {
                    const int f = fb - 1024 + fi * 32 + crow(i, h);
                    const int bh_ = (tok >> 8) * 4 + (f >> 8), d_ = f & 255, key_ = tok & 255, k16 = key_ & 15;
                    const int ln_ = ((k16 >> 2) & 1) * 32 + (d_ & 31), e_ = ((k16 >> 3) << 2) | (k16 & 3);
                    J.vt[((((((size_t)bh_ * 8 + (d_ >> 5)) * 8 + (key_ >> 5)) * 2 + ((key_ >> 4) & 1)) * 64 + ln_) << 3) + e_] = (bf16_t)(pk2(acc[fi][ti][i] * rsc[ti], 0.f) & 0xffffu);
                }
        }
        return;
    }
    char* wl = smem + wid * 16384;
#pragma unroll
    for (int ti = 0; ti < 2; ++ti) {
#pragma unroll
        for (int fp = 0; fp < 2; ++fp) {
            const float sc = (J.mode == 1) ? J.alpha : rsc[ti];
#pragma unroll
            for (int fi2 = 0; fi2 < 2; ++fi2)
#pragma unroll
                for (int g = 0; g < 4; ++g) {
                    float4 v;
                    v.x = acc[2 * fp + fi2][ti][4 * g + 0] * sc; v.y = acc[2 * fp + fi2][ti][4 * g + 1] * sc;
                    v.z = acc[2 * fp + fi2][ti][4 * g + 2] * sc; v.w = acc[2 * fp + fi2][ti][4 * g + 3] * sc;
                    *(float4*)(wl + r * 272 + (fi2 * 32 + 8 * g + 4 * h) * 4) = v;
                }
            const int tok0 = tokb + ti * 32, f0 = fb + fp * 64;
            if (J.mode == 0) {
                const int c4 = (lane & 7) * 4;
#pragma unroll
                for (int p = 0; p < 4; ++p) {
                    const int row = p * 8 + (lane >> 3);
                    const float4 ga = *(const float4*)(wl + row * 272 + c4 * 4);
                    const float4 up = *(const float4*)(wl + row * 272 + (32 + c4) * 4);
                    float y0 = ga.x * up.x * __builtin_amdgcn_rcpf(1.f + fexp2(-ga.x * LOG2E));
                    float y1 = ga.y * up.y * __builtin_amdgcn_rcpf(1.f + fexp2(-ga.y * LOG2E));
                    float y2 = ga.z * up.z * __builtin_amdgcn_rcpf(1.f + fexp2(-ga.z * LOG2E));
                    float y3 = ga.w * up.w * __builtin_amdgcn_rcpf(1.f + fexp2(-ga.w * LOG2E));
                    *(uint2*)(J.O + (size_t)(tok0 + row) * J.ldo + (f0 >> 1) + c4) = make_uint2(pk2(y0, y1), pk2(y2, y3));
                }
            } else if (J.mode == 1) {
                const int c4 = (lane & 15) * 4;
#pragma unroll
                for (int p = 0; p < 8; ++p) {
                    const int row = p * 4 + (lane >> 4);
                    const size_t tok = tok0 + row;
                    const float4 v = *(const float4*)(wl + row * 272 + c4 * 4);
                    const float4 xo = *(const float4*)(J.xin + tok * D + f0 + c4);
                    float4 xn; xn.x = xo.x + v.x; xn.y = xo.y + v.y; xn.z = xo.z + v.z; xn.w = xo.w + v.w;
                    *(float4*)(J.xout + tok * D + f0 + c4) = xn;
                    if (J.xb) {
                        *(uint2*)(J.xb + tok * D + f0 + c4) = make_uint2(pk2(xn.x, xn.y), pk2(xn.z, xn.w));
                        float ss = xn.x * xn.x + xn.y * xn.y + xn.z * xn.z + xn.w * xn.w;
                        ss += __shfl_xor(ss, 1); ss += __shfl_xor(ss, 2); ss += __shfl_xor(ss, 4); ss += __shfl_xor(ss, 8);
                        if ((lane & 15) == 0) atomicAdd(J.ssq_out + tok, ss);
                    }
                }
            } else {
                const int nm = f0 < J.qn_end ? 1 : (f0 < J.kn_end ? 2 : 0);
                const float* gp = nm == 1 ? J.qg : J.kg;
                const int c4 = (lane & 15) * 4;
                float4 gn = make_float4(1.f, 1.f, 1.f, 1.f);
                if (nm) gn = *(const float4*)(gp + c4);
#pragma unroll
                for (int p = 0; p < 8; ++p) {
                    const int row = p * 4 + (lane >> 4);
                    float4 v = *(const float4*)(wl + row * 272 + c4 * 4);
                    if (nm) {
                        float ss = v.x * v.x + v.y * v.y + v.z * v.z + v.w * v.w;
                        ss += __shfl_xor(ss, 1); ss += __shfl_xor(ss, 2); ss += __shfl_xor(ss, 4); ss += __shfl_xor(ss, 8);
                        const float inv = __builtin_amdgcn_rsqf(ss * (1.f / 64.f) + EPS);
                        v.x *= inv * gn.x; v.y *= inv * gn.y; v.z *= inv * gn.z; v.w *= inv * gn.w;
                    }
                    *(uint2*)(J.O + (size_t)(tok0 + row) * J.ldo + f0 + c4) = make_uint2(pk2(v.x, v.y), pk2(v.z, v.w));
                }
            }
        }
    }
}

DI void gemm_phase(const GJob& JA, int nA, int nB, const Params& P, char* smem, bool dry) {
    for (int u = (int)gridDim.x - 1 - (int)blockIdx.x; u < nA + nB; u += gridDim.x) {
        GJob J = JA; int t = u;
        if (u >= nA) {
            const int v = u - nA; const int layer = v >> 5; t = v & 31;
            J.A = (const bf16_t*)(P.ws + OFF_MEMB); J.lda = D; J.ksplit = 1 << 30; J.kextra = 0;
            J.W = (const bf16_t*)(P.ws + OFF_WKV + (size_t)layer * 2 * SZ_MM); J.K = D; J.ntm = 4; J.ntn = 8; J.mode = 3;
            J.rs = (const float*)(P.ws + OFF_SSQM); J.O = (bf16_t*)(P.ws + OFF_KN + (size_t)layer * SZ_MM); J.ldo = D;
            J.qn_end = 0; J.kn_end = 0; J.vt = (bf16_t*)(P.ws + OFF_VT + (size_t)layer * SZ_MM);
        }
        gemm_tile(J, t, smem, dry);
    }
}

namespace pg8 {
#define PG8_LAS __attribute__((address_space(3)))
typedef float f32x4 __attribute__((ext_vector_type(4)));
typedef unsigned u32x4 __attribute__((ext_vector_type(4)));
constexpr int BM = 256, BK = 64, HALF = 128, HTB = HALF * BK * 2, STAGE_BYTES = 8 * HTB, NXCD = 8, WGM = 8;
DI int lds_byte(int r, int c) { const int st = (r >> 4) * 2 + (c >> 5), rr = r & 15, cc = c & 31, ob = rr * 64 + cc * 2; return st * 1024 + (ob ^ (((ob >> 9) & 1) << 5)); }
DI void stage_rc(int b, int& R, int& C) { const int st = b / 1024, sb = b % 1024, swz = sb ^ (((sb >> 9) & 1) << 5); R = (st >> 1) * 16 + swz / 64; C = (st & 1) * 32 + (swz % 64) / 2; }
DI int perm32(int rho) { const int n = rho >> 4, i = rho & 15; return 8 * (i >> 2) + 4 * n + (i & 3); }
struct Unit { int pm, pn; };
struct Gemm { const bf16_t* A; const bf16_t* Bt; int M, N, K, lda; };
struct StaticOrder {
    int nM, nN, nwg, G, c;
    DI void init(int M, int N, int G_, int c_) { nM = M / BM; nN = N / BM; nwg = nM * nN; G = G_; c = c_; }
    DI bool next(int i, Unit& u) const {
        const long L = (long)i * G + c; if (L >= nwg) return false;
        int wgid = (int)L; { const int q = nwg / NXCD, r = nwg % NXCD, xcd = wgid % NXCD, off = wgid / NXCD; wgid = (xcd < r ? xcd * (q + 1) : r * (q + 1) + (xcd - r) * q) + off; }
        const int nig = WGM * nN, gid = wgid / nig, fm = gid * WGM, gsz = (nM - fm) < WGM ? (nM - fm) : WGM;
        u.pm = fm + ((wgid % nig) % gsz); u.pn = (wgid % nig) / gsz; return true;
    }
    DI void a_ready(const Unit&) const {}
    DI void done(const Unit&) const {}
};

struct Epi {
    static constexpr bool PERM = true, AFTER_DRAIN = false;
    int mode;
    const float* rs;
    bf16_t* O; int ldo;
    const float* xin; float* xout; bf16_t* xb; float* ssq_out; float alpha;
    const float* qg; const float* kg; int qn_end, kn_beg, kn_end; int dryrun;
    DI void operator()(const f32x4 (&acc)[2][2][4][2], const Unit& u, int wr, int wc, int fr, int fq) const {
        if (dryrun) { if (acc[0][0][0][0][0] + acc[1][1][3][1][3] + acc[0][1][2][0][1] + acc[1][0][1][1][2] == 12345.678f) O[0] = 1; return; }
        const int row0 = u.pm * BM + wr * 64 + fr;
        if (mode == 0) {
            const int col = u.pn * 128 + wc * 32 + 8 * fq;
#pragma unroll
            for (int ai = 0; ai < 2; ++ai)
#pragma unroll
                for (int m = 0; m < 4; ++m) {
                    const size_t tok = row0 + ai * HALF + m * 16;
                    const float sc = __builtin_amdgcn_rsqf(rs[tok] * (1.f / 1024.f) + EPS);
                    float y[8];
#pragma unroll
                    for (int n = 0; n < 2; ++n)
#pragma unroll
                        for (int j = 0; j < 4; ++j) {
                            const float ga = acc[ai][0][m][n][j] * sc, up = acc[ai][1][m][n][j] * sc;
                            y[4 * n + j] = ga * up * __builtin_amdgcn_rcpf(1.f + fexp2(-ga * LOG2E));
                        }
                    *(uint4*)(O + tok * ldo + col) = make_uint4(pk2(y[0], y[1]), pk2(y[2], y[3]), pk2(y[4], y[5]), pk2(y[6], y[7]));
                }
        } else if (mode == 1) {
#pragma unroll
            for (int ai = 0; ai < 2; ++ai)
#pragma unroll
                for (int m = 0; m < 4; ++m) {
                    const size_t tok = row0 + ai * HALF + m * 16;
                    float ss = 0.f;
#pragma unroll
                    for (int bj = 0; bj < 2; ++bj) {
                        const int col = u.pn * BM + wc * 64 + bj * 32 + 8 * fq;
                        const float4 x0 = *(const float4*)(xin + tok * D + col), x1 = *(const float4*)(xin + tok * D + col + 4);
                        float4 n0, n1;
                        n0.x = x0.x + alpha * acc[ai][bj][m][0][0]; n0.y = x0.y + alpha * acc[ai][bj][m][0][1]; n0.z = x0.z + alpha * acc[ai][bj][m][0][2]; n0.w = x0.w + alpha * acc[ai][bj][m][0][3];
                        n1.x = x1.x + alpha * acc[ai][bj][m][1][0]; n1.y = x1.y + alpha * acc[ai][bj][m][1][1]; n1.z = x1.z + alpha * acc[ai][bj][m][1][2]; n1.w = x1.w + alpha * acc[ai][bj][m][1][3];
                        *(float4*)(xout + tok * D + col) = n0; *(float4*)(xout + tok * D + col + 4) = n1;
                        if (xb) {
                            *(uint4*)(xb + tok * D + col) = make_uint4(pk2(n0.x, n0.y), pk2(n0.z, n0.w), pk2(n1.x, n1.y), pk2(n1.z, n1.w));
                            ss += n0.x * n0.x + n0.y * n0.y + n0.z * n0.z + n0.w * n0.w + n1.x * n1.x + n1.y * n1.y + n1.z * n1.z + n1.w * n1.w;
                        }
                    }
                    if (xb) {
                        ss += __shfl_xor(ss, 16); ss += __shfl_xor(ss, 32);
                        if (fq == 0) atomicAdd(ssq_out + tok, ss);
                    }
                }
        } else {
            const int f0 = u.pn * BM + wc * 64;
            const int nm = f0 < qn_end ? 1 : ((f0 >= kn_beg && f0 < kn_end) ? 2 : 0);
            const float* gp = nm == 1 ? qg : kg;
            float4 g4[2][2];
#pragma unroll
            for (int bj = 0; bj < 2; ++bj)
#pragma unroll
                for (int n = 0; n < 2; ++n) g4[bj][n] = nm ? *(const float4*)(gp + bj * 32 + 8 * fq + 4 * n) : make_float4(1.f, 1.f, 1.f, 1.f);
#pragma unroll
            for (int ai = 0; ai < 2; ++ai)
#pragma unroll
                for (int m = 0; m < 4; ++m) {
                    const size_t tok = row0 + ai * HALF + m * 16;
                    float sc = rs ? __builtin_amdgcn_rsqf(rs[tok] * (1.f / 1024.f) + EPS) : 1.f;
                    if (nm) {
                        float ss = 0.f;
#pragma unroll
                        for (int bj = 0; bj < 2; ++bj)
#pragma unroll
                            for (int n = 0; n < 2; ++n)
#pragma unroll
                                for (int j = 0; j < 4; ++j) { const float v = acc[ai][bj][m][n][j] * sc; ss += v * v; }
                        ss += __shfl_xor(ss, 16); ss += __shfl_xor(ss, 32);
                        sc *= __builtin_amdgcn_rsqf(ss * (1.f / 64.f) + EPS);
                    }
#pragma unroll
                    for (int bj = 0; bj < 2; ++bj) {
                        const f32x4 a0 = acc[ai][bj][m][0], a1 = acc[ai][bj][m][1];
                        *(uint4*)(O + tok * ldo + f0 + bj * 32 + 8 * fq) =
                            make_uint4(pk2(a0[0] * sc * g4[bj][0].x, a0[1] * sc * g4[bj][0].y), pk2(a0[2] * sc * g4[bj][0].z, a0[3] * sc * g4[bj][0].w),
                                       pk2(a1[0] * sc * g4[bj][1].x, a1[1] * sc * g4[bj][1].y), pk2(a1[2] * sc * g4[bj][1].z, a1[3] * sc * g4[bj][1].w));
                    }
                }
        }
    }
};

template <class Epi, class Sched, bool ALIGN_EPI = false, bool SP2 = false>
__device__ __forceinline__ void gemm_phase(PG8_LAS unsigned char* lds, const Gemm g, const Sched& S, const Epi& E) {
    const int tid = otid(), wid = __builtin_amdgcn_readfirstlane(tid >> 6), lane = tid & 63, wr = wid >> 2, wc = wid & 3, fr = lane & 15, fq = lane >> 4;
    const int K = g.K, nt = K / BK;
    unsigned voffA[2], voffB[2];
#pragma unroll
    for (int i = 0; i < 2; ++i) { int R, C; stage_rc(tid * 16 + i * 8192, R, C); const int Rb = Epi::PERM ? ((R & ~31) + perm32(R & 31)) : R;
        voffA[i] = (unsigned)(R * g.lda + C) * 2u; voffB[i] = (unsigned)(Rb * K + C) * 2u; }
    const size_t kstep = (size_t)(BK * 2);
    const size_t hstepA = (size_t)HALF * g.lda * 2, hstepB = (size_t)HALF * K * 2;
    const size_t tstepA = 2 * hstepA, tstepB = 2 * hstepB;
    const unsigned ldsw = (unsigned)wid * 1024u;
    const int aoff = lds_byte(wr * 64 + fr, fq * 8), boff = lds_byte(wc * 32 + fr, fq * 8);
#define PG8_SA(b, h) (((b) * 2 + (h)) * HTB)
#define PG8_SB(b, h) ((4 + (b) * 2 + (h)) * HTB)
#define PG8_STAGE(bufoff, gbase, voff) do { _Pragma("unroll") for (int _i = 0; _i < 2; ++_i) \
        __builtin_amdgcn_global_load_lds((const unsigned*)((const char*)(gbase) + (voff)[_i]), (PG8_LAS unsigned*)(lds + (bufoff) + ldsw + _i * 8192), 16, 0, 0); } while (0)
#define PG8_LDA(dst, b, h) do { _Pragma("unroll") for (int m = 0; m < 4; ++m) _Pragma("unroll") for (int k = 0; k < 2; ++k) dst[m][k] = *(const PG8_LAS bf16x8*)(lds + PG8_SA(b, h) + aoff + m * 2048 + k * 1024); } while (0)
#define PG8_LDB(dst, b, h) do { _Pragma("unroll") for (int n = 0; n < 2; ++n) _Pragma("unroll") for (int k = 0; k < 2; ++k) dst[n][k] = *(const PG8_LAS bf16x8*)(lds + PG8_SB(b, h) + boff + n * 2048 + k * 1024); } while (0)
#define PG8_MMA(ai, bj, At, Bt) do { __builtin_amdgcn_s_setprio(1); _Pragma("unroll") for (int m = 0; m < 4; ++m) _Pragma("unroll") for (int n = 0; n < 2; ++n) _Pragma("unroll") for (int k = 0; k < 2; ++k) \
        acc[ai][bj][m][n] = __builtin_amdgcn_mfma_f32_16x16x32_bf16(Bt[n][k], At[m][k], acc[ai][bj][m][n], 0, 0, 0); __builtin_amdgcn_s_setprio(0); } while (0)
#define PG8_WAIT_V(n) asm volatile("s_waitcnt vmcnt(" #n ")" ::: "memory")
#define PG8_WAIT_L(n) asm volatile("s_waitcnt lgkmcnt(" #n ")" ::: "memory")
#define PG8_BAR __builtin_amdgcn_s_barrier()
#define PG8_SCHED __builtin_amdgcn_sched_barrier(0)
    Unit cur, nxt; int ui = 0;
    if (!S.next(0, cur)) return;
    f32x4 acc[2][2][4][2];
#pragma unroll
    for (int a = 0; a < 2; ++a)
#pragma unroll
        for (int b = 0; b < 2; ++b)
#pragma unroll
            for (int m = 0; m < 4; ++m)
#pragma unroll
                for (int n = 0; n < 2; ++n) acc[a][b][m][n] = (f32x4){0.f, 0.f, 0.f, 0.f};
    bf16x8 At[4][2], B0[2][2], B1[2][2];
    const char* cA = (const char*)g.A + (size_t)cur.pm * tstepA; const char* cB = (const char*)g.Bt + (size_t)cur.pn * tstepB;
    S.a_ready(cur);
    if constexpr (SP2) {
        PG8_STAGE(PG8_SB(0, 0), cB, voffB); PG8_STAGE(PG8_SB(0, 1), cB + hstepB, voffB); PG8_STAGE(PG8_SA(0, 0), cA, voffA); PG8_STAGE(PG8_SA(0, 1), cA + hstepA, voffA);
        if (wr == 1) PG8_BAR;
        PG8_WAIT_V(2); PG8_BAR;
        PG8_STAGE(PG8_SB(1, 0), cB + kstep, voffB); PG8_STAGE(PG8_SA(1, 0), cA + kstep, voffA); PG8_STAGE(PG8_SB(1, 1), cB + hstepB + kstep, voffB);
        PG8_WAIT_V(6); PG8_BAR;
    } else {
        PG8_STAGE(PG8_SB(0, 0), cB, voffB); PG8_STAGE(PG8_SA(0, 0), cA, voffA); PG8_STAGE(PG8_SB(0, 1), cB + hstepB, voffB); PG8_STAGE(PG8_SA(0, 1), cA + hstepA, voffA);
        if (wr == 1) PG8_BAR;
        PG8_WAIT_V(4); PG8_BAR;
        PG8_STAGE(PG8_SB(1, 0), cB + kstep, voffB); PG8_STAGE(PG8_SA(1, 0), cA + kstep, voffA); PG8_STAGE(PG8_SB(1, 1), cB + hstepB + kstep, voffB);
        PG8_WAIT_V(6); PG8_BAR;
    }
    for (;;) {
        const bool has_next = S.next(ui + 1, nxt);
        const char* nA = has_next ? (const char*)g.A + (size_t)nxt.pm * tstepA : cA; const char* nB = has_next ? (const char*)g.Bt + (size_t)nxt.pn * tstepB : cB;
        for (int t = 0; t < nt; t += 2) {
            const bool last = (t == nt - 2);
            const char* a1 = cA + (size_t)(t + 1) * kstep;
            const char* a2 = last ? nA : cA + (size_t)(t + 2) * kstep; const char* b2 = last ? nB : cB + (size_t)(t + 2) * kstep;
            const char* a3 = a2 + kstep; const char* b3 = b2 + kstep;
            if (last && has_next) S.a_ready(nxt);
            if constexpr (SP2) {
            PG8_LDB(B0, 0, 0); PG8_LDB(B1, 0, 1); PG8_SCHED; PG8_LDA(At, 0, 0); PG8_STAGE(PG8_SA(1, 1), a1 + hstepA, voffA);
            PG8_WAIT_V(8); PG8_WAIT_L(0); PG8_BAR; PG8_MMA(0, 0, At, B0); PG8_MMA(0, 1, At, B1); PG8_BAR; PG8_SCHED;
            PG8_LDA(At, 0, 1); PG8_STAGE(PG8_SB(0, 0), b2, voffB); PG8_STAGE(PG8_SB(0, 1), b2 + hstepB, voffB); PG8_STAGE(PG8_SA(0, 0), a2, voffA);
            PG8_WAIT_V(8); PG8_WAIT_L(0); PG8_BAR; PG8_MMA(1, 0, At, B0); PG8_MMA(1, 1, At, B1); PG8_BAR; PG8_SCHED;
            PG8_LDB(B0, 1, 0); PG8_LDB(B1, 1, 1); PG8_SCHED; PG8_LDA(At, 1, 0); PG8_STAGE(PG8_SA(0, 1), a2 + hstepA, voffA);
            PG8_WAIT_V(8); PG8_WAIT_L(0); PG8_BAR; PG8_MMA(0, 0, At, B0); PG8_MMA(0, 1, At, B1); PG8_BAR; PG8_SCHED;
            PG8_LDA(At, 1, 1); PG8_STAGE(PG8_SB(1, 0), b3, voffB); PG8_STAGE(PG8_SB(1, 1), b3 + hstepB, voffB); PG8_STAGE(PG8_SA(1, 0), a3, voffA);
            PG8_WAIT_V(8); PG8_WAIT_L(0); PG8_BAR; PG8_MMA(1, 0, At, B0); PG8_MMA(1, 1, At, B1); PG8_BAR; PG8_SCHED;
            } else {
            PG8_LDB(B0, 0, 0); PG8_SCHED; PG8_LDA(At, 0, 0); PG8_STAGE(PG8_SA(1, 1), a1 + hstepA, voffA);
            PG8_WAIT_L(8); PG8_BAR; PG8_WAIT_L(0); PG8_MMA(0, 0, At, B0); PG8_BAR; PG8_SCHED;
            PG8_LDB(B1, 0, 1); PG8_STAGE(PG8_SB(0, 0), b2, voffB);
            PG8_BAR; PG8_WAIT_L(0); PG8_MMA(0, 1, At, B1); PG8_BAR;
            PG8_LDA(At, 0, 1); PG8_STAGE(PG8_SA(0, 0), a2, voffA);
            PG8_BAR; PG8_WAIT_L(0); PG8_MMA(1, 0, At, B0); PG8_BAR; PG8_SCHED;
            PG8_STAGE(PG8_SB(0, 1), b2 + hstepB, voffB);
            PG8_WAIT_V(6); PG8_BAR; PG8_MMA(1, 1, At, B1); PG8_BAR;
            PG8_LDB(B0, 1, 0); PG8_SCHED; PG8_LDA(At, 1, 0); PG8_STAGE(PG8_SA(0, 1), a2 + hstepA, voffA);
            PG8_WAIT_L(8); PG8_BAR; PG8_WAIT_L(0); PG8_MMA(0, 0, At, B0); PG8_BAR; PG8_SCHED;
            PG8_LDB(B1, 1, 1); PG8_STAGE(PG8_SB(1, 0), b3, voffB);
            PG8_BAR; PG8_WAIT_L(0); PG8_MMA(0, 1, At, B1); PG8_BAR;
            PG8_LDA(At, 1, 1); PG8_STAGE(PG8_SA(1, 0), a3, voffA);
            PG8_BAR; PG8_WAIT_L(0); PG8_MMA(1, 0, At, B0); PG8_BAR; PG8_SCHED;
            PG8_STAGE(PG8_SB(1, 1), b3 + hstepB, voffB);
            PG8_WAIT_V(6); PG8_BAR; PG8_MMA(1, 1, At, B1); PG8_BAR;
            }
        }
        if constexpr (ALIGN_EPI) { if (wr == 0) PG8_BAR; }
        if constexpr (!Epi::AFTER_DRAIN) { E(acc, cur, wr, wc, fr, fq); S.done(cur); }
        if (!has_next) break;
#pragma unroll
        for (int a = 0; a < 2; ++a)
#pragma unroll
            for (int b = 0; b < 2; ++b)
#pragma unroll
                for (int m = 0; m < 4; ++m)
#pragma unroll
                    for (int n = 0; n < 2; ++n) acc[a][b][m][n] = (f32x4){0.f, 0.f, 0.f, 0.f};
        cur = nxt; cA = nA; cB = nB; ++ui;
        if constexpr (ALIGN_EPI) { if (wr == 1) PG8_BAR; }
    }
    PG8_WAIT_V(0);
    if constexpr (!ALIGN_EPI) { if (wr == 0) PG8_BAR; }
    PG8_BAR;
    if constexpr (Epi::AFTER_DRAIN) { E.fused(acc, cur, wr, wc, fr, fq, lds, wid, lane); S.done(cur); }
#undef PG8_SA
#undef PG8_SB
#undef PG8_STAGE
#undef PG8_LDA
#undef PG8_LDB
#undef PG8_MMA
#undef PG8_WAIT_V
#undef PG8_WAIT_L
#undef PG8_BAR
#undef PG8_SCHED
}
}

#define KV_DECL uint4 rk0, rk1, rk2, rk3, rv0, rv1, rv2, rv3
#define KV_LOAD(kb_, dil_) do { const int kk_ = lane >> 3; \
    const bf16_t* p0_ = qkv + (rowb + min(max((kb_) + (dil_) * kk_, 0), S - 1)) * ld + (lane & 7) * 8; \
    const bf16_t* p1_ = qkv + (rowb + min(max((kb_) + (dil_) * (kk_ + 8), 0), S - 1)) * ld + (lane & 7) * 8; \
    const bf16_t* p2_ = qkv + (rowb + min(max((kb_) + (dil_) * (kk_ + 16), 0), S - 1)) * ld + (lane & 7) * 8; \
    const bf16_t* p3_ = qkv + (rowb + min(max((kb_) + (dil_) * (kk_ + 24), 0), S - 1)) * ld + (lane & 7) * 8; \
    rk0 = *(const uint4*)(p0_ + kcol); rk1 = *(const uint4*)(p1_ + kcol); rk2 = *(const uint4*)(p2_ + kcol); rk3 = *(const uint4*)(p3_ + kcol); \
    rv0 = *(const uint4*)(p0_ + vcol); rv1 = *(const uint4*)(p1_ + vcol); rv2 = *(const uint4*)(p2_ + vcol); rv3 = *(const uint4*)(p3_ + vcol); } while (0)
#define KV_STORE() do { char* wp_ = vl + (lane >> 3) * 144 + (lane & 7) * 16; \
    *(uint4*)(wp_) = rk0; *(uint4*)(wp_ + 8 * 144) = rk1; *(uint4*)(wp_ + 16 * 144) = rk2; *(uint4*)(wp_ + 24 * 144) = rk3; \
    *(uint4*)(wp_ + 4608) = rv0; *(uint4*)(wp_ + 4608 + 8 * 144) = rv1; *(uint4*)(wp_ + 4608 + 16 * 144) = rv2; *(uint4*)(wp_ + 4608 + 24 * 144) = rv3; } while (0)

DI bf16x8 v_frag(const char* vbase, int s, int dt) {
    typedef __attribute__((address_space(3))) v4i16_t* lp_t;
    const char* a = vbase + s * (16 * 144) + dt * 64;
    const s16x4 lo = __builtin_bit_cast(s16x4, __builtin_amdgcn_ds_read_tr16_b64_v4i16((lp_t)(a)));
    const s16x4 hi = __builtin_bit_cast(s16x4, __builtin_amdgcn_ds_read_tr16_b64_v4i16((lp_t)(a + 8 * 144)));
    return __builtin_shufflevector(lo, hi, 0, 1, 2, 3, 4, 5, 6, 7);
}

template <int OFF> DI bf16x8 pack8v(const f32x16& p) {
    typedef unsigned u32x4 __attribute__((ext_vector_type(4)));
    u32x4 w; w[0] = pk2(p[OFF + 0], p[OFF + 1]); w[1] = pk2(p[OFF + 2], p[OFF + 3]); w[2] = pk2(p[OFF + 4], p[OFF + 5]); w[3] = pk2(p[OFF + 6], p[OFF + 7]);
    return __builtin_bit_cast(bf16x8, w);
}

DI void win_attn_wave(bf16_t* qkv, int ld, int b, int qcol, int kcol, int vcol, int tq0, int qstride,
                      float slope2, float m_init, float l_init, int mode, char* vl, int lane, bool dry) {
    const int r = lane & 31, h = lane >> 5;
    const size_t rowb = (size_t)b * S;
    const int tq = tq0 + qstride * r;
    const int tqlast = tq0 + qstride * 31;
    bf16x8 qf[4];
    {
        const bf16_t* qp = qkv + (rowb + tq) * ld + qcol + h * 32;
#pragma unroll
        for (int ks = 0; ks < 4; ++ks) qf[ks] = *(const bf16x8*)(qp + ks * 8);
    }
    f32x16 o0, o1;
#pragma unroll
    for (int i = 0; i < 16; ++i) { o0[i] = 0.f; o1[i] = 0.f; }
    float m = m_init, l = (h == 0) ? l_init : 0.f;
    const float sc2 = 0.125f * LOG2E;
    const int i16 = lane & 15;
    const char* vbase = vl + 4608 + (4 * h + (i16 >> 2)) * 144 + (16 * ((lane >> 4) & 1) + 4 * (i16 & 3)) * 2;
    const int npat = mode ? 3 : 1;
    const char* kfp = vl + r * 144 + h * 64;
    KV_DECL;
    for (int pi = 0; pi < npat; ++pi) {
        int dil, W, kfirst, nt;
        if (!mode) { dil = 1; W = 127; kfirst = tq0 - 128; nt = 5; }
        else if (pi == 0) { dil = 1; W = 128; kfirst = tq0 - 128; nt = 20; }
        else if (pi == 1) { dil = 4; W = 512; kfirst = tq0 - 512; nt = 8; }
        else { dil = 16; W = 2048; kfirst = tq0 - 2048; nt = 5; }
        const int step = 32 * dil;
        int t0 = 0;
        { const int need = -kfirst - 31 * dil; if (need > 0) t0 = (need + step - 1) / step; }
        if (t0 >= nt) continue;
        KV_LOAD(kfirst + t0 * step, dil);
        for (int tile = t0; tile < nt; ++tile) {
            const int kb = kfirst + tile * step;
            KV_STORE();
            asm volatile("" ::: "memory");
            if (tile + 1 < nt) KV_LOAD(kb + step, dil);
            f32x16 s;
#pragma unroll
            for (int i = 0; i < 16; ++i) s[i] = 0.f;
#pragma unroll
            for (int ks = 0; ks < 4; ++ks) s = MFMA(*(const bf16x8*)(kfp + ks * 16), qf[ks], s);
            f32x16 sv; float mloc = -INFINITY;
            const int d0 = tq - kb - 4 * h * dil;
            const unsigned wlim = (unsigned)min(W, tq);
#pragma unroll
            for (int i = 0; i < 16; ++i) {
                const int diff = d0 - dil * crow(i, 0);
                const float sb = s[i] * sc2 - slope2 * (float)diff;
                sv[i] = ((unsigned)diff <= wlim) ? sb : -INFINITY;
                mloc = fmaxf(mloc, sv[i]);
            }
            mloc = fmaxf(mloc, __shfl_xor(mloc, 32));
            const float mn = fmaxf(m, mloc);
            float ps = 0.f;
#pragma unroll
            for (int i = 0; i < 16; ++i) { sv[i] = fexp2(sv[i] - mn); ps += sv[i]; }
            if (__builtin_amdgcn_ballot_w64(mn != m) != 0) {
                const float alpha = fexp2(m - mn);
                l *= alpha;
#pragma unroll
                for (int i = 0; i < 16; ++i) { o0[i] *= alpha; o1[i] *= alpha; }
                m = mn;
            }
            l += ps;
            const bf16x8 p0 = pack8v<0>(sv), p1 = pack8v<8>(sv);
            o0 = MFMA(v_frag(vbase, 0, 0), p0, o0);
            o0 = MFMA(v_frag(vbase, 1, 0), p1, o0);
            o1 = MFMA(v_frag(vbase, 0, 1), p0, o1);
            o1 = MFMA(v_frag(vbase, 1, 1), p1, o1);
            asm volatile("" ::: "memory");
        }
    }
    const float lt = l + __shfl_xor(l, 32);
    const float inv = 1.f / lt;
    if (dry) { if (o0[0] + o1[0] + lt == 12345.678f) qkv[0] = 1; return; }
    bf16_t* op = qkv + (rowb + tq) * ld + qcol + 4 * h;
#pragma unroll
    for (int g = 0; g < 4; ++g) {
        *(uint2*)(op + 8 * g) = make_uint2(pk2(o0[4 * g] * inv, o0[4 * g + 1] * inv), pk2(o0[4 * g + 2] * inv, o0[4 * g + 3] * inv));
        *(uint2*)(op + 32 + 8 * g) = make_uint2(pk2(o1[4 * g] * inv, o1[4 * g + 1] * inv), pk2(o1[4 * g + 2] * inv, o1[4 * g + 3] * inv));
    }
}

DI void stick_wave(bf16_t* qkv, int ld, int b, int qcol, int kcol, int vcol, int qt, char* vl, int lane, bool dry) {
    const int r = lane & 31, h = lane >> 5;
    const size_t rowb = (size_t)b * S;
    const int tq = qt * 32 + r;
    bf16x8 qf[4];
    {
        const bf16_t* qp = qkv + (rowb + tq) * ld + qcol + h * 32;
#pragma unroll
        for (int ks = 0; ks < 4; ++ks) qf[ks] = *(const bf16x8*)(qp + ks * 8);
    }
    f32x16 o0, o1;
#pragma unroll
    for (int i = 0; i < 16; ++i) { o0[i] = 0.f; o1[i] = 0.f; }
    float R = 1.f;
    const int i16 = lane & 15;
    const char* vbase = vl + 4608 + (4 * h + (i16 >> 2)) * 144 + (16 * ((lane >> 4) & 1) + 4 * (i16 & 3)) * 2;
    const char* kfp = vl + r * 144 + h * 64;
    KV_DECL;
    KV_LOAD(qt * 32, 1);
    for (int tile = qt; tile >= 0; --tile) {
        KV_STORE();
        asm volatile("" ::: "memory");
        if (tile > 0) KV_LOAD((tile - 1) * 32, 1);
        f32x16 s;
#pragma unroll
        for (int i = 0; i < 16; ++i) s[i] = 0.f;
#pragma unroll
        for (int ks = 0; ks < 4; ++ks) s = MFMA(*(const bf16x8*)(kfp + ks * 16), qf[ks], s);
        const bool diag = (tile == qt);
        f32x16 sg, kp;
#pragma unroll
        for (int i = 0; i < 16; ++i) {
            const float z2 = fminf(s[i] * (0.125f * LOG2E), 80.f);
            const float t = fexp2(z2);
            const float k = __builtin_amdgcn_rcpf(1.f + t);
            kp[i] = k; sg[i] = t * k;
        }
        if (diag) {
#pragma unroll
            for (int i = 0; i < 16; ++i) { const bool strict = crow(i, h) < r; kp[i] = strict ? kp[i] : 1.f; sg[i] = strict ? sg[i] : 0.f; }
        }
        float G[4], PG[4], both[4];
#pragma unroll
        for (int g = 0; g < 4; ++g) { G[g] = (kp[4 * g] * kp[4 * g + 1]) * (kp[4 * g + 2] * kp[4 * g + 3]); PG[g] = __shfl_xor(G[g], 32); both[g] = G[g] * PG[g]; }
        float Sx[4];
        Sx[3] = 1.f; Sx[2] = both[3]; Sx[1] = both[3] * both[2]; Sx[0] = Sx[1] * both[1];
        f32x16 a;
#pragma unroll
        for (int g = 0; g < 4; ++g) {
            float la = R * Sx[g] * (h == 0 ? PG[g] : 1.f);
#pragma unroll
            for (int j = 3; j >= 0; --j) {
                a[4 * g + j] = sg[4 * g + j] * la;
                la *= kp[4 * g + j];
            }
        }
        R *= Sx[0] * both[0];
        const bf16x8 p0 = pack8v<0>(a), p1 = pack8v<8>(a);
        o0 = MFMA(v_frag(vbase, 0, 0), p0, o0);
        o0 = MFMA(v_frag(vbase, 1, 0), p1, o0);
        o1 = MFMA(v_frag(vbase, 0, 1), p0, o1);
        o1 = MFMA(v_frag(vbase, 1, 1), p1, o1);
        asm volatile("" ::: "memory");
        if (__builtin_amdgcn_ballot_w64(R >= 1.17549435e-38f) == 0) break;
    }
    if (dry) { if (o0[0] + o1[0] == 12345.678f) qkv[0] = 1; return; }
    bf16_t* op = qkv + (rowb + tq) * ld + qcol + 4 * h;
#pragma unroll
    for (int g = 0; g < 4; ++g) {
        *(uint2*)(op + 8 * g) = make_uint2(pk2(o0[4 * g], o0[4 * g + 1]), pk2(o0[4 * g + 2], o0[4 * g + 3]));
        *(uint2*)(op + 32 + 8 * g) = make_uint2(pk2(o1[4 * g], o1[4 * g + 1]), pk2(o1[4 * g + 2], o1[4 * g + 3]));
    }
}

DI void attn_even_phase(const Params& P, char* smem, bool dry) {
    const int tid_ = otid(); const int lane = tid_ & 63, wid = tid_ >> 6;
    bf16_t* qkv = (bf16_t*)(P.ws + OFF_BIG);
    char* vl = smem + wid * 9216;
    for (int it = blockIdx.x * 8 + wid; it < 2048 + 4096; it += gridDim.x * 8) {
        if (it < 2048) {
            const int bh = it >> 6, p = it & 63; const int b = bh >> 3, head = bh & 7;
            stick_wave(qkv, 2304, b, 512 + head * 64, 1280 + head * 64, 1792 + head * 64, 127 - p, vl, lane, dry);
            stick_wave(qkv, 2304, b, 512 + head * 64, 1280 + head * 64, 1792 + head * 64, p, vl, lane, dry);
        } else {
            const int v = it - 2048; const int g = v & 3; const int qt = (v >> 2) & 127; const int rest = v >> 9; const int b = rest >> 1, kvh = rest & 1;
            const int head = kvh * 4 + g;
            const float slope = exp2f(-(float)(head + 1));
            const float sink = P.in[9][head];
            win_attn_wave(qkv, 2304, b, head * 64, 1024 + kvh * 64, 1152 + kvh * 64, qt * 32, 1, slope * LOG2E, sink * LOG2E, 1.f, 0, vl, lane, dry);
        }
    }
}

DI void attn_odd_phase(const Params& P, char* smem, bool dry) {
    const int tid_ = otid(); const int lane = tid_ & 63, wid = tid_ >> 6;
    bf16_t* qkv = (bf16_t*)(P.ws + OFF_BIG);
    char* vl = smem + wid * 9216;
    for (int it = blockIdx.x * 8 + wid; it < 8192; it += gridDim.x * 8) {
        const int res16 = it & 15; const int u0 = ((it >> 4) & 7) * 32; const int head = (it >> 7) & 15; const int b = it >> 11;
        const float slope = exp2f(-0.5f * (float)(head + 1));
        win_attn_wave(qkv, 3072, b, head * 64, 1024 + head * 64, 2048 + head * 64, res16 + 16 * u0, 16, slope * LOG2E, -1e30f, 0.f, 1, vl, lane, dry);
    }
}

DI void xattn_wave(bf16_t* qb, const bf16_t* Kn, const bf16_t* VT, const float* qg, float kmax2, int b, int head, int tok0, char* ql, int lane, bool dry) {
    const int r = lane & 31, h = lane >> 5;
    const size_t token = (size_t)b * S + tok0 + r;
    bf16_t* qp = qb + token * D + head * 256 + h * 128;
    float ss = 0.f;
#pragma unroll
    for (int ks = 0; ks < 16; ++ks) {
        const uint4 v = *(const uint4*)(qp + ks * 8);
        const unsigned w[4] = {v.x, v.y, v.z, v.w};
#pragma unroll
        for (int e = 0; e < 4; ++e) { const float a = bflo(w[e]), c = bfhi(w[e]); ss += a * a + c * c; }
    }
    ss += __shfl_xor(ss, 32);
    const float inv = __builtin_amdgcn_rsqf(ss * (1.f / 256.f) + EPS);
    float qq2 = 0.f;
#pragma unroll
    for (int ks = 0; ks < 16; ++ks) {
        const uint4 v = *(const uint4*)(qp + ks * 8);
        const float4 g0 = *(const float4*)(qg + h * 128 + ks * 8), g1 = *(const float4*)(qg + h * 128 + ks * 8 + 4);
        uint4 o;
        o.x = pk2(bflo(v.x) * inv * g0.x, bfhi(v.x) * inv * g0.y); o.y = pk2(bflo(v.y) * inv * g0.z, bfhi(v.y) * inv * g0.w);
        o.z = pk2(bflo(v.z) * inv * g1.x, bfhi(v.z) * inv * g1.y); o.w = pk2(bflo(v.w) * inv * g1.z, bfhi(v.w) * inv * g1.w);
        qq2 += bflo(o.x) * bflo(o.x) + bfhi(o.x) * bfhi(o.x) + bflo(o.y) * bflo(o.y) + bfhi(o.y) * bfhi(o.y)
             + bflo(o.z) * bflo(o.z) + bfhi(o.z) * bfhi(o.z) + bflo(o.w) * bflo(o.w) + bfhi(o.w) * bfhi(o.w);
        *(uint4*)(ql + (ks * 64 + lane) * 16) = o;
    }
    qq2 += __shfl_xor(qq2, 32);
    asm volatile("" ::: "memory");
    const float sc2 = 0.0625f * LOG2E;
    const bf16_t* kp0 = Kn + ((size_t)(b * 4 + head) * 8 * 16 * 64 + lane) * 8;
    const float m = __builtin_amdgcn_sqrtf(qq2 * kmax2) * 1.001f;
    float l = 0.f;
    bf16x8 pf[8][2];
    bf16x8 kc[16], kn[16];
#pragma unroll
    for (int ks = 0; ks < 16; ++ks) kc[ks] = *(const bf16x8*)(kp0 + ks * 512);
#pragma unroll
    for (int tile = 0; tile < 8; ++tile) {
        if (tile < 7) {
#pragma unroll
            for (int ks = 0; ks < 16; ++ks) kn[ks] = *(const bf16x8*)(kp0 + (size_t)(tile + 1) * 16 * 512 + ks * 512);
        }
        f32x16 s, s_b;
#pragma unroll
        for (int i = 0; i < 16; ++i) { s[i] = 0.f; s_b[i] = 0.f; }
#pragma unroll
        for (int ks = 0; ks < 16; ks += 2) {
            const bf16x8 qf0 = *(const bf16x8*)(ql + (ks * 64 + lane) * 16);
            const bf16x8 qf1 = *(const bf16x8*)(ql + ((ks + 1) * 64 + lane) * 16);
            s = MFMA(kc[ks], qf0, s);
            s_b = MFMA(kc[ks + 1], qf1, s_b);
        }
#pragma unroll
        for (int i = 0; i < 16; ++i) s[i] += s_b[i];
#pragma unroll
        for (int i = 0; i < 16; ++i) { s[i] = fexp2((s[i] - m) * sc2); l += s[i]; }
        pf[tile][0] = pack8v<0>(s); pf[tile][1] = pack8v<8>(s);
#pragma unroll
        for (int ks = 0; ks < 16; ++ks) kc[ks] = kn[ks];
    }
    l += __shfl_xor(l, 32);
    const float il = 1.f / l;
    bf16_t* op = qb + token * D + head * 256 + 4 * h;
    const bf16_t* vp0 = VT + (((size_t)(b * 4 + head) * 8 * 8 * 2 * 64) + lane) * 8;
    bf16x8 vc[16], vn[16];
#pragma unroll
    for (int e = 0; e < 16; ++e) vc[e] = *(const bf16x8*)(vp0 + e * 512);
#pragma unroll 1
    for (int dt = 0; dt < 8; ++dt) {
        const int dn = dt < 7 ? dt + 1 : 7;
#pragma unroll
        for (int e = 0; e < 16; ++e) vn[e] = *(const bf16x8*)(vp0 + (size_t)dn * 16 * 512 + e * 512);
        f32x16 o, o_b;
#pragma unroll
        for (int i = 0; i < 16; ++i) { o[i] = 0.f; o_b[i] = 0.f; }
#pragma unroll
        for (int tile = 0; tile < 8; ++tile) { o = MFMA(vc[tile * 2], pf[tile][0], o); o_b = MFMA(vc[tile * 2 + 1], pf[tile][1], o_b); }
#pragma unroll
        for (int i = 0; i < 16; ++i) o[i] += o_b[i];
#pragma unroll
        for (int g = 0; g < 4; ++g)
            if (dry) { if (o[4 * g] == 12345.678f) qb[0] = 1; } else *(uint2*)(op + dt * 32 + 8 * g) = make_uint2(pk2(o[4 * g] * il, o[4 * g + 1] * il), pk2(o[4 * g + 2] * il, o[4 * g + 3] * il));
#pragma unroll
        for (int e = 0; e < 16; ++e) vc[e] = vn[e];
    }
}

DI void xattn_phase(const Params& P, int l, char* smem, bool dry) {
    const int tid_ = otid(); const int lane = tid_ & 63, wid = tid_ >> 6;
    bf16_t* qb = (bf16_t*)(P.ws + OFF_BIG);
    const bf16_t* Kn = (const bf16_t*)(P.ws + OFF_KF + (size_t)l * SZ_MM);
    const bf16_t* VT = (const bf16_t*)(P.ws + OFF_VT + (size_t)l * SZ_MM);
    const float* qg = P.in[19] + l * 256;
    char* ql = smem + wid * 16384;
    for (int it = blockIdx.x * 8 + wid; it < 2048; it += gridDim.x * 8) {
        const int qt = it & 127, head = (it >> 7) & 3, b = it >> 9;
        const float kmax2 = ((const float*)(P.ws + OFF_KMAX))[l * 16 + b * 4 + head];
        xattn_wave(qb, Kn, VT, qg, kmax2, b, head, qt * 32, ql, lane, dry);
    }
}

DI void knorm_phase(const Params& P) {
    const int tid_ = otid(); const int lane = tid_ & 63, wid = tid_ >> 6;
    for (int u = blockIdx.x * 8 + wid; u < 8192; u += gridDim.x * 8) {
        const int l = u >> 12, row = (u >> 2) & 1023, head = u & 3;
        const bf16_t* kp = (const bf16_t*)(P.ws + OFF_KN + (size_t)l * SZ_MM) + (size_t)row * D + head * 256 + lane * 4;
        const uint2 v = *(const uint2*)kp;
        const float a0 = bflo(v.x), a1 = bfhi(v.x), a2 = bflo(v.y), a3 = bfhi(v.y);
        float ss = a0 * a0 + a1 * a1 + a2 * a2 + a3 * a3;
        ss = wave_sum(ss);
        const float inv = __builtin_amdgcn_rsqf(ss * (1.f / 256.f) + EPS);
        const float4 g = *(const float4*)(P.in[20] + l * 256 + lane * 4);
        const int b = row >> 8, key = row & 255;
        const int h = lane >> 5, ks = (lane & 31) >> 1, j0 = (lane & 1) * 4;
        bf16_t* dp = (bf16_t*)(P.ws + OFF_KF + (size_t)l * SZ_MM) + ((((((size_t)(b * 4 + head) * 8 + (key >> 5)) * 16 + ks) * 64) + h * 32 + (key & 31)) << 3) + j0;
        const unsigned w0_ = pk2(a0 * inv * g.x, a1 * inv * g.y), w1_ = pk2(a2 * inv * g.z, a3 * inv * g.w);
        *(uint2*)dp = make_uint2(w0_, w1_);
        float kk2 = bflo(w0_) * bflo(w0_) + bfhi(w0_) * bfhi(w0_) + bflo(w1_) * bflo(w1_) + bfhi(w1_) * bfhi(w1_);
        kk2 = wave_sum(kk2);
        if (lane == 0) atomicMax((unsigned*)(P.ws + OFF_KMAX) + l * 16 + b * 4 + head, __float_as_uint(kk2));
    }
}

DI void fast_grid_sync(unsigned* bar, unsigned target) {
    asm volatile("s_waitcnt vmcnt(0) lgkmcnt(0)" ::: "memory");
    __syncthreads();
    if (threadIdx.x == 0) {
        __builtin_amdgcn_fence(__ATOMIC_RELEASE, "agent");
        asm volatile("s_waitcnt vmcnt(0)" ::: "memory");
        __hip_atomic_fetch_add(bar, 1u, __ATOMIC_RELAXED, __HIP_MEMORY_SCOPE_AGENT);
        while (__hip_atomic_load(bar, __ATOMIC_RELAXED, __HIP_MEMORY_SCOPE_AGENT) < target) __builtin_amdgcn_s_sleep(2);
        __builtin_amdgcn_fence(__ATOMIC_ACQUIRE, "agent");
        asm volatile("s_waitcnt vmcnt(0)" ::: "memory");
    }
    __syncthreads();
}

__global__ void __launch_bounds__(512) fwd_megakernel(Params P) {
    extern __shared__ __attribute__((aligned(16))) char smem[];
    cg::grid_group grid = cg::this_grid();
    unsigned nbar = 0;
#pragma unroll 1
    for (int ph = 0; ph < 21; ++ph) {
        float* ssq = (float*)(P.ws + OFF_SSQ);
        bf16_t* xb = (bf16_t*)(P.ws + OFF_XB);
        bf16_t* big = (bf16_t*)(P.ws + OFF_BIG);
        int nrep = 1;
        if (ph > 0) { const int s_ = (ph - 1) % 10; const int kind = (s_ == 3) ? 2 : (s_ == 6) ? 4 : 1; if (PROBE_MASK & kind) nrep = 2; }
        for (int rep = 0; rep < nrep; ++rep) {
        const bool dry = rep + 1 < nrep;
        if (ph == 0) {
            phase0(P, smem);
        } else {
            const int l = (ph - 1) / 10, s = (ph - 1) % 10;
            if (s == 3) {
                if (l == 0) attn_even_phase(P, smem, dry); else attn_odd_phase(P, smem, dry);
            } else if (s == 6) {
                xattn_phase(P, l, smem, dry);
            } else {
                pg8::Gemm g; pg8::Epi E;
                g.A = xb; g.lda = D; g.K = D; g.M = T; g.N = D; g.Bt = nullptr;
                E.mode = 1; E.rs = nullptr; E.O = big; E.ldo = D; E.xin = P.out; E.xout = P.out; E.xb = xb; E.ssq_out = ssq; E.alpha = 1.f;
                E.qg = nullptr; E.kg = nullptr; E.qn_end = 0; E.kn_beg = 0; E.kn_end = 0;
                if (s == 0 || s == 8) {
                    g.Bt = (const bf16_t*)(P.ws + (s == 0 ? OFF_GU1 : OFF_GU2) + (size_t)l * SZ_GU); g.N = NGU;
                    E.mode = 0; E.rs = ssq + (size_t)(4 * l + (s == 0 ? 0 : 3)) * T; E.ldo = DFF;
                } else if (s == 1 || s == 9) {
                    g.A = big; g.lda = DFF; g.K = DFF;
                    g.Bt = (const bf16_t*)(P.ws + (s == 1 ? OFF_DN1 : OFF_DN2) + (size_t)l * SZ_DN);
                    E.alpha = 0.5f; E.ssq_out = ssq + (size_t)(4 * l + (s == 1 ? 1 : 4)) * T;
                    if (ph == 2) E.xin = P.in[0];
                    if (ph == 20) E.xb = nullptr;
                } else if (s == 2) {
                    E.mode = 2; E.rs = ssq + (size_t)(4 * l + 1) * T;
                    if (l == 0) { g.Bt = (const bf16_t*)(P.ws + OFF_EVIN); g.N = 2304; E.ldo = 2304; E.qg = P.in[7]; E.kg = P.in[8]; E.qn_end = 512; E.kn_beg = 1024; E.kn_end = 1152; }
                    else { g.Bt = (const bf16_t*)(P.ws + OFF_ODIN); g.N = 3072; E.ldo = 3072; E.qg = P.in[12]; E.kg = P.in[13]; E.qn_end = 1024; E.kn_beg = 1024; E.kn_end = 2048; }
                } else if (s == 4) {
                    g.A = big;
                    if (l == 0) { g.Bt = (const bf16_t*)(P.ws + OFF_EVOUT); g.lda = 2304; }
                    else { g.Bt = (const bf16_t*)(P.ws + OFF_ODOUT); g.lda = 3072; }
                    E.ssq_out = ssq + (size_t)(4 * l + 2) * T;
                } else if (s == 5) {
                    g.Bt = (const bf16_t*)(P.ws + OFF_WQ + (size_t)l * SZ_MM); E.mode = 2; E.rs = ssq + (size_t)(4 * l + 2) * T; E.ldo = D;
                } else {
                    g.A = big; g.Bt = (const bf16_t*)(P.ws + OFF_WO + (size_t)l * SZ_MM); E.ssq_out = ssq + (size_t)(4 * l + 3) * T;
                }
                pg8::StaticOrder So; So.init(T, g.N, (int)gridDim.x, (int)blockIdx.x);
                E.dryrun = 0;
#if PROBE_GEMM
                for (int rep_ = 0; rep_ < 2; ++rep_) {
                pg8::Epi E2 = E;
                if (rep_ == 0) { if (PROBE_GEMM == 1) E2.dryrun = 1; else if (E.mode == 1) { E2.alpha = 0.f; E2.ssq_out = ssq + (size_t)8 * T; if (ph == 2) E2.xout = P.out; } }
                __syncthreads();
                pg8::gemm_phase<pg8::Epi, pg8::StaticOrder, true, true>((PG8_LAS unsigned char*)smem, g, So, rep_ == 0 ? E2 : E);
                ++nbar; fast_grid_sync((unsigned*)(P.ws + OFF_BAR), nbar * gridDim.x);
                }
#else
                __syncthreads();
                pg8::gemm_phase<pg8::Epi, pg8::StaticOrder, true, true>((PG8_LAS unsigned char*)smem, g, So, E);
#endif
                if (ph == 1) {
                    GJob J;
                    J.A = xb; J.lda = D; J.ksplit = 1 << 30; J.kextra = 0; J.K = D; J.ntm = 4; J.mode = 3; J.rs = nullptr;
                    J.O = big; J.ldo = D; J.xin = P.out; J.xout = P.out; J.xb = xb; J.ssq_out = ssq; J.alpha = 1.f;
                    J.qg = nullptr; J.kg = nullptr; J.qn_end = 0; J.kn_end = 0; J.vt = nullptr; J.W = nullptr; J.ntn = 8;
                    gemm_phase(J, 0, 64, P, smem, false);
                }
                if (ph == 2 && !dry) knorm_phase(P);
            }
        }
        if (P.ws == nullptr) grid.sync();
        if (ph < 20) { ++nbar; fast_grid_sync((unsigned*)(P.ws + OFF_BAR), nbar * gridDim.x); }
        }
    }
}

extern "C" void kernel_launch(void* const* d_in, const int* in_sizes, int n_in, void* d_out, int out_size, void* d_ws, size_t ws_size,
                              hipStream_t stream) {
    static int grid_blocks = 0;
    if (!grid_blocks) {
        int dev = 0, cus = 0, per_cu = 0;
        hipGetDevice(&dev);
        hipDeviceGetAttribute(&cus, hipDeviceAttributeMultiprocessorCount, dev);
        hipFuncSetAttribute((const void*)fwd_megakernel, hipFuncAttributeMaxDynamicSharedMemorySize, LDS_BYTES);
        hipOccupancyMaxActiveBlocksPerMultiprocessor(&per_cu, fwd_megakernel, NTHR, LDS_BYTES);
        if (per_cu < 1) per_cu = 1;
        if (per_cu > 1) per_cu = 1;
        grid_blocks = cus * per_cu;
    }
    if (ws_size < WS_NEED) { fprintf(stderr, "workspace too small: %zu < %zu\n", ws_size, (size_t)WS_NEED); return; }
    Params p{};
    for (int i = 0; i < 25; ++i) p.in[i] = (const float*)d_in[i];
    p.out = (float*)d_out; p.ws = (char*)d_ws;
    hipMemsetAsync((char*)d_ws + OFF_BAR, 0, 256, stream);
    void* args[] = {&p};
    hipError_t e = hipLaunchCooperativeKernel((void*)fwd_megakernel, dim3(grid_blocks), dim3(NTHR), args, LDS_BYTES, stream);
    if (e != hipSuccess) fprintf(stderr, "cooperative launch failed: %s (grid %d)\n", hipGetErrorString(e), grid_blocks);
}
```

```cpp
#include <hip/hip_runtime.h>
#include <hip/hip_cooperative_groups.h>
#include <cstdio>
#include <cstdint>
namespace cg = cooperative_groups;

#define DI __device__ __forceinline__
typedef unsigned short bf16_t;
typedef short bf16x8 __attribute__((ext_vector_type(8)));
typedef short s16x4 __attribute__((ext_vector_type(4)));
typedef float f32x16 __attribute__((ext_vector_type(16)));
typedef __bf16 bf2_t __attribute__((ext_vector_type(2)));
typedef float f2_t __attribute__((ext_vector_type(2)));
typedef short v4i16_t __attribute__((ext_vector_type(4)));
#define MFMA(a, b, c) __builtin_amdgcn_mfma_f32_32x32x16_bf16((a), (b), (c), 0, 0, 0)

constexpr int T = 16384, S = 4096, D = 1024, DFF = 2816, NGU = 5632;
constexpr float EPS = 1e-6f;
constexpr float LOG2E = 1.4426950408889634f;
constexpr float LN2 = 0.6931471805599453f;

constexpr size_t SZ_GU = (size_t)NGU * D * 2, SZ_DN = (size_t)D * DFF * 2, SZ_MM = (size_t)D * D * 2;
constexpr size_t OFF_GU1 = 0;
constexpr size_t OFF_DN1 = OFF_GU1 + 2 * SZ_GU;
constexpr size_t OFF_GU2 = OFF_DN1 + 2 * SZ_DN;
constexpr size_t OFF_DN2 = OFF_GU2 + 2 * SZ_GU;
constexpr size_t OFF_WQ = OFF_DN2 + 2 * SZ_DN;
constexpr size_t OFF_WKV = OFF_WQ + 2 * SZ_MM;
constexpr size_t OFF_WO = OFF_WKV + 4 * SZ_MM;
constexpr size_t OFF_EVIN = OFF_WO + 2 * SZ_MM;
constexpr size_t OFF_EVOUT = OFF_EVIN + (size_t)2304 * D * 2;
constexpr size_t OFF_ODIN = OFF_EVOUT + SZ_MM;
constexpr size_t OFF_ODOUT = OFF_ODIN + (size_t)3072 * D * 2;
constexpr size_t OFF_XB = OFF_ODOUT + SZ_MM;
constexpr size_t OFF_BIG = OFF_XB + (size_t)T * D * 2;
constexpr size_t OFF_MEMB = OFF_BIG + (size_t)T * 3072 * 2;
constexpr size_t OFF_KN = OFF_MEMB + SZ_MM;
constexpr size_t OFF_VT = OFF_KN + 2 * SZ_MM;
constexpr size_t OFF_SSQ = OFF_VT + 2 * SZ_MM;
constexpr size_t OFF_SSQM = OFF_SSQ + (size_t)9 * T * 4;
constexpr size_t OFF_KMAX = OFF_SSQM + 4096;
constexpr size_t OFF_BAR = OFF_KMAX + 256;
constexpr size_t OFF_KF = OFF_BAR + 256;
constexpr size_t WS_NEED = OFF_KF + 2 * SZ_MM;

#ifndef PROBE_MASK
#define PROBE_MASK 0
#endif
#ifndef PROBE_GEMM
#define PROBE_GEMM 0
#endif
constexpr int NTHR = 512;
constexpr int NST = 4;
constexpr int STAGE_B = 32768;
constexpr int OPB = 16384;
constexpr int LDS_BYTES = 131072;

struct Params { const float* in[25]; float* out; char* ws; };

DI unsigned pk2(float a, float b) { f2_t v = {a, b}; bf2_t r = __builtin_convertvector(v, bf2_t); return __builtin_bit_cast(unsigned, r); }
DI float bflo(unsigned w) { return __uint_as_float(w << 16); }
DI float bfhi(unsigned w) { return __uint_as_float(w & 0xffff0000u); }
DI int otid() { int t = threadIdx.x; asm volatile("" : "+v"(t)); return t; }
DI int crow(int i, int h) { return (i & 3) + 8 * (i >> 2) + 4 * h; }
DI float fexp2(float x) { return __builtin_amdgcn_exp2f(x); }
DI float flog2(float x) { return __builtin_amdgcn_logf(x); }

struct WJob { const float* src; bf16_t* dst; const float* gain; int K, N, gu; };

DI int wjob_tiles(int j) {
    if (j < 14) {
        const int kind = j >> 1;
        switch (kind) {
            case 0: case 2: return 16 * 88;
            case 1: case 3: return 44 * 16;
            case 4: return 256;
            case 5: return 512;
            default: return 256;
        }
    }
    if (j == 14) return 16 * 36;
    if (j == 16) return 16 * 48;
    return 256;
}

DI WJob get_wjob(const Params& P, int j) {
    WJob w; w.gain = nullptr; w.gu = 0;
    bf16_t* wsb = (bf16_t*)P.ws;
    if (j < 14) {
        const int kind = j >> 1, l = j & 1;
        switch (kind) {
            case 0: w.src = P.in[3] + (size_t)l * D * NGU; w.dst = (bf16_t*)(P.ws + OFF_GU1 + l * SZ_GU); w.gain = P.in[2] + l * D; w.K = D; w.N = NGU; w.gu = 1; break;
            case 1: w.src = P.in[4] + (size_t)l * DFF * D; w.dst = (bf16_t*)(P.ws + OFF_DN1 + l * SZ_DN); w.K = DFF; w.N = D; w.gu = 2; break;
            case 2: w.src = P.in[23] + (size_t)l * D * NGU; w.dst = (bf16_t*)(P.ws + OFF_GU2 + l * SZ_GU); w.gain = P.in[22] + l * D; w.K = D; w.N = NGU; w.gu = 1; break;
            case 3: w.src = P.in[24] + (size_t)l * DFF * D; w.dst = (bf16_t*)(P.ws + OFF_DN2 + l * SZ_DN); w.K = DFF; w.N = D; w.gu = 2; break;
            case 4: w.src = P.in[17] + (size_t)l * D * D; w.dst = (bf16_t*)(P.ws + OFF_WQ + l * SZ_MM); w.gain = P.in[15] + l * D; w.K = D; w.N = D; w.gu = 2; break;
            case 5: w.src = P.in[18] + (size_t)l * D * 2048; w.dst = (bf16_t*)(P.ws + OFF_WKV + l * 2 * SZ_MM); w.gain = P.in[16] + l * D; w.K = D; w.N = 2048; break;
            default: w.src = P.in[21] + (size_t)l * D * D; w.dst = (bf16_t*)(P.ws + OFF_WO + l * SZ_MM); w.K = D; w.N = D; w.gu = 2; break;
        }
    } else if (j == 14) { w.src = P.in[6]; w.dst = (bf16_t*)(P.ws + OFF_EVIN); w.gain = P.in[5]; w.K = D; w.N = 2304; w.gu = 3; }
    else if (j == 15) { w.src = P.in[10]; w.dst = (bf16_t*)(P.ws + OFF_EVOUT); w.K = D; w.N = D; w.gu = 2; }
    else if (j == 16) { w.src = P.in[11]; w.dst = (bf16_t*)(P.ws + OFF_ODIN); w.gain = P.in[5] + D; w.K = D; w.N = 3072; w.gu = 2; }
    else { w.src = P.in[14]; w.dst = (bf16_t*)(P.ws + OFF_ODOUT); w.K = D; w.N = D; w.gu = 2; }
    (void)wsb;
    return w;
}

DI void wconv_tile(const WJob& w, int t, float* sm, int tid, bool act) {
    const int ntn = w.N >> 6; const int tk = t / ntn, tn = t - tk * ntn;
    if (act) {
#pragma unroll
        for (int p = 0; p < 4; ++p) {
            const int kr = p * 16 + (tid >> 4);
            const float4 v = *(const float4*)(w.src + (size_t)(tk * 64 + kr) * w.N + tn * 64 + (tid & 15) * 4);
            const float g = w.gain ? w.gain[tk * 64 + kr] : 1.f;
            float* sp = sm + kr * 65 + (tid & 15) * 4;
            sp[0] = v.x * g; sp[1] = v.y * g; sp[2] = v.z * g; sp[3] = v.w * g;
        }
    }
    __syncthreads();
    if (act) {
        const int n = tid >> 2, kq = tid & 3; const int ng = tn * 64 + n;
        int drow = ng;
        if (w.gu == 1) drow = ng < DFF ? ((ng >> 7) * 256 + (ng & 127)) : (((ng - DFF) >> 7) * 256 + 128 + ((ng - DFF) & 127));
        else if (w.gu >= 2) {
            int a = ng;
            if (w.gu == 3) a = ng < 512 ? ng : ng < 768 ? ng + 512 : ng < 1280 ? ng - 256 : ng;
            drow = (a & ~255) + (((a >> 5) & 1) << 7) + (((a >> 6) & 3) << 5) + (a & 31);
        }
        unsigned o[8];
#pragma unroll
        for (int e = 0; e < 8; ++e) o[e] = pk2(sm[(kq * 16 + 2 * e) * 65 + n], sm[(kq * 16 + 2 * e + 1) * 65 + n]);
        uint4* dp = (uint4*)(w.dst + (size_t)drow * w.K + tk * 64 + kq * 16);
        dp[0] = make_uint4(o[0], o[1], o[2], o[3]); dp[1] = make_uint4(o[4], o[5], o[6], o[7]);
    }
    __syncthreads();
}

DI float wave_sum(float v) {
    v += __shfl_xor(v, 1); v += __shfl_xor(v, 2); v += __shfl_xor(v, 4); v += __shfl_xor(v, 8); v += __shfl_xor(v, 16); v += __shfl_xor(v, 32);
    return v;
}

DI void rowconv(const float* src, bf16_t* dst, float* ssq, int row, int lane) {
    const float* xr = src + (size_t)row * D;
    float ss = 0.f;
#pragma unroll
    for (int p = 0; p < 4; ++p) {
        const float4 v = *(const float4*)(xr + p * 256 + lane * 4);
        ss += v.x * v.x + v.y * v.y + v.z * v.z + v.w * v.w;
        *(uint2*)(dst + (size_t)row * D + p * 256 + lane * 4) = make_uint2(pk2(v.x, v.y), pk2(v.z, v.w));
    }
    ss = wave_sum(ss);
    if (lane == 0) ssq[row] = ss;
}

DI void phase0(const Params& P, char* smem) {
    const int tid = otid(), lane = tid & 63, wid = tid >> 6;
    float* ssq = (float*)(P.ws + OFF_SSQ);
    for (int i = blockIdx.x * NTHR + tid; i < 8 * T; i += gridDim.x * NTHR) ssq[T + i] = 0.f;
    if (blockIdx.x == 0 && tid < 32) ((unsigned*)(P.ws + OFF_KMAX))[tid] = 0u;
    constexpr int NW = 12352 / 2, NX = T / 8, NM = 1024 / 8;
    for (int u = blockIdx.x; u < NW + NX + NM; u += gridDim.x) {
        if (u < NW) {
            const int half = tid >> 8;
            int t = 2 * u + half, j = 0;
            for (; j < 17; ++j) { const int c = wjob_tiles(j); if (t < c) break; t -= c; }
            const WJob w = get_wjob(P, j);
            wconv_tile(w, t, (float*)smem + half * (64 * 65), tid & 255, true);
        } else if (u < NW + NX) {
            rowconv(P.in[0], (bf16_t*)(P.ws + OFF_XB), ssq, (u - NW) * 8 + wid, lane);
        } else {
            rowconv(P.in[1], (bf16_t*)(P.ws + OFF_MEMB), (float*)(P.ws + OFF_SSQM), (u - NW - NX) * 8 + wid, lane);
        }
    }
}

struct GJob {
    const bf16_t* A; const bf16_t* W;
    int lda, ksplit, kextra, K, ntm, ntn, mode;
    const float* rs;
    bf16_t* O; int ldo;
    const float* xin; float* xout; bf16_t* xb; float* ssq_out; float alpha;
    const float* qg; const float* kg; int qn_end, kn_end;
    bf16_t* vt;
};

typedef __attribute__((address_space(3))) unsigned* ldsu_t;
typedef const __attribute__((address_space(1))) unsigned* glbu_t;
DI void glds16(const bf16_t* g, char* l) { __builtin_amdgcn_global_load_lds((glbu_t)(const void*)g, (ldsu_t)(void*)l, 16, 0, 0); }

DI void gemm_tile(const GJob& J, int t, char* smem, bool dry) {
    const int tid = otid(), lane = tid & 63, wid = tid >> 6, wr = wid >> 2, wc = wid & 3;
    const int r = lane & 31, h = lane >> 5;
    int tm, tn;
    { const int gsz = 32 * J.ntn; const int g = t / gsz; const int rem = t - g * gsz; const int rows = min(32, J.ntm - g * 32); tn = rem / rows; tm = g * 32 + (rem - tn * rows); }
    const int lrow = wid * 16 + (lane >> 2);
    const int csw = ((lane & 3) ^ ((lane >> 4) & 3)) * 8;
    const bf16_t* Ag = J.A + (size_t)(tm * 256 + lrow) * J.lda + csw;
    const bf16_t* Wg = J.W + (size_t)(tn * 256 + lrow) * J.K + csw;
    const size_t astr = (size_t)128 * J.lda, wstr = (size_t)128 * J.K;
    char* lb = smem + tid * 16;
    const int nk = J.K >> 5;
#define GLDS(kt, buf) do { const int k0_ = (kt) * 32; const int ka_ = k0_ + (k0_ >= J.ksplit ? J.kextra : 0); char* l_ = lb + (buf) * STAGE_B; \
        glds16(Ag + ka_, l_); glds16(Ag + astr + ka_, l_ + 8192); glds16(Wg + k0_, l_ + OPB); glds16(Wg + wstr + k0_, l_ + OPB + 8192); } while (0)
    f32x16 acc[4][2];
#pragma unroll
    for (int a = 0; a < 4; ++a)
#pragma unroll
        for (int b = 0; b < 2; ++b)
#pragma unroll
            for (int i = 0; i < 16; ++i) acc[a][b][i] = 0.f;
    const int fr = (r >> 2) & 3;
    const int xrow = (wc * 64 + r) * 64, wrow = OPB + (wr * 128 + r) * 64;
    const int co0 = ((0 + h) ^ fr) * 16, co1 = ((2 + h) ^ fr) * 16;

    __syncthreads();
    GLDS(0, 0); GLDS(1, 1); GLDS(2, 2);
    asm volatile("s_waitcnt vmcnt(8)" ::: "memory");
    __builtin_amdgcn_s_barrier();
    bf16x8 w0[4], x0[2], w1[4], x1[2];
#define LOADF(W_, X_, sb_, co_) do { _Pragma("unroll") for (int ti = 0; ti < 2; ++ti) X_[ti] = *(const bf16x8*)((sb_) + xrow + ti * 2048 + (co_)); \
        _Pragma("unroll") for (int fi = 0; fi < 4; ++fi) W_[fi] = *(const bf16x8*)((sb_) + wrow + fi * 2048 + (co_)); } while (0)
#define MFMA8(W_, X_) do { __builtin_amdgcn_s_setprio(1); _Pragma("unroll") for (int fi = 0; fi < 4; ++fi) _Pragma("unroll") for (int ti = 0; ti < 2; ++ti) \
        acc[fi][ti] = MFMA(W_[fi], X_[ti], acc[fi][ti]); __builtin_amdgcn_s_setprio(0); } while (0)
    LOADF(w0, x0, smem, co0);
    __builtin_amdgcn_s_waitcnt(0xC07F);
    int buf = 0;
    for (int kt = 0; kt < nk; ++kt) {
        const char* sb = smem + buf * STAGE_B;
        LOADF(w1, x1, sb, co1);
        __builtin_amdgcn_sched_barrier(0);
        MFMA8(w0, x0);
        __builtin_amdgcn_s_waitcnt(0xC07F);
        __builtin_amdgcn_sched_barrier(0);
        const int nb = (buf + 1 == NST) ? 0 : buf + 1;
        if (kt + 1 < nk) {
            if (kt + 2 < nk) asm volatile("s_waitcnt vmcnt(4)" ::: "memory"); else asm volatile("s_waitcnt vmcnt(0)" ::: "memory");
            __builtin_amdgcn_s_barrier();
            if (kt + 3 < nk) { const int fb_ = (buf + 3 >= NST) ? buf + 3 - NST : buf + 3; GLDS(kt + 3, fb_); }
        }
        LOADF(w0, x0, smem + nb * STAGE_B, co0);
        __builtin_amdgcn_sched_barrier(0);
        MFMA8(w1, x1);
        __builtin_amdgcn_s_waitcnt(0xC07F);
        __builtin_amdgcn_sched_barrier(0);
        buf = nb;
    }
#undef LOADF
#undef MFMA8
#undef GLDS
    __syncthreads();

    if (dry) { if (acc[0][0][0] + acc[1][1][0] + acc[2][0][0] + acc[3][1][0] == 12345.678f) J.O[0] = 1; return; }
    const int tokb = tm * 256 + wc * 64;
    const int fb = tn * 256 + wr * 128;
    float rsc[2];
#pragma unroll
    for (int ti = 0; ti < 2; ++ti) rsc[ti] = J.rs ? __builtin_amdgcn_rsqf(J.rs[tokb + ti * 32 + r] * (1.f / 1024.f) + EPS) : 1.f;

    if (J.mode == 3 && fb >= 1024) {
#pragma unroll
        for (int ti = 0; ti < 2; ++ti) {
            const int tok = tokb + ti * 32 + r;
#pragma unroll
            for (int fi = 0; fi < 4; ++fi)
#pragma unroll
                for (int i = 0; i < 16; ++i) {
                    const int f = fb - 1024 + fi * 32 + crow(i, h);
                    const int bh_ = (tok >> 8) * 4 + (f >> 8), d_ = f & 255, key_ = tok & 255, k16 = key_ & 15;
                    const int ln_ = ((k16 >> 2) & 1) * 32 + (d_ & 31), e_ = ((k16 >> 3) << 2) | (k16 & 3);
                    J.vt[((((((size_t)bh_ * 8 + (d_ >> 5)) * 8 + (key_ >> 5)) * 2 + ((key_ >> 4) & 1)) * 64 + ln_) << 3) + e_] = (bf16_t)(pk2(acc[fi][ti][i] * rsc[ti], 0.f) & 0xffffu);
                }
        }
        return;
    }
    char* wl = smem + wid * 16384;
#pragma unroll
    for (int ti = 0; ti < 2; ++ti) {
#pragma unroll
        for (int fp = 0; fp < 2; ++fp) {
            const float sc = (J.mode == 1) ? J.alpha : rsc[ti];
#pragma unroll
            for (int fi2 = 0; fi2 < 2; ++fi2)
#pragma unroll
                for (int g = 0; g < 4; ++g) {
                    float4 v;
                    v.x = acc[2 * fp + fi2][ti][4 * g + 0] * sc; v.y = acc[2 * fp + fi2][ti][4 * g + 1] * sc;
                    v.z = acc[2 * fp + fi2][ti][4 * g + 2] * sc; v.w = acc[2 * fp + fi2][ti][4 * g + 3] * sc;
                    *(float4*)(wl + r * 272 + (fi2 * 32 + 8 * g + 4 * h) * 4) = v;
                }
            const int tok0 = tokb + ti * 32, f0 = fb + fp * 64;
            if (J.mode == 0) {
                const int c4 = (lane & 7) * 4;
#pragma unroll
                for (int p = 0; p < 4; ++p) {
                    const int row = p * 8 + (lane >> 3);
                    const float4 ga = *(const float4*)(wl + row * 272 + c4 * 4);
                    const float4 up = *(const float4*)(wl + row * 272 + (32 + c4) * 4);
                    float y0 = ga.x * up.x * __builtin_amdgcn_rcpf(1.f + fexp2(-ga.x * LOG2E));
                    float y1 = ga.y * up.y * __builtin_amdgcn_rcpf(1.f + fexp2(-ga.y * LOG2E));
                    float y2 = ga.z * up.z * __builtin_amdgcn_rcpf(1.f + fexp2(-ga.z * LOG2E));
                    float y3 = ga.w * up.w * __builtin_amdgcn_rcpf(1.f + fexp2(-ga.w * LOG2E));
                    *(uint2*)(J.O + (size_t)(tok0 + row) * J.ldo + (f0 >> 1) + c4) = make_uint2(pk2(y0, y1), pk2(y2, y3));
                }
            } else if (J.mode == 1) {
                const int c4 = (lane & 15) * 4;
#pragma unroll
                for (int p = 0; p < 8; ++p) {
                    const int row = p * 4 + (lane >> 4);
                    const size_t tok = tok0 + row;
                    const float4 v = *(const float4*)(wl + row * 272 + c4 * 4);
                    const float4 xo = *(const float4*)(J.xin + tok * D + f0 + c4);
                    float4 xn; xn.x = xo.x + v.x; xn.y = xo.y + v.y; xn.z = xo.z + v.z; xn.w = xo.w + v.w;
                    *(float4*)(J.xout + tok * D + f0 + c4) = xn;
                    if (J.xb) {
                        *(uint2*)(J.xb + tok * D + f0 + c4) = make_uint2(pk2(xn.x, xn.y), pk2(xn.z, xn.w));
                        float ss = xn.x * xn.x + xn.y * xn.y + xn.z * xn.z + xn.w * xn.w;
                        ss += __shfl_xor(ss, 1); ss += __shfl_xor(ss, 2); ss += __shfl_xor(ss, 4); ss += __shfl_xor(ss, 8);
                        if ((lane & 15) == 0) atomicAdd(J.ssq_out + tok, ss);
                    }
                }
            } else {
                const int nm = f0 < J.qn_end ? 1 : (f0 < J.kn_end ? 2 : 0);
                const float* gp = nm == 1 ? J.qg : J.kg;
                const int c4 = (lane & 15) * 4;
                float4 gn = make_float4(1.f, 1.f, 1.f, 1.f);
                if (nm) gn = *(const float4*)(gp + c4);
#pragma unroll
                for (int p = 0; p < 8; ++p) {
                    const int row = p * 4 + (lane >> 4);
                    float4 v = *(const float4*)(wl + row * 272 + c4 * 4);
                    if (nm) {
                        float ss = v.x * v.x + v.y * v.y + v.z * v.z + v.w * v.w;
                        ss += __shfl_xor(ss, 1); ss += __shfl_xor(ss, 2); ss += __shfl_xor(ss, 4); ss += __shfl_xor(ss, 8);
                        const float inv = __builtin_amdgcn_rsqf(ss * (1.f / 64.f) + EPS);
                        v.x *= inv * gn.x; v.y *= inv * gn.y; v.z *= inv * gn.z; v.w *= inv * gn.w;
                    }
                    *(uint2*)(J.O + (size_t)(tok0 + row) * J.ldo + f0 + c4) = make_uint2(pk2(v.x, v.y), pk2(v.z, v.w));
                }
            }
        }
    }
}

DI void gemm_phase(const GJob& JA, int nA, int nB, const Params& P, char* smem, bool dry) {
    for (int u = (int)gridDim.x - 1 - (int)blockIdx.x; u < nA + nB; u += gridDim.x) {
        GJob J = JA; int t = u;
        if (u >= nA) {
            const int v = u - nA; const int layer = v >> 5; t = v & 31;
            J.A = (const bf16_t*)(P.ws + OFF_MEMB); J.lda = D; J.ksplit = 1 << 30; J.kextra = 0;
            J.W = (const bf16_t*)(P.ws + OFF_WKV + (size_t)layer * 2 * SZ_MM); J.K = D; J.ntm = 4; J.ntn = 8; J.mode = 3;
            J.rs = (const float*)(P.ws + OFF_SSQM); J.O = (bf16_t*)(P.ws + OFF_KN + (size_t)layer * SZ_MM); J.ldo = D;
            J.qn_end = 0; J.kn_end = 0; J.vt = (bf16_t*)(P.ws + OFF_VT + (size_t)layer * SZ_MM);
        }
        gemm_tile(J, t, smem, dry);
    }
}

namespace pg8 {
#define PG8_LAS __attribute__((address_space(3)))
typedef float f32x4 __attribute__((ext_vector_type(4)));
typedef unsigned u32x4 __attribute__((ext_vector_type(4)));
constexpr int BM = 256, BK = 64, HALF = 128, HTB = HALF * BK * 2, STAGE_BYTES = 8 * HTB, NXCD = 8, WGM = 8;
DI int lds_byte(int r, int c) { const int st = (r >> 4) * 2 + (c >> 5), rr = r & 15, cc = c & 31, ob = rr * 64 + cc * 2; return st * 1024 + (ob ^ (((ob >> 9) & 1) << 5)); }
DI void stage_rc(int b, int& R, int& C) { const int st = b / 1024, sb = b % 1024, swz = sb ^ (((sb >> 9) & 1) << 5); R = (st >> 1) * 16 + swz / 64; C = (st & 1) * 32 + (swz % 64) / 2; }
DI int perm32(int rho) { const int n = rho >> 4, i = rho & 15; return 8 * (i >> 2) + 4 * n + (i & 3); }
struct Unit { int pm, pn; };
struct Gemm { const bf16_t* A; const bf16_t* Bt; int M, N, K, lda; };
struct StaticOrder {
    int nM, nN, nwg, G, c;
    DI void init(int M, int N, int G_, int c_) { nM = M / BM; nN = N / BM; nwg = nM * nN; G = G_; c = c_; }
    DI bool next(int i, Unit& u) const {
        const long L = (long)i * G + c; if (L >= nwg) return false;
        int wgid = (int)L; { const int q = nwg / NXCD, r = nwg % NXCD, xcd = wgid % NXCD, off = wgid / NXCD; wgid = (xcd < r ? xcd * (q + 1) : r * (q + 1) + (xcd - r) * q) + off; }
        const int nig = WGM * nN, gid = wgid / nig, fm = gid * WGM, gsz = (nM - fm) < WGM ? (nM - fm) : WGM;
        u.pm = fm + ((wgid % nig) % gsz); u.pn = (wgid % nig) / gsz; return true;
    }
    DI void a_ready(const Unit&) const {}
    DI void done(const Unit&) const {}
};

struct Epi {
    static constexpr bool PERM = true, AFTER_DRAIN = false;
    int mode;
    const float* rs;
    bf16_t* O; int ldo;
    const float* xin; float* xout; bf16_t* xb; float* ssq_out; float alpha;
    const float* qg; const float* kg; int qn_end, kn_beg, kn_end; int dryrun;
    DI void operator()(const f32x4 (&acc)[2][2][4][2], const Unit& u, int wr, int wc, int fr, int fq) const {
        if (dryrun) { if (acc[0][0][0][0][0] + acc[1][1][3][1][3] + acc[0][1][2][0][1] + acc[1][0][1][1][2] == 12345.678f) O[0] = 1; return; }
        const int row0 = u.pm * BM + wr * 64 + fr;
        if (mode == 0) {
            const int col = u.pn * 128 + wc * 32 + 8 * fq;
#pragma unroll
            for (int ai = 0; ai < 2; ++ai)
#pragma unroll
                for (int m = 0; m < 4; ++m) {
                    const size_t tok = row0 + ai * HALF + m * 16;
                    const float sc = __builtin_amdgcn_rsqf(rs[tok] * (1.f / 1024.f) + EPS);
                    float y[8];
#pragma unroll
                    for (int n = 0; n < 2; ++n)
#pragma unroll
                        for (int j = 0; j < 4; ++j) {
                            const float ga = acc[ai][0][m][n][j] * sc, up = acc[ai][1][m][n][j] * sc;
                            y[4 * n + j] = ga * up * __builtin_amdgcn_rcpf(1.f + fexp2(-ga * LOG2E));
                        }
                    *(uint4*)(O + tok * ldo + col) = make_uint4(pk2(y[0], y[1]), pk2(y[2], y[3]), pk2(y[4], y[5]), pk2(y[6], y[7]));
                }
        } else if (mode == 1) {
#pragma unroll
            for (int ai = 0; ai < 2; ++ai)
#pragma unroll
                for (int m = 0; m < 4; ++m) {
                    const size_t tok = row0 + ai * HALF + m * 16;
                    float ss = 0.f;
#pragma unroll
                    for (int bj = 0; bj < 2; ++bj) {
                        const int col = u.pn * BM + wc * 64 + bj * 32 + 8 * fq;
                        float4 x0, x1;
                        if (xin) { x0 = *(const float4*)(xin + tok * D + col); x1 = *(const float4*)(xin + tok * D + col + 4); }
                        else {
                            const uint4 w = *(const uint4*)(xb + tok * D + col);
                            x0 = make_float4(bflo(w.x), bfhi(w.x), bflo(w.y), bfhi(w.y)); x1 = make_float4(bflo(w.z), bfhi(w.z), bflo(w.w), bfhi(w.w));
                        }
                        float4 n0, n1;
                        n0.x = x0.x + alpha * acc[ai][bj][m][0][0]; n0.y = x0.y + alpha * acc[ai][bj][m][0][1]; n0.z = x0.z + alpha * acc[ai][bj][m][0][2]; n0.w = x0.w + alpha * acc[ai][bj][m][0][3];
                        n1.x = x1.x + alpha * acc[ai][bj][m][1][0]; n1.y = x1.y + alpha * acc[ai][bj][m][1][1]; n1.z = x1.z + alpha * acc[ai][bj][m][1][2]; n1.w = x1.w + alpha * acc[ai][bj][m][1][3];
                        if (xout) { *(float4*)(xout + tok * D + col) = n0; *(float4*)(xout + tok * D + col + 4) = n1; }
                        if (ssq_out) {
                            const uint4 w = make_uint4(pk2(n0.x, n0.y), pk2(n0.z, n0.w), pk2(n1.x, n1.y), pk2(n1.z, n1.w));
                            *(uint4*)(xb + tok * D + col) = w;
                            const float r0 = bflo(w.x), r1 = bfhi(w.x), r2 = bflo(w.y), r3 = bfhi(w.y), r4 = bflo(w.z), r5 = bfhi(w.z), r6 = bflo(w.w), r7 = bfhi(w.w);
                            ss += r0 * r0 + r1 * r1 + r2 * r2 + r3 * r3 + r4 * r4 + r5 * r5 + r6 * r6 + r7 * r7;
                        }
                    }
                    if (ssq_out) {
                        ss += __shfl_xor(ss, 16); ss += __shfl_xor(ss, 32);
                        if (fq == 0) atomicAdd(ssq_out + tok, ss);
                    }
                }
        } else {
            const int f0 = u.pn * BM + wc * 64;
            const int nm = f0 < qn_end ? 1 : ((f0 >= kn_beg && f0 < kn_end) ? 2 : 0);
            const float* gp = nm == 1 ? qg : kg;
            float4 g4[2][2];
#pragma unroll
            for (int bj = 0; bj < 2; ++bj)
#pragma unroll
                for (int n = 0; n < 2; ++n) g4[bj][n] = nm ? *(const float4*)(gp + bj * 32 + 8 * fq + 4 * n) : make_float4(1.f, 1.f, 1.f, 1.f);
#pragma unroll
            for (int ai = 0; ai < 2; ++ai)
#pragma unroll
                for (int m = 0; m < 4; ++m) {
                    const size_t tok = row0 + ai * HALF + m * 16;
                    float sc = rs ? __builtin_amdgcn_rsqf(rs[tok] * (1.f / 1024.f) + EPS) : 1.f;
                    if (nm) {
                        float ss = 0.f;
#pragma unroll
                        for (int bj = 0; bj < 2; ++bj)
#pragma unroll
                            for (int n = 0; n < 2; ++n)
#pragma unroll
                                for (int j = 0; j < 4; ++j) { const float v = acc[ai][bj][m][n][j] * sc; ss += v * v; }
                        ss += __shfl_xor(ss, 16); ss += __shfl_xor(ss, 32);
                        sc *= __builtin_amdgcn_rsqf(ss * (1.f / 64.f) + EPS);
                    }
#pragma unroll
                    for (int bj = 0; bj < 2; ++bj) {
                        const f32x4 a0 = acc[ai][bj][m][0], a1 = acc[ai][bj][m][1];
                        *(uint4*)(O + tok * ldo + f0 + bj * 32 + 8 * fq) =
                            make_uint4(pk2(a0[0] * sc * g4[bj][0].x, a0[1] * sc * g4[bj][0].y), pk2(a0[2] * sc * g4[bj][0].z, a0[3] * sc * g4[bj][0].w),
                                       pk2(a1[0] * sc * g4[bj][1].x, a1[1] * sc * g4[bj][1].y), pk2(a1[2] * sc * g4[bj][1].z, a1[3] * sc * g4[bj][1].w));
                    }
                }
        }
    }
};

template <class Epi, class Sched, bool ALIGN_EPI = false, bool SP2 = false>
__device__ __forceinline__ void gemm_phase(PG8_LAS unsigned char* lds, const Gemm g, const Sched& S, const Epi& E) {
    const int tid = otid(), wid = __builtin_amdgcn_readfirstlane(tid >> 6), lane = tid & 63, wr = wid >> 2, wc = wid & 3, fr = lane & 15, fq = lane >> 4;
    const int K = g.K, nt = K / BK;
    unsigned voffA[2], voffB[2];
#pragma unroll
    for (int i = 0; i < 2; ++i) { int R, C; stage_rc(tid * 16 + i * 8192, R, C); const int Rb = Epi::PERM ? ((R & ~31) + perm32(R & 31)) : R;
        voffA[i] = (unsigned)(R * g.lda + C) * 2u; voffB[i] = (unsigned)(Rb * K + C) * 2u; }
    const size_t kstep = (size_t)(BK * 2);
    const size_t hstepA = (size_t)HALF * g.lda * 2, hstepB = (size_t)HALF * K * 2;
    const size_t tstepA = 2 * hstepA, tstepB = 2 * hstepB;
    const unsigned ldsw = (unsigned)wid * 1024u;
    const int aoff = lds_byte(wr * 64 + fr, fq * 8), boff = lds_byte(wc * 32 + fr, fq * 8);
#define PG8_SA(b, h) (((b) * 2 + (h)) * HTB)
#define PG8_SB(b, h) ((4 + (b) * 2 + (h)) * HTB)
#define PG8_STAGE(bufoff, gbase, voff) do { _Pragma("unroll") for (int _i = 0; _i < 2; ++_i) \
        __builtin_amdgcn_global_load_lds((const unsigned*)((const char*)(gbase) + (voff)[_i]), (PG8_LAS unsigned*)(lds + (bufoff) + ldsw + _i * 8192), 16, 0, 0); } while (0)
#define PG8_LDA(dst, b, h) do { _Pragma("unroll") for (int m = 0; m < 4; ++m) _Pragma("unroll") for (int k = 0; k < 2; ++k) dst[m][k] = *(const PG8_LAS bf16x8*)(lds + PG8_SA(b, h) + aoff + m * 2048 + k * 1024); } while (0)
#define PG8_LDB(dst, b, h) do { _Pragma("unroll") for (int n = 0; n < 2; ++n) _Pragma("unroll") for (int k = 0; k < 2; ++k) dst[n][k] = *(const PG8_LAS bf16x8*)(lds + PG8_SB(b, h) + boff + n * 2048 + k * 1024); } while (0)
#define PG8_MMA(ai, bj, At, Bt) do { __builtin_amdgcn_s_setprio(1); _Pragma("unroll") for (int m = 0; m < 4; ++m) _Pragma("unroll") for (int n = 0; n < 2; ++n) _Pragma("unroll") for (int k = 0; k < 2; ++k) \
        acc[ai][bj][m][n] = __builtin_amdgcn_mfma_f32_16x16x32_bf16(Bt[n][k], At[m][k], acc[ai][bj][m][n], 0, 0, 0); __builtin_amdgcn_s_setprio(0); } while (0)
#define PG8_WAIT_V(n) asm volatile("s_waitcnt vmcnt(" #n ")" ::: "memory")
#define PG8_WAIT_L(n) asm volatile("s_waitcnt lgkmcnt(" #n ")" ::: "memory")
#define PG8_BAR __builtin_amdgcn_s_barrier()
#define PG8_SCHED __builtin_amdgcn_sched_barrier(0)
    Unit cur, nxt; int ui = 0;
    if (!S.next(0, cur)) return;
    f32x4 acc[2][2][4][2];
#pragma unroll
    for (int a = 0; a < 2; ++a)
#pragma unroll
        for (int b = 0; b < 2; ++b)
#pragma unroll
            for (int m = 0; m < 4; ++m)
#pragma unroll
                for (int n = 0; n < 2; ++n) acc[a][b][m][n] = (f32x4){0.f, 0.f, 0.f, 0.f};
    bf16x8 At[4][2], B0[2][2], B1[2][2];
    const char* cA = (const char*)g.A + (size_t)cur.pm * tstepA; const char* cB = (const char*)g.Bt + (size_t)cur.pn * tstepB;
    S.a_ready(cur);
    if constexpr (SP2) {
        PG8_STAGE(PG8_SB(0, 0), cB, voffB); PG8_STAGE(PG8_SB(0, 1), cB + hstepB, voffB); PG8_STAGE(PG8_SA(0, 0), cA, voffA); PG8_STAGE(PG8_SA(0, 1), cA + hstepA, voffA);
        if (wr == 1) PG8_BAR;
        PG8_WAIT_V(2); PG8_BAR;
        PG8_STAGE(PG8_SB(1, 0), cB + kstep, voffB); PG8_STAGE(PG8_SA(1, 0), cA + kstep, voffA); PG8_STAGE(PG8_SB(1, 1), cB + hstepB + kstep, voffB);
        PG8_WAIT_V(6); PG8_BAR;
    } else {
        PG8_STAGE(PG8_SB(0, 0), cB, voffB); PG8_STAGE(PG8_SA(0, 0), cA, voffA); PG8_STAGE(PG8_SB(0, 1), cB + hstepB, voffB); PG8_STAGE(PG8_SA(0, 1), cA + hstepA, voffA);
        if (wr == 1) PG8_BAR;
        PG8_WAIT_V(4); PG8_BAR;
        PG8_STAGE(PG8_SB(1, 0), cB + kstep, voffB); PG8_STAGE(PG8_SA(1, 0), cA + kstep, voffA); PG8_STAGE(PG8_SB(1, 1), cB + hstepB + kstep, voffB);
        PG8_WAIT_V(6); PG8_BAR;
    }
    for (;;) {
        const bool has_next = S.next(ui + 1, nxt);
        const char* nA = has_next ? (const char*)g.A + (size_t)nxt.pm * tstepA : cA; const char* nB = has_next ? (const char*)g.Bt + (size_t)nxt.pn * tstepB : cB;
        for (int t = 0; t < nt; t += 2) {
            const bool last = (t == nt - 2);
            const char* a1 = cA + (size_t)(t + 1) * kstep;
            const char* a2 = last ? nA : cA + (size_t)(t + 2) * kstep; const char* b2 = last ? nB : cB + (size_t)(t + 2) * kstep;
            const char* a3 = a2 + kstep; const char* b3 = b2 + kstep;
            if (last && has_next) S.a_ready(nxt);
            if constexpr (SP2) {
            PG8_LDB(B0, 0, 0); PG8_LDB(B1, 0, 1); PG8_SCHED; PG8_LDA(At, 0, 0); PG8_STAGE(PG8_SA(1, 1), a1 + hstepA, voffA);
            PG8_WAIT_V(8); PG8_WAIT_L(0); PG8_BAR; PG8_MMA(0, 0, At, B0); PG8_MMA(0, 1, At, B1); PG8_BAR; PG8_SCHED;
            PG8_LDA(At, 0, 1); PG8_STAGE(PG8_SB(0, 0), b2, voffB); PG8_STAGE(PG8_SB(0, 1), b2 + hstepB, voffB); PG8_STAGE(PG8_SA(0, 0), a2, voffA);
            PG8_WAIT_V(8); PG8_WAIT_L(0); PG8_BAR; PG8_MMA(1, 0, At, B0); PG8_MMA(1, 1, At, B1); PG8_BAR; PG8_SCHED;
            PG8_LDB(B0, 1, 0); PG8_LDB(B1, 1, 1); PG8_SCHED; PG8_LDA(At, 1, 0); PG8_STAGE(PG8_SA(0, 1), a2 + hstepA, voffA);
            PG8_WAIT_V(8); PG8_WAIT_L(0); PG8_BAR; PG8_MMA(0, 0, At, B0); PG8_MMA(0, 1, At, B1); PG8_BAR; PG8_SCHED;
            PG8_LDA(At, 1, 1); PG8_STAGE(PG8_SB(1, 0), b3, voffB); PG8_STAGE(PG8_SB(1, 1), b3 + hstepB, voffB); PG8_STAGE(PG8_SA(1, 0), a3, voffA);
            PG8_WAIT_V(8); PG8_WAIT_L(0); PG8_BAR; PG8_MMA(1, 0, At, B0); PG8_MMA(1, 1, At, B1); PG8_BAR; PG8_SCHED;
            } else {
            PG8_LDB(B0, 0, 0); PG8_SCHED; PG8_LDA(At, 0, 0); PG8_STAGE(PG8_SA(1, 1), a1 + hstepA, voffA);
            PG8_WAIT_L(8); PG8_BAR; PG8_WAIT_L(0); PG8_MMA(0, 0, At, B0); PG8_BAR; PG8_SCHED;
            PG8_LDB(B1, 0, 1); PG8_STAGE(PG8_SB(0, 0), b2, voffB);
            PG8_BAR; PG8_WAIT_L(0); PG8_MMA(0, 1, At, B1); PG8_BAR;
            PG8_LDA(At, 0, 1); PG8_STAGE(PG8_SA(0, 0), a2, voffA);
            PG8_BAR; PG8_WAIT_L(0); PG8_MMA(1, 0, At, B0); PG8_BAR; PG8_SCHED;
            PG8_STAGE(PG8_SB(0, 1), b2 + hstepB, voffB);
            PG8_WAIT_V(6); PG8_BAR; PG8_MMA(1, 1, At, B1); PG8_BAR;
            PG8_LDB(B0, 1, 0); PG8_SCHED; PG8_LDA(At, 1, 0); PG8_STAGE(PG8_SA(0, 1), a2 + hstepA, voffA);
            PG8_WAIT_L(8); PG8_BAR; PG8_WAIT_L(0); PG8_MMA(0, 0, At, B0); PG8_BAR; PG8_SCHED;
            PG8_LDB(B1, 1, 1); PG8_STAGE(PG8_SB(1, 0), b3, voffB);
            PG8_BAR; PG8_WAIT_L(0); PG8_MMA(0, 1, At, B1); PG8_BAR;
            PG8_LDA(At, 1, 1); PG8_STAGE(PG8_SA(1, 0), a3, voffA);
            PG8_BAR; PG8_WAIT_L(0); PG8_MMA(1, 0, At, B0); PG8_BAR; PG8_SCHED;
            PG8_STAGE(PG8_SB(1, 1), b3 + hstepB, voffB);
            PG8_WAIT_V(6); PG8_BAR; PG8_MMA(1, 1, At, B1); PG8_BAR;
            }
        }
        if constexpr (ALIGN_EPI) { if (wr == 0) PG8_BAR; }
        if constexpr (!Epi::AFTER_DRAIN) { E(acc, cur, wr, wc, fr, fq); S.done(cur); }
        if (!has_next) break;
#pragma unroll
        for (int a = 0; a < 2; ++a)
#pragma unroll
            for (int b = 0; b < 2; ++b)
#pragma unroll
                for (int m = 0; m < 4; ++m)
#pragma unroll
                    for (int n = 0; n < 2; ++n) acc[a][b][m][n] = (f32x4){0.f, 0.f, 0.f, 0.f};
        cur = nxt; cA = nA; cB = nB; ++ui;
        if constexpr (ALIGN_EPI) { if (wr == 1) PG8_BAR; }
    }
    PG8_WAIT_V(0);
    if constexpr (!ALIGN_EPI) { if (wr == 0) PG8_BAR; }
    PG8_BAR;
    if constexpr (Epi::AFTER_DRAIN) { E.fused(acc, cur, wr, wc, fr, fq, lds, wid, lane); S.done(cur); }
#undef PG8_SA
#undef PG8_SB
#undef PG8_STAGE
#undef PG8_LDA
#undef PG8_LDB
#undef PG8_MMA
#undef PG8_WAIT_V
#undef PG8_WAIT_L
#undef PG8_BAR
#undef PG8_SCHED
}
}

#define KV_DECL uint4 rk0, rk1, rk2, rk3, rv0, rv1, rv2, rv3
#define KV_LOAD(kb_, dil_) do { const int kk_ = lane >> 3; \
    const bf16_t* p0_ = qkv + (rowb + min(max((kb_) + (dil_) * kk_, 0), S - 1)) * ld + (lane & 7) * 8; \
    const bf16_t* p1_ = qkv + (rowb + min(max((kb_) + (dil_) * (kk_ + 8), 0), S - 1)) * ld + (lane & 7) * 8; \
    const bf16_t* p2_ = qkv + (rowb + min(max((kb_) + (dil_) * (kk_ + 16), 0), S - 1)) * ld + (lane & 7) * 8; \
    const bf16_t* p3_ = qkv + (rowb + min(max((kb_) + (dil_) * (kk_ + 24), 0), S - 1)) * ld + (lane & 7) * 8; \
    rk0 = *(const uint4*)(p0_ + kcol); rk1 = *(const uint4*)(p1_ + kcol); rk2 = *(const uint4*)(p2_ + kcol); rk3 = *(const uint4*)(p3_ + kcol); \
    rv0 = *(const uint4*)(p0_ + vcol); rv1 = *(const uint4*)(p1_ + vcol); rv2 = *(const uint4*)(p2_ + vcol); rv3 = *(const uint4*)(p3_ + vcol); } while (0)
#define KV_STORE() do { char* wp_ = vl + (lane >> 3) * 144 + (lane & 7) * 16; \
    *(uint4*)(wp_) = rk0; *(uint4*)(wp_ + 8 * 144) = rk1; *(uint4*)(wp_ + 16 * 144) = rk2; *(uint4*)(wp_ + 24 * 144) = rk3; \
    *(uint4*)(wp_ + 4608) = rv0; *(uint4*)(wp_ + 4608 + 8 * 144) = rv1; *(uint4*)(wp_ + 4608 + 16 * 144) = rv2; *(uint4*)(wp_ + 4608 + 24 * 144) = rv3; } while (0)

DI bf16x8 v_frag(const char* vbase, int s, int dt) {
    typedef __attribute__((address_space(3))) v4i16_t* lp_t;
    const char* a = vbase + s * (16 * 144) + dt * 64;
    const s16x4 lo = __builtin_bit_cast(s16x4, __builtin_amdgcn_ds_read_tr16_b64_v4i16((lp_t)(a)));
    const s16x4 hi = __builtin_bit_cast(s16x4, __builtin_amdgcn_ds_read_tr16_b64_v4i16((lp_t)(a + 8 * 144)));
    return __builtin_shufflevector(lo, hi, 0, 1, 2, 3, 4, 5, 6, 7);
}

template <int OFF> DI bf16x8 pack8v(const f32x16& p) {
    typedef unsigned u32x4 __attribute__((ext_vector_type(4)));
    u32x4 w; w[0] = pk2(p[OFF + 0], p[OFF + 1]); w[1] = pk2(p[OFF + 2], p[OFF + 3]); w[2] = pk2(p[OFF + 4], p[OFF + 5]); w[3] = pk2(p[OFF + 6], p[OFF + 7]);
    return __builtin_bit_cast(bf16x8, w);
}

DI void win_attn_wave(bf16_t* qkv, int ld, int b, int qcol, int kcol, int vcol, int tq0, int qstride,
                      float slope2, float m_init, float l_init, int mode, char* vl, int lane, bool dry) {
    const int r = lane & 31, h = lane >> 5;
    const size_t rowb = (size_t)b * S;
    const int tq = tq0 + qstride * r;
    const int tqlast = tq0 + qstride * 31;
    bf16x8 qf[4];
    {
        const bf16_t* qp = qkv + (rowb + tq) * ld + qcol + h * 32;
#pragma unroll
        for (int ks = 0; ks < 4; ++ks) qf[ks] = *(const bf16x8*)(qp + ks * 8);
    }
    f32x16 o0, o1;
#pragma unroll
    for (int i = 0; i < 16; ++i) { o0[i] = 0.f; o1[i] = 0.f; }
    float m = m_init, l = (h == 0) ? l_init : 0.f;
    const float sc2 = 0.125f * LOG2E;
    const int i16 = lane & 15;
    const char* vbase = vl + 4608 + (4 * h + (i16 >> 2)) * 144 + (16 * ((lane >> 4) & 1) + 4 * (i16 & 3)) * 2;
    const int npat = mode ? 3 : 1;
    const char* kfp = vl + r * 144 + h * 64;
    KV_DECL;
    for (int pi = 0; pi < npat; ++pi) {
        int dil, W, kfirst, nt;
        if (!mode) { dil = 1; W = 127; kfirst = tq0 - 128; nt = 5; }
        else if (pi == 0) { dil = 1; W = 128; kfirst = tq0 - 128; nt = 20; }
        else if (pi == 1) { dil = 4; W = 512; kfirst = tq0 - 512; nt = 8; }
        else { dil = 16; W = 2048; kfirst = tq0 - 2048; nt = 5; }
        const int step = 32 * dil;
        int t0 = 0;
        { const int need = -kfirst - 31 * dil; if (need > 0) t0 = (need + step - 1) / step; }
        if (t0 >= nt) continue;
        KV_LOAD(kfirst + t0 * step, dil);
        for (int tile = t0; tile < nt; ++tile) {
            const int kb = kfirst + tile * step;
            KV_STORE();
            asm volatile("" ::: "memory");
            if (tile + 1 < nt) KV_LOAD(kb + step, dil);
            f32x16 s;
#pragma unroll
            for (int i = 0; i < 16; ++i) s[i] = 0.f;
#pragma unroll
            for (int ks = 0; ks < 4; ++ks) s = MFMA(*(const bf16x8*)(kfp + ks * 16), qf[ks], s);
            f32x16 sv; float mloc = -INFINITY;
            const int d0 = tq - kb - 4 * h * dil;
            const unsigned wlim = (unsigned)min(W, tq);
#pragma unroll
            for (int i = 0; i < 16; ++i) {
                const int diff = d0 - dil * crow(i, 0);
                const float sb = s[i] * sc2 - slope2 * (float)diff;
                sv[i] = ((unsigned)diff <= wlim) ? sb : -INFINITY;
                mloc = fmaxf(mloc, sv[i]);
            }
            mloc = fmaxf(mloc, __shfl_xor(mloc, 32));
            const float mn = fmaxf(m, mloc);
            float ps = 0.f;
#pragma unroll
            for (int i = 0; i < 16; ++i) { sv[i] = fexp2(sv[i] - mn); ps += sv[i]; }
            if (__builtin_amdgcn_ballot_w64(mn != m) != 0) {
                const float alpha = fexp2(m - mn);
                l *= alpha;
#pragma unroll
                for (int i = 0; i < 16; ++i) { o0[i] *= alpha; o1[i] *= alpha; }
                m = mn;
            }
            l += ps;
            const bf16x8 p0 = pack8v<0>(sv), p1 = pack8v<8>(sv);
            o0 = MFMA(v_frag(vbase, 0, 0), p0, o0);
            o0 = MFMA(v_frag(vbase, 1, 0), p1, o0);
            o1 = MFMA(v_frag(vbase, 0, 1), p0, o1);
            o1 = MFMA(v_frag(vbase, 1, 1), p1, o1);
            asm volatile("" ::: "memory");
        }
    }
    const float lt = l + __shfl_xor(l, 32);
    const float inv = 1.f / lt;
    if (dry) { if (o0[0] + o1[0] + lt == 12345.678f) qkv[0] = 1; return; }
    bf16_t* op = qkv + (rowb + tq) * ld + qcol + 4 * h;
#pragma unroll
    for (int g = 0; g < 4; ++g) {
        *(uint2*)(op + 8 * g) = make_uint2(pk2(o0[4 * g] * inv, o0[4 * g + 1] * inv), pk2(o0[4 * g + 2] * inv, o0[4 * g + 3] * inv));
        *(uint2*)(op + 32 + 8 * g) = make_uint2(pk2(o1[4 * g] * inv, o1[4 * g + 1] * inv), pk2(o1[4 * g + 2] * inv, o1[4 * g + 3] * inv));
    }
}

DI void stick_wave(bf16_t* qkv, int ld, int b, int qcol, int kcol, int vcol, int qt, char* vl, int lane, bool dry) {
    const int r = lane & 31, h = lane >> 5;
    const size_t rowb = (size_t)b * S;
    const int tq = qt * 32 + r;
    bf16x8 qf[4];
    {
        const bf16_t* qp = qkv + (rowb + tq) * ld + qcol + h * 32;
#pragma unroll
        for (int ks = 0; ks < 4; ++ks) qf[ks] = *(const bf16x8*)(qp + ks * 8);
    }
    f32x16 o0, o1;
#pragma unroll
    for (int i = 0; i < 16; ++i) { o0[i] = 0.f; o1[i] = 0.f; }
    float R = 1.f;
    const int i16 = lane & 15;
    const char* vbase = vl + 4608 + (4 * h + (i16 >> 2)) * 144 + (16 * ((lane >> 4) & 1) + 4 * (i16 & 3)) * 2;
    const char* kfp = vl + r * 144 + h * 64;
    KV_DECL;
    KV_LOAD(qt * 32, 1);
    for (int tile = qt; tile >= 0; --tile) {
        KV_STORE();
        asm volatile("" ::: "memory");
        if (tile > 0) KV_LOAD((tile - 1) * 32, 1);
        f32x16 s;
#pragma unroll
        for (int i = 0; i < 16; ++i) s[i] = 0.f;
#pragma unroll
        for (int ks = 0; ks < 4; ++ks) s = MFMA(*(const bf16x8*)(kfp + ks * 16), qf[ks], s);
        const bool diag = (tile == qt);
        f32x16 sg, kp;
#pragma unroll
        for (int i = 0; i < 16; ++i) {
            const float z2 = fminf(s[i] * (0.125f * LOG2E), 80.f);
            const float t = fexp2(z2);
            const float k = __builtin_amdgcn_rcpf(1.f + t);
            kp[i] = k; sg[i] = t * k;
        }
        if (diag) {
#pragma unroll
            for (int i = 0; i < 16; ++i) { const bool strict = crow(i, h) < r; kp[i] = strict ? kp[i] : 1.f; sg[i] = strict ? sg[i] : 0.f; }
        }
        float G[4], PG[4], both[4];
#pragma unroll
        for (int g = 0; g < 4; ++g) { G[g] = (kp[4 * g] * kp[4 * g + 1]) * (kp[4 * g + 2] * kp[4 * g + 3]); PG[g] = __shfl_xor(G[g], 32); both[g] = G[g] * PG[g]; }
        float Sx[4];
        Sx[3] = 1.f; Sx[2] = both[3]; Sx[1] = both[3] * both[2]; Sx[0] = Sx[1] * both[1];
        f32x16 a;
#pragma unroll
        for (int g = 0; g < 4; ++g) {
            float la = R * Sx[g] * (h == 0 ? PG[g] : 1.f);
#pragma unroll
            for (int j = 3; j >= 0; --j) {
                a[4 * g + j] = sg[4 * g + j] * la;
                la *= kp[4 * g + j];
            }
        }
        R *= Sx[0] * both[0];
        const bf16x8 p0 = pack8v<0>(a), p1 = pack8v<8>(a);
        o0 = MFMA(v_frag(vbase, 0, 0), p0, o0);
        o0 = MFMA(v_frag(vbase, 1, 0), p1, o0);
        o1 = MFMA(v_frag(vbase, 0, 1), p0, o1);
        o1 = MFMA(v_frag(vbase, 1, 1), p1, o1);
        asm volatile("" ::: "memory");
        if (__builtin_amdgcn_ballot_w64(R >= 1.17549435e-38f) == 0) break;
    }
    if (dry) { if (o0[0] + o1[0] == 12345.678f) qkv[0] = 1; return; }
    bf16_t* op = qkv + (rowb + tq) * ld + qcol + 4 * h;
#pragma unroll
    for (int g = 0; g < 4; ++g) {
        *(uint2*)(op + 8 * g) = make_uint2(pk2(o0[4 * g], o0[4 * g + 1]), pk2(o0[4 * g + 2], o0[4 * g + 3]));
        *(uint2*)(op + 32 + 8 * g) = make_uint2(pk2(o1[4 * g], o1[4 * g + 1]), pk2(o1[4 * g + 2], o1[4 * g + 3]));
    }
}

DI void attn_even_phase(const Params& P, char* smem, bool dry) {
    const int tid_ = otid(); const int lane = tid_ & 63, wid = tid_ >> 6;
    bf16_t* qkv = (bf16_t*)(P.ws + OFF_BIG);
    char* vl = smem + wid * 9216;
    for (int it = blockIdx.x * 8 + wid; it < 2048 + 4096; it += gridDim.x * 8) {
        if (it < 2048) {
            const int bh = it >> 6, p = it & 63; const int b = bh >> 3, head = bh & 7;
            stick_wave(qkv, 2304, b, 512 + head * 64, 1280 + head * 64, 1792 + head * 64, 127 - p, vl, lane, dry);
            stick_wave(qkv, 2304, b, 512 + head * 64, 1280 + head * 64, 1792 + head * 64, p, vl, lane, dry);
        } else {
            const int v = it - 2048; const int g = v & 3; const int qt = (v >> 2) & 127; const int rest = v >> 9; const int b = rest >> 1, kvh = rest & 1;
            const int head = kvh * 4 + g;
            const float slope = exp2f(-(float)(head + 1));
            const float sink = P.in[9][head];
            win_attn_wave(qkv, 2304, b, head * 64, 1024 + kvh * 64, 1152 + kvh * 64, qt * 32, 1, slope * LOG2E, sink * LOG2E, 1.f, 0, vl, lane, dry);
        }
    }
}

DI void attn_odd_phase(const Params& P, char* smem, bool dry) {
    const int tid_ = otid(); const int lane = tid_ & 63, wid = tid_ >> 6;
    bf16_t* qkv = (bf16_t*)(P.ws + OFF_BIG);
    char* vl = smem + wid * 9216;
    for (int it = blockIdx.x * 8 + wid; it < 8192; it += gridDim.x * 8) {
        const int res16 = it & 15; const int u0 = ((it >> 4) & 7) * 32; const int head = (it >> 7) & 15; const int b = it >> 11;
        const float slope = exp2f(-0.5f * (float)(head + 1));
        win_attn_wave(qkv, 3072, b, head * 64, 1024 + head * 64, 2048 + head * 64, res16 + 16 * u0, 16, slope * LOG2E, -1e30f, 0.f, 1, vl, lane, dry);
    }
}

DI void xattn_wave(bf16_t* qb, const bf16_t* Kn, const bf16_t* VT, const float* qg, float kmax2, int b, int head, int tok0, char* ql, int lane, bool dry) {
    const int r = lane & 31, h = lane >> 5;
    const size_t token = (size_t)b * S + tok0 + r;
    bf16_t* qp = qb + token * D + head * 256 + h * 128;
    float ss = 0.f;
#pragma unroll
    for (int ks = 0; ks < 16; ++ks) {
        const uint4 v = *(const uint4*)(qp + ks * 8);
        const unsigned w[4] = {v.x, v.y, v.z, v.w};
#pragma unroll
        for (int e = 0; e < 4; ++e) { const float a = bflo(w[e]), c = bfhi(w[e]); ss += a * a + c * c; }
    }
    ss += __shfl_xor(ss, 32);
    const float inv = __builtin_amdgcn_rsqf(ss * (1.f / 256.f) + EPS);
    float qq2 = 0.f;
#pragma unroll
    for (int ks = 0; ks < 16; ++ks) {
        const uint4 v = *(const uint4*)(qp + ks * 8);
        const float4 g0 = *(const float4*)(qg + h * 128 + ks * 8), g1 = *(const float4*)(qg + h * 128 + ks * 8 + 4);
        uint4 o;
        o.x = pk2(bflo(v.x) * inv * g0.x, bfhi(v.x) * inv * g0.y); o.y = pk2(bflo(v.y) * inv * g0.z, bfhi(v.y) * inv * g0.w);
        o.z = pk2(bflo(v.z) * inv * g1.x, bfhi(v.z) * inv * g1.y); o.w = pk2(bflo(v.w) * inv * g1.z, bfhi(v.w) * inv * g1.w);
        qq2 += bflo(o.x) * bflo(o.x) + bfhi(o.x) * bfhi(o.x) + bflo(o.y) * bflo(o.y) + bfhi(o.y) * bfhi(o.y)
             + bflo(o.z) * bflo(o.z) + bfhi(o.z) * bfhi(o.z) + bflo(o.w) * bflo(o.w) + bfhi(o.w) * bfhi(o.w);
        *(uint4*)(ql + (ks * 64 + lane) * 16) = o;
    }
    qq2 += __shfl_xor(qq2, 32);
    asm volatile("" ::: "memory");
    const float sc2 = 0.0625f * LOG2E;
    const bf16_t* kp0 = Kn + ((size_t)(b * 4 + head) * 8 * 16 * 64 + lane) * 8;
    const float m = __builtin_amdgcn_sqrtf(qq2 * kmax2) * 1.001f;
    float l = 0.f;
    bf16x8 pf[8][2];
    bf16x8 kc[16], kn[16];
#pragma unroll
    for (int ks = 0; ks < 16; ++ks) kc[ks] = *(const bf16x8*)(kp0 + ks * 512);
#pragma unroll
    for (int tile = 0; tile < 8; ++tile) {
        if (tile < 7) {
#pragma unroll
            for (int ks = 0; ks < 16; ++ks) kn[ks] = *(const bf16x8*)(kp0 + (size_t)(tile + 1) * 16 * 512 + ks * 512);
        }
        f32x16 s, s_b;
#pragma unroll
        for (int i = 0; i < 16; ++i) { s[i] = 0.f; s_b[i] = 0.f; }
#pragma unroll
        for (int ks = 0; ks < 16; ks += 2) {
            const bf16x8 qf0 = *(const bf16x8*)(ql + (ks * 64 + lane) * 16);
            const bf16x8 qf1 = *(const bf16x8*)(ql + ((ks + 1) * 64 + lane) * 16);
            s = MFMA(kc[ks], qf0, s);
            s_b = MFMA(kc[ks + 1], qf1, s_b);
        }
#pragma unroll
        for (int i = 0; i < 16; ++i) s[i] += s_b[i];
#pragma unroll
        for (int i = 0; i < 16; ++i) { s[i] = fexp2((s[i] - m) * sc2); l += s[i]; }
        pf[tile][0] = pack8v<0>(s); pf[tile][1] = pack8v<8>(s);
#pragma unroll
        for (int ks = 0; ks < 16; ++ks) kc[ks] = kn[ks];
    }
    l += __shfl_xor(l, 32);
    const float il = 1.f / l;
    bf16_t* op = qb + token * D + head * 256 + 4 * h;
    const bf16_t* vp0 = VT + (((size_t)(b * 4 + head) * 8 * 8 * 2 * 64) + lane) * 8;
    bf16x8 vc[16], vn[16];
#pragma unroll
    for (int e = 0; e < 16; ++e) vc[e] = *(const bf16x8*)(vp0 + e * 512);
#pragma unroll 1
    for (int dt = 0; dt < 8; ++dt) {
        const int dn = dt < 7 ? dt + 1 : 7;
#pragma unroll
        for (int e = 0; e < 16; ++e) vn[e] = *(const bf16x8*)(vp0 + (size_t)dn * 16 * 512 + e * 512);
        f32x16 o, o_b;
#pragma unroll
        for (int i = 0; i < 16; ++i) { o[i] = 0.f; o_b[i] = 0.f; }
#pragma unroll
        for (int tile = 0; tile < 8; ++tile) { o = MFMA(vc[tile * 2], pf[tile][0], o); o_b = MFMA(vc[tile * 2 + 1], pf[tile][1], o_b); }
#pragma unroll
        for (int i = 0; i < 16; ++i) o[i] += o_b[i];
#pragma unroll
        for (int g = 0; g < 4; ++g)
            if (dry) { if (o[4 * g] == 12345.678f) qb[0] = 1; } else *(uint2*)(op + dt * 32 + 8 * g) = make_uint2(pk2(o[4 * g] * il, o[4 * g + 1] * il), pk2(o[4 * g + 2] * il, o[4 * g + 3] * il));
#pragma unroll
        for (int e = 0; e < 16; ++e) vc[e] = vn[e];
    }
}

DI void xattn_phase(const Params& P, int l, char* smem, bool dry) {
    const int tid_ = otid(); const int lane = tid_ & 63, wid = tid_ >> 6;
    bf16_t* qb = (bf16_t*)(P.ws + OFF_BIG);
    const bf16_t* Kn = (const bf16_t*)(P.ws + OFF_KF + (size_t)l * SZ_MM);
    const bf16_t* VT = (const bf16_t*)(P.ws + OFF_VT + (size_t)l * SZ_MM);
    const float* qg = P.in[19] + l * 256;
    char* ql = smem + wid * 16384;
    for (int it = blockIdx.x * 8 + wid; it < 2048; it += gridDim.x * 8) {
        const int qt = it & 127, head = (it >> 7) & 3, b = it >> 9;
        const float kmax2 = ((const float*)(P.ws + OFF_KMAX))[l * 16 + b * 4 + head];
        xattn_wave(qb, Kn, VT, qg, kmax2, b, head, qt * 32, ql, lane, dry);
    }
}

DI void knorm_phase(const Params& P) {
    const int tid_ = otid(); const int lane = tid_ & 63, wid = tid_ >> 6;
    for (int u = blockIdx.x * 8 + wid; u < 8192; u += gridDim.x * 8) {
        const int l = u >> 12, row = (u >> 2) & 1023, head = u & 3;
        const bf16_t* kp = (const bf16_t*)(P.ws + OFF_KN + (size_t)l * SZ_MM) + (size_t)row * D + head * 256 + lane * 4;
        const uint2 v = *(const uint2*)kp;
        const float a0 = bflo(v.x), a1 = bfhi(v.x), a2 = bflo(v.y), a3 = bfhi(v.y);
        float ss = a0 * a0 + a1 * a1 + a2 * a2 + a3 * a3;
        ss = wave_sum(ss);
        const float inv = __builtin_amdgcn_rsqf(ss * (1.f / 256.f) + EPS);
        const float4 g = *(const float4*)(P.in[20] + l * 256 + lane * 4);
        const int b = row >> 8, key = row & 255;
        const int h = lane >> 5, ks = (lane & 31) >> 1, j0 = (lane & 1) * 4;
        bf16_t* dp = (bf16_t*)(P.ws + OFF_KF + (size_t)l * SZ_MM) + ((((((size_t)(b * 4 + head) * 8 + (key >> 5)) * 16 + ks) * 64) + h * 32 + (key & 31)) << 3) + j0;
        const unsigned w0_ = pk2(a0 * inv * g.x, a1 * inv * g.y), w1_ = pk2(a2 * inv * g.z, a3 * inv * g.w);
        *(uint2*)dp = make_uint2(w0_, w1_);
        float kk2 = bflo(w0_) * bflo(w0_) + bfhi(w0_) * bfhi(w0_) + bflo(w1_) * bflo(w1_) + bfhi(w1_) * bfhi(w1_);
        kk2 = wave_sum(kk2);
        if (lane == 0) atomicMax((unsigned*)(P.ws + OFF_KMAX) + l * 16 + b * 4 + head, __float_as_uint(kk2));
    }
}

DI void fast_grid_sync(unsigned* bar, unsigned target) {
    asm volatile("s_waitcnt vmcnt(0) lgkmcnt(0)" ::: "memory");
    __syncthreads();
    if (threadIdx.x == 0) {
        __builtin_amdgcn_fence(__ATOMIC_RELEASE, "agent");
        asm volatile("s_waitcnt vmcnt(0)" ::: "memory");
        __hip_atomic_fetch_add(bar, 1u, __ATOMIC_RELAXED, __HIP_MEMORY_SCOPE_AGENT);
        while (__hip_atomic_load(bar, __ATOMIC_RELAXED, __HIP_MEMORY_SCOPE_AGENT) < target) __builtin_amdgcn_s_sleep(2);
        __builtin_amdgcn_fence(__ATOMIC_ACQUIRE, "agent");
        asm volatile("s_waitcnt vmcnt(0)" ::: "memory");
    }
    __syncthreads();
}

__global__ void __launch_bounds__(512) fwd_megakernel(Params P) {
    extern __shared__ __attribute__((aligned(16))) char smem[];
    cg::grid_group grid = cg::this_grid();
    unsigned nbar = 0;
#pragma unroll 1
    for (int ph = 0; ph < 21; ++ph) {
        float* ssq = (float*)(P.ws + OFF_SSQ);
        bf16_t* xb = (bf16_t*)(P.ws + OFF_XB);
        bf16_t* big = (bf16_t*)(P.ws + OFF_BIG);
        int nrep = 1;
        if (ph > 0) { const int s_ = (ph - 1) % 10; const int kind = (s_ == 3) ? 2 : (s_ == 6) ? 4 : 1; if (PROBE_MASK & kind) nrep = 2; }
        for (int rep = 0; rep < nrep; ++rep) {
        const bool dry = rep + 1 < nrep;
        if (ph == 0) {
            phase0(P, smem);
        } else {
            const int l = (ph - 1) / 10, s = (ph - 1) % 10;
            if (s == 3) {
                if (l == 0) attn_even_phase(P, smem, dry); else attn_odd_phase(P, smem, dry);
            } else if (s == 6) {
                xattn_phase(P, l, smem, dry);
            } else {
                pg8::Gemm g; pg8::Epi E;
                g.A = xb; g.lda = D; g.K = D; g.M = T; g.N = D; g.Bt = nullptr;
                E.mode = 1; E.rs = nullptr; E.O = big; E.ldo = D; E.xin = nullptr; E.xout = nullptr; E.xb = xb; E.ssq_out = ssq; E.alpha = 1.f;
                E.qg = nullptr; E.kg = nullptr; E.qn_end = 0; E.kn_beg = 0; E.kn_end = 0;
                if (s == 0 || s == 8) {
                    g.Bt = (const bf16_t*)(P.ws + (s == 0 ? OFF_GU1 : OFF_GU2) + (size_t)l * SZ_GU); g.N = NGU;
                    E.mode = 0; E.rs = ssq + (size_t)(4 * l + (s == 0 ? 0 : 3)) * T; E.ldo = DFF;
                } else if (s == 1 || s == 9) {
                    g.A = big; g.lda = DFF; g.K = DFF;
                    g.Bt = (const bf16_t*)(P.ws + (s == 1 ? OFF_DN1 : OFF_DN2) + (size_t)l * SZ_DN);
                    E.alpha = 0.5f; E.ssq_out = ssq + (size_t)(4 * l + (s == 1 ? 1 : 4)) * T;
                    if (ph == 2) E.xin = P.in[0];
                    if (ph == 20) { E.xout = P.out; E.ssq_out = nullptr; }
                } else if (s == 2) {
                    E.mode = 2; E.rs = ssq + (size_t)(4 * l + 1) * T;
                    if (l == 0) { g.Bt = (const bf16_t*)(P.ws + OFF_EVIN); g.N = 2304; E.ldo = 2304; E.qg = P.in[7]; E.kg = P.in[8]; E.qn_end = 512; E.kn_beg = 1024; E.kn_end = 1152; }
                    else { g.Bt = (const bf16_t*)(P.ws + OFF_ODIN); g.N = 3072; E.ldo = 3072; E.qg = P.in[12]; E.kg = P.in[13]; E.qn_end = 1024; E.kn_beg = 1024; E.kn_end = 2048; }
                } else if (s == 4) {
                    g.A = big;
                    if (l == 0) { g.Bt = (const bf16_t*)(P.ws + OFF_EVOUT); g.lda = 2304; }
                    else { g.Bt = (const bf16_t*)(P.ws + OFF_ODOUT); g.lda = 3072; }
                    E.ssq_out = ssq + (size_t)(4 * l + 2) * T;
                } else if (s == 5) {
                    g.Bt = (const bf16_t*)(P.ws + OFF_WQ + (size_t)l * SZ_MM); E.mode = 2; E.rs = ssq + (size_t)(4 * l + 2) * T; E.ldo = D;
                } else {
                    g.A = big; g.Bt = (const bf16_t*)(P.ws + OFF_WO + (size_t)l * SZ_MM); E.ssq_out = ssq + (size_t)(4 * l + 3) * T;
                }
                pg8::StaticOrder So; So.init(T, g.N, (int)gridDim.x, (int)blockIdx.x);
                E.dryrun = 0;
#if PROBE_GEMM
                for (int rep_ = 0; rep_ < 2; ++rep_) {
                pg8::Epi E2 = E;
                if (rep_ == 0) { if (PROBE_GEMM == 1) E2.dryrun = 1; else if (E.mode == 1) { E2.alpha = 0.f; } }
                __syncthreads();
                pg8::gemm_phase<pg8::Epi, pg8::StaticOrder, true, true>((PG8_LAS unsigned char*)smem, g, So, rep_ == 0 ? E2 : E);
                ++nbar; fast_grid_sync((unsigned*)(P.ws + OFF_BAR), nbar * gridDim.x);
                }
#else
                __syncthreads();
                pg8::gemm_phase<pg8::Epi, pg8::StaticOrder, true, true>((PG8_LAS unsigned char*)smem, g, So, E);
#endif
                if (ph == 1) {
                    GJob J;
                    J.A = xb; J.lda = D; J.ksplit = 1 << 30; J.kextra = 0; J.K = D; J.ntm = 4; J.mode = 3; J.rs = nullptr;
                    J.O = big; J.ldo = D; J.xin = P.out; J.xout = P.out; J.xb = xb; J.ssq_out = ssq; J.alpha = 1.f;
                    J.qg = nullptr; J.kg = nullptr; J.qn_end = 0; J.kn_end = 0; J.vt = nullptr; J.W = nullptr; J.ntn = 8;
                    gemm_phase(J, 0, 64, P, smem, false);
                }
                if (ph == 2 && !dry) knorm_phase(P);
            }
        }
        if (P.ws == nullptr) grid.sync();
        if (ph < 20) { ++nbar; fast_grid_sync((unsigned*)(P.ws + OFF_BAR), nbar * gridDim.x); }
        }
    }
}

extern "C" void kernel_launch(void* const* d_in, const int* in_sizes, int n_in, void* d_out, int out_size, void* d_ws, size_t ws_size,
                              hipStream_t stream) {
    static int grid_blocks = 0;
    if (!grid_blocks) {
        int dev = 0, cus = 0, per_cu = 0;
        hipGetDevice(&dev);
        hipDeviceGetAttribute(&cus, hipDeviceAttributeMultiprocessorCount, dev);
        hipFuncSetAttribute((const void*)fwd_megakernel, hipFuncAttributeMaxDynamicSharedMemorySize, LDS_BYTES);
        hipOccupancyMaxActiveBlocksPerMultiprocessor(&per_cu, fwd_megakernel, NTHR, LDS_BYTES);
        if (per_cu < 1) per_cu = 1;
        if (per_cu > 1) per_cu = 1;
        grid_blocks = cus * per_cu;
    }
    if (ws_size < WS_NEED) { fprintf(stderr, "workspace too small: %zu < %zu\n", ws_size, (size_t)WS_NEED); return; }
    Params p{};
    for (int i = 0; i < 25; ++i) p.in[i] = (const float*)d_in[i];
    p.out = (float*)d_out; p.ws = (char*)d_ws;
    hipMemsetAsync((char*)d_ws + OFF_BAR, 0, 256, stream);
    void* args[] = {&p};
    hipError_t e = hipLaunchCooperativeKernel((void*)fwd_megakernel, dim3(grid_blocks), dim3(NTHR), args, LDS_BYTES, stream);
    if (e != hipSuccess) fprintf(stderr, "cooperative launch failed: %s (grid %d)\n", hipGetErrorString(e), grid_blocks);
}
```

```cpp
#include <hip/hip_runtime.h>
#include <hip/hip_cooperative_groups.h>
#include <cstdio>
#include <cstdint>
namespace cg = cooperative_groups;

#define DI __device__ __forceinline__
typedef unsigned short bf16_t;
typedef short bf16x8 __attribute__((ext_vector_type(8)));
typedef short s16x4 __attribute__((ext_vector_type(4)));
typedef float f32x16 __attribute__((ext_vector_type(16)));
typedef __bf16 bf2_t __attribute__((ext_vector_type(2)));
typedef float f2_t __attribute__((ext_vector_type(2)));
typedef short v4i16_t __attribute__((ext_vector_type(4)));
#define MFMA(a, b, c) __builtin_amdgcn_mfma_f32_32x32x16_bf16((a), (b), (c), 0, 0, 0)

constexpr int T = 16384, S = 4096, D = 1024, DFF = 2816, NGU = 5632;
constexpr float EPS = 1e-6f;
constexpr float LOG2E = 1.4426950408889634f;
constexpr float LN2 = 0.6931471805599453f;

constexpr size_t SZ_GU = (size_t)NGU * D * 2, SZ_DN = (size_t)D * DFF * 2, SZ_MM = (size_t)D * D * 2;
constexpr size_t OFF_GU1 = 0;
constexpr size_t OFF_DN1 = OFF_GU1 + 2 * SZ_GU;
constexpr size_t OFF_GU2 = OFF_DN1 + 2 * SZ_DN;
constexpr size_t OFF_DN2 = OFF_GU2 + 2 * SZ_GU;
constexpr size_t OFF_WQ = OFF_DN2 + 2 * SZ_DN;
constexpr size_t OFF_WKV = OFF_WQ + 2 * SZ_MM;
constexpr size_t OFF_WO = OFF_WKV + 4 * SZ_MM;
constexpr size_t OFF_EVIN = OFF_WO + 2 * SZ_MM;
constexpr size_t OFF_EVOUT = OFF_EVIN + (size_t)2304 * D * 2;
constexpr size_t OFF_ODIN = OFF_EVOUT + SZ_MM;
constexpr size_t OFF_ODOUT = OFF_ODIN + (size_t)3072 * D * 2;
constexpr size_t OFF_XB = OFF_ODOUT + SZ_MM;
constexpr size_t OFF_BIG = OFF_XB + (size_t)T * D * 2;
constexpr size_t OFF_MEMB = OFF_BIG + (size_t)T * 3072 * 2;
constexpr size_t OFF_KN = OFF_MEMB + SZ_MM;
constexpr size_t OFF_VT = OFF_KN + 2 * SZ_MM;
constexpr size_t OFF_SSQ = OFF_VT + 2 * SZ_MM;
constexpr size_t OFF_SSQM = OFF_SSQ + (size_t)9 * T * 4;
constexpr size_t OFF_KMAX = OFF_SSQM + 4096;
constexpr size_t OFF_BAR = OFF_KMAX + 256;
constexpr size_t OFF_KF = OFF_BAR + 256;
constexpr size_t WS_NEED = OFF_KF + 2 * SZ_MM;

#ifndef PROBE_MASK
#define PROBE_MASK 0
#endif
#ifndef PROBE_GEMM
#define PROBE_GEMM 0
#endif
constexpr int NTHR = 512;
constexpr int NST = 4;
constexpr int STAGE_B = 32768;
constexpr int OPB = 16384;
constexpr int LDS_BYTES = 131072;

struct Params { const float* in[25]; float* out; char* ws; };

DI unsigned pk2(float a, float b) { f2_t v = {a, b}; bf2_t r = __builtin_convertvector(v, bf2_t); return __builtin_bit_cast(unsigned, r); }
DI float bflo(unsigned w) { return __uint_as_float(w << 16); }
DI float bfhi(unsigned w) { return __uint_as_float(w & 0xffff0000u); }
DI int otid() { int t = threadIdx.x; asm volatile("" : "+v"(t)); return t; }
DI int crow(int i, int h) { return (i & 3) + 8 * (i >> 2) + 4 * h; }
DI float fexp2(float x) { return __builtin_amdgcn_exp2f(x); }
DI float flog2(float x) { return __builtin_amdgcn_logf(x); }

struct WJob { const float* src; bf16_t* dst; const float* gain; int K, N, gu; };

DI int wjob_tiles(int j) {
    if (j < 14) {
        const int kind = j >> 1;
        switch (kind) {
            case 0: case 2: return 16 * 88;
            case 1: case 3: return 44 * 16;
            case 4: return 256;
            case 5: return 512;
            default: return 256;
        }
    }
    if (j == 14) return 16 * 36;
    if (j == 16) return 16 * 48;
    return 256;
}

DI WJob get_wjob(const Params& P, int j) {
    WJob w; w.gain = nullptr; w.gu = 0;
    bf16_t* wsb = (bf16_t*)P.ws;
    if (j < 14) {
        const int kind = j >> 1, l = j & 1;
        switch (kind) {
            case 0: w.src = P.in[3] + (size_t)l * D * NGU; w.dst = (bf16_t*)(P.ws + OFF_GU1 + l * SZ_GU); w.gain = P.in[2] + l * D; w.K = D; w.N = NGU; w.gu = 1; break;
            case 1: w.src = P.in[4] + (size_t)l * DFF * D; w.dst = (bf16_t*)(P.ws + OFF_DN1 + l * SZ_DN); w.K = DFF; w.N = D; w.gu = 2; break;
            case 2: w.src = P.in[23] + (size_t)l * D * NGU; w.dst = (bf16_t*)(P.ws + OFF_GU2 + l * SZ_GU); w.gain = P.in[22] + l * D; w.K = D; w.N = NGU; w.gu = 1; break;
            case 3: w.src = P.in[24] + (size_t)l * DFF * D; w.dst = (bf16_t*)(P.ws + OFF_DN2 + l * SZ_DN); w.K = DFF; w.N = D; w.gu = 2; break;
            case 4: w.src = P.in[17] + (size_t)l * D * D; w.dst = (bf16_t*)(P.ws + OFF_WQ + l * SZ_MM); w.gain = P.in[15] + l * D; w.K = D; w.N = D; w.gu = 2; break;
            case 5: w.src = P.in[18] + (size_t)l * D * 2048; w.dst = (bf16_t*)(P.ws + OFF_WKV + l * 2 * SZ_MM); w.gain = P.in[16] + l * D; w.K = D; w.N = 2048; break;
            default: w.src = P.in[21] + (size_t)l * D * D; w.dst = (bf16_t*)(P.ws + OFF_WO + l * SZ_MM); w.K = D; w.N = D; w.gu = 2; break;
        }
    } else if (j == 14) { w.src = P.in[6]; w.dst = (bf16_t*)(P.ws + OFF_EVIN); w.gain = P.in[5]; w.K = D; w.N = 2304; w.gu = 3; }
    else if (j == 15) { w.src = P.in[10]; w.dst = (bf16_t*)(P.ws + OFF_EVOUT); w.K = D; w.N = D; w.gu = 2; }
    else if (j == 16) { w.src = P.in[11]; w.dst = (bf16_t*)(P.ws + OFF_ODIN); w.gain = P.in[5] + D; w.K = D; w.N = 3072; w.gu = 2; }
    else { w.src = P.in[14]; w.dst = (bf16_t*)(P.ws + OFF_ODOUT); w.K = D; w.N = D; w.gu = 2; }
    (void)wsb;
    return w;
}

DI void wconv_tile(const WJob& w, int t, float* sm, int tid, bool act) {
    const int ntn = w.N >> 6; const int tk = t / ntn, tn = t - tk * ntn;
    if (act) {
#pragma unroll
        for (int p = 0; p < 4; ++p) {
            const int kr = p * 16 + (tid >> 4);
            const float4 v = *(const float4*)(w.src + (size_t)(tk * 64 + kr) * w.N + tn * 64 + (tid & 15) * 4);
            const float g = w.gain ? w.gain[tk * 64 + kr] : 1.f;
            float* sp = sm + kr * 65 + (tid & 15) * 4;
            sp[0] = v.x * g; sp[1] = v.y * g; sp[2] = v.z * g; sp[3] = v.w * g;
        }
    }
    __syncthreads();
    if (act) {
        const int n = tid >> 2, kq = tid & 3; const int ng = tn * 64 + n;
        int drow = ng;
        if (w.gu == 1) drow = ng < DFF ? ((ng >> 7) * 256 + (ng & 127)) : (((ng - DFF) >> 7) * 256 + 128 + ((ng - DFF) & 127));
        else if (w.gu >= 2) {
            int a = ng;
            if (w.gu == 3) a = ng < 512 ? ng : ng < 768 ? ng + 512 : ng < 1280 ? ng - 256 : ng;
            drow = (a & ~255) + (((a >> 5) & 1) << 7) + (((a >> 6) & 3) << 5) + (a & 31);
        }
        unsigned o[8];
#pragma unroll
        for (int e = 0; e < 8; ++e) o[e] = pk2(sm[(kq * 16 + 2 * e) * 65 + n], sm[(kq * 16 + 2 * e + 1) * 65 + n]);
        uint4* dp = (uint4*)(w.dst + (size_t)drow * w.K + tk * 64 + kq * 16);
        dp[0] = make_uint4(o[0], o[1], o[2], o[3]); dp[1] = make_uint4(o[4], o[5], o[6], o[7]);
    }
    __syncthreads();
}

DI float wave_sum(float v) {
    v += __shfl_xor(v, 1); v += __shfl_xor(v, 2); v += __shfl_xor(v, 4); v += __shfl_xor(v, 8); v += __shfl_xor(v, 16); v += __shfl_xor(v, 32);
    return v;
}

DI void rowconv(const float* src, bf16_t* dst, float* ssq, int row, int lane) {
    const float* xr = src + (size_t)row * D;
    float ss = 0.f;
#pragma unroll
    for (int p = 0; p < 4; ++p) {
        const float4 v = *(const float4*)(xr + p * 256 + lane * 4);
        ss += v.x * v.x + v.y * v.y + v.z * v.z + v.w * v.w;
        *(uint2*)(dst + (size_t)row * D + p * 256 + lane * 4) = make_uint2(pk2(v.x, v.y), pk2(v.z, v.w));
    }
    ss = wave_sum(ss);
    if (lane == 0) ssq[row] = ss;
}

DI void phase0(const Params& P, char* smem) {
    const int tid = otid(), lane = tid & 63, wid = tid >> 6;
    float* ssq = (float*)(P.ws + OFF_SSQ);
    for (int i = blockIdx.x * NTHR + tid; i < 8 * T; i += gridDim.x * NTHR) ssq[T + i] = 0.f;
    if (blockIdx.x == 0 && tid < 32) ((unsigned*)(P.ws + OFF_KMAX))[tid] = 0u;
    constexpr int NW = 12352 / 2, NX = T / 8, NM = 1024 / 8;
    for (int u = blockIdx.x; u < NW + NX + NM; u += gridDim.x) {
        if (u < NW) {
            const int half = tid >> 8;
            int t = 2 * u + half, j = 0;
            for (; j < 17; ++j) { const int c = wjob_tiles(j); if (t < c) break; t -= c; }
            const WJob w = get_wjob(P, j);
            wconv_tile(w, t, (float*)smem + half * (64 * 65), tid & 255, true);
        } else if (u < NW + NX) {
            rowconv(P.in[0], (bf16_t*)(P.ws + OFF_XB), ssq, (u - NW) * 8 + wid, lane);
        } else {
            rowconv(P.in[1], (bf16_t*)(P.ws + OFF_MEMB), (float*)(P.ws + OFF_SSQM), (u - NW - NX) * 8 + wid, lane);
        }
    }
}

struct GJob {
    const bf16_t* A; const bf16_t* W;
    int lda, ksplit, kextra, K, ntm, ntn, mode;
    const float* rs;
    bf16_t* O; int ldo;
    const float* xin; float* xout; bf16_t* xb; float* ssq_out; float alpha;
    const float* qg; const float* kg; int qn_end, kn_end;
    bf16_t* vt;
};

typedef __attribute__((address_space(3))) unsigned* ldsu_t;
typedef const __attribute__((address_space(1))) unsigned* glbu_t;
DI void glds16(const bf16_t* g, char* l) { __builtin_amdgcn_global_load_lds((glbu_t)(const void*)g, (ldsu_t)(void*)l, 16, 0, 0); }

DI void gemm_tile(const GJob& J, int t, char* smem, bool dry) {
    const int tid = otid(), lane = tid & 63, wid = tid >> 6, wr = wid >> 2, wc = wid & 3;
    const int r = lane & 31, h = lane >> 5;
    int tm, tn;
    { const int gsz = 32 * J.ntn; const int g = t / gsz; const int rem = t - g * gsz; const int rows = min(32, J.ntm - g * 32); tn = rem / rows; tm = g * 32 + (rem - tn * rows); }
    const int lrow = wid * 16 + (lane >> 2);
    const int csw = ((lane & 3) ^ ((lane >> 4) & 3)) * 8;
    const bf16_t* Ag = J.A + (size_t)(tm * 256 + lrow) * J.lda + csw;
    const bf16_t* Wg = J.W + (size_t)(tn * 256 + lrow) * J.K + csw;
    const size_t astr = (size_t)128 * J.lda, wstr = (size_t)128 * J.K;
    char* lb = smem + tid * 16;
    const int nk = J.K >> 5;
#define GLDS(kt, buf) do { const int k0_ = (kt) * 32; const int ka_ = k0_ + (k0_ >= J.ksplit ? J.kextra : 0); char* l_ = lb + (buf) * STAGE_B; \
        glds16(Ag + ka_, l_); glds16(Ag + astr + ka_, l_ + 8192); glds16(Wg + k0_, l_ + OPB); glds16(Wg + wstr + k0_, l_ + OPB + 8192); } while (0)
    f32x16 acc[4][2];
#pragma unroll
    for (int a = 0; a < 4; ++a)
#pragma unroll
        for (int b = 0; b < 2; ++b)
#pragma unroll
            for (int i = 0; i < 16; ++i) acc[a][b][i] = 0.f;
    const int fr = (r >> 2) & 3;
    const int xrow = (wc * 64 + r) * 64, wrow = OPB + (wr * 128 + r) * 64;
    const int co0 = ((0 + h) ^ fr) * 16, co1 = ((2 + h) ^ fr) * 16;

    __syncthreads();
    GLDS(0, 0); GLDS(1, 1); GLDS(2, 2);
    asm volatile("s_waitcnt vmcnt(8)" ::: "memory");
    __builtin_amdgcn_s_barrier();
    bf16x8 w0[4], x0[2], w1[4], x1[2];
#define LOADF(W_, X_, sb_, co_) do { _Pragma("unroll") for (int ti = 0; ti < 2; ++ti) X_[ti] = *(const bf16x8*)((sb_) + xrow + ti * 2048 + (co_)); \
        _Pragma("unroll") for (int fi = 0; fi < 4; ++fi) W_[fi] = *(const bf16x8*)((sb_) + wrow + fi * 2048 + (co_)); } while (0)
#define MFMA8(W_, X_) do { __builtin_amdgcn_s_setprio(1); _Pragma("unroll") for (int fi = 0; fi < 4; ++fi) _Pragma("unroll") for (int ti = 0; ti < 2; ++ti) \
        acc[fi][ti] = MFMA(W_[fi], X_[ti], acc[fi][ti]); __builtin_amdgcn_s_setprio(0); } while (0)
    LOADF(w0, x0, smem, co0);
    __builtin_amdgcn_s_waitcnt(0xC07F);
    int buf = 0;
    for (int kt = 0; kt < nk; ++kt) {
        const char* sb = smem + buf * STAGE_B;
        LOADF(w1, x1, sb, co1);
        __builtin_amdgcn_sched_barrier(0);
        MFMA8(w0, x0);
        __builtin_amdgcn_s_waitcnt(0xC07F);
        __builtin_amdgcn_sched_barrier(0);
        const int nb = (buf + 1 == NST) ? 0 : buf + 1;
        if (kt + 1 < nk) {
            if (kt + 2 < nk) asm volatile("s_waitcnt vmcnt(4)" ::: "memory"); else asm volatile("s_waitcnt vmcnt(0)" ::: "memory");
            __builtin_amdgcn_s_barrier();
            if (kt + 3 < nk) { const int fb_ = (buf + 3 >= NST) ? buf + 3 - NST : buf + 3; GLDS(kt + 3, fb_); }
        }
        LOADF(w0, x0, smem + nb * STAGE_B, co0);
        __builtin_amdgcn_sched_barrier(0);
        MFMA8(w1, x1);
        __builtin_amdgcn_s_waitcnt(0xC07F);
        __builtin_amdgcn_sched_barrier(0);
        buf = nb;
    }
#undef LOADF
#undef MFMA8
#undef GLDS
    __syncthreads();

    if (dry) { if (acc[0][0][0] + acc[1][1][0] + acc[2][0][0] + acc[3][1][0] == 12345.678f) J.O[0] = 1; return; }
    const int tokb = tm * 256 + wc * 64;
    const int fb = tn * 256 + wr * 128;
    float rsc[2];
#pragma unroll
    for (int ti = 0; ti < 2; ++ti) rsc[ti] = J.rs ? __builtin_amdgcn_rsqf(J.rs[tokb + ti * 32 + r] * (1.f / 1024.f) + EPS) : 1.f;

    if (J.mode == 3 && fb >= 1024) {
#pragma unroll
        for (int ti = 0; ti < 2; ++ti) {
            const int tok = tokb + ti * 32 + r;
#pragma unroll
            for (int fi = 0; fi < 4; ++fi)
#pragma unroll
                for (int i = 0; i < 16; ++i) {
                    const int f = fb - 1024 + fi * 32 + crow(i, h);
                    const int bh_ = (tok >> 8) * 4 + (f >> 8), d_ = f & 255, key_ = tok & 255, k16 = key_ & 15;
                    const int ln_ = ((k16 >> 2) & 1) * 32 + (d_ & 31), e_ = ((k16 >> 3) << 2) | (k16 & 3);
                    J.vt[((((((size_t)bh_ * 8 + (d_ >> 5)) * 8 + (key_ >> 5)) * 2 + ((key_ >> 4) & 1)) * 64 + ln_) << 3) + e_] = (bf16_t)(pk2(acc[fi][ti][i] * rsc[ti], 0.f) & 0xffffu);
                }
        }
        return;
    }
    char* wl = smem + wid * 16384;
#pragma unroll
    for (int ti = 0; ti < 2; ++ti) {
#pragma unroll
        for (int fp = 0; fp < 2; ++fp) {
            const float sc = (J.mode == 1) ? J.alpha : rsc[ti];
#pragma unroll
            for (int fi2 = 0; fi2 < 2; ++fi2)
#pragma unroll
                for (int g = 0; g < 4; ++g) {
                    float4 v;
                    v.x = acc[2 * fp + fi2][ti][4 * g + 0] * sc; v.y = acc[2 * fp + fi2][ti][4 * g + 1] * sc;
                    v.z = acc[2 * fp + fi2][ti][4 * g + 2] * sc; v.w = acc[2 * fp + fi2][ti][4 * g + 3] * sc;
                    *(float4*)(wl + r * 272 + (fi2 * 32 + 8 * g + 4 * h) * 4) = v;
                }
            const int tok0 = tokb + ti * 32, f0 = fb + fp * 64;
            if (J.mode == 0) {
                const int c4 = (lane & 7) * 4;
#pragma unroll
                for (int p = 0; p < 4; ++p) {
                    const int row = p * 8 + (lane >> 3);
                    const float4 ga = *(const float4*)(wl + row * 272 + c4 * 4);
                    const float4 up = *(const float4*)(wl + row * 272 + (32 + c4) * 4);
                    float y0 = ga.x * up.x * __builtin_amdgcn_rcpf(1.f + fexp2(-ga.x * LOG2E));
                    float y1 = ga.y * up.y * __builtin_amdgcn_rcpf(1.f + fexp2(-ga.y * LOG2E));
                    float y2 = ga.z * up.z * __builtin_amdgcn_rcpf(1.f + fexp2(-ga.z * LOG2E));
                    float y3 = ga.w * up.w * __builtin_amdgcn_rcpf(1.f + fexp2(-ga.w * LOG2E));
                    *(uint2*)(J.O + (size_t)(tok0 + row) * J.ldo + (f0 >> 1) + c4) = make_uint2(pk2(y0, y1), pk2(y2, y3));
                }
            } else if (J.mode == 1) {
                const int c4 = (lane & 15) * 4;
#pragma unroll
                for (int p = 0; p < 8; ++p) {
                    const int row = p * 4 + (lane >> 4);
                    const size_t tok = tok0 + row;
                    const float4 v = *(const float4*)(wl + row * 272 + c4 * 4);
                    const float4 xo = *(const float4*)(J.xin + tok * D + f0 + c4);
                    float4 xn; xn.x = xo.x + v.x; xn.y = xo.y + v.y; xn.z = xo.z + v.z; xn.w = xo.w + v.w;
                    *(float4*)(J.xout + tok * D + f0 + c4) = xn;
                    if (J.xb) {
                        *(uint2*)(J.xb + tok * D + f0 + c4) = make_uint2(pk2(xn.x, xn.y), pk2(xn.z, xn.w));
                        float ss = xn.x * xn.x + xn.y * xn.y + xn.z * xn.z + xn.w * xn.w;
                        ss += __shfl_xor(ss, 1); ss += __shfl_xor(ss, 2); ss += __shfl_xor(ss, 4); ss += __shfl_xor(ss, 8);
                        if ((lane & 15) == 0) atomicAdd(J.ssq_out + tok, ss);
                    }
                }
            } else {
                const int nm = f0 < J.qn_end ? 1 : (f0 < J.kn_end ? 2 : 0);
                const float* gp = nm == 1 ? J.qg : J.kg;
                const int c4 = (lane & 15) * 4;
                float4 gn = make_float4(1.f, 1.f, 1.f, 1.f);
                if (nm) gn = *(const float4*)(gp + c4);
#pragma unroll
                for (int p = 0; p < 8; ++p) {
                    const int row = p * 4 + (lane >> 4);
                    float4 v = *(const float4*)(wl + row * 272 + c4 * 4);
                    if (nm) {
                        float ss = v.x * v.x + v.y * v.y + v.z * v.z + v.w * v.w;
                        ss += __shfl_xor(ss, 1); ss += __shfl_xor(ss, 2); ss += __shfl_xor(ss, 4); ss += __shfl_xor(ss, 8);
                        const float inv = __builtin_amdgcn_rsqf(ss * (1.f / 64.f) + EPS);
                        v.x *= inv * gn.x; v.y *= inv * gn.y; v.z *= inv * gn.z; v.w *= inv * gn.w;
                    }
                    *(uint2*)(J.O + (size_t)(tok0 + row) * J.ldo + f0 + c4) = make_uint2(pk2(v.x, v.y), pk2(v.z, v.w));
                }
            }
        }
    }
}

DI void gemm_phase(const GJob& JA, int nA, int nB, const Params& P, char* smem, bool dry) {
    for (int u = (int)gridDim.x - 1 - (int)blockIdx.x; u < nA + nB; u += gridDim.x) {
        GJob J = JA; int t = u;
        if (u >= nA) {
            const int v = u - nA; const int layer = v >> 5; t = v & 31;
            J.A = (const bf16_t*)(P.ws + OFF_MEMB); J.lda = D; J.ksplit = 1 << 30; J.kextra = 0;
            J.W = (const bf16_t*)(P.ws + OFF_WKV + (size_t)layer * 2 * SZ_MM); J.K = D; J.ntm = 4; J.ntn = 8; J.mode = 3;
            J.rs = (const float*)(P.ws + OFF_SSQM); J.O = (bf16_t*)(P.ws + OFF_KN + (size_t)layer * SZ_MM); J.ldo = D;
            J.qn_end = 0; J.kn_end = 0; J.vt = (bf16_t*)(P.ws + OFF_VT + (size_t)layer * SZ_MM);
        }
        gemm_tile(J, t, smem, dry);
    }
}

namespace pg8 {
#define PG8_LAS __attribute__((address_space(3)))
typedef float f32x4 __attribute__((ext_vector_type(4)));
typedef unsigned u32x4 __attribute__((ext_vector_type(4)));
constexpr int BM = 256, BK = 64, HALF = 128, HTB = HALF * BK * 2, STAGE_BYTES = 8 * HTB, NXCD = 8, WGM = 8;
DI int lds_byte(int r, int c) { const int st = (r >> 4) * 2 + (c >> 5), rr = r & 15, cc = c & 31, ob = rr * 64 + cc * 2; return st * 1024 + (ob ^ (((ob >> 9) & 1) << 5)); }
DI void stage_rc(int b, int& R, int& C) { const int st = b / 1024, sb = b % 1024, swz = sb ^ (((sb >> 9) & 1) << 5); R = (st >> 1) * 16 + swz / 64; C = (st & 1) * 32 + (swz % 64) / 2; }
DI int perm32(int rho) { const int n = rho >> 4, i = rho & 15; return 8 * (i >> 2) + 4 * n + (i & 3); }
struct Unit { int pm, pn; };
struct Gemm { const bf16_t* A; const bf16_t* Bt; int M, N, K, lda; };
struct StaticOrder {
    int nM, nN, nwg, G, c;
    DI void init(int M, int N, int G_, int c_) { nM = M / BM; nN = N / BM; nwg = nM * nN; G = G_; c = c_; }
    DI bool next(int i, Unit& u) const {
        const long L = (long)i * G + c; if (L >= nwg) return false;
        int wgid = (int)L; { const int q = nwg / NXCD, r = nwg % NXCD, xcd = wgid % NXCD, off = wgid / NXCD; wgid = (xcd < r ? xcd * (q + 1) : r * (q + 1) + (xcd - r) * q) + off; }
        const int nig = WGM * nN, gid = wgid / nig, fm = gid * WGM, gsz = (nM - fm) < WGM ? (nM - fm) : WGM;
        u.pm = fm + ((wgid % nig) % gsz); u.pn = (wgid % nig) / gsz; return true;
    }
    DI void a_ready(const Unit&) const {}
    DI void done(const Unit&) const {}
};

struct Epi {
    static constexpr bool PERM = true, AFTER_DRAIN = false;
    int mode;
    const float* rs;
    bf16_t* O; int ldo;
    const float* xin; float* xout; bf16_t* xb; float* ssq_out; float alpha;
    const float* qg; const float* kg; int qn_end, kn_beg, kn_end; int dryrun;
    DI void operator()(const f32x4 (&acc)[2][2][4][2], const Unit& u, int wr, int wc, int fr, int fq) const {
        if (dryrun) { if (acc[0][0][0][0][0] + acc[1][1][3][1][3] + acc[0][1][2][0][1] + acc[1][0][1][1][2] == 12345.678f) O[0] = 1; return; }
        const int row0 = u.pm * BM + wr * 64 + fr;
        if (mode == 0) {
            const int col = u.pn * 128 + wc * 32 + 8 * fq;
#pragma unroll
            for (int ai = 0; ai < 2; ++ai)
#pragma unroll
                for (int m = 0; m < 4; ++m) {
                    const size_t tok = row0 + ai * HALF + m * 16;
                    const float sc = __builtin_amdgcn_rsqf(rs[tok] * (1.f / 1024.f) + EPS);
                    float y[8];
#pragma unroll
                    for (int n = 0; n < 2; ++n)
#pragma unroll
                        for (int j = 0; j < 4; ++j) {
                            const float ga = acc[ai][0][m][n][j] * sc, up = acc[ai][1][m][n][j] * sc;
                            y[4 * n + j] = ga * up * __builtin_amdgcn_rcpf(1.f + fexp2(-ga * LOG2E));
                        }
                    *(uint4*)(O + tok * ldo + col) = make_uint4(pk2(y[0], y[1]), pk2(y[2], y[3]), pk2(y[4], y[5]), pk2(y[6], y[7]));
                }
        } else if (mode == 1) {
#pragma unroll
            for (int ai = 0; ai < 2; ++ai)
#pragma unroll
                for (int m = 0; m < 4; ++m) {
                    const size_t tok = row0 + ai * HALF + m * 16;
                    float ss = 0.f;
#pragma unroll
                    for (int bj = 0; bj < 2; ++bj) {
                        const int col = u.pn * BM + wc * 64 + bj * 32 + 8 * fq;
                        float4 x0, x1;
                        if (xin) { x0 = *(const float4*)(xin + tok * D + col); x1 = *(const float4*)(xin + tok * D + col + 4); }
                        else {
                            const uint4 w = *(const uint4*)(xb + tok * D + col);
                            x0 = make_float4(bflo(w.x), bfhi(w.x), bflo(w.y), bfhi(w.y)); x1 = make_float4(bflo(w.z), bfhi(w.z), bflo(w.w), bfhi(w.w));
                        }
                        float4 n0, n1;
                        n0.x = x0.x + alpha * acc[ai][bj][m][0][0]; n0.y = x0.y + alpha * acc[ai][bj][m][0][1]; n0.z = x0.z + alpha * acc[ai][bj][m][0][2]; n0.w = x0.w + alpha * acc[ai][bj][m][0][3];
                        n1.x = x1.x + alpha * acc[ai][bj][m][1][0]; n1.y = x1.y + alpha * acc[ai][bj][m][1][1]; n1.z = x1.z + alpha * acc[ai][bj][m][1][2]; n1.w = x1.w + alpha * acc[ai][bj][m][1][3];
                        if (xout) { *(float4*)(xout + tok * D + col) = n0; *(float4*)(xout + tok * D + col + 4) = n1; }
                        if (ssq_out) {
                            const uint4 w = make_uint4(pk2(n0.x, n0.y), pk2(n0.z, n0.w), pk2(n1.x, n1.y), pk2(n1.z, n1.w));
                            *(uint4*)(xb + tok * D + col) = w;
                            const float r0 = bflo(w.x), r1 = bfhi(w.x), r2 = bflo(w.y), r3 = bfhi(w.y), r4 = bflo(w.z), r5 = bfhi(w.z), r6 = bflo(w.w), r7 = bfhi(w.w);
                            ss += r0 * r0 + r1 * r1 + r2 * r2 + r3 * r3 + r4 * r4 + r5 * r5 + r6 * r6 + r7 * r7;
                        }
                    }
                    if (ssq_out) {
                        ss += __shfl_xor(ss, 16); ss += __shfl_xor(ss, 32);
                        if (fq == 0) atomicAdd(ssq_out + tok, ss);
                    }
                }
        } else {
            const int f0 = u.pn * BM + wc * 64;
            const int nm = f0 < qn_end ? 1 : ((f0 >= kn_beg && f0 < kn_end) ? 2 : 0);
            const float* gp = nm == 1 ? qg : kg;
            float4 g4[2][2];
#pragma unroll
            for (int bj = 0; bj < 2; ++bj)
#pragma unroll
                for (int n = 0; n < 2; ++n) g4[bj][n] = nm ? *(const float4*)(gp + bj * 32 + 8 * fq + 4 * n) : make_float4(1.f, 1.f, 1.f, 1.f);
#pragma unroll
            for (int ai = 0; ai < 2; ++ai)
#pragma unroll
                for (int m = 0; m < 4; ++m) {
                    const size_t tok = row0 + ai * HALF + m * 16;
                    float sc = rs ? __builtin_amdgcn_rsqf(rs[tok] * (1.f / 1024.f) + EPS) : 1.f;
                    if (nm) {
                        float ss = 0.f;
#pragma unroll
                        for (int bj = 0; bj < 2; ++bj)
#pragma unroll
                            for (int n = 0; n < 2; ++n)
#pragma unroll
                                for (int j = 0; j < 4; ++j) { const float v = acc[ai][bj][m][n][j] * sc; ss += v * v; }
                        ss += __shfl_xor(ss, 16); ss += __shfl_xor(ss, 32);
                        sc *= __builtin_amdgcn_rsqf(ss * (1.f / 64.f) + EPS);
                    }
#pragma unroll
                    for (int bj = 0; bj < 2; ++bj) {
                        const f32x4 a0 = acc[ai][bj][m][0], a1 = acc[ai][bj][m][1];
                        *(uint4*)(O + tok * ldo + f0 + bj * 32 + 8 * fq) =
                            make_uint4(pk2(a0[0] * sc * g4[bj][0].x, a0[1] * sc * g4[bj][0].y), pk2(a0[2] * sc * g4[bj][0].z, a0[3] * sc * g4[bj][0].w),
                                       pk2(a1[0] * sc * g4[bj][1].x, a1[1] * sc * g4[bj][1].y), pk2(a1[2] * sc * g4[bj][1].z, a1[3] * sc * g4[bj][1].w));
                    }
                }
        }
    }
};

template <class Epi, class Sched, bool ALIGN_EPI = false, bool SP2 = false>
__device__ __forceinline__ void gemm_phase(PG8_LAS unsigned char* lds, const Gemm g, const Sched& S, const Epi& E) {
    const int tid = otid(), wid = __builtin_amdgcn_readfirstlane(tid >> 6), lane = tid & 63, wr = wid >> 2, wc = wid & 3, fr = lane & 15, fq = lane >> 4;
    const int K = g.K, nt = K / BK;
    unsigned voffA[2], voffB[2];
#pragma unroll
    for (int i = 0; i < 2; ++i) { int R, C; stage_rc(tid * 16 + i * 8192, R, C); const int Rb = Epi::PERM ? ((R & ~31) + perm32(R & 31)) : R;
        voffA[i] = (unsigned)(R * g.lda + C) * 2u; voffB[i] = (unsigned)(Rb * K + C) * 2u; }
    const size_t kstep = (size_t)(BK * 2);
    const size_t hstepA = (size_t)HALF * g.lda * 2, hstepB = (size_t)HALF * K * 2;
    const size_t tstepA = 2 * hstepA, tstepB = 2 * hstepB;
    const unsigned ldsw = (unsigned)wid * 1024u;
    const int aoff = lds_byte(wr * 64 + fr, fq * 8), boff = lds_byte(wc * 32 + fr, fq * 8);
#define PG8_SA(b, h) (((b) * 2 + (h)) * HTB)
#define PG8_SB(b, h) ((4 + (b) * 2 + (h)) * HTB)
#define PG8_STAGE(bufoff, gbase, voff) do { _Pragma("unroll") for (int _i = 0; _i < 2; ++_i) \
        __builtin_amdgcn_global_load_lds((const unsigned*)((const char*)(gbase) + (voff)[_i]), (PG8_LAS unsigned*)(lds + (bufoff) + ldsw + _i * 8192), 16, 0, 0); } while (0)
#define PG8_LDA(dst, b, h) do { _Pragma("unroll") for (int m = 0; m < 4; ++m) _Pragma("unroll") for (int k = 0; k < 2; ++k) dst[m][k] = *(const PG8_LAS bf16x8*)(lds + PG8_SA(b, h) + aoff + m * 2048 + k * 1024); } while (0)
#define PG8_LDB(dst, b, h) do { _Pragma("unroll") for (int n = 0; n < 2; ++n) _Pragma("unroll") for (int k = 0; k < 2; ++k) dst[n][k] = *(const PG8_LAS bf16x8*)(lds + PG8_SB(b, h) + boff + n * 2048 + k * 1024); } while (0)
#define PG8_MMA(ai, bj, At, Bt) do { __builtin_amdgcn_s_setprio(1); _Pragma("unroll") for (int m = 0; m < 4; ++m) _Pragma("unroll") for (int n = 0; n < 2; ++n) _Pragma("unroll") for (int k = 0; k < 2; ++k) \
        acc[ai][bj][m][n] = __builtin_amdgcn_mfma_f32_16x16x32_bf16(Bt[n][k], At[m][k], acc[ai][bj][m][n], 0, 0, 0); __builtin_amdgcn_s_setprio(0); } while (0)
#define PG8_WAIT_V(n) asm volatile("s_waitcnt vmcnt(" #n ")" ::: "memory")
#define PG8_WAIT_L(n) asm volatile("s_waitcnt lgkmcnt(" #n ")" ::: "memory")
#define PG8_BAR __builtin_amdgcn_s_barrier()
#define PG8_SCHED __builtin_amdgcn_sched_barrier(0)
    Unit cur, nxt; int ui = 0;
    if (!S.next(0, cur)) return;
    f32x4 acc[2][2][4][2];
#pragma unroll
    for (int a = 0; a < 2; ++a)
#pragma unroll
        for (int b = 0; b < 2; ++b)
#pragma unroll
            for (int m = 0; m < 4; ++m)
#pragma unroll
                for (int n = 0; n < 2; ++n) acc[a][b][m][n] = (f32x4){0.f, 0.f, 0.f, 0.f};
    bf16x8 At[4][2], B0[2][2], B1[2][2];
    const char* cA = (const char*)g.A + (size_t)cur.pm * tstepA; const char* cB = (const char*)g.Bt + (size_t)cur.pn * tstepB;
    S.a_ready(cur);
    if constexpr (SP2) {
        PG8_STAGE(PG8_SB(0, 0), cB, voffB); PG8_STAGE(PG8_SB(0, 1), cB + hstepB, voffB); PG8_STAGE(PG8_SA(0, 0), cA, voffA); PG8_STAGE(PG8_SA(0, 1), cA + hstepA, voffA);
        if (wr == 1) PG8_BAR;
        PG8_WAIT_V(2); PG8_BAR;
        PG8_STAGE(PG8_SB(1, 0), cB + kstep, voffB); PG8_STAGE(PG8_SA(1, 0), cA + kstep, voffA); PG8_STAGE(PG8_SB(1, 1), cB + hstepB + kstep, voffB);
        PG8_WAIT_V(6); PG8_BAR;
    } else {
        PG8_STAGE(PG8_SB(0, 0), cB, voffB); PG8_STAGE(PG8_SA(0, 0), cA, voffA); PG8_STAGE(PG8_SB(0, 1), cB + hstepB, voffB); PG8_STAGE(PG8_SA(0, 1), cA + hstepA, voffA);
        if (wr == 1) PG8_BAR;
        PG8_WAIT_V(4); PG8_BAR;
        PG8_STAGE(PG8_SB(1, 0), cB + kstep, voffB); PG8_STAGE(PG8_SA(1, 0), cA + kstep, voffA); PG8_STAGE(PG8_SB(1, 1), cB + hstepB + kstep, voffB);
        PG8_WAIT_V(6); PG8_BAR;
    }
    for (;;) {
        const bool has_next = S.next(ui + 1, nxt);
        const char* nA = has_next ? (const char*)g.A + (size_t)nxt.pm * tstepA : cA; const char* nB = has_next ? (const char*)g.Bt + (size_t)nxt.pn * tstepB : cB;
        for (int t = 0; t < nt; t += 2) {
            const bool last = (t == nt - 2);
            const char* a1 = cA + (size_t)(t + 1) * kstep;
            const char* a2 = last ? nA : cA + (size_t)(t + 2) * kstep; const char* b2 = last ? nB : cB + (size_t)(t + 2) * kstep;
            const char* a3 = a2 + kstep; const char* b3 = b2 + kstep;
            if (last && has_next) S.a_ready(nxt);
            if constexpr (SP2) {
            PG8_LDB(B0, 0, 0); PG8_LDB(B1, 0, 1); PG8_SCHED; PG8_LDA(At, 0, 0); PG8_STAGE(PG8_SA(1, 1), a1 + hstepA, voffA);
            PG8_WAIT_V(8); PG8_WAIT_L(0); PG8_BAR; PG8_MMA(0, 0, At, B0); PG8_MMA(0, 1, At, B1); PG8_BAR; PG8_SCHED;
            PG8_LDA(At, 0, 1); PG8_STAGE(PG8_SB(0, 0), b2, voffB); PG8_STAGE(PG8_SB(0, 1), b2 + hstepB, voffB); PG8_STAGE(PG8_SA(0, 0), a2, voffA);
            PG8_WAIT_V(8); PG8_WAIT_L(0); PG8_BAR; PG8_MMA(1, 0, At, B0); PG8_MMA(1, 1, At, B1); PG8_BAR; PG8_SCHED;
            PG8_LDB(B0, 1, 0); PG8_LDB(B1, 1, 1); PG8_SCHED; PG8_LDA(At, 1, 0); PG8_STAGE(PG8_SA(0, 1), a2 + hstepA, voffA);
            PG8_WAIT_V(8); PG8_WAIT_L(0); PG8_BAR; PG8_MMA(0, 0, At, B0); PG8_MMA(0, 1, At, B1); PG8_BAR; PG8_SCHED;
            PG8_LDA(At, 1, 1); PG8_STAGE(PG8_SB(1, 0), b3, voffB); PG8_STAGE(PG8_SB(1, 1), b3 + hstepB, voffB); PG8_STAGE(PG8_SA(1, 0), a3, voffA);
            PG8_WAIT_V(8); PG8_WAIT_L(0); PG8_BAR; PG8_MMA(1, 0, At, B0); PG8_MMA(1, 1, At, B1); PG8_BAR; PG8_SCHED;
            } else {
            PG8_LDB(B0, 0, 0); PG8_SCHED; PG8_LDA(At, 0, 0); PG8_STAGE(PG8_SA(1, 1), a1 + hstepA, voffA);
            PG8_WAIT_L(8); PG8_BAR; PG8_WAIT_L(0); PG8_MMA(0, 0, At, B0); PG8_BAR; PG8_SCHED;
            PG8_LDB(B1, 0, 1); PG8_STAGE(PG8_SB(0, 0), b2, voffB);
            PG8_BAR; PG8_WAIT_L(0); PG8_MMA(0, 1, At, B1); PG8_BAR;
            PG8_LDA(At, 0, 1); PG8_STAGE(PG8_SA(0, 0), a2, voffA);
            PG8_BAR; PG8_WAIT_L(0); PG8_MMA(1, 0, At, B0); PG8_BAR; PG8_SCHED;
            PG8_STAGE(PG8_SB(0, 1), b2 + hstepB, voffB);
            PG8_WAIT_V(6); PG8_BAR; PG8_MMA(1, 1, At, B1); PG8_BAR;
            PG8_LDB(B0, 1, 0); PG8_SCHED; PG8_LDA(At, 1, 0); PG8_STAGE(PG8_SA(0, 1), a2 + hstepA, voffA);
            PG8_WAIT_L(8); PG8_BAR; PG8_WAIT_L(0); PG8_MMA(0, 0, At, B0); PG8_BAR; PG8_SCHED;
            PG8_LDB(B1, 1, 1); PG8_STAGE(PG8_SB(1, 0), b3, voffB);
            PG8_BAR; PG8_WAIT_L(0); PG8_MMA(0, 1, At, B1); PG8_BAR;
            PG8_LDA(At, 1, 1); PG8_STAGE(PG8_SA(1, 0), a3, voffA);
            PG8_BAR; PG8_WAIT_L(0); PG8_MMA(1, 0, At, B0); PG8_BAR; PG8_SCHED;
            PG8_STAGE(PG8_SB(1, 1), b3 + hstepB, voffB);
            PG8_WAIT_V(6); PG8_BAR; PG8_MMA(1, 1, At, B1); PG8_BAR;
            }
        }
        if constexpr (ALIGN_EPI) { if (wr == 0) PG8_BAR; }
        if constexpr (!Epi::AFTER_DRAIN) { E(acc, cur, wr, wc, fr, fq); S.done(cur); }
        if (!has_next) break;
#pragma unroll
        for (int a = 0; a < 2; ++a)
#pragma unroll
            for (int b = 0; b < 2; ++b)
#pragma unroll
                for (int m = 0; m < 4; ++m)
#pragma unroll
                    for (int n = 0; n < 2; ++n) acc[a][b][m][n] = (f32x4){0.f, 0.f, 0.f, 0.f};
        cur = nxt; cA = nA; cB = nB; ++ui;
        if constexpr (ALIGN_EPI) { if (wr == 1) PG8_BAR; }
    }
    PG8_WAIT_V(0);
    if constexpr (!ALIGN_EPI) { if (wr == 0) PG8_BAR; }
    PG8_BAR;
    if constexpr (Epi::AFTER_DRAIN) { E.fused(acc, cur, wr, wc, fr, fq, lds, wid, lane); S.done(cur); }
#undef PG8_SA
#undef PG8_SB
#undef PG8_STAGE
#undef PG8_LDA
#undef PG8_LDB
#undef PG8_MMA
#undef PG8_WAIT_V
#undef PG8_WAIT_L
#undef PG8_BAR
#undef PG8_SCHED
}
}

#define KV_DECL uint4 rk0, rk1, rk2, rk3, rv0, rv1, rv2, rv3
#define KV_LOAD(kb_, dil_) do { const int kk_ = lane >> 3; \
    const bf16_t* p0_ = qkv + (rowb + min(max((kb_) + (dil_) * kk_, 0), S - 1)) * ld + (lane & 7) * 8; \
    const bf16_t* p1_ = qkv + (rowb + min(max((kb_) + (dil_) * (kk_ + 8), 0), S - 1)) * ld + (lane & 7) * 8; \
    const bf16_t* p2_ = qkv + (rowb + min(max((kb_) + (dil_) * (kk_ + 16), 0), S - 1)) * ld + (lane & 7) * 8; \
    const bf16_t* p3_ = qkv + (rowb + min(max((kb_) + (dil_) * (kk_ + 24), 0), S - 1)) * ld + (lane & 7) * 8; \
    rk0 = *(const uint4*)(p0_ + kcol); rk1 = *(const uint4*)(p1_ + kcol); rk2 = *(const uint4*)(p2_ + kcol); rk3 = *(const uint4*)(p3_ + kcol); \
    rv0 = *(const uint4*)(p0_ + vcol); rv1 = *(const uint4*)(p1_ + vcol); rv2 = *(const uint4*)(p2_ + vcol); rv3 = *(const uint4*)(p3_ + vcol); } while (0)
#define KV_STORE() do { char* wp_ = vl + (lane >> 3) * 144 + (lane & 7) * 16; \
    *(uint4*)(wp_) = rk0; *(uint4*)(wp_ + 8 * 144) = rk1; *(uint4*)(wp_ + 16 * 144) = rk2; *(uint4*)(wp_ + 24 * 144) = rk3; \
    *(uint4*)(wp_ + 4608) = rv0; *(uint4*)(wp_ + 4608 + 8 * 144) = rv1; *(uint4*)(wp_ + 4608 + 16 * 144) = rv2; *(uint4*)(wp_ + 4608 + 24 * 144) = rv3; } while (0)

DI bf16x8 v_frag(const char* vbase, int s, int dt) {
    typedef __attribute__((address_space(3))) v4i16_t* lp_t;
    const char* a = vbase + s * (16 * 144) + dt * 64;
    const s16x4 lo = __builtin_bit_cast(s16x4, __builtin_amdgcn_ds_read_tr16_b64_v4i16((lp_t)(a)));
    const s16x4 hi = __builtin_bit_cast(s16x4, __builtin_amdgcn_ds_read_tr16_b64_v4i16((lp_t)(a + 8 * 144)));
    return __builtin_shufflevector(lo, hi, 0, 1, 2, 3, 4, 5, 6, 7);
}

template <int OFF> DI bf16x8 pack8v(const f32x16& p) {
    typedef unsigned u32x4 __attribute__((ext_vector_type(4)));
    u32x4 w; w[0] = pk2(p[OFF + 0], p[OFF + 1]); w[1] = pk2(p[OFF + 2], p[OFF + 3]); w[2] = pk2(p[OFF + 4], p[OFF + 5]); w[3] = pk2(p[OFF + 6], p[OFF + 7]);
    return __builtin_bit_cast(bf16x8, w);
}

DI void win_attn_wave(bf16_t* qkv, int ld, int b, int qcol, int kcol, int vcol, int tq0, int qstride,
                      float slope2, float m_init, float l_init, int mode, char* vl, int lane, bool dry) {
    const int r = lane & 31, h = lane >> 5;
    const size_t rowb = (size_t)b * S;
    const int tq = tq0 + qstride * r;
    const int tqlast = tq0 + qstride * 31;
    bf16x8 qf[4];
    {
        const bf16_t* qp = qkv + (rowb + tq) * ld + qcol + h * 32;
#pragma unroll
        for (int ks = 0; ks < 4; ++ks) qf[ks] = *(const bf16x8*)(qp + ks * 8);
    }
    f32x16 o0, o1;
#pragma unroll
    for (int i = 0; i < 16; ++i) { o0[i] = 0.f; o1[i] = 0.f; }
    float m = m_init, l = (h == 0) ? l_init : 0.f;
    const float sc2 = 0.125f * LOG2E;
    const int i16 = lane & 15;
    const char* vbase = vl + 4608 + (4 * h + (i16 >> 2)) * 144 + (16 * ((lane >> 4) & 1) + 4 * (i16 & 3)) * 2;
    const int npat = mode ? 3 : 1;
    const char* kfp = vl + r * 144 + h * 64;
    KV_DECL;
    for (int pi = 0; pi < npat; ++pi) {
        int dil, W, kfirst, nt;
        if (!mode) { dil = 1; W = 127; kfirst = tq0 - 128; nt = 5; }
        else if (pi == 0) { dil = 1; W = 128; kfirst = tq0 - 128; nt = 20; }
        else if (pi == 1) { dil = 4; W = 512; kfirst = tq0 - 512; nt = 8; }
        else { dil = 16; W = 2048; kfirst = tq0 - 2048; nt = 5; }
        const int step = 32 * dil;
        int t0 = 0;
        { const int need = -kfirst - 31 * dil; if (need > 0) t0 = (need + step - 1) / step; }
        if (t0 >= nt) continue;
        KV_LOAD(kfirst + t0 * step, dil);
        for (int tile = t0; tile < nt; ++tile) {
            const int kb = kfirst + tile * step;
            KV_STORE();
            asm volatile("" ::: "memory");
            if (tile + 1 < nt) KV_LOAD(kb + step, dil);
            f32x16 s;
#pragma unroll
            for (int i = 0; i < 16; ++i) s[i] = 0.f;
#pragma unroll
            for (int ks = 0; ks < 4; ++ks) s = MFMA(*(const bf16x8*)(kfp + ks * 16), qf[ks], s);
            f32x16 sv; float mloc = -INFINITY;
            const int d0 = tq - kb - 4 * h * dil;
            const unsigned wlim = (unsigned)min(W, tq);
#pragma unroll
            for (int i = 0; i < 16; ++i) {
                const int diff = d0 - dil * crow(i, 0);
                const float sb = s[i] * sc2 - slope2 * (float)diff;
                sv[i] = ((unsigned)diff <= wlim) ? sb : -INFINITY;
                mloc = fmaxf(mloc, sv[i]);
            }
            mloc = fmaxf(mloc, __shfl_xor(mloc, 32));
            const float mn = fmaxf(m, mloc);
            float ps = 0.f;
#pragma unroll
            for (int i = 0; i < 16; ++i) { sv[i] = fexp2(sv[i] - mn); ps += sv[i]; }
            if (__builtin_amdgcn_ballot_w64(mn != m) != 0) {
                const float alpha = fexp2(m - mn);
                l *= alpha;
#pragma unroll
                for (int i = 0; i < 16; ++i) { o0[i] *= alpha; o1[i] *= alpha; }
                m = mn;
            }
            l += ps;
            const bf16x8 p0 = pack8v<0>(sv), p1 = pack8v<8>(sv);
            o0 = MFMA(v_frag(vbase, 0, 0), p0, o0);
            o0 = MFMA(v_frag(vbase, 1, 0), p1, o0);
            o1 = MFMA(v_frag(vbase, 0, 1), p0, o1);
            o1 = MFMA(v_frag(vbase, 1, 1), p1, o1);
            asm volatile("" ::: "memory");
        }
    }
    const float lt = l + __shfl_xor(l, 32);
    const float inv = 1.f / lt;
    if (dry) { if (o0[0] + o1[0] + lt == 12345.678f) qkv[0] = 1; return; }
    bf16_t* op = qkv + (rowb + tq) * ld + qcol + 4 * h;
#pragma unroll
    for (int g = 0; g < 4; ++g) {
        *(uint2*)(op + 8 * g) = make_uint2(pk2(o0[4 * g] * inv, o0[4 * g + 1] * inv), pk2(o0[4 * g + 2] * inv, o0[4 * g + 3] * inv));
        *(uint2*)(op + 32 + 8 * g) = make_uint2(pk2(o1[4 * g] * inv, o1[4 * g + 1] * inv), pk2(o1[4 * g + 2] * inv, o1[4 * g + 3] * inv));
    }
}

DI void stick_wave(bf16_t* qkv, int ld, int b, int qcol, int kcol, int vcol, int qt, char* vl, int lane, bool dry) {
    const int r = lane & 31, h = lane >> 5;
    const size_t rowb = (size_t)b * S;
    const int tq = qt * 32 + r;
    bf16x8 qf[4];
    {
        const bf16_t* qp = qkv + (rowb + tq) * ld + qcol + h * 32;
#pragma unroll
        for (int ks = 0; ks < 4; ++ks) qf[ks] = *(const bf16x8*)(qp + ks * 8);
    }
    f32x16 o0, o1;
#pragma unroll
    for (int i = 0; i < 16; ++i) { o0[i] = 0.f; o1[i] = 0.f; }
    float R = 1.f;
    const int i16 = lane & 15;
    const char* vbase = vl + 4608 + (4 * h + (i16 >> 2)) * 144 + (16 * ((lane >> 4) & 1) + 4 * (i16 & 3)) * 2;
    const char* kfp = vl + r * 144 + h * 64;
    KV_DECL;
    KV_LOAD(qt * 32, 1);
    for (int tile = qt; tile >= 0; --tile) {
        KV_STORE();
        asm volatile("" ::: "memory");
        if (tile > 0) KV_LOAD((tile - 1) * 32, 1);
        f32x16 s;
#pragma unroll
        for (int i = 0; i < 16; ++i) s[i] = 0.f;
#pragma unroll
        for (int ks = 0; ks < 4; ++ks) s = MFMA(*(const bf16x8*)(kfp + ks * 16), qf[ks], s);
        const bool diag = (tile == qt);
        f32x16 sg, kp;
#pragma unroll
        for (int i = 0; i < 16; ++i) {
            const float z2 = fminf(s[i] * (0.125f * LOG2E), 80.f);
            const float t = fexp2(z2);
            const float k = __builtin_amdgcn_rcpf(1.f + t);
            kp[i] = k; sg[i] = t * k;
        }
        if (diag) {
#pragma unroll
            for (int i = 0; i < 16; ++i) { const bool strict = crow(i, h) < r; kp[i] = strict ? kp[i] : 1.f; sg[i] = strict ? sg[i] : 0.f; }
        }
        float G[4], PG[4], both[4];
#pragma unroll
        for (int g = 0; g < 4; ++g) { G[g] = (kp[4 * g] * kp[4 * g + 1]) * (kp[4 * g + 2] * kp[4 * g + 3]); PG[g] = __shfl_xor(G[g], 32); both[g] = G[g] * PG[g]; }
        float Sx[4];
        Sx[3] = 1.f; Sx[2] = both[3]; Sx[1] = both[3] * both[2]; Sx[0] = Sx[1] * both[1];
        f32x16 a;
#pragma unroll
        for (int g = 0; g < 4; ++g) {
            float la = R * Sx[g] * (h == 0 ? PG[g] : 1.f);
#pragma unroll
            for (int j = 3; j >= 0; --j) {
                a[4 * g + j] = sg[4 * g + j] * la;
                la *= kp[4 * g + j];
            }
        }
        R *= Sx[0] * both[0];
        const bf16x8 p0 = pack8v<0>(a), p1 = pack8v<8>(a);
        o0 = MFMA(v_frag(vbase, 0, 0), p0, o0);
        o0 = MFMA(v_frag(vbase, 1, 0), p1, o0);
        o1 = MFMA(v_frag(vbase, 0, 1), p0, o1);
        o1 = MFMA(v_frag(vbase, 1, 1), p1, o1);
        asm volatile("" ::: "memory");
        if (__builtin_amdgcn_ballot_w64(R >= 1.17549435e-38f) == 0) break;
    }
    if (dry) { if (o0[0] + o1[0] == 12345.678f) qkv[0] = 1; return; }
    bf16_t* op = qkv + (rowb + tq) * ld + qcol + 4 * h;
#pragma unroll
    for (int g = 0; g < 4; ++g) {
        *(uint2*)(op + 8 * g) = make_uint2(pk2(o0[4 * g], o0[4 * g + 1]), pk2(o0[4 * g + 2], o0[4 * g + 3]));
        *(uint2*)(op + 32 + 8 * g) = make_uint2(pk2(o1[4 * g], o1[4 * g + 1]), pk2(o1[4 * g + 2], o1[4 * g + 3]));
    }
}

DI void attn_even_phase(const Params& P, char* smem, bool dry) {
    const int tid_ = otid(); const int lane = tid_ & 63, wid = tid_ >> 6;
    bf16_t* qkv = (bf16_t*)(P.ws + OFF_BIG);
    char* vl = smem + wid * 9216;
    for (int it = blockIdx.x * 8 + wid; it < 2048 + 4096; it += gridDim.x * 8) {
        if (it < 2048) {
            const int bh = it >> 6, p = it & 63; const int b = bh >> 3, head = bh & 7;
            stick_wave(qkv, 2304, b, 512 + head * 64, 1280 + head * 64, 1792 + head * 64, 127 - p, vl, lane, dry);
            stick_wave(qkv, 2304, b, 512 + head * 64, 1280 + head * 64, 1792 + head * 64, p, vl, lane, dry);
        } else {
            const int v = it - 2048; const int g = v & 3; const int qt = (v >> 2) & 127; const int rest = v >> 9; const int b = rest >> 1, kvh = rest & 1;
            const int head = kvh * 4 + g;
            const float slope = exp2f(-(float)(head + 1));
            const float sink = P.in[9][head];
            win_attn_wave(qkv, 2304, b, head * 64, 1024 + kvh * 64, 1152 + kvh * 64, qt * 32, 1, slope * LOG2E, sink * LOG2E, 1.f, 0, vl, lane, dry);
        }
    }
}

DI void attn_odd_phase(const Params& P, char* smem, bool dry) {
    const int tid_ = otid(); const int lane = tid_ & 63, wid = tid_ >> 6;
    bf16_t* qkv = (bf16_t*)(P.ws + OFF_BIG);
    char* vl = smem + wid * 9216;
    for (int it = blockIdx.x * 8 + wid; it < 8192; it += gridDim.x * 8) {
        const int res16 = it & 15; const int u0 = ((it >> 4) & 7) * 32; const int head = (it >> 7) & 15; const int b = it >> 11;
        const float slope = exp2f(-0.5f * (float)(head + 1));
        win_attn_wave(qkv, 3072, b, head * 64, 1024 + head * 64, 2048 + head * 64, res16 + 16 * u0, 16, slope * LOG2E, -1e30f, 0.f, 1, vl, lane, dry);
    }
}

DI void xattn_wave(bf16_t* qb, const bf16_t* Kn, const bf16_t* VT, const float* qg, float kmax2, int b, int head, int tok0, char* ql, int lane, bool dry) {
    const int r = lane & 31, h = lane >> 5;
    const size_t token = (size_t)b * S + tok0 + r;
    bf16_t* qp = qb + token * D + head * 256 + h * 128;
    float ss = 0.f;
#pragma unroll
    for (int ks = 0; ks < 16; ++ks) {
        const uint4 v = *(const uint4*)(qp + ks * 8);
        const unsigned w[4] = {v.x, v.y, v.z, v.w};
#pragma unroll
        for (int e = 0; e < 4; ++e) { const float a = bflo(w[e]), c = bfhi(w[e]); ss += a * a + c * c; }
    }
    ss += __shfl_xor(ss, 32);
    const float inv = __builtin_amdgcn_rsqf(ss * (1.f / 256.f) + EPS);
    float qq2 = 0.f;
#pragma unroll
    for (int ks = 0; ks < 16; ++ks) {
        const uint4 v = *(const uint4*)(qp + ks * 8);
        const float4 g0 = *(const float4*)(qg + h * 128 + ks * 8), g1 = *(const float4*)(qg + h * 128 + ks * 8 + 4);
        uint4 o;
        o.x = pk2(bflo(v.x) * inv * g0.x, bfhi(v.x) * inv * g0.y); o.y = pk2(bflo(v.y) * inv * g0.z, bfhi(v.y) * inv * g0.w);
        o.z = pk2(bflo(v.z) * inv * g1.x, bfhi(v.z) * inv * g1.y); o.w = pk2(bflo(v.w) * inv * g1.z, bfhi(v.w) * inv * g1.w);
        qq2 += bflo(o.x) * bflo(o.x) + bfhi(o.x) * bfhi(o.x) + bflo(o.y) * bflo(o.y) + bfhi(o.y) * bfhi(o.y)
             + bflo(o.z) * bflo(o.z) + bfhi(o.z) * bfhi(o.z) + bflo(o.w) * bflo(o.w) + bfhi(o.w) * bfhi(o.w);
        *(uint4*)(ql + (ks * 64 + lane) * 16) = o;
    }
    qq2 += __shfl_xor(qq2, 32);
    asm volatile("" ::: "memory");
    const float sc2 = 0.0625f * LOG2E;
    const bf16_t* kp0 = Kn + ((size_t)(b * 4 + head) * 8 * 16 * 64 + lane) * 8;
    const float m = __builtin_amdgcn_sqrtf(qq2 * kmax2) * 1.001f;
    float l = 0.f;
    bf16x8 pf[8][2];
    bf16x8 kc[16], kn[16];
#pragma unroll
    for (int ks = 0; ks < 16; ++ks) kc[ks] = *(const bf16x8*)(kp0 + ks * 512);
#pragma unroll
    for (int tile = 0; tile < 8; ++tile) {
        if (tile < 7) {
#pragma unroll
            for (int ks = 0; ks < 16; ++ks) kn[ks] = *(const bf16x8*)(kp0 + (size_t)(tile + 1) * 16 * 512 + ks * 512);
        }
        f32x16 s, s_b;
#pragma unroll
        for (int i = 0; i < 16; ++i) { s[i] = 0.f; s_b[i] = 0.f; }
#pragma unroll
        for (int ks = 0; ks < 16; ks += 2) {
            const bf16x8 qf0 = *(const bf16x8*)(ql + (ks * 64 + lane) * 16);
            const bf16x8 qf1 = *(const bf16x8*)(ql + ((ks + 1) * 64 + lane) * 16);
            s = MFMA(kc[ks], qf0, s);
            s_b = MFMA(kc[ks + 1], qf1, s_b);
        }
#pragma unroll
        for (int i = 0; i < 16; ++i) s[i] += s_b[i];
#pragma unroll
        for (int i = 0; i < 16; ++i) { s[i] = fexp2((s[i] - m) * sc2); l += s[i]; }
        pf[tile][0] = pack8v<0>(s); pf[tile][1] = pack8v<8>(s);
#pragma unroll
        for (int ks = 0; ks < 16; ++ks) kc[ks] = kn[ks];
    }
    l += __shfl_xor(l, 32);
    const float il = 1.f / l;
    bf16_t* op = qb + token * D + head * 256 + 4 * h;
    const bf16_t* vp0 = VT + (((size_t)(b * 4 + head) * 8 * 8 * 2 * 64) + lane) * 8;
    bf16x8 vc[16], vn[16];
#pragma unroll
    for (int e = 0; e < 16; ++e) vc[e] = *(const bf16x8*)(vp0 + e * 512);
#pragma unroll 1
    for (int dt = 0; dt < 8; ++dt) {
        const int dn = dt < 7 ? dt + 1 : 7;
#pragma unroll
        for (int e = 0; e < 16; ++e) vn[e] = *(const bf16x8*)(vp0 + (size_t)dn * 16 * 512 + e * 512);
        f32x16 o, o_b;
#pragma unroll
        for (int i = 0; i < 16; ++i) { o[i] = 0.f; o_b[i] = 0.f; }
#pragma unroll
        for (int tile = 0; tile < 8; ++tile) { o = MFMA(vc[tile * 2], pf[tile][0], o); o_b = MFMA(vc[tile * 2 + 1], pf[tile][1], o_b); }
#pragma unroll
        for (int i = 0; i < 16; ++i) o[i] += o_b[i];
#pragma unroll
        for (int g = 0; g < 4; ++g)
            if (dry) { if (o[4 * g] == 12345.678f) qb[0] = 1; } else *(uint2*)(op + dt * 32 + 8 * g) = make_uint2(pk2(o[4 * g] * il, o[4 * g + 1] * il), pk2(o[4 * g + 2] * il, o[4 * g + 3] * il));
#pragma unroll
        for (int e = 0; e < 16; ++e) vc[e] = vn[e];
    }
}

DI void xattn_block(bf16_t* qb, const bf16_t* KF, const bf16_t* VF, const float* qg, float kmax2, int b, int head, int qblk, char* smem, int lane, int wid) {
    const int r = lane & 31, h = lane >> 5;
    const size_t token = (size_t)b * S + qblk * 256 + wid * 32 + r;
    bf16_t* qp = qb + token * D + head * 256 + h * 128;
    const bf16_t* kbase = KF + (size_t)(b * 4 + head) * 8 * 8192;
    const bf16_t* vbase = VF + (size_t)(b * 4 + head) * 8 * 8192;
    const int pc0 = (2 * wid) * 512 + lane * 8, pc1 = pc0 + 512;
    char* ld0 = smem + (2 * wid) * 1024 + lane * 16;
#define XA_ISSUE(u_) do { const int u__ = (u_); const bf16_t* src_ = (u__ < 8) ? kbase + (size_t)u__ * 8192 : vbase + (size_t)(u__ - 8) * 8192; \
        char* dst_ = ld0 + (u__ & 3) * 16384; glds16(src_ + pc0, dst_); glds16(src_ + pc1, dst_ + 1024); } while (0)
    __syncthreads();
    XA_ISSUE(0); XA_ISSUE(1); XA_ISSUE(2);
    uint4 qraw[16];
    float ss = 0.f;
#pragma unroll
    for (int ks = 0; ks < 16; ++ks) {
        qraw[ks] = *(const uint4*)(qp + ks * 8);
        const uint4 v = qraw[ks];
        ss += bflo(v.x) * bflo(v.x) + bfhi(v.x) * bfhi(v.x) + bflo(v.y) * bflo(v.y) + bfhi(v.y) * bfhi(v.y)
            + bflo(v.z) * bflo(v.z) + bfhi(v.z) * bfhi(v.z) + bflo(v.w) * bflo(v.w) + bfhi(v.w) * bfhi(v.w);
    }
    ss += __shfl_xor(ss, 32);
    const float inv = __builtin_amdgcn_rsqf(ss * (1.f / 256.f) + EPS);
    float qq2 = 0.f;
    bf16x8 qf[16];
#pragma unroll
    for (int ks = 0; ks < 16; ++ks) {
        const uint4 v = qraw[ks];
        const float4 g0 = *(const float4*)(qg + h * 128 + ks * 8), g1 = *(const float4*)(qg + h * 128 + ks * 8 + 4);
        uint4 o;
        o.x = pk2(bflo(v.x) * inv * g0.x, bfhi(v.x) * inv * g0.y); o.y = pk2(bflo(v.y) * inv * g0.z, bfhi(v.y) * inv * g0.w);
        o.z = pk2(bflo(v.z) * inv * g1.x, bfhi(v.z) * inv * g1.y); o.w = pk2(bflo(v.w) * inv * g1.z, bfhi(v.w) * inv * g1.w);
        qq2 += bflo(o.x) * bflo(o.x) + bfhi(o.x) * bfhi(o.x) + bflo(o.y) * bflo(o.y) + bfhi(o.y) * bfhi(o.y)
             + bflo(o.z) * bflo(o.z) + bfhi(o.z) * bfhi(o.z) + bflo(o.w) * bflo(o.w) + bfhi(o.w) * bfhi(o.w);
        qf[ks] = __builtin_bit_cast(bf16x8, o);
    }
    qq2 += __shfl_xor(qq2, 32);
    const float sc2 = 0.0625f * LOG2E;
    const float m = __builtin_amdgcn_sqrtf(qq2 * kmax2) * 1.001f;
    float l = 0.f;
    bf16x8 pf[8][2];
    const char* fr0 = smem + lane * 16;
#pragma unroll
    for (int u = 0; u < 8; ++u) {
        asm volatile("s_waitcnt vmcnt(4)" ::: "memory");
        __builtin_amdgcn_s_barrier();
        XA_ISSUE(u + 3);
        const char* sl = fr0 + (u & 3) * 16384;
        f32x16 s, s_b;
#pragma unroll
        for (int i = 0; i < 16; ++i) { s[i] = 0.f; s_b[i] = 0.f; }
#pragma unroll
        for (int ks = 0; ks < 16; ks += 2) {
            s = MFMA(*(const bf16x8*)(sl + ks * 1024), qf[ks], s);
            s_b = MFMA(*(const bf16x8*)(sl + (ks + 1) * 1024), qf[ks + 1], s_b);
        }
#pragma unroll
        for (int i = 0; i < 16; ++i) { s[i] = fexp2((s[i] + s_b[i] - m) * sc2); l += s[i]; }
        pf[u][0] = pack8v<0>(s); pf[u][1] = pack8v<8>(s);
    }
    l += __shfl_xor(l, 32);
    const float il = 1.f / l;
    bf16_t* op = qb + token * D + head * 256 + 4 * h;
#pragma unroll 1
    for (int dt = 0; dt < 8; ++dt) {
        if (dt < 6) asm volatile("s_waitcnt vmcnt(4)" ::: "memory");
        else if (dt == 6) asm volatile("s_waitcnt vmcnt(2)" ::: "memory");
        else asm volatile("s_waitcnt vmcnt(0)" ::: "memory");
        __builtin_amdgcn_s_barrier();
        if (dt < 5) XA_ISSUE(dt + 11);
        const char* sl = fr0 + (dt & 3) * 16384;
        f32x16 o, o_b;
#pragma unroll
        for (int i = 0; i < 16; ++i) { o[i] = 0.f; o_b[i] = 0.f; }
#pragma unroll
        for (int tile = 0; tile < 8; ++tile) {
            o = MFMA(*(const bf16x8*)(sl + (tile * 2) * 1024), pf[tile][0], o);
            o_b = MFMA(*(const bf16x8*)(sl + (tile * 2 + 1) * 1024), pf[tile][1], o_b);
        }
#pragma unroll
        for (int g = 0; g < 4; ++g)
            *(uint2*)(op + dt * 32 + 8 * g) = make_uint2(pk2((o[4 * g] + o_b[4 * g]) * il, (o[4 * g + 1] + o_b[4 * g + 1]) * il),
                                                        pk2((o[4 * g + 2] + o_b[4 * g + 2]) * il, (o[4 * g + 3] + o_b[4 * g + 3]) * il));
    }
#undef XA_ISSUE
}

DI void xattn_phase(const Params& P, int l, char* smem, bool dry) {
    const int tid_ = otid(); const int lane = tid_ & 63, wid = tid_ >> 6;
    bf16_t* qb = (bf16_t*)(P.ws + OFF_BIG);
    const bf16_t* KF = (const bf16_t*)(P.ws + OFF_KF + (size_t)l * SZ_MM);
    const bf16_t* VF = (const bf16_t*)(P.ws + OFF_VT + (size_t)l * SZ_MM);
    const float* qg = P.in[19] + l * 256;
    (void)dry;
    for (int it = blockIdx.x; it < 256; it += gridDim.x) {
        const int qblk = it & 15, head = (it >> 4) & 3, b = it >> 6;
        const float kmax2 = ((const float*)(P.ws + OFF_KMAX))[l * 16 + b * 4 + head];
        xattn_block(qb, KF, VF, qg, kmax2, b, head, qblk, smem, lane, wid);
    }
}

DI void knorm_phase(const Params& P) {
    const int tid_ = otid(); const int lane = tid_ & 63, wid = tid_ >> 6;
    for (int u = blockIdx.x * 8 + wid; u < 8192; u += gridDim.x * 8) {
        const int l = u >> 12, row = (u >> 2) & 1023, head = u & 3;
        const bf16_t* kp = (const bf16_t*)(P.ws + OFF_KN + (size_t)l * SZ_MM) + (size_t)row * D + head * 256 + lane * 4;
        const uint2 v = *(const uint2*)kp;
        const float a0 = bflo(v.x), a1 = bfhi(v.x), a2 = bflo(v.y), a3 = bfhi(v.y);
        float ss = a0 * a0 + a1 * a1 + a2 * a2 + a3 * a3;
        ss = wave_sum(ss);
        const float inv = __builtin_amdgcn_rsqf(ss * (1.f / 256.f) + EPS);
        const float4 g = *(const float4*)(P.in[20] + l * 256 + lane * 4);
        const int b = row >> 8, key = row & 255;
        const int h = lane >> 5, ks = (lane & 31) >> 1, j0 = (lane & 1) * 4;
        bf16_t* dp = (bf16_t*)(P.ws + OFF_KF + (size_t)l * SZ_MM) + ((((((size_t)(b * 4 + head) * 8 + (key >> 5)) * 16 + ks) * 64) + h * 32 + (key & 31)) << 3) + j0;
        const unsigned w0_ = pk2(a0 * inv * g.x, a1 * inv * g.y), w1_ = pk2(a2 * inv * g.z, a3 * inv * g.w);
        *(uint2*)dp = make_uint2(w0_, w1_);
        float kk2 = bflo(w0_) * bflo(w0_) + bfhi(w0_) * bfhi(w0_) + bflo(w1_) * bflo(w1_) + bfhi(w1_) * bfhi(w1_);
        kk2 = wave_sum(kk2);
        if (lane == 0) atomicMax((unsigned*)(P.ws + OFF_KMAX) + l * 16 + b * 4 + head, __float_as_uint(kk2));
    }
}

DI void fast_grid_sync(unsigned* bar, unsigned target) {
    asm volatile("s_waitcnt vmcnt(0) lgkmcnt(0)" ::: "memory");
    __syncthreads();
    if (threadIdx.x == 0) {
        __builtin_amdgcn_fence(__ATOMIC_RELEASE, "agent");
        asm volatile("s_waitcnt vmcnt(0)" ::: "memory");
        __hip_atomic_fetch_add(bar, 1u, __ATOMIC_RELAXED, __HIP_MEMORY_SCOPE_AGENT);
        while (__hip_atomic_load(bar, __ATOMIC_RELAXED, __HIP_MEMORY_SCOPE_AGENT) < target) __builtin_amdgcn_s_sleep(2);
        __builtin_amdgcn_fence(__ATOMIC_ACQUIRE, "agent");
        asm volatile("s_waitcnt vmcnt(0)" ::: "memory");
    }
    __syncthreads();
}

__global__ void __launch_bounds__(512) fwd_megakernel(Params P) {
    extern __shared__ __attribute__((aligned(16))) char smem[];
    cg::grid_group grid = cg::this_grid();
    unsigned nbar = 0;
#pragma unroll 1
    for (int ph = 0; ph < 21; ++ph) {
        float* ssq = (float*)(P.ws + OFF_SSQ);
        bf16_t* xb = (bf16_t*)(P.ws + OFF_XB);
        bf16_t* big = (bf16_t*)(P.ws + OFF_BIG);
        int nrep = 1;
        if (ph > 0) { const int s_ = (ph - 1) % 10; const int kind = (s_ == 3) ? 2 : (s_ == 6) ? 4 : 1; if (PROBE_MASK & kind) nrep = 2; }
        for (int rep = 0; rep < nrep; ++rep) {
        const bool dry = rep + 1 < nrep;
        if (ph == 0) {
            phase0(P, smem);
        } else {
            const int l = (ph - 1) / 10, s = (ph - 1) % 10;
            if (s == 3) {
                if (l == 0) attn_even_phase(P, smem, dry); else attn_odd_phase(P, smem, dry);
            } else if (s == 6) {
                xattn_phase(P, l, smem, dry);
            } else {
                pg8::Gemm g; pg8::Epi E;
                g.A = xb; g.lda = D; g.K = D; g.M = T; g.N = D; g.Bt = nullptr;
                E.mode = 1; E.rs = nullptr; E.O = big; E.ldo = D; E.xin = nullptr; E.xout = nullptr; E.xb = xb; E.ssq_out = ssq; E.alpha = 1.f;
                E.qg = nullptr; E.kg = nullptr; E.qn_end = 0; E.kn_beg = 0; E.kn_end = 0;
                if (s == 0 || s == 8) {
                    g.Bt = (const bf16_t*)(P.ws + (s == 0 ? OFF_GU1 : OFF_GU2) + (size_t)l * SZ_GU); g.N = NGU;
                    E.mode = 0; E.rs = ssq + (size_t)(4 * l + (s == 0 ? 0 : 3)) * T; E.ldo = DFF;
                } else if (s == 1 || s == 9) {
                    g.A = big; g.lda = DFF; g.K = DFF;
                    g.Bt = (const bf16_t*)(P.ws + (s == 1 ? OFF_DN1 : OFF_DN2) + (size_t)l * SZ_DN);
                    E.alpha = 0.5f; E.ssq_out = ssq + (size_t)(4 * l + (s == 1 ? 1 : 4)) * T;
                    if (ph == 2) E.xin = P.in[0];
                    if (ph == 20) { E.xout = P.out; E.ssq_out = nullptr; }
                } else if (s == 2) {
                    E.mode = 2; E.rs = ssq + (size_t)(4 * l + 1) * T;
                    if (l == 0) { g.Bt = (const bf16_t*)(P.ws + OFF_EVIN); g.N = 2304; E.ldo = 2304; E.qg = P.in[7]; E.kg = P.in[8]; E.qn_end = 512; E.kn_beg = 1024; E.kn_end = 1152; }
                    else { g.Bt = (const bf16_t*)(P.ws + OFF_ODIN); g.N = 3072; E.ldo = 3072; E.qg = P.in[12]; E.kg = P.in[13]; E.qn_end = 1024; E.kn_beg = 1024; E.kn_end = 2048; }
                } else if (s == 4) {
                    g.A = big;
                    if (l == 0) { g.Bt = (const bf16_t*)(P.ws + OFF_EVOUT); g.lda = 2304; }
                    else { g.Bt = (const bf16_t*)(P.ws + OFF_ODOUT); g.lda = 3072; }
                    E.ssq_out = ssq + (size_t)(4 * l + 2) * T;
                } else if (s == 5) {
                    g.Bt = (const bf16_t*)(P.ws + OFF_WQ + (size_t)l * SZ_MM); E.mode = 2; E.rs = ssq + (size_t)(4 * l + 2) * T; E.ldo = D;
                } else {
                    g.A = big; g.Bt = (const bf16_t*)(P.ws + OFF_WO + (size_t)l * SZ_MM); E.ssq_out = ssq + (size_t)(4 * l + 3) * T;
                }
                pg8::StaticOrder So; So.init(T, g.N, (int)gridDim.x, (int)blockIdx.x);
                E.dryrun = 0;
#if PROBE_GEMM
                for (int rep_ = 0; rep_ < 2; ++rep_) {
                pg8::Epi E2 = E;
                if (rep_ == 0) { if (PROBE_GEMM == 1) E2.dryrun = 1; else if (E.mode == 1) { E2.alpha = 0.f; } }
                __syncthreads();
                pg8::gemm_phase<pg8::Epi, pg8::StaticOrder, true, true>((PG8_LAS unsigned char*)smem, g, So, rep_ == 0 ? E2 : E);
                ++nbar; fast_grid_sync((unsigned*)(P.ws + OFF_BAR), nbar * gridDim.x);
                }
#else
                __syncthreads();
                pg8::gemm_phase<pg8::Epi, pg8::StaticOrder, true, true>((PG8_LAS unsigned char*)smem, g, So, E);
#endif
                if (ph == 1) {
                    GJob J;
                    J.A = xb; J.lda = D; J.ksplit = 1 << 30; J.kextra = 0; J.K = D; J.ntm = 4; J.mode = 3; J.rs = nullptr;
                    J.O = big; J.ldo = D; J.xin = P.out; J.xout = P.out; J.xb = xb; J.ssq_out = ssq; J.alpha = 1.f;
                    J.qg = nullptr; J.kg = nullptr; J.qn_end = 0; J.kn_end = 0; J.vt = nullptr; J.W = nullptr; J.ntn = 8;
                    gemm_phase(J, 0, 64, P, smem, false);
                }
                if (ph == 2 && !dry) knorm_phase(P);
            }
        }
        if (P.ws == nullptr) grid.sync();
        if (ph < 20) { ++nbar; fast_grid_sync((unsigned*)(P.ws + OFF_BAR), nbar * gridDim.x); }
        }
    }
}

extern "C" void kernel_launch(void* const* d_in, const int* in_sizes, int n_in, void* d_out, int out_size, void* d_ws, size_t ws_size,
                              hipStream_t stream) {
    static int grid_blocks = 0;
    if (!grid_blocks) {
        int dev = 0, cus = 0, per_cu = 0;
        hipGetDevice(&dev);
        hipDeviceGetAttribute(&cus, hipDeviceAttributeMultiprocessorCount, dev);
        hipFuncSetAttribute((const void*)fwd_megakernel, hipFuncAttributeMaxDynamicSharedMemorySize, LDS_BYTES);
        hipOccupancyMaxActiveBlocksPerMultiprocessor(&per_cu, fwd_megakernel, NTHR, LDS_BYTES);
        if (per_cu < 1) per_cu = 1;
        if (per_cu > 1) per_cu = 1;
        grid_blocks = cus * per_cu;
    }
    if (ws_size < WS_NEED) { fprintf(stderr, "workspace too small: %zu < %zu\n", ws_size, (size_t)WS_NEED); return; }
    Params p{};
    for (int i = 0; i < 25; ++i) p.in[i] = (const float*)d_in[i];
    p.out = (float*)d_out; p.ws = (char*)d_ws;
    hipMemsetAsync((char*)d_ws + OFF_BAR, 0, 256, stream);
    void* args[] = {&p};
    hipError_t e = hipLaunchCooperativeKernel((void*)fwd_megakernel, dim3(grid_blocks), dim3(NTHR), args, LDS_BYTES, stream);
    if (e != hipSuccess) fprintf(stderr, "cooperative launch failed: %s (grid %d)\n", hipGetErrorString(e), grid_blocks);
}
```

```cpp
#include <hip/hip_runtime.h>
#include <hip/hip_cooperative_groups.h>
#include <cstdio>
#include <cstdint>
namespace cg = cooperative_groups;

#define DI __device__ __forceinline__
typedef unsigned short bf16_t;
typedef short bf16x8 __attribute__((ext_vector_type(8)));
typedef short s16x4 __attribute__((ext_vector_type(4)));
typedef float f32x16 __attribute__((ext_vector_type(16)));
typedef __bf16 bf2_t __attribute__((ext_vector_type(2)));
typedef float f2_t __attribute__((ext_vector_type(2)));
typedef short v4i16_t __attribute__((ext_vector_type(4)));
#define MFMA(a, b, c) __builtin_amdgcn_mfma_f32_32x32x16_bf16((a), (b), (c), 0, 0, 0)

constexpr int T = 16384, S = 4096, D = 1024, DFF = 2816, NGU = 5632;
constexpr float EPS = 1e-6f;
constexpr float LOG2E = 1.4426950408889634f;
constexpr float LN2 = 0.6931471805599453f;

constexpr size_t SZ_GU = (size_t)NGU * D * 2, SZ_DN = (size_t)D * DFF * 2, SZ_MM = (size_t)D * D * 2;
constexpr size_t OFF_GU1 = 0;
constexpr size_t OFF_DN1 = OFF_GU1 + 2 * SZ_GU;
constexpr size_t OFF_GU2 = OFF_DN1 + 2 * SZ_DN;
constexpr size_t OFF_DN2 = OFF_GU2 + 2 * SZ_GU;
constexpr size_t OFF_WQ = OFF_DN2 + 2 * SZ_DN;
constexpr size_t OFF_WKV = OFF_WQ + 2 * SZ_MM;
constexpr size_t OFF_WO = OFF_WKV + 4 * SZ_MM;
constexpr size_t OFF_EVIN = OFF_WO + 2 * SZ_MM;
constexpr size_t OFF_EVOUT = OFF_EVIN + (size_t)2304 * D * 2;
constexpr size_t OFF_ODIN = OFF_EVOUT + SZ_MM;
constexpr size_t OFF_ODOUT = OFF_ODIN + (size_t)3072 * D * 2;
constexpr size_t OFF_XB = OFF_ODOUT + SZ_MM;
constexpr size_t OFF_BIG = OFF_XB + (size_t)T * D * 2;
constexpr size_t OFF_MEMB = OFF_BIG + (size_t)T * 3072 * 2;
constexpr size_t OFF_KN = OFF_MEMB + SZ_MM;
constexpr size_t OFF_VT = OFF_KN + 2 * SZ_MM;
constexpr size_t OFF_SSQ = OFF_VT + 2 * SZ_MM;
constexpr size_t OFF_SSQM = OFF_SSQ + (size_t)9 * T * 4;
constexpr size_t OFF_KMAX = OFF_SSQM + 4096;
constexpr size_t OFF_BAR = OFF_KMAX + 256;
constexpr size_t OFF_KF = OFF_BAR + 256;
constexpr size_t WS_NEED = OFF_KF + 2 * SZ_MM;

#ifndef PROBE_MASK
#define PROBE_MASK 0
#endif
#ifndef PROBE_GEMM
#define PROBE_GEMM 0
#endif
constexpr int NTHR = 512;
constexpr int NST = 4;
constexpr int STAGE_B = 32768;
constexpr int OPB = 16384;
constexpr int LDS_BYTES = 131072;

struct Params { const float* in[25]; float* out; char* ws; };

DI unsigned pk2(float a, float b) { f2_t v = {a, b}; bf2_t r = __builtin_convertvector(v, bf2_t); return __builtin_bit_cast(unsigned, r); }
DI float bflo(unsigned w) { return __uint_as_float(w << 16); }
DI float bfhi(unsigned w) { return __uint_as_float(w & 0xffff0000u); }
DI int otid() { int t = threadIdx.x; asm volatile("" : "+v"(t)); return t; }
DI int crow(int i, int h) { return (i & 3) + 8 * (i >> 2) + 4 * h; }
DI float fexp2(float x) { return __builtin_amdgcn_exp2f(x); }
DI float flog2(float x) { return __builtin_amdgcn_logf(x); }

struct WJob { const float* src; bf16_t* dst; const float* gain; int K, N, gu; };

DI int wjob_tiles(int j) {
    if (j < 14) {
        const int kind = j >> 1;
        switch (kind) {
            case 0: case 2: return 16 * 88;
            case 1: case 3: return 44 * 16;
            case 4: return 256;
            case 5: return 512;
            default: return 256;
        }
    }
    if (j == 14) return 16 * 36;
    if (j == 16) return 16 * 48;
    return 256;
}

DI WJob get_wjob(const Params& P, int j) {
    WJob w; w.gain = nullptr; w.gu = 0;
    bf16_t* wsb = (bf16_t*)P.ws;
    if (j < 14) {
        const int kind = j >> 1, l = j & 1;
        switch (kind) {
            case 0: w.src = P.in[3] + (size_t)l * D * NGU; w.dst = (bf16_t*)(P.ws + OFF_GU1 + l * SZ_GU); w.gain = P.in[2] + l * D; w.K = D; w.N = NGU; w.gu = 1; break;
            case 1: w.src = P.in[4] + (size_t)l * DFF * D; w.dst = (bf16_t*)(P.ws + OFF_DN1 + l * SZ_DN); w.K = DFF; w.N = D; w.gu = 2; break;
            case 2: w.src = P.in[23] + (size_t)l * D * NGU; w.dst = (bf16_t*)(P.ws + OFF_GU2 + l * SZ_GU); w.gain = P.in[22] + l * D; w.K = D; w.N = NGU; w.gu = 1; break;
            case 3: w.src = P.in[24] + (size_t)l * DFF * D; w.dst = (bf16_t*)(P.ws + OFF_DN2 + l * SZ_DN); w.K = DFF; w.N = D; w.gu = 2; break;
            case 4: w.src = P.in[17] + (size_t)l * D * D; w.dst = (bf16_t*)(P.ws + OFF_WQ + l * SZ_MM); w.gain = P.in[15] + l * D; w.K = D; w.N = D; w.gu = 2; break;
            case 5: w.src = P.in[18] + (size_t)l * D * 2048; w.dst = (bf16_t*)(P.ws + OFF_WKV + l * 2 * SZ_MM); w.gain = P.in[16] + l * D; w.K = D; w.N = 2048; break;
            default: w.src = P.in[21] + (size_t)l * D * D; w.dst = (bf16_t*)(P.ws + OFF_WO + l * SZ_MM); w.K = D; w.N = D; w.gu = 2; break;
        }
    } else if (j == 14) { w.src = P.in[6]; w.dst = (bf16_t*)(P.ws + OFF_EVIN); w.gain = P.in[5]; w.K = D; w.N = 2304; w.gu = 3; }
    else if (j == 15) { w.src = P.in[10]; w.dst = (bf16_t*)(P.ws + OFF_EVOUT); w.K = D; w.N = D; w.gu = 2; }
    else if (j == 16) { w.src = P.in[11]; w.dst = (bf16_t*)(P.ws + OFF_ODIN); w.gain = P.in[5] + D; w.K = D; w.N = 3072; w.gu = 2; }
    else { w.src = P.in[14]; w.dst = (bf16_t*)(P.ws + OFF_ODOUT); w.K = D; w.N = D; w.gu = 2; }
    (void)wsb;
    return w;
}

DI void wconv_tile(const WJob& w, int t, float* sm, int tid, bool act) {
    const int ntn = w.N >> 6; const int tk = t / ntn, tn = t - tk * ntn;
    if (act) {
#pragma unroll
        for (int p = 0; p < 4; ++p) {
            const int kr = p * 16 + (tid >> 4);
            typedef float f32x4nt __attribute__((ext_vector_type(4)));
            const f32x4nt v = __builtin_nontemporal_load((const f32x4nt*)(w.src + (size_t)(tk * 64 + kr) * w.N + tn * 64 + (tid & 15) * 4));
            const float g = w.gain ? w.gain[tk * 64 + kr] : 1.f;
            float* sp = sm + kr * 65 + (tid & 15) * 4;
            sp[0] = v[0] * g; sp[1] = v[1] * g; sp[2] = v[2] * g; sp[3] = v[3] * g;
        }
    }
    __syncthreads();
    if (act) {
        const int n = tid >> 2, kq = tid & 3; const int ng = tn * 64 + n;
        int drow = ng;
        if (w.gu == 1) drow = ng < DFF ? ((ng >> 7) * 256 + (ng & 127)) : (((ng - DFF) >> 7) * 256 + 128 + ((ng - DFF) & 127));
        else if (w.gu >= 2) {
            int a = ng;
            if (w.gu == 3) a = ng < 512 ? ng : ng < 768 ? ng + 512 : ng < 1280 ? ng - 256 : ng;
            drow = (a & ~255) + (((a >> 5) & 1) << 7) + (((a >> 6) & 3) << 5) + (a & 31);
        }
        unsigned o[8];
#pragma unroll
        for (int e = 0; e < 8; ++e) o[e] = pk2(sm[(kq * 16 + 2 * e) * 65 + n], sm[(kq * 16 + 2 * e + 1) * 65 + n]);
        uint4* dp = (uint4*)(w.dst + (size_t)drow * w.K + tk * 64 + kq * 16);
        dp[0] = make_uint4(o[0], o[1], o[2], o[3]); dp[1] = make_uint4(o[4], o[5], o[6], o[7]);
    }
    __syncthreads();
}

DI float wave_sum(float v) {
    v += __shfl_xor(v, 1); v += __shfl_xor(v, 2); v += __shfl_xor(v, 4); v += __shfl_xor(v, 8); v += __shfl_xor(v, 16); v += __shfl_xor(v, 32);
    return v;
}

DI void rowconv(const float* src, bf16_t* dst, float* ssq, int row, int lane) {
    const float* xr = src + (size_t)row * D;
    float ss = 0.f;
#pragma unroll
    for (int p = 0; p < 4; ++p) {
        const float4 v = *(const float4*)(xr + p * 256 + lane * 4);
        ss += v.x * v.x + v.y * v.y + v.z * v.z + v.w * v.w;
        *(uint2*)(dst + (size_t)row * D + p * 256 + lane * 4) = make_uint2(pk2(v.x, v.y), pk2(v.z, v.w));
    }
    ss = wave_sum(ss);
    if (lane == 0) ssq[row] = ss;
}

DI void phase0(const Params& P, char* smem) {
    const int tid = otid(), lane = tid & 63, wid = tid >> 6;
    float* ssq = (float*)(P.ws + OFF_SSQ);
    for (int i = blockIdx.x * NTHR + tid; i < 8 * T; i += gridDim.x * NTHR) ssq[T + i] = 0.f;
    if (blockIdx.x == 0 && tid < 32) ((unsigned*)(P.ws + OFF_KMAX))[tid] = 0u;
    constexpr int NW = 12352 / 2, NX = T / 8, NM = 1024 / 8;
    for (int u = blockIdx.x; u < NW + NX + NM; u += gridDim.x) {
        if (u < NW) {
            const int half = tid >> 8;
            int t = 2 * u + half, j = 0;
            for (; j < 17; ++j) { const int c = wjob_tiles(j); if (t < c) break; t -= c; }
            const WJob w = get_wjob(P, j);
            wconv_tile(w, t, (float*)smem + half * (64 * 65), tid & 255, true);
        } else if (u < NW + NX) {
            rowconv(P.in[0], (bf16_t*)(P.ws + OFF_XB), ssq, (u - NW) * 8 + wid, lane);
        } else {
            rowconv(P.in[1], (bf16_t*)(P.ws + OFF_MEMB), (float*)(P.ws + OFF_SSQM), (u - NW - NX) * 8 + wid, lane);
        }
    }
}

struct GJob {
    const bf16_t* A; const bf16_t* W;
    int lda, ksplit, kextra, K, ntm, ntn, mode;
    const float* rs;
    bf16_t* O; int ldo;
    const float* xin; float* xout; bf16_t* xb; float* ssq_out; float alpha;
    const float* qg; const float* kg; int qn_end, kn_end;
    bf16_t* vt;
};

typedef __attribute__((address_space(3))) unsigned* ldsu_t;
typedef const __attribute__((address_space(1))) unsigned* glbu_t;
DI void glds16(const bf16_t* g, char* l) { __builtin_amdgcn_global_load_lds((glbu_t)(const void*)g, (ldsu_t)(void*)l, 16, 0, 0); }

DI void gemm_tile(const GJob& J, int t, char* smem, bool dry) {
    const int tid = otid(), lane = tid & 63, wid = tid >> 6, wr = wid >> 2, wc = wid & 3;
    const int r = lane & 31, h = lane >> 5;
    int tm, tn;
    { const int gsz = 32 * J.ntn; const int g = t / gsz; const int rem = t - g * gsz; const int rows = min(32, J.ntm - g * 32); tn = rem / rows; tm = g * 32 + (rem - tn * rows); }
    const int lrow = wid * 16 + (lane >> 2);
    const int csw = ((lane & 3) ^ ((lane >> 4) & 3)) * 8;
    const bf16_t* Ag = J.A + (size_t)(tm * 256 + lrow) * J.lda + csw;
    const bf16_t* Wg = J.W + (size_t)(tn * 256 + lrow) * J.K + csw;
    const size_t astr = (size_t)128 * J.lda, wstr = (size_t)128 * J.K;
    char* lb = smem + tid * 16;
    const int nk = J.K >> 5;
#define GLDS(kt, buf) do { const int k0_ = (kt) * 32; const int ka_ = k0_ + (k0_ >= J.ksplit ? J.kextra : 0); char* l_ = lb + (buf) * STAGE_B; \
        glds16(Ag + ka_, l_); glds16(Ag + astr + ka_, l_ + 8192); glds16(Wg + k0_, l_ + OPB); glds16(Wg + wstr + k0_, l_ + OPB + 8192); } while (0)
    f32x16 acc[4][2];
#pragma unroll
    for (int a = 0; a < 4; ++a)
#pragma unroll
        for (int b = 0; b < 2; ++b)
#pragma unroll
            for (int i = 0; i < 16; ++i) acc[a][b][i] = 0.f;
    const int fr = (r >> 2) & 3;
    const int xrow = (wc * 64 + r) * 64, wrow = OPB + (wr * 128 + r) * 64;
    const int co0 = ((0 + h) ^ fr) * 16, co1 = ((2 + h) ^ fr) * 16;

    __syncthreads();
    GLDS(0, 0); GLDS(1, 1); GLDS(2, 2);
    asm volatile("s_waitcnt vmcnt(8)" ::: "memory");
    __builtin_amdgcn_s_barrier();
    bf16x8 w0[4], x0[2], w1[4], x1[2];
#define LOADF(W_, X_, sb_, co_) do { _Pragma("unroll") for (int ti = 0; ti < 2; ++ti) X_[ti] = *(const bf16x8*)((sb_) + xrow + ti * 2048 + (co_)); \
        _Pragma("unroll") for (int fi = 0; fi < 4; ++fi) W_[fi] = *(const bf16x8*)((sb_) + wrow + fi * 2048 + (co_)); } while (0)
#define MFMA8(W_, X_) do { __builtin_amdgcn_s_setprio(1); _Pragma("unroll") for (int fi = 0; fi < 4; ++fi) _Pragma("unroll") for (int ti = 0; ti < 2; ++ti) \
        acc[fi][ti] = MFMA(W_[fi], X_[ti], acc[fi][ti]); __builtin_amdgcn_s_setprio(0); } while (0)
    LOADF(w0, x0, smem, co0);
    __builtin_amdgcn_s_waitcnt(0xC07F);
    int buf = 0;
    for (int kt = 0; kt < nk; ++kt) {
        const char* sb = smem + buf * STAGE_B;
        LOADF(w1, x1, sb, co1);
        __builtin_amdgcn_sched_barrier(0);
        MFMA8(w0, x0);
        __builtin_amdgcn_s_waitcnt(0xC07F);
        __builtin_amdgcn_sched_barrier(0);
        const int nb = (buf + 1 == NST) ? 0 : buf + 1;
        if (kt + 1 < nk) {
            if (kt + 2 < nk) asm volatile("s_waitcnt vmcnt(4)" ::: "memory"); else asm volatile("s_waitcnt vmcnt(0)" ::: "memory");
            __builtin_amdgcn_s_barrier();
            if (kt + 3 < nk) { const int fb_ = (buf + 3 >= NST) ? buf + 3 - NST : buf + 3; GLDS(kt + 3, fb_); }
        }
        LOADF(w0, x0, smem + nb * STAGE_B, co0);
        __builtin_amdgcn_sched_barrier(0);
        MFMA8(w1, x1);
        __builtin_amdgcn_s_waitcnt(0xC07F);
        __builtin_amdgcn_sched_barrier(0);
        buf = nb;
    }
#undef LOADF
#undef MFMA8
#undef GLDS
    __syncthreads();

    if (dry) { if (acc[0][0][0] + acc[1][1][0] + acc[2][0][0] + acc[3][1][0] == 12345.678f) J.O[0] = 1; return; }
    const int tokb = tm * 256 + wc * 64;
    const int fb = tn * 256 + wr * 128;
    float rsc[2];
#pragma unroll
    for (int ti = 0; ti < 2; ++ti) rsc[ti] = J.rs ? __builtin_amdgcn_rsqf(J.rs[tokb + ti * 32 + r] * (1.f / 1024.f) + EPS) : 1.f;

    if (J.mode == 3 && fb >= 1024) {
#pragma unroll
        for (int ti = 0; ti < 2; ++ti) {
            const int tok = tokb + ti * 32 + r;
#pragma unroll
            for (int fi = 0; fi < 4; ++fi)
#pragma unroll
                for (int i = 0; i < 16; ++i) {
                    const int f = fb - 1024 + fi * 32 + crow(i, h);
                    const int bh_ = (tok >> 8) * 4 + (f >> 8), d_ = f & 255, key_ = tok & 255, k16 = key_ & 15;
                    const int ln_ = ((k16 >> 2) & 1) * 32 + (d_ & 31), e_ = ((k16 >> 3) << 2) | (k16 & 3);
                    J.vt[((((((size_t)bh_ * 8 + (d_ >> 5)) * 8 + (key_ >> 5)) * 2 + ((key_ >> 4) & 1)) * 64 + ln_) << 3) + e_] = (bf16_t)(pk2(acc[fi][ti][i] * rsc[ti], 0.f) & 0xffffu);
                }
        }
        return;
    }
    char* wl = smem + wid * 16384;
#pragma unroll
    for (int ti = 0; ti < 2; ++ti) {
#pragma unroll
        for (int fp = 0; fp < 2; ++fp) {
            const float sc = (J.mode == 1) ? J.alpha : rsc[ti];
#pragma unroll
            for (int fi2 = 0; fi2 < 2; ++fi2)
#pragma unroll
                for (int g = 0; g < 4; ++g) {
                    float4 v;
                    v.x = acc[2 * fp + fi2][ti][4 * g + 0] * sc; v.y = acc[2 * fp + fi2][ti][4 * g + 1] * sc;
                    v.z = acc[2 * fp + fi2][ti][4 * g + 2] * sc; v.w = acc[2 * fp + fi2][ti][4 * g + 3] * sc;
                    *(float4*)(wl + r * 272 + (fi2 * 32 + 8 * g + 4 * h) * 4) = v;
                }
            const int tok0 = tokb + ti * 32, f0 = fb + fp * 64;
            if (J.mode == 0) {
                const int c4 = (lane & 7) * 4;
#pragma unroll
                for (int p = 0; p < 4; ++p) {
                    const int row = p * 8 + (lane >> 3);
                    const float4 ga = *(const float4*)(wl + row * 272 + c4 * 4);
                    const float4 up = *(const float4*)(wl + row * 272 + (32 + c4) * 4);
                    float y0 = ga.x * up.x * __builtin_amdgcn_rcpf(1.f + fexp2(-ga.x * LOG2E));
                    float y1 = ga.y * up.y * __builtin_amdgcn_rcpf(1.f + fexp2(-ga.y * LOG2E));
                    float y2 = ga.z * up.z * __builtin_amdgcn_rcpf(1.f + fexp2(-ga.z * LOG2E));
                    float y3 = ga.w * up.w * __builtin_amdgcn_rcpf(1.f + fexp2(-ga.w * LOG2E));
                    *(uint2*)(J.O + (size_t)(tok0 + row) * J.ldo + (f0 >> 1) + c4) = make_uint2(pk2(y0, y1), pk2(y2, y3));
                }
            } else if (J.mode == 1) {
                const int c4 = (lane & 15) * 4;
#pragma unroll
                for (int p = 0; p < 8; ++p) {
                    const int row = p * 4 + (lane >> 4);
                    const size_t tok = tok0 + row;
                    const float4 v = *(const float4*)(wl + row * 272 + c4 * 4);
                    const float4 xo = *(const float4*)(J.xin + tok * D + f0 + c4);
                    float4 xn; xn.x = xo.x + v.x; xn.y = xo.y + v.y; xn.z = xo.z + v.z; xn.w = xo.w + v.w;
                    *(float4*)(J.xout + tok * D + f0 + c4) = xn;
                    if (J.xb) {
                        *(uint2*)(J.xb + tok * D + f0 + c4) = make_uint2(pk2(xn.x, xn.y), pk2(xn.z, xn.w));
                        float ss = xn.x * xn.x + xn.y * xn.y + xn.z * xn.z + xn.w * xn.w;
                        ss += __shfl_xor(ss, 1); ss += __shfl_xor(ss, 2); ss += __shfl_xor(ss, 4); ss += __shfl_xor(ss, 8);
                        if ((lane & 15) == 0) atomicAdd(J.ssq_out + tok, ss);
                    }
                }
            } else {
                const int nm = f0 < J.qn_end ? 1 : (f0 < J.kn_end ? 2 : 0);
                const float* gp = nm == 1 ? J.qg : J.kg;
                const int c4 = (lane & 15) * 4;
                float4 gn = make_float4(1.f, 1.f, 1.f, 1.f);
                if (nm) gn = *(const float4*)(gp + c4);
#pragma unroll
                for (int p = 0; p < 8; ++p) {
                    const int row = p * 4 + (lane >> 4);
                    float4 v = *(const float4*)(wl + row * 272 + c4 * 4);
                    if (nm) {
                        float ss = v.x * v.x + v.y * v.y + v.z * v.z + v.w * v.w;
                        ss += __shfl_xor(ss, 1); ss += __shfl_xor(ss, 2); ss += __shfl_xor(ss, 4); ss += __shfl_xor(ss, 8);
                        const float inv = __builtin_amdgcn_rsqf(ss * (1.f / 64.f) + EPS);
                        v.x *= inv * gn.x; v.y *= inv * gn.y; v.z *= inv * gn.z; v.w *= inv * gn.w;
                    }
                    *(uint2*)(J.O + (size_t)(tok0 + row) * J.ldo + f0 + c4) = make_uint2(pk2(v.x, v.y), pk2(v.z, v.w));
                }
            }
        }
    }
}

DI void gemm_phase(const GJob& JA, int nA, int nB, const Params& P, char* smem, bool dry) {
    for (int u = (int)gridDim.x - 1 - (int)blockIdx.x; u < nA + nB; u += gridDim.x) {
        GJob J = JA; int t = u;
        if (u >= nA) {
            const int v = u - nA; const int layer = v >> 5; t = v & 31;
            J.A = (const bf16_t*)(P.ws + OFF_MEMB); J.lda = D; J.ksplit = 1 << 30; J.kextra = 0;
            J.W = (const bf16_t*)(P.ws + OFF_WKV + (size_t)layer * 2 * SZ_MM); J.K = D; J.ntm = 4; J.ntn = 8; J.mode = 3;
            J.rs = (const float*)(P.ws + OFF_SSQM); J.O = (bf16_t*)(P.ws + OFF_KN + (size_t)layer * SZ_MM); J.ldo = D;
            J.qn_end = 0; J.kn_end = 0; J.vt = (bf16_t*)(P.ws + OFF_VT + (size_t)layer * SZ_MM);
        }
        gemm_tile(J, t, smem, dry);
    }
}

namespace pg8 {
#define PG8_LAS __attribute__((address_space(3)))
typedef float f32x4 __attribute__((ext_vector_type(4)));
typedef unsigned u32x4 __attribute__((ext_vector_type(4)));
constexpr int BM = 256, BK = 64, HALF = 128, HTB = HALF * BK * 2, STAGE_BYTES = 8 * HTB, NXCD = 8, WGM = 8;
DI int lds_byte(int r, int c) { const int st = (r >> 4) * 2 + (c >> 5), rr = r & 15, cc = c & 31, ob = rr * 64 + cc * 2; return st * 1024 + (ob ^ (((ob >> 9) & 1) << 5)); }
DI void stage_rc(int b, int& R, int& C) { const int st = b / 1024, sb = b % 1024, swz = sb ^ (((sb >> 9) & 1) << 5); R = (st >> 1) * 16 + swz / 64; C = (st & 1) * 32 + (swz % 64) / 2; }
DI int perm32(int rho) { const int n = rho >> 4, i = rho & 15; return 8 * (i >> 2) + 4 * n + (i & 3); }
struct Unit { int pm, pn; };
struct Gemm { const bf16_t* A; const bf16_t* Bt; int M, N, K, lda; };
struct StaticOrder {
    int nM, nN, nwg, G, c;
    DI void init(int M, int N, int G_, int c_) { nM = M / BM; nN = N / BM; nwg = nM * nN; G = G_; c = c_; }
    DI bool next(int i, Unit& u) const {
        const long L = (long)i * G + c; if (L >= nwg) return false;
        int wgid = (int)L; { const int q = nwg / NXCD, r = nwg % NXCD, xcd = wgid % NXCD, off = wgid / NXCD; wgid = (xcd < r ? xcd * (q + 1) : r * (q + 1) + (xcd - r) * q) + off; }
        const int nig = WGM * nN, gid = wgid / nig, fm = gid * WGM, gsz = (nM - fm) < WGM ? (nM - fm) : WGM;
        u.pm = fm + ((wgid % nig) % gsz); u.pn = (wgid % nig) / gsz; return true;
    }
    DI void a_ready(const Unit&) const {}
    DI void done(const Unit&) const {}
};

struct Epi {
    static constexpr bool PERM = true, AFTER_DRAIN = false;
    int mode;
    const float* rs;
    bf16_t* O; int ldo;
    const float* xin; float* xout; bf16_t* xb; float* ssq_out; float alpha;
    const float* qg; const float* kg; int qn_end, kn_beg, kn_end; int dryrun;
    DI void operator()(const f32x4 (&acc)[2][2][4][2], const Unit& u, int wr, int wc, int fr, int fq) const {
        if (dryrun) { if (acc[0][0][0][0][0] + acc[1][1][3][1][3] + acc[0][1][2][0][1] + acc[1][0][1][1][2] == 12345.678f) O[0] = 1; return; }
        const int row0 = u.pm * BM + wr * 64 + fr;
        if (mode == 0) {
            const int col = u.pn * 128 + wc * 32 + 8 * fq;
#pragma unroll
            for (int ai = 0; ai < 2; ++ai)
#pragma unroll
                for (int m = 0; m < 4; ++m) {
                    const size_t tok = row0 + ai * HALF + m * 16;
                    const float sc = __builtin_amdgcn_rsqf(rs[tok] * (1.f / 1024.f) + EPS);
                    float y[8];
#pragma unroll
                    for (int n = 0; n < 2; ++n)
#pragma unroll
                        for (int j = 0; j < 4; ++j) {
                            const float ga = acc[ai][0][m][n][j] * sc, up = acc[ai][1][m][n][j] * sc;
                            y[4 * n + j] = ga * up * __builtin_amdgcn_rcpf(1.f + fexp2(-ga * LOG2E));
                        }
                    *(uint4*)(O + tok * ldo + col) = make_uint4(pk2(y[0], y[1]), pk2(y[2], y[3]), pk2(y[4], y[5]), pk2(y[6], y[7]));
                }
        } else if (mode == 1) {
#pragma unroll
            for (int ai = 0; ai < 2; ++ai)
#pragma unroll
                for (int m = 0; m < 4; ++m) {
                    const size_t tok = row0 + ai * HALF + m * 16;
                    float ss = 0.f;
#pragma unroll
                    for (int bj = 0; bj < 2; ++bj) {
                        const int col = u.pn * BM + wc * 64 + bj * 32 + 8 * fq;
                        float4 x0, x1;
                        if (xin) { x0 = *(const float4*)(xin + tok * D + col); x1 = *(const float4*)(xin + tok * D + col + 4); }
                        else {
                            const uint4 w = *(const uint4*)(xb + tok * D + col);
                            x0 = make_float4(bflo(w.x), bfhi(w.x), bflo(w.y), bfhi(w.y)); x1 = make_float4(bflo(w.z), bfhi(w.z), bflo(w.w), bfhi(w.w));
                        }
                        float4 n0, n1;
                        n0.x = x0.x + alpha * acc[ai][bj][m][0][0]; n0.y = x0.y + alpha * acc[ai][bj][m][0][1]; n0.z = x0.z + alpha * acc[ai][bj][m][0][2]; n0.w = x0.w + alpha * acc[ai][bj][m][0][3];
                        n1.x = x1.x + alpha * acc[ai][bj][m][1][0]; n1.y = x1.y + alpha * acc[ai][bj][m][1][1]; n1.z = x1.z + alpha * acc[ai][bj][m][1][2]; n1.w = x1.w + alpha * acc[ai][bj][m][1][3];
                        if (xout) { *(float4*)(xout + tok * D + col) = n0; *(float4*)(xout + tok * D + col + 4) = n1; }
                        if (ssq_out) {
                            const uint4 w = make_uint4(pk2(n0.x, n0.y), pk2(n0.z, n0.w), pk2(n1.x, n1.y), pk2(n1.z, n1.w));
                            *(uint4*)(xb + tok * D + col) = w;
                            const float r0 = bflo(w.x), r1 = bfhi(w.x), r2 = bflo(w.y), r3 = bfhi(w.y), r4 = bflo(w.z), r5 = bfhi(w.z), r6 = bflo(w.w), r7 = bfhi(w.w);
                            ss += r0 * r0 + r1 * r1 + r2 * r2 + r3 * r3 + r4 * r4 + r5 * r5 + r6 * r6 + r7 * r7;
                        }
                    }
                    if (ssq_out) {
                        ss += __shfl_xor(ss, 16); ss += __shfl_xor(ss, 32);
                        if (fq == 0) atomicAdd(ssq_out + tok, ss);
                    }
                }
        } else {
            const int f0 = u.pn * BM + wc * 64;
            const int nm = f0 < qn_end ? 1 : ((f0 >= kn_beg && f0 < kn_end) ? 2 : 0);
            const float* gp = nm == 1 ? qg : kg;
            float4 g4[2][2];
#pragma unroll
            for (int bj = 0; bj < 2; ++bj)
#pragma unroll
                for (int n = 0; n < 2; ++n) g4[bj][n] = nm ? *(const float4*)(gp + bj * 32 + 8 * fq + 4 * n) : make_float4(1.f, 1.f, 1.f, 1.f);
#pragma unroll
            for (int ai = 0; ai < 2; ++ai)
#pragma unroll
                for (int m = 0; m < 4; ++m) {
                    const size_t tok = row0 + ai * HALF + m * 16;
                    float sc = rs ? __builtin_amdgcn_rsqf(rs[tok] * (1.f / 1024.f) + EPS) : 1.f;
                    if (nm) {
                        float ss = 0.f;
#pragma unroll
                        for (int bj = 0; bj < 2; ++bj)
#pragma unroll
                            for (int n = 0; n < 2; ++n)
#pragma unroll
                                for (int j = 0; j < 4; ++j) { const float v = acc[ai][bj][m][n][j] * sc; ss += v * v; }
                        ss += __shfl_xor(ss, 16); ss += __shfl_xor(ss, 32);
                        sc *= __builtin_amdgcn_rsqf(ss * (1.f / 64.f) + EPS);
                    }
#pragma unroll
                    for (int bj = 0; bj < 2; ++bj) {
                        const f32x4 a0 = acc[ai][bj][m][0], a1 = acc[ai][bj][m][1];
                        *(uint4*)(O + tok * ldo + f0 + bj * 32 + 8 * fq) =
                            make_uint4(pk2(a0[0] * sc * g4[bj][0].x, a0[1] * sc * g4[bj][0].y), pk2(a0[2] * sc * g4[bj][0].z, a0[3] * sc * g4[bj][0].w),
                                       pk2(a1[0] * sc * g4[bj][1].x, a1[1] * sc * g4[bj][1].y), pk2(a1[2] * sc * g4[bj][1].z, a1[3] * sc * g4[bj][1].w));
                    }
                }
        }
    }
};

template <class Epi, class Sched, bool ALIGN_EPI = false, bool SP2 = false>
__device__ __forceinline__ void gemm_phase(PG8_LAS unsigned char* lds, const Gemm g, const Sched& S, const Epi& E) {
    const int tid = otid(), wid = __builtin_amdgcn_readfirstlane(tid >> 6), lane = tid & 63, wr = wid >> 2, wc = wid & 3, fr = lane & 15, fq = lane >> 4;
    const int K = g.K, nt = K / BK;
    unsigned voffA[2], voffB[2];
#pragma unroll
    for (int i = 0; i < 2; ++i) { int R, C; stage_rc(tid * 16 + i * 8192, R, C); const int Rb = Epi::PERM ? ((R & ~31) + perm32(R & 31)) : R;
        voffA[i] = (unsigned)(R * g.lda + C) * 2u; voffB[i] = (unsigned)(Rb * K + C) * 2u; }
    const size_t kstep = (size_t)(BK * 2);
    const size_t hstepA = (size_t)HALF * g.lda * 2, hstepB = (size_t)HALF * K * 2;
    const size_t tstepA = 2 * hstepA, tstepB = 2 * hstepB;
    const unsigned ldsw = (unsigned)wid * 1024u;
    const int aoff = lds_byte(wr * 64 + fr, fq * 8), boff = lds_byte(wc * 32 + fr, fq * 8);
#define PG8_SA(b, h) (((b) * 2 + (h)) * HTB)
#define PG8_SB(b, h) ((4 + (b) * 2 + (h)) * HTB)
#define PG8_STAGE(bufoff, gbase, voff) do { _Pragma("unroll") for (int _i = 0; _i < 2; ++_i) \
        __builtin_amdgcn_global_load_lds((const unsigned*)((const char*)(gbase) + (voff)[_i]), (PG8_LAS unsigned*)(lds + (bufoff) + ldsw + _i * 8192), 16, 0, 0); } while (0)
#define PG8_LDA(dst, b, h) do { _Pragma("unroll") for (int m = 0; m < 4; ++m) _Pragma("unroll") for (int k = 0; k < 2; ++k) dst[m][k] = *(const PG8_LAS bf16x8*)(lds + PG8_SA(b, h) + aoff + m * 2048 + k * 1024); } while (0)
#define PG8_LDB(dst, b, h) do { _Pragma("unroll") for (int n = 0; n < 2; ++n) _Pragma("unroll") for (int k = 0; k < 2; ++k) dst[n][k] = *(const PG8_LAS bf16x8*)(lds + PG8_SB(b, h) + boff + n * 2048 + k * 1024); } while (0)
#define PG8_MMA(ai, bj, At, Bt) do { __builtin_amdgcn_s_setprio(1); _Pragma("unroll") for (int m = 0; m < 4; ++m) _Pragma("unroll") for (int n = 0; n < 2; ++n) _Pragma("unroll") for (int k = 0; k < 2; ++k) \
        acc[ai][bj][m][n] = __builtin_amdgcn_mfma_f32_16x16x32_bf16(Bt[n][k], At[m][k], acc[ai][bj][m][n], 0, 0, 0); __builtin_amdgcn_s_setprio(0); } while (0)
#define PG8_WAIT_V(n) asm volatile("s_waitcnt vmcnt(" #n ")" ::: "memory")
#define PG8_WAIT_L(n) asm volatile("s_waitcnt lgkmcnt(" #n ")" ::: "memory")
#define PG8_BAR __builtin_amdgcn_s_barrier()
#define PG8_SCHED __builtin_amdgcn_sched_barrier(0)
    Unit cur, nxt; int ui = 0;
    if (!S.next(0, cur)) return;
    f32x4 acc[2][2][4][2];
#pragma unroll
    for (int a = 0; a < 2; ++a)
#pragma unroll
        for (int b = 0; b < 2; ++b)
#pragma unroll
            for (int m = 0; m < 4; ++m)
#pragma unroll
                for (int n = 0; n < 2; ++n) acc[a][b][m][n] = (f32x4){0.f, 0.f, 0.f, 0.f};
    bf16x8 At[4][2], B0[2][2], B1[2][2];
    const char* cA = (const char*)g.A + (size_t)cur.pm * tstepA; const char* cB = (const char*)g.Bt + (size_t)cur.pn * tstepB;
    S.a_ready(cur);
    if constexpr (SP2) {
        PG8_STAGE(PG8_SB(0, 0), cB, voffB); PG8_STAGE(PG8_SB(0, 1), cB + hstepB, voffB); PG8_STAGE(PG8_SA(0, 0), cA, voffA); PG8_STAGE(PG8_SA(0, 1), cA + hstepA, voffA);
        if (wr == 1) PG8_BAR;
        PG8_WAIT_V(2); PG8_BAR;
        PG8_STAGE(PG8_SB(1, 0), cB + kstep, voffB); PG8_STAGE(PG8_SA(1, 0), cA + kstep, voffA); PG8_STAGE(PG8_SB(1, 1), cB + hstepB + kstep, voffB);
        PG8_WAIT_V(6); PG8_BAR;
    } else {
        PG8_STAGE(PG8_SB(0, 0), cB, voffB); PG8_STAGE(PG8_SA(0, 0), cA, voffA); PG8_STAGE(PG8_SB(0, 1), cB + hstepB, voffB); PG8_STAGE(PG8_SA(0, 1), cA + hstepA, voffA);
        if (wr == 1) PG8_BAR;
        PG8_WAIT_V(4); PG8_BAR;
        PG8_STAGE(PG8_SB(1, 0), cB + kstep, voffB); PG8_STAGE(PG8_SA(1, 0), cA + kstep, voffA); PG8_STAGE(PG8_SB(1, 1), cB + hstepB + kstep, voffB);
        PG8_WAIT_V(6); PG8_BAR;
    }
    for (;;) {
        const bool has_next = S.next(ui + 1, nxt);
        const char* nA = has_next ? (const char*)g.A + (size_t)nxt.pm * tstepA : cA; const char* nB = has_next ? (const char*)g.Bt + (size_t)nxt.pn * tstepB : cB;
        for (int t = 0; t < nt; t += 2) {
            const bool last = (t == nt - 2);
            const char* a1 = cA + (size_t)(t + 1) * kstep;
            const char* a2 = last ? nA : cA + (size_t)(t + 2) * kstep; const char* b2 = last ? nB : cB + (size_t)(t + 2) * kstep;
            const char* a3 = a2 + kstep; const char* b3 = b2 + kstep;
            if (last && has_next) S.a_ready(nxt);
            if constexpr (SP2) {
            PG8_LDB(B0, 0, 0); PG8_LDB(B1, 0, 1); PG8_SCHED; PG8_LDA(At, 0, 0); PG8_STAGE(PG8_SA(1, 1), a1 + hstepA, voffA);
            PG8_WAIT_V(8); PG8_WAIT_L(0); PG8_BAR; PG8_MMA(0, 0, At, B0); PG8_MMA(0, 1, At, B1); PG8_BAR; PG8_SCHED;
            PG8_LDA(At, 0, 1); PG8_STAGE(PG8_SB(0, 0), b2, voffB); PG8_STAGE(PG8_SB(0, 1), b2 + hstepB, voffB); PG8_STAGE(PG8_SA(0, 0), a2, voffA);
            PG8_WAIT_V(8); PG8_WAIT_L(0); PG8_BAR; PG8_MMA(1, 0, At, B0); PG8_MMA(1, 1, At, B1); PG8_BAR; PG8_SCHED;
            PG8_LDB(B0, 1, 0); PG8_LDB(B1, 1, 1); PG8_SCHED; PG8_LDA(At, 1, 0); PG8_STAGE(PG8_SA(0, 1), a2 + hstepA, voffA);
            PG8_WAIT_V(8); PG8_WAIT_L(0); PG8_BAR; PG8_MMA(0, 0, At, B0); PG8_MMA(0, 1, At, B1); PG8_BAR; PG8_SCHED;
            PG8_LDA(At, 1, 1); PG8_STAGE(PG8_SB(1, 0), b3, voffB); PG8_STAGE(PG8_SB(1, 1), b3 + hstepB, voffB); PG8_STAGE(PG8_SA(1, 0), a3, voffA);
            PG8_WAIT_V(8); PG8_WAIT_L(0); PG8_BAR; PG8_MMA(1, 0, At, B0); PG8_MMA(1, 1, At, B1); PG8_BAR; PG8_SCHED;
            } else {
            PG8_LDB(B0, 0, 0); PG8_SCHED; PG8_LDA(At, 0, 0); PG8_STAGE(PG8_SA(1, 1), a1 + hstepA, voffA);
            PG8_WAIT_L(8); PG8_BAR; PG8_WAIT_L(0); PG8_MMA(0, 0, At, B0); PG8_BAR; PG8_SCHED;
            PG8_LDB(B1, 0, 1); PG8_STAGE(PG8_SB(0, 0), b2, voffB);
            PG8_BAR; PG8_WAIT_L(0); PG8_MMA(0, 1, At, B1); PG8_BAR;
            PG8_LDA(At, 0, 1); PG8_STAGE(PG8_SA(0, 0), a2, voffA);
            PG8_BAR; PG8_WAIT_L(0); PG8_MMA(1, 0, At, B0); PG8_BAR; PG8_SCHED;
            PG8_STAGE(PG8_SB(0, 1), b2 + hstepB, voffB);
            PG8_WAIT_V(6); PG8_BAR; PG8_MMA(1, 1, At, B1); PG8_BAR;
            PG8_LDB(B0, 1, 0); PG8_SCHED; PG8_LDA(At, 1, 0); PG8_STAGE(PG8_SA(0, 1), a2 + hstepA, voffA);
            PG8_WAIT_L(8); PG8_BAR; PG8_WAIT_L(0); PG8_MMA(0, 0, At, B0); PG8_BAR; PG8_SCHED;
            PG8_LDB(B1, 1, 1); PG8_STAGE(PG8_SB(1, 0), b3, voffB);
            PG8_BAR; PG8_WAIT_L(0); PG8_MMA(0, 1, At, B1); PG8_BAR;
            PG8_LDA(At, 1, 1); PG8_STAGE(PG8_SA(1, 0), a3, voffA);
            PG8_BAR; PG8_WAIT_L(0); PG8_MMA(1, 0, At, B0); PG8_BAR; PG8_SCHED;
            PG8_STAGE(PG8_SB(1, 1), b3 + hstepB, voffB);
            PG8_WAIT_V(6); PG8_BAR; PG8_MMA(1, 1, At, B1); PG8_BAR;
            }
        }
        if constexpr (ALIGN_EPI) { if (wr == 0) PG8_BAR; }
        if constexpr (!Epi::AFTER_DRAIN) { E(acc, cur, wr, wc, fr, fq); S.done(cur); }
        if (!has_next) break;
#pragma unroll
        for (int a = 0; a < 2; ++a)
#pragma unroll
            for (int b = 0; b < 2; ++b)
#pragma unroll
                for (int m = 0; m < 4; ++m)
#pragma unroll
                    for (int n = 0; n < 2; ++n) acc[a][b][m][n] = (f32x4){0.f, 0.f, 0.f, 0.f};
        cur = nxt; cA = nA; cB = nB; ++ui;
        if constexpr (ALIGN_EPI) { if (wr == 1) PG8_BAR; }
    }
    PG8_WAIT_V(0);
    if constexpr (!ALIGN_EPI) { if (wr == 0) PG8_BAR; }
    PG8_BAR;
    if constexpr (Epi::AFTER_DRAIN) { E.fused(acc, cur, wr, wc, fr, fq, lds, wid, lane); S.done(cur); }
#undef PG8_SA
#undef PG8_SB
#undef PG8_STAGE
#undef PG8_LDA
#undef PG8_LDB
#undef PG8_MMA
#undef PG8_WAIT_V
#undef PG8_WAIT_L
#undef PG8_BAR
#undef PG8_SCHED
}
}

#define KV_DECL uint4 rk0, rk1, rk2, rk3, rv0, rv1, rv2, rv3
#define KV_LOAD(kb_, dil_) do { const int kk_ = lane >> 3; \
    const bf16_t* p0_ = qkv + (rowb + min(max((kb_) + (dil_) * kk_, 0), S - 1)) * ld + (lane & 7) * 8; \
    const bf16_t* p1_ = qkv + (rowb + min(max((kb_) + (dil_) * (kk_ + 8), 0), S - 1)) * ld + (lane & 7) * 8; \
    const bf16_t* p2_ = qkv + (rowb + min(max((kb_) + (dil_) * (kk_ + 16), 0), S - 1)) * ld + (lane & 7) * 8; \
    const bf16_t* p3_ = qkv + (rowb + min(max((kb_) + (dil_) * (kk_ + 24), 0), S - 1)) * ld + (lane & 7) * 8; \
    rk0 = *(const uint4*)(p0_ + kcol); rk1 = *(const uint4*)(p1_ + kcol); rk2 = *(const uint4*)(p2_ + kcol); rk3 = *(const uint4*)(p3_ + kcol); \
    rv0 = *(const uint4*)(p0_ + vcol); rv1 = *(const uint4*)(p1_ + vcol); rv2 = *(const uint4*)(p2_ + vcol); rv3 = *(const uint4*)(p3_ + vcol); } while (0)
#define KV_STORE() do { char* wp_ = vl + (lane >> 3) * 144 + (lane & 7) * 16; \
    *(uint4*)(wp_) = rk0; *(uint4*)(wp_ + 8 * 144) = rk1; *(uint4*)(wp_ + 16 * 144) = rk2; *(uint4*)(wp_ + 24 * 144) = rk3; \
    *(uint4*)(wp_ + 4608) = rv0; *(uint4*)(wp_ + 4608 + 8 * 144) = rv1; *(uint4*)(wp_ + 4608 + 16 * 144) = rv2; *(uint4*)(wp_ + 4608 + 24 * 144) = rv3; } while (0)

DI bf16x8 v_frag(const char* vbase, int s, int dt) {
    typedef __attribute__((address_space(3))) v4i16_t* lp_t;
    const char* a = vbase + s * (16 * 144) + dt * 64;
    const s16x4 lo = __builtin_bit_cast(s16x4, __builtin_amdgcn_ds_read_tr16_b64_v4i16((lp_t)(a)));
    const s16x4 hi = __builtin_bit_cast(s16x4, __builtin_amdgcn_ds_read_tr16_b64_v4i16((lp_t)(a + 8 * 144)));
    return __builtin_shufflevector(lo, hi, 0, 1, 2, 3, 4, 5, 6, 7);
}

template <int OFF> DI bf16x8 pack8v(const f32x16& p) {
    typedef unsigned u32x4 __attribute__((ext_vector_type(4)));
    u32x4 w; w[0] = pk2(p[OFF + 0], p[OFF + 1]); w[1] = pk2(p[OFF + 2], p[OFF + 3]); w[2] = pk2(p[OFF + 4], p[OFF + 5]); w[3] = pk2(p[OFF + 6], p[OFF + 7]);
    return __builtin_bit_cast(bf16x8, w);
}

DI void win_attn_wave(bf16_t* qkv, int ld, int b, int qcol, int kcol, int vcol, int tq0, int qstride,
                      float slope2, float m_init, float l_init, int mode, char* vl, int lane, bool dry) {
    const int r = lane & 31, h = lane >> 5;
    const size_t rowb = (size_t)b * S;
    const int tq = tq0 + qstride * r;
    const int tqlast = tq0 + qstride * 31;
    bf16x8 qf[4];
    {
        const bf16_t* qp = qkv + (rowb + tq) * ld + qcol + h * 32;
#pragma unroll
        for (int ks = 0; ks < 4; ++ks) qf[ks] = *(const bf16x8*)(qp + ks * 8);
    }
    f32x16 o0, o1;
#pragma unroll
    for (int i = 0; i < 16; ++i) { o0[i] = 0.f; o1[i] = 0.f; }
    float m = m_init, l = (h == 0) ? l_init : 0.f;
    const float sc2 = 0.125f * LOG2E;
    const int i16 = lane & 15;
    const char* vbase = vl + 4608 + (4 * h + (i16 >> 2)) * 144 + (16 * ((lane >> 4) & 1) + 4 * (i16 & 3)) * 2;
    const int npat = mode ? 3 : 1;
    const char* kfp = vl + r * 144 + h * 64;
    KV_DECL;
    for (int pi = 0; pi < npat; ++pi) {
        int dil, W, kfirst, nt;
        if (!mode) { dil = 1; W = 127; kfirst = tq0 - 128; nt = 5; }
        else if (pi == 0) { dil = 1; W = 128; kfirst = tq0 - 128; nt = 20; }
        else if (pi == 1) { dil = 4; W = 512; kfirst = tq0 - 512; nt = 8; }
        else { dil = 16; W = 2048; kfirst = tq0 - 2048; nt = 5; }
        const int step = 32 * dil;
        int t0 = 0;
        { const int need = -kfirst - 31 * dil; if (need > 0) t0 = (need + step - 1) / step; }
        if (t0 >= nt) continue;
        KV_LOAD(kfirst + t0 * step, dil);
        for (int tile = t0; tile < nt; ++tile) {
            const int kb = kfirst + tile * step;
            KV_STORE();
            asm volatile("" ::: "memory");
            if (tile + 1 < nt) KV_LOAD(kb + step, dil);
            f32x16 s;
#pragma unroll
            for (int i = 0; i < 16; ++i) s[i] = 0.f;
#pragma unroll
            for (int ks = 0; ks < 4; ++ks) s = MFMA(*(const bf16x8*)(kfp + ks * 16), qf[ks], s);
            f32x16 sv; float mloc = -INFINITY;
            const int d0 = tq - kb - 4 * h * dil;
            const unsigned wlim = (unsigned)min(W, tq);
#pragma unroll
            for (int i = 0; i < 16; ++i) {
                const int diff = d0 - dil * crow(i, 0);
                const float sb = s[i] * sc2 - slope2 * (float)diff;
                sv[i] = ((unsigned)diff <= wlim) ? sb : -INFINITY;
                mloc = fmaxf(mloc, sv[i]);
            }
            mloc = fmaxf(mloc, __shfl_xor(mloc, 32));
            const float mn = fmaxf(m, mloc);
            float ps = 0.f;
#pragma unroll
            for (int i = 0; i < 16; ++i) { sv[i] = fexp2(sv[i] - mn); ps += sv[i]; }
            if (__builtin_amdgcn_ballot_w64(mn != m) != 0) {
                const float alpha = fexp2(m - mn);
                l *= alpha;
#pragma unroll
                for (int i = 0; i < 16; ++i) { o0[i] *= alpha; o1[i] *= alpha; }
                m = mn;
            }
            l += ps;
            const bf16x8 p0 = pack8v<0>(sv), p1 = pack8v<8>(sv);
            o0 = MFMA(v_frag(vbase, 0, 0), p0, o0);
            o0 = MFMA(v_frag(vbase, 1, 0), p1, o0);
            o1 = MFMA(v_frag(vbase, 0, 1), p0, o1);
            o1 = MFMA(v_frag(vbase, 1, 1), p1, o1);
            asm volatile("" ::: "memory");
        }
    }
    const float lt = l + __shfl_xor(l, 32);
    const float inv = 1.f / lt;
    if (dry) { if (o0[0] + o1[0] + lt == 12345.678f) qkv[0] = 1; return; }
    bf16_t* op = qkv + (rowb + tq) * ld + qcol + 4 * h;
#pragma unroll
    for (int g = 0; g < 4; ++g) {
        *(uint2*)(op + 8 * g) = make_uint2(pk2(o0[4 * g] * inv, o0[4 * g + 1] * inv), pk2(o0[4 * g + 2] * inv, o0[4 * g + 3] * inv));
        *(uint2*)(op + 32 + 8 * g) = make_uint2(pk2(o1[4 * g] * inv, o1[4 * g + 1] * inv), pk2(o1[4 * g + 2] * inv, o1[4 * g + 3] * inv));
    }
}

DI void stick_wave(bf16_t* qkv, int ld, int b, int qcol, int kcol, int vcol, int qt, char* vl, int lane, bool dry) {
    const int r = lane & 31, h = lane >> 5;
    const size_t rowb = (size_t)b * S;
    const int tq = qt * 32 + r;
    bf16x8 qf[4];
    {
        const bf16_t* qp = qkv + (rowb + tq) * ld + qcol + h * 32;
#pragma unroll
        for (int ks = 0; ks < 4; ++ks) qf[ks] = *(const bf16x8*)(qp + ks * 8);
    }
    f32x16 o0, o1;
#pragma unroll
    for (int i = 0; i < 16; ++i) { o0[i] = 0.f; o1[i] = 0.f; }
    float R = 1.f;
    const int i16 = lane & 15;
    const char* vbase = vl + 4608 + (4 * h + (i16 >> 2)) * 144 + (16 * ((lane >> 4) & 1) + 4 * (i16 & 3)) * 2;
    const char* kfp = vl + r * 144 + h * 64;
    KV_DECL;
    KV_LOAD(qt * 32, 1);
    for (int tile = qt; tile >= 0; --tile) {
        KV_STORE();
        asm volatile("" ::: "memory");
        if (tile > 0) KV_LOAD((tile - 1) * 32, 1);
        f32x16 s;
#pragma unroll
        for (int i = 0; i < 16; ++i) s[i] = 0.f;
#pragma unroll
        for (int ks = 0; ks < 4; ++ks) s = MFMA(*(const bf16x8*)(kfp + ks * 16), qf[ks], s);
        const bool diag = (tile == qt);
        f32x16 sg, kp;
#pragma unroll
        for (int i = 0; i < 16; ++i) {
            const float z2 = fminf(s[i] * (0.125f * LOG2E), 80.f);
            const float t = fexp2(z2);
            const float k = __builtin_amdgcn_rcpf(1.f + t);
            kp[i] = k; sg[i] = t * k;
        }
        if (diag) {
#pragma unroll
            for (int i = 0; i < 16; ++i) { const bool strict = crow(i, h) < r; kp[i] = strict ? kp[i] : 1.f; sg[i] = strict ? sg[i] : 0.f; }
        }
        float G[4], PG[4], both[4];
#pragma unroll
        for (int g = 0; g < 4; ++g) { G[g] = (kp[4 * g] * kp[4 * g + 1]) * (kp[4 * g + 2] * kp[4 * g + 3]); PG[g] = __shfl_xor(G[g], 32); both[g] = G[g] * PG[g]; }
        float Sx[4];
        Sx[3] = 1.f; Sx[2] = both[3]; Sx[1] = both[3] * both[2]; Sx[0] = Sx[1] * both[1];
        f32x16 a;
#pragma unroll
        for (int g = 0; g < 4; ++g) {
            float la = R * Sx[g] * (h == 0 ? PG[g] : 1.f);
#pragma unroll
            for (int j = 3; j >= 0; --j) {
                a[4 * g + j] = sg[4 * g + j] * la;
                la *= kp[4 * g + j];
            }
        }
        R *= Sx[0] * both[0];
        const bf16x8 p0 = pack8v<0>(a), p1 = pack8v<8>(a);
        o0 = MFMA(v_frag(vbase, 0, 0), p0, o0);
        o0 = MFMA(v_frag(vbase, 1, 0), p1, o0);
        o1 = MFMA(v_frag(vbase, 0, 1), p0, o1);
        o1 = MFMA(v_frag(vbase, 1, 1), p1, o1);
        asm volatile("" ::: "memory");
        if (__builtin_amdgcn_ballot_w64(R >= 1.17549435e-38f) == 0) break;
    }
    if (dry) { if (o0[0] + o1[0] == 12345.678f) qkv[0] = 1; return; }
    bf16_t* op = qkv + (rowb + tq) * ld + qcol + 4 * h;
#pragma unroll
    for (int g = 0; g < 4; ++g) {
        *(uint2*)(op + 8 * g) = make_uint2(pk2(o0[4 * g], o0[4 * g + 1]), pk2(o0[4 * g + 2], o0[4 * g + 3]));
        *(uint2*)(op + 32 + 8 * g) = make_uint2(pk2(o1[4 * g], o1[4 * g + 1]), pk2(o1[4 * g + 2], o1[4 * g + 3]));
    }
}

DI void attn_even_phase(const Params& P, char* smem, bool dry) {
    const int tid_ = otid(); const int lane = tid_ & 63, wid = tid_ >> 6;
    bf16_t* qkv = (bf16_t*)(P.ws + OFF_BIG);
    char* vl = smem + wid * 9216;
    for (int it = blockIdx.x * 8 + wid; it < 2048 + 4096; it += gridDim.x * 8) {
        if (it < 2048) {
            const int bh = it >> 6, p = it & 63; const int b = bh >> 3, head = bh & 7;
            stick_wave(qkv, 2304, b, 512 + head * 64, 1280 + head * 64, 1792 + head * 64, 127 - p, vl, lane, dry);
            stick_wave(qkv, 2304, b, 512 + head * 64, 1280 + head * 64, 1792 + head * 64, p, vl, lane, dry);
        } else {
            const int v = it - 2048; const int g = v & 3; const int qt = (v >> 2) & 127; const int rest = v >> 9; const int b = rest >> 1, kvh = rest & 1;
            const int head = kvh * 4 + g;
            const float slope = exp2f(-(float)(head + 1));
            const float sink = P.in[9][head];
            win_attn_wave(qkv, 2304, b, head * 64, 1024 + kvh * 64, 1152 + kvh * 64, qt * 32, 1, slope * LOG2E, sink * LOG2E, 1.f, 0, vl, lane, dry);
        }
    }
}

DI void attn_odd_phase(const Params& P, char* smem, bool dry) {
    const int tid_ = otid(); const int lane = tid_ & 63, wid = tid_ >> 6;
    bf16_t* qkv = (bf16_t*)(P.ws + OFF_BIG);
    char* vl = smem + wid * 9216;
    for (int it = blockIdx.x * 8 + wid; it < 8192; it += gridDim.x * 8) {
        const int res16 = it & 15; const int u0 = ((it >> 4) & 7) * 32; const int head = (it >> 7) & 15; const int b = it >> 11;
        const float slope = exp2f(-0.5f * (float)(head + 1));
        win_attn_wave(qkv, 3072, b, head * 64, 1024 + head * 64, 2048 + head * 64, res16 + 16 * u0, 16, slope * LOG2E, -1e30f, 0.f, 1, vl, lane, dry);
    }
}

DI void xattn_wave(bf16_t* qb, const bf16_t* Kn, const bf16_t* VT, const float* qg, float kmax2, int b, int head, int tok0, char* ql, int lane, bool dry) {
    const int r = lane & 31, h = lane >> 5;
    const size_t token = (size_t)b * S + tok0 + r;
    bf16_t* qp = qb + token * D + head * 256 + h * 128;
    float ss = 0.f;
#pragma unroll
    for (int ks = 0; ks < 16; ++ks) {
        const uint4 v = *(const uint4*)(qp + ks * 8);
        const unsigned w[4] = {v.x, v.y, v.z, v.w};
#pragma unroll
        for (int e = 0; e < 4; ++e) { const float a = bflo(w[e]), c = bfhi(w[e]); ss += a * a + c * c; }
    }
    ss += __shfl_xor(ss, 32);
    const float inv = __builtin_amdgcn_rsqf(ss * (1.f / 256.f) + EPS);
    float qq2 = 0.f;
#pragma unroll
    for (int ks = 0; ks < 16; ++ks) {
        const uint4 v = *(const uint4*)(qp + ks * 8);
        const float4 g0 = *(const float4*)(qg + h * 128 + ks * 8), g1 = *(const float4*)(qg + h * 128 + ks * 8 + 4);
        uint4 o;
        o.x = pk2(bflo(v.x) * inv * g0.x, bfhi(v.x) * inv * g0.y); o.y = pk2(bflo(v.y) * inv * g0.z, bfhi(v.y) * inv * g0.w);
        o.z = pk2(bflo(v.z) * inv * g1.x, bfhi(v.z) * inv * g1.y); o.w = pk2(bflo(v.w) * inv * g1.z, bfhi(v.w) * inv * g1.w);
        qq2 += bflo(o.x) * bflo(o.x) + bfhi(o.x) * bfhi(o.x) + bflo(o.y) * bflo(o.y) + bfhi(o.y) * bfhi(o.y)
             + bflo(o.z) * bflo(o.z) + bfhi(o.z) * bfhi(o.z) + bflo(o.w) * bflo(o.w) + bfhi(o.w) * bfhi(o.w);
        *(uint4*)(ql + (ks * 64 + lane) * 16) = o;
    }
    qq2 += __shfl_xor(qq2, 32);
    asm volatile("" ::: "memory");
    const float sc2 = 0.0625f * LOG2E;
    const bf16_t* kp0 = Kn + ((size_t)(b * 4 + head) * 8 * 16 * 64 + lane) * 8;
    const float m = __builtin_amdgcn_sqrtf(qq2 * kmax2) * 1.001f;
    float l = 0.f;
    bf16x8 pf[8][2];
    bf16x8 kc[16], kn[16];
#pragma unroll
    for (int ks = 0; ks < 16; ++ks) kc[ks] = *(const bf16x8*)(kp0 + ks * 512);
#pragma unroll
    for (int tile = 0; tile < 8; ++tile) {
        if (tile < 7) {
#pragma unroll
            for (int ks = 0; ks < 16; ++ks) kn[ks] = *(const bf16x8*)(kp0 + (size_t)(tile + 1) * 16 * 512 + ks * 512);
        }
        f32x16 s, s_b;
#pragma unroll
        for (int i = 0; i < 16; ++i) { s[i] = 0.f; s_b[i] = 0.f; }
#pragma unroll
        for (int ks = 0; ks < 16; ks += 2) {
            const bf16x8 qf0 = *(const bf16x8*)(ql + (ks * 64 + lane) * 16);
            const bf16x8 qf1 = *(const bf16x8*)(ql + ((ks + 1) * 64 + lane) * 16);
            s = MFMA(kc[ks], qf0, s);
            s_b = MFMA(kc[ks + 1], qf1, s_b);
        }
#pragma unroll
        for (int i = 0; i < 16; ++i) s[i] += s_b[i];
#pragma unroll
        for (int i = 0; i < 16; ++i) { s[i] = fexp2((s[i] - m) * sc2); l += s[i]; }
        pf[tile][0] = pack8v<0>(s); pf[tile][1] = pack8v<8>(s);
#pragma unroll
        for (int ks = 0; ks < 16; ++ks) kc[ks] = kn[ks];
    }
    l += __shfl_xor(l, 32);
    const float il = 1.f / l;
    bf16_t* op = qb + token * D + head * 256 + 4 * h;
    const bf16_t* vp0 = VT + (((size_t)(b * 4 + head) * 8 * 8 * 2 * 64) + lane) * 8;
    bf16x8 vc[16], vn[16];
#pragma unroll
    for (int e = 0; e < 16; ++e) vc[e] = *(const bf16x8*)(vp0 + e * 512);
#pragma unroll 1
    for (int dt = 0; dt < 8; ++dt) {
        const int dn = dt < 7 ? dt + 1 : 7;
#pragma unroll
        for (int e = 0; e < 16; ++e) vn[e] = *(const bf16x8*)(vp0 + (size_t)dn * 16 * 512 + e * 512);
        f32x16 o, o_b;
#pragma unroll
        for (int i = 0; i < 16; ++i) { o[i] = 0.f; o_b[i] = 0.f; }
#pragma unroll
        for (int tile = 0; tile < 8; ++tile) { o = MFMA(vc[tile * 2], pf[tile][0], o); o_b = MFMA(vc[tile * 2 + 1], pf[tile][1], o_b); }
#pragma unroll
        for (int i = 0; i < 16; ++i) o[i] += o_b[i];
#pragma unroll
        for (int g = 0; g < 4; ++g)
            if (dry) { if (o[4 * g] == 12345.678f) qb[0] = 1; } else *(uint2*)(op + dt * 32 + 8 * g) = make_uint2(pk2(o[4 * g] * il, o[4 * g + 1] * il), pk2(o[4 * g + 2] * il, o[4 * g + 3] * il));
#pragma unroll
        for (int e = 0; e < 16; ++e) vc[e] = vn[e];
    }
}

DI void xattn_block(bf16_t* qb, const bf16_t* KF, const bf16_t* VF, const float* qg, float kmax2, int b, int head, int qblk, char* smem, int lane, int wid) {
    const int r = lane & 31, h = lane >> 5;
    const size_t token = (size_t)b * S + qblk * 256 + wid * 32 + r;
    bf16_t* qp = qb + token * D + head * 256 + h * 128;
    const bf16_t* kbase = KF + (size_t)(b * 4 + head) * 8 * 8192;
    const bf16_t* vbase = VF + (size_t)(b * 4 + head) * 8 * 8192;
    const int pc0 = (2 * wid) * 512 + lane * 8, pc1 = pc0 + 512;
    char* ld0 = smem + (2 * wid) * 1024 + lane * 16;
#define XA_ISSUE(u_) do { const int u__ = (u_); const bf16_t* src_ = (u__ < 8) ? kbase + (size_t)u__ * 8192 : vbase + (size_t)(u__ - 8) * 8192; \
        char* dst_ = ld0 + (u__ & 3) * 16384; glds16(src_ + pc0, dst_); glds16(src_ + pc1, dst_ + 1024); } while (0)
    __syncthreads();
    XA_ISSUE(0); XA_ISSUE(1); XA_ISSUE(2);
    uint4 qraw[16];
    float ss = 0.f;
#pragma unroll
    for (int ks = 0; ks < 16; ++ks) {
        qraw[ks] = *(const uint4*)(qp + ks * 8);
        const uint4 v = qraw[ks];
        ss += bflo(v.x) * bflo(v.x) + bfhi(v.x) * bfhi(v.x) + bflo(v.y) * bflo(v.y) + bfhi(v.y) * bfhi(v.y)
            + bflo(v.z) * bflo(v.z) + bfhi(v.z) * bfhi(v.z) + bflo(v.w) * bflo(v.w) + bfhi(v.w) * bfhi(v.w);
    }
    ss += __shfl_xor(ss, 32);
    const float inv = __builtin_amdgcn_rsqf(ss * (1.f / 256.f) + EPS);
    float qq2 = 0.f;
    bf16x8 qf[16];
#pragma unroll
    for (int ks = 0; ks < 16; ++ks) {
        const uint4 v = qraw[ks];
        const float4 g0 = *(const float4*)(qg + h * 128 + ks * 8), g1 = *(const float4*)(qg + h * 128 + ks * 8 + 4);
        uint4 o;
        o.x = pk2(bflo(v.x) * inv * g0.x, bfhi(v.x) * inv * g0.y); o.y = pk2(bflo(v.y) * inv * g0.z, bfhi(v.y) * inv * g0.w);
        o.z = pk2(bflo(v.z) * inv * g1.x, bfhi(v.z) * inv * g1.y); o.w = pk2(bflo(v.w) * inv * g1.z, bfhi(v.w) * inv * g1.w);
        qq2 += bflo(o.x) * bflo(o.x) + bfhi(o.x) * bfhi(o.x) + bflo(o.y) * bflo(o.y) + bfhi(o.y) * bfhi(o.y)
             + bflo(o.z) * bflo(o.z) + bfhi(o.z) * bfhi(o.z) + bflo(o.w) * bflo(o.w) + bfhi(o.w) * bfhi(o.w);
        qf[ks] = __builtin_bit_cast(bf16x8, o);
    }
    qq2 += __shfl_xor(qq2, 32);
    const float sc2 = 0.0625f * LOG2E;
    const float m = __builtin_amdgcn_sqrtf(qq2 * kmax2) * 1.001f;
    float l = 0.f;
    bf16x8 pf[8][2];
    const char* fr0 = smem + lane * 16;
#pragma unroll
    for (int u = 0; u < 8; ++u) {
        asm volatile("s_waitcnt vmcnt(4)" ::: "memory");
        __builtin_amdgcn_s_barrier();
        XA_ISSUE(u + 3);
        const char* sl = fr0 + (u & 3) * 16384;
        f32x16 s, s_b;
#pragma unroll
        for (int i = 0; i < 16; ++i) { s[i] = 0.f; s_b[i] = 0.f; }
#pragma unroll
        for (int ks = 0; ks < 16; ks += 2) {
            s = MFMA(*(const bf16x8*)(sl + ks * 1024), qf[ks], s);
            s_b = MFMA(*(const bf16x8*)(sl + (ks + 1) * 1024), qf[ks + 1], s_b);
        }
#pragma unroll
        for (int i = 0; i < 16; ++i) { s[i] = fexp2((s[i] + s_b[i] - m) * sc2); l += s[i]; }
        pf[u][0] = pack8v<0>(s); pf[u][1] = pack8v<8>(s);
    }
    l += __shfl_xor(l, 32);
    const float il = 1.f / l;
    bf16_t* op = qb + token * D + head * 256 + 4 * h;
#pragma unroll 1
    for (int dt = 0; dt < 8; ++dt) {
        if (dt < 6) asm volatile("s_waitcnt vmcnt(4)" ::: "memory");
        else if (dt == 6) asm volatile("s_waitcnt vmcnt(2)" ::: "memory");
        else asm volatile("s_waitcnt vmcnt(0)" ::: "memory");
        __builtin_amdgcn_s_barrier();
        if (dt < 5) XA_ISSUE(dt + 11);
        const char* sl = fr0 + (dt & 3) * 16384;
        f32x16 o, o_b;
#pragma unroll
        for (int i = 0; i < 16; ++i) { o[i] = 0.f; o_b[i] = 0.f; }
#pragma unroll
        for (int tile = 0; tile < 8; ++tile) {
            o = MFMA(*(const bf16x8*)(sl + (tile * 2) * 1024), pf[tile][0], o);
            o_b = MFMA(*(const bf16x8*)(sl + (tile * 2 + 1) * 1024), pf[tile][1], o_b);
        }
#pragma unroll
        for (int g = 0; g < 4; ++g)
            *(uint2*)(op + dt * 32 + 8 * g) = make_uint2(pk2((o[4 * g] + o_b[4 * g]) * il, (o[4 * g + 1] + o_b[4 * g + 1]) * il),
                                                        pk2((o[4 * g + 2] + o_b[4 * g + 2]) * il, (o[4 * g + 3] + o_b[4 * g + 3]) * il));
    }
#undef XA_ISSUE
}

DI void xattn_phase(const Params& P, int l, char* smem, bool dry) {
    const int tid_ = otid(); const int lane = tid_ & 63, wid = tid_ >> 6;
    bf16_t* qb = (bf16_t*)(P.ws + OFF_BIG);
    const bf16_t* KF = (const bf16_t*)(P.ws + OFF_KF + (size_t)l * SZ_MM);
    const bf16_t* VF = (const bf16_t*)(P.ws + OFF_VT + (size_t)l * SZ_MM);
    const float* qg = P.in[19] + l * 256;
    (void)dry;
    for (int it = blockIdx.x; it < 256; it += gridDim.x) {
        const int qblk = it & 15, head = (it >> 4) & 3, b = it >> 6;
        const float kmax2 = ((const float*)(P.ws + OFF_KMAX))[l * 16 + b * 4 + head];
        xattn_block(qb, KF, VF, qg, kmax2, b, head, qblk, smem, lane, wid);
    }
}

DI void knorm_phase(const Params& P) {
    const int tid_ = otid(); const int lane = tid_ & 63, wid = tid_ >> 6;
    for (int u = blockIdx.x * 8 + wid; u < 8192; u += gridDim.x * 8) {
        const int l = u >> 12, row = (u >> 2) & 1023, head = u & 3;
        const bf16_t* kp = (const bf16_t*)(P.ws + OFF_KN + (size_t)l * SZ_MM) + (size_t)row * D + head * 256 + lane * 4;
        const uint2 v = *(const uint2*)kp;
        const float a0 = bflo(v.x), a1 = bfhi(v.x), a2 = bflo(v.y), a3 = bfhi(v.y);
        float ss = a0 * a0 + a1 * a1 + a2 * a2 + a3 * a3;
        ss = wave_sum(ss);
        const float inv = __builtin_amdgcn_rsqf(ss * (1.f / 256.f) + EPS);
        const float4 g = *(const float4*)(P.in[20] + l * 256 + lane * 4);
        const int b = row >> 8, key = row & 255;
        const int h = lane >> 5, ks = (lane & 31) >> 1, j0 = (lane & 1) * 4;
        bf16_t* dp = (bf16_t*)(P.ws + OFF_KF + (size_t)l * SZ_MM) + ((((((size_t)(b * 4 + head) * 8 + (key >> 5)) * 16 + ks) * 64) + h * 32 + (key & 31)) << 3) + j0;
        const unsigned w0_ = pk2(a0 * inv * g.x, a1 * inv * g.y), w1_ = pk2(a2 * inv * g.z, a3 * inv * g.w);
        *(uint2*)dp = make_uint2(w0_, w1_);
        float kk2 = bflo(w0_) * bflo(w0_) + bfhi(w0_) * bfhi(w0_) + bflo(w1_) * bflo(w1_) + bfhi(w1_) * bfhi(w1_);
        kk2 = wave_sum(kk2);
        if (lane == 0) atomicMax((unsigned*)(P.ws + OFF_KMAX) + l * 16 + b * 4 + head, __float_as_uint(kk2));
    }
}

DI void fast_grid_sync(unsigned* bar, unsigned target) {
    asm volatile("s_waitcnt vmcnt(0) lgkmcnt(0)" ::: "memory");
    __syncthreads();
    if (threadIdx.x == 0) {
        __builtin_amdgcn_fence(__ATOMIC_RELEASE, "agent");
        asm volatile("s_waitcnt vmcnt(0)" ::: "memory");
        __hip_atomic_fetch_add(bar, 1u, __ATOMIC_RELAXED, __HIP_MEMORY_SCOPE_AGENT);
        while (__hip_atomic_load(bar, __ATOMIC_RELAXED, __HIP_MEMORY_SCOPE_AGENT) < target) __builtin_amdgcn_s_sleep(2);
        __builtin_amdgcn_fence(__ATOMIC_ACQUIRE, "agent");
        asm volatile("s_waitcnt vmcnt(0)" ::: "memory");
    }
    __syncthreads();
}

__global__ void __launch_bounds__(512) fwd_megakernel(Params P) {
    extern __shared__ __attribute__((aligned(16))) char smem[];
    cg::grid_group grid = cg::this_grid();
    unsigned nbar = 0;
#pragma unroll 1
    for (int ph = 0; ph < 21; ++ph) {
        float* ssq = (float*)(P.ws + OFF_SSQ);
        bf16_t* xb = (bf16_t*)(P.ws + OFF_XB);
        bf16_t* big = (bf16_t*)(P.ws + OFF_BIG);
        int nrep = 1;
        if (ph > 0) { const int s_ = (ph - 1) % 10; const int kind = (s_ == 3) ? 2 : (s_ == 6) ? 4 : 1; if (PROBE_MASK & kind) nrep = 2; }
        for (int rep = 0; rep < nrep; ++rep) {
        const bool dry = rep + 1 < nrep;
        if (ph == 0) {
            phase0(P, smem);
        } else {
            const int l = (ph - 1) / 10, s = (ph - 1) % 10;
            if (s == 3) {
                if (l == 0) attn_even_phase(P, smem, dry); else attn_odd_phase(P, smem, dry);
            } else if (s == 6) {
                xattn_phase(P, l, smem, dry);
            } else {
                pg8::Gemm g; pg8::Epi E;
                g.A = xb; g.lda = D; g.K = D; g.M = T; g.N = D; g.Bt = nullptr;
                E.mode = 1; E.rs = nullptr; E.O = big; E.ldo = D; E.xin = nullptr; E.xout = nullptr; E.xb = xb; E.ssq_out = ssq; E.alpha = 1.f;
                E.qg = nullptr; E.kg = nullptr; E.qn_end = 0; E.kn_beg = 0; E.kn_end = 0;
                if (s == 0 || s == 8) {
                    g.Bt = (const bf16_t*)(P.ws + (s == 0 ? OFF_GU1 : OFF_GU2) + (size_t)l * SZ_GU); g.N = NGU;
                    E.mode = 0; E.rs = ssq + (size_t)(4 * l + (s == 0 ? 0 : 3)) * T; E.ldo = DFF;
                } else if (s == 1 || s == 9) {
                    g.A = big; g.lda = DFF; g.K = DFF;
                    g.Bt = (const bf16_t*)(P.ws + (s == 1 ? OFF_DN1 : OFF_DN2) + (size_t)l * SZ_DN);
                    E.alpha = 0.5f; E.ssq_out = ssq + (size_t)(4 * l + (s == 1 ? 1 : 4)) * T;
                    if (ph == 2) E.xin = P.in[0];
                    if (ph == 20) { E.xout = P.out; E.ssq_out = nullptr; }
                } else if (s == 2) {
                    E.mode = 2; E.rs = ssq + (size_t)(4 * l + 1) * T;
                    if (l == 0) { g.Bt = (const bf16_t*)(P.ws + OFF_EVIN); g.N = 2304; E.ldo = 2304; E.qg = P.in[7]; E.kg = P.in[8]; E.qn_end = 512; E.kn_beg = 1024; E.kn_end = 1152; }
                    else { g.Bt = (const bf16_t*)(P.ws + OFF_ODIN); g.N = 3072; E.ldo = 3072; E.qg = P.in[12]; E.kg = P.in[13]; E.qn_end = 1024; E.kn_beg = 1024; E.kn_end = 2048; }
                } else if (s == 4) {
                    g.A = big;
                    if (l == 0) { g.Bt = (const bf16_t*)(P.ws + OFF_EVOUT); g.lda = 2304; }
                    else { g.Bt = (const bf16_t*)(P.ws + OFF_ODOUT); g.lda = 3072; }
                    E.ssq_out = ssq + (size_t)(4 * l + 2) * T;
                } else if (s == 5) {
                    g.Bt = (const bf16_t*)(P.ws + OFF_WQ + (size_t)l * SZ_MM); E.mode = 2; E.rs = ssq + (size_t)(4 * l + 2) * T; E.ldo = D;
                } else {
                    g.A = big; g.Bt = (const bf16_t*)(P.ws + OFF_WO + (size_t)l * SZ_MM); E.ssq_out = ssq + (size_t)(4 * l + 3) * T;
                }
                pg8::StaticOrder So; So.init(T, g.N, (int)gridDim.x, (int)blockIdx.x);
                E.dryrun = 0;
#if PROBE_GEMM
                for (int rep_ = 0; rep_ < 2; ++rep_) {
                pg8::Epi E2 = E;
                if (rep_ == 0) { if (PROBE_GEMM == 1) E2.dryrun = 1; else if (E.mode == 1) { E2.alpha = 0.f; } }
                __syncthreads();
                pg8::gemm_phase<pg8::Epi, pg8::StaticOrder, true, true>((PG8_LAS unsigned char*)smem, g, So, rep_ == 0 ? E2 : E);
                ++nbar; fast_grid_sync((unsigned*)(P.ws + OFF_BAR), nbar * gridDim.x);
                }
#else
                __syncthreads();
                pg8::gemm_phase<pg8::Epi, pg8::StaticOrder, true, true>((PG8_LAS unsigned char*)smem, g, So, E);
#endif
                if (ph == 1) {
                    GJob J;
                    J.A = xb; J.lda = D; J.ksplit = 1 << 30; J.kextra = 0; J.K = D; J.ntm = 4; J.mode = 3; J.rs = nullptr;
                    J.O = big; J.ldo = D; J.xin = P.out; J.xout = P.out; J.xb = xb; J.ssq_out = ssq; J.alpha = 1.f;
                    J.qg = nullptr; J.kg = nullptr; J.qn_end = 0; J.kn_end = 0; J.vt = nullptr; J.W = nullptr; J.ntn = 8;
                    gemm_phase(J, 0, 64, P, smem, false);
                }
                if (ph == 2 && !dry) knorm_phase(P);
            }
        }
        if (P.ws == nullptr) grid.sync();
        if (ph < 20) { ++nbar; fast_grid_sync((unsigned*)(P.ws + OFF_BAR), nbar * gridDim.x); }
        }
    }
}

extern "C" void kernel_launch(void* const* d_in, const int* in_sizes, int n_in, void* d_out, int out_size, void* d_ws, size_t ws_size,
                              hipStream_t stream) {
    static int grid_blocks = 0;
    if (!grid_blocks) {
        int dev = 0, cus = 0, per_cu = 0;
        hipGetDevice(&dev);
        hipDeviceGetAttribute(&cus, hipDeviceAttributeMultiprocessorCount, dev);
        hipFuncSetAttribute((const void*)fwd_megakernel, hipFuncAttributeMaxDynamicSharedMemorySize, LDS_BYTES);
        hipOccupancyMaxActiveBlocksPerMultiprocessor(&per_cu, fwd_megakernel, NTHR, LDS_BYTES);
        if (per_cu < 1) per_cu = 1;
        if (per_cu > 1) per_cu = 1;
        grid_blocks = cus * per_cu;
    }
    if (ws_size < WS_NEED) { fprintf(stderr, "workspace too small: %zu < %zu\n", ws_size, (size_t)WS_NEED); return; }
    Params p{};
    for (int i = 0; i < 25; ++i) p.in[i] = (const float*)d_in[i];
    p.out = (float*)d_out; p.ws = (char*)d_ws;
    hipMemsetAsync((char*)d_ws + OFF_BAR, 0, 256, stream);
    void* args[] = {&p};
    hipError_t e = hipLaunchCooperativeKernel((void*)fwd_megakernel, dim3(grid_blocks), dim3(NTHR), args, LDS_BYTES, stream);
    if (e != hipSuccess) fprintf(stderr, "cooperative launch failed: %s (grid %d)\n", hipGetErrorString(e), grid_blocks);
}
```

```cpp
#include <hip/hip_runtime.h>
#include <hip/hip_cooperative_groups.h>
#include <cstdio>
#include <cstdint>
namespace cg = cooperative_groups;

#define DI __device__ __forceinline__
typedef unsigned short bf16_t;
typedef short bf16x8 __attribute__((ext_vector_type(8)));
typedef short s16x4 __attribute__((ext_vector_type(4)));
typedef float f32x16 __attribute__((ext_vector_type(16)));
typedef __bf16 bf2_t __attribute__((ext_vector_type(2)));
typedef float f2_t __attribute__((ext_vector_type(2)));
typedef short v4i16_t __attribute__((ext_vector_type(4)));
#define MFMA(a, b, c) __builtin_amdgcn_mfma_f32_32x32x16_bf16((a), (b), (c), 0, 0, 0)

constexpr int T = 16384, S = 4096, D = 1024, DFF = 2816, NGU = 5632;
constexpr float EPS = 1e-6f;
constexpr float LOG2E = 1.4426950408889634f;
constexpr float LN2 = 0.6931471805599453f;

constexpr size_t SZ_GU = (size_t)NGU * D * 2, SZ_DN = (size_t)D * DFF * 2, SZ_MM = (size_t)D * D * 2;
constexpr size_t OFF_GU1 = 0;
constexpr size_t OFF_DN1 = OFF_GU1 + 2 * SZ_GU;
constexpr size_t OFF_GU2 = OFF_DN1 + 2 * SZ_DN;
constexpr size_t OFF_DN2 = OFF_GU2 + 2 * SZ_GU;
constexpr size_t OFF_WQ = OFF_DN2 + 2 * SZ_DN;
constexpr size_t OFF_WKV = OFF_WQ + 2 * SZ_MM;
constexpr size_t OFF_WO = OFF_WKV + 4 * SZ_MM;
constexpr size_t OFF_EVIN = OFF_WO + 2 * SZ_MM;
constexpr size_t OFF_EVOUT = OFF_EVIN + (size_t)2304 * D * 2;
constexpr size_t OFF_ODIN = OFF_EVOUT + SZ_MM;
constexpr size_t OFF_ODOUT = OFF_ODIN + (size_t)3072 * D * 2;
constexpr size_t OFF_XB = OFF_ODOUT + SZ_MM;
constexpr size_t OFF_BIG = OFF_XB + (size_t)T * D * 2;
constexpr size_t OFF_MEMB = OFF_BIG + (size_t)T * 3072 * 2;
constexpr size_t OFF_KN = OFF_MEMB + SZ_MM;
constexpr size_t OFF_VT = OFF_KN + 2 * SZ_MM;
constexpr size_t OFF_SSQ = OFF_VT + 2 * SZ_MM;
constexpr size_t OFF_SSQM = OFF_SSQ + (size_t)9 * T * 4;
constexpr size_t OFF_KMAX = OFF_SSQM + 4096;
constexpr size_t OFF_BAR = OFF_KMAX + 256;
constexpr size_t OFF_KF = OFF_BAR + 256;
constexpr size_t WS_NEED = OFF_KF + 2 * SZ_MM;

#ifndef PROBE_MASK
#define PROBE_MASK 0
#endif
#ifndef PROBE_GEMM
#define PROBE_GEMM 0
#endif
constexpr int NTHR = 512;
constexpr int NST = 4;
constexpr int STAGE_B = 32768;
constexpr int OPB = 16384;
constexpr int LDS_BYTES = 147456;

struct Params { const float* in[25]; float* out; char* ws; };

DI unsigned pk2(float a, float b) { f2_t v = {a, b}; bf2_t r = __builtin_convertvector(v, bf2_t); return __builtin_bit_cast(unsigned, r); }
DI float bflo(unsigned w) { return __uint_as_float(w << 16); }
DI float bfhi(unsigned w) { return __uint_as_float(w & 0xffff0000u); }
DI int otid() { int t = threadIdx.x; asm volatile("" : "+v"(t)); return t; }
DI int crow(int i, int h) { return (i & 3) + 8 * (i >> 2) + 4 * h; }
DI float fexp2(float x) { return __builtin_amdgcn_exp2f(x); }
DI float flog2(float x) { return __builtin_amdgcn_logf(x); }

struct WJob { const float* src; bf16_t* dst; const float* gain; int K, N, gu; };

DI int wjob_tiles(int j) {
    if (j < 14) {
        const int kind = j >> 1;
        switch (kind) {
            case 0: case 2: return 16 * 88;
            case 1: case 3: return 44 * 16;
            case 4: return 256;
            case 5: return 512;
            default: return 256;
        }
    }
    if (j == 14) return 16 * 36;
    if (j == 16) return 16 * 48;
    return 256;
}

DI WJob get_wjob(const Params& P, int j) {
    WJob w; w.gain = nullptr; w.gu = 0;
    bf16_t* wsb = (bf16_t*)P.ws;
    if (j < 14) {
        const int kind = j >> 1, l = j & 1;
        switch (kind) {
            case 0: w.src = P.in[3] + (size_t)l * D * NGU; w.dst = (bf16_t*)(P.ws + OFF_GU1 + l * SZ_GU); w.gain = P.in[2] + l * D; w.K = D; w.N = NGU; w.gu = 1; break;
            case 1: w.src = P.in[4] + (size_t)l * DFF * D; w.dst = (bf16_t*)(P.ws + OFF_DN1 + l * SZ_DN); w.K = DFF; w.N = D; w.gu = 2; break;
            case 2: w.src = P.in[23] + (size_t)l * D * NGU; w.dst = (bf16_t*)(P.ws + OFF_GU2 + l * SZ_GU); w.gain = P.in[22] + l * D; w.K = D; w.N = NGU; w.gu = 1; break;
            case 3: w.src = P.in[24] + (size_t)l * DFF * D; w.dst = (bf16_t*)(P.ws + OFF_DN2 + l * SZ_DN); w.K = DFF; w.N = D; w.gu = 2; break;
            case 4: w.src = P.in[17] + (size_t)l * D * D; w.dst = (bf16_t*)(P.ws + OFF_WQ + l * SZ_MM); w.gain = P.in[15] + l * D; w.K = D; w.N = D; w.gu = 2; break;
            case 5: w.src = P.in[18] + (size_t)l * D * 2048; w.dst = (bf16_t*)(P.ws + OFF_WKV + l * 2 * SZ_MM); w.gain = P.in[16] + l * D; w.K = D; w.N = 2048; break;
            default: w.src = P.in[21] + (size_t)l * D * D; w.dst = (bf16_t*)(P.ws + OFF_WO + l * SZ_MM); w.K = D; w.N = D; w.gu = 2; break;
        }
    } else if (j == 14) { w.src = P.in[6]; w.dst = (bf16_t*)(P.ws + OFF_EVIN); w.gain = P.in[5]; w.K = D; w.N = 2304; w.gu = 3; }
    else if (j == 15) { w.src = P.in[10]; w.dst = (bf16_t*)(P.ws + OFF_EVOUT); w.K = D; w.N = D; w.gu = 2; }
    else if (j == 16) { w.src = P.in[11]; w.dst = (bf16_t*)(P.ws + OFF_ODIN); w.gain = P.in[5] + D; w.K = D; w.N = 3072; w.gu = 2; }
    else { w.src = P.in[14]; w.dst = (bf16_t*)(P.ws + OFF_ODOUT); w.K = D; w.N = D; w.gu = 2; }
    (void)wsb;
    return w;
}

DI void wconv_tile(const WJob& w, int t, float* sm, int tid, bool act) {
    const int ntn = w.N >> 6; const int tk = t / ntn, tn = t - tk * ntn;
    if (act) {
#pragma unroll
        for (int p = 0; p < 4; ++p) {
            const int kr = p * 16 + (tid >> 4);
            typedef float f32x4nt __attribute__((ext_vector_type(4)));
            const f32x4nt v = __builtin_nontemporal_load((const f32x4nt*)(w.src + (size_t)(tk * 64 + kr) * w.N + tn * 64 + (tid & 15) * 4));
            const float g = w.gain ? w.gain[tk * 64 + kr] : 1.f;
            float* sp = sm + kr * 65 + (tid & 15) * 4;
            sp[0] = v[0] * g; sp[1] = v[1] * g; sp[2] = v[2] * g; sp[3] = v[3] * g;
        }
    }
    __syncthreads();
    if (act) {
        const int n = tid >> 2, kq = tid & 3; const int ng = tn * 64 + n;
        int drow = ng;
        if (w.gu == 1) drow = ng < DFF ? ((ng >> 7) * 256 + (ng & 127)) : (((ng - DFF) >> 7) * 256 + 128 + ((ng - DFF) & 127));
        else if (w.gu >= 2) {
            int a = ng;
            if (w.gu == 3) a = ng < 512 ? ng : ng < 768 ? ng + 512 : ng < 1280 ? ng - 256 : ng;
            drow = (a & ~255) + (((a >> 5) & 1) << 7) + (((a >> 6) & 3) << 5) + (a & 31);
        }
        unsigned o[8];
#pragma unroll
        for (int e = 0; e < 8; ++e) o[e] = pk2(sm[(kq * 16 + 2 * e) * 65 + n], sm[(kq * 16 + 2 * e + 1) * 65 + n]);
        uint4* dp = (uint4*)(w.dst + (size_t)drow * w.K + tk * 64 + kq * 16);
        dp[0] = make_uint4(o[0], o[1], o[2], o[3]); dp[1] = make_uint4(o[4], o[5], o[6], o[7]);
    }
    __syncthreads();
}

DI float wave_sum(float v) {
    v += __shfl_xor(v, 1); v += __shfl_xor(v, 2); v += __shfl_xor(v, 4); v += __shfl_xor(v, 8); v += __shfl_xor(v, 16); v += __shfl_xor(v, 32);
    return v;
}

DI void rowconv(const float* src, bf16_t* dst, float* ssq, int row, int lane) {
    const float* xr = src + (size_t)row * D;
    float ss = 0.f;
#pragma unroll
    for (int p = 0; p < 4; ++p) {
        const float4 v = *(const float4*)(xr + p * 256 + lane * 4);
        ss += v.x * v.x + v.y * v.y + v.z * v.z + v.w * v.w;
        *(uint2*)(dst + (size_t)row * D + p * 256 + lane * 4) = make_uint2(pk2(v.x, v.y), pk2(v.z, v.w));
    }
    ss = wave_sum(ss);
    if (lane == 0) ssq[row] = ss;
}

DI void phase0(const Params& P, char* smem) {
    const int tid = otid(), lane = tid & 63, wid = tid >> 6;
    float* ssq = (float*)(P.ws + OFF_SSQ);
    for (int i = blockIdx.x * NTHR + tid; i < 8 * T; i += gridDim.x * NTHR) ssq[T + i] = 0.f;
    if (blockIdx.x == 0 && tid < 32) ((unsigned*)(P.ws + OFF_KMAX))[tid] = 0u;
    constexpr int NW = 12352 / 2, NX = T / 8, NM = 1024 / 8;
    for (int u = blockIdx.x; u < NW + NX + NM; u += gridDim.x) {
        if (u < NW) {
            const int half = tid >> 8;
            int t = 2 * u + half, j = 0;
            for (; j < 17; ++j) { const int c = wjob_tiles(j); if (t < c) break; t -= c; }
            const WJob w = get_wjob(P, j);
            wconv_tile(w, t, (float*)smem + half * (64 * 65), tid & 255, true);
        } else if (u < NW + NX) {
            rowconv(P.in[0], (bf16_t*)(P.ws + OFF_XB), ssq, (u - NW) * 8 + wid, lane);
        } else {
            rowconv(P.in[1], (bf16_t*)(P.ws + OFF_MEMB), (float*)(P.ws + OFF_SSQM), (u - NW - NX) * 8 + wid, lane);
        }
    }
}

struct GJob {
    const bf16_t* A; const bf16_t* W;
    int lda, ksplit, kextra, K, ntm, ntn, mode;
    const float* rs;
    bf16_t* O; int ldo;
    const float* xin; float* xout; bf16_t* xb; float* ssq_out; float alpha;
    const float* qg; const float* kg; int qn_end, kn_end;
    bf16_t* vt;
};

typedef __attribute__((address_space(3))) unsigned* ldsu_t;
typedef const __attribute__((address_space(1))) unsigned* glbu_t;
DI void glds16(const bf16_t* g, char* l) { __builtin_amdgcn_global_load_lds((glbu_t)(const void*)g, (ldsu_t)(void*)l, 16, 0, 0); }

DI void gemm_tile(const GJob& J, int t, char* smem, bool dry) {
    const int tid = otid(), lane = tid & 63, wid = tid >> 6, wr = wid >> 2, wc = wid & 3;
    const int r = lane & 31, h = lane >> 5;
    int tm, tn;
    { const int gsz = 32 * J.ntn; const int g = t / gsz; const int rem = t - g * gsz; const int rows = min(32, J.ntm - g * 32); tn = rem / rows; tm = g * 32 + (rem - tn * rows); }
    const int lrow = wid * 16 + (lane >> 2);
    const int csw = ((lane & 3) ^ ((lane >> 4) & 3)) * 8;
    const bf16_t* Ag = J.A + (size_t)(tm * 256 + lrow) * J.lda + csw;
    const bf16_t* Wg = J.W + (size_t)(tn * 256 + lrow) * J.K + csw;
    const size_t astr = (size_t)128 * J.lda, wstr = (size_t)128 * J.K;
    char* lb = smem + tid * 16;
    const int nk = J.K >> 5;
#define GLDS(kt, buf) do { const int k0_ = (kt) * 32; const int ka_ = k0_ + (k0_ >= J.ksplit ? J.kextra : 0); char* l_ = lb + (buf) * STAGE_B; \
        glds16(Ag + ka_, l_); glds16(Ag + astr + ka_, l_ + 8192); glds16(Wg + k0_, l_ + OPB); glds16(Wg + wstr + k0_, l_ + OPB + 8192); } while (0)
    f32x16 acc[4][2];
#pragma unroll
    for (int a = 0; a < 4; ++a)
#pragma unroll
        for (int b = 0; b < 2; ++b)
#pragma unroll
            for (int i = 0; i < 16; ++i) acc[a][b][i] = 0.f;
    const int fr = (r >> 2) & 3;
    const int xrow = (wc * 64 + r) * 64, wrow = OPB + (wr * 128 + r) * 64;
    const int co0 = ((0 + h) ^ fr) * 16, co1 = ((2 + h) ^ fr) * 16;

    __syncthreads();
    GLDS(0, 0); GLDS(1, 1); GLDS(2, 2);
    asm volatile("s_waitcnt vmcnt(8)" ::: "memory");
    __builtin_amdgcn_s_barrier();
    bf16x8 w0[4], x0[2], w1[4], x1[2];
#define LOADF(W_, X_, sb_, co_) do { _Pragma("unroll") for (int ti = 0; ti < 2; ++ti) X_[ti] = *(const bf16x8*)((sb_) + xrow + ti * 2048 + (co_)); \
        _Pragma("unroll") for (int fi = 0; fi < 4; ++fi) W_[fi] = *(const bf16x8*)((sb_) + wrow + fi * 2048 + (co_)); } while (0)
#define MFMA8(W_, X_) do { __builtin_amdgcn_s_setprio(1); _Pragma("unroll") for (int fi = 0; fi < 4; ++fi) _Pragma("unroll") for (int ti = 0; ti < 2; ++ti) \
        acc[fi][ti] = MFMA(W_[fi], X_[ti], acc[fi][ti]); __builtin_amdgcn_s_setprio(0); } while (0)
    LOADF(w0, x0, smem, co0);
    __builtin_amdgcn_s_waitcnt(0xC07F);
    int buf = 0;
    for (int kt = 0; kt < nk; ++kt) {
        const char* sb = smem + buf * STAGE_B;
        LOADF(w1, x1, sb, co1);
        __builtin_amdgcn_sched_barrier(0);
        MFMA8(w0, x0);
        __builtin_amdgcn_s_waitcnt(0xC07F);
        __builtin_amdgcn_sched_barrier(0);
        const int nb = (buf + 1 == NST) ? 0 : buf + 1;
        if (kt + 1 < nk) {
            if (kt + 2 < nk) asm volatile("s_waitcnt vmcnt(4)" ::: "memory"); else asm volatile("s_waitcnt vmcnt(0)" ::: "memory");
            __builtin_amdgcn_s_barrier();
            if (kt + 3 < nk) { const int fb_ = (buf + 3 >= NST) ? buf + 3 - NST : buf + 3; GLDS(kt + 3, fb_); }
        }
        LOADF(w0, x0, smem + nb * STAGE_B, co0);
        __builtin_amdgcn_sched_barrier(0);
        MFMA8(w1, x1);
        __builtin_amdgcn_s_waitcnt(0xC07F);
        __builtin_amdgcn_sched_barrier(0);
        buf = nb;
    }
#undef LOADF
#undef MFMA8
#undef GLDS
    __syncthreads();

    if (dry) { if (acc[0][0][0] + acc[1][1][0] + acc[2][0][0] + acc[3][1][0] == 12345.678f) J.O[0] = 1; return; }
    const int tokb = tm * 256 + wc * 64;
    const int fb = tn * 256 + wr * 128;
    float rsc[2];
#pragma unroll
    for (int ti = 0; ti < 2; ++ti) rsc[ti] = J.rs ? __builtin_amdgcn_rsqf(J.rs[tokb + ti * 32 + r] * (1.f / 1024.f) + EPS) : 1.f;

    if (J.mode == 3 && fb >= 1024) {
#pragma unroll
        for (int ti = 0; ti < 2; ++ti) {
            const int tok = tokb + ti * 32 + r;
#pragma unroll
            for (int fi = 0; fi < 4; ++fi)
#pragma unroll
                for (int i = 0; i < 16; ++i) {
                    const int f = fb - 1024 + fi * 32 + crow(i, h);
                    const int bh_ = (tok >> 8) * 4 + (f >> 8), d_ = f & 255, key_ = tok & 255, k16 = key_ & 15;
                    const int ln_ = ((k16 >> 2) & 1) * 32 + (d_ & 31), e_ = ((k16 >> 3) << 2) | (k16 & 3);
                    J.vt[((((((size_t)bh_ * 8 + (d_ >> 5)) * 8 + (key_ >> 5)) * 2 + ((key_ >> 4) & 1)) * 64 + ln_) << 3) + e_] = (bf16_t)(pk2(acc[fi][ti][i] * rsc[ti], 0.f) & 0xffffu);
                }
        }
        return;
    }
    char* wl = smem + wid * 16384;
#pragma unroll
    for (int ti = 0; ti < 2; ++ti) {
#pragma unroll
        for (int fp = 0; fp < 2; ++fp) {
            const float sc = (J.mode == 1) ? J.alpha : rsc[ti];
#pragma unroll
            for (int fi2 = 0; fi2 < 2; ++fi2)
#pragma unroll
                for (int g = 0; g < 4; ++g) {
                    float4 v;
                    v.x = acc[2 * fp + fi2][ti][4 * g + 0] * sc; v.y = acc[2 * fp + fi2][ti][4 * g + 1] * sc;
                    v.z = acc[2 * fp + fi2][ti][4 * g + 2] * sc; v.w = acc[2 * fp + fi2][ti][4 * g + 3] * sc;
                    *(float4*)(wl + r * 272 + (fi2 * 32 + 8 * g + 4 * h) * 4) = v;
                }
            const int tok0 = tokb + ti * 32, f0 = fb + fp * 64;
            if (J.mode == 0) {
                const int c4 = (lane & 7) * 4;
#pragma unroll
                for (int p = 0; p < 4; ++p) {
                    const int row = p * 8 + (lane >> 3);
                    const float4 ga = *(const float4*)(wl + row * 272 + c4 * 4);
                    const float4 up = *(const float4*)(wl + row * 272 + (32 + c4) * 4);
                    float y0 = ga.x * up.x * __builtin_amdgcn_rcpf(1.f + fexp2(-ga.x * LOG2E));
                    float y1 = ga.y * up.y * __builtin_amdgcn_rcpf(1.f + fexp2(-ga.y * LOG2E));
                    float y2 = ga.z * up.z * __builtin_amdgcn_rcpf(1.f + fexp2(-ga.z * LOG2E));
                    float y3 = ga.w * up.w * __builtin_amdgcn_rcpf(1.f + fexp2(-ga.w * LOG2E));
                    *(uint2*)(J.O + (size_t)(tok0 + row) * J.ldo + (f0 >> 1) + c4) = make_uint2(pk2(y0, y1), pk2(y2, y3));
                }
            } else if (J.mode == 1) {
                const int c4 = (lane & 15) * 4;
#pragma unroll
                for (int p = 0; p < 8; ++p) {
                    const int row = p * 4 + (lane >> 4);
                    const size_t tok = tok0 + row;
                    const float4 v = *(const float4*)(wl + row * 272 + c4 * 4);
                    const float4 xo = *(const float4*)(J.xin + tok * D + f0 + c4);
                    float4 xn; xn.x = xo.x + v.x; xn.y = xo.y + v.y; xn.z = xo.z + v.z; xn.w = xo.w + v.w;
                    *(float4*)(J.xout + tok * D + f0 + c4) = xn;
                    if (J.xb) {
                        *(uint2*)(J.xb + tok * D + f0 + c4) = make_uint2(pk2(xn.x, xn.y), pk2(xn.z, xn.w));
                        float ss = xn.x * xn.x + xn.y * xn.y + xn.z * xn.z + xn.w * xn.w;
                        ss += __shfl_xor(ss, 1); ss += __shfl_xor(ss, 2); ss += __shfl_xor(ss, 4); ss += __shfl_xor(ss, 8);
                        if ((lane & 15) == 0) atomicAdd(J.ssq_out + tok, ss);
                    }
                }
            } else {
                const int nm = f0 < J.qn_end ? 1 : (f0 < J.kn_end ? 2 : 0);
                const float* gp = nm == 1 ? J.qg : J.kg;
                const int c4 = (lane & 15) * 4;
                float4 gn = make_float4(1.f, 1.f, 1.f, 1.f);
                if (nm) gn = *(const float4*)(gp + c4);
#pragma unroll
                for (int p = 0; p < 8; ++p) {
                    const int row = p * 4 + (lane >> 4);
                    float4 v = *(const float4*)(wl + row * 272 + c4 * 4);
                    if (nm) {
                        float ss = v.x * v.x + v.y * v.y + v.z * v.z + v.w * v.w;
                        ss += __shfl_xor(ss, 1); ss += __shfl_xor(ss, 2); ss += __shfl_xor(ss, 4); ss += __shfl_xor(ss, 8);
                        const float inv = __builtin_amdgcn_rsqf(ss * (1.f / 64.f) + EPS);
                        v.x *= inv * gn.x; v.y *= inv * gn.y; v.z *= inv * gn.z; v.w *= inv * gn.w;
                    }
                    *(uint2*)(J.O + (size_t)(tok0 + row) * J.ldo + f0 + c4) = make_uint2(pk2(v.x, v.y), pk2(v.z, v.w));
                }
            }
        }
    }
}

DI void gemm_phase(const GJob& JA, int nA, int nB, const Params& P, char* smem, bool dry) {
    for (int u = (int)gridDim.x - 1 - (int)blockIdx.x; u < nA + nB; u += gridDim.x) {
        GJob J = JA; int t = u;
        if (u >= nA) {
            const int v = u - nA; const int layer = v >> 5; t = v & 31;
            J.A = (const bf16_t*)(P.ws + OFF_MEMB); J.lda = D; J.ksplit = 1 << 30; J.kextra = 0;
            J.W = (const bf16_t*)(P.ws + OFF_WKV + (size_t)layer * 2 * SZ_MM); J.K = D; J.ntm = 4; J.ntn = 8; J.mode = 3;
            J.rs = (const float*)(P.ws + OFF_SSQM); J.O = (bf16_t*)(P.ws + OFF_KN + (size_t)layer * SZ_MM); J.ldo = D;
            J.qn_end = 0; J.kn_end = 0; J.vt = (bf16_t*)(P.ws + OFF_VT + (size_t)layer * SZ_MM);
        }
        gemm_tile(J, t, smem, dry);
    }
}

namespace pg8 {
#define PG8_LAS __attribute__((address_space(3)))
typedef float f32x4 __attribute__((ext_vector_type(4)));
typedef unsigned u32x4 __attribute__((ext_vector_type(4)));
constexpr int BM = 256, BK = 64, HALF = 128, HTB = HALF * BK * 2, STAGE_BYTES = 8 * HTB, NXCD = 8, WGM = 8;
DI int lds_byte(int r, int c) { const int st = (r >> 4) * 2 + (c >> 5), rr = r & 15, cc = c & 31, ob = rr * 64 + cc * 2; return st * 1024 + (ob ^ (((ob >> 9) & 1) << 5)); }
DI void stage_rc(int b, int& R, int& C) { const int st = b / 1024, sb = b % 1024, swz = sb ^ (((sb >> 9) & 1) << 5); R = (st >> 1) * 16 + swz / 64; C = (st & 1) * 32 + (swz % 64) / 2; }
DI int perm32(int rho) { const int n = rho >> 4, i = rho & 15; return 8 * (i >> 2) + 4 * n + (i & 3); }
struct Unit { int pm, pn; };
struct Gemm { const bf16_t* A; const bf16_t* Bt; int M, N, K, lda; };
struct StaticOrder {
    int nM, nN, nwg, G, c;
    DI void init(int M, int N, int G_, int c_) { nM = M / BM; nN = N / BM; nwg = nM * nN; G = G_; c = c_; }
    DI bool next(int i, Unit& u) const {
        const long L = (long)i * G + c; if (L >= nwg) return false;
        int wgid = (int)L; { const int q = nwg / NXCD, r = nwg % NXCD, xcd = wgid % NXCD, off = wgid / NXCD; wgid = (xcd < r ? xcd * (q + 1) : r * (q + 1) + (xcd - r) * q) + off; }
        const int nig = WGM * nN, gid = wgid / nig, fm = gid * WGM, gsz = (nM - fm) < WGM ? (nM - fm) : WGM;
        u.pm = fm + ((wgid % nig) % gsz); u.pn = (wgid % nig) / gsz; return true;
    }
    DI void a_ready(const Unit&) const {}
    DI void done(const Unit&) const {}
};

struct Epi {
    static constexpr bool PERM = true, AFTER_DRAIN = false;
    int mode;
    const float* rs;
    bf16_t* O; int ldo;
    const float* xin; float* xout; bf16_t* xb; float* ssq_out; float alpha;
    const float* qg; const float* kg; int qn_end, kn_beg, kn_end; int dryrun;
    DI void operator()(const f32x4 (&acc)[2][2][4][2], const Unit& u, int wr, int wc, int fr, int fq) const {
        if (dryrun) { if (acc[0][0][0][0][0] + acc[1][1][3][1][3] + acc[0][1][2][0][1] + acc[1][0][1][1][2] == 12345.678f) O[0] = 1; return; }
        const int row0 = u.pm * BM + wr * 64 + fr;
        if (mode == 0) {
            const int col = u.pn * 128 + wc * 32 + 8 * fq;
#pragma unroll
            for (int ai = 0; ai < 2; ++ai)
#pragma unroll
                for (int m = 0; m < 4; ++m) {
                    const size_t tok = row0 + ai * HALF + m * 16;
                    const float sc = __builtin_amdgcn_rsqf(rs[tok] * (1.f / 1024.f) + EPS);
                    float y[8];
#pragma unroll
                    for (int n = 0; n < 2; ++n)
#pragma unroll
                        for (int j = 0; j < 4; ++j) {
                            const float ga = acc[ai][0][m][n][j] * sc, up = acc[ai][1][m][n][j] * sc;
                            y[4 * n + j] = ga * up * __builtin_amdgcn_rcpf(1.f + fexp2(-ga * LOG2E));
                        }
                    *(uint4*)(O + tok * ldo + col) = make_uint4(pk2(y[0], y[1]), pk2(y[2], y[3]), pk2(y[4], y[5]), pk2(y[6], y[7]));
                }
        } else if (mode == 1) {
#pragma unroll
            for (int ai = 0; ai < 2; ++ai)
#pragma unroll
                for (int m = 0; m < 4; ++m) {
                    const size_t tok = row0 + ai * HALF + m * 16;
                    float ss = 0.f;
#pragma unroll
                    for (int bj = 0; bj < 2; ++bj) {
                        const int col = u.pn * BM + wc * 64 + bj * 32 + 8 * fq;
                        float4 x0, x1;
                        if (xin) { x0 = *(const float4*)(xin + tok * D + col); x1 = *(const float4*)(xin + tok * D + col + 4); }
                        else {
                            const uint4 w = *(const uint4*)(xb + tok * D + col);
                            x0 = make_float4(bflo(w.x), bfhi(w.x), bflo(w.y), bfhi(w.y)); x1 = make_float4(bflo(w.z), bfhi(w.z), bflo(w.w), bfhi(w.w));
                        }
                        float4 n0, n1;
                        n0.x = x0.x + alpha * acc[ai][bj][m][0][0]; n0.y = x0.y + alpha * acc[ai][bj][m][0][1]; n0.z = x0.z + alpha * acc[ai][bj][m][0][2]; n0.w = x0.w + alpha * acc[ai][bj][m][0][3];
                        n1.x = x1.x + alpha * acc[ai][bj][m][1][0]; n1.y = x1.y + alpha * acc[ai][bj][m][1][1]; n1.z = x1.z + alpha * acc[ai][bj][m][1][2]; n1.w = x1.w + alpha * acc[ai][bj][m][1][3];
                        if (xout) { *(float4*)(xout + tok * D + col) = n0; *(float4*)(xout + tok * D + col + 4) = n1; }
                        if (ssq_out) {
                            const uint4 w = make_uint4(pk2(n0.x, n0.y), pk2(n0.z, n0.w), pk2(n1.x, n1.y), pk2(n1.z, n1.w));
                            *(uint4*)(xb + tok * D + col) = w;
                            const float r0 = bflo(w.x), r1 = bfhi(w.x), r2 = bflo(w.y), r3 = bfhi(w.y), r4 = bflo(w.z), r5 = bfhi(w.z), r6 = bflo(w.w), r7 = bfhi(w.w);
                            ss += r0 * r0 + r1 * r1 + r2 * r2 + r3 * r3 + r4 * r4 + r5 * r5 + r6 * r6 + r7 * r7;
                        }
                    }
                    if (ssq_out) {
                        ss += __shfl_xor(ss, 16); ss += __shfl_xor(ss, 32);
                        if (fq == 0) atomicAdd(ssq_out + tok, ss);
                    }
                }
        } else {
            const int f0 = u.pn * BM + wc * 64;
            const int nm = f0 < qn_end ? 1 : ((f0 >= kn_beg && f0 < kn_end) ? 2 : 0);
            const float* gp = nm == 1 ? qg : kg;
            float4 g4[2][2];
#pragma unroll
            for (int bj = 0; bj < 2; ++bj)
#pragma unroll
                for (int n = 0; n < 2; ++n) g4[bj][n] = nm ? *(const float4*)(gp + bj * 32 + 8 * fq + 4 * n) : make_float4(1.f, 1.f, 1.f, 1.f);
#pragma unroll
            for (int ai = 0; ai < 2; ++ai)
#pragma unroll
                for (int m = 0; m < 4; ++m) {
                    const size_t tok = row0 + ai * HALF + m * 16;
                    float sc = rs ? __builtin_amdgcn_rsqf(rs[tok] * (1.f / 1024.f) + EPS) : 1.f;
                    if (nm) {
                        float ss = 0.f;
#pragma unroll
                        for (int bj = 0; bj < 2; ++bj)
#pragma unroll
                            for (int n = 0; n < 2; ++n)
#pragma unroll
                                for (int j = 0; j < 4; ++j) { const float v = acc[ai][bj][m][n][j] * sc; ss += v * v; }
                        ss += __shfl_xor(ss, 16); ss += __shfl_xor(ss, 32);
                        sc *= __builtin_amdgcn_rsqf(ss * (1.f / 64.f) + EPS);
                    }
#pragma unroll
                    for (int bj = 0; bj < 2; ++bj) {
                        const f32x4 a0 = acc[ai][bj][m][0], a1 = acc[ai][bj][m][1];
                        *(uint4*)(O + tok * ldo + f0 + bj * 32 + 8 * fq) =
                            make_uint4(pk2(a0[0] * sc * g4[bj][0].x, a0[1] * sc * g4[bj][0].y), pk2(a0[2] * sc * g4[bj][0].z, a0[3] * sc * g4[bj][0].w),
                                       pk2(a1[0] * sc * g4[bj][1].x, a1[1] * sc * g4[bj][1].y), pk2(a1[2] * sc * g4[bj][1].z, a1[3] * sc * g4[bj][1].w));
                    }
                }
        }
    }
};

template <class Epi, class Sched, bool ALIGN_EPI = false, bool SP2 = false>
__device__ __forceinline__ void gemm_phase(PG8_LAS unsigned char* lds, const Gemm g, const Sched& S, const Epi& E) {
    const int tid = otid(), wid = __builtin_amdgcn_readfirstlane(tid >> 6), lane = tid & 63, wr = wid >> 2, wc = wid & 3, fr = lane & 15, fq = lane >> 4;
    const int K = g.K, nt = K / BK;
    unsigned voffA[2], voffB[2];
#pragma unroll
    for (int i = 0; i < 2; ++i) { int R, C; stage_rc(tid * 16 + i * 8192, R, C); const int Rb = Epi::PERM ? ((R & ~31) + perm32(R & 31)) : R;
        voffA[i] = (unsigned)(R * g.lda + C) * 2u; voffB[i] = (unsigned)(Rb * K + C) * 2u; }
    const size_t kstep = (size_t)(BK * 2);
    const size_t hstepA = (size_t)HALF * g.lda * 2, hstepB = (size_t)HALF * K * 2;
    const size_t tstepA = 2 * hstepA, tstepB = 2 * hstepB;
    const unsigned ldsw = (unsigned)wid * 1024u;
    const int aoff = lds_byte(wr * 64 + fr, fq * 8), boff = lds_byte(wc * 32 + fr, fq * 8);
#define PG8_SA(b, h) (((b) * 2 + (h)) * HTB)
#define PG8_SB(b, h) ((4 + (b) * 2 + (h)) * HTB)
#define PG8_STAGE(bufoff, gbase, voff) do { _Pragma("unroll") for (int _i = 0; _i < 2; ++_i) \
        __builtin_amdgcn_global_load_lds((const unsigned*)((const char*)(gbase) + (voff)[_i]), (PG8_LAS unsigned*)(lds + (bufoff) + ldsw + _i * 8192), 16, 0, 0); } while (0)
#define PG8_LDA(dst, b, h) do { _Pragma("unroll") for (int m = 0; m < 4; ++m) _Pragma("unroll") for (int k = 0; k < 2; ++k) dst[m][k] = *(const PG8_LAS bf16x8*)(lds + PG8_SA(b, h) + aoff + m * 2048 + k * 1024); } while (0)
#define PG8_LDB(dst, b, h) do { _Pragma("unroll") for (int n = 0; n < 2; ++n) _Pragma("unroll") for (int k = 0; k < 2; ++k) dst[n][k] = *(const PG8_LAS bf16x8*)(lds + PG8_SB(b, h) + boff + n * 2048 + k * 1024); } while (0)
#define PG8_MMA(ai, bj, At, Bt) do { __builtin_amdgcn_s_setprio(1); _Pragma("unroll") for (int m = 0; m < 4; ++m) _Pragma("unroll") for (int n = 0; n < 2; ++n) _Pragma("unroll") for (int k = 0; k < 2; ++k) \
        acc[ai][bj][m][n] = __builtin_amdgcn_mfma_f32_16x16x32_bf16(Bt[n][k], At[m][k], acc[ai][bj][m][n], 0, 0, 0); __builtin_amdgcn_s_setprio(0); } while (0)
#define PG8_WAIT_V(n) asm volatile("s_waitcnt vmcnt(" #n ")" ::: "memory")
#define PG8_WAIT_L(n) asm volatile("s_waitcnt lgkmcnt(" #n ")" ::: "memory")
#define PG8_BAR __builtin_amdgcn_s_barrier()
#define PG8_SCHED __builtin_amdgcn_sched_barrier(0)
    Unit cur, nxt; int ui = 0;
    if (!S.next(0, cur)) return;
    f32x4 acc[2][2][4][2];
#pragma unroll
    for (int a = 0; a < 2; ++a)
#pragma unroll
        for (int b = 0; b < 2; ++b)
#pragma unroll
            for (int m = 0; m < 4; ++m)
#pragma unroll
                for (int n = 0; n < 2; ++n) acc[a][b][m][n] = (f32x4){0.f, 0.f, 0.f, 0.f};
    bf16x8 At[4][2], B0[2][2], B1[2][2];
    const char* cA = (const char*)g.A + (size_t)cur.pm * tstepA; const char* cB = (const char*)g.Bt + (size_t)cur.pn * tstepB;
    S.a_ready(cur);
    if constexpr (SP2) {
        PG8_STAGE(PG8_SB(0, 0), cB, voffB); PG8_STAGE(PG8_SB(0, 1), cB + hstepB, voffB); PG8_STAGE(PG8_SA(0, 0), cA, voffA); PG8_STAGE(PG8_SA(0, 1), cA + hstepA, voffA);
        if (wr == 1) PG8_BAR;
        PG8_WAIT_V(2); PG8_BAR;
        PG8_STAGE(PG8_SB(1, 0), cB + kstep, voffB); PG8_STAGE(PG8_SA(1, 0), cA + kstep, voffA); PG8_STAGE(PG8_SB(1, 1), cB + hstepB + kstep, voffB);
        PG8_WAIT_V(6); PG8_BAR;
    } else {
        PG8_STAGE(PG8_SB(0, 0), cB, voffB); PG8_STAGE(PG8_SA(0, 0), cA, voffA); PG8_STAGE(PG8_SB(0, 1), cB + hstepB, voffB); PG8_STAGE(PG8_SA(0, 1), cA + hstepA, voffA);
        if (wr == 1) PG8_BAR;
        PG8_WAIT_V(4); PG8_BAR;
        PG8_STAGE(PG8_SB(1, 0), cB + kstep, voffB); PG8_STAGE(PG8_SA(1, 0), cA + kstep, voffA); PG8_STAGE(PG8_SB(1, 1), cB + hstepB + kstep, voffB);
        PG8_WAIT_V(6); PG8_BAR;
    }
    for (;;) {
        const bool has_next = S.next(ui + 1, nxt);
        const char* nA = has_next ? (const char*)g.A + (size_t)nxt.pm * tstepA : cA; const char* nB = has_next ? (const char*)g.Bt + (size_t)nxt.pn * tstepB : cB;
        for (int t = 0; t < nt; t += 2) {
            const bool last = (t == nt - 2);
            const char* a1 = cA + (size_t)(t + 1) * kstep;
            const char* a2 = last ? nA : cA + (size_t)(t + 2) * kstep; const char* b2 = last ? nB : cB + (size_t)(t + 2) * kstep;
            const char* a3 = a2 + kstep; const char* b3 = b2 + kstep;
            if (last && has_next) S.a_ready(nxt);
            if constexpr (SP2) {
            PG8_LDB(B0, 0, 0); PG8_LDB(B1, 0, 1); PG8_SCHED; PG8_LDA(At, 0, 0); PG8_STAGE(PG8_SA(1, 1), a1 + hstepA, voffA);
            PG8_WAIT_V(8); PG8_WAIT_L(0); PG8_BAR; PG8_MMA(0, 0, At, B0); PG8_MMA(0, 1, At, B1); PG8_BAR; PG8_SCHED;
            PG8_LDA(At, 0, 1); PG8_STAGE(PG8_SB(0, 0), b2, voffB); PG8_STAGE(PG8_SB(0, 1), b2 + hstepB, voffB); PG8_STAGE(PG8_SA(0, 0), a2, voffA);
            PG8_WAIT_V(8); PG8_WAIT_L(0); PG8_BAR; PG8_MMA(1, 0, At, B0); PG8_MMA(1, 1, At, B1); PG8_BAR; PG8_SCHED;
            PG8_LDB(B0, 1, 0); PG8_LDB(B1, 1, 1); PG8_SCHED; PG8_LDA(At, 1, 0); PG8_STAGE(PG8_SA(0, 1), a2 + hstepA, voffA);
            PG8_WAIT_V(8); PG8_WAIT_L(0); PG8_BAR; PG8_MMA(0, 0, At, B0); PG8_MMA(0, 1, At, B1); PG8_BAR; PG8_SCHED;
            PG8_LDA(At, 1, 1); PG8_STAGE(PG8_SB(1, 0), b3, voffB); PG8_STAGE(PG8_SB(1, 1), b3 + hstepB, voffB); PG8_STAGE(PG8_SA(1, 0), a3, voffA);
            PG8_WAIT_V(8); PG8_WAIT_L(0); PG8_BAR; PG8_MMA(1, 0, At, B0); PG8_MMA(1, 1, At, B1); PG8_BAR; PG8_SCHED;
            } else {
            PG8_LDB(B0, 0, 0); PG8_SCHED; PG8_LDA(At, 0, 0); PG8_STAGE(PG8_SA(1, 1), a1 + hstepA, voffA);
            PG8_WAIT_L(8); PG8_BAR; PG8_WAIT_L(0); PG8_MMA(0, 0, At, B0); PG8_BAR; PG8_SCHED;
            PG8_LDB(B1, 0, 1); PG8_STAGE(PG8_SB(0, 0), b2, voffB);
            PG8_BAR; PG8_WAIT_L(0); PG8_MMA(0, 1, At, B1); PG8_BAR;
            PG8_LDA(At, 0, 1); PG8_STAGE(PG8_SA(0, 0), a2, voffA);
            PG8_BAR; PG8_WAIT_L(0); PG8_MMA(1, 0, At, B0); PG8_BAR; PG8_SCHED;
            PG8_STAGE(PG8_SB(0, 1), b2 + hstepB, voffB);
            PG8_WAIT_V(6); PG8_BAR; PG8_MMA(1, 1, At, B1); PG8_BAR;
            PG8_LDB(B0, 1, 0); PG8_SCHED; PG8_LDA(At, 1, 0); PG8_STAGE(PG8_SA(0, 1), a2 + hstepA, voffA);
            PG8_WAIT_L(8); PG8_BAR; PG8_WAIT_L(0); PG8_MMA(0, 0, At, B0); PG8_BAR; PG8_SCHED;
            PG8_LDB(B1, 1, 1); PG8_STAGE(PG8_SB(1, 0), b3, voffB);
            PG8_BAR; PG8_WAIT_L(0); PG8_MMA(0, 1, At, B1); PG8_BAR;
            PG8_LDA(At, 1, 1); PG8_STAGE(PG8_SA(1, 0), a3, voffA);
            PG8_BAR; PG8_WAIT_L(0); PG8_MMA(1, 0, At, B0); PG8_BAR; PG8_SCHED;
            PG8_STAGE(PG8_SB(1, 1), b3 + hstepB, voffB);
            PG8_WAIT_V(6); PG8_BAR; PG8_MMA(1, 1, At, B1); PG8_BAR;
            }
        }
        if constexpr (ALIGN_EPI) { if (wr == 0) PG8_BAR; }
        if constexpr (!Epi::AFTER_DRAIN) { E(acc, cur, wr, wc, fr, fq); S.done(cur); }
        if (!has_next) break;
#pragma unroll
        for (int a = 0; a < 2; ++a)
#pragma unroll
            for (int b = 0; b < 2; ++b)
#pragma unroll
                for (int m = 0; m < 4; ++m)
#pragma unroll
                    for (int n = 0; n < 2; ++n) acc[a][b][m][n] = (f32x4){0.f, 0.f, 0.f, 0.f};
        cur = nxt; cA = nA; cB = nB; ++ui;
        if constexpr (ALIGN_EPI) { if (wr == 1) PG8_BAR; }
    }
    PG8_WAIT_V(0);
    if constexpr (!ALIGN_EPI) { if (wr == 0) PG8_BAR; }
    PG8_BAR;
    if constexpr (Epi::AFTER_DRAIN) { E.fused(acc, cur, wr, wc, fr, fq, lds, wid, lane); S.done(cur); }
#undef PG8_SA
#undef PG8_SB
#undef PG8_STAGE
#undef PG8_LDA
#undef PG8_LDB
#undef PG8_MMA
#undef PG8_WAIT_V
#undef PG8_WAIT_L
#undef PG8_BAR
#undef PG8_SCHED
}
}

#define KV_DECL uint4 rk0, rk1, rk2, rk3, rv0, rv1, rv2, rv3
#define KV_LOAD(kb_, dil_) do { const int kk_ = lane >> 3; \
    const bf16_t* p0_ = qkv + (rowb + min(max((kb_) + (dil_) * kk_, 0), S - 1)) * ld + (lane & 7) * 8; \
    const bf16_t* p1_ = qkv + (rowb + min(max((kb_) + (dil_) * (kk_ + 8), 0), S - 1)) * ld + (lane & 7) * 8; \
    const bf16_t* p2_ = qkv + (rowb + min(max((kb_) + (dil_) * (kk_ + 16), 0), S - 1)) * ld + (lane & 7) * 8; \
    const bf16_t* p3_ = qkv + (rowb + min(max((kb_) + (dil_) * (kk_ + 24), 0), S - 1)) * ld + (lane & 7) * 8; \
    rk0 = *(const uint4*)(p0_ + kcol); rk1 = *(const uint4*)(p1_ + kcol); rk2 = *(const uint4*)(p2_ + kcol); rk3 = *(const uint4*)(p3_ + kcol); \
    rv0 = *(const uint4*)(p0_ + vcol); rv1 = *(const uint4*)(p1_ + vcol); rv2 = *(const uint4*)(p2_ + vcol); rv3 = *(const uint4*)(p3_ + vcol); } while (0)
#define KV_STORE() do { char* wp_ = vl + (lane >> 3) * 144 + (lane & 7) * 16; \
    *(uint4*)(wp_) = rk0; *(uint4*)(wp_ + 8 * 144) = rk1; *(uint4*)(wp_ + 16 * 144) = rk2; *(uint4*)(wp_ + 24 * 144) = rk3; \
    *(uint4*)(wp_ + 4608) = rv0; *(uint4*)(wp_ + 4608 + 8 * 144) = rv1; *(uint4*)(wp_ + 4608 + 16 * 144) = rv2; *(uint4*)(wp_ + 4608 + 24 * 144) = rv3; } while (0)

DI bf16x8 v_frag(const char* vbase, int s, int dt) {
    typedef __attribute__((address_space(3))) v4i16_t* lp_t;
    const char* a = vbase + s * (16 * 144) + dt * 64;
    const s16x4 lo = __builtin_bit_cast(s16x4, __builtin_amdgcn_ds_read_tr16_b64_v4i16((lp_t)(a)));
    const s16x4 hi = __builtin_bit_cast(s16x4, __builtin_amdgcn_ds_read_tr16_b64_v4i16((lp_t)(a + 8 * 144)));
    return __builtin_shufflevector(lo, hi, 0, 1, 2, 3, 4, 5, 6, 7);
}

template <int OFF> DI bf16x8 pack8v(const f32x16& p) {
    typedef unsigned u32x4 __attribute__((ext_vector_type(4)));
    u32x4 w; w[0] = pk2(p[OFF + 0], p[OFF + 1]); w[1] = pk2(p[OFF + 2], p[OFF + 3]); w[2] = pk2(p[OFF + 4], p[OFF + 5]); w[3] = pk2(p[OFF + 6], p[OFF + 7]);
    return __builtin_bit_cast(bf16x8, w);
}

DI void win_attn_wave(bf16_t* qkv, int ld, int b, int qcol, int kcol, int vcol, int tq0, int qstride,
                      float slope2, float m_init, float l_init, int pat, char* vl, int lane, bool dry,
                      int nq = 32, float* st = nullptr, int tloc0 = 0, int tlstride = 0, int stage = 0) {
    const int r = lane & 31, h = lane >> 5;
    const size_t rowb = (size_t)b * S;
    const int tq = tq0 + qstride * r;
    bf16x8 qf[4];
    {
        const bf16_t* qp = qkv + (rowb + min(tq, S - 1)) * ld + qcol + h * 32;
#pragma unroll
        for (int ks = 0; ks < 4; ++ks) qf[ks] = *(const bf16x8*)(qp + ks * 8);
    }
    f32x16 o0, o1;
#pragma unroll
    for (int i = 0; i < 16; ++i) { o0[i] = 0.f; o1[i] = 0.f; }
    float m = m_init, l = (h == 0) ? l_init : 0.f;
    const float sc2 = 0.125f * LOG2E;
    const int i16 = lane & 15;
    const char* vbase = vl + 4608 + (4 * h + (i16 >> 2)) * 144 + (16 * ((lane >> 4) & 1) + 4 * (i16 & 3)) * 2;
    const char* kfp = vl + r * 144 + h * 64;
    KV_DECL;
    for (int pi = 0; pi < 1; ++pi) {
        int dil, W, kfirst; const int nt = 5;
        if (pat < 0) { dil = 1; W = 127; kfirst = tq0 - 128; }
        else if (pat == 0) { dil = 1; W = 128; kfirst = tq0 - 128; }
        else if (pat == 1) { dil = 4; W = 512; kfirst = tq0 - 512; }
        else { dil = 16; W = 2048; kfirst = tq0 - 2048; }
        const int step = 32 * dil;
        int t0 = 0;
        { const int need = -kfirst - 31 * dil; if (need > 0) t0 = (need + step - 1) / step; }
        if (t0 >= nt) continue;
        KV_LOAD(kfirst + t0 * step, dil);
        for (int tile = t0; tile < nt; ++tile) {
            const int kb = kfirst + tile * step;
            KV_STORE();
            asm volatile("" ::: "memory");
            if (tile + 1 < nt) KV_LOAD(kb + step, dil);
            f32x16 s;
#pragma unroll
            for (int i = 0; i < 16; ++i) s[i] = 0.f;
#pragma unroll
            for (int ks = 0; ks < 4; ++ks) s = MFMA(*(const bf16x8*)(kfp + ks * 16), qf[ks], s);
            f32x16 sv; float mloc = -INFINITY;
            const int d0 = tq - kb - 4 * h * dil;
            const unsigned wlim = (unsigned)min(W, tq);
#pragma unroll
            for (int i = 0; i < 16; ++i) {
                const int diff = d0 - dil * crow(i, 0);
                const float sb = s[i] * sc2 - slope2 * (float)diff;
                sv[i] = ((unsigned)diff <= wlim) ? sb : -INFINITY;
                mloc = fmaxf(mloc, sv[i]);
            }
            mloc = fmaxf(mloc, __shfl_xor(mloc, 32));
            const float mn = fmaxf(m, mloc);
            float ps = 0.f;
#pragma unroll
            for (int i = 0; i < 16; ++i) { sv[i] = fexp2(sv[i] - mn); ps += sv[i]; }
            if (__builtin_amdgcn_ballot_w64(mn != m) != 0) {
                const float alpha = fexp2(m - mn);
                l *= alpha;
#pragma unroll
                for (int i = 0; i < 16; ++i) { o0[i] *= alpha; o1[i] *= alpha; }
                m = mn;
            }
            l += ps;
            const bf16x8 p0 = pack8v<0>(sv), p1 = pack8v<8>(sv);
            o0 = MFMA(v_frag(vbase, 0, 0), p0, o0);
            o0 = MFMA(v_frag(vbase, 1, 0), p1, o0);
            o1 = MFMA(v_frag(vbase, 0, 1), p0, o1);
            o1 = MFMA(v_frag(vbase, 1, 1), p1, o1);
            asm volatile("" ::: "memory");
        }
    }
    float lt = l + __shfl_xor(l, 32);
    if (st) {
        const bool act = r < nq;
        float* sp = st + (tloc0 + tlstride * r) * 68;
        if (act) {
            if (stage > 0) {
                const float ms = sp[64], ls = sp[65];
                const float mn = fmaxf(ms, m);
                const float as = fexp2(ms - mn), aw = fexp2(m - mn);
                lt = ls * as + lt * aw; m = mn;
#pragma unroll
                for (int g = 0; g < 4; ++g) {
                    const float4 a = *(const float4*)(sp + 8 * g + 4 * h), c = *(const float4*)(sp + 32 + 8 * g + 4 * h);
                    o0[4 * g] = a.x * as + o0[4 * g] * aw; o0[4 * g + 1] = a.y * as + o0[4 * g + 1] * aw; o0[4 * g + 2] = a.z * as + o0[4 * g + 2] * aw; o0[4 * g + 3] = a.w * as + o0[4 * g + 3] * aw;
                    o1[4 * g] = c.x * as + o1[4 * g] * aw; o1[4 * g + 1] = c.y * as + o1[4 * g + 1] * aw; o1[4 * g + 2] = c.z * as + o1[4 * g + 2] * aw; o1[4 * g + 3] = c.w * as + o1[4 * g + 3] * aw;
                }
            }
            if (stage < 2) {
                if (h == 0) { sp[64] = m; sp[65] = lt; }
#pragma unroll
                for (int g = 0; g < 4; ++g) {
                    *(float4*)(sp + 8 * g + 4 * h) = make_float4(o0[4 * g], o0[4 * g + 1], o0[4 * g + 2], o0[4 * g + 3]);
                    *(float4*)(sp + 32 + 8 * g + 4 * h) = make_float4(o1[4 * g], o1[4 * g + 1], o1[4 * g + 2], o1[4 * g + 3]);
                }
            }
        }
        if (stage < 2 || !act) return;
    }
    const float inv = 1.f / lt;
    if (dry) { if (o0[0] + o1[0] + lt == 12345.678f) qkv[0] = 1; return; }
    bf16_t* op = qkv + (rowb + tq) * ld + qcol + 4 * h;
#pragma unroll
    for (int g = 0; g < 4; ++g) {
        *(uint2*)(op + 8 * g) = make_uint2(pk2(o0[4 * g] * inv, o0[4 * g + 1] * inv), pk2(o0[4 * g + 2] * inv, o0[4 * g + 3] * inv));
        *(uint2*)(op + 32 + 8 * g) = make_uint2(pk2(o1[4 * g] * inv, o1[4 * g + 1] * inv), pk2(o1[4 * g + 2] * inv, o1[4 * g + 3] * inv));
    }
}

DI void stick_wave(bf16_t* qkv, int ld, int b, int qcol, int kcol, int vcol, int qt, char* vl, int lane, bool dry) {
    const int r = lane & 31, h = lane >> 5;
    const size_t rowb = (size_t)b * S;
    const int tq = qt * 32 + r;
    bf16x8 qf[4];
    {
        const bf16_t* qp = qkv + (rowb + tq) * ld + qcol + h * 32;
#pragma unroll
        for (int ks = 0; ks < 4; ++ks) qf[ks] = *(const bf16x8*)(qp + ks * 8);
    }
    f32x16 o0, o1;
#pragma unroll
    for (int i = 0; i < 16; ++i) { o0[i] = 0.f; o1[i] = 0.f; }
    float R = 1.f;
    const int i16 = lane & 15;
    const char* vbase = vl + 4608 + (4 * h + (i16 >> 2)) * 144 + (16 * ((lane >> 4) & 1) + 4 * (i16 & 3)) * 2;
    const char* kfp = vl + r * 144 + h * 64;
    KV_DECL;
    KV_LOAD(qt * 32, 1);
    for (int tile = qt; tile >= 0; --tile) {
        KV_STORE();
        asm volatile("" ::: "memory");
        if (tile > 0) KV_LOAD((tile - 1) * 32, 1);
        f32x16 s;
#pragma unroll
        for (int i = 0; i < 16; ++i) s[i] = 0.f;
#pragma unroll
        for (int ks = 0; ks < 4; ++ks) s = MFMA(*(const bf16x8*)(kfp + ks * 16), qf[ks], s);
        const bool diag = (tile == qt);
        f32x16 sg, kp;
#pragma unroll
        for (int i = 0; i < 16; ++i) {
            const float z2 = fminf(s[i] * (0.125f * LOG2E), 80.f);
            const float t = fexp2(z2);
            const float k = __builtin_amdgcn_rcpf(1.f + t);
            kp[i] = k; sg[i] = t * k;
        }
        if (diag) {
#pragma unroll
            for (int i = 0; i < 16; ++i) { const bool strict = crow(i, h) < r; kp[i] = strict ? kp[i] : 1.f; sg[i] = strict ? sg[i] : 0.f; }
        }
        float G[4], PG[4], both[4];
#pragma unroll
        for (int g = 0; g < 4; ++g) { G[g] = (kp[4 * g] * kp[4 * g + 1]) * (kp[4 * g + 2] * kp[4 * g + 3]); PG[g] = __shfl_xor(G[g], 32); both[g] = G[g] * PG[g]; }
        float Sx[4];
        Sx[3] = 1.f; Sx[2] = both[3]; Sx[1] = both[3] * both[2]; Sx[0] = Sx[1] * both[1];
        f32x16 a;
#pragma unroll
        for (int g = 0; g < 4; ++g) {
            float la = R * Sx[g] * (h == 0 ? PG[g] : 1.f);
#pragma unroll
            for (int j = 3; j >= 0; --j) {
                a[4 * g + j] = sg[4 * g + j] * la;
                la *= kp[4 * g + j];
            }
        }
        R *= Sx[0] * both[0];
        const bf16x8 p0 = pack8v<0>(a), p1 = pack8v<8>(a);
        o0 = MFMA(v_frag(vbase, 0, 0), p0, o0);
        o0 = MFMA(v_frag(vbase, 1, 0), p1, o0);
        o1 = MFMA(v_frag(vbase, 0, 1), p0, o1);
        o1 = MFMA(v_frag(vbase, 1, 1), p1, o1);
        asm volatile("" ::: "memory");
        if (__builtin_amdgcn_ballot_w64(R >= 1.17549435e-38f) == 0) break;
    }
    if (dry) { if (o0[0] + o1[0] == 12345.678f) qkv[0] = 1; return; }
    bf16_t* op = qkv + (rowb + tq) * ld + qcol + 4 * h;
#pragma unroll
    for (int g = 0; g < 4; ++g) {
        *(uint2*)(op + 8 * g) = make_uint2(pk2(o0[4 * g], o0[4 * g + 1]), pk2(o0[4 * g + 2], o0[4 * g + 3]));
        *(uint2*)(op + 32 + 8 * g) = make_uint2(pk2(o1[4 * g], o1[4 * g + 1]), pk2(o1[4 * g + 2], o1[4 * g + 3]));
    }
}

DI void attn_even_phase(const Params& P, char* smem, bool dry) {
    const int tid_ = otid(); const int lane = tid_ & 63, wid = tid_ >> 6;
    bf16_t* qkv = (bf16_t*)(P.ws + OFF_BIG);
    char* vl = smem + wid * 9216;
    for (int it = blockIdx.x * 8 + wid; it < 2048 + 4096; it += gridDim.x * 8) {
        if (it < 2048) {
            const int bh = it >> 6, p = it & 63; const int b = bh >> 3, head = bh & 7;
            stick_wave(qkv, 2304, b, 512 + head * 64, 1280 + head * 64, 1792 + head * 64, 127 - p, vl, lane, dry);
            stick_wave(qkv, 2304, b, 512 + head * 64, 1280 + head * 64, 1792 + head * 64, p, vl, lane, dry);
        } else {
            const int v = it - 2048; const int g = v & 3; const int qt = (v >> 2) & 127; const int rest = v >> 9; const int b = rest >> 1, kvh = rest & 1;
            const int head = kvh * 4 + g;
            const float slope = exp2f(-(float)(head + 1));
            const float sink = P.in[9][head];
            win_attn_wave(qkv, 2304, b, head * 64, 1024 + kvh * 64, 1152 + kvh * 64, qt * 32, 1, slope * LOG2E, sink * LOG2E, 1.f, -1, vl, lane, dry);
        }
    }
}

DI void attn_odd_phase(const Params& P, char* smem, bool dry) {
    const int tid_ = otid(); const int lane = tid_ & 63, wid = tid_ >> 6;
    bf16_t* qkv = (bf16_t*)(P.ws + OFF_BIG);
    char* vl = smem + wid * 9216;
    float* st = (float*)(smem + 8 * 9216);
    for (int it = blockIdx.x; it < 1024; it += gridDim.x) {
        const int span = it & 15, head = (it >> 4) & 15, b = it >> 8; const int t0 = span * 256;
        const float slope2 = exp2f(-0.5f * (float)(head + 1)) * LOG2E;
        const int qc = head * 64, kc = 1024 + head * 64, vc = 2048 + head * 64;
        __syncthreads();
        win_attn_wave(qkv, 3072, b, qc, kc, vc, t0 + 32 * wid, 1, slope2, -1e30f, 0.f, 0, vl, lane, dry, 32, st, 32 * wid, 1, 0);
        __syncthreads();
        { const int r4 = wid >> 1, hf = wid & 1;
          win_attn_wave(qkv, 3072, b, qc, kc, vc, t0 + r4 + 128 * hf, 4, slope2, -1e30f, 0.f, 1, vl, lane, dry, 32, st, r4 + 128 * hf, 4, 1); }
        __syncthreads();
#pragma unroll 1
        for (int k = 0; k < 2; ++k) {
            const int r16 = 2 * wid + k;
            win_attn_wave(qkv, 3072, b, qc, kc, vc, t0 + r16, 16, slope2, -1e30f, 0.f, 2, vl, lane, dry, 16, st, r16, 16, 2);
        }
    }
}

DI void xattn_wave(bf16_t* qb, const bf16_t* Kn, const bf16_t* VT, const float* qg, float kmax2, int b, int head, int tok0, char* ql, int lane, bool dry) {
    const int r = lane & 31, h = lane >> 5;
    const size_t token = (size_t)b * S + tok0 + r;
    bf16_t* qp = qb + token * D + head * 256 + h * 128;
    float ss = 0.f;
#pragma unroll
    for (int ks = 0; ks < 16; ++ks) {
        const uint4 v = *(const uint4*)(qp + ks * 8);
        const unsigned w[4] = {v.x, v.y, v.z, v.w};
#pragma unroll
        for (int e = 0; e < 4; ++e) { const float a = bflo(w[e]), c = bfhi(w[e]); ss += a * a + c * c; }
    }
    ss += __shfl_xor(ss, 32);
    const float inv = __builtin_amdgcn_rsqf(ss * (1.f / 256.f) + EPS);
    float qq2 = 0.f;
#pragma unroll
    for (int ks = 0; ks < 16; ++ks) {
        const uint4 v = *(const uint4*)(qp + ks * 8);
        const float4 g0 = *(const float4*)(qg + h * 128 + ks * 8), g1 = *(const float4*)(qg + h * 128 + ks * 8 + 4);
        uint4 o;
        o.x = pk2(bflo(v.x) * inv * g0.x, bfhi(v.x) * inv * g0.y); o.y = pk2(bflo(v.y) * inv * g0.z, bfhi(v.y) * inv * g0.w);
        o.z = pk2(bflo(v.z) * inv * g1.x, bfhi(v.z) * inv * g1.y); o.w = pk2(bflo(v.w) * inv * g1.z, bfhi(v.w) * inv * g1.w);
        qq2 += bflo(o.x) * bflo(o.x) + bfhi(o.x) * bfhi(o.x) + bflo(o.y) * bflo(o.y) + bfhi(o.y) * bfhi(o.y)
             + bflo(o.z) * bflo(o.z) + bfhi(o.z) * bfhi(o.z) + bflo(o.w) * bflo(o.w) + bfhi(o.w) * bfhi(o.w);
        *(uint4*)(ql + (ks * 64 + lane) * 16) = o;
    }
    qq2 += __shfl_xor(qq2, 32);
    asm volatile("" ::: "memory");
    const float sc2 = 0.0625f * LOG2E;
    const bf16_t* kp0 = Kn + ((size_t)(b * 4 + head) * 8 * 16 * 64 + lane) * 8;
    const float m = __builtin_amdgcn_sqrtf(qq2 * kmax2) * 1.001f;
    float l = 0.f;
    bf16x8 pf[8][2];
    bf16x8 kc[16], kn[16];
#pragma unroll
    for (int ks = 0; ks < 16; ++ks) kc[ks] = *(const bf16x8*)(kp0 + ks * 512);
#pragma unroll
    for (int tile = 0; tile < 8; ++tile) {
        if (tile < 7) {
#pragma unroll
            for (int ks = 0; ks < 16; ++ks) kn[ks] = *(const bf16x8*)(kp0 + (size_t)(tile + 1) * 16 * 512 + ks * 512);
        }
        f32x16 s, s_b;
#pragma unroll
        for (int i = 0; i < 16; ++i) { s[i] = 0.f; s_b[i] = 0.f; }
#pragma unroll
        for (int ks = 0; ks < 16; ks += 2) {
            const bf16x8 qf0 = *(const bf16x8*)(ql + (ks * 64 + lane) * 16);
            const bf16x8 qf1 = *(const bf16x8*)(ql + ((ks + 1) * 64 + lane) * 16);
            s = MFMA(kc[ks], qf0, s);
            s_b = MFMA(kc[ks + 1], qf1, s_b);
        }
#pragma unroll
        for (int i = 0; i < 16; ++i) s[i] += s_b[i];
#pragma unroll
        for (int i = 0; i < 16; ++i) { s[i] = fexp2((s[i] - m) * sc2); l += s[i]; }
        pf[tile][0] = pack8v<0>(s); pf[tile][1] = pack8v<8>(s);
#pragma unroll
        for (int ks = 0; ks < 16; ++ks) kc[ks] = kn[ks];
    }
    l += __shfl_xor(l, 32);
    const float il = 1.f / l;
    bf16_t* op = qb + token * D + head * 256 + 4 * h;
    const bf16_t* vp0 = VT + (((size_t)(b * 4 + head) * 8 * 8 * 2 * 64) + lane) * 8;
    bf16x8 vc[16], vn[16];
#pragma unroll
    for (int e = 0; e < 16; ++e) vc[e] = *(const bf16x8*)(vp0 + e * 512);
#pragma unroll 1
    for (int dt = 0; dt < 8; ++dt) {
        const int dn = dt < 7 ? dt + 1 : 7;
#pragma unroll
        for (int e = 0; e < 16; ++e) vn[e] = *(const bf16x8*)(vp0 + (size_t)dn * 16 * 512 + e * 512);
        f32x16 o, o_b;
#pragma unroll
        for (int i = 0; i < 16; ++i) { o[i] = 0.f; o_b[i] = 0.f; }
#pragma unroll
        for (int tile = 0; tile < 8; ++tile) { o = MFMA(vc[tile * 2], pf[tile][0], o); o_b = MFMA(vc[tile * 2 + 1], pf[tile][1], o_b); }
#pragma unroll
        for (int i = 0; i < 16; ++i) o[i] += o_b[i];
#pragma unroll
        for (int g = 0; g < 4; ++g)
            if (dry) { if (o[4 * g] == 12345.678f) qb[0] = 1; } else *(uint2*)(op + dt * 32 + 8 * g) = make_uint2(pk2(o[4 * g] * il, o[4 * g + 1] * il), pk2(o[4 * g + 2] * il, o[4 * g + 3] * il));
#pragma unroll
        for (int e = 0; e < 16; ++e) vc[e] = vn[e];
    }
}

DI void xattn_block(bf16_t* qb, const bf16_t* KF, const bf16_t* VF, const float* qg, float kmax2, int b, int head, int qblk, char* smem, int lane, int wid) {
    const int r = lane & 31, h = lane >> 5;
    const size_t token = (size_t)b * S + qblk * 256 + wid * 32 + r;
    bf16_t* qp = qb + token * D + head * 256 + h * 128;
    const bf16_t* kbase = KF + (size_t)(b * 4 + head) * 8 * 8192;
    const bf16_t* vbase = VF + (size_t)(b * 4 + head) * 8 * 8192;
    const int pc0 = (2 * wid) * 512 + lane * 8, pc1 = pc0 + 512;
    char* ld0 = smem + (2 * wid) * 1024 + lane * 16;
#define XA_ISSUE(u_) do { const int u__ = (u_); const bf16_t* src_ = (u__ < 8) ? kbase + (size_t)u__ * 8192 : vbase + (size_t)(u__ - 8) * 8192; \
        char* dst_ = ld0 + (u__ & 3) * 16384; glds16(src_ + pc0, dst_); glds16(src_ + pc1, dst_ + 1024); } while (0)
    __syncthreads();
    XA_ISSUE(0); XA_ISSUE(1); XA_ISSUE(2);
    uint4 qraw[16];
    float ss = 0.f;
#pragma unroll
    for (int ks = 0; ks < 16; ++ks) {
        qraw[ks] = *(const uint4*)(qp + ks * 8);
        const uint4 v = qraw[ks];
        ss += bflo(v.x) * bflo(v.x) + bfhi(v.x) * bfhi(v.x) + bflo(v.y) * bflo(v.y) + bfhi(v.y) * bfhi(v.y)
            + bflo(v.z) * bflo(v.z) + bfhi(v.z) * bfhi(v.z) + bflo(v.w) * bflo(v.w) + bfhi(v.w) * bfhi(v.w);
    }
    ss += __shfl_xor(ss, 32);
    const float inv = __builtin_amdgcn_rsqf(ss * (1.f / 256.f) + EPS);
    float qq2 = 0.f;
    bf16x8 qf[16];
#pragma unroll
    for (int ks = 0; ks < 16; ++ks) {
        const uint4 v = qraw[ks];
        const float4 g0 = *(const float4*)(qg + h * 128 + ks * 8), g1 = *(const float4*)(qg + h * 128 + ks * 8 + 4);
        uint4 o;
        o.x = pk2(bflo(v.x) * inv * g0.x, bfhi(v.x) * inv * g0.y); o.y = pk2(bflo(v.y) * inv * g0.z, bfhi(v.y) * inv * g0.w);
        o.z = pk2(bflo(v.z) * inv * g1.x, bfhi(v.z) * inv * g1.y); o.w = pk2(bflo(v.w) * inv * g1.z, bfhi(v.w) * inv * g1.w);
        qq2 += bflo(o.x) * bflo(o.x) + bfhi(o.x) * bfhi(o.x) + bflo(o.y) * bflo(o.y) + bfhi(o.y) * bfhi(o.y)
             + bflo(o.z) * bflo(o.z) + bfhi(o.z) * bfhi(o.z) + bflo(o.w) * bflo(o.w) + bfhi(o.w) * bfhi(o.w);
        qf[ks] = __builtin_bit_cast(bf16x8, o);
    }
    qq2 += __shfl_xor(qq2, 32);
    const float sc2 = 0.0625f * LOG2E;
    const float m = __builtin_amdgcn_sqrtf(qq2 * kmax2) * 1.001f;
    float l = 0.f;
    bf16x8 pf[8][2];
    const char* fr0 = smem + lane * 16;
#pragma unroll
    for (int u = 0; u < 8; ++u) {
        asm volatile("s_waitcnt vmcnt(4)" ::: "memory");
        __builtin_amdgcn_s_barrier();
        XA_ISSUE(u + 3);
        const char* sl = fr0 + (u & 3) * 16384;
        f32x16 s, s_b;
#pragma unroll
        for (int i = 0; i < 16; ++i) { s[i] = 0.f; s_b[i] = 0.f; }
#pragma unroll
        for (int ks = 0; ks < 16; ks += 2) {
            s = MFMA(*(const bf16x8*)(sl + ks * 1024), qf[ks], s);
            s_b = MFMA(*(const bf16x8*)(sl + (ks + 1) * 1024), qf[ks + 1], s_b);
        }
#pragma unroll
        for (int i = 0; i < 16; ++i) { s[i] = fexp2((s[i] + s_b[i] - m) * sc2); l += s[i]; }
        pf[u][0] = pack8v<0>(s); pf[u][1] = pack8v<8>(s);
    }
    l += __shfl_xor(l, 32);
    const float il = 1.f / l;
    bf16_t* op = qb + token * D + head * 256 + 4 * h;
#pragma unroll 1
    for (int dt = 0; dt < 8; ++dt) {
        if (dt < 6) asm volatile("s_waitcnt vmcnt(4)" ::: "memory");
        else if (dt == 6) asm volatile("s_waitcnt vmcnt(2)" ::: "memory");
        else asm volatile("s_waitcnt vmcnt(0)" ::: "memory");
        __builtin_amdgcn_s_barrier();
        if (dt < 5) XA_ISSUE(dt + 11);
        const char* sl = fr0 + (dt & 3) * 16384;
        f32x16 o, o_b;
#pragma unroll
        for (int i = 0; i < 16; ++i) { o[i] = 0.f; o_b[i] = 0.f; }
#pragma unroll
        for (int tile = 0; tile < 8; ++tile) {
            o = MFMA(*(const bf16x8*)(sl + (tile * 2) * 1024), pf[tile][0], o);
            o_b = MFMA(*(const bf16x8*)(sl + (tile * 2 + 1) * 1024), pf[tile][1], o_b);
        }
#pragma unroll
        for (int g = 0; g < 4; ++g)
            *(uint2*)(op + dt * 32 + 8 * g) = make_uint2(pk2((o[4 * g] + o_b[4 * g]) * il, (o[4 * g + 1] + o_b[4 * g + 1]) * il),
                                                        pk2((o[4 * g + 2] + o_b[4 * g + 2]) * il, (o[4 * g + 3] + o_b[4 * g + 3]) * il));
    }
#undef XA_ISSUE
}

DI void xattn_phase(const Params& P, int l, char* smem, bool dry) {
    const int tid_ = otid(); const int lane = tid_ & 63, wid = tid_ >> 6;
    bf16_t* qb = (bf16_t*)(P.ws + OFF_BIG);
    const bf16_t* KF = (const bf16_t*)(P.ws + OFF_KF + (size_t)l * SZ_MM);
    const bf16_t* VF = (const bf16_t*)(P.ws + OFF_VT + (size_t)l * SZ_MM);
    const float* qg = P.in[19] + l * 256;
    (void)dry;
    for (int it = blockIdx.x; it < 256; it += gridDim.x) {
        const int qblk = it & 15, head = (it >> 4) & 3, b = it >> 6;
        const float kmax2 = ((const float*)(P.ws + OFF_KMAX))[l * 16 + b * 4 + head];
        xattn_block(qb, KF, VF, qg, kmax2, b, head, qblk, smem, lane, wid);
    }
}

DI void knorm_phase(const Params& P) {
    const int tid_ = otid(); const int lane = tid_ & 63, wid = tid_ >> 6;
    for (int u = blockIdx.x * 8 + wid; u < 8192; u += gridDim.x * 8) {
        const int l = u >> 12, row = (u >> 2) & 1023, head = u & 3;
        const bf16_t* kp = (const bf16_t*)(P.ws + OFF_KN + (size_t)l * SZ_MM) + (size_t)row * D + head * 256 + lane * 4;
        const uint2 v = *(const uint2*)kp;
        const float a0 = bflo(v.x), a1 = bfhi(v.x), a2 = bflo(v.y), a3 = bfhi(v.y);
        float ss = a0 * a0 + a1 * a1 + a2 * a2 + a3 * a3;
        ss = wave_sum(ss);
        const float inv = __builtin_amdgcn_rsqf(ss * (1.f / 256.f) + EPS);
        const float4 g = *(const float4*)(P.in[20] + l * 256 + lane * 4);
        const int b = row >> 8, key = row & 255;
        const int h = lane >> 5, ks = (lane & 31) >> 1, j0 = (lane & 1) * 4;
        bf16_t* dp = (bf16_t*)(P.ws + OFF_KF + (size_t)l * SZ_MM) + ((((((size_t)(b * 4 + head) * 8 + (key >> 5)) * 16 + ks) * 64) + h * 32 + (key & 31)) << 3) + j0;
        const unsigned w0_ = pk2(a0 * inv * g.x, a1 * inv * g.y), w1_ = pk2(a2 * inv * g.z, a3 * inv * g.w);
        *(uint2*)dp = make_uint2(w0_, w1_);
        float kk2 = bflo(w0_) * bflo(w0_) + bfhi(w0_) * bfhi(w0_) + bflo(w1_) * bflo(w1_) + bfhi(w1_) * bfhi(w1_);
        kk2 = wave_sum(kk2);
        if (lane == 0) atomicMax((unsigned*)(P.ws + OFF_KMAX) + l * 16 + b * 4 + head, __float_as_uint(kk2));
    }
}

DI void fast_grid_sync(unsigned* bar, unsigned target) {
    asm volatile("s_waitcnt vmcnt(0) lgkmcnt(0)" ::: "memory");
    __syncthreads();
    if (threadIdx.x == 0) {
        __builtin_amdgcn_fence(__ATOMIC_RELEASE, "agent");
        asm volatile("s_waitcnt vmcnt(0)" ::: "memory");
        __hip_atomic_fetch_add(bar, 1u, __ATOMIC_RELAXED, __HIP_MEMORY_SCOPE_AGENT);
        while (__hip_atomic_load(bar, __ATOMIC_RELAXED, __HIP_MEMORY_SCOPE_AGENT) < target) __builtin_amdgcn_s_sleep(2);
        __builtin_amdgcn_fence(__ATOMIC_ACQUIRE, "agent");
        asm volatile("s_waitcnt vmcnt(0)" ::: "memory");
    }
    __syncthreads();
}

__global__ void __launch_bounds__(512) fwd_megakernel(Params P) {
    extern __shared__ __attribute__((aligned(16))) char smem[];
    cg::grid_group grid = cg::this_grid();
    unsigned nbar = 0;
#pragma unroll 1
    for (int ph = 0; ph < 21; ++ph) {
        float* ssq = (float*)(P.ws + OFF_SSQ);
        bf16_t* xb = (bf16_t*)(P.ws + OFF_XB);
        bf16_t* big = (bf16_t*)(P.ws + OFF_BIG);
        int nrep = 1;
        if (ph > 0) { const int s_ = (ph - 1) % 10; const int kind = (s_ == 3) ? 2 : (s_ == 6) ? 4 : 1; if (PROBE_MASK & kind) nrep = 2; }
        for (int rep = 0; rep < nrep; ++rep) {
        const bool dry = rep + 1 < nrep;
        if (ph == 0) {
            phase0(P, smem);
        } else {
            const int l = (ph - 1) / 10, s = (ph - 1) % 10;
            if (s == 3) {
                if (l == 0) attn_even_phase(P, smem, dry); else attn_odd_phase(P, smem, dry);
            } else if (s == 6) {
                xattn_phase(P, l, smem, dry);
            } else {
                pg8::Gemm g; pg8::Epi E;
                g.A = xb; g.lda = D; g.K = D; g.M = T; g.N = D; g.Bt = nullptr;
                E.mode = 1; E.rs = nullptr; E.O = big; E.ldo = D; E.xin = nullptr; E.xout = nullptr; E.xb = xb; E.ssq_out = ssq; E.alpha = 1.f;
                E.qg = nullptr; E.kg = nullptr; E.qn_end = 0; E.kn_beg = 0; E.kn_end = 0;
                if (s == 0 || s == 8) {
                    g.Bt = (const bf16_t*)(P.ws + (s == 0 ? OFF_GU1 : OFF_GU2) + (size_t)l * SZ_GU); g.N = NGU;
                    E.mode = 0; E.rs = ssq + (size_t)(4 * l + (s == 0 ? 0 : 3)) * T; E.ldo = DFF;
                } else if (s == 1 || s == 9) {
                    g.A = big; g.lda = DFF; g.K = DFF;
                    g.Bt = (const bf16_t*)(P.ws + (s == 1 ? OFF_DN1 : OFF_DN2) + (size_t)l * SZ_DN);
                    E.alpha = 0.5f; E.ssq_out = ssq + (size_t)(4 * l + (s == 1 ? 1 : 4)) * T;
                    if (ph == 2) E.xin = P.in[0];
                    if (ph == 20) { E.xout = P.out; E.ssq_out = nullptr; }
                } else if (s == 2) {
                    E.mode = 2; E.rs = ssq + (size_t)(4 * l + 1) * T;
                    if (l == 0) { g.Bt = (const bf16_t*)(P.ws + OFF_EVIN); g.N = 2304; E.ldo = 2304; E.qg = P.in[7]; E.kg = P.in[8]; E.qn_end = 512; E.kn_beg = 1024; E.kn_end = 1152; }
                    else { g.Bt = (const bf16_t*)(P.ws + OFF_ODIN); g.N = 3072; E.ldo = 3072; E.qg = P.in[12]; E.kg = P.in[13]; E.qn_end = 1024; E.kn_beg = 1024; E.kn_end = 2048; }
                } else if (s == 4) {
                    g.A = big;
                    if (l == 0) { g.Bt = (const bf16_t*)(P.ws + OFF_EVOUT); g.lda = 2304; }
                    else { g.Bt = (const bf16_t*)(P.ws + OFF_ODOUT); g.lda = 3072; }
                    E.ssq_out = ssq + (size_t)(4 * l + 2) * T;
                } else if (s == 5) {
                    g.Bt = (const bf16_t*)(P.ws + OFF_WQ + (size_t)l * SZ_MM); E.mode = 2; E.rs = ssq + (size_t)(4 * l + 2) * T; E.ldo = D;
                } else {
                    g.A = big; g.Bt = (const bf16_t*)(P.ws + OFF_WO + (size_t)l * SZ_MM); E.ssq_out = ssq + (size_t)(4 * l + 3) * T;
                }
                pg8::StaticOrder So; So.init(T, g.N, (int)gridDim.x, (int)blockIdx.x);
                E.dryrun = 0;
#if PROBE_GEMM
                for (int rep_ = 0; rep_ < 2; ++rep_) {
                pg8::Epi E2 = E;
                if (rep_ == 0) { if (PROBE_GEMM == 1) E2.dryrun = 1; else if (E.mode == 1) { E2.alpha = 0.f; } }
                __syncthreads();
                pg8::gemm_phase<pg8::Epi, pg8::StaticOrder, true, true>((PG8_LAS unsigned char*)smem, g, So, rep_ == 0 ? E2 : E);
                ++nbar; fast_grid_sync((unsigned*)(P.ws + OFF_BAR), nbar * gridDim.x);
                }
#else
                __syncthreads();
                pg8::gemm_phase<pg8::Epi, pg8::StaticOrder, true, true>((PG8_LAS unsigned char*)smem, g, So, E);
#endif
                if (ph == 1) {
                    GJob J;
                    J.A = xb; J.lda = D; J.ksplit = 1 << 30; J.kextra = 0; J.K = D; J.ntm = 4; J.mode = 3; J.rs = nullptr;
                    J.O = big; J.ldo = D; J.xin = P.out; J.xout = P.out; J.xb = xb; J.ssq_out = ssq; J.alpha = 1.f;
                    J.qg = nullptr; J.kg = nullptr; J.qn_end = 0; J.kn_end = 0; J.vt = nullptr; J.W = nullptr; J.ntn = 8;
                    gemm_phase(J, 0, 64, P, smem, false);
                }
                if (ph == 2 && !dry) knorm_phase(P);
            }
        }
        if (P.ws == nullptr) grid.sync();
        if (ph < 20) { ++nbar; fast_grid_sync((unsigned*)(P.ws + OFF_BAR), nbar * gridDim.x); }
        }
    }
}

extern "C" void kernel_launch(void* const* d_in, const int* in_sizes, int n_in, void* d_out, int out_size, void* d_ws, size_t ws_size,
                              hipStream_t stream) {
    static int grid_blocks = 0;
    if (!grid_blocks) {
        int dev = 0, cus = 0, per_cu = 0;
        hipGetDevice(&dev);
        hipDeviceGetAttribute(&cus, hipDeviceAttributeMultiprocessorCount, dev);
        hipFuncSetAttribute((const void*)fwd_megakernel, hipFuncAttributeMaxDynamicSharedMemorySize, LDS_BYTES);
        hipOccupancyMaxActiveBlocksPerMultiprocessor(&per_cu, fwd_megakernel, NTHR, LDS_BYTES);
        if (per_cu < 1) per_cu = 1;
        if (per_cu > 1) per_cu = 1;
        grid_blocks = cus * per_cu;
    }
    if (ws_size < WS_NEED) { fprintf(stderr, "workspace too small: %zu < %zu\n", ws_size, (size_t)WS_NEED); return; }
    Params p{};
    for (int i = 0; i < 25; ++i) p.in[i] = (const float*)d_in[i];
    p.out = (float*)d_out; p.ws = (char*)d_ws;
    hipMemsetAsync((char*)d_ws + OFF_BAR, 0, 256, stream);
    void* args[] = {&p};
    hipError_t e = hipLaunchCooperativeKernel((void*)fwd_megakernel, dim3(grid_blocks), dim3(NTHR), args, LDS_BYTES, stream);
    if (e != hipSuccess) fprintf(stderr, "cooperative launch failed: %s (grid %d)\n", hipGetErrorString(e), grid_blocks);
}
```

```cpp
#include <hip/hip_runtime.h>
#include <hip/hip_cooperative_groups.h>
#include <cstdio>
#include <cstdint>
namespace cg = cooperative_groups;

#define DI __device__ __forceinline__
typedef unsigned short bf16_t;
typedef short bf16x8 __attribute__((ext_vector_type(8)));
typedef short s16x4 __attribute__((ext_vector_type(4)));
typedef float f32x16 __attribute__((ext_vector_type(16)));
typedef __bf16 bf2_t __attribute__((ext_vector_type(2)));
typedef float f2_t __attribute__((ext_vector_type(2)));
typedef short v4i16_t __attribute__((ext_vector_type(4)));
#define MFMA(a, b, c) __builtin_amdgcn_mfma_f32_32x32x16_bf16((a), (b), (c), 0, 0, 0)

constexpr int T = 16384, S = 4096, D = 1024, DFF = 2816, NGU = 5632;
constexpr float EPS = 1e-6f;
constexpr float LOG2E = 1.4426950408889634f;
constexpr float LN2 = 0.6931471805599453f;

constexpr size_t SZ_GU = (size_t)NGU * D * 2, SZ_DN = (size_t)D * DFF * 2, SZ_MM = (size_t)D * D * 2;
constexpr size_t OFF_GU1 = 0;
constexpr size_t OFF_DN1 = OFF_GU1 + 2 * SZ_GU;
constexpr size_t OFF_GU2 = OFF_DN1 + 2 * SZ_DN;
constexpr size_t OFF_DN2 = OFF_GU2 + 2 * SZ_GU;
constexpr size_t OFF_WQ = OFF_DN2 + 2 * SZ_DN;
constexpr size_t OFF_WKV = OFF_WQ + 2 * SZ_MM;
constexpr size_t OFF_WO = OFF_WKV + 4 * SZ_MM;
constexpr size_t OFF_EVIN = OFF_WO + 2 * SZ_MM;
constexpr size_t OFF_EVOUT = OFF_EVIN + (size_t)2304 * D * 2;
constexpr size_t OFF_ODIN = OFF_EVOUT + SZ_MM;
constexpr size_t OFF_ODOUT = OFF_ODIN + (size_t)3072 * D * 2;
constexpr size_t OFF_XB = OFF_ODOUT + SZ_MM;
constexpr size_t OFF_BIG = OFF_XB + (size_t)T * D * 2;
constexpr size_t OFF_MEMB = OFF_BIG + (size_t)T * 3072 * 2;
constexpr size_t OFF_KN = OFF_MEMB + SZ_MM;
constexpr size_t OFF_VT = OFF_KN + 2 * SZ_MM;
constexpr size_t OFF_SSQ = OFF_VT + 2 * SZ_MM;
constexpr size_t OFF_SSQM = OFF_SSQ + (size_t)9 * T * 4;
constexpr size_t OFF_KMAX = OFF_SSQM + 4096;
constexpr size_t OFF_BAR = OFF_KMAX + 256;
constexpr size_t OFF_KF = OFF_BAR + 16384;
constexpr size_t WS_NEED = OFF_KF + 2 * SZ_MM;

#ifndef PROBE_MASK
#define PROBE_MASK 0
#endif
#ifndef PROBE_GEMM
#define PROBE_GEMM 0
#endif
constexpr int NTHR = 512;
constexpr int NST = 4;
constexpr int STAGE_B = 32768;
constexpr int OPB = 16384;
constexpr int LDS_BYTES = 147456;

struct Params { const float* in[25]; float* out; char* ws; };

DI unsigned pk2(float a, float b) { f2_t v = {a, b}; bf2_t r = __builtin_convertvector(v, bf2_t); return __builtin_bit_cast(unsigned, r); }
DI float bflo(unsigned w) { return __uint_as_float(w << 16); }
DI float bfhi(unsigned w) { return __uint_as_float(w & 0xffff0000u); }
DI int otid() { int t = threadIdx.x; asm volatile("" : "+v"(t)); return t; }
DI int crow(int i, int h) { return (i & 3) + 8 * (i >> 2) + 4 * h; }
DI float fexp2(float x) { return __builtin_amdgcn_exp2f(x); }
DI float flog2(float x) { return __builtin_amdgcn_logf(x); }

struct WJob { const float* src; bf16_t* dst; const float* gain; int K, N, gu; };

DI int wjob_tiles(int j) {
    if (j < 14) {
        const int kind = j >> 1;
        switch (kind) {
            case 0: case 2: return 16 * 88;
            case 1: case 3: return 44 * 16;
            case 4: return 256;
            case 5: return 512;
            default: return 256;
        }
    }
    if (j == 14) return 16 * 36;
    if (j == 16) return 16 * 48;
    return 256;
}

DI WJob get_wjob(const Params& P, int j) {
    WJob w; w.gain = nullptr; w.gu = 0;
    bf16_t* wsb = (bf16_t*)P.ws;
    if (j < 14) {
        const int kind = j >> 1, l = j & 1;
        switch (kind) {
            case 0: w.src = P.in[3] + (size_t)l * D * NGU; w.dst = (bf16_t*)(P.ws + OFF_GU1 + l * SZ_GU); w.gain = P.in[2] + l * D; w.K = D; w.N = NGU; w.gu = 1; break;
            case 1: w.src = P.in[4] + (size_t)l * DFF * D; w.dst = (bf16_t*)(P.ws + OFF_DN1 + l * SZ_DN); w.K = DFF; w.N = D; w.gu = 2; break;
            case 2: w.src = P.in[23] + (size_t)l * D * NGU; w.dst = (bf16_t*)(P.ws + OFF_GU2 + l * SZ_GU); w.gain = P.in[22] + l * D; w.K = D; w.N = NGU; w.gu = 1; break;
            case 3: w.src = P.in[24] + (size_t)l * DFF * D; w.dst = (bf16_t*)(P.ws + OFF_DN2 + l * SZ_DN); w.K = DFF; w.N = D; w.gu = 2; break;
            case 4: w.src = P.in[17] + (size_t)l * D * D; w.dst = (bf16_t*)(P.ws + OFF_WQ + l * SZ_MM); w.gain = P.in[15] + l * D; w.K = D; w.N = D; w.gu = 2; break;
            case 5: w.src = P.in[18] + (size_t)l * D * 2048; w.dst = (bf16_t*)(P.ws + OFF_WKV + l * 2 * SZ_MM); w.gain = P.in[16] + l * D; w.K = D; w.N = 2048; break;
            default: w.src = P.in[21] + (size_t)l * D * D; w.dst = (bf16_t*)(P.ws + OFF_WO + l * SZ_MM); w.K = D; w.N = D; w.gu = 2; break;
        }
    } else if (j == 14) { w.src = P.in[6]; w.dst = (bf16_t*)(P.ws + OFF_EVIN); w.gain = P.in[5]; w.K = D; w.N = 2304; w.gu = 3; }
    else if (j == 15) { w.src = P.in[10]; w.dst = (bf16_t*)(P.ws + OFF_EVOUT); w.K = D; w.N = D; w.gu = 2; }
    else if (j == 16) { w.src = P.in[11]; w.dst = (bf16_t*)(P.ws + OFF_ODIN); w.gain = P.in[5] + D; w.K = D; w.N = 3072; w.gu = 2; }
    else { w.src = P.in[14]; w.dst = (bf16_t*)(P.ws + OFF_ODOUT); w.K = D; w.N = D; w.gu = 2; }
    (void)wsb;
    return w;
}

DI void wconv_tile(const WJob& w, int t, float* sm, int tid, bool act) {
    const int ntn = w.N >> 6; const int tk = t / ntn, tn = t - tk * ntn;
    if (act) {
#pragma unroll
        for (int p = 0; p < 4; ++p) {
            const int kr = p * 16 + (tid >> 4);
            typedef float f32x4nt __attribute__((ext_vector_type(4)));
            const f32x4nt v = __builtin_nontemporal_load((const f32x4nt*)(w.src + (size_t)(tk * 64 + kr) * w.N + tn * 64 + (tid & 15) * 4));
            const float g = w.gain ? w.gain[tk * 64 + kr] : 1.f;
            float* sp = sm + kr * 65 + (tid & 15) * 4;
            sp[0] = v[0] * g; sp[1] = v[1] * g; sp[2] = v[2] * g; sp[3] = v[3] * g;
        }
    }
    __syncthreads();
    if (act) {
        const int n = tid >> 2, kq = tid & 3; const int ng = tn * 64 + n;
        int drow = ng;
        if (w.gu == 1) drow = ng < DFF ? ((ng >> 7) * 256 + (ng & 127)) : (((ng - DFF) >> 7) * 256 + 128 + ((ng - DFF) & 127));
        else if (w.gu >= 2) {
            int a = ng;
            if (w.gu == 3) a = ng < 512 ? ng : ng < 768 ? ng + 512 : ng < 1280 ? ng - 256 : ng;
            drow = (a & ~255) + (((a >> 5) & 1) << 7) + (((a >> 6) & 3) << 5) + (a & 31);
        }
        unsigned o[8];
#pragma unroll
        for (int e = 0; e < 8; ++e) o[e] = pk2(sm[(kq * 16 + 2 * e) * 65 + n], sm[(kq * 16 + 2 * e + 1) * 65 + n]);
        uint4* dp = (uint4*)(w.dst + (size_t)drow * w.K + tk * 64 + kq * 16);
        dp[0] = make_uint4(o[0], o[1], o[2], o[3]); dp[1] = make_uint4(o[4], o[5], o[6], o[7]);
    }
    __syncthreads();
}

DI float wave_sum(float v) {
    v += __shfl_xor(v, 1); v += __shfl_xor(v, 2); v += __shfl_xor(v, 4); v += __shfl_xor(v, 8); v += __shfl_xor(v, 16); v += __shfl_xor(v, 32);
    return v;
}

DI void rowconv(const float* src, bf16_t* dst, float* ssq, int row, int lane) {
    const float* xr = src + (size_t)row * D;
    float ss = 0.f;
#pragma unroll
    for (int p = 0; p < 4; ++p) {
        const float4 v = *(const float4*)(xr + p * 256 + lane * 4);
        ss += v.x * v.x + v.y * v.y + v.z * v.z + v.w * v.w;
        *(uint2*)(dst + (size_t)row * D + p * 256 + lane * 4) = make_uint2(pk2(v.x, v.y), pk2(v.z, v.w));
    }
    ss = wave_sum(ss);
    if (lane == 0) ssq[row] = ss;
}

DI void phase0(const Params& P, char* smem) {
    const int tid = otid(), lane = tid & 63, wid = tid >> 6;
    float* ssq = (float*)(P.ws + OFF_SSQ);
    for (int i = blockIdx.x * NTHR + tid; i < 8 * T; i += gridDim.x * NTHR) ssq[T + i] = 0.f;
    if (blockIdx.x == 0 && tid < 32) ((unsigned*)(P.ws + OFF_KMAX))[tid] = 0u;
    constexpr int NW = 12352 / 2, NX = T / 8, NM = 1024 / 8;
    for (int u = blockIdx.x; u < NW + NX + NM; u += gridDim.x) {
        if (u < NW) {
            const int half = tid >> 8;
            int t = 2 * u + half, j = 0;
            for (; j < 17; ++j) { const int c = wjob_tiles(j); if (t < c) break; t -= c; }
            const WJob w = get_wjob(P, j);
            wconv_tile(w, t, (float*)smem + half * (64 * 65), tid & 255, true);
        } else if (u < NW + NX) {
            rowconv(P.in[0], (bf16_t*)(P.ws + OFF_XB), ssq, (u - NW) * 8 + wid, lane);
        } else {
            rowconv(P.in[1], (bf16_t*)(P.ws + OFF_MEMB), (float*)(P.ws + OFF_SSQM), (u - NW - NX) * 8 + wid, lane);
        }
    }
}

struct GJob {
    const bf16_t* A; const bf16_t* W;
    int lda, ksplit, kextra, K, ntm, ntn, mode;
    const float* rs;
    bf16_t* O; int ldo;
    const float* xin; float* xout; bf16_t* xb; float* ssq_out; float alpha;
    const float* qg; const float* kg; int qn_end, kn_end;
    bf16_t* vt;
};

typedef __attribute__((address_space(3))) unsigned* ldsu_t;
typedef const __attribute__((address_space(1))) unsigned* glbu_t;
DI void glds16(const bf16_t* g, char* l) { __builtin_amdgcn_global_load_lds((glbu_t)(const void*)g, (ldsu_t)(void*)l, 16, 0, 0); }

DI void gemm_tile(const GJob& J, int t, char* smem, bool dry) {
    const int tid = otid(), lane = tid & 63, wid = tid >> 6, wr = wid >> 2, wc = wid & 3;
    const int r = lane & 31, h = lane >> 5;
    int tm, tn;
    { const int gsz = 32 * J.ntn; const int g = t / gsz; const int rem = t - g * gsz; const int rows = min(32, J.ntm - g * 32); tn = rem / rows; tm = g * 32 + (rem - tn * rows); }
    const int lrow = wid * 16 + (lane >> 2);
    const int csw = ((lane & 3) ^ ((lane >> 4) & 3)) * 8;
    const bf16_t* Ag = J.A + (size_t)(tm * 256 + lrow) * J.lda + csw;
    const bf16_t* Wg = J.W + (size_t)(tn * 256 + lrow) * J.K + csw;
    const size_t astr = (size_t)128 * J.lda, wstr = (size_t)128 * J.K;
    char* lb = smem + tid * 16;
    const int nk = J.K >> 5;
#define GLDS(kt, buf) do { const int k0_ = (kt) * 32; const int ka_ = k0_ + (k0_ >= J.ksplit ? J.kextra : 0); char* l_ = lb + (buf) * STAGE_B; \
        glds16(Ag + ka_, l_); glds16(Ag + astr + ka_, l_ + 8192); glds16(Wg + k0_, l_ + OPB); glds16(Wg + wstr + k0_, l_ + OPB + 8192); } while (0)
    f32x16 acc[4][2];
#pragma unroll
    for (int a = 0; a < 4; ++a)
#pragma unroll
        for (int b = 0; b < 2; ++b)
#pragma unroll
            for (int i = 0; i < 16; ++i) acc[a][b][i] = 0.f;
    const int fr = (r >> 2) & 3;
    const int xrow = (wc * 64 + r) * 64, wrow = OPB + (wr * 128 + r) * 64;
    const int co0 = ((0 + h) ^ fr) * 16, co1 = ((2 + h) ^ fr) * 16;

    __syncthreads();
    GLDS(0, 0); GLDS(1, 1); GLDS(2, 2);
    asm volatile("s_waitcnt vmcnt(8)" ::: "memory");
    __builtin_amdgcn_s_barrier();
    bf16x8 w0[4], x0[2], w1[4], x1[2];
#define LOADF(W_, X_, sb_, co_) do { _Pragma("unroll") for (int ti = 0; ti < 2; ++ti) X_[ti] = *(const bf16x8*)((sb_) + xrow + ti * 2048 + (co_)); \
        _Pragma("unroll") for (int fi = 0; fi < 4; ++fi) W_[fi] = *(const bf16x8*)((sb_) + wrow + fi * 2048 + (co_)); } while (0)
#define MFMA8(W_, X_) do { __builtin_amdgcn_s_setprio(1); _Pragma("unroll") for (int fi = 0; fi < 4; ++fi) _Pragma("unroll") for (int ti = 0; ti < 2; ++ti) \
        acc[fi][ti] = MFMA(W_[fi], X_[ti], acc[fi][ti]); __builtin_amdgcn_s_setprio(0); } while (0)
    LOADF(w0, x0, smem, co0);
    __builtin_amdgcn_s_waitcnt(0xC07F);
    int buf = 0;
    for (int kt = 0; kt < nk; ++kt) {
        const char* sb = smem + buf * STAGE_B;
        LOADF(w1, x1, sb, co1);
        __builtin_amdgcn_sched_barrier(0);
        MFMA8(w0, x0);
        __builtin_amdgcn_s_waitcnt(0xC07F);
        __builtin_amdgcn_sched_barrier(0);
        const int nb = (buf + 1 == NST) ? 0 : buf + 1;
        if (kt + 1 < nk) {
            if (kt + 2 < nk) asm volatile("s_waitcnt vmcnt(4)" ::: "memory"); else asm volatile("s_waitcnt vmcnt(0)" ::: "memory");
            __builtin_amdgcn_s_barrier();
            if (kt + 3 < nk) { const int fb_ = (buf + 3 >= NST) ? buf + 3 - NST : buf + 3; GLDS(kt + 3, fb_); }
        }
        LOADF(w0, x0, smem + nb * STAGE_B, co0);
        __builtin_amdgcn_sched_barrier(0);
        MFMA8(w1, x1);
        __builtin_amdgcn_s_waitcnt(0xC07F);
        __builtin_amdgcn_sched_barrier(0);
        buf = nb;
    }
#undef LOADF
#undef MFMA8
#undef GLDS
    __syncthreads();

    if (dry) { if (acc[0][0][0] + acc[1][1][0] + acc[2][0][0] + acc[3][1][0] == 12345.678f) J.O[0] = 1; return; }
    const int tokb = tm * 256 + wc * 64;
    const int fb = tn * 256 + wr * 128;
    float rsc[2];
#pragma unroll
    for (int ti = 0; ti < 2; ++ti) rsc[ti] = J.rs ? __builtin_amdgcn_rsqf(J.rs[tokb + ti * 32 + r] * (1.f / 1024.f) + EPS) : 1.f;

    if (J.mode == 3 && fb >= 1024) {
#pragma unroll
        for (int ti = 0; ti < 2; ++ti) {
            const int tok = tokb + ti * 32 + r;
#pragma unroll
            for (int fi = 0; fi < 4; ++fi)
#pragma unroll
                for (int i = 0; i < 16; ++i) {
                    const int f = fb - 1024 + fi * 32 + crow(i, h);
                    const int bh_ = (tok >> 8) * 4 + (f >> 8), d_ = f & 255, key_ = tok & 255, k16 = key_ & 15;
                    const int ln_ = ((k16 >> 2) & 1) * 32 + (d_ & 31), e_ = ((k16 >> 3) << 2) | (k16 & 3);
                    J.vt[((((((size_t)bh_ * 8 + (d_ >> 5)) * 8 + (key_ >> 5)) * 2 + ((key_ >> 4) & 1)) * 64 + ln_) << 3) + e_] = (bf16_t)(pk2(acc[fi][ti][i] * rsc[ti], 0.f) & 0xffffu);
                }
        }
        return;
    }
    char* wl = smem + wid * 16384;
#pragma unroll
    for (int ti = 0; ti < 2; ++ti) {
#pragma unroll
        for (int fp = 0; fp < 2; ++fp) {
            const float sc = (J.mode == 1) ? J.alpha : rsc[ti];
#pragma unroll
            for (int fi2 = 0; fi2 < 2; ++fi2)
#pragma unroll
                for (int g = 0; g < 4; ++g) {
                    float4 v;
                    v.x = acc[2 * fp + fi2][ti][4 * g + 0] * sc; v.y = acc[2 * fp + fi2][ti][4 * g + 1] * sc;
                    v.z = acc[2 * fp + fi2][ti][4 * g + 2] * sc; v.w = acc[2 * fp + fi2][ti][4 * g + 3] * sc;
                    *(float4*)(wl + r * 272 + (fi2 * 32 + 8 * g + 4 * h) * 4) = v;
                }
            const int tok0 = tokb + ti * 32, f0 = fb + fp * 64;
            if (J.mode == 0) {
                const int c4 = (lane & 7) * 4;
#pragma unroll
                for (int p = 0; p < 4; ++p) {
                    const int row = p * 8 + (lane >> 3);
                    const float4 ga = *(const float4*)(wl + row * 272 + c4 * 4);
                    const float4 up = *(const float4*)(wl + row * 272 + (32 + c4) * 4);
                    float y0 = ga.x * up.x * __builtin_amdgcn_rcpf(1.f + fexp2(-ga.x * LOG2E));
                    float y1 = ga.y * up.y * __builtin_amdgcn_rcpf(1.f + fexp2(-ga.y * LOG2E));
                    float y2 = ga.z * up.z * __builtin_amdgcn_rcpf(1.f + fexp2(-ga.z * LOG2E));
                    float y3 = ga.w * up.w * __builtin_amdgcn_rcpf(1.f + fexp2(-ga.w * LOG2E));
                    *(uint2*)(J.O + (size_t)(tok0 + row) * J.ldo + (f0 >> 1) + c4) = make_uint2(pk2(y0, y1), pk2(y2, y3));
                }
            } else if (J.mode == 1) {
                const int c4 = (lane & 15) * 4;
#pragma unroll
                for (int p = 0; p < 8; ++p) {
                    const int row = p * 4 + (lane >> 4);
                    const size_t tok = tok0 + row;
                    const float4 v = *(const float4*)(wl + row * 272 + c4 * 4);
                    const float4 xo = *(const float4*)(J.xin + tok * D + f0 + c4);
                    float4 xn; xn.x = xo.x + v.x; xn.y = xo.y + v.y; xn.z = xo.z + v.z; xn.w = xo.w + v.w;
                    *(float4*)(J.xout + tok * D + f0 + c4) = xn;
                    if (J.xb) {
                        *(uint2*)(J.xb + tok * D + f0 + c4) = make_uint2(pk2(xn.x, xn.y), pk2(xn.z, xn.w));
                        float ss = xn.x * xn.x + xn.y * xn.y + xn.z * xn.z + xn.w * xn.w;
                        ss += __shfl_xor(ss, 1); ss += __shfl_xor(ss, 2); ss += __shfl_xor(ss, 4); ss += __shfl_xor(ss, 8);
                        if ((lane & 15) == 0) atomicAdd(J.ssq_out + tok, ss);
                    }
                }
            } else {
                const int nm = f0 < J.qn_end ? 1 : (f0 < J.kn_end ? 2 : 0);
                const float* gp = nm == 1 ? J.qg : J.kg;
                const int c4 = (lane & 15) * 4;
                float4 gn = make_float4(1.f, 1.f, 1.f, 1.f);
                if (nm) gn = *(const float4*)(gp + c4);
#pragma unroll
                for (int p = 0; p < 8; ++p) {
                    const int row = p * 4 + (lane >> 4);
                    float4 v = *(const float4*)(wl + row * 272 + c4 * 4);
                    if (nm) {
                        float ss = v.x * v.x + v.y * v.y + v.z * v.z + v.w * v.w;
                        ss += __shfl_xor(ss, 1); ss += __shfl_xor(ss, 2); ss += __shfl_xor(ss, 4); ss += __shfl_xor(ss, 8);
                        const float inv = __builtin_amdgcn_rsqf(ss * (1.f / 64.f) + EPS);
                        v.x *= inv * gn.x; v.y *= inv * gn.y; v.z *= inv * gn.z; v.w *= inv * gn.w;
                    }
                    *(uint2*)(J.O + (size_t)(tok0 + row) * J.ldo + f0 + c4) = make_uint2(pk2(v.x, v.y), pk2(v.z, v.w));
                }
            }
        }
    }
}

DI void gemm_phase(const GJob& JA, int nA, int nB, const Params& P, char* smem, bool dry) {
    for (int u = (int)gridDim.x - 1 - (int)blockIdx.x; u < nA + nB; u += gridDim.x) {
        GJob J = JA; int t = u;
        if (u >= nA) {
            const int v = u - nA; const int layer = v >> 5; t = v & 31;
            J.A = (const bf16_t*)(P.ws + OFF_MEMB); J.lda = D; J.ksplit = 1 << 30; J.kextra = 0;
            J.W = (const bf16_t*)(P.ws + OFF_WKV + (size_t)layer * 2 * SZ_MM); J.K = D; J.ntm = 4; J.ntn = 8; J.mode = 3;
            J.rs = (const float*)(P.ws + OFF_SSQM); J.O = (bf16_t*)(P.ws + OFF_KN + (size_t)layer * SZ_MM); J.ldo = D;
            J.qn_end = 0; J.kn_end = 0; J.vt = (bf16_t*)(P.ws + OFF_VT + (size_t)layer * SZ_MM);
        }
        gemm_tile(J, t, smem, dry);
    }
}

namespace pg8 {
#define PG8_LAS __attribute__((address_space(3)))
typedef float f32x4 __attribute__((ext_vector_type(4)));
typedef unsigned u32x4 __attribute__((ext_vector_type(4)));
constexpr int BM = 256, BK = 64, HALF = 128, HTB = HALF * BK * 2, STAGE_BYTES = 8 * HTB, NXCD = 8, WGM = 8;
DI int lds_byte(int r, int c) { const int st = (r >> 4) * 2 + (c >> 5), rr = r & 15, cc = c & 31, ob = rr * 64 + cc * 2; return st * 1024 + (ob ^ (((ob >> 9) & 1) << 5)); }
DI void stage_rc(int b, int& R, int& C) { const int st = b / 1024, sb = b % 1024, swz = sb ^ (((sb >> 9) & 1) << 5); R = (st >> 1) * 16 + swz / 64; C = (st & 1) * 32 + (swz % 64) / 2; }
DI int perm32(int rho) { const int n = rho >> 4, i = rho & 15; return 8 * (i >> 2) + 4 * n + (i & 3); }
struct Unit { int pm, pn; };
struct Gemm { const bf16_t* A; const bf16_t* Bt; int M, N, K, lda; };
struct StaticOrder {
    int nM, nN, nwg, G, c;
    DI void init(int M, int N, int G_, int c_) { nM = M / BM; nN = N / BM; nwg = nM * nN; G = G_; c = c_; }
    DI bool next(int i, Unit& u) const {
        const long L = (long)i * G + c; if (L >= nwg) return false;
        int wgid = (int)L; { const int q = nwg / NXCD, r = nwg % NXCD, xcd = wgid % NXCD, off = wgid / NXCD; wgid = (xcd < r ? xcd * (q + 1) : r * (q + 1) + (xcd - r) * q) + off; }
        const int nig = WGM * nN, gid = wgid / nig, fm = gid * WGM, gsz = (nM - fm) < WGM ? (nM - fm) : WGM;
        u.pm = fm + ((wgid % nig) % gsz); u.pn = (wgid % nig) / gsz; return true;
    }
    DI void a_ready(const Unit&) const {}
    DI void done(const Unit&) const {}
};

struct Epi {
    static constexpr bool PERM = true, AFTER_DRAIN = false;
    int mode;
    const float* rs;
    bf16_t* O; int ldo;
    const float* xin; float* xout; bf16_t* xb; float* ssq_out; float alpha;
    const float* qg; const float* kg; int qn_end, kn_beg, kn_end; int dryrun;
    DI void operator()(const f32x4 (&acc)[2][2][4][2], const Unit& u, int wr, int wc, int fr, int fq) const {
        if (dryrun) { if (acc[0][0][0][0][0] + acc[1][1][3][1][3] + acc[0][1][2][0][1] + acc[1][0][1][1][2] == 12345.678f) O[0] = 1; return; }
        const int row0 = u.pm * BM + wr * 64 + fr;
        if (mode == 0) {
            const int col = u.pn * 128 + wc * 32 + 8 * fq;
#pragma unroll
            for (int ai = 0; ai < 2; ++ai)
#pragma unroll
                for (int m = 0; m < 4; ++m) {
                    const size_t tok = row0 + ai * HALF + m * 16;
                    const float sc = __builtin_amdgcn_rsqf(rs[tok] * (1.f / 1024.f) + EPS);
                    float y[8];
#pragma unroll
                    for (int n = 0; n < 2; ++n)
#pragma unroll
                        for (int j = 0; j < 4; ++j) {
                            const float ga = acc[ai][0][m][n][j] * sc, up = acc[ai][1][m][n][j] * sc;
                            y[4 * n + j] = ga * up * __builtin_amdgcn_rcpf(1.f + fexp2(-ga * LOG2E));
                        }
                    *(uint4*)(O + tok * ldo + col) = make_uint4(pk2(y[0], y[1]), pk2(y[2], y[3]), pk2(y[4], y[5]), pk2(y[6], y[7]));
                }
        } else if (mode == 1) {
#pragma unroll
            for (int ai = 0; ai < 2; ++ai)
#pragma unroll
                for (int m = 0; m < 4; ++m) {
                    const size_t tok = row0 + ai * HALF + m * 16;
                    float ss = 0.f;
#pragma unroll
                    for (int bj = 0; bj < 2; ++bj) {
                        const int col = u.pn * BM + wc * 64 + bj * 32 + 8 * fq;
                        float4 x0, x1;
                        if (xin) { x0 = *(const float4*)(xin + tok * D + col); x1 = *(const float4*)(xin + tok * D + col + 4); }
                        else {
                            const uint4 w = *(const uint4*)(xb + tok * D + col);
                            x0 = make_float4(bflo(w.x), bfhi(w.x), bflo(w.y), bfhi(w.y)); x1 = make_float4(bflo(w.z), bfhi(w.z), bflo(w.w), bfhi(w.w));
                        }
                        float4 n0, n1;
                        n0.x = x0.x + alpha * acc[ai][bj][m][0][0]; n0.y = x0.y + alpha * acc[ai][bj][m][0][1]; n0.z = x0.z + alpha * acc[ai][bj][m][0][2]; n0.w = x0.w + alpha * acc[ai][bj][m][0][3];
                        n1.x = x1.x + alpha * acc[ai][bj][m][1][0]; n1.y = x1.y + alpha * acc[ai][bj][m][1][1]; n1.z = x1.z + alpha * acc[ai][bj][m][1][2]; n1.w = x1.w + alpha * acc[ai][bj][m][1][3];
                        if (xout) { *(float4*)(xout + tok * D + col) = n0; *(float4*)(xout + tok * D + col + 4) = n1; }
                        if (ssq_out) {
                            const uint4 w = make_uint4(pk2(n0.x, n0.y), pk2(n0.z, n0.w), pk2(n1.x, n1.y), pk2(n1.z, n1.w));
                            *(uint4*)(xb + tok * D + col) = w;
                            const float r0 = bflo(w.x), r1 = bfhi(w.x), r2 = bflo(w.y), r3 = bfhi(w.y), r4 = bflo(w.z), r5 = bfhi(w.z), r6 = bflo(w.w), r7 = bfhi(w.w);
                            ss += r0 * r0 + r1 * r1 + r2 * r2 + r3 * r3 + r4 * r4 + r5 * r5 + r6 * r6 + r7 * r7;
                        }
                    }
                    if (ssq_out) {
                        ss += __shfl_xor(ss, 16); ss += __shfl_xor(ss, 32);
                        if (fq == 0) atomicAdd(ssq_out + tok, ss);
                    }
                }
        } else {
            const int f0 = u.pn * BM + wc * 64;
            const int nm = f0 < qn_end ? 1 : ((f0 >= kn_beg && f0 < kn_end) ? 2 : 0);
            const float* gp = nm == 1 ? qg : kg;
            float4 g4[2][2];
#pragma unroll
            for (int bj = 0; bj < 2; ++bj)
#pragma unroll
                for (int n = 0; n < 2; ++n) g4[bj][n] = nm ? *(const float4*)(gp + bj * 32 + 8 * fq + 4 * n) : make_float4(1.f, 1.f, 1.f, 1.f);
#pragma unroll
            for (int ai = 0; ai < 2; ++ai)
#pragma unroll
                for (int m = 0; m < 4; ++m) {
                    const size_t tok = row0 + ai * HALF + m * 16;
                    float sc = rs ? __builtin_amdgcn_rsqf(rs[tok] * (1.f / 1024.f) + EPS) : 1.f;
                    if (nm) {
                        float ss = 0.f;
#pragma unroll
                        for (int bj = 0; bj < 2; ++bj)
#pragma unroll
                            for (int n = 0; n < 2; ++n)
#pragma unroll
                                for (int j = 0; j < 4; ++j) { const float v = acc[ai][bj][m][n][j] * sc; ss += v * v; }
                        ss += __shfl_xor(ss, 16); ss += __shfl_xor(ss, 32);
                        sc *= __builtin_amdgcn_rsqf(ss * (1.f / 64.f) + EPS);
                    }
#pragma unroll
                    for (int bj = 0; bj < 2; ++bj) {
                        const f32x4 a0 = acc[ai][bj][m][0], a1 = acc[ai][bj][m][1];
                        *(uint4*)(O + tok * ldo + f0 + bj * 32 + 8 * fq) =
                            make_uint4(pk2(a0[0] * sc * g4[bj][0].x, a0[1] * sc * g4[bj][0].y), pk2(a0[2] * sc * g4[bj][0].z, a0[3] * sc * g4[bj][0].w),
                                       pk2(a1[0] * sc * g4[bj][1].x, a1[1] * sc * g4[bj][1].y), pk2(a1[2] * sc * g4[bj][1].z, a1[3] * sc * g4[bj][1].w));
                    }
                }
        }
    }
};

template <class Epi, class Sched, bool ALIGN_EPI = false, bool SP2 = false>
__device__ __forceinline__ void gemm_phase(PG8_LAS unsigned char* lds, const Gemm g, const Sched& S, const Epi& E) {
    const int tid = otid(), wid = __builtin_amdgcn_readfirstlane(tid >> 6), lane = tid & 63, wr = wid >> 2, wc = wid & 3, fr = lane & 15, fq = lane >> 4;
    const int K = g.K, nt = K / BK;
    unsigned voffA[2], voffB[2];
#pragma unroll
    for (int i = 0; i < 2; ++i) { int R, C; stage_rc(tid * 16 + i * 8192, R, C); const int Rb = Epi::PERM ? ((R & ~31) + perm32(R & 31)) : R;
        voffA[i] = (unsigned)(R * g.lda + C) * 2u; voffB[i] = (unsigned)(Rb * K + C) * 2u; }
    const size_t kstep = (size_t)(BK * 2);
    const size_t hstepA = (size_t)HALF * g.lda * 2, hstepB = (size_t)HALF * K * 2;
    const size_t tstepA = 2 * hstepA, tstepB = 2 * hstepB;
    const unsigned ldsw = (unsigned)wid * 1024u;
    const int aoff = lds_byte(wr * 64 + fr, fq * 8), boff = lds_byte(wc * 32 + fr, fq * 8);
#define PG8_SA(b, h) (((b) * 2 + (h)) * HTB)
#define PG8_SB(b, h) ((4 + (b) * 2 + (h)) * HTB)
#define PG8_STAGE(bufoff, gbase, voff) do { _Pragma("unroll") for (int _i = 0; _i < 2; ++_i) \
        __builtin_amdgcn_global_load_lds((const unsigned*)((const char*)(gbase) + (voff)[_i]), (PG8_LAS unsigned*)(lds + (bufoff) + ldsw + _i * 8192), 16, 0, 0); } while (0)
#define PG8_LDA(dst, b, h) do { _Pragma("unroll") for (int m = 0; m < 4; ++m) _Pragma("unroll") for (int k = 0; k < 2; ++k) dst[m][k] = *(const PG8_LAS bf16x8*)(lds + PG8_SA(b, h) + aoff + m * 2048 + k * 1024); } while (0)
#define PG8_LDB(dst, b, h) do { _Pragma("unroll") for (int n = 0; n < 2; ++n) _Pragma("unroll") for (int k = 0; k < 2; ++k) dst[n][k] = *(const PG8_LAS bf16x8*)(lds + PG8_SB(b, h) + boff + n * 2048 + k * 1024); } while (0)
#define PG8_MMA(ai, bj, At, Bt) do { __builtin_amdgcn_s_setprio(1); _Pragma("unroll") for (int m = 0; m < 4; ++m) _Pragma("unroll") for (int n = 0; n < 2; ++n) _Pragma("unroll") for (int k = 0; k < 2; ++k) \
        acc[ai][bj][m][n] = __builtin_amdgcn_mfma_f32_16x16x32_bf16(Bt[n][k], At[m][k], acc[ai][bj][m][n], 0, 0, 0); __builtin_amdgcn_s_setprio(0); } while (0)
#define PG8_WAIT_V(n) asm volatile("s_waitcnt vmcnt(" #n ")" ::: "memory")
#define PG8_WAIT_L(n) asm volatile("s_waitcnt lgkmcnt(" #n ")" ::: "memory")
#define PG8_BAR __builtin_amdgcn_s_barrier()
#define PG8_SCHED __builtin_amdgcn_sched_barrier(0)
    Unit cur, nxt; int ui = 0;
    if (!S.next(0, cur)) return;
    f32x4 acc[2][2][4][2];
#pragma unroll
    for (int a = 0; a < 2; ++a)
#pragma unroll
        for (int b = 0; b < 2; ++b)
#pragma unroll
            for (int m = 0; m < 4; ++m)
#pragma unroll
                for (int n = 0; n < 2; ++n) acc[a][b][m][n] = (f32x4){0.f, 0.f, 0.f, 0.f};
    bf16x8 At[4][2], B0[2][2], B1[2][2];
    const char* cA = (const char*)g.A + (size_t)cur.pm * tstepA; const char* cB = (const char*)g.Bt + (size_t)cur.pn * tstepB;
    S.a_ready(cur);
    if constexpr (SP2) {
        PG8_STAGE(PG8_SB(0, 0), cB, voffB); PG8_STAGE(PG8_SB(0, 1), cB + hstepB, voffB); PG8_STAGE(PG8_SA(0, 0), cA, voffA); PG8_STAGE(PG8_SA(0, 1), cA + hstepA, voffA);
        if (wr == 1) PG8_BAR;
        PG8_WAIT_V(2); PG8_BAR;
        PG8_STAGE(PG8_SB(1, 0), cB + kstep, voffB); PG8_STAGE(PG8_SA(1, 0), cA + kstep, voffA); PG8_STAGE(PG8_SB(1, 1), cB + hstepB + kstep, voffB);
        PG8_WAIT_V(6); PG8_BAR;
    } else {
        PG8_STAGE(PG8_SB(0, 0), cB, voffB); PG8_STAGE(PG8_SA(0, 0), cA, voffA); PG8_STAGE(PG8_SB(0, 1), cB + hstepB, voffB); PG8_STAGE(PG8_SA(0, 1), cA + hstepA, voffA);
        if (wr == 1) PG8_BAR;
        PG8_WAIT_V(4); PG8_BAR;
        PG8_STAGE(PG8_SB(1, 0), cB + kstep, voffB); PG8_STAGE(PG8_SA(1, 0), cA + kstep, voffA); PG8_STAGE(PG8_SB(1, 1), cB + hstepB + kstep, voffB);
        PG8_WAIT_V(6); PG8_BAR;
    }
    for (;;) {
        const bool has_next = S.next(ui + 1, nxt);
        const char* nA = has_next ? (const char*)g.A + (size_t)nxt.pm * tstepA : cA; const char* nB = has_next ? (const char*)g.Bt + (size_t)nxt.pn * tstepB : cB;
        for (int t = 0; t < nt; t += 2) {
            const bool last = (t == nt - 2);
            const char* a1 = cA + (size_t)(t + 1) * kstep;
            const char* a2 = last ? nA : cA + (size_t)(t + 2) * kstep; const char* b2 = last ? nB : cB + (size_t)(t + 2) * kstep;
            const char* a3 = a2 + kstep; const char* b3 = b2 + kstep;
            if (last && has_next) S.a_ready(nxt);
            if constexpr (SP2) {
            PG8_LDB(B0, 0, 0); PG8_LDB(B1, 0, 1); PG8_SCHED; PG8_LDA(At, 0, 0); PG8_STAGE(PG8_SA(1, 1), a1 + hstepA, voffA);
            PG8_WAIT_V(8); PG8_WAIT_L(0); PG8_BAR; PG8_MMA(0, 0, At, B0); PG8_MMA(0, 1, At, B1); PG8_BAR; PG8_SCHED;
            PG8_LDA(At, 0, 1); PG8_STAGE(PG8_SB(0, 0), b2, voffB); PG8_STAGE(PG8_SB(0, 1), b2 + hstepB, voffB); PG8_STAGE(PG8_SA(0, 0), a2, voffA);
            PG8_WAIT_V(8); PG8_WAIT_L(0); PG8_BAR; PG8_MMA(1, 0, At, B0); PG8_MMA(1, 1, At, B1); PG8_BAR; PG8_SCHED;
            PG8_LDB(B0, 1, 0); PG8_LDB(B1, 1, 1); PG8_SCHED; PG8_LDA(At, 1, 0); PG8_STAGE(PG8_SA(0, 1), a2 + hstepA, voffA);
            PG8_WAIT_V(8); PG8_WAIT_L(0); PG8_BAR; PG8_MMA(0, 0, At, B0); PG8_MMA(0, 1, At, B1); PG8_BAR; PG8_SCHED;
            PG8_LDA(At, 1, 1); PG8_STAGE(PG8_SB(1, 0), b3, voffB); PG8_STAGE(PG8_SB(1, 1), b3 + hstepB, voffB); PG8_STAGE(PG8_SA(1, 0), a3, voffA);
            PG8_WAIT_V(8); PG8_WAIT_L(0); PG8_BAR; PG8_MMA(1, 0, At, B0); PG8_MMA(1, 1, At, B1); PG8_BAR; PG8_SCHED;
            } else {
            PG8_LDB(B0, 0, 0); PG8_SCHED; PG8_LDA(At, 0, 0); PG8_STAGE(PG8_SA(1, 1), a1 + hstepA, voffA);
            PG8_WAIT_L(8); PG8_BAR; PG8_WAIT_L(0); PG8_MMA(0, 0, At, B0); PG8_BAR; PG8_SCHED;
            PG8_LDB(B1, 0, 1); PG8_STAGE(PG8_SB(0, 0), b2, voffB);
            PG8_BAR; PG8_WAIT_L(0); PG8_MMA(0, 1, At, B1); PG8_BAR;
            PG8_LDA(At, 0, 1); PG8_STAGE(PG8_SA(0, 0), a2, voffA);
            PG8_BAR; PG8_WAIT_L(0); PG8_MMA(1, 0, At, B0); PG8_BAR; PG8_SCHED;
            PG8_STAGE(PG8_SB(0, 1), b2 + hstepB, voffB);
            PG8_WAIT_V(6); PG8_BAR; PG8_MMA(1, 1, At, B1); PG8_BAR;
            PG8_LDB(B0, 1, 0); PG8_SCHED; PG8_LDA(At, 1, 0); PG8_STAGE(PG8_SA(0, 1), a2 + hstepA, voffA);
            PG8_WAIT_L(8); PG8_BAR; PG8_WAIT_L(0); PG8_MMA(0, 0, At, B0); PG8_BAR; PG8_SCHED;
            PG8_LDB(B1, 1, 1); PG8_STAGE(PG8_SB(1, 0), b3, voffB);
            PG8_BAR; PG8_WAIT_L(0); PG8_MMA(0, 1, At, B1); PG8_BAR;
            PG8_LDA(At, 1, 1); PG8_STAGE(PG8_SA(1, 0), a3, voffA);
            PG8_BAR; PG8_WAIT_L(0); PG8_MMA(1, 0, At, B0); PG8_BAR; PG8_SCHED;
            PG8_STAGE(PG8_SB(1, 1), b3 + hstepB, voffB);
            PG8_WAIT_V(6); PG8_BAR; PG8_MMA(1, 1, At, B1); PG8_BAR;
            }
        }
        if constexpr (ALIGN_EPI) { if (wr == 0) PG8_BAR; }
        if constexpr (!Epi::AFTER_DRAIN) { E(acc, cur, wr, wc, fr, fq); S.done(cur); }
        if (!has_next) break;
#pragma unroll
        for (int a = 0; a < 2; ++a)
#pragma unroll
            for (int b = 0; b < 2; ++b)
#pragma unroll
                for (int m = 0; m < 4; ++m)
#pragma unroll
                    for (int n = 0; n < 2; ++n) acc[a][b][m][n] = (f32x4){0.f, 0.f, 0.f, 0.f};
        cur = nxt; cA = nA; cB = nB; ++ui;
        if constexpr (ALIGN_EPI) { if (wr == 1) PG8_BAR; }
    }
    PG8_WAIT_V(0);
    if constexpr (!ALIGN_EPI) { if (wr == 0) PG8_BAR; }
    PG8_BAR;
    if constexpr (Epi::AFTER_DRAIN) { E.fused(acc, cur, wr, wc, fr, fq, lds, wid, lane); S.done(cur); }
#undef PG8_SA
#undef PG8_SB
#undef PG8_STAGE
#undef PG8_LDA
#undef PG8_LDB
#undef PG8_MMA
#undef PG8_WAIT_V
#undef PG8_WAIT_L
#undef PG8_BAR
#undef PG8_SCHED
}
}

#define KV_DECL uint4 rk0, rk1, rk2, rk3, rv0, rv1, rv2, rv3
#define KV_LOAD(kb_, dil_) do { const int kk_ = lane >> 3; \
    const bf16_t* p0_ = qkv + (rowb + min(max((kb_) + (dil_) * kk_, 0), S - 1)) * ld + (lane & 7) * 8; \
    const bf16_t* p1_ = qkv + (rowb + min(max((kb_) + (dil_) * (kk_ + 8), 0), S - 1)) * ld + (lane & 7) * 8; \
    const bf16_t* p2_ = qkv + (rowb + min(max((kb_) + (dil_) * (kk_ + 16), 0), S - 1)) * ld + (lane & 7) * 8; \
    const bf16_t* p3_ = qkv + (rowb + min(max((kb_) + (dil_) * (kk_ + 24), 0), S - 1)) * ld + (lane & 7) * 8; \
    rk0 = *(const uint4*)(p0_ + kcol); rk1 = *(const uint4*)(p1_ + kcol); rk2 = *(const uint4*)(p2_ + kcol); rk3 = *(const uint4*)(p3_ + kcol); \
    rv0 = *(const uint4*)(p0_ + vcol); rv1 = *(const uint4*)(p1_ + vcol); rv2 = *(const uint4*)(p2_ + vcol); rv3 = *(const uint4*)(p3_ + vcol); } while (0)
#define KV_STORE() do { char* wp_ = vl + (lane >> 3) * 144 + (lane & 7) * 16; \
    *(uint4*)(wp_) = rk0; *(uint4*)(wp_ + 8 * 144) = rk1; *(uint4*)(wp_ + 16 * 144) = rk2; *(uint4*)(wp_ + 24 * 144) = rk3; \
    *(uint4*)(wp_ + 4608) = rv0; *(uint4*)(wp_ + 4608 + 8 * 144) = rv1; *(uint4*)(wp_ + 4608 + 16 * 144) = rv2; *(uint4*)(wp_ + 4608 + 24 * 144) = rv3; } while (0)

DI bf16x8 v_frag(const char* vbase, int s, int dt) {
    typedef __attribute__((address_space(3))) v4i16_t* lp_t;
    const char* a = vbase + s * (16 * 144) + dt * 64;
    const s16x4 lo = __builtin_bit_cast(s16x4, __builtin_amdgcn_ds_read_tr16_b64_v4i16((lp_t)(a)));
    const s16x4 hi = __builtin_bit_cast(s16x4, __builtin_amdgcn_ds_read_tr16_b64_v4i16((lp_t)(a + 8 * 144)));
    return __builtin_shufflevector(lo, hi, 0, 1, 2, 3, 4, 5, 6, 7);
}

template <int OFF> DI bf16x8 pack8v(const f32x16& p) {
    typedef unsigned u32x4 __attribute__((ext_vector_type(4)));
    u32x4 w; w[0] = pk2(p[OFF + 0], p[OFF + 1]); w[1] = pk2(p[OFF + 2], p[OFF + 3]); w[2] = pk2(p[OFF + 4], p[OFF + 5]); w[3] = pk2(p[OFF + 6], p[OFF + 7]);
    return __builtin_bit_cast(bf16x8, w);
}

DI void win_attn_wave(bf16_t* qkv, int ld, int b, int qcol, int kcol, int vcol, int tq0, int qstride,
                      float slope2, float m_init, float l_init, int pat, char* vl, int lane, bool dry,
                      int nq = 32, float* st = nullptr, int tloc0 = 0, int tlstride = 0, int stage = 0) {
    const int r = lane & 31, h = lane >> 5;
    const size_t rowb = (size_t)b * S;
    const int tq = tq0 + qstride * r;
    bf16x8 qf[4];
    {
        const bf16_t* qp = qkv + (rowb + min(tq, S - 1)) * ld + qcol + h * 32;
#pragma unroll
        for (int ks = 0; ks < 4; ++ks) qf[ks] = *(const bf16x8*)(qp + ks * 8);
    }
    f32x16 o0, o1;
#pragma unroll
    for (int i = 0; i < 16; ++i) { o0[i] = 0.f; o1[i] = 0.f; }
    float m = m_init, l = (h == 0) ? l_init : 0.f;
    const float sc2 = 0.125f * LOG2E;
    const int i16 = lane & 15;
    const char* vbase = vl + 4608 + (4 * h + (i16 >> 2)) * 144 + (16 * ((lane >> 4) & 1) + 4 * (i16 & 3)) * 2;
    const char* kfp = vl + r * 144 + h * 64;
    KV_DECL;
    for (int pi = 0; pi < 1; ++pi) {
        int dil, W, kfirst; const int nt = 5;
        if (pat < 0) { dil = 1; W = 127; kfirst = tq0 - 128; }
        else if (pat == 0) { dil = 1; W = 128; kfirst = tq0 - 128; }
        else if (pat == 1) { dil = 4; W = 512; kfirst = tq0 - 512; }
        else { dil = 16; W = 2048; kfirst = tq0 - 2048; }
        const int step = 32 * dil;
        int t0 = 0;
        { const int need = -kfirst - 31 * dil; if (need > 0) t0 = (need + step - 1) / step; }
        if (t0 >= nt) continue;
        KV_LOAD(kfirst + t0 * step, dil);
        for (int tile = t0; tile < nt; ++tile) {
            const int kb = kfirst + tile * step;
            KV_STORE();
            asm volatile("" ::: "memory");
            if (tile + 1 < nt) KV_LOAD(kb + step, dil);
            f32x16 s;
#pragma unroll
            for (int i = 0; i < 16; ++i) s[i] = 0.f;
#pragma unroll
            for (int ks = 0; ks < 4; ++ks) s = MFMA(*(const bf16x8*)(kfp + ks * 16), qf[ks], s);
            f32x16 sv; float mloc = -INFINITY;
            const int d0 = tq - kb - 4 * h * dil;
            const float b0 = -slope2 * (float)d0, b1 = slope2 * (float)dil;
            if (tile >= 1 && tile <= 3 && kb >= 0) {
#pragma unroll
                for (int i = 0; i < 16; ++i) {
                    sv[i] = __builtin_fmaf(s[i], sc2, __builtin_fmaf(b1, (float)crow(i, 0), b0));
                    mloc = fmaxf(mloc, sv[i]);
                }
            } else {
                const unsigned wlim = (unsigned)min(W, tq);
#pragma unroll
                for (int i = 0; i < 16; ++i) {
                    const int diff = d0 - dil * crow(i, 0);
                    const float sb = __builtin_fmaf(s[i], sc2, __builtin_fmaf(b1, (float)crow(i, 0), b0));
                    sv[i] = ((unsigned)diff <= wlim) ? sb : -INFINITY;
                    mloc = fmaxf(mloc, sv[i]);
                }
            }
            mloc = fmaxf(mloc, __shfl_xor(mloc, 32));
            const float mn = fmaxf(m, mloc);
            float ps = 0.f;
#pragma unroll
            for (int i = 0; i < 16; ++i) { sv[i] = fexp2(sv[i] - mn); ps += sv[i]; }
            if (__builtin_amdgcn_ballot_w64(mn != m) != 0) {
                const float alpha = fexp2(m - mn);
                l *= alpha;
#pragma unroll
                for (int i = 0; i < 16; ++i) { o0[i] *= alpha; o1[i] *= alpha; }
                m = mn;
            }
            l += ps;
            const bf16x8 p0 = pack8v<0>(sv), p1 = pack8v<8>(sv);
            o0 = MFMA(v_frag(vbase, 0, 0), p0, o0);
            o0 = MFMA(v_frag(vbase, 1, 0), p1, o0);
            o1 = MFMA(v_frag(vbase, 0, 1), p0, o1);
            o1 = MFMA(v_frag(vbase, 1, 1), p1, o1);
            asm volatile("" ::: "memory");
        }
    }
    float lt = l + __shfl_xor(l, 32);
    if (st) {
        const bool act = r < nq;
        float* sp = st + (tloc0 + tlstride * r) * 68;
        if (act) {
            if (stage > 0) {
                const float ms = sp[64], ls = sp[65];
                const float mn = fmaxf(ms, m);
                const float as = fexp2(ms - mn), aw = fexp2(m - mn);
                lt = ls * as + lt * aw; m = mn;
#pragma unroll
                for (int g = 0; g < 4; ++g) {
                    const float4 a = *(const float4*)(sp + 8 * g + 4 * h), c = *(const float4*)(sp + 32 + 8 * g + 4 * h);
                    o0[4 * g] = a.x * as + o0[4 * g] * aw; o0[4 * g + 1] = a.y * as + o0[4 * g + 1] * aw; o0[4 * g + 2] = a.z * as + o0[4 * g + 2] * aw; o0[4 * g + 3] = a.w * as + o0[4 * g + 3] * aw;
                    o1[4 * g] = c.x * as + o1[4 * g] * aw; o1[4 * g + 1] = c.y * as + o1[4 * g + 1] * aw; o1[4 * g + 2] = c.z * as + o1[4 * g + 2] * aw; o1[4 * g + 3] = c.w * as + o1[4 * g + 3] * aw;
                }
            }
            if (stage < 2) {
                if (h == 0) { sp[64] = m; sp[65] = lt; }
#pragma unroll
                for (int g = 0; g < 4; ++g) {
                    *(float4*)(sp + 8 * g + 4 * h) = make_float4(o0[4 * g], o0[4 * g + 1], o0[4 * g + 2], o0[4 * g + 3]);
                    *(float4*)(sp + 32 + 8 * g + 4 * h) = make_float4(o1[4 * g], o1[4 * g + 1], o1[4 * g + 2], o1[4 * g + 3]);
                }
            }
        }
        if (stage < 2 || !act) return;
    }
    const float inv = 1.f / lt;
    if (dry) { if (o0[0] + o1[0] + lt == 12345.678f) qkv[0] = 1; return; }
    bf16_t* op = qkv + (rowb + tq) * ld + qcol + 4 * h;
#pragma unroll
    for (int g = 0; g < 4; ++g) {
        *(uint2*)(op + 8 * g) = make_uint2(pk2(o0[4 * g] * inv, o0[4 * g + 1] * inv), pk2(o0[4 * g + 2] * inv, o0[4 * g + 3] * inv));
        *(uint2*)(op + 32 + 8 * g) = make_uint2(pk2(o1[4 * g] * inv, o1[4 * g + 1] * inv), pk2(o1[4 * g + 2] * inv, o1[4 * g + 3] * inv));
    }
}

DI void stick_wave(bf16_t* qkv, int ld, int b, int qcol, int kcol, int vcol, int qt, char* vl, int lane, bool dry) {
    const int r = lane & 31, h = lane >> 5;
    const size_t rowb = (size_t)b * S;
    const int tq = qt * 32 + r;
    bf16x8 qf[4];
    {
        const bf16_t* qp = qkv + (rowb + tq) * ld + qcol + h * 32;
#pragma unroll
        for (int ks = 0; ks < 4; ++ks) qf[ks] = *(const bf16x8*)(qp + ks * 8);
    }
    f32x16 o0, o1;
#pragma unroll
    for (int i = 0; i < 16; ++i) { o0[i] = 0.f; o1[i] = 0.f; }
    float R = 1.f;
    const int i16 = lane & 15;
    const char* vbase = vl + 4608 + (4 * h + (i16 >> 2)) * 144 + (16 * ((lane >> 4) & 1) + 4 * (i16 & 3)) * 2;
    const char* kfp = vl + r * 144 + h * 64;
    KV_DECL;
    KV_LOAD(qt * 32, 1);
    for (int tile = qt; tile >= 0; --tile) {
        KV_STORE();
        asm volatile("" ::: "memory");
        if (tile > 0) KV_LOAD((tile - 1) * 32, 1);
        f32x16 s;
#pragma unroll
        for (int i = 0; i < 16; ++i) s[i] = 0.f;
#pragma unroll
        for (int ks = 0; ks < 4; ++ks) s = MFMA(*(const bf16x8*)(kfp + ks * 16), qf[ks], s);
        const bool diag = (tile == qt);
        f32x16 sg, kp;
#pragma unroll
        for (int i = 0; i < 16; ++i) {
            const float z2 = fminf(s[i] * (0.125f * LOG2E), 80.f);
            const float t = fexp2(z2);
            const float k = __builtin_amdgcn_rcpf(1.f + t);
            kp[i] = k; sg[i] = t * k;
        }
        if (diag) {
#pragma unroll
            for (int i = 0; i < 16; ++i) { const bool strict = crow(i, h) < r; kp[i] = strict ? kp[i] : 1.f; sg[i] = strict ? sg[i] : 0.f; }
        }
        float G[4], PG[4], both[4];
#pragma unroll
        for (int g = 0; g < 4; ++g) { G[g] = (kp[4 * g] * kp[4 * g + 1]) * (kp[4 * g + 2] * kp[4 * g + 3]); PG[g] = __shfl_xor(G[g], 32); both[g] = G[g] * PG[g]; }
        float Sx[4];
        Sx[3] = 1.f; Sx[2] = both[3]; Sx[1] = both[3] * both[2]; Sx[0] = Sx[1] * both[1];
        f32x16 a;
#pragma unroll
        for (int g = 0; g < 4; ++g) {
            float la = R * Sx[g] * (h == 0 ? PG[g] : 1.f);
#pragma unroll
            for (int j = 3; j >= 0; --j) {
                a[4 * g + j] = sg[4 * g + j] * la;
                la *= kp[4 * g + j];
            }
        }
        R *= Sx[0] * both[0];
        const bf16x8 p0 = pack8v<0>(a), p1 = pack8v<8>(a);
        o0 = MFMA(v_frag(vbase, 0, 0), p0, o0);
        o0 = MFMA(v_frag(vbase, 1, 0), p1, o0);
        o1 = MFMA(v_frag(vbase, 0, 1), p0, o1);
        o1 = MFMA(v_frag(vbase, 1, 1), p1, o1);
        asm volatile("" ::: "memory");
        if (__builtin_amdgcn_ballot_w64(R >= 1.17549435e-38f) == 0) break;
    }
    if (dry) { if (o0[0] + o1[0] == 12345.678f) qkv[0] = 1; return; }
    bf16_t* op = qkv + (rowb + tq) * ld + qcol + 4 * h;
#pragma unroll
    for (int g = 0; g < 4; ++g) {
        *(uint2*)(op + 8 * g) = make_uint2(pk2(o0[4 * g], o0[4 * g + 1]), pk2(o0[4 * g + 2], o0[4 * g + 3]));
        *(uint2*)(op + 32 + 8 * g) = make_uint2(pk2(o1[4 * g], o1[4 * g + 1]), pk2(o1[4 * g + 2], o1[4 * g + 3]));
    }
}

DI void attn_even_phase(const Params& P, char* smem, bool dry) {
    const int tid_ = otid(); const int lane = tid_ & 63, wid = tid_ >> 6;
    bf16_t* qkv = (bf16_t*)(P.ws + OFF_BIG);
    char* vl = smem + wid * 9216;
    for (int it = blockIdx.x * 8 + wid; it < 2048 + 4096; it += gridDim.x * 8) {
        if (it < 2048) {
            const int bh = it >> 6, p = it & 63; const int b = bh >> 3, head = bh & 7;
            stick_wave(qkv, 2304, b, 512 + head * 64, 1280 + head * 64, 1792 + head * 64, 127 - p, vl, lane, dry);
            stick_wave(qkv, 2304, b, 512 + head * 64, 1280 + head * 64, 1792 + head * 64, p, vl, lane, dry);
        } else {
            const int v = it - 2048; const int g = v & 3; const int qt = (v >> 2) & 127; const int rest = v >> 9; const int b = rest >> 1, kvh = rest & 1;
            const int head = kvh * 4 + g;
            const float slope = exp2f(-(float)(head + 1));
            const float sink = P.in[9][head];
            win_attn_wave(qkv, 2304, b, head * 64, 1024 + kvh * 64, 1152 + kvh * 64, qt * 32, 1, slope * LOG2E, sink * LOG2E, 1.f, -1, vl, lane, dry);
        }
    }
}

DI void attn_odd_phase(const Params& P, char* smem, bool dry) {
    const int tid_ = otid(); const int lane = tid_ & 63, wid = tid_ >> 6;
    bf16_t* qkv = (bf16_t*)(P.ws + OFF_BIG);
    char* vl = smem + wid * 9216;
    float* st = (float*)(smem + 8 * 9216);
    for (int it = blockIdx.x; it < 1024; it += gridDim.x) {
        const int span = it & 15, head = (it >> 4) & 15, b = it >> 8; const int t0 = span * 256;
        const float slope2 = exp2f(-0.5f * (float)(head + 1)) * LOG2E;
        const int qc = head * 64, kc = 1024 + head * 64, vc = 2048 + head * 64;
        __syncthreads();
        win_attn_wave(qkv, 3072, b, qc, kc, vc, t0 + 32 * wid, 1, slope2, -1e30f, 0.f, 0, vl, lane, dry, 32, st, 32 * wid, 1, 0);
        __syncthreads();
        { const int r4 = wid >> 1, hf = wid & 1;
          win_attn_wave(qkv, 3072, b, qc, kc, vc, t0 + r4 + 128 * hf, 4, slope2, -1e30f, 0.f, 1, vl, lane, dry, 32, st, r4 + 128 * hf, 4, 1); }
        __syncthreads();
#pragma unroll 1
        for (int k = 0; k < 2; ++k) {
            const int r16 = 2 * wid + k;
            win_attn_wave(qkv, 3072, b, qc, kc, vc, t0 + r16, 16, slope2, -1e30f, 0.f, 2, vl, lane, dry, 16, st, r16, 16, 2);
        }
    }
}

DI void xattn_wave(bf16_t* qb, const bf16_t* Kn, const bf16_t* VT, const float* qg, float kmax2, int b, int head, int tok0, char* ql, int lane, bool dry) {
    const int r = lane & 31, h = lane >> 5;
    const size_t token = (size_t)b * S + tok0 + r;
    bf16_t* qp = qb + token * D + head * 256 + h * 128;
    float ss = 0.f;
#pragma unroll
    for (int ks = 0; ks < 16; ++ks) {
        const uint4 v = *(const uint4*)(qp + ks * 8);
        const unsigned w[4] = {v.x, v.y, v.z, v.w};
#pragma unroll
        for (int e = 0; e < 4; ++e) { const float a = bflo(w[e]), c = bfhi(w[e]); ss += a * a + c * c; }
    }
    ss += __shfl_xor(ss, 32);
    const float inv = __builtin_amdgcn_rsqf(ss * (1.f / 256.f) + EPS);
    float qq2 = 0.f;
#pragma unroll
    for (int ks = 0; ks < 16; ++ks) {
        const uint4 v = *(const uint4*)(qp + ks * 8);
        const float4 g0 = *(const float4*)(qg + h * 128 + ks * 8), g1 = *(const float4*)(qg + h * 128 + ks * 8 + 4);
        uint4 o;
        o.x = pk2(bflo(v.x) * inv * g0.x, bfhi(v.x) * inv * g0.y); o.y = pk2(bflo(v.y) * inv * g0.z, bfhi(v.y) * inv * g0.w);
        o.z = pk2(bflo(v.z) * inv * g1.x, bfhi(v.z) * inv * g1.y); o.w = pk2(bflo(v.w) * inv * g1.z, bfhi(v.w) * inv * g1.w);
        qq2 += bflo(o.x) * bflo(o.x) + bfhi(o.x) * bfhi(o.x) + bflo(o.y) * bflo(o.y) + bfhi(o.y) * bfhi(o.y)
             + bflo(o.z) * bflo(o.z) + bfhi(o.z) * bfhi(o.z) + bflo(o.w) * bflo(o.w) + bfhi(o.w) * bfhi(o.w);
        *(uint4*)(ql + (ks * 64 + lane) * 16) = o;
    }
    qq2 += __shfl_xor(qq2, 32);
    asm volatile("" ::: "memory");
    const float sc2 = 0.0625f * LOG2E;
    const bf16_t* kp0 = Kn + ((size_t)(b * 4 + head) * 8 * 16 * 64 + lane) * 8;
    const float m = __builtin_amdgcn_sqrtf(qq2 * kmax2) * 1.001f;
    float l = 0.f;
    bf16x8 pf[8][2];
    bf16x8 kc[16], kn[16];
#pragma unroll
    for (int ks = 0; ks < 16; ++ks) kc[ks] = *(const bf16x8*)(kp0 + ks * 512);
#pragma unroll
    for (int tile = 0; tile < 8; ++tile) {
        if (tile < 7) {
#pragma unroll
            for (int ks = 0; ks < 16; ++ks) kn[ks] = *(const bf16x8*)(kp0 + (size_t)(tile + 1) * 16 * 512 + ks * 512);
        }
        f32x16 s, s_b;
#pragma unroll
        for (int i = 0; i < 16; ++i) { s[i] = 0.f; s_b[i] = 0.f; }
#pragma unroll
        for (int ks = 0; ks < 16; ks += 2) {
            const bf16x8 qf0 = *(const bf16x8*)(ql + (ks * 64 + lane) * 16);
            const bf16x8 qf1 = *(const bf16x8*)(ql + ((ks + 1) * 64 + lane) * 16);
            s = MFMA(kc[ks], qf0, s);
            s_b = MFMA(kc[ks + 1], qf1, s_b);
        }
#pragma unroll
        for (int i = 0; i < 16; ++i) s[i] += s_b[i];
#pragma unroll
        for (int i = 0; i < 16; ++i) { s[i] = fexp2((s[i] - m) * sc2); l += s[i]; }
        pf[tile][0] = pack8v<0>(s); pf[tile][1] = pack8v<8>(s);
#pragma unroll
        for (int ks = 0; ks < 16; ++ks) kc[ks] = kn[ks];
    }
    l += __shfl_xor(l, 32);
    const float il = 1.f / l;
    bf16_t* op = qb + token * D + head * 256 + 4 * h;
    const bf16_t* vp0 = VT + (((size_t)(b * 4 + head) * 8 * 8 * 2 * 64) + lane) * 8;
    bf16x8 vc[16], vn[16];
#pragma unroll
    for (int e = 0; e < 16; ++e) vc[e] = *(const bf16x8*)(vp0 + e * 512);
#pragma unroll 1
    for (int dt = 0; dt < 8; ++dt) {
        const int dn = dt < 7 ? dt + 1 : 7;
#pragma unroll
        for (int e = 0; e < 16; ++e) vn[e] = *(const bf16x8*)(vp0 + (size_t)dn * 16 * 512 + e * 512);
        f32x16 o, o_b;
#pragma unroll
        for (int i = 0; i < 16; ++i) { o[i] = 0.f; o_b[i] = 0.f; }
#pragma unroll
        for (int tile = 0; tile < 8; ++tile) { o = MFMA(vc[tile * 2], pf[tile][0], o); o_b = MFMA(vc[tile * 2 + 1], pf[tile][1], o_b); }
#pragma unroll
        for (int i = 0; i < 16; ++i) o[i] += o_b[i];
#pragma unroll
        for (int g = 0; g < 4; ++g)
            if (dry) { if (o[4 * g] == 12345.678f) qb[0] = 1; } else *(uint2*)(op + dt * 32 + 8 * g) = make_uint2(pk2(o[4 * g] * il, o[4 * g + 1] * il), pk2(o[4 * g + 2] * il, o[4 * g + 3] * il));
#pragma unroll
        for (int e = 0; e < 16; ++e) vc[e] = vn[e];
    }
}

DI void xattn_block(bf16_t* qb, const bf16_t* KF, const bf16_t* VF, const float* qg, float kmax2, int b, int head, int qblk, char* smem, int lane, int wid) {
    const int r = lane & 31, h = lane >> 5;
    const size_t token = (size_t)b * S + qblk * 256 + wid * 32 + r;
    bf16_t* qp = qb + token * D + head * 256 + h * 128;
    const bf16_t* kbase = KF + (size_t)(b * 4 + head) * 8 * 8192;
    const bf16_t* vbase = VF + (size_t)(b * 4 + head) * 8 * 8192;
    const int pc0 = (2 * wid) * 512 + lane * 8, pc1 = pc0 + 512;
    char* ld0 = smem + (2 * wid) * 1024 + lane * 16;
#define XA_ISSUE(u_) do { const int u__ = (u_); const bf16_t* src_ = (u__ < 8) ? kbase + (size_t)u__ * 8192 : vbase + (size_t)(u__ - 8) * 8192; \
        char* dst_ = ld0 + (u__ & 3) * 16384; glds16(src_ + pc0, dst_); glds16(src_ + pc1, dst_ + 1024); } while (0)
    __syncthreads();
    XA_ISSUE(0); XA_ISSUE(1); XA_ISSUE(2);
    uint4 qraw[16];
    float ss = 0.f;
#pragma unroll
    for (int ks = 0; ks < 16; ++ks) {
        qraw[ks] = *(const uint4*)(qp + ks * 8);
        const uint4 v = qraw[ks];
        ss += bflo(v.x) * bflo(v.x) + bfhi(v.x) * bfhi(v.x) + bflo(v.y) * bflo(v.y) + bfhi(v.y) * bfhi(v.y)
            + bflo(v.z) * bflo(v.z) + bfhi(v.z) * bfhi(v.z) + bflo(v.w) * bflo(v.w) + bfhi(v.w) * bfhi(v.w);
    }
    ss += __shfl_xor(ss, 32);
    const float inv = __builtin_amdgcn_rsqf(ss * (1.f / 256.f) + EPS);
    float qq2 = 0.f;
    bf16x8 qf[16];
#pragma unroll
    for (int ks = 0; ks < 16; ++ks) {
        const uint4 v = qraw[ks];
        const float4 g0 = *(const float4*)(qg + h * 128 + ks * 8), g1 = *(const float4*)(qg + h * 128 + ks * 8 + 4);
        uint4 o;
        o.x = pk2(bflo(v.x) * inv * g0.x, bfhi(v.x) * inv * g0.y); o.y = pk2(bflo(v.y) * inv * g0.z, bfhi(v.y) * inv * g0.w);
        o.z = pk2(bflo(v.z) * inv * g1.x, bfhi(v.z) * inv * g1.y); o.w = pk2(bflo(v.w) * inv * g1.z, bfhi(v.w) * inv * g1.w);
        qq2 += bflo(o.x) * bflo(o.x) + bfhi(o.x) * bfhi(o.x) + bflo(o.y) * bflo(o.y) + bfhi(o.y) * bfhi(o.y)
             + bflo(o.z) * bflo(o.z) + bfhi(o.z) * bfhi(o.z) + bflo(o.w) * bflo(o.w) + bfhi(o.w) * bfhi(o.w);
        qf[ks] = __builtin_bit_cast(bf16x8, o);
    }
    qq2 += __shfl_xor(qq2, 32);
    const float sc2 = 0.0625f * LOG2E;
    const float m = __builtin_amdgcn_sqrtf(qq2 * kmax2) * 1.001f;
    float l = 0.f;
    bf16x8 pf[8][2];
    const char* fr0 = smem + lane * 16;
#pragma unroll
    for (int u = 0; u < 8; ++u) {
        asm volatile("s_waitcnt vmcnt(4)" ::: "memory");
        __builtin_amdgcn_s_barrier();
        XA_ISSUE(u + 3);
        const char* sl = fr0 + (u & 3) * 16384;
        f32x16 s, s_b;
#pragma unroll
        for (int i = 0; i < 16; ++i) { s[i] = 0.f; s_b[i] = 0.f; }
#pragma unroll
        for (int ks = 0; ks < 16; ks += 2) {
            s = MFMA(*(const bf16x8*)(sl + ks * 1024), qf[ks], s);
            s_b = MFMA(*(const bf16x8*)(sl + (ks + 1) * 1024), qf[ks + 1], s_b);
        }
#pragma unroll
        for (int i = 0; i < 16; ++i) { s[i] = fexp2((s[i] + s_b[i] - m) * sc2); l += s[i]; }
        pf[u][0] = pack8v<0>(s); pf[u][1] = pack8v<8>(s);
    }
    l += __shfl_xor(l, 32);
    const float il = 1.f / l;
    bf16_t* op = qb + token * D + head * 256 + 4 * h;
#pragma unroll 1
    for (int dt = 0; dt < 8; ++dt) {
        if (dt < 6) asm volatile("s_waitcnt vmcnt(4)" ::: "memory");
        else if (dt == 6) asm volatile("s_waitcnt vmcnt(2)" ::: "memory");
        else asm volatile("s_waitcnt vmcnt(0)" ::: "memory");
        __builtin_amdgcn_s_barrier();
        if (dt < 5) XA_ISSUE(dt + 11);
        const char* sl = fr0 + (dt & 3) * 16384;
        f32x16 o, o_b;
#pragma unroll
        for (int i = 0; i < 16; ++i) { o[i] = 0.f; o_b[i] = 0.f; }
#pragma unroll
        for (int tile = 0; tile < 8; ++tile) {
            o = MFMA(*(const bf16x8*)(sl + (tile * 2) * 1024), pf[tile][0], o);
            o_b = MFMA(*(const bf16x8*)(sl + (tile * 2 + 1) * 1024), pf[tile][1], o_b);
        }
#pragma unroll
        for (int g = 0; g < 4; ++g)
            *(uint2*)(op + dt * 32 + 8 * g) = make_uint2(pk2((o[4 * g] + o_b[4 * g]) * il, (o[4 * g + 1] + o_b[4 * g + 1]) * il),
                                                        pk2((o[4 * g + 2] + o_b[4 * g + 2]) * il, (o[4 * g + 3] + o_b[4 * g + 3]) * il));
    }
#undef XA_ISSUE
}

DI void xattn_phase(const Params& P, int l, char* smem, bool dry) {
    const int tid_ = otid(); const int lane = tid_ & 63, wid = tid_ >> 6;
    bf16_t* qb = (bf16_t*)(P.ws + OFF_BIG);
    const bf16_t* KF = (const bf16_t*)(P.ws + OFF_KF + (size_t)l * SZ_MM);
    const bf16_t* VF = (const bf16_t*)(P.ws + OFF_VT + (size_t)l * SZ_MM);
    const float* qg = P.in[19] + l * 256;
    (void)dry;
    for (int it = blockIdx.x; it < 256; it += gridDim.x) {
        const int qblk = it & 15, head = (it >> 4) & 3, b = it >> 6;
        const float kmax2 = ((const float*)(P.ws + OFF_KMAX))[l * 16 + b * 4 + head];
        xattn_block(qb, KF, VF, qg, kmax2, b, head, qblk, smem, lane, wid);
    }
}

DI void knorm_phase(const Params& P) {
    const int tid_ = otid(); const int lane = tid_ & 63, wid = tid_ >> 6;
    for (int u = blockIdx.x * 8 + wid; u < 8192; u += gridDim.x * 8) {
        const int l = u >> 12, row = (u >> 2) & 1023, head = u & 3;
        const bf16_t* kp = (const bf16_t*)(P.ws + OFF_KN + (size_t)l * SZ_MM) + (size_t)row * D + head * 256 + lane * 4;
        const uint2 v = *(const uint2*)kp;
        const float a0 = bflo(v.x), a1 = bfhi(v.x), a2 = bflo(v.y), a3 = bfhi(v.y);
        float ss = a0 * a0 + a1 * a1 + a2 * a2 + a3 * a3;
        ss = wave_sum(ss);
        const float inv = __builtin_amdgcn_rsqf(ss * (1.f / 256.f) + EPS);
        const float4 g = *(const float4*)(P.in[20] + l * 256 + lane * 4);
        const int b = row >> 8, key = row & 255;
        const int h = lane >> 5, ks = (lane & 31) >> 1, j0 = (lane & 1) * 4;
        bf16_t* dp = (bf16_t*)(P.ws + OFF_KF + (size_t)l * SZ_MM) + ((((((size_t)(b * 4 + head) * 8 + (key >> 5)) * 16 + ks) * 64) + h * 32 + (key & 31)) << 3) + j0;
        const unsigned w0_ = pk2(a0 * inv * g.x, a1 * inv * g.y), w1_ = pk2(a2 * inv * g.z, a3 * inv * g.w);
        *(uint2*)dp = make_uint2(w0_, w1_);
        float kk2 = bflo(w0_) * bflo(w0_) + bfhi(w0_) * bfhi(w0_) + bflo(w1_) * bflo(w1_) + bfhi(w1_) * bfhi(w1_);
        kk2 = wave_sum(kk2);
        if (lane == 0) atomicMax((unsigned*)(P.ws + OFF_KMAX) + l * 16 + b * 4 + head, __float_as_uint(kk2));
    }
}

#define XB_TMO      128
#define XB_XCNT(j)  (256  + 64 * (j))
#define XB_XSUB(j)  (1280 + 64 * (j))
#define XB_XGEN(j)  (2304 + 64 * (j))
#define XB_TOP      3328
#define XB_TOPGEN   3392
#define XCD_BAR_WORDS 3456
#define XB_SPIN_CAP (1u << 18)
#define XB_LAS __attribute__((address_space(3)))

__device__ __forceinline__ unsigned xb_ld(unsigned* p)              { return __hip_atomic_load(p, __ATOMIC_RELAXED, __HIP_MEMORY_SCOPE_AGENT); }
__device__ __forceinline__ unsigned xb_add(unsigned* p, unsigned v) { return __hip_atomic_fetch_add(p, v, __ATOMIC_RELAXED, __HIP_MEMORY_SCOPE_AGENT); }
__device__ __forceinline__ unsigned xb_xcc_id() { return (unsigned)__builtin_amdgcn_s_getreg((3 << 11) | 20) & 0xFu; }
#define XB_SPIN(cond, bar) do { unsigned _sp = 0; while (cond) { __builtin_amdgcn_s_sleep(1); \
    if ((++_sp & 255u) == 0u) { if (xb_ld(&(bar)[XB_TMO])) break; if (_sp > XB_SPIN_CAP) { atomicAdd(&(bar)[XB_TMO], 1u); break; } } } } while (0)

struct XcdBarrier {
    unsigned* bar; unsigned x;
    volatile XB_LAS unsigned* st;
};

__device__ __forceinline__ XcdBarrier xcd_barrier_post(unsigned* bar, volatile XB_LAS unsigned* st) {
    XcdBarrier b; b.bar = bar; b.x = xb_xcc_id(); b.st = st;
    if (threadIdx.x == 0) (void)xb_add(&bar[XB_XCNT(b.x)], 1u);
    return b;
}
__device__ __forceinline__ void xcd_barrier_complete(unsigned* bar, unsigned x, unsigned& nloc, unsigned& nx) {
    const unsigned G = gridDim.x * gridDim.y * gridDim.z;
    unsigned sum, cnt, mine, sp = 0u;
    for (;;) {
        sum = 0u; cnt = 0u; mine = 0u;
#pragma unroll
        for (unsigned j = 0; j < 16; ++j) { const unsigned c = xb_ld(&bar[XB_XCNT(j)]); sum += c; cnt += (c > 0u) ? 1u : 0u; mine = (j == x) ? c : mine; }
        if (sum == G) break;
        __builtin_amdgcn_s_sleep(1);
        if ((++sp & 255u) == 0u) { if (xb_ld(&bar[XB_TMO])) break; if (sp > XB_SPIN_CAP) { atomicAdd(&bar[XB_TMO], 1u); break; } }
    }
    nloc = mine > 0u ? mine : 1u; nx = cnt > 0u ? cnt : 1u;
}

__device__ __forceinline__ void xcd_barrier(const XcdBarrier& b) {
    asm volatile("s_waitcnt vmcnt(0)" ::: "memory");
    __syncthreads();
    if (threadIdx.x == 0) {
        unsigned* bar = b.bar;
        __builtin_amdgcn_s_waitcnt(0);
        unsigned nloc = b.st[0], nx = b.st[1];
        if (nloc == 0u) { xcd_barrier_complete(bar, b.x, nloc, nx); b.st[0] = nloc; b.st[1] = nx; }
        const unsigned old = xb_add(&bar[XB_XSUB(b.x)], 1u);
        const unsigned gen = old / nloc;
        if (old + 1u == (gen + 1u) * nloc) {
            __builtin_amdgcn_fence(__ATOMIC_RELEASE, "agent");
            asm volatile("s_waitcnt vmcnt(0)" ::: "memory");
            const unsigned og = xb_add(&bar[XB_TOP], 1u);
            const unsigned tg = og / nx;
            if (og + 1u == (tg + 1u) * nx) xb_add(&bar[XB_TOPGEN], 1u);
            else XB_SPIN(xb_ld(&bar[XB_TOPGEN]) == tg, bar);
            __builtin_amdgcn_fence(__ATOMIC_ACQUIRE, "agent");
            xb_add(&bar[XB_XGEN(b.x)], 1u);
            asm volatile("s_waitcnt vmcnt(0)" ::: "memory");
        } else {
            XB_SPIN(xb_ld(&bar[XB_XGEN(b.x)]) == gen, bar);
            __builtin_amdgcn_fence(__ATOMIC_ACQUIRE, "agent");
            asm volatile("s_waitcnt vmcnt(0)" ::: "memory");
        }
    }
    __syncthreads();
}


DI void fast_grid_sync(unsigned* bar, unsigned target) {
    asm volatile("s_waitcnt vmcnt(0) lgkmcnt(0)" ::: "memory");
    __syncthreads();
    if (threadIdx.x == 0) {
        __builtin_amdgcn_fence(__ATOMIC_RELEASE, "agent");
        asm volatile("s_waitcnt vmcnt(0)" ::: "memory");
        __hip_atomic_fetch_add(bar, 1u, __ATOMIC_RELAXED, __HIP_MEMORY_SCOPE_AGENT);
        while (__hip_atomic_load(bar, __ATOMIC_RELAXED, __HIP_MEMORY_SCOPE_AGENT) < target) __builtin_amdgcn_s_sleep(2);
        __builtin_amdgcn_fence(__ATOMIC_ACQUIRE, "agent");
        asm volatile("s_waitcnt vmcnt(0)" ::: "memory");
    }
    __syncthreads();
}

__global__ void __launch_bounds__(512) fwd_megakernel(Params P) {
    extern __shared__ __attribute__((aligned(16))) char smem[];
    cg::grid_group grid = cg::this_grid();
    unsigned nbar = 0; (void)nbar;
    volatile XB_LAS unsigned* xst = (volatile XB_LAS unsigned*)(smem + LDS_BYTES - 16);
    if (threadIdx.x == 0) { xst[0] = 0u; xst[1] = 0u; }
    __syncthreads();
    const XcdBarrier xbar = xcd_barrier_post((unsigned*)(P.ws + OFF_BAR), xst);
#pragma unroll 1
    for (int ph = 0; ph < 21; ++ph) {
        float* ssq = (float*)(P.ws + OFF_SSQ);
        bf16_t* xb = (bf16_t*)(P.ws + OFF_XB);
        bf16_t* big = (bf16_t*)(P.ws + OFF_BIG);
        int nrep = 1;
        if (ph > 0) { const int s_ = (ph - 1) % 10; const int kind = (s_ == 3) ? 2 : (s_ == 6) ? 4 : 1; if (PROBE_MASK & kind) nrep = 2; }
        for (int rep = 0; rep < nrep; ++rep) {
        const bool dry = rep + 1 < nrep;
        if (ph == 0) {
            phase0(P, smem);
        } else {
            const int l = (ph - 1) / 10, s = (ph - 1) % 10;
            if (s == 3) {
                if (l == 0) attn_even_phase(P, smem, dry); else attn_odd_phase(P, smem, dry);
            } else if (s == 6) {
                xattn_phase(P, l, smem, dry);
            } else {
                pg8::Gemm g; pg8::Epi E;
                g.A = xb; g.lda = D; g.K = D; g.M = T; g.N = D; g.Bt = nullptr;
                E.mode = 1; E.rs = nullptr; E.O = big; E.ldo = D; E.xin = nullptr; E.xout = nullptr; E.xb = xb; E.ssq_out = ssq; E.alpha = 1.f;
                E.qg = nullptr; E.kg = nullptr; E.qn_end = 0; E.kn_beg = 0; E.kn_end = 0;
                if (s == 0 || s == 8) {
                    g.Bt = (const bf16_t*)(P.ws + (s == 0 ? OFF_GU1 : OFF_GU2) + (size_t)l * SZ_GU); g.N = NGU;
                    E.mode = 0; E.rs = ssq + (size_t)(4 * l + (s == 0 ? 0 : 3)) * T; E.ldo = DFF;
                } else if (s == 1 || s == 9) {
                    g.A = big; g.lda = DFF; g.K = DFF;
                    g.Bt = (const bf16_t*)(P.ws + (s == 1 ? OFF_DN1 : OFF_DN2) + (size_t)l * SZ_DN);
                    E.alpha = 0.5f; E.ssq_out = ssq + (size_t)(4 * l + (s == 1 ? 1 : 4)) * T;
                    if (ph == 2) E.xin = P.in[0];
                    if (ph == 20) { E.xout = P.out; E.ssq_out = nullptr; }
                } else if (s == 2) {
                    E.mode = 2; E.rs = ssq + (size_t)(4 * l + 1) * T;
                    if (l == 0) { g.Bt = (const bf16_t*)(P.ws + OFF_EVIN); g.N = 2304; E.ldo = 2304; E.qg = P.in[7]; E.kg = P.in[8]; E.qn_end = 512; E.kn_beg = 1024; E.kn_end = 1152; }
                    else { g.Bt = (const bf16_t*)(P.ws + OFF_ODIN); g.N = 3072; E.ldo = 3072; E.qg = P.in[12]; E.kg = P.in[13]; E.qn_end = 1024; E.kn_beg = 1024; E.kn_end = 2048; }
                } else if (s == 4) {
                    g.A = big;
                    if (l == 0) { g.Bt = (const bf16_t*)(P.ws + OFF_EVOUT); g.lda = 2304; }
                    else { g.Bt = (const bf16_t*)(P.ws + OFF_ODOUT); g.lda = 3072; }
                    E.ssq_out = ssq + (size_t)(4 * l + 2) * T;
                } else if (s == 5) {
                    g.Bt = (const bf16_t*)(P.ws + OFF_WQ + (size_t)l * SZ_MM); E.mode = 2; E.rs = ssq + (size_t)(4 * l + 2) * T; E.ldo = D;
                } else {
                    g.A = big; g.Bt = (const bf16_t*)(P.ws + OFF_WO + (size_t)l * SZ_MM); E.ssq_out = ssq + (size_t)(4 * l + 3) * T;
                }
                pg8::StaticOrder So; So.init(T, g.N, (int)gridDim.x, (int)blockIdx.x);
                E.dryrun = 0;
#if PROBE_GEMM
                for (int rep_ = 0; rep_ < 2; ++rep_) {
                pg8::Epi E2 = E;
                if (rep_ == 0) { if (PROBE_GEMM == 1) E2.dryrun = 1; else if (E.mode == 1) { E2.alpha = 0.f; } }
                __syncthreads();
                pg8::gemm_phase<pg8::Epi, pg8::StaticOrder, true, true>((PG8_LAS unsigned char*)smem, g, So, rep_ == 0 ? E2 : E);
                ++nbar; fast_grid_sync((unsigned*)(P.ws + OFF_BAR), nbar * gridDim.x);
                }
#else
                __syncthreads();
                pg8::gemm_phase<pg8::Epi, pg8::StaticOrder, true, true>((PG8_LAS unsigned char*)smem, g, So, E);
#endif
                if (ph == 1) {
                    GJob J;
                    J.A = xb; J.lda = D; J.ksplit = 1 << 30; J.kextra = 0; J.K = D; J.ntm = 4; J.mode = 3; J.rs = nullptr;
                    J.O = big; J.ldo = D; J.xin = P.out; J.xout = P.out; J.xb = xb; J.ssq_out = ssq; J.alpha = 1.f;
                    J.qg = nullptr; J.kg = nullptr; J.qn_end = 0; J.kn_end = 0; J.vt = nullptr; J.W = nullptr; J.ntn = 8;
                    gemm_phase(J, 0, 64, P, smem, false);
                }
                if (ph == 2 && !dry) knorm_phase(P);
            }
        }
        if (P.ws == nullptr) grid.sync();
        if (ph < 20) xcd_barrier(xbar);
        }
    }
}

extern "C" void kernel_launch(void* const* d_in, const int* in_sizes, int n_in, void* d_out, int out_size, void* d_ws, size_t ws_size,
                              hipStream_t stream) {
    static int grid_blocks = 0;
    if (!grid_blocks) {
        int dev = 0, cus = 0, per_cu = 0;
        hipGetDevice(&dev);
        hipDeviceGetAttribute(&cus, hipDeviceAttributeMultiprocessorCount, dev);
        hipFuncSetAttribute((const void*)fwd_megakernel, hipFuncAttributeMaxDynamicSharedMemorySize, LDS_BYTES);
        hipOccupancyMaxActiveBlocksPerMultiprocessor(&per_cu, fwd_megakernel, NTHR, LDS_BYTES);
        if (per_cu < 1) per_cu = 1;
        if (per_cu > 1) per_cu = 1;
        grid_blocks = cus * per_cu;
    }
    if (ws_size < WS_NEED) { fprintf(stderr, "workspace too small: %zu < %zu\n", ws_size, (size_t)WS_NEED); return; }
    Params p{};
    for (int i = 0; i < 25; ++i) p.in[i] = (const float*)d_in[i];
    p.out = (float*)d_out; p.ws = (char*)d_ws;
    hipMemsetAsync((char*)d_ws + OFF_BAR, 0, 16384, stream);
    void* args[] = {&p};
    hipError_t e = hipLaunchCooperativeKernel((void*)fwd_megakernel, dim3(grid_blocks), dim3(NTHR), args, LDS_BYTES, stream);
    if (e != hipSuccess) fprintf(stderr, "cooperative launch failed: %s (grid %d)\n", hipGetErrorString(e), grid_blocks);
}
```

```cpp
#include <hip/hip_runtime.h>
#include <hip/hip_cooperative_groups.h>
#include <cstdio>
#include <cstdint>
namespace cg = cooperative_groups;

#define DI __device__ __forceinline__
typedef unsigned short bf16_t;
typedef short bf16x8 __attribute__((ext_vector_type(8)));
typedef short s16x4 __attribute__((ext_vector_type(4)));
typedef float f32x16 __attribute__((ext_vector_type(16)));
typedef __bf16 bf2_t __attribute__((ext_vector_type(2)));
typedef float f2_t __attribute__((ext_vector_type(2)));
typedef short v4i16_t __attribute__((ext_vector_type(4)));
#define MFMA(a, b, c) __builtin_amdgcn_mfma_f32_32x32x16_bf16((a), (b), (c), 0, 0, 0)

constexpr int T = 16384, S = 4096, D = 1024, DFF = 2816, NGU = 5632;
constexpr float EPS = 1e-6f;
constexpr float LOG2E = 1.4426950408889634f;
constexpr float LN2 = 0.6931471805599453f;

constexpr size_t SZ_GU = (size_t)NGU * D * 2, SZ_DN = (size_t)D * DFF * 2, SZ_MM = (size_t)D * D * 2;
constexpr size_t OFF_GU1 = 0;
constexpr size_t OFF_DN1 = OFF_GU1 + 2 * SZ_GU;
constexpr size_t OFF_GU2 = OFF_DN1 + 2 * SZ_DN;
constexpr size_t OFF_DN2 = OFF_GU2 + 2 * SZ_GU;
constexpr size_t OFF_WQ = OFF_DN2 + 2 * SZ_DN;
constexpr size_t OFF_WKV = OFF_WQ + 2 * SZ_MM;
constexpr size_t OFF_WO = OFF_WKV + 4 * SZ_MM;
constexpr size_t OFF_EVIN = OFF_WO + 2 * SZ_MM;
constexpr size_t OFF_EVOUT = OFF_EVIN + (size_t)2304 * D * 2;
constexpr size_t OFF_ODIN = OFF_EVOUT + SZ_MM;
constexpr size_t OFF_ODOUT = OFF_ODIN + (size_t)3072 * D * 2;
constexpr size_t OFF_XB = OFF_ODOUT + SZ_MM;
constexpr size_t OFF_BIG = OFF_XB + (size_t)T * D * 2;
constexpr size_t OFF_MEMB = OFF_BIG + (size_t)T * 3072 * 2;
constexpr size_t OFF_KN = OFF_MEMB + SZ_MM;
constexpr size_t OFF_VT = OFF_KN + 2 * SZ_MM;
constexpr size_t OFF_SSQ = OFF_VT + 2 * SZ_MM;
constexpr size_t OFF_SSQM = OFF_SSQ + (size_t)9 * T * 4;
constexpr size_t OFF_KMAX = OFF_SSQM + 4096;
constexpr size_t OFF_BAR = OFF_KMAX + 256;
constexpr size_t OFF_KF = OFF_BAR + 16384;
constexpr size_t WS_NEED = OFF_KF + 2 * SZ_MM;

#ifndef PROBE_MASK
#define PROBE_MASK 0
#endif
#ifndef PROBE_GEMM
#define PROBE_GEMM 0
#endif
constexpr int NTHR = 512;
constexpr int NST = 4;
constexpr int STAGE_B = 32768;
constexpr int OPB = 16384;
constexpr int LDS_BYTES = 147456;

struct Params { const float* in[25]; float* out; char* ws; };

DI unsigned pk2(float a, float b) { f2_t v = {a, b}; bf2_t r = __builtin_convertvector(v, bf2_t); return __builtin_bit_cast(unsigned, r); }
typedef unsigned v4u_t __attribute__((ext_vector_type(4)));
DI __amdgpu_buffer_rsrc_t wt_rsrc(const void* base, size_t bytes) { return __builtin_amdgcn_make_buffer_rsrc((void*)base, (short)0, (int)bytes, 0x00020000); }
DI void st16_wt(__amdgpu_buffer_rsrc_t r, size_t byteoff, uint4 v) { const v4u_t x = {v.x, v.y, v.z, v.w}; __builtin_amdgcn_raw_buffer_store_b128(x, r, (unsigned)byteoff, 0, 16); }
DI void st16f_wt(__amdgpu_buffer_rsrc_t r, size_t byteoff, float4 v) { const v4u_t x = {__float_as_uint(v.x), __float_as_uint(v.y), __float_as_uint(v.z), __float_as_uint(v.w)}; __builtin_amdgcn_raw_buffer_store_b128(x, r, (unsigned)byteoff, 0, 16); }
DI float bflo(unsigned w) { return __uint_as_float(w << 16); }
DI float bfhi(unsigned w) { return __uint_as_float(w & 0xffff0000u); }
DI int otid() { int t = threadIdx.x; asm volatile("" : "+v"(t)); return t; }
DI int crow(int i, int h) { return (i & 3) + 8 * (i >> 2) + 4 * h; }
DI float fexp2(float x) { return __builtin_amdgcn_exp2f(x); }
DI float flog2(float x) { return __builtin_amdgcn_logf(x); }

struct WJob { const float* src; bf16_t* dst; const float* gain; int K, N, gu; };

DI int wjob_tiles(int j) {
    if (j < 14) {
        const int kind = j >> 1;
        switch (kind) {
            case 0: case 2: return 16 * 88;
            case 1: case 3: return 44 * 16;
            case 4: return 256;
            case 5: return 512;
            default: return 256;
        }
    }
    if (j == 14) return 16 * 36;
    if (j == 16) return 16 * 48;
    return 256;
}

DI WJob get_wjob(const Params& P, int j) {
    WJob w; w.gain = nullptr; w.gu = 0;
    bf16_t* wsb = (bf16_t*)P.ws;
    if (j < 14) {
        const int kind = j >> 1, l = j & 1;
        switch (kind) {
            case 0: w.src = P.in[3] + (size_t)l * D * NGU; w.dst = (bf16_t*)(P.ws + OFF_GU1 + l * SZ_GU); w.gain = P.in[2] + l * D; w.K = D; w.N = NGU; w.gu = 1; break;
            case 1: w.src = P.in[4] + (size_t)l * DFF * D; w.dst = (bf16_t*)(P.ws + OFF_DN1 + l * SZ_DN); w.K = DFF; w.N = D; w.gu = 2; break;
            case 2: w.src = P.in[23] + (size_t)l * D * NGU; w.dst = (bf16_t*)(P.ws + OFF_GU2 + l * SZ_GU); w.gain = P.in[22] + l * D; w.K = D; w.N = NGU; w.gu = 1; break;
            case 3: w.src = P.in[24] + (size_t)l * DFF * D; w.dst = (bf16_t*)(P.ws + OFF_DN2 + l * SZ_DN); w.K = DFF; w.N = D; w.gu = 2; break;
            case 4: w.src = P.in[17] + (size_t)l * D * D; w.dst = (bf16_t*)(P.ws + OFF_WQ + l * SZ_MM); w.gain = P.in[15] + l * D; w.K = D; w.N = D; w.gu = 2; break;
            case 5: w.src = P.in[18] + (size_t)l * D * 2048; w.dst = (bf16_t*)(P.ws + OFF_WKV + l * 2 * SZ_MM); w.gain = P.in[16] + l * D; w.K = D; w.N = 2048; break;
            default: w.src = P.in[21] + (size_t)l * D * D; w.dst = (bf16_t*)(P.ws + OFF_WO + l * SZ_MM); w.K = D; w.N = D; w.gu = 2; break;
        }
    } else if (j == 14) { w.src = P.in[6]; w.dst = (bf16_t*)(P.ws + OFF_EVIN); w.gain = P.in[5]; w.K = D; w.N = 2304; w.gu = 3; }
    else if (j == 15) { w.src = P.in[10]; w.dst = (bf16_t*)(P.ws + OFF_EVOUT); w.K = D; w.N = D; w.gu = 2; }
    else if (j == 16) { w.src = P.in[11]; w.dst = (bf16_t*)(P.ws + OFF_ODIN); w.gain = P.in[5] + D; w.K = D; w.N = 3072; w.gu = 2; }
    else { w.src = P.in[14]; w.dst = (bf16_t*)(P.ws + OFF_ODOUT); w.K = D; w.N = D; w.gu = 2; }
    (void)wsb;
    return w;
}

DI void wconv_tile(const WJob& w, int t, float* sm, int tid, bool act) {
    const int ntn = w.N >> 6; const int tk = t / ntn, tn = t - tk * ntn;
    if (act) {
#pragma unroll
        for (int p = 0; p < 4; ++p) {
            const int kr = p * 16 + (tid >> 4);
            typedef float f32x4nt __attribute__((ext_vector_type(4)));
            const f32x4nt v = __builtin_nontemporal_load((const f32x4nt*)(w.src + (size_t)(tk * 64 + kr) * w.N + tn * 64 + (tid & 15) * 4));
            const float g = w.gain ? w.gain[tk * 64 + kr] : 1.f;
            float* sp = sm + kr * 65 + (tid & 15) * 4;
            sp[0] = v[0] * g; sp[1] = v[1] * g; sp[2] = v[2] * g; sp[3] = v[3] * g;
        }
    }
    __syncthreads();
    if (act) {
        const int n = tid >> 2, kq = tid & 3; const int ng = tn * 64 + n;
        int drow = ng;
        if (w.gu == 1) drow = ng < DFF ? ((ng >> 7) * 256 + (ng & 127)) : (((ng - DFF) >> 7) * 256 + 128 + ((ng - DFF) & 127));
        else if (w.gu >= 2) {
            int a = ng;
            if (w.gu == 3) a = ng < 512 ? ng : ng < 768 ? ng + 512 : ng < 1280 ? ng - 256 : ng;
            drow = (a & ~255) + (((a >> 5) & 1) << 7) + (((a >> 6) & 3) << 5) + (a & 31);
        }
        unsigned o[8];
#pragma unroll
        for (int e = 0; e < 8; ++e) o[e] = pk2(sm[(kq * 16 + 2 * e) * 65 + n], sm[(kq * 16 + 2 * e + 1) * 65 + n]);
        uint4* dp = (uint4*)(w.dst + (size_t)drow * w.K + tk * 64 + kq * 16);
        dp[0] = make_uint4(o[0], o[1], o[2], o[3]); dp[1] = make_uint4(o[4], o[5], o[6], o[7]);
    }
    __syncthreads();
}

DI float wave_sum(float v) {
    v += __shfl_xor(v, 1); v += __shfl_xor(v, 2); v += __shfl_xor(v, 4); v += __shfl_xor(v, 8); v += __shfl_xor(v, 16); v += __shfl_xor(v, 32);
    return v;
}

DI void rowconv(const float* src, bf16_t* dst, float* ssq, int row, int lane) {
    const float* xr = src + (size_t)row * D;
    float ss = 0.f;
#pragma unroll
    for (int p = 0; p < 4; ++p) {
        const float4 v = *(const float4*)(xr + p * 256 + lane * 4);
        ss += v.x * v.x + v.y * v.y + v.z * v.z + v.w * v.w;
        *(uint2*)(dst + (size_t)row * D + p * 256 + lane * 4) = make_uint2(pk2(v.x, v.y), pk2(v.z, v.w));
    }
    ss = wave_sum(ss);
    if (lane == 0) ssq[row] = ss;
}

DI void phase0(const Params& P, char* smem) {
    const int tid = otid(), lane = tid & 63, wid = tid >> 6;
    float* ssq = (float*)(P.ws + OFF_SSQ);
    for (int i = blockIdx.x * NTHR + tid; i < 8 * T; i += gridDim.x * NTHR) ssq[T + i] = 0.f;
    if (blockIdx.x == 0 && tid < 32) ((unsigned*)(P.ws + OFF_KMAX))[tid] = 0u;
    constexpr int NW = 12352 / 2, NX = T / 8, NM = 1024 / 8;
    for (int u = blockIdx.x; u < NW + NX + NM; u += gridDim.x) {
        if (u < NW) {
            const int half = tid >> 8;
            int t = 2 * u + half, j = 0;
            for (; j < 17; ++j) { const int c = wjob_tiles(j); if (t < c) break; t -= c; }
            const WJob w = get_wjob(P, j);
            wconv_tile(w, t, (float*)smem + half * (64 * 65), tid & 255, true);
        } else if (u < NW + NX) {
            rowconv(P.in[0], (bf16_t*)(P.ws + OFF_XB), ssq, (u - NW) * 8 + wid, lane);
        } else {
            rowconv(P.in[1], (bf16_t*)(P.ws + OFF_MEMB), (float*)(P.ws + OFF_SSQM), (u - NW - NX) * 8 + wid, lane);
        }
    }
}

struct GJob {
    const bf16_t* A; const bf16_t* W;
    int lda, ksplit, kextra, K, ntm, ntn, mode;
    const float* rs;
    bf16_t* O; int ldo;
    const float* xin; float* xout; bf16_t* xb; float* ssq_out; float alpha;
    const float* qg; const float* kg; int qn_end, kn_end;
    bf16_t* vt;
};

typedef __attribute__((address_space(3))) unsigned* ldsu_t;
typedef const __attribute__((address_space(1))) unsigned* glbu_t;
DI void glds16(const bf16_t* g, char* l) { __builtin_amdgcn_global_load_lds((glbu_t)(const void*)g, (ldsu_t)(void*)l, 16, 0, 0); }

DI void gemm_tile(const GJob& J, int t, char* smem, bool dry) {
    const int tid = otid(), lane = tid & 63, wid = tid >> 6, wr = wid >> 2, wc = wid & 3;
    const int r = lane & 31, h = lane >> 5;
    int tm, tn;
    { const int gsz = 32 * J.ntn; const int g = t / gsz; const int rem = t - g * gsz; const int rows = min(32, J.ntm - g * 32); tn = rem / rows; tm = g * 32 + (rem - tn * rows); }
    const int lrow = wid * 16 + (lane >> 2);
    const int csw = ((lane & 3) ^ ((lane >> 4) & 3)) * 8;
    const bf16_t* Ag = J.A + (size_t)(tm * 256 + lrow) * J.lda + csw;
    const bf16_t* Wg = J.W + (size_t)(tn * 256 + lrow) * J.K + csw;
    const size_t astr = (size_t)128 * J.lda, wstr = (size_t)128 * J.K;
    char* lb = smem + tid * 16;
    const int nk = J.K >> 5;
#define GLDS(kt, buf) do { const int k0_ = (kt) * 32; const int ka_ = k0_ + (k0_ >= J.ksplit ? J.kextra : 0); char* l_ = lb + (buf) * STAGE_B; \
        glds16(Ag + ka_, l_); glds16(Ag + astr + ka_, l_ + 8192); glds16(Wg + k0_, l_ + OPB); glds16(Wg + wstr + k0_, l_ + OPB + 8192); } while (0)
    f32x16 acc[4][2];
#pragma unroll
    for (int a = 0; a < 4; ++a)
#pragma unroll
        for (int b = 0; b < 2; ++b)
#pragma unroll
            for (int i = 0; i < 16; ++i) acc[a][b][i] = 0.f;
    const int fr = (r >> 2) & 3;
    const int xrow = (wc * 64 + r) * 64, wrow = OPB + (wr * 128 + r) * 64;
    const int co0 = ((0 + h) ^ fr) * 16, co1 = ((2 + h) ^ fr) * 16;

    __syncthreads();
    GLDS(0, 0); GLDS(1, 1); GLDS(2, 2);
    asm volatile("s_waitcnt vmcnt(8)" ::: "memory");
    __builtin_amdgcn_s_barrier();
    bf16x8 w0[4], x0[2], w1[4], x1[2];
#define LOADF(W_, X_, sb_, co_) do { _Pragma("unroll") for (int ti = 0; ti < 2; ++ti) X_[ti] = *(const bf16x8*)((sb_) + xrow + ti * 2048 + (co_)); \
        _Pragma("unroll") for (int fi = 0; fi < 4; ++fi) W_[fi] = *(const bf16x8*)((sb_) + wrow + fi * 2048 + (co_)); } while (0)
#define MFMA8(W_, X_) do { __builtin_amdgcn_s_setprio(1); _Pragma("unroll") for (int fi = 0; fi < 4; ++fi) _Pragma("unroll") for (int ti = 0; ti < 2; ++ti) \
        acc[fi][ti] = MFMA(W_[fi], X_[ti], acc[fi][ti]); __builtin_amdgcn_s_setprio(0); } while (0)
    LOADF(w0, x0, smem, co0);
    __builtin_amdgcn_s_waitcnt(0xC07F);
    int buf = 0;
    for (int kt = 0; kt < nk; ++kt) {
        const char* sb = smem + buf * STAGE_B;
        LOADF(w1, x1, sb, co1);
        __builtin_amdgcn_sched_barrier(0);
        MFMA8(w0, x0);
        __builtin_amdgcn_s_waitcnt(0xC07F);
        __builtin_amdgcn_sched_barrier(0);
        const int nb = (buf + 1 == NST) ? 0 : buf + 1;
        if (kt + 1 < nk) {
            if (kt + 2 < nk) asm volatile("s_waitcnt vmcnt(4)" ::: "memory"); else asm volatile("s_waitcnt vmcnt(0)" ::: "memory");
            __builtin_amdgcn_s_barrier();
            if (kt + 3 < nk) { const int fb_ = (buf + 3 >= NST) ? buf + 3 - NST : buf + 3; GLDS(kt + 3, fb_); }
        }
        LOADF(w0, x0, smem + nb * STAGE_B, co0);
        __builtin_amdgcn_sched_barrier(0);
        MFMA8(w1, x1);
        __builtin_amdgcn_s_waitcnt(0xC07F);
        __builtin_amdgcn_sched_barrier(0);
        buf = nb;
    }
#undef LOADF
#undef MFMA8
#undef GLDS
    __syncthreads();

    if (dry) { if (acc[0][0][0] + acc[1][1][0] + acc[2][0][0] + acc[3][1][0] == 12345.678f) J.O[0] = 1; return; }
    const int tokb = tm * 256 + wc * 64;
    const int fb = tn * 256 + wr * 128;
    float rsc[2];
#pragma unroll
    for (int ti = 0; ti < 2; ++ti) rsc[ti] = J.rs ? __builtin_amdgcn_rsqf(J.rs[tokb + ti * 32 + r] * (1.f / 1024.f) + EPS) : 1.f;

    if (J.mode == 3 && fb >= 1024) {
#pragma unroll
        for (int ti = 0; ti < 2; ++ti) {
            const int tok = tokb + ti * 32 + r;
#pragma unroll
            for (int fi = 0; fi < 4; ++fi)
#pragma unroll
                for (int i = 0; i < 16; ++i) {
                    const int f = fb - 1024 + fi * 32 + crow(i, h);
                    const int bh_ = (tok >> 8) * 4 + (f >> 8), d_ = f & 255, key_ = tok & 255, k16 = key_ & 15;
                    const int ln_ = ((k16 >> 2) & 1) * 32 + (d_ & 31), e_ = ((k16 >> 3) << 2) | (k16 & 3);
                    J.vt[((((((size_t)bh_ * 8 + (d_ >> 5)) * 8 + (key_ >> 5)) * 2 + ((key_ >> 4) & 1)) * 64 + ln_) << 3) + e_] = (bf16_t)(pk2(acc[fi][ti][i] * rsc[ti], 0.f) & 0xffffu);
                }
        }
        return;
    }
    char* wl = smem + wid * 16384;
#pragma unroll
    for (int ti = 0; ti < 2; ++ti) {
#pragma unroll
        for (int fp = 0; fp < 2; ++fp) {
            const float sc = (J.mode == 1) ? J.alpha : rsc[ti];
#pragma unroll
            for (int fi2 = 0; fi2 < 2; ++fi2)
#pragma unroll
                for (int g = 0; g < 4; ++g) {
                    float4 v;
                    v.x = acc[2 * fp + fi2][ti][4 * g + 0] * sc; v.y = acc[2 * fp + fi2][ti][4 * g + 1] * sc;
                    v.z = acc[2 * fp + fi2][ti][4 * g + 2] * sc; v.w = acc[2 * fp + fi2][ti][4 * g + 3] * sc;
                    *(float4*)(wl + r * 272 + (fi2 * 32 + 8 * g + 4 * h) * 4) = v;
                }
            const int tok0 = tokb + ti * 32, f0 = fb + fp * 64;
            if (J.mode == 0) {
                const int c4 = (lane & 7) * 4;
#pragma unroll
                for (int p = 0; p < 4; ++p) {
                    const int row = p * 8 + (lane >> 3);
                    const float4 ga = *(const float4*)(wl + row * 272 + c4 * 4);
                    const float4 up = *(const float4*)(wl + row * 272 + (32 + c4) * 4);
                    float y0 = ga.x * up.x * __builtin_amdgcn_rcpf(1.f + fexp2(-ga.x * LOG2E));
                    float y1 = ga.y * up.y * __builtin_amdgcn_rcpf(1.f + fexp2(-ga.y * LOG2E));
                    float y2 = ga.z * up.z * __builtin_amdgcn_rcpf(1.f + fexp2(-ga.z * LOG2E));
                    float y3 = ga.w * up.w * __builtin_amdgcn_rcpf(1.f + fexp2(-ga.w * LOG2E));
                    *(uint2*)(J.O + (size_t)(tok0 + row) * J.ldo + (f0 >> 1) + c4) = make_uint2(pk2(y0, y1), pk2(y2, y3));
                }
            } else if (J.mode == 1) {
                const int c4 = (lane & 15) * 4;
#pragma unroll
                for (int p = 0; p < 8; ++p) {
                    const int row = p * 4 + (lane >> 4);
                    const size_t tok = tok0 + row;
                    const float4 v = *(const float4*)(wl + row * 272 + c4 * 4);
                    const float4 xo = *(const float4*)(J.xin + tok * D + f0 + c4);
                    float4 xn; xn.x = xo.x + v.x; xn.y = xo.y + v.y; xn.z = xo.z + v.z; xn.w = xo.w + v.w;
                    *(float4*)(J.xout + tok * D + f0 + c4) = xn;
                    if (J.xb) {
                        *(uint2*)(J.xb + tok * D + f0 + c4) = make_uint2(pk2(xn.x, xn.y), pk2(xn.z, xn.w));
                        float ss = xn.x * xn.x + xn.y * xn.y + xn.z * xn.z + xn.w * xn.w;
                        ss += __shfl_xor(ss, 1); ss += __shfl_xor(ss, 2); ss += __shfl_xor(ss, 4); ss += __shfl_xor(ss, 8);
                        if ((lane & 15) == 0) atomicAdd(J.ssq_out + tok, ss);
                    }
                }
            } else {
                const int nm = f0 < J.qn_end ? 1 : (f0 < J.kn_end ? 2 : 0);
                const float* gp = nm == 1 ? J.qg : J.kg;
                const int c4 = (lane & 15) * 4;
                float4 gn = make_float4(1.f, 1.f, 1.f, 1.f);
                if (nm) gn = *(const float4*)(gp + c4);
#pragma unroll
                for (int p = 0; p < 8; ++p) {
                    const int row = p * 4 + (lane >> 4);
                    float4 v = *(const float4*)(wl + row * 272 + c4 * 4);
                    if (nm) {
                        float ss = v.x * v.x + v.y * v.y + v.z * v.z + v.w * v.w;
                        ss += __shfl_xor(ss, 1); ss += __shfl_xor(ss, 2); ss += __shfl_xor(ss, 4); ss += __shfl_xor(ss, 8);
                        const float inv = __builtin_amdgcn_rsqf(ss * (1.f / 64.f) + EPS);
                        v.x *= inv * gn.x; v.y *= inv * gn.y; v.z *= inv * gn.z; v.w *= inv * gn.w;
                    }
                    *(uint2*)(J.O + (size_t)(tok0 + row) * J.ldo + f0 + c4) = make_uint2(pk2(v.x, v.y), pk2(v.z, v.w));
                }
            }
        }
    }
}

DI void gemm_phase(const GJob& JA, int nA, int nB, const Params& P, char* smem, bool dry) {
    for (int u = (int)gridDim.x - 1 - (int)blockIdx.x; u < nA + nB; u += gridDim.x) {
        GJob J = JA; int t = u;
        if (u >= nA) {
            const int v = u - nA; const int layer = v >> 5; t = v & 31;
            J.A = (const bf16_t*)(P.ws + OFF_MEMB); J.lda = D; J.ksplit = 1 << 30; J.kextra = 0;
            J.W = (const bf16_t*)(P.ws + OFF_WKV + (size_t)layer * 2 * SZ_MM); J.K = D; J.ntm = 4; J.ntn = 8; J.mode = 3;
            J.rs = (const float*)(P.ws + OFF_SSQM); J.O = (bf16_t*)(P.ws + OFF_KN + (size_t)layer * SZ_MM); J.ldo = D;
            J.qn_end = 0; J.kn_end = 0; J.vt = (bf16_t*)(P.ws + OFF_VT + (size_t)layer * SZ_MM);
        }
        gemm_tile(J, t, smem, dry);
    }
}

namespace pg8 {
#define PG8_LAS __attribute__((address_space(3)))
typedef float f32x4 __attribute__((ext_vector_type(4)));
typedef unsigned u32x4 __attribute__((ext_vector_type(4)));
constexpr int BM = 256, BK = 64, HALF = 128, HTB = HALF * BK * 2, STAGE_BYTES = 8 * HTB, NXCD = 8, WGM = 8;
DI int lds_byte(int r, int c) { const int st = (r >> 4) * 2 + (c >> 5), rr = r & 15, cc = c & 31, ob = rr * 64 + cc * 2; return st * 1024 + (ob ^ (((ob >> 9) & 1) << 5)); }
DI void stage_rc(int b, int& R, int& C) { const int st = b / 1024, sb = b % 1024, swz = sb ^ (((sb >> 9) & 1) << 5); R = (st >> 1) * 16 + swz / 64; C = (st & 1) * 32 + (swz % 64) / 2; }
DI int perm32(int rho) { const int n = rho >> 4, i = rho & 15; return 8 * (i >> 2) + 4 * n + (i & 3); }
struct Unit { int pm, pn; };
struct Gemm { const bf16_t* A; const bf16_t* Bt; int M, N, K, lda; };
struct StaticOrder {
    int nM, nN, nwg, G, c;
    DI void init(int M, int N, int G_, int c_) { nM = M / BM; nN = N / BM; nwg = nM * nN; G = G_; c = c_; }
    DI bool next(int i, Unit& u) const {
        const long L = (long)i * G + c; if (L >= nwg) return false;
        int wgid = (int)L; { const int q = nwg / NXCD, r = nwg % NXCD, xcd = wgid % NXCD, off = wgid / NXCD; wgid = (xcd < r ? xcd * (q + 1) : r * (q + 1) + (xcd - r) * q) + off; }
        const int nig = WGM * nN, gid = wgid / nig, fm = gid * WGM, gsz = (nM - fm) < WGM ? (nM - fm) : WGM;
        u.pm = fm + ((wgid % nig) % gsz); u.pn = (wgid % nig) / gsz; return true;
    }
    DI void a_ready(const Unit&) const {}
    DI void done(const Unit&) const {}
};

struct Epi {
    static constexpr bool PERM = true, AFTER_DRAIN = false;
    int mode;
    const float* rs;
    bf16_t* O; int ldo;
    const float* xin; float* xout; bf16_t* xb; float* ssq_out; float alpha;
    const float* qg; const float* kg; int qn_end, kn_beg, kn_end; int dryrun;
    template <bool SRC_F32, bool DST_F32>
    DI void res_path(const f32x4 (&acc)[2][2][4][2], int row0, int colb, int fq) const {
        const __amdgpu_buffer_rsrc_t r_xb = wt_rsrc(xb, (size_t)T * D * 2), r_out = wt_rsrc(DST_F32 ? (const void*)xout : (const void*)xb, (size_t)T * D * (DST_F32 ? 4 : 2));
#pragma unroll
        for (int ai = 0; ai < 2; ++ai) {
            float4 xf[4][2][2];
            uint4 xw[4][2];
#pragma unroll
            for (int m = 0; m < 4; ++m)
#pragma unroll
                for (int bj = 0; bj < 2; ++bj) {
                    const size_t off = (size_t)(row0 + ai * HALF + m * 16) * D + colb + bj * 32;
                    if (SRC_F32) { xf[m][bj][0] = *(const float4*)(xin + off); xf[m][bj][1] = *(const float4*)(xin + off + 4); }
                    else xw[m][bj] = *(const uint4*)(xb + off);
                }
#pragma unroll
            for (int m = 0; m < 4; ++m) {
                const size_t tok = row0 + ai * HALF + m * 16;
                float ss = 0.f;
#pragma unroll
                for (int bj = 0; bj < 2; ++bj) {
                    const size_t off = tok * D + colb + bj * 32;
                    float4 x0, x1;
                    if (SRC_F32) { x0 = xf[m][bj][0]; x1 = xf[m][bj][1]; }
                    else { const uint4 w = xw[m][bj]; x0 = make_float4(bflo(w.x), bfhi(w.x), bflo(w.y), bfhi(w.y)); x1 = make_float4(bflo(w.z), bfhi(w.z), bflo(w.w), bfhi(w.w)); }
                    float4 n0, n1;
                    n0.x = x0.x + alpha * acc[ai][bj][m][0][0]; n0.y = x0.y + alpha * acc[ai][bj][m][0][1]; n0.z = x0.z + alpha * acc[ai][bj][m][0][2]; n0.w = x0.w + alpha * acc[ai][bj][m][0][3];
                    n1.x = x1.x + alpha * acc[ai][bj][m][1][0]; n1.y = x1.y + alpha * acc[ai][bj][m][1][1]; n1.z = x1.z + alpha * acc[ai][bj][m][1][2]; n1.w = x1.w + alpha * acc[ai][bj][m][1][3];
                    if (DST_F32) { st16f_wt(r_out, off * 4, n0); st16f_wt(r_out, off * 4 + 16, n1); }
                    else {
                        const uint4 w = make_uint4(pk2(n0.x, n0.y), pk2(n0.z, n0.w), pk2(n1.x, n1.y), pk2(n1.z, n1.w));
                        st16_wt(r_xb, off * 2, w);
                        const float r0 = bflo(w.x), r1 = bfhi(w.x), r2 = bflo(w.y), r3 = bfhi(w.y), r4 = bflo(w.z), r5 = bfhi(w.z), r6 = bflo(w.w), r7 = bfhi(w.w);
                        ss += r0 * r0 + r1 * r1 + r2 * r2 + r3 * r3 + r4 * r4 + r5 * r5 + r6 * r6 + r7 * r7;
                    }
                }
                if (!DST_F32) {
                    ss += __shfl_xor(ss, 16); ss += __shfl_xor(ss, 32);
                    if (fq == 0) atomicAdd(ssq_out + tok, ss);
                }
            }
        }
    }
    template <bool NM>
    DI void qkv_path(const f32x4 (&acc)[2][2][4][2], int row0, int f0, int fq, const float* gp) const {
        const __amdgpu_buffer_rsrc_t r_o = wt_rsrc(O, (size_t)T * ldo * 2);
        float4 g4[2][2];
#pragma unroll
        for (int bj = 0; bj < 2; ++bj)
#pragma unroll
            for (int n = 0; n < 2; ++n) g4[bj][n] = NM ? *(const float4*)(gp + bj * 32 + 8 * fq + 4 * n) : make_float4(1.f, 1.f, 1.f, 1.f);
        float sc8[2][4];
#pragma unroll
        for (int ai = 0; ai < 2; ++ai)
#pragma unroll
            for (int m = 0; m < 4; ++m) sc8[ai][m] = rs[row0 + ai * HALF + m * 16];
#pragma unroll
        for (int ai = 0; ai < 2; ++ai)
#pragma unroll
            for (int m = 0; m < 4; ++m) {
                const size_t tok = row0 + ai * HALF + m * 16;
                float sc = __builtin_amdgcn_rsqf(sc8[ai][m] * (1.f / 1024.f) + EPS);
                if (NM) {
                    float ss = 0.f;
#pragma unroll
                    for (int bj = 0; bj < 2; ++bj)
#pragma unroll
                        for (int n = 0; n < 2; ++n)
#pragma unroll
                            for (int j = 0; j < 4; ++j) { const float v = acc[ai][bj][m][n][j] * sc; ss += v * v; }
                    ss += __shfl_xor(ss, 16); ss += __shfl_xor(ss, 32);
                    sc *= __builtin_amdgcn_rsqf(ss * (1.f / 64.f) + EPS);
                }
#pragma unroll
                for (int bj = 0; bj < 2; ++bj) {
                    const f32x4 a0 = acc[ai][bj][m][0], a1 = acc[ai][bj][m][1];
                    st16_wt(r_o, (tok * ldo + f0 + bj * 32 + 8 * fq) * 2,
                        make_uint4(pk2(a0[0] * sc * g4[bj][0].x, a0[1] * sc * g4[bj][0].y), pk2(a0[2] * sc * g4[bj][0].z, a0[3] * sc * g4[bj][0].w),
                                   pk2(a1[0] * sc * g4[bj][1].x, a1[1] * sc * g4[bj][1].y), pk2(a1[2] * sc * g4[bj][1].z, a1[3] * sc * g4[bj][1].w)));
                }
            }
    }
    DI void operator()(const f32x4 (&acc)[2][2][4][2], const Unit& u, int wr, int wc, int fr, int fq) const {
        if (dryrun) { if (acc[0][0][0][0][0] + acc[1][1][3][1][3] + acc[0][1][2][0][1] + acc[1][0][1][1][2] == 12345.678f) O[0] = 1; return; }
        const int row0 = u.pm * BM + wr * 64 + fr;
        if (mode == 0) {
            const int col = u.pn * 128 + wc * 32 + 8 * fq;
            const __amdgpu_buffer_rsrc_t r_o = wt_rsrc(O, (size_t)T * ldo * 2);
            float sc8[2][4];
#pragma unroll
            for (int ai = 0; ai < 2; ++ai)
#pragma unroll
                for (int m = 0; m < 4; ++m) sc8[ai][m] = rs[row0 + ai * HALF + m * 16];
#pragma unroll
            for (int ai = 0; ai < 2; ++ai)
#pragma unroll
                for (int m = 0; m < 4; ++m) {
                    const size_t tok = row0 + ai * HALF + m * 16;
                    const float sc = __builtin_amdgcn_rsqf(sc8[ai][m] * (1.f / 1024.f) + EPS);
                    float y[8];
#pragma unroll
                    for (int n = 0; n < 2; ++n)
#pragma unroll
                        for (int j = 0; j < 4; ++j) {
                            const float ga = acc[ai][0][m][n][j] * sc, up = acc[ai][1][m][n][j] * sc;
                            y[4 * n + j] = ga * up * __builtin_amdgcn_rcpf(1.f + fexp2(-ga * LOG2E));
                        }
                    st16_wt(r_o, (tok * ldo + col) * 2, make_uint4(pk2(y[0], y[1]), pk2(y[2], y[3]), pk2(y[4], y[5]), pk2(y[6], y[7])));
                }
        } else if (mode == 1) {
            const int colb = u.pn * BM + wc * 64 + 8 * fq;
            if (xin) res_path<true, false>(acc, row0, colb, fq);
            else if (xout) res_path<false, true>(acc, row0, colb, fq);
            else res_path<false, false>(acc, row0, colb, fq);
        } else {
            const int f0 = u.pn * BM + wc * 64;
            const int nm = f0 < qn_end ? 1 : ((f0 >= kn_beg && f0 < kn_end) ? 2 : 0);
            if (nm) qkv_path<true>(acc, row0, f0, fq, nm == 1 ? qg : kg);
            else qkv_path<false>(acc, row0, f0, fq, nullptr);
        }
    }
};

template <class Epi, class Sched, bool ALIGN_EPI = false, bool SP2 = false>
__device__ __forceinline__ void gemm_phase(PG8_LAS unsigned char* lds, const Gemm g, const Sched& S, const Epi& E) {
    const int tid = otid(), wid = __builtin_amdgcn_readfirstlane(tid >> 6), lane = tid & 63, wr = wid >> 2, wc = wid & 3, fr = lane & 15, fq = lane >> 4;
    const int K = g.K, nt = K / BK;
    unsigned voffA[2], voffB[2];
#pragma unroll
    for (int i = 0; i < 2; ++i) { int R, C; stage_rc(tid * 16 + i * 8192, R, C); const int Rb = Epi::PERM ? ((R & ~31) + perm32(R & 31)) : R;
        voffA[i] = (unsigned)(R * g.lda + C) * 2u; voffB[i] = (unsigned)(Rb * K + C) * 2u; }
    const size_t kstep = (size_t)(BK * 2);
    const size_t hstepA = (size_t)HALF * g.lda * 2, hstepB = (size_t)HALF * K * 2;
    const size_t tstepA = 2 * hstepA, tstepB = 2 * hstepB;
    const unsigned ldsw = (unsigned)wid * 1024u;
    const int aoff = lds_byte(wr * 64 + fr, fq * 8), boff = lds_byte(wc * 32 + fr, fq * 8);
#define PG8_SA(b, h) (((b) * 2 + (h)) * HTB)
#define PG8_SB(b, h) ((4 + (b) * 2 + (h)) * HTB)
#define PG8_STAGE(bufoff, gbase, voff) do { _Pragma("unroll") for (int _i = 0; _i < 2; ++_i) \
        __builtin_amdgcn_global_load_lds((const unsigned*)((const char*)(gbase) + (voff)[_i]), (PG8_LAS unsigned*)(lds + (bufoff) + ldsw + _i * 8192), 16, 0, 0); } while (0)
#define PG8_LDA(dst, b, h) do { _Pragma("unroll") for (int m = 0; m < 4; ++m) _Pragma("unroll") for (int k = 0; k < 2; ++k) dst[m][k] = *(const PG8_LAS bf16x8*)(lds + PG8_SA(b, h) + aoff + m * 2048 + k * 1024); } while (0)
#define PG8_LDB(dst, b, h) do { _Pragma("unroll") for (int n = 0; n < 2; ++n) _Pragma("unroll") for (int k = 0; k < 2; ++k) dst[n][k] = *(const PG8_LAS bf16x8*)(lds + PG8_SB(b, h) + boff + n * 2048 + k * 1024); } while (0)
#define PG8_MMA(ai, bj, At, Bt) do { __builtin_amdgcn_s_setprio(1); _Pragma("unroll") for (int m = 0; m < 4; ++m) _Pragma("unroll") for (int n = 0; n < 2; ++n) _Pragma("unroll") for (int k = 0; k < 2; ++k) \
        acc[ai][bj][m][n] = __builtin_amdgcn_mfma_f32_16x16x32_bf16(Bt[n][k], At[m][k], acc[ai][bj][m][n], 0, 0, 0); __builtin_amdgcn_s_setprio(0); } while (0)
#define PG8_WAIT_V(n) asm volatile("s_waitcnt vmcnt(" #n ")" ::: "memory")
#define PG8_WAIT_L(n) asm volatile("s_waitcnt lgkmcnt(" #n ")" ::: "memory")
#define PG8_BAR __builtin_amdgcn_s_barrier()
#define PG8_SCHED __builtin_amdgcn_sched_barrier(0)
    Unit cur, nxt; int ui = 0;
    if (!S.next(0, cur)) return;
    f32x4 acc[2][2][4][2];
#pragma unroll
    for (int a = 0; a < 2; ++a)
#pragma unroll
        for (int b = 0; b < 2; ++b)
#pragma unroll
            for (int m = 0; m < 4; ++m)
#pragma unroll
                for (int n = 0; n < 2; ++n) acc[a][b][m][n] = (f32x4){0.f, 0.f, 0.f, 0.f};
    bf16x8 At[4][2], B0[2][2], B1[2][2];
    const char* cA = (const char*)g.A + (size_t)cur.pm * tstepA; const char* cB = (const char*)g.Bt + (size_t)cur.pn * tstepB;
    S.a_ready(cur);
    if constexpr (SP2) {
        PG8_STAGE(PG8_SB(0, 0), cB, voffB); PG8_STAGE(PG8_SB(0, 1), cB + hstepB, voffB); PG8_STAGE(PG8_SA(0, 0), cA, voffA); PG8_STAGE(PG8_SA(0, 1), cA + hstepA, voffA);
        if (wr == 1) PG8_BAR;
        PG8_WAIT_V(2); PG8_BAR;
        PG8_STAGE(PG8_SB(1, 0), cB + kstep, voffB); PG8_STAGE(PG8_SA(1, 0), cA + kstep, voffA); PG8_STAGE(PG8_SB(1, 1), cB + hstepB + kstep, voffB);
        PG8_WAIT_V(6); PG8_BAR;
    } else {
        PG8_STAGE(PG8_SB(0, 0), cB, voffB); PG8_STAGE(PG8_SA(0, 0), cA, voffA); PG8_STAGE(PG8_SB(0, 1), cB + hstepB, voffB); PG8_STAGE(PG8_SA(0, 1), cA + hstepA, voffA);
        if (wr == 1) PG8_BAR;
        PG8_WAIT_V(4); PG8_BAR;
        PG8_STAGE(PG8_SB(1, 0), cB + kstep, voffB); PG8_STAGE(PG8_SA(1, 0), cA + kstep, voffA); PG8_STAGE(PG8_SB(1, 1), cB + hstepB + kstep, voffB);
        PG8_WAIT_V(6); PG8_BAR;
    }
    for (;;) {
        const bool has_next = S.next(ui + 1, nxt);
        const char* nA = has_next ? (const char*)g.A + (size_t)nxt.pm * tstepA : cA; const char* nB = has_next ? (const char*)g.Bt + (size_t)nxt.pn * tstepB : cB;
        for (int t = 0; t < nt; t += 2) {
            const bool last = (t == nt - 2);
            const char* a1 = cA + (size_t)(t + 1) * kstep;
            const char* a2 = last ? nA : cA + (size_t)(t + 2) * kstep; const char* b2 = last ? nB : cB + (size_t)(t + 2) * kstep;
            const char* a3 = a2 + kstep; const char* b3 = b2 + kstep;
            if (last && has_next) S.a_ready(nxt);
            if constexpr (SP2) {
            PG8_LDB(B0, 0, 0); PG8_LDB(B1, 0, 1); PG8_SCHED; PG8_LDA(At, 0, 0); PG8_STAGE(PG8_SA(1, 1), a1 + hstepA, voffA);
            PG8_WAIT_V(8); PG8_WAIT_L(0); PG8_BAR; PG8_MMA(0, 0, At, B0); PG8_MMA(0, 1, At, B1); PG8_BAR; PG8_SCHED;
            PG8_LDA(At, 0, 1); PG8_STAGE(PG8_SB(0, 0), b2, voffB); PG8_STAGE(PG8_SB(0, 1), b2 + hstepB, voffB); PG8_STAGE(PG8_SA(0, 0), a2, voffA);
            PG8_WAIT_V(8); PG8_WAIT_L(0); PG8_BAR; PG8_MMA(1, 0, At, B0); PG8_MMA(1, 1, At, B1); PG8_BAR; PG8_SCHED;
            PG8_LDB(B0, 1, 0); PG8_LDB(B1, 1, 1); PG8_SCHED; PG8_LDA(At, 1, 0); PG8_STAGE(PG8_SA(0, 1), a2 + hstepA, voffA);
            PG8_WAIT_V(8); PG8_WAIT_L(0); PG8_BAR; PG8_MMA(0, 0, At, B0); PG8_MMA(0, 1, At, B1); PG8_BAR; PG8_SCHED;
            PG8_LDA(At, 1, 1); PG8_STAGE(PG8_SB(1, 0), b3, voffB); PG8_STAGE(PG8_SB(1, 1), b3 + hstepB, voffB); PG8_STAGE(PG8_SA(1, 0), a3, voffA);
            PG8_WAIT_V(8); PG8_WAIT_L(0); PG8_BAR; PG8_MMA(1, 0, At, B0); PG8_MMA(1, 1, At, B1); PG8_BAR; PG8_SCHED;
            } else {
            PG8_LDB(B0, 0, 0); PG8_SCHED; PG8_LDA(At, 0, 0); PG8_STAGE(PG8_SA(1, 1), a1 + hstepA, voffA);
            PG8_WAIT_L(8); PG8_BAR; PG8_WAIT_L(0); PG8_MMA(0, 0, At, B0); PG8_BAR; PG8_SCHED;
            PG8_LDB(B1, 0, 1); PG8_STAGE(PG8_SB(0, 0), b2, voffB);
            PG8_BAR; PG8_WAIT_L(0); PG8_MMA(0, 1, At, B1); PG8_BAR;
            PG8_LDA(At, 0, 1); PG8_STAGE(PG8_SA(0, 0), a2, voffA);
            PG8_BAR; PG8_WAIT_L(0); PG8_MMA(1, 0, At, B0); PG8_BAR; PG8_SCHED;
            PG8_STAGE(PG8_SB(0, 1), b2 + hstepB, voffB);
            PG8_WAIT_V(6); PG8_BAR; PG8_MMA(1, 1, At, B1); PG8_BAR;
            PG8_LDB(B0, 1, 0); PG8_SCHED; PG8_LDA(At, 1, 0); PG8_STAGE(PG8_SA(0, 1), a2 + hstepA, voffA);
            PG8_WAIT_L(8); PG8_BAR; PG8_WAIT_L(0); PG8_MMA(0, 0, At, B0); PG8_BAR; PG8_SCHED;
            PG8_LDB(B1, 1, 1); PG8_STAGE(PG8_SB(1, 0), b3, voffB);
            PG8_BAR; PG8_WAIT_L(0); PG8_MMA(0, 1, At, B1); PG8_BAR;
            PG8_LDA(At, 1, 1); PG8_STAGE(PG8_SA(1, 0), a3, voffA);
            PG8_BAR; PG8_WAIT_L(0); PG8_MMA(1, 0, At, B0); PG8_BAR; PG8_SCHED;
            PG8_STAGE(PG8_SB(1, 1), b3 + hstepB, voffB);
            PG8_WAIT_V(6); PG8_BAR; PG8_MMA(1, 1, At, B1); PG8_BAR;
            }
        }
        if constexpr (ALIGN_EPI) { if (wr == 0) PG8_BAR; }
        if constexpr (!Epi::AFTER_DRAIN) { E(acc, cur, wr, wc, fr, fq); S.done(cur); }
        if (!has_next) break;
#pragma unroll
        for (int a = 0; a < 2; ++a)
#pragma unroll
            for (int b = 0; b < 2; ++b)
#pragma unroll
                for (int m = 0; m < 4; ++m)
#pragma unroll
                    for (int n = 0; n < 2; ++n) acc[a][b][m][n] = (f32x4){0.f, 0.f, 0.f, 0.f};
        cur = nxt; cA = nA; cB = nB; ++ui;
        if constexpr (ALIGN_EPI) { if (wr == 1) PG8_BAR; }
    }
    PG8_WAIT_V(0);
    if constexpr (!ALIGN_EPI) { if (wr == 0) PG8_BAR; }
    PG8_BAR;
    if constexpr (Epi::AFTER_DRAIN) { E.fused(acc, cur, wr, wc, fr, fq, lds, wid, lane); S.done(cur); }
#undef PG8_SA
#undef PG8_SB
#undef PG8_STAGE
#undef PG8_LDA
#undef PG8_LDB
#undef PG8_MMA
#undef PG8_WAIT_V
#undef PG8_WAIT_L
#undef PG8_BAR
#undef PG8_SCHED
}
}

#define KV_DECL uint4 rk0, rk1, rk2, rk3, rv0, rv1, rv2, rv3
#define KV_LOAD(kb_, dil_) do { const int kk_ = lane >> 3; \
    const bf16_t* p0_ = qkv + (rowb + min(max((kb_) + (dil_) * kk_, 0), S - 1)) * ld + (lane & 7) * 8; \
    const bf16_t* p1_ = qkv + (rowb + min(max((kb_) + (dil_) * (kk_ + 8), 0), S - 1)) * ld + (lane & 7) * 8; \
    const bf16_t* p2_ = qkv + (rowb + min(max((kb_) + (dil_) * (kk_ + 16), 0), S - 1)) * ld + (lane & 7) * 8; \
    const bf16_t* p3_ = qkv + (rowb + min(max((kb_) + (dil_) * (kk_ + 24), 0), S - 1)) * ld + (lane & 7) * 8; \
    rk0 = *(const uint4*)(p0_ + kcol); rk1 = *(const uint4*)(p1_ + kcol); rk2 = *(const uint4*)(p2_ + kcol); rk3 = *(const uint4*)(p3_ + kcol); \
    rv0 = *(const uint4*)(p0_ + vcol); rv1 = *(const uint4*)(p1_ + vcol); rv2 = *(const uint4*)(p2_ + vcol); rv3 = *(const uint4*)(p3_ + vcol); } while (0)
#define KV_STORE() do { char* wp_ = vl + (lane >> 3) * 144 + (lane & 7) * 16; \
    *(uint4*)(wp_) = rk0; *(uint4*)(wp_ + 8 * 144) = rk1; *(uint4*)(wp_ + 16 * 144) = rk2; *(uint4*)(wp_ + 24 * 144) = rk3; \
    *(uint4*)(wp_ + 4608) = rv0; *(uint4*)(wp_ + 4608 + 8 * 144) = rv1; *(uint4*)(wp_ + 4608 + 16 * 144) = rv2; *(uint4*)(wp_ + 4608 + 24 * 144) = rv3; } while (0)

DI bf16x8 v_frag(const char* vbase, int s, int dt) {
    typedef __attribute__((address_space(3))) v4i16_t* lp_t;
    const char* a = vbase + s * (16 * 144) + dt * 64;
    const s16x4 lo = __builtin_bit_cast(s16x4, __builtin_amdgcn_ds_read_tr16_b64_v4i16((lp_t)(a)));
    const s16x4 hi = __builtin_bit_cast(s16x4, __builtin_amdgcn_ds_read_tr16_b64_v4i16((lp_t)(a + 8 * 144)));
    return __builtin_shufflevector(lo, hi, 0, 1, 2, 3, 4, 5, 6, 7);
}

template <int OFF> DI bf16x8 pack8v(const f32x16& p) {
    typedef unsigned u32x4 __attribute__((ext_vector_type(4)));
    u32x4 w; w[0] = pk2(p[OFF + 0], p[OFF + 1]); w[1] = pk2(p[OFF + 2], p[OFF + 3]); w[2] = pk2(p[OFF + 4], p[OFF + 5]); w[3] = pk2(p[OFF + 6], p[OFF + 7]);
    return __builtin_bit_cast(bf16x8, w);
}

DI void win_attn_wave(bf16_t* qkv, int ld, int b, int qcol, int kcol, int vcol, int tq0, int qstride,
                      float slope2, float m_init, float l_init, int pat, char* vl, int lane, bool dry,
                      int nq = 32, float* st = nullptr, int tloc0 = 0, int tlstride = 0, int stage = 0) {
    const int r = lane & 31, h = lane >> 5;
    const size_t rowb = (size_t)b * S;
    const int tq = tq0 + qstride * r;
    bf16x8 qf[4];
    {
        const bf16_t* qp = qkv + (rowb + min(tq, S - 1)) * ld + qcol + h * 32;
#pragma unroll
        for (int ks = 0; ks < 4; ++ks) qf[ks] = *(const bf16x8*)(qp + ks * 8);
    }
    f32x16 o0, o1;
#pragma unroll
    for (int i = 0; i < 16; ++i) { o0[i] = 0.f; o1[i] = 0.f; }
    float m = m_init, l = (h == 0) ? l_init : 0.f;
    const float sc2 = 0.125f * LOG2E;
    const int i16 = lane & 15;
    const char* vbase = vl + 4608 + (4 * h + (i16 >> 2)) * 144 + (16 * ((lane >> 4) & 1) + 4 * (i16 & 3)) * 2;
    const char* kfp = vl + r * 144 + h * 64;
    KV_DECL;
    for (int pi = 0; pi < 1; ++pi) {
        int dil, W, kfirst; const int nt = 5;
        if (pat < 0) { dil = 1; W = 127; kfirst = tq0 - 128; }
        else if (pat == 0) { dil = 1; W = 128; kfirst = tq0 - 128; }
        else if (pat == 1) { dil = 4; W = 512; kfirst = tq0 - 512; }
        else { dil = 16; W = 2048; kfirst = tq0 - 2048; }
        const int step = 32 * dil;
        int t0 = 0;
        { const int need = -kfirst - 31 * dil; if (need > 0) t0 = (need + step - 1) / step; }
        if (t0 >= nt) continue;
        KV_LOAD(kfirst + t0 * step, dil);
        for (int tile = t0; tile < nt; ++tile) {
            const int kb = kfirst + tile * step;
            KV_STORE();
            asm volatile("" ::: "memory");
            if (tile + 1 < nt) KV_LOAD(kb + step, dil);
            f32x16 s;
#pragma unroll
            for (int i = 0; i < 16; ++i) s[i] = 0.f;
#pragma unroll
            for (int ks = 0; ks < 4; ++ks) s = MFMA(*(const bf16x8*)(kfp + ks * 16), qf[ks], s);
            f32x16 sv; float mloc = -INFINITY;
            const int d0 = tq - kb - 4 * h * dil;
            const float b0 = -slope2 * (float)d0, b1 = slope2 * (float)dil;
            if (tile >= 1 && tile <= 3 && kb >= 0) {
#pragma unroll
                for (int i = 0; i < 16; ++i) {
                    sv[i] = __builtin_fmaf(s[i], sc2, __builtin_fmaf(b1, (float)crow(i, 0), b0));
                    mloc = fmaxf(mloc, sv[i]);
                }
            } else {
                const unsigned wlim = (unsigned)min(W, tq);
#pragma unroll
                for (int i = 0; i < 16; ++i) {
                    const int diff = d0 - dil * crow(i, 0);
                    const float sb = __builtin_fmaf(s[i], sc2, __builtin_fmaf(b1, (float)crow(i, 0), b0));
                    sv[i] = ((unsigned)diff <= wlim) ? sb : -INFINITY;
                    mloc = fmaxf(mloc, sv[i]);
                }
            }
            mloc = fmaxf(mloc, __shfl_xor(mloc, 32));
            const float mn = fmaxf(m, mloc);
            float ps = 0.f;
#pragma unroll
            for (int i = 0; i < 16; ++i) { sv[i] = fexp2(sv[i] - mn); ps += sv[i]; }
            if (__builtin_amdgcn_ballot_w64(mn != m) != 0) {
                const float alpha = fexp2(m - mn);
                l *= alpha;
#pragma unroll
                for (int i = 0; i < 16; ++i) { o0[i] *= alpha; o1[i] *= alpha; }
                m = mn;
            }
            l += ps;
            const bf16x8 p0 = pack8v<0>(sv), p1 = pack8v<8>(sv);
            o0 = MFMA(v_frag(vbase, 0, 0), p0, o0);
            o0 = MFMA(v_frag(vbase, 1, 0), p1, o0);
            o1 = MFMA(v_frag(vbase, 0, 1), p0, o1);
            o1 = MFMA(v_frag(vbase, 1, 1), p1, o1);
            asm volatile("" ::: "memory");
        }
    }
    float lt = l + __shfl_xor(l, 32);
    if (st) {
        const bool act = r < nq;
        float* sp = st + (tloc0 + tlstride * r) * 68;
        if (act) {
            if (stage > 0) {
                const float ms = sp[64], ls = sp[65];
                const float mn = fmaxf(ms, m);
                const float as = fexp2(ms - mn), aw = fexp2(m - mn);
                lt = ls * as + lt * aw; m = mn;
#pragma unroll
                for (int g = 0; g < 4; ++g) {
                    const float4 a = *(const float4*)(sp + 8 * g + 4 * h), c = *(const float4*)(sp + 32 + 8 * g + 4 * h);
                    o0[4 * g] = a.x * as + o0[4 * g] * aw; o0[4 * g + 1] = a.y * as + o0[4 * g + 1] * aw; o0[4 * g + 2] = a.z * as + o0[4 * g + 2] * aw; o0[4 * g + 3] = a.w * as + o0[4 * g + 3] * aw;
                    o1[4 * g] = c.x * as + o1[4 * g] * aw; o1[4 * g + 1] = c.y * as + o1[4 * g + 1] * aw; o1[4 * g + 2] = c.z * as + o1[4 * g + 2] * aw; o1[4 * g + 3] = c.w * as + o1[4 * g + 3] * aw;
                }
            }
            if (stage < 2) {
                if (h == 0) { sp[64] = m; sp[65] = lt; }
#pragma unroll
                for (int g = 0; g < 4; ++g) {
                    *(float4*)(sp + 8 * g + 4 * h) = make_float4(o0[4 * g], o0[4 * g + 1], o0[4 * g + 2], o0[4 * g + 3]);
                    *(float4*)(sp + 32 + 8 * g + 4 * h) = make_float4(o1[4 * g], o1[4 * g + 1], o1[4 * g + 2], o1[4 * g + 3]);
                }
            }
        }
        if (stage < 2 || !act) return;
    }
    const float inv = 1.f / lt;
    if (dry) { if (o0[0] + o1[0] + lt == 12345.678f) qkv[0] = 1; return; }
    bf16_t* op = qkv + (rowb + tq) * ld + qcol + 4 * h;
#pragma unroll
    for (int g = 0; g < 4; ++g) {
        *(uint2*)(op + 8 * g) = make_uint2(pk2(o0[4 * g] * inv, o0[4 * g + 1] * inv), pk2(o0[4 * g + 2] * inv, o0[4 * g + 3] * inv));
        *(uint2*)(op + 32 + 8 * g) = make_uint2(pk2(o1[4 * g] * inv, o1[4 * g + 1] * inv), pk2(o1[4 * g + 2] * inv, o1[4 * g + 3] * inv));
    }
}

DI void stick_wave(bf16_t* qkv, int ld, int b, int qcol, int kcol, int vcol, int qt, char* vl, int lane, bool dry) {
    const int r = lane & 31, h = lane >> 5;
    const size_t rowb = (size_t)b * S;
    const int tq = qt * 32 + r;
    bf16x8 qf[4];
    {
        const bf16_t* qp = qkv + (rowb + tq) * ld + qcol + h * 32;
#pragma unroll
        for (int ks = 0; ks < 4; ++ks) qf[ks] = *(const bf16x8*)(qp + ks * 8);
    }
    f32x16 o0, o1;
#pragma unroll
    for (int i = 0; i < 16; ++i) { o0[i] = 0.f; o1[i] = 0.f; }
    float R = 1.f;
    const int i16 = lane & 15;
    const char* vbase = vl + 4608 + (4 * h + (i16 >> 2)) * 144 + (16 * ((lane >> 4) & 1) + 4 * (i16 & 3)) * 2;
    const char* kfp = vl + r * 144 + h * 64;
    KV_DECL;
    KV_LOAD(qt * 32, 1);
    for (int tile = qt; tile >= 0; --tile) {
        KV_STORE();
        asm volatile("" ::: "memory");
        if (tile > 0) KV_LOAD((tile - 1) * 32, 1);
        f32x16 s;
#pragma unroll
        for (int i = 0; i < 16; ++i) s[i] = 0.f;
#pragma unroll
        for (int ks = 0; ks < 4; ++ks) s = MFMA(*(const bf16x8*)(kfp + ks * 16), qf[ks], s);
        const bool diag = (tile == qt);
        f32x16 sg, kp;
#pragma unroll
        for (int i = 0; i < 16; ++i) {
            const float z2 = fminf(s[i] * (0.125f * LOG2E), 80.f);
            const float t = fexp2(z2);
            const float k = __builtin_amdgcn_rcpf(1.f + t);
            kp[i] = k; sg[i] = t * k;
        }
        if (diag) {
#pragma unroll
            for (int i = 0; i < 16; ++i) { const bool strict = crow(i, h) < r; kp[i] = strict ? kp[i] : 1.f; sg[i] = strict ? sg[i] : 0.f; }
        }
        float G[4], PG[4], both[4];
#pragma unroll
        for (int g = 0; g < 4; ++g) { G[g] = (kp[4 * g] * kp[4 * g + 1]) * (kp[4 * g + 2] * kp[4 * g + 3]); PG[g] = __shfl_xor(G[g], 32); both[g] = G[g] * PG[g]; }
        float Sx[4];
        Sx[3] = 1.f; Sx[2] = both[3]; Sx[1] = both[3] * both[2]; Sx[0] = Sx[1] * both[1];
        f32x16 a;
#pragma unroll
        for (int g = 0; g < 4; ++g) {
            float la = R * Sx[g] * (h == 0 ? PG[g] : 1.f);
#pragma unroll
            for (int j = 3; j >= 0; --j) {
                a[4 * g + j] = sg[4 * g + j] * la;
                la *= kp[4 * g + j];
            }
        }
        R *= Sx[0] * both[0];
        const bf16x8 p0 = pack8v<0>(a), p1 = pack8v<8>(a);
        o0 = MFMA(v_frag(vbase, 0, 0), p0, o0);
        o0 = MFMA(v_frag(vbase, 1, 0), p1, o0);
        o1 = MFMA(v_frag(vbase, 0, 1), p0, o1);
        o1 = MFMA(v_frag(vbase, 1, 1), p1, o1);
        asm volatile("" ::: "memory");
        if (__builtin_amdgcn_ballot_w64(R >= 1.17549435e-38f) == 0) break;
    }
    if (dry) { if (o0[0] + o1[0] == 12345.678f) qkv[0] = 1; return; }
    bf16_t* op = qkv + (rowb + tq) * ld + qcol + 4 * h;
#pragma unroll
    for (int g = 0; g < 4; ++g) {
        *(uint2*)(op + 8 * g) = make_uint2(pk2(o0[4 * g], o0[4 * g + 1]), pk2(o0[4 * g + 2], o0[4 * g + 3]));
        *(uint2*)(op + 32 + 8 * g) = make_uint2(pk2(o1[4 * g], o1[4 * g + 1]), pk2(o1[4 * g + 2], o1[4 * g + 3]));
    }
}

DI void attn_even_phase(const Params& P, char* smem, bool dry) {
    const int tid_ = otid(); const int lane = tid_ & 63, wid = tid_ >> 6;
    bf16_t* qkv = (bf16_t*)(P.ws + OFF_BIG);
    char* vl = smem + wid * 9216;
    for (int it = blockIdx.x * 8 + wid; it < 2048 + 4096; it += gridDim.x * 8) {
        if (it < 2048) {
            const int bh = it >> 6, p = it & 63; const int b = bh >> 3, head = bh & 7;
            stick_wave(qkv, 2304, b, 512 + head * 64, 1280 + head * 64, 1792 + head * 64, 127 - p, vl, lane, dry);
            stick_wave(qkv, 2304, b, 512 + head * 64, 1280 + head * 64, 1792 + head * 64, p, vl, lane, dry);
        } else {
            const int v = it - 2048; const int g = v & 3; const int qt = (v >> 2) & 127; const int rest = v >> 9; const int b = rest >> 1, kvh = rest & 1;
            const int head = kvh * 4 + g;
            const float slope = exp2f(-(float)(head + 1));
            const float sink = P.in[9][head];
            win_attn_wave(qkv, 2304, b, head * 64, 1024 + kvh * 64, 1152 + kvh * 64, qt * 32, 1, slope * LOG2E, sink * LOG2E, 1.f, -1, vl, lane, dry);
        }
    }
}

DI void attn_odd_phase(const Params& P, char* smem, bool dry) {
    const int tid_ = otid(); const int lane = tid_ & 63, wid = tid_ >> 6;
    bf16_t* qkv = (bf16_t*)(P.ws + OFF_BIG);
    char* vl = smem + wid * 9216;
    float* st = (float*)(smem + 8 * 9216);
    for (int it = blockIdx.x; it < 1024; it += gridDim.x) {
        const int span = it & 15, head = (it >> 4) & 15, b = it >> 8; const int t0 = span * 256;
        const float slope2 = exp2f(-0.5f * (float)(head + 1)) * LOG2E;
        const int qc = head * 64, kc = 1024 + head * 64, vc = 2048 + head * 64;
        __syncthreads();
        win_attn_wave(qkv, 3072, b, qc, kc, vc, t0 + 32 * wid, 1, slope2, -1e30f, 0.f, 0, vl, lane, dry, 32, st, 32 * wid, 1, 0);
        __syncthreads();
        { const int r4 = wid >> 1, hf = wid & 1;
          win_attn_wave(qkv, 3072, b, qc, kc, vc, t0 + r4 + 128 * hf, 4, slope2, -1e30f, 0.f, 1, vl, lane, dry, 32, st, r4 + 128 * hf, 4, 1); }
        __syncthreads();
#pragma unroll 1
        for (int k = 0; k < 2; ++k) {
            const int r16 = 2 * wid + k;
            win_attn_wave(qkv, 3072, b, qc, kc, vc, t0 + r16, 16, slope2, -1e30f, 0.f, 2, vl, lane, dry, 16, st, r16, 16, 2);
        }
    }
}

DI void xattn_wave(bf16_t* qb, const bf16_t* Kn, const bf16_t* VT, const float* qg, float kmax2, int b, int head, int tok0, char* ql, int lane, bool dry) {
    const int r = lane & 31, h = lane >> 5;
    const size_t token = (size_t)b * S + tok0 + r;
    bf16_t* qp = qb + token * D + head * 256 + h * 128;
    float ss = 0.f;
#pragma unroll
    for (int ks = 0; ks < 16; ++ks) {
        const uint4 v = *(const uint4*)(qp + ks * 8);
        const unsigned w[4] = {v.x, v.y, v.z, v.w};
#pragma unroll
        for (int e = 0; e < 4; ++e) { const float a = bflo(w[e]), c = bfhi(w[e]); ss += a * a + c * c; }
    }
    ss += __shfl_xor(ss, 32);
    const float inv = __builtin_amdgcn_rsqf(ss * (1.f / 256.f) + EPS);
    float qq2 = 0.f;
#pragma unroll
    for (int ks = 0; ks < 16; ++ks) {
        const uint4 v = *(const uint4*)(qp + ks * 8);
        const float4 g0 = *(const float4*)(qg + h * 128 + ks * 8), g1 = *(const float4*)(qg + h * 128 + ks * 8 + 4);
        uint4 o;
        o.x = pk2(bflo(v.x) * inv * g0.x, bfhi(v.x) * inv * g0.y); o.y = pk2(bflo(v.y) * inv * g0.z, bfhi(v.y) * inv * g0.w);
        o.z = pk2(bflo(v.z) * inv * g1.x, bfhi(v.z) * inv * g1.y); o.w = pk2(bflo(v.w) * inv * g1.z, bfhi(v.w) * inv * g1.w);
        qq2 += bflo(o.x) * bflo(o.x) + bfhi(o.x) * bfhi(o.x) + bflo(o.y) * bflo(o.y) + bfhi(o.y) * bfhi(o.y)
             + bflo(o.z) * bflo(o.z) + bfhi(o.z) * bfhi(o.z) + bflo(o.w) * bflo(o.w) + bfhi(o.w) * bfhi(o.w);
        *(uint4*)(ql + (ks * 64 + lane) * 16) = o;
    }
    qq2 += __shfl_xor(qq2, 32);
    asm volatile("" ::: "memory");
    const float sc2 = 0.0625f * LOG2E;
    const bf16_t* kp0 = Kn + ((size_t)(b * 4 + head) * 8 * 16 * 64 + lane) * 8;
    const float m = __builtin_amdgcn_sqrtf(qq2 * kmax2) * 1.001f;
    float l = 0.f;
    bf16x8 pf[8][2];
    bf16x8 kc[16], kn[16];
#pragma unroll
    for (int ks = 0; ks < 16; ++ks) kc[ks] = *(const bf16x8*)(kp0 + ks * 512);
#pragma unroll
    for (int tile = 0; tile < 8; ++tile) {
        if (tile < 7) {
#pragma unroll
            for (int ks = 0; ks < 16; ++ks) kn[ks] = *(const bf16x8*)(kp0 + (size_t)(tile + 1) * 16 * 512 + ks * 512);
        }
        f32x16 s, s_b;
#pragma unroll
        for (int i = 0; i < 16; ++i) { s[i] = 0.f; s_b[i] = 0.f; }
#pragma unroll
        for (int ks = 0; ks < 16; ks += 2) {
            const bf16x8 qf0 = *(const bf16x8*)(ql + (ks * 64 + lane) * 16);
            const bf16x8 qf1 = *(const bf16x8*)(ql + ((ks + 1) * 64 + lane) * 16);
            s = MFMA(kc[ks], qf0, s);
            s_b = MFMA(kc[ks + 1], qf1, s_b);
        }
#pragma unroll
        for (int i = 0; i < 16; ++i) s[i] += s_b[i];
#pragma unroll
        for (int i = 0; i < 16; ++i) { s[i] = fexp2((s[i] - m) * sc2); l += s[i]; }
        pf[tile][0] = pack8v<0>(s); pf[tile][1] = pack8v<8>(s);
#pragma unroll
        for (int ks = 0; ks < 16; ++ks) kc[ks] = kn[ks];
    }
    l += __shfl_xor(l, 32);
    const float il = 1.f / l;
    bf16_t* op = qb + token * D + head * 256 + 4 * h;
    const bf16_t* vp0 = VT + (((size_t)(b * 4 + head) * 8 * 8 * 2 * 64) + lane) * 8;
    bf16x8 vc[16], vn[16];
#pragma unroll
    for (int e = 0; e < 16; ++e) vc[e] = *(const bf16x8*)(vp0 + e * 512);
#pragma unroll 1
    for (int dt = 0; dt < 8; ++dt) {
        const int dn = dt < 7 ? dt + 1 : 7;
#pragma unroll
        for (int e = 0; e < 16; ++e) vn[e] = *(const bf16x8*)(vp0 + (size_t)dn * 16 * 512 + e * 512);
        f32x16 o, o_b;
#pragma unroll
        for (int i = 0; i < 16; ++i) { o[i] = 0.f; o_b[i] = 0.f; }
#pragma unroll
        for (int tile = 0; tile < 8; ++tile) { o = MFMA(vc[tile * 2], pf[tile][0], o); o_b = MFMA(vc[tile * 2 + 1], pf[tile][1], o_b); }
#pragma unroll
        for (int i = 0; i < 16; ++i) o[i] += o_b[i];
#pragma unroll
        for (int g = 0; g < 4; ++g)
            if (dry) { if (o[4 * g] == 12345.678f) qb[0] = 1; } else *(uint2*)(op + dt * 32 + 8 * g) = make_uint2(pk2(o[4 * g] * il, o[4 * g + 1] * il), pk2(o[4 * g + 2] * il, o[4 * g + 3] * il));
#pragma unroll
        for (int e = 0; e < 16; ++e) vc[e] = vn[e];
    }
}

DI void xattn_block(bf16_t* qb, const bf16_t* KF, const bf16_t* VF, const float* qg, float kmax2, int b, int head, int qblk, char* smem, int lane, int wid) {
    const int r = lane & 31, h = lane >> 5;
    const size_t token = (size_t)b * S + qblk * 256 + wid * 32 + r;
    bf16_t* qp = qb + token * D + head * 256 + h * 128;
    const bf16_t* kbase = KF + (size_t)(b * 4 + head) * 8 * 8192;
    const bf16_t* vbase = VF + (size_t)(b * 4 + head) * 8 * 8192;
    const int pc0 = (2 * wid) * 512 + lane * 8, pc1 = pc0 + 512;
    char* ld0 = smem + (2 * wid) * 1024 + lane * 16;
#define XA_ISSUE(u_) do { const int u__ = (u_); const bf16_t* src_ = (u__ < 8) ? kbase + (size_t)u__ * 8192 : vbase + (size_t)(u__ - 8) * 8192; \
        char* dst_ = ld0 + (u__ & 3) * 16384; glds16(src_ + pc0, dst_); glds16(src_ + pc1, dst_ + 1024); } while (0)
    __syncthreads();
    XA_ISSUE(0); XA_ISSUE(1); XA_ISSUE(2);
    uint4 qraw[16];
    float ss = 0.f;
#pragma unroll
    for (int ks = 0; ks < 16; ++ks) {
        qraw[ks] = *(const uint4*)(qp + ks * 8);
        const uint4 v = qraw[ks];
        ss += bflo(v.x) * bflo(v.x) + bfhi(v.x) * bfhi(v.x) + bflo(v.y) * bflo(v.y) + bfhi(v.y) * bfhi(v.y)
            + bflo(v.z) * bflo(v.z) + bfhi(v.z) * bfhi(v.z) + bflo(v.w) * bflo(v.w) + bfhi(v.w) * bfhi(v.w);
    }
    ss += __shfl_xor(ss, 32);
    const float inv = __builtin_amdgcn_rsqf(ss * (1.f / 256.f) + EPS);
    float qq2 = 0.f;
    bf16x8 qf[16];
#pragma unroll
    for (int ks = 0; ks < 16; ++ks) {
        const uint4 v = qraw[ks];
        const float4 g0 = *(const float4*)(qg + h * 128 + ks * 8), g1 = *(const float4*)(qg + h * 128 + ks * 8 + 4);
        uint4 o;
        o.x = pk2(bflo(v.x) * inv * g0.x, bfhi(v.x) * inv * g0.y); o.y = pk2(bflo(v.y) * inv * g0.z, bfhi(v.y) * inv * g0.w);
        o.z = pk2(bflo(v.z) * inv * g1.x, bfhi(v.z) * inv * g1.y); o.w = pk2(bflo(v.w) * inv * g1.z, bfhi(v.w) * inv * g1.w);
        qq2 += bflo(o.x) * bflo(o.x) + bfhi(o.x) * bfhi(o.x) + bflo(o.y) * bflo(o.y) + bfhi(o.y) * bfhi(o.y)
             + bflo(o.z) * bflo(o.z) + bfhi(o.z) * bfhi(o.z) + bflo(o.w) * bflo(o.w) + bfhi(o.w) * bfhi(o.w);
        qf[ks] = __builtin_bit_cast(bf16x8, o);
    }
    qq2 += __shfl_xor(qq2, 32);
    const float sc2 = 0.0625f * LOG2E;
    const float m = __builtin_amdgcn_sqrtf(qq2 * kmax2) * 1.001f;
    float l = 0.f;
    bf16x8 pf[8][2];
    const char* fr0 = smem + lane * 16;
#pragma unroll
    for (int u = 0; u < 8; ++u) {
        asm volatile("s_waitcnt vmcnt(4)" ::: "memory");
        __builtin_amdgcn_s_barrier();
        XA_ISSUE(u + 3);
        const char* sl = fr0 + (u & 3) * 16384;
        f32x16 s, s_b;
#pragma unroll
        for (int i = 0; i < 16; ++i) { s[i] = 0.f; s_b[i] = 0.f; }
#pragma unroll
        for (int ks = 0; ks < 16; ks += 2) {
            s = MFMA(*(const bf16x8*)(sl + ks * 1024), qf[ks], s);
            s_b = MFMA(*(const bf16x8*)(sl + (ks + 1) * 1024), qf[ks + 1], s_b);
        }
#pragma unroll
        for (int i = 0; i < 16; ++i) { s[i] = fexp2((s[i] + s_b[i] - m) * sc2); l += s[i]; }
        pf[u][0] = pack8v<0>(s); pf[u][1] = pack8v<8>(s);
    }
    l += __shfl_xor(l, 32);
    const float il = 1.f / l;
    bf16_t* op = qb + token * D + head * 256 + 4 * h;
#pragma unroll 1
    for (int dt = 0; dt < 8; ++dt) {
        if (dt < 6) asm volatile("s_waitcnt vmcnt(4)" ::: "memory");
        else if (dt == 6) asm volatile("s_waitcnt vmcnt(2)" ::: "memory");
        else asm volatile("s_waitcnt vmcnt(0)" ::: "memory");
        __builtin_amdgcn_s_barrier();
        if (dt < 5) XA_ISSUE(dt + 11);
        const char* sl = fr0 + (dt & 3) * 16384;
        f32x16 o, o_b;
#pragma unroll
        for (int i = 0; i < 16; ++i) { o[i] = 0.f; o_b[i] = 0.f; }
#pragma unroll
        for (int tile = 0; tile < 8; ++tile) {
            o = MFMA(*(const bf16x8*)(sl + (tile * 2) * 1024), pf[tile][0], o);
            o_b = MFMA(*(const bf16x8*)(sl + (tile * 2 + 1) * 1024), pf[tile][1], o_b);
        }
#pragma unroll
        for (int g = 0; g < 4; ++g)
            *(uint2*)(op + dt * 32 + 8 * g) = make_uint2(pk2((o[4 * g] + o_b[4 * g]) * il, (o[4 * g + 1] + o_b[4 * g + 1]) * il),
                                                        pk2((o[4 * g + 2] + o_b[4 * g + 2]) * il, (o[4 * g + 3] + o_b[4 * g + 3]) * il));
    }
#undef XA_ISSUE
}

DI void xattn_phase(const Params& P, int l, char* smem, bool dry) {
    const int tid_ = otid(); const int lane = tid_ & 63, wid = tid_ >> 6;
    bf16_t* qb = (bf16_t*)(P.ws + OFF_BIG);
    const bf16_t* KF = (const bf16_t*)(P.ws + OFF_KF + (size_t)l * SZ_MM);
    const bf16_t* VF = (const bf16_t*)(P.ws + OFF_VT + (size_t)l * SZ_MM);
    const float* qg = P.in[19] + l * 256;
    (void)dry;
    for (int it = blockIdx.x; it < 256; it += gridDim.x) {
        const int qblk = it & 15, head = (it >> 4) & 3, b = it >> 6;
        const float kmax2 = ((const float*)(P.ws + OFF_KMAX))[l * 16 + b * 4 + head];
        xattn_block(qb, KF, VF, qg, kmax2, b, head, qblk, smem, lane, wid);
    }
}

DI void knorm_phase(const Params& P) {
    const int tid_ = otid(); const int lane = tid_ & 63, wid = tid_ >> 6;
    for (int u = blockIdx.x * 8 + wid; u < 8192; u += gridDim.x * 8) {
        const int l = u >> 12, row = (u >> 2) & 1023, head = u & 3;
        const bf16_t* kp = (const bf16_t*)(P.ws + OFF_KN + (size_t)l * SZ_MM) + (size_t)row * D + head * 256 + lane * 4;
        const uint2 v = *(const uint2*)kp;
        const float a0 = bflo(v.x), a1 = bfhi(v.x), a2 = bflo(v.y), a3 = bfhi(v.y);
        float ss = a0 * a0 + a1 * a1 + a2 * a2 + a3 * a3;
        ss = wave_sum(ss);
        const float inv = __builtin_amdgcn_rsqf(ss * (1.f / 256.f) + EPS);
        const float4 g = *(const float4*)(P.in[20] + l * 256 + lane * 4);
        const int b = row >> 8, key = row & 255;
        const int h = lane >> 5, ks = (lane & 31) >> 1, j0 = (lane & 1) * 4;
        bf16_t* dp = (bf16_t*)(P.ws + OFF_KF + (size_t)l * SZ_MM) + ((((((size_t)(b * 4 + head) * 8 + (key >> 5)) * 16 + ks) * 64) + h * 32 + (key & 31)) << 3) + j0;
        const unsigned w0_ = pk2(a0 * inv * g.x, a1 * inv * g.y), w1_ = pk2(a2 * inv * g.z, a3 * inv * g.w);
        *(uint2*)dp = make_uint2(w0_, w1_);
        float kk2 = bflo(w0_) * bflo(w0_) + bfhi(w0_) * bfhi(w0_) + bflo(w1_) * bflo(w1_) + bfhi(w1_) * bfhi(w1_);
        kk2 = wave_sum(kk2);
        if (lane == 0) atomicMax((unsigned*)(P.ws + OFF_KMAX) + l * 16 + b * 4 + head, __float_as_uint(kk2));
    }
}

#define XB_TMO      128
#define XB_XCNT(j)  (256  + 64 * (j))
#define XB_XSUB(j)  (1280 + 64 * (j))
#define XB_XGEN(j)  (2304 + 64 * (j))
#define XB_TOP      3328
#define XB_TOPGEN   3392
#define XCD_BAR_WORDS 3456
#define XB_SPIN_CAP (1u << 18)
#define XB_LAS __attribute__((address_space(3)))

__device__ __forceinline__ unsigned xb_ld(unsigned* p)              { return __hip_atomic_load(p, __ATOMIC_RELAXED, __HIP_MEMORY_SCOPE_AGENT); }
__device__ __forceinline__ unsigned xb_add(unsigned* p, unsigned v) { return __hip_atomic_fetch_add(p, v, __ATOMIC_RELAXED, __HIP_MEMORY_SCOPE_AGENT); }
__device__ __forceinline__ unsigned xb_xcc_id() { return (unsigned)__builtin_amdgcn_s_getreg((3 << 11) | 20) & 0xFu; }
#define XB_SPIN(cond, bar) do { unsigned _sp = 0; while (cond) { __builtin_amdgcn_s_sleep(1); \
    if ((++_sp & 255u) == 0u) { if (xb_ld(&(bar)[XB_TMO])) break; if (_sp > XB_SPIN_CAP) { atomicAdd(&(bar)[XB_TMO], 1u); break; } } } } while (0)

struct XcdBarrier {
    unsigned* bar; unsigned x;
    volatile XB_LAS unsigned* st;
};

__device__ __forceinline__ XcdBarrier xcd_barrier_post(unsigned* bar, volatile XB_LAS unsigned* st) {
    XcdBarrier b; b.bar = bar; b.x = xb_xcc_id(); b.st = st;
    if (threadIdx.x == 0) (void)xb_add(&bar[XB_XCNT(b.x)], 1u);
    return b;
}
__device__ __forceinline__ void xcd_barrier_complete(unsigned* bar, unsigned x, unsigned& nloc, unsigned& nx) {
    const unsigned G = gridDim.x * gridDim.y * gridDim.z;
    unsigned sum, cnt, mine, sp = 0u;
    for (;;) {
        sum = 0u; cnt = 0u; mine = 0u;
#pragma unroll
        for (unsigned j = 0; j < 16; ++j) { const unsigned c = xb_ld(&bar[XB_XCNT(j)]); sum += c; cnt += (c > 0u) ? 1u : 0u; mine = (j == x) ? c : mine; }
        if (sum == G) break;
        __builtin_amdgcn_s_sleep(1);
        if ((++sp & 255u) == 0u) { if (xb_ld(&bar[XB_TMO])) break; if (sp > XB_SPIN_CAP) { atomicAdd(&bar[XB_TMO], 1u); break; } }
    }
    nloc = mine > 0u ? mine : 1u; nx = cnt > 0u ? cnt : 1u;
}

__device__ __forceinline__ void xcd_barrier(const XcdBarrier& b) {
    asm volatile("s_waitcnt vmcnt(0)" ::: "memory");
    __syncthreads();
    if (threadIdx.x == 0) {
        unsigned* bar = b.bar;
        __builtin_amdgcn_s_waitcnt(0);
        unsigned nloc = b.st[0], nx = b.st[1];
        if (nloc == 0u) { xcd_barrier_complete(bar, b.x, nloc, nx); b.st[0] = nloc; b.st[1] = nx; }
        const unsigned old = xb_add(&bar[XB_XSUB(b.x)], 1u);
        const unsigned gen = old / nloc;
        if (old + 1u == (gen + 1u) * nloc) {
            __builtin_amdgcn_fence(__ATOMIC_RELEASE, "agent");
            asm volatile("s_waitcnt vmcnt(0)" ::: "memory");
            const unsigned og = xb_add(&bar[XB_TOP], 1u);
            const unsigned tg = og / nx;
            if (og + 1u == (tg + 1u) * nx) xb_add(&bar[XB_TOPGEN], 1u);
            else XB_SPIN(xb_ld(&bar[XB_TOPGEN]) == tg, bar);
            __builtin_amdgcn_fence(__ATOMIC_ACQUIRE, "agent");
            xb_add(&bar[XB_XGEN(b.x)], 1u);
            asm volatile("s_waitcnt vmcnt(0)" ::: "memory");
        } else {
            XB_SPIN(xb_ld(&bar[XB_XGEN(b.x)]) == gen, bar);
            __builtin_amdgcn_fence(__ATOMIC_ACQUIRE, "agent");
            asm volatile("s_waitcnt vmcnt(0)" ::: "memory");
        }
    }
    __syncthreads();
}


DI void fast_grid_sync(unsigned* bar, unsigned target) {
    asm volatile("s_waitcnt vmcnt(0) lgkmcnt(0)" ::: "memory");
    __syncthreads();
    if (threadIdx.x == 0) {
        __builtin_amdgcn_fence(__ATOMIC_RELEASE, "agent");
        asm volatile("s_waitcnt vmcnt(0)" ::: "memory");
        __hip_atomic_fetch_add(bar, 1u, __ATOMIC_RELAXED, __HIP_MEMORY_SCOPE_AGENT);
        while (__hip_atomic_load(bar, __ATOMIC_RELAXED, __HIP_MEMORY_SCOPE_AGENT) < target) __builtin_amdgcn_s_sleep(2);
        __builtin_amdgcn_fence(__ATOMIC_ACQUIRE, "agent");
        asm volatile("s_waitcnt vmcnt(0)" ::: "memory");
    }
    __syncthreads();
}

__global__ void __launch_bounds__(512) fwd_megakernel(Params P) {
    extern __shared__ __attribute__((aligned(16))) char smem[];
    cg::grid_group grid = cg::this_grid();
    unsigned nbar = 0; (void)nbar;
    volatile XB_LAS unsigned* xst = (volatile XB_LAS unsigned*)(smem + LDS_BYTES - 16);
    if (threadIdx.x == 0) { xst[0] = 0u; xst[1] = 0u; }
    __syncthreads();
    const XcdBarrier xbar = xcd_barrier_post((unsigned*)(P.ws + OFF_BAR), xst);
#pragma unroll 1
    for (int ph = 0; ph < 21; ++ph) {
        float* ssq = (float*)(P.ws + OFF_SSQ);
        bf16_t* xb = (bf16_t*)(P.ws + OFF_XB);
        bf16_t* big = (bf16_t*)(P.ws + OFF_BIG);
        int nrep = 1;
        if (ph > 0) { const int s_ = (ph - 1) % 10; const int kind = (s_ == 3) ? 2 : (s_ == 6) ? 4 : 1; if (PROBE_MASK & kind) nrep = 2; }
        for (int rep = 0; rep < nrep; ++rep) {
        const bool dry = rep + 1 < nrep;
        if (ph == 0) {
            phase0(P, smem);
        } else {
            const int l = (ph - 1) / 10, s = (ph - 1) % 10;
            if (s == 3) {
                if (l == 0) attn_even_phase(P, smem, dry); else attn_odd_phase(P, smem, dry);
            } else if (s == 6) {
                xattn_phase(P, l, smem, dry);
            } else {
                pg8::Gemm g; pg8::Epi E;
                g.A = xb; g.lda = D; g.K = D; g.M = T; g.N = D; g.Bt = nullptr;
                E.mode = 1; E.rs = nullptr; E.O = big; E.ldo = D; E.xin = nullptr; E.xout = nullptr; E.xb = xb; E.ssq_out = ssq; E.alpha = 1.f;
                E.qg = nullptr; E.kg = nullptr; E.qn_end = 0; E.kn_beg = 0; E.kn_end = 0;
                if (s == 0 || s == 8) {
                    g.Bt = (const bf16_t*)(P.ws + (s == 0 ? OFF_GU1 : OFF_GU2) + (size_t)l * SZ_GU); g.N = NGU;
                    E.mode = 0; E.rs = ssq + (size_t)(4 * l + (s == 0 ? 0 : 3)) * T; E.ldo = DFF;
                } else if (s == 1 || s == 9) {
                    g.A = big; g.lda = DFF; g.K = DFF;
                    g.Bt = (const bf16_t*)(P.ws + (s == 1 ? OFF_DN1 : OFF_DN2) + (size_t)l * SZ_DN);
                    E.alpha = 0.5f; E.ssq_out = ssq + (size_t)(4 * l + (s == 1 ? 1 : 4)) * T;
                    if (ph == 2) E.xin = P.in[0];
                    if (ph == 20) { E.xout = P.out; E.ssq_out = nullptr; }
                } else if (s == 2) {
                    E.mode = 2; E.rs = ssq + (size_t)(4 * l + 1) * T;
                    if (l == 0) { g.Bt = (const bf16_t*)(P.ws + OFF_EVIN); g.N = 2304; E.ldo = 2304; E.qg = P.in[7]; E.kg = P.in[8]; E.qn_end = 512; E.kn_beg = 1024; E.kn_end = 1152; }
                    else { g.Bt = (const bf16_t*)(P.ws + OFF_ODIN); g.N = 3072; E.ldo = 3072; E.qg = P.in[12]; E.kg = P.in[13]; E.qn_end = 1024; E.kn_beg = 1024; E.kn_end = 2048; }
                } else if (s == 4) {
                    g.A = big;
                    if (l == 0) { g.Bt = (const bf16_t*)(P.ws + OFF_EVOUT); g.lda = 2304; }
                    else { g.Bt = (const bf16_t*)(P.ws + OFF_ODOUT); g.lda = 3072; }
                    E.ssq_out = ssq + (size_t)(4 * l + 2) * T;
                } else if (s == 5) {
                    g.Bt = (const bf16_t*)(P.ws + OFF_WQ + (size_t)l * SZ_MM); E.mode = 2; E.rs = ssq + (size_t)(4 * l + 2) * T; E.ldo = D;
                } else {
                    g.A = big; g.Bt = (const bf16_t*)(P.ws + OFF_WO + (size_t)l * SZ_MM); E.ssq_out = ssq + (size_t)(4 * l + 3) * T;
                }
                pg8::StaticOrder So; So.init(T, g.N, (int)gridDim.x, (int)blockIdx.x);
                E.dryrun = 0;
#if PROBE_GEMM
                for (int rep_ = 0; rep_ < 2; ++rep_) {
                pg8::Epi E2 = E;
                if (rep_ == 0) { if (PROBE_GEMM == 1) E2.dryrun = 1; else if (E.mode == 1) { E2.alpha = 0.f; } }
                __syncthreads();
                pg8::gemm_phase<pg8::Epi, pg8::StaticOrder, true, true>((PG8_LAS unsigned char*)smem, g, So, rep_ == 0 ? E2 : E);
                ++nbar; fast_grid_sync((unsigned*)(P.ws + OFF_BAR), nbar * gridDim.x);
                }
#else
                __syncthreads();
                pg8::gemm_phase<pg8::Epi, pg8::StaticOrder, true, true>((PG8_LAS unsigned char*)smem, g, So, E);
#endif
                if (ph == 1) {
                    GJob J;
                    J.A = xb; J.lda = D; J.ksplit = 1 << 30; J.kextra = 0; J.K = D; J.ntm = 4; J.mode = 3; J.rs = nullptr;
                    J.O = big; J.ldo = D; J.xin = P.out; J.xout = P.out; J.xb = xb; J.ssq_out = ssq; J.alpha = 1.f;
                    J.qg = nullptr; J.kg = nullptr; J.qn_end = 0; J.kn_end = 0; J.vt = nullptr; J.W = nullptr; J.ntn = 8;
                    gemm_phase(J, 0, 64, P, smem, false);
                }
                if (ph == 2 && !dry) knorm_phase(P);
            }
        }
        if (P.ws == nullptr) grid.sync();
        if (ph < 20) xcd_barrier(xbar);
        }
    }
}

extern "C" void kernel_launch(void* const* d_in, const int* in_sizes, int n_in, void* d_out, int out_size, void* d_ws, size_t ws_size,
                              hipStream_t stream) {
    static int grid_blocks = 0;
    if (!grid_blocks) {
        int dev = 0, cus = 0, per_cu = 0;
        hipGetDevice(&dev);
        hipDeviceGetAttribute(&cus, hipDeviceAttributeMultiprocessorCount, dev);
        hipFuncSetAttribute((const void*)fwd_megakernel, hipFuncAttributeMaxDynamicSharedMemorySize, LDS_BYTES);
        hipOccupancyMaxActiveBlocksPerMultiprocessor(&per_cu, fwd_megakernel, NTHR, LDS_BYTES);
        if (per_cu < 1) per_cu = 1;
        if (per_cu > 1) per_cu = 1;
        grid_blocks = cus * per_cu;
    }
    if (ws_size < WS_NEED) { fprintf(stderr, "workspace too small: %zu < %zu\n", ws_size, (size_t)WS_NEED); return; }
    Params p{};
    for (int i = 0; i < 25; ++i) p.in[i] = (const float*)d_in[i];
    p.out = (float*)d_out; p.ws = (char*)d_ws;
    hipMemsetAsync((char*)d_ws + OFF_BAR, 0, 16384, stream);
    void* args[] = {&p};
    hipError_t e = hipLaunchCooperativeKernel((void*)fwd_megakernel, dim3(grid_blocks), dim3(NTHR), args, LDS_BYTES, stream);
    if (e != hipSuccess) fprintf(stderr, "cooperative launch failed: %s (grid %d)\n", hipGetErrorString(e), grid_blocks);
}
```

```cpp
#include <hip/hip_runtime.h>
#include <hip/hip_cooperative_groups.h>
#include <cstdio>
#include <cstdint>
namespace cg = cooperative_groups;

#define DI __device__ __forceinline__
typedef unsigned short bf16_t;
typedef short bf16x8 __attribute__((ext_vector_type(8)));
typedef short s16x4 __attribute__((ext_vector_type(4)));
typedef float f32x16 __attribute__((ext_vector_type(16)));
typedef __bf16 bf2_t __attribute__((ext_vector_type(2)));
typedef float f2_t __attribute__((ext_vector_type(2)));
typedef short v4i16_t __attribute__((ext_vector_type(4)));
#define MFMA(a, b, c) __builtin_amdgcn_mfma_f32_32x32x16_bf16((a), (b), (c), 0, 0, 0)

constexpr int T = 16384, S = 4096, D = 1024, DFF = 2816, NGU = 5632;
constexpr float EPS = 1e-6f;
constexpr float LOG2E = 1.4426950408889634f;
constexpr float LN2 = 0.6931471805599453f;

constexpr size_t SZ_GU = (size_t)NGU * D * 2, SZ_DN = (size_t)D * DFF * 2, SZ_MM = (size_t)D * D * 2;
constexpr size_t OFF_GU1 = 0;
constexpr size_t OFF_DN1 = OFF_GU1 + 2 * SZ_GU;
constexpr size_t OFF_GU2 = OFF_DN1 + 2 * SZ_DN;
constexpr size_t OFF_DN2 = OFF_GU2 + 2 * SZ_GU;
constexpr size_t OFF_WQ = OFF_DN2 + 2 * SZ_DN;
constexpr size_t OFF_WKV = OFF_WQ + 2 * SZ_MM;
constexpr size_t OFF_WO = OFF_WKV + 4 * SZ_MM;
constexpr size_t OFF_EVIN = OFF_WO + 2 * SZ_MM;
constexpr size_t OFF_EVOUT = OFF_EVIN + (size_t)2304 * D * 2;
constexpr size_t OFF_ODIN = OFF_EVOUT + SZ_MM;
constexpr size_t OFF_ODOUT = OFF_ODIN + (size_t)3072 * D * 2;
constexpr size_t OFF_XB = OFF_ODOUT + SZ_MM;
constexpr size_t OFF_BIG = OFF_XB + (size_t)T * D * 2;
constexpr size_t OFF_MEMB = OFF_BIG + (size_t)T * 3072 * 2;
constexpr size_t OFF_KN = OFF_MEMB + SZ_MM;
constexpr size_t OFF_VT = OFF_KN + 2 * SZ_MM;
constexpr size_t OFF_SSQ = OFF_VT + 2 * SZ_MM;
constexpr size_t OFF_SSQM = OFF_SSQ + (size_t)9 * T * 4;
constexpr size_t OFF_KMAX = OFF_SSQM + 4096;
constexpr size_t OFF_BAR = OFF_KMAX + 256;
constexpr size_t OFF_KF = OFF_BAR + 16384;
constexpr size_t WS_NEED = OFF_KF + 2 * SZ_MM;

#ifndef PROBE_MASK
#define PROBE_MASK 0
#endif
#ifndef PROBE_GEMM
#define PROBE_GEMM 0
#endif
constexpr int NTHR = 512;
constexpr int NST = 4;
constexpr int STAGE_B = 32768;
constexpr int OPB = 16384;
constexpr int LDS_BYTES = 147456;

struct Params { const float* in[25]; float* out; char* ws; };

DI unsigned pk2(float a, float b) { f2_t v = {a, b}; bf2_t r = __builtin_convertvector(v, bf2_t); return __builtin_bit_cast(unsigned, r); }
typedef unsigned v4u_t __attribute__((ext_vector_type(4)));
DI __amdgpu_buffer_rsrc_t wt_rsrc(const void* base, size_t bytes) { return __builtin_amdgcn_make_buffer_rsrc((void*)base, (short)0, (int)bytes, 0x00020000); }
DI void st16_wt(__amdgpu_buffer_rsrc_t r, size_t byteoff, uint4 v) { const v4u_t x = {v.x, v.y, v.z, v.w}; __builtin_amdgcn_raw_buffer_store_b128(x, r, (unsigned)byteoff, 0, 16); }
DI void st16f_wt(__amdgpu_buffer_rsrc_t r, size_t byteoff, float4 v) { const v4u_t x = {__float_as_uint(v.x), __float_as_uint(v.y), __float_as_uint(v.z), __float_as_uint(v.w)}; __builtin_amdgcn_raw_buffer_store_b128(x, r, (unsigned)byteoff, 0, 16); }
DI float bflo(unsigned w) { return __uint_as_float(w << 16); }
DI float bfhi(unsigned w) { return __uint_as_float(w & 0xffff0000u); }
DI int otid() { int t = threadIdx.x; asm volatile("" : "+v"(t)); return t; }
DI int crow(int i, int h) { return (i & 3) + 8 * (i >> 2) + 4 * h; }
DI float fexp2(float x) { return __builtin_amdgcn_exp2f(x); }
DI float flog2(float x) { return __builtin_amdgcn_logf(x); }

struct WJob { const float* src; bf16_t* dst; const float* gain; int K, N, gu; };

DI int wjob_tiles(int j) {
    if (j < 14) {
        const int kind = j >> 1;
        switch (kind) {
            case 0: case 2: return 16 * 88;
            case 1: case 3: return 44 * 16;
            case 4: return 256;
            case 5: return 512;
            default: return 256;
        }
    }
    if (j == 14) return 16 * 36;
    if (j == 16) return 16 * 48;
    return 256;
}

DI WJob get_wjob(const Params& P, int j) {
    WJob w; w.gain = nullptr; w.gu = 0;
    bf16_t* wsb = (bf16_t*)P.ws;
    if (j < 14) {
        const int kind = j >> 1, l = j & 1;
        switch (kind) {
            case 0: w.src = P.in[3] + (size_t)l * D * NGU; w.dst = (bf16_t*)(P.ws + OFF_GU1 + l * SZ_GU); w.gain = P.in[2] + l * D; w.K = D; w.N = NGU; w.gu = 1; break;
            case 1: w.src = P.in[4] + (size_t)l * DFF * D; w.dst = (bf16_t*)(P.ws + OFF_DN1 + l * SZ_DN); w.K = DFF; w.N = D; w.gu = 2; break;
            case 2: w.src = P.in[23] + (size_t)l * D * NGU; w.dst = (bf16_t*)(P.ws + OFF_GU2 + l * SZ_GU); w.gain = P.in[22] + l * D; w.K = D; w.N = NGU; w.gu = 1; break;
            case 3: w.src = P.in[24] + (size_t)l * DFF * D; w.dst = (bf16_t*)(P.ws + OFF_DN2 + l * SZ_DN); w.K = DFF; w.N = D; w.gu = 2; break;
            case 4: w.src = P.in[17] + (size_t)l * D * D; w.dst = (bf16_t*)(P.ws + OFF_WQ + l * SZ_MM); w.gain = P.in[15] + l * D; w.K = D; w.N = D; w.gu = 2; break;
            case 5: w.src = P.in[18] + (size_t)l * D * 2048; w.dst = (bf16_t*)(P.ws + OFF_WKV + l * 2 * SZ_MM); w.gain = P.in[16] + l * D; w.K = D; w.N = 2048; break;
            default: w.src = P.in[21] + (size_t)l * D * D; w.dst = (bf16_t*)(P.ws + OFF_WO + l * SZ_MM); w.K = D; w.N = D; w.gu = 2; break;
        }
    } else if (j == 14) { w.src = P.in[6]; w.dst = (bf16_t*)(P.ws + OFF_EVIN); w.gain = P.in[5]; w.K = D; w.N = 2304; w.gu = 3; }
    else if (j == 15) { w.src = P.in[10]; w.dst = (bf16_t*)(P.ws + OFF_EVOUT); w.K = D; w.N = D; w.gu = 2; }
    else if (j == 16) { w.src = P.in[11]; w.dst = (bf16_t*)(P.ws + OFF_ODIN); w.gain = P.in[5] + D; w.K = D; w.N = 3072; w.gu = 2; }
    else { w.src = P.in[14]; w.dst = (bf16_t*)(P.ws + OFF_ODOUT); w.K = D; w.N = D; w.gu = 2; }
    (void)wsb;
    return w;
}

DI void wconv_tile(const WJob& w, int t, float* sm, int tid, bool act) {
    const int ntn = w.N >> 6; const int tk = t / ntn, tn = t - tk * ntn;
    if (act) {
#pragma unroll
        for (int p = 0; p < 4; ++p) {
            const int kr = p * 16 + (tid >> 4);
            typedef float f32x4nt __attribute__((ext_vector_type(4)));
            const f32x4nt v = __builtin_nontemporal_load((const f32x4nt*)(w.src + (size_t)(tk * 64 + kr) * w.N + tn * 64 + (tid & 15) * 4));
            const float g = w.gain ? w.gain[tk * 64 + kr] : 1.f;
            float* sp = sm + kr * 65 + (tid & 15) * 4;
            sp[0] = v[0] * g; sp[1] = v[1] * g; sp[2] = v[2] * g; sp[3] = v[3] * g;
        }
    }
    __syncthreads();
    if (act) {
        const int n = tid >> 2, kq = tid & 3; const int ng = tn * 64 + n;
        int drow = ng;
        if (w.gu == 1) drow = ng < DFF ? ((ng >> 7) * 256 + (ng & 127)) : (((ng - DFF) >> 7) * 256 + 128 + ((ng - DFF) & 127));
        else if (w.gu >= 2) {
            int a = ng;
            if (w.gu == 3) a = ng < 512 ? ng : ng < 768 ? ng + 512 : ng < 1280 ? ng - 256 : ng;
            drow = (a & ~255) + (((a >> 5) & 1) << 7) + (((a >> 6) & 3) << 5) + (a & 31);
        }
        unsigned o[8];
#pragma unroll
        for (int e = 0; e < 8; ++e) o[e] = pk2(sm[(kq * 16 + 2 * e) * 65 + n], sm[(kq * 16 + 2 * e + 1) * 65 + n]);
        uint4* dp = (uint4*)(w.dst + (size_t)drow * w.K + tk * 64 + kq * 16);
        dp[0] = make_uint4(o[0], o[1], o[2], o[3]); dp[1] = make_uint4(o[4], o[5], o[6], o[7]);
    }
    __syncthreads();
}

DI float wave_sum(float v) {
    v += __shfl_xor(v, 1); v += __shfl_xor(v, 2); v += __shfl_xor(v, 4); v += __shfl_xor(v, 8); v += __shfl_xor(v, 16); v += __shfl_xor(v, 32);
    return v;
}

DI void rowconv(const float* src, bf16_t* dst, float* ssq, int row, int lane) {
    const float* xr = src + (size_t)row * D;
    float ss = 0.f;
#pragma unroll
    for (int p = 0; p < 4; ++p) {
        const float4 v = *(const float4*)(xr + p * 256 + lane * 4);
        ss += v.x * v.x + v.y * v.y + v.z * v.z + v.w * v.w;
        *(uint2*)(dst + (size_t)row * D + p * 256 + lane * 4) = make_uint2(pk2(v.x, v.y), pk2(v.z, v.w));
    }
    ss = wave_sum(ss);
    if (lane == 0) ssq[row] = ss;
}

DI void phase0(const Params& P, char* smem) {
    const int tid = otid(), lane = tid & 63, wid = tid >> 6;
    float* ssq = (float*)(P.ws + OFF_SSQ);
    for (int i = blockIdx.x * NTHR + tid; i < 8 * T; i += gridDim.x * NTHR) ssq[T + i] = 0.f;
    if (blockIdx.x == 0 && tid < 32) ((unsigned*)(P.ws + OFF_KMAX))[tid] = 0u;
    constexpr int NW = 12352 / 2, NX = T / 8, NM = 1024 / 8;
    for (int u = blockIdx.x; u < NW + NX + NM; u += gridDim.x) {
        if (u < NW) {
            const int half = tid >> 8;
            int t = 2 * u + half, j = 0;
            for (; j < 17; ++j) { const int c = wjob_tiles(j); if (t < c) break; t -= c; }
            const WJob w = get_wjob(P, j);
            wconv_tile(w, t, (float*)smem + half * (64 * 65), tid & 255, true);
        } else if (u < NW + NX) {
            rowconv(P.in[0], (bf16_t*)(P.ws + OFF_XB), ssq, (u - NW) * 8 + wid, lane);
        } else {
            rowconv(P.in[1], (bf16_t*)(P.ws + OFF_MEMB), (float*)(P.ws + OFF_SSQM), (u - NW - NX) * 8 + wid, lane);
        }
    }
}

struct GJob {
    const bf16_t* A; const bf16_t* W;
    int lda, ksplit, kextra, K, ntm, ntn, mode;
    const float* rs;
    bf16_t* O; int ldo;
    const float* xin; float* xout; bf16_t* xb; float* ssq_out; float alpha;
    const float* qg; const float* kg; int qn_end, kn_end;
    bf16_t* vt;
};

typedef __attribute__((address_space(3))) unsigned* ldsu_t;
typedef const __attribute__((address_space(1))) unsigned* glbu_t;
DI void glds16(const bf16_t* g, char* l) { __builtin_amdgcn_global_load_lds((glbu_t)(const void*)g, (ldsu_t)(void*)l, 16, 0, 0); }

DI void gemm_tile(const GJob& J, int t, char* smem, bool dry) {
    const int tid = otid(), lane = tid & 63, wid = tid >> 6, wr = wid >> 2, wc = wid & 3;
    const int r = lane & 31, h = lane >> 5;
    int tm, tn;
    { const int gsz = 32 * J.ntn; const int g = t / gsz; const int rem = t - g * gsz; const int rows = min(32, J.ntm - g * 32); tn = rem / rows; tm = g * 32 + (rem - tn * rows); }
    const int lrow = wid * 16 + (lane >> 2);
    const int csw = ((lane & 3) ^ ((lane >> 4) & 3)) * 8;
    const bf16_t* Ag = J.A + (size_t)(tm * 256 + lrow) * J.lda + csw;
    const bf16_t* Wg = J.W + (size_t)(tn * 256 + lrow) * J.K + csw;
    const size_t astr = (size_t)128 * J.lda, wstr = (size_t)128 * J.K;
    char* lb = smem + tid * 16;
    const int nk = J.K >> 5;
#define GLDS(kt, buf) do { const int k0_ = (kt) * 32; const int ka_ = k0_ + (k0_ >= J.ksplit ? J.kextra : 0); char* l_ = lb + (buf) * STAGE_B; \
        glds16(Ag + ka_, l_); glds16(Ag + astr + ka_, l_ + 8192); glds16(Wg + k0_, l_ + OPB); glds16(Wg + wstr + k0_, l_ + OPB + 8192); } while (0)
    f32x16 acc[4][2];
#pragma unroll
    for (int a = 0; a < 4; ++a)
#pragma unroll
        for (int b = 0; b < 2; ++b)
#pragma unroll
            for (int i = 0; i < 16; ++i) acc[a][b][i] = 0.f;
    const int fr = (r >> 2) & 3;
    const int xrow = (wc * 64 + r) * 64, wrow = OPB + (wr * 128 + r) * 64;
    const int co0 = ((0 + h) ^ fr) * 16, co1 = ((2 + h) ^ fr) * 16;

    __syncthreads();
    GLDS(0, 0); GLDS(1, 1); GLDS(2, 2);
    asm volatile("s_waitcnt vmcnt(8)" ::: "memory");
    __builtin_amdgcn_s_barrier();
    bf16x8 w0[4], x0[2], w1[4], x1[2];
#define LOADF(W_, X_, sb_, co_) do { _Pragma("unroll") for (int ti = 0; ti < 2; ++ti) X_[ti] = *(const bf16x8*)((sb_) + xrow + ti * 2048 + (co_)); \
        _Pragma("unroll") for (int fi = 0; fi < 4; ++fi) W_[fi] = *(const bf16x8*)((sb_) + wrow + fi * 2048 + (co_)); } while (0)
#define MFMA8(W_, X_) do { __builtin_amdgcn_s_setprio(1); _Pragma("unroll") for (int fi = 0; fi < 4; ++fi) _Pragma("unroll") for (int ti = 0; ti < 2; ++ti) \
        acc[fi][ti] = MFMA(W_[fi], X_[ti], acc[fi][ti]); __builtin_amdgcn_s_setprio(0); } while (0)
    LOADF(w0, x0, smem, co0);
    __builtin_amdgcn_s_waitcnt(0xC07F);
    int buf = 0;
    for (int kt = 0; kt < nk; ++kt) {
        const char* sb = smem + buf * STAGE_B;
        LOADF(w1, x1, sb, co1);
        __builtin_amdgcn_sched_barrier(0);
        MFMA8(w0, x0);
        __builtin_amdgcn_s_waitcnt(0xC07F);
        __builtin_amdgcn_sched_barrier(0);
        const int nb = (buf + 1 == NST) ? 0 : buf + 1;
        if (kt + 1 < nk) {
            if (kt + 2 < nk) asm volatile("s_waitcnt vmcnt(4)" ::: "memory"); else asm volatile("s_waitcnt vmcnt(0)" ::: "memory");
            __builtin_amdgcn_s_barrier();
            if (kt + 3 < nk) { const int fb_ = (buf + 3 >= NST) ? buf + 3 - NST : buf + 3; GLDS(kt + 3, fb_); }
        }
        LOADF(w0, x0, smem + nb * STAGE_B, co0);
        __builtin_amdgcn_sched_barrier(0);
        MFMA8(w1, x1);
        __builtin_amdgcn_s_waitcnt(0xC07F);
        __builtin_amdgcn_sched_barrier(0);
        buf = nb;
    }
#undef LOADF
#undef MFMA8
#undef GLDS
    __syncthreads();

    if (dry) { if (acc[0][0][0] + acc[1][1][0] + acc[2][0][0] + acc[3][1][0] == 12345.678f) J.O[0] = 1; return; }
    const int tokb = tm * 256 + wc * 64;
    const int fb = tn * 256 + wr * 128;
    float rsc[2];
#pragma unroll
    for (int ti = 0; ti < 2; ++ti) rsc[ti] = J.rs ? __builtin_amdgcn_rsqf(J.rs[tokb + ti * 32 + r] * (1.f / 1024.f) + EPS) : 1.f;

    if (J.mode == 3 && fb >= 1024) {
#pragma unroll
        for (int ti = 0; ti < 2; ++ti) {
            const int tok = tokb + ti * 32 + r;
#pragma unroll
            for (int fi = 0; fi < 4; ++fi)
#pragma unroll
                for (int i = 0; i < 16; ++i) {
                    const int f = fb - 1024 + fi * 32 + crow(i, h);
                    const int bh_ = (tok >> 8) * 4 + (f >> 8), d_ = f & 255, key_ = tok & 255, k16 = key_ & 15;
                    const int ln_ = ((k16 >> 2) & 1) * 32 + (d_ & 31), e_ = ((k16 >> 3) << 2) | (k16 & 3);
                    J.vt[((((((size_t)bh_ * 8 + (d_ >> 5)) * 8 + (key_ >> 5)) * 2 + ((key_ >> 4) & 1)) * 64 + ln_) << 3) + e_] = (bf16_t)(pk2(acc[fi][ti][i] * rsc[ti], 0.f) & 0xffffu);
                }
        }
        return;
    }
    char* wl = smem + wid * 16384;
#pragma unroll
    for (int ti = 0; ti < 2; ++ti) {
#pragma unroll
        for (int fp = 0; fp < 2; ++fp) {
            const float sc = (J.mode == 1) ? J.alpha : rsc[ti];
#pragma unroll
            for (int fi2 = 0; fi2 < 2; ++fi2)
#pragma unroll
                for (int g = 0; g < 4; ++g) {
                    float4 v;
                    v.x = acc[2 * fp + fi2][ti][4 * g + 0] * sc; v.y = acc[2 * fp + fi2][ti][4 * g + 1] * sc;
                    v.z = acc[2 * fp + fi2][ti][4 * g + 2] * sc; v.w = acc[2 * fp + fi2][ti][4 * g + 3] * sc;
                    *(float4*)(wl + r * 272 + (fi2 * 32 + 8 * g + 4 * h) * 4) = v;
                }
            const int tok0 = tokb + ti * 32, f0 = fb + fp * 64;
            if (J.mode == 0) {
                const int c4 = (lane & 7) * 4;
#pragma unroll
                for (int p = 0; p < 4; ++p) {
                    const int row = p * 8 + (lane >> 3);
                    const float4 ga = *(const float4*)(wl + row * 272 + c4 * 4);
                    const float4 up = *(const float4*)(wl + row * 272 + (32 + c4) * 4);
                    float y0 = ga.x * up.x * __builtin_amdgcn_rcpf(1.f + fexp2(-ga.x * LOG2E));
                    float y1 = ga.y * up.y * __builtin_amdgcn_rcpf(1.f + fexp2(-ga.y * LOG2E));
                    float y2 = ga.z * up.z * __builtin_amdgcn_rcpf(1.f + fexp2(-ga.z * LOG2E));
                    float y3 = ga.w * up.w * __builtin_amdgcn_rcpf(1.f + fexp2(-ga.w * LOG2E));
                    *(uint2*)(J.O + (size_t)(tok0 + row) * J.ldo + (f0 >> 1) + c4) = make_uint2(pk2(y0, y1), pk2(y2, y3));
                }
            } else if (J.mode == 1) {
                const int c4 = (lane & 15) * 4;
#pragma unroll
                for (int p = 0; p < 8; ++p) {
                    const int row = p * 4 + (lane >> 4);
                    const size_t tok = tok0 + row;
                    const float4 v = *(const float4*)(wl + row * 272 + c4 * 4);
                    const float4 xo = *(const float4*)(J.xin + tok * D + f0 + c4);
                    float4 xn; xn.x = xo.x + v.x; xn.y = xo.y + v.y; xn.z = xo.z + v.z; xn.w = xo.w + v.w;
                    *(float4*)(J.xout + tok * D + f0 + c4) = xn;
                    if (J.xb) {
                        *(uint2*)(J.xb + tok * D + f0 + c4) = make_uint2(pk2(xn.x, xn.y), pk2(xn.z, xn.w));
                        float ss = xn.x * xn.x + xn.y * xn.y + xn.z * xn.z + xn.w * xn.w;
                        ss += __shfl_xor(ss, 1); ss += __shfl_xor(ss, 2); ss += __shfl_xor(ss, 4); ss += __shfl_xor(ss, 8);
                        if ((lane & 15) == 0) atomicAdd(J.ssq_out + tok, ss);
                    }
                }
            } else {
                const int nm = f0 < J.qn_end ? 1 : (f0 < J.kn_end ? 2 : 0);
                const float* gp = nm == 1 ? J.qg : J.kg;
                const int c4 = (lane & 15) * 4;
                float4 gn = make_float4(1.f, 1.f, 1.f, 1.f);
                if (nm) gn = *(const float4*)(gp + c4);
#pragma unroll
                for (int p = 0; p < 8; ++p) {
                    const int row = p * 4 + (lane >> 4);
                    float4 v = *(const float4*)(wl + row * 272 + c4 * 4);
                    if (nm) {
                        float ss = v.x * v.x + v.y * v.y + v.z * v.z + v.w * v.w;
                        ss += __shfl_xor(ss, 1); ss += __shfl_xor(ss, 2); ss += __shfl_xor(ss, 4); ss += __shfl_xor(ss, 8);
                        const float inv = __builtin_amdgcn_rsqf(ss * (1.f / 64.f) + EPS);
                        v.x *= inv * gn.x; v.y *= inv * gn.y; v.z *= inv * gn.z; v.w *= inv * gn.w;
                    }
                    *(uint2*)(J.O + (size_t)(tok0 + row) * J.ldo + f0 + c4) = make_uint2(pk2(v.x, v.y), pk2(v.z, v.w));
                }
            }
        }
    }
}

DI void gemm_phase(const GJob& JA, int nA, int nB, const Params& P, char* smem, bool dry) {
    for (int u = (int)gridDim.x - 1 - (int)blockIdx.x; u < nA + nB; u += gridDim.x) {
        GJob J = JA; int t = u;
        if (u >= nA) {
            const int v = u - nA; const int layer = v >> 5; t = v & 31;
            J.A = (const bf16_t*)(P.ws + OFF_MEMB); J.lda = D; J.ksplit = 1 << 30; J.kextra = 0;
            J.W = (const bf16_t*)(P.ws + OFF_WKV + (size_t)layer * 2 * SZ_MM); J.K = D; J.ntm = 4; J.ntn = 8; J.mode = 3;
            J.rs = (const float*)(P.ws + OFF_SSQM); J.O = (bf16_t*)(P.ws + OFF_KN + (size_t)layer * SZ_MM); J.ldo = D;
            J.qn_end = 0; J.kn_end = 0; J.vt = (bf16_t*)(P.ws + OFF_VT + (size_t)layer * SZ_MM);
        }
        gemm_tile(J, t, smem, dry);
    }
}

namespace pg8 {
#define PG8_LAS __attribute__((address_space(3)))
typedef float f32x4 __attribute__((ext_vector_type(4)));
typedef unsigned u32x4 __attribute__((ext_vector_type(4)));
constexpr int BM = 256, BK = 64, HALF = 128, HTB = HALF * BK * 2, STAGE_BYTES = 8 * HTB, NXCD = 8, WGM = 8;
DI int lds_byte(int r, int c) { const int st = (r >> 4) * 2 + (c >> 5), rr = r & 15, cc = c & 31, ob = rr * 64 + cc * 2; return st * 1024 + (ob ^ (((ob >> 9) & 1) << 5)); }
DI void stage_rc(int b, int& R, int& C) { const int st = b / 1024, sb = b % 1024, swz = sb ^ (((sb >> 9) & 1) << 5); R = (st >> 1) * 16 + swz / 64; C = (st & 1) * 32 + (swz % 64) / 2; }
DI int perm32(int rho) { const int n = rho >> 4, i = rho & 15; return 8 * (i >> 2) + 4 * n + (i & 3); }
struct Unit { int pm, pn; };
struct Gemm { const bf16_t* A; const bf16_t* Bt; int M, N, K, lda; };
struct StaticOrder {
    int nM, nN, nwg, G, c;
    DI void init(int M, int N, int G_, int c_) { nM = M / BM; nN = N / BM; nwg = nM * nN; G = G_; c = c_; }
    DI bool next(int i, Unit& u) const {
        const long L = (long)i * G + c; if (L >= nwg) return false;
        int wgid = (int)L; { const int q = nwg / NXCD, r = nwg % NXCD, xcd = wgid % NXCD, off = wgid / NXCD; wgid = (xcd < r ? xcd * (q + 1) : r * (q + 1) + (xcd - r) * q) + off; }
        const int nig = WGM * nN, gid = wgid / nig, fm = gid * WGM, gsz = (nM - fm) < WGM ? (nM - fm) : WGM;
        u.pm = fm + ((wgid % nig) % gsz); u.pn = (wgid % nig) / gsz; return true;
    }
    DI void a_ready(const Unit&) const {}
    DI void done(const Unit&) const {}
};

struct Epi {
    static constexpr bool PERM = true, AFTER_DRAIN = false;
    int mode;
    const float* rs;
    bf16_t* O; int ldo;
    const float* xin; float* xout; bf16_t* xb; float* ssq_out; float alpha;
    const float* qg; const float* kg; int qn_end, kn_beg, kn_end; int dryrun;
    template <bool SRC_F32, bool DST_F32>
    DI void res_path(const f32x4 (&acc)[2][2][4][2], int row0, int colb, int fq) const {
        const __amdgpu_buffer_rsrc_t r_xb = wt_rsrc(xb, (size_t)T * D * 2), r_out = wt_rsrc(DST_F32 ? (const void*)xout : (const void*)xb, (size_t)T * D * (DST_F32 ? 4 : 2));
#pragma unroll
        for (int ai = 0; ai < 2; ++ai) {
            float4 xf[4][2][2];
            uint4 xw[4][2];
#pragma unroll
            for (int m = 0; m < 4; ++m)
#pragma unroll
                for (int bj = 0; bj < 2; ++bj) {
                    const size_t off = (size_t)(row0 + ai * HALF + m * 16) * D + colb + bj * 32;
                    if (SRC_F32) { xf[m][bj][0] = *(const float4*)(xin + off); xf[m][bj][1] = *(const float4*)(xin + off + 4); }
                    else xw[m][bj] = *(const uint4*)(xb + off);
                }
#pragma unroll
            for (int m = 0; m < 4; ++m) {
                const size_t tok = row0 + ai * HALF + m * 16;
                float ss = 0.f;
#pragma unroll
                for (int bj = 0; bj < 2; ++bj) {
                    const size_t off = tok * D + colb + bj * 32;
                    float4 x0, x1;
                    if (SRC_F32) { x0 = xf[m][bj][0]; x1 = xf[m][bj][1]; }
                    else { const uint4 w = xw[m][bj]; x0 = make_float4(bflo(w.x), bfhi(w.x), bflo(w.y), bfhi(w.y)); x1 = make_float4(bflo(w.z), bfhi(w.z), bflo(w.w), bfhi(w.w)); }
                    float4 n0, n1;
                    n0.x = x0.x + alpha * acc[ai][bj][m][0][0]; n0.y = x0.y + alpha * acc[ai][bj][m][0][1]; n0.z = x0.z + alpha * acc[ai][bj][m][0][2]; n0.w = x0.w + alpha * acc[ai][bj][m][0][3];
                    n1.x = x1.x + alpha * acc[ai][bj][m][1][0]; n1.y = x1.y + alpha * acc[ai][bj][m][1][1]; n1.z = x1.z + alpha * acc[ai][bj][m][1][2]; n1.w = x1.w + alpha * acc[ai][bj][m][1][3];
                    if (DST_F32) { st16f_wt(r_out, off * 4, n0); st16f_wt(r_out, off * 4 + 16, n1); }
                    else {
                        const uint4 w = make_uint4(pk2(n0.x, n0.y), pk2(n0.z, n0.w), pk2(n1.x, n1.y), pk2(n1.z, n1.w));
                        st16_wt(r_xb, off * 2, w);
                        const float r0 = bflo(w.x), r1 = bfhi(w.x), r2 = bflo(w.y), r3 = bfhi(w.y), r4 = bflo(w.z), r5 = bfhi(w.z), r6 = bflo(w.w), r7 = bfhi(w.w);
                        ss += r0 * r0 + r1 * r1 + r2 * r2 + r3 * r3 + r4 * r4 + r5 * r5 + r6 * r6 + r7 * r7;
                    }
                }
                if (!DST_F32) {
                    ss += __shfl_xor(ss, 16); ss += __shfl_xor(ss, 32);
                    if (fq == 0) atomicAdd(ssq_out + tok, ss);
                }
            }
        }
    }
    template <bool NM>
    DI void qkv_path(const f32x4 (&acc)[2][2][4][2], int row0, int f0, int fq, const float* gp) const {
        const __amdgpu_buffer_rsrc_t r_o = wt_rsrc(O, (size_t)T * ldo * 2);
        float4 g4[2][2];
#pragma unroll
        for (int bj = 0; bj < 2; ++bj)
#pragma unroll
            for (int n = 0; n < 2; ++n) g4[bj][n] = NM ? *(const float4*)(gp + bj * 32 + 8 * fq + 4 * n) : make_float4(1.f, 1.f, 1.f, 1.f);
        float sc8[2][4];
#pragma unroll
        for (int ai = 0; ai < 2; ++ai)
#pragma unroll
            for (int m = 0; m < 4; ++m) sc8[ai][m] = rs[row0 + ai * HALF + m * 16];
#pragma unroll
        for (int ai = 0; ai < 2; ++ai)
#pragma unroll
            for (int m = 0; m < 4; ++m) {
                const size_t tok = row0 + ai * HALF + m * 16;
                float sc = __builtin_amdgcn_rsqf(sc8[ai][m] * (1.f / 1024.f) + EPS);
                if (NM) {
                    float ss = 0.f;
#pragma unroll
                    for (int bj = 0; bj < 2; ++bj)
#pragma unroll
                        for (int n = 0; n < 2; ++n)
#pragma unroll
                            for (int j = 0; j < 4; ++j) { const float v = acc[ai][bj][m][n][j] * sc; ss += v * v; }
                    ss += __shfl_xor(ss, 16); ss += __shfl_xor(ss, 32);
                    sc *= __builtin_amdgcn_rsqf(ss * (1.f / 64.f) + EPS);
                }
#pragma unroll
                for (int bj = 0; bj < 2; ++bj) {
                    const f32x4 a0 = acc[ai][bj][m][0], a1 = acc[ai][bj][m][1];
                    st16_wt(r_o, (tok * ldo + f0 + bj * 32 + 8 * fq) * 2,
                        make_uint4(pk2(a0[0] * sc * g4[bj][0].x, a0[1] * sc * g4[bj][0].y), pk2(a0[2] * sc * g4[bj][0].z, a0[3] * sc * g4[bj][0].w),
                                   pk2(a1[0] * sc * g4[bj][1].x, a1[1] * sc * g4[bj][1].y), pk2(a1[2] * sc * g4[bj][1].z, a1[3] * sc * g4[bj][1].w)));
                }
            }
    }
    DI void operator()(const f32x4 (&acc)[2][2][4][2], const Unit& u, int wr, int wc, int fr, int fq) const {
        if (dryrun) { if (acc[0][0][0][0][0] + acc[1][1][3][1][3] + acc[0][1][2][0][1] + acc[1][0][1][1][2] == 12345.678f) O[0] = 1; return; }
        const int row0 = u.pm * BM + wr * 64 + fr;
        if (mode == 0) {
            const int col = u.pn * 128 + wc * 32 + 8 * fq;
            const __amdgpu_buffer_rsrc_t r_o = wt_rsrc(O, (size_t)T * ldo * 2);
            float sc8[2][4];
#pragma unroll
            for (int ai = 0; ai < 2; ++ai)
#pragma unroll
                for (int m = 0; m < 4; ++m) sc8[ai][m] = rs[row0 + ai * HALF + m * 16];
#pragma unroll
            for (int ai = 0; ai < 2; ++ai)
#pragma unroll
                for (int m = 0; m < 4; ++m) {
                    const size_t tok = row0 + ai * HALF + m * 16;
                    const float sc = __builtin_amdgcn_rsqf(sc8[ai][m] * (1.f / 1024.f) + EPS);
                    float y[8];
#pragma unroll
                    for (int n = 0; n < 2; ++n)
#pragma unroll
                        for (int j = 0; j < 4; ++j) {
                            const float ga = acc[ai][0][m][n][j] * sc, up = acc[ai][1][m][n][j] * sc;
                            y[4 * n + j] = ga * up * __builtin_amdgcn_rcpf(1.f + fexp2(-ga * LOG2E));
                        }
                    st16_wt(r_o, (tok * ldo + col) * 2, make_uint4(pk2(y[0], y[1]), pk2(y[2], y[3]), pk2(y[4], y[5]), pk2(y[6], y[7])));
                }
        } else if (mode == 1) {
            const int colb = u.pn * BM + wc * 64 + 8 * fq;
            if (xin) res_path<true, false>(acc, row0, colb, fq);
            else if (xout) res_path<false, true>(acc, row0, colb, fq);
            else res_path<false, false>(acc, row0, colb, fq);
        } else {
            const int f0 = u.pn * BM + wc * 64;
            const int nm = f0 < qn_end ? 1 : ((f0 >= kn_beg && f0 < kn_end) ? 2 : 0);
            if (nm) qkv_path<true>(acc, row0, f0, fq, nm == 1 ? qg : kg);
            else qkv_path<false>(acc, row0, f0, fq, nullptr);
        }
    }
};

template <class Epi, class Sched, bool ALIGN_EPI = false, bool SP2 = false>
__device__ __forceinline__ void gemm_phase(PG8_LAS unsigned char* lds, const Gemm g, const Sched& S, const Epi& E) {
    const int tid = otid(), wid = __builtin_amdgcn_readfirstlane(tid >> 6), lane = tid & 63, wr = wid >> 2, wc = wid & 3, fr = lane & 15, fq = lane >> 4;
    const int K = g.K, nt = K / BK;
    unsigned voffA[2], voffB[2];
#pragma unroll
    for (int i = 0; i < 2; ++i) { int R, C; stage_rc(tid * 16 + i * 8192, R, C); const int Rb = Epi::PERM ? ((R & ~31) + perm32(R & 31)) : R;
        voffA[i] = (unsigned)(R * g.lda + C) * 2u; voffB[i] = (unsigned)(Rb * K + C) * 2u; }
    const size_t kstep = (size_t)(BK * 2);
    const size_t hstepA = (size_t)HALF * g.lda * 2, hstepB = (size_t)HALF * K * 2;
    const size_t tstepA = 2 * hstepA, tstepB = 2 * hstepB;
    const unsigned ldsw = (unsigned)wid * 1024u;
    const int aoff = lds_byte(wr * 64 + fr, fq * 8), boff = lds_byte(wc * 32 + fr, fq * 8);
#define PG8_SA(b, h) (((b) * 2 + (h)) * HTB)
#define PG8_SB(b, h) ((4 + (b) * 2 + (h)) * HTB)
#define PG8_STAGE(bufoff, gbase, voff) do { _Pragma("unroll") for (int _i = 0; _i < 2; ++_i) \
        __builtin_amdgcn_global_load_lds((const unsigned*)((const char*)(gbase) + (voff)[_i]), (PG8_LAS unsigned*)(lds + (bufoff) + ldsw + _i * 8192), 16, 0, 0); } while (0)
#define PG8_LDA(dst, b, h) do { _Pragma("unroll") for (int m = 0; m < 4; ++m) _Pragma("unroll") for (int k = 0; k < 2; ++k) dst[m][k] = *(const PG8_LAS bf16x8*)(lds + PG8_SA(b, h) + aoff + m * 2048 + k * 1024); } while (0)
#define PG8_LDB(dst, b, h) do { _Pragma("unroll") for (int n = 0; n < 2; ++n) _Pragma("unroll") for (int k = 0; k < 2; ++k) dst[n][k] = *(const PG8_LAS bf16x8*)(lds + PG8_SB(b, h) + boff + n * 2048 + k * 1024); } while (0)
#define PG8_MMA(ai, bj, At, Bt) do { __builtin_amdgcn_s_setprio(1); _Pragma("unroll") for (int m = 0; m < 4; ++m) _Pragma("unroll") for (int n = 0; n < 2; ++n) _Pragma("unroll") for (int k = 0; k < 2; ++k) \
        acc[ai][bj][m][n] = __builtin_amdgcn_mfma_f32_16x16x32_bf16(Bt[n][k], At[m][k], acc[ai][bj][m][n], 0, 0, 0); __builtin_amdgcn_s_setprio(0); } while (0)
#define PG8_WAIT_V(n) asm volatile("s_waitcnt vmcnt(" #n ")" ::: "memory")
#define PG8_WAIT_L(n) asm volatile("s_waitcnt lgkmcnt(" #n ")" ::: "memory")
#define PG8_BAR __builtin_amdgcn_s_barrier()
#define PG8_SCHED __builtin_amdgcn_sched_barrier(0)
    Unit cur, nxt; int ui = 0;
    if (!S.next(0, cur)) return;
    f32x4 acc[2][2][4][2];
#pragma unroll
    for (int a = 0; a < 2; ++a)
#pragma unroll
        for (int b = 0; b < 2; ++b)
#pragma unroll
            for (int m = 0; m < 4; ++m)
#pragma unroll
                for (int n = 0; n < 2; ++n) acc[a][b][m][n] = (f32x4){0.f, 0.f, 0.f, 0.f};
    bf16x8 At[4][2], B0[2][2], B1[2][2];
    const char* cA = (const char*)g.A + (size_t)cur.pm * tstepA; const char* cB = (const char*)g.Bt + (size_t)cur.pn * tstepB;
    S.a_ready(cur);
    if constexpr (SP2) {
        PG8_STAGE(PG8_SB(0, 0), cB, voffB); PG8_STAGE(PG8_SB(0, 1), cB + hstepB, voffB); PG8_STAGE(PG8_SA(0, 0), cA, voffA); PG8_STAGE(PG8_SA(0, 1), cA + hstepA, voffA);
        if (wr == 1) PG8_BAR;
        PG8_WAIT_V(2); PG8_BAR;
        PG8_STAGE(PG8_SB(1, 0), cB + kstep, voffB); PG8_STAGE(PG8_SA(1, 0), cA + kstep, voffA); PG8_STAGE(PG8_SB(1, 1), cB + hstepB + kstep, voffB);
        PG8_WAIT_V(6); PG8_BAR;
    } else {
        PG8_STAGE(PG8_SB(0, 0), cB, voffB); PG8_STAGE(PG8_SA(0, 0), cA, voffA); PG8_STAGE(PG8_SB(0, 1), cB + hstepB, voffB); PG8_STAGE(PG8_SA(0, 1), cA + hstepA, voffA);
        if (wr == 1) PG8_BAR;
        PG8_WAIT_V(4); PG8_BAR;
        PG8_STAGE(PG8_SB(1, 0), cB + kstep, voffB); PG8_STAGE(PG8_SA(1, 0), cA + kstep, voffA); PG8_STAGE(PG8_SB(1, 1), cB + hstepB + kstep, voffB);
        PG8_WAIT_V(6); PG8_BAR;
    }
    for (;;) {
        const bool has_next = S.next(ui + 1, nxt);
        const char* nA = has_next ? (const char*)g.A + (size_t)nxt.pm * tstepA : cA; const char* nB = has_next ? (const char*)g.Bt + (size_t)nxt.pn * tstepB : cB;
        for (int t = 0; t < nt; t += 2) {
            const bool last = (t == nt - 2);
            const char* a1 = cA + (size_t)(t + 1) * kstep;
            const char* a2 = last ? nA : cA + (size_t)(t + 2) * kstep; const char* b2 = last ? nB : cB + (size_t)(t + 2) * kstep;
            const char* a3 = a2 + kstep; const char* b3 = b2 + kstep;
            if (last && has_next) S.a_ready(nxt);
            if constexpr (SP2) {
            PG8_LDB(B0, 0, 0); PG8_LDB(B1, 0, 1); PG8_SCHED; PG8_LDA(At, 0, 0); PG8_STAGE(PG8_SA(1, 1), a1 + hstepA, voffA);
            PG8_WAIT_V(8); PG8_WAIT_L(0); PG8_BAR; PG8_MMA(0, 0, At, B0); PG8_MMA(0, 1, At, B1); PG8_BAR; PG8_SCHED;
            PG8_LDA(At, 0, 1); PG8_STAGE(PG8_SB(0, 0), b2, voffB); PG8_STAGE(PG8_SB(0, 1), b2 + hstepB, voffB); PG8_STAGE(PG8_SA(0, 0), a2, voffA);
            PG8_WAIT_V(8); PG8_WAIT_L(0); PG8_BAR; PG8_MMA(1, 0, At, B0); PG8_MMA(1, 1, At, B1); PG8_BAR; PG8_SCHED;
            PG8_LDB(B0, 1, 0); PG8_LDB(B1, 1, 1); PG8_SCHED; PG8_LDA(At, 1, 0); PG8_STAGE(PG8_SA(0, 1), a2 + hstepA, voffA);
            PG8_WAIT_V(8); PG8_WAIT_L(0); PG8_BAR; PG8_MMA(0, 0, At, B0); PG8_MMA(0, 1, At, B1); PG8_BAR; PG8_SCHED;
            PG8_LDA(At, 1, 1); PG8_STAGE(PG8_SB(1, 0), b3, voffB); PG8_STAGE(PG8_SB(1, 1), b3 + hstepB, voffB); PG8_STAGE(PG8_SA(1, 0), a3, voffA);
            PG8_WAIT_V(8); PG8_WAIT_L(0); PG8_BAR; PG8_MMA(1, 0, At, B0); PG8_MMA(1, 1, At, B1); PG8_BAR; PG8_SCHED;
            } else {
            PG8_LDB(B0, 0, 0); PG8_SCHED; PG8_LDA(At, 0, 0); PG8_STAGE(PG8_SA(1, 1), a1 + hstepA, voffA);
            PG8_WAIT_L(8); PG8_BAR; PG8_WAIT_L(0); PG8_MMA(0, 0, At, B0); PG8_BAR; PG8_SCHED;
            PG8_LDB(B1, 0, 1); PG8_STAGE(PG8_SB(0, 0), b2, voffB);
            PG8_BAR; PG8_WAIT_L(0); PG8_MMA(0, 1, At, B1); PG8_BAR;
            PG8_LDA(At, 0, 1); PG8_STAGE(PG8_SA(0, 0), a2, voffA);
            PG8_BAR; PG8_WAIT_L(0); PG8_MMA(1, 0, At, B0); PG8_BAR; PG8_SCHED;
            PG8_STAGE(PG8_SB(0, 1), b2 + hstepB, voffB);
            PG8_WAIT_V(6); PG8_BAR; PG8_MMA(1, 1, At, B1); PG8_BAR;
            PG8_LDB(B0, 1, 0); PG8_SCHED; PG8_LDA(At, 1, 0); PG8_STAGE(PG8_SA(0, 1), a2 + hstepA, voffA);
            PG8_WAIT_L(8); PG8_BAR; PG8_WAIT_L(0); PG8_MMA(0, 0, At, B0); PG8_BAR; PG8_SCHED;
            PG8_LDB(B1, 1, 1); PG8_STAGE(PG8_SB(1, 0), b3, voffB);
            PG8_BAR; PG8_WAIT_L(0); PG8_MMA(0, 1, At, B1); PG8_BAR;
            PG8_LDA(At, 1, 1); PG8_STAGE(PG8_SA(1, 0), a3, voffA);
            PG8_BAR; PG8_WAIT_L(0); PG8_MMA(1, 0, At, B0); PG8_BAR; PG8_SCHED;
            PG8_STAGE(PG8_SB(1, 1), b3 + hstepB, voffB);
            PG8_WAIT_V(6); PG8_BAR; PG8_MMA(1, 1, At, B1); PG8_BAR;
            }
        }
        if constexpr (ALIGN_EPI) { if (wr == 0) PG8_BAR; }
        if constexpr (!Epi::AFTER_DRAIN) { E(acc, cur, wr, wc, fr, fq); S.done(cur); }
        if (!has_next) break;
#pragma unroll
        for (int a = 0; a < 2; ++a)
#pragma unroll
            for (int b = 0; b < 2; ++b)
#pragma unroll
                for (int m = 0; m < 4; ++m)
#pragma unroll
                    for (int n = 0; n < 2; ++n) acc[a][b][m][n] = (f32x4){0.f, 0.f, 0.f, 0.f};
        cur = nxt; cA = nA; cB = nB; ++ui;
        if constexpr (ALIGN_EPI) { if (wr == 1) PG8_BAR; }
    }
    PG8_WAIT_V(0);
    if constexpr (!ALIGN_EPI) { if (wr == 0) PG8_BAR; }
    PG8_BAR;
    if constexpr (Epi::AFTER_DRAIN) { E.fused(acc, cur, wr, wc, fr, fq, lds, wid, lane); S.done(cur); }
#undef PG8_SA
#undef PG8_SB
#undef PG8_STAGE
#undef PG8_LDA
#undef PG8_LDB
#undef PG8_MMA
#undef PG8_WAIT_V
#undef PG8_WAIT_L
#undef PG8_BAR
#undef PG8_SCHED
}
}

#define KV_DECL uint4 rk0, rk1, rk2, rk3, rv0, rv1, rv2, rv3
#define KV_LOAD(kb_, dil_) do { const int kk_ = lane >> 3; \
    const bf16_t* p0_ = qkv + (rowb + min(max((kb_) + (dil_) * kk_, 0), S - 1)) * ld + (lane & 7) * 8; \
    const bf16_t* p1_ = qkv + (rowb + min(max((kb_) + (dil_) * (kk_ + 8), 0), S - 1)) * ld + (lane & 7) * 8; \
    const bf16_t* p2_ = qkv + (rowb + min(max((kb_) + (dil_) * (kk_ + 16), 0), S - 1)) * ld + (lane & 7) * 8; \
    const bf16_t* p3_ = qkv + (rowb + min(max((kb_) + (dil_) * (kk_ + 24), 0), S - 1)) * ld + (lane & 7) * 8; \
    rk0 = *(const uint4*)(p0_ + kcol); rk1 = *(const uint4*)(p1_ + kcol); rk2 = *(const uint4*)(p2_ + kcol); rk3 = *(const uint4*)(p3_ + kcol); \
    rv0 = *(const uint4*)(p0_ + vcol); rv1 = *(const uint4*)(p1_ + vcol); rv2 = *(const uint4*)(p2_ + vcol); rv3 = *(const uint4*)(p3_ + vcol); } while (0)
#define KV_STORE() do { char* wp_ = vl + (lane >> 3) * 144 + (lane & 7) * 16; \
    *(uint4*)(wp_) = rk0; *(uint4*)(wp_ + 8 * 144) = rk1; *(uint4*)(wp_ + 16 * 144) = rk2; *(uint4*)(wp_ + 24 * 144) = rk3; \
    *(uint4*)(wp_ + 4608) = rv0; *(uint4*)(wp_ + 4608 + 8 * 144) = rv1; *(uint4*)(wp_ + 4608 + 16 * 144) = rv2; *(uint4*)(wp_ + 4608 + 24 * 144) = rv3; } while (0)

DI bf16x8 v_frag(const char* vbase, int s, int dt) {
    typedef __attribute__((address_space(3))) v4i16_t* lp_t;
    const char* a = vbase + s * (16 * 144) + dt * 64;
    const s16x4 lo = __builtin_bit_cast(s16x4, __builtin_amdgcn_ds_read_tr16_b64_v4i16((lp_t)(a)));
    const s16x4 hi = __builtin_bit_cast(s16x4, __builtin_amdgcn_ds_read_tr16_b64_v4i16((lp_t)(a + 8 * 144)));
    return __builtin_shufflevector(lo, hi, 0, 1, 2, 3, 4, 5, 6, 7);
}

template <int OFF> DI bf16x8 pack8v(const f32x16& p) {
    typedef unsigned u32x4 __attribute__((ext_vector_type(4)));
    u32x4 w; w[0] = pk2(p[OFF + 0], p[OFF + 1]); w[1] = pk2(p[OFF + 2], p[OFF + 3]); w[2] = pk2(p[OFF + 4], p[OFF + 5]); w[3] = pk2(p[OFF + 6], p[OFF + 7]);
    return __builtin_bit_cast(bf16x8, w);
}

DI void win_attn_wave(bf16_t* qkv, int ld, int b, int qcol, int kcol, int vcol, int tq0, int qstride,
                      float slope2, float m_init, float l_init, int pat, char* vl, int lane, bool dry,
                      int nq = 32, float* st = nullptr, int tloc0 = 0, int tlstride = 0, int stage = 0) {
    const int r = lane & 31, h = lane >> 5;
    const size_t rowb = (size_t)b * S;
    const int tq = tq0 + qstride * r;
    bf16x8 qf[4];
    {
        const bf16_t* qp = qkv + (rowb + min(tq, S - 1)) * ld + qcol + h * 32;
#pragma unroll
        for (int ks = 0; ks < 4; ++ks) qf[ks] = *(const bf16x8*)(qp + ks * 8);
    }
    f32x16 o0, o1;
#pragma unroll
    for (int i = 0; i < 16; ++i) { o0[i] = 0.f; o1[i] = 0.f; }
    float m = m_init, l = (h == 0) ? l_init : 0.f;
    const float sc2 = 0.125f * LOG2E;
    const int i16 = lane & 15;
    const char* vbase = vl + 4608 + (4 * h + (i16 >> 2)) * 144 + (16 * ((lane >> 4) & 1) + 4 * (i16 & 3)) * 2;
    const char* kfp = vl + r * 144 + h * 64;
    KV_DECL;
    for (int pi = 0; pi < 1; ++pi) {
        int dil, W, kfirst; const int nt = 5;
        if (pat < 0) { dil = 1; W = 127; kfirst = tq0 - 128; }
        else if (pat == 0) { dil = 1; W = 128; kfirst = tq0 - 128; }
        else if (pat == 1) { dil = 4; W = 512; kfirst = tq0 - 512; }
        else { dil = 16; W = 2048; kfirst = tq0 - 2048; }
        const int step = 32 * dil;
        int t0 = 0;
        { const int need = -kfirst - 31 * dil; if (need > 0) t0 = (need + step - 1) / step; }
        if (t0 >= nt) continue;
        KV_LOAD(kfirst + t0 * step, dil);
        for (int tile = t0; tile < nt; ++tile) {
            const int kb = kfirst + tile * step;
            KV_STORE();
            asm volatile("" ::: "memory");
            if (tile + 1 < nt) KV_LOAD(kb + step, dil);
            f32x16 s;
#pragma unroll
            for (int i = 0; i < 16; ++i) s[i] = 0.f;
#pragma unroll
            for (int ks = 0; ks < 4; ++ks) s = MFMA(*(const bf16x8*)(kfp + ks * 16), qf[ks], s);
            f32x16 sv; float mloc = -INFINITY;
            const int d0 = tq - kb - 4 * h * dil;
            const float b0 = -slope2 * (float)d0, b1 = slope2 * (float)dil;
            if (tile >= 1 && tile <= 3 && kb >= 0) {
#pragma unroll
                for (int i = 0; i < 16; ++i) {
                    sv[i] = __builtin_fmaf(s[i], sc2, __builtin_fmaf(b1, (float)crow(i, 0), b0));
                    mloc = fmaxf(mloc, sv[i]);
                }
            } else {
                const unsigned wlim = (unsigned)min(W, tq);
#pragma unroll
                for (int i = 0; i < 16; ++i) {
                    const int diff = d0 - dil * crow(i, 0);
                    const float sb = __builtin_fmaf(s[i], sc2, __builtin_fmaf(b1, (float)crow(i, 0), b0));
                    sv[i] = ((unsigned)diff <= wlim) ? sb : -INFINITY;
                    mloc = fmaxf(mloc, sv[i]);
                }
            }
            mloc = fmaxf(mloc, __shfl_xor(mloc, 32));
            const float mn = fmaxf(m, mloc);
            if (__builtin_amdgcn_ballot_w64(mn > m + 8.f) != 0) {
                const float alpha = fexp2(m - mn);
                l *= alpha;
#pragma unroll
                for (int i = 0; i < 16; ++i) { o0[i] *= alpha; o1[i] *= alpha; }
                m = mn;
            }
            float ps = 0.f;
#pragma unroll
            for (int i = 0; i < 16; ++i) { sv[i] = fexp2(sv[i] - m); ps += sv[i]; }
            l += ps;
            const bf16x8 p0 = pack8v<0>(sv), p1 = pack8v<8>(sv);
            o0 = MFMA(v_frag(vbase, 0, 0), p0, o0);
            o0 = MFMA(v_frag(vbase, 1, 0), p1, o0);
            o1 = MFMA(v_frag(vbase, 0, 1), p0, o1);
            o1 = MFMA(v_frag(vbase, 1, 1), p1, o1);
            asm volatile("" ::: "memory");
        }
    }
    float lt = l + __shfl_xor(l, 32);
    if (st) {
        const bool act = r < nq;
        float* sp = st + (tloc0 + tlstride * r) * 68;
        if (act) {
            if (stage > 0) {
                const float ms = sp[64], ls = sp[65];
                const float mn = fmaxf(ms, m);
                const float as = fexp2(ms - mn), aw = fexp2(m - mn);
                lt = ls * as + lt * aw; m = mn;
#pragma unroll
                for (int g = 0; g < 4; ++g) {
                    const float4 a = *(const float4*)(sp + 8 * g + 4 * h), c = *(const float4*)(sp + 32 + 8 * g + 4 * h);
                    o0[4 * g] = a.x * as + o0[4 * g] * aw; o0[4 * g + 1] = a.y * as + o0[4 * g + 1] * aw; o0[4 * g + 2] = a.z * as + o0[4 * g + 2] * aw; o0[4 * g + 3] = a.w * as + o0[4 * g + 3] * aw;
                    o1[4 * g] = c.x * as + o1[4 * g] * aw; o1[4 * g + 1] = c.y * as + o1[4 * g + 1] * aw; o1[4 * g + 2] = c.z * as + o1[4 * g + 2] * aw; o1[4 * g + 3] = c.w * as + o1[4 * g + 3] * aw;
                }
            }
            if (stage < 2) {
                if (h == 0) { sp[64] = m; sp[65] = lt; }
#pragma unroll
                for (int g = 0; g < 4; ++g) {
                    *(float4*)(sp + 8 * g + 4 * h) = make_float4(o0[4 * g], o0[4 * g + 1], o0[4 * g + 2], o0[4 * g + 3]);
                    *(float4*)(sp + 32 + 8 * g + 4 * h) = make_float4(o1[4 * g], o1[4 * g + 1], o1[4 * g + 2], o1[4 * g + 3]);
                }
            }
        }
        if (stage < 2 || !act) return;
    }
    const float inv = 1.f / lt;
    if (dry) { if (o0[0] + o1[0] + lt == 12345.678f) qkv[0] = 1; return; }
    bf16_t* op = qkv + (rowb + tq) * ld + qcol + 4 * h;
#pragma unroll
    for (int g = 0; g < 4; ++g) {
        *(uint2*)(op + 8 * g) = make_uint2(pk2(o0[4 * g] * inv, o0[4 * g + 1] * inv), pk2(o0[4 * g + 2] * inv, o0[4 * g + 3] * inv));
        *(uint2*)(op + 32 + 8 * g) = make_uint2(pk2(o1[4 * g] * inv, o1[4 * g + 1] * inv), pk2(o1[4 * g + 2] * inv, o1[4 * g + 3] * inv));
    }
}

DI void stick_wave(bf16_t* qkv, int ld, int b, int qcol, int kcol, int vcol, int qt, char* vl, int lane, bool dry) {
    const int r = lane & 31, h = lane >> 5;
    const size_t rowb = (size_t)b * S;
    const int tq = qt * 32 + r;
    bf16x8 qf[4];
    {
        const bf16_t* qp = qkv + (rowb + tq) * ld + qcol + h * 32;
#pragma unroll
        for (int ks = 0; ks < 4; ++ks) qf[ks] = *(const bf16x8*)(qp + ks * 8);
    }
    f32x16 o0, o1;
#pragma unroll
    for (int i = 0; i < 16; ++i) { o0[i] = 0.f; o1[i] = 0.f; }
    float R = 1.f;
    const int i16 = lane & 15;
    const char* vbase = vl + 4608 + (4 * h + (i16 >> 2)) * 144 + (16 * ((lane >> 4) & 1) + 4 * (i16 & 3)) * 2;
    const char* kfp = vl + r * 144 + h * 64;
    KV_DECL;
    KV_LOAD(qt * 32, 1);
    for (int tile = qt; tile >= 0; --tile) {
        KV_STORE();
        asm volatile("" ::: "memory");
        if (tile > 0) KV_LOAD((tile - 1) * 32, 1);
        f32x16 s;
#pragma unroll
        for (int i = 0; i < 16; ++i) s[i] = 0.f;
#pragma unroll
        for (int ks = 0; ks < 4; ++ks) s = MFMA(*(const bf16x8*)(kfp + ks * 16), qf[ks], s);
        const bool diag = (tile == qt);
        f32x16 sg, kp;
#pragma unroll
        for (int i = 0; i < 16; ++i) {
            const float z2 = fminf(s[i] * (0.125f * LOG2E), 80.f);
            const float t = fexp2(z2);
            const float k = __builtin_amdgcn_rcpf(1.f + t);
            kp[i] = k; sg[i] = t * k;
        }
        if (diag) {
#pragma unroll
            for (int i = 0; i < 16; ++i) { const bool strict = crow(i, h) < r; kp[i] = strict ? kp[i] : 1.f; sg[i] = strict ? sg[i] : 0.f; }
        }
        float G[4], PG[4], both[4];
#pragma unroll
        for (int g = 0; g < 4; ++g) { G[g] = (kp[4 * g] * kp[4 * g + 1]) * (kp[4 * g + 2] * kp[4 * g + 3]); PG[g] = __shfl_xor(G[g], 32); both[g] = G[g] * PG[g]; }
        float Sx[4];
        Sx[3] = 1.f; Sx[2] = both[3]; Sx[1] = both[3] * both[2]; Sx[0] = Sx[1] * both[1];
        f32x16 a;
#pragma unroll
        for (int g = 0; g < 4; ++g) {
            float la = R * Sx[g] * (h == 0 ? PG[g] : 1.f);
#pragma unroll
            for (int j = 3; j >= 0; --j) {
                a[4 * g + j] = sg[4 * g + j] * la;
                la *= kp[4 * g + j];
            }
        }
        R *= Sx[0] * both[0];
        const bf16x8 p0 = pack8v<0>(a), p1 = pack8v<8>(a);
        o0 = MFMA(v_frag(vbase, 0, 0), p0, o0);
        o0 = MFMA(v_frag(vbase, 1, 0), p1, o0);
        o1 = MFMA(v_frag(vbase, 0, 1), p0, o1);
        o1 = MFMA(v_frag(vbase, 1, 1), p1, o1);
        asm volatile("" ::: "memory");
        if (__builtin_amdgcn_ballot_w64(R >= 1.17549435e-38f) == 0) break;
    }
    if (dry) { if (o0[0] + o1[0] == 12345.678f) qkv[0] = 1; return; }
    bf16_t* op = qkv + (rowb + tq) * ld + qcol + 4 * h;
#pragma unroll
    for (int g = 0; g < 4; ++g) {
        *(uint2*)(op + 8 * g) = make_uint2(pk2(o0[4 * g], o0[4 * g + 1]), pk2(o0[4 * g + 2], o0[4 * g + 3]));
        *(uint2*)(op + 32 + 8 * g) = make_uint2(pk2(o1[4 * g], o1[4 * g + 1]), pk2(o1[4 * g + 2], o1[4 * g + 3]));
    }
}

DI void attn_even_phase(const Params& P, char* smem, bool dry) {
    const int tid_ = otid(); const int lane = tid_ & 63, wid = tid_ >> 6;
    bf16_t* qkv = (bf16_t*)(P.ws + OFF_BIG);
    char* vl = smem + wid * 9216;
    for (int it = blockIdx.x * 8 + wid; it < 2048 + 4096; it += gridDim.x * 8) {
        if (it < 2048) {
            const int bh = it >> 6, p = it & 63; const int b = bh >> 3, head = bh & 7;
            stick_wave(qkv, 2304, b, 512 + head * 64, 1280 + head * 64, 1792 + head * 64, 127 - p, vl, lane, dry);
            stick_wave(qkv, 2304, b, 512 + head * 64, 1280 + head * 64, 1792 + head * 64, p, vl, lane, dry);
        } else {
            const int v = it - 2048; const int g = v & 3; const int qt = (v >> 2) & 127; const int rest = v >> 9; const int b = rest >> 1, kvh = rest & 1;
            const int head = kvh * 4 + g;
            const float slope = exp2f(-(float)(head + 1));
            const float sink = P.in[9][head];
            win_attn_wave(qkv, 2304, b, head * 64, 1024 + kvh * 64, 1152 + kvh * 64, qt * 32, 1, slope * LOG2E, sink * LOG2E, 1.f, -1, vl, lane, dry);
        }
    }
}

DI void attn_odd_phase(const Params& P, char* smem, bool dry) {
    const int tid_ = otid(); const int lane = tid_ & 63, wid = tid_ >> 6;
    bf16_t* qkv = (bf16_t*)(P.ws + OFF_BIG);
    char* vl = smem + wid * 9216;
    float* st = (float*)(smem + 8 * 9216);
    for (int it = blockIdx.x; it < 1024; it += gridDim.x) {
        const int span = it & 15, head = (it >> 4) & 15, b = it >> 8; const int t0 = span * 256;
        const float slope2 = exp2f(-0.5f * (float)(head + 1)) * LOG2E;
        const int qc = head * 64, kc = 1024 + head * 64, vc = 2048 + head * 64;
        __syncthreads();
        win_attn_wave(qkv, 3072, b, qc, kc, vc, t0 + 32 * wid, 1, slope2, -1e30f, 0.f, 0, vl, lane, dry, 32, st, 32 * wid, 1, 0);
        __syncthreads();
        { const int r4 = wid >> 1, hf = wid & 1;
          win_attn_wave(qkv, 3072, b, qc, kc, vc, t0 + r4 + 128 * hf, 4, slope2, -1e30f, 0.f, 1, vl, lane, dry, 32, st, r4 + 128 * hf, 4, 1); }
        __syncthreads();
#pragma unroll 1
        for (int k = 0; k < 2; ++k) {
            const int r16 = 2 * wid + k;
            win_attn_wave(qkv, 3072, b, qc, kc, vc, t0 + r16, 16, slope2, -1e30f, 0.f, 2, vl, lane, dry, 16, st, r16, 16, 2);
        }
    }
}

DI void xattn_wave(bf16_t* qb, const bf16_t* Kn, const bf16_t* VT, const float* qg, float kmax2, int b, int head, int tok0, char* ql, int lane, bool dry) {
    const int r = lane & 31, h = lane >> 5;
    const size_t token = (size_t)b * S + tok0 + r;
    bf16_t* qp = qb + token * D + head * 256 + h * 128;
    float ss = 0.f;
#pragma unroll
    for (int ks = 0; ks < 16; ++ks) {
        const uint4 v = *(const uint4*)(qp + ks * 8);
        const unsigned w[4] = {v.x, v.y, v.z, v.w};
#pragma unroll
        for (int e = 0; e < 4; ++e) { const float a = bflo(w[e]), c = bfhi(w[e]); ss += a * a + c * c; }
    }
    ss += __shfl_xor(ss, 32);
    const float inv = __builtin_amdgcn_rsqf(ss * (1.f / 256.f) + EPS);
    float qq2 = 0.f;
#pragma unroll
    for (int ks = 0; ks < 16; ++ks) {
        const uint4 v = *(const uint4*)(qp + ks * 8);
        const float4 g0 = *(const float4*)(qg + h * 128 + ks * 8), g1 = *(const float4*)(qg + h * 128 + ks * 8 + 4);
        uint4 o;
        o.x = pk2(bflo(v.x) * inv * g0.x, bfhi(v.x) * inv * g0.y); o.y = pk2(bflo(v.y) * inv * g0.z, bfhi(v.y) * inv * g0.w);
        o.z = pk2(bflo(v.z) * inv * g1.x, bfhi(v.z) * inv * g1.y); o.w = pk2(bflo(v.w) * inv * g1.z, bfhi(v.w) * inv * g1.w);
        qq2 += bflo(o.x) * bflo(o.x) + bfhi(o.x) * bfhi(o.x) + bflo(o.y) * bflo(o.y) + bfhi(o.y) * bfhi(o.y)
             + bflo(o.z) * bflo(o.z) + bfhi(o.z) * bfhi(o.z) + bflo(o.w) * bflo(o.w) + bfhi(o.w) * bfhi(o.w);
        *(uint4*)(ql + (ks * 64 + lane) * 16) = o;
    }
    qq2 += __shfl_xor(qq2, 32);
    asm volatile("" ::: "memory");
    const float sc2 = 0.0625f * LOG2E;
    const bf16_t* kp0 = Kn + ((size_t)(b * 4 + head) * 8 * 16 * 64 + lane) * 8;
    const float m = __builtin_amdgcn_sqrtf(qq2 * kmax2) * 1.001f;
    float l = 0.f;
    bf16x8 pf[8][2];
    bf16x8 kc[16], kn[16];
#pragma unroll
    for (int ks = 0; ks < 16; ++ks) kc[ks] = *(const bf16x8*)(kp0 + ks * 512);
#pragma unroll
    for (int tile = 0; tile < 8; ++tile) {
        if (tile < 7) {
#pragma unroll
            for (int ks = 0; ks < 16; ++ks) kn[ks] = *(const bf16x8*)(kp0 + (size_t)(tile + 1) * 16 * 512 + ks * 512);
        }
        f32x16 s, s_b;
#pragma unroll
        for (int i = 0; i < 16; ++i) { s[i] = 0.f; s_b[i] = 0.f; }
#pragma unroll
        for (int ks = 0; ks < 16; ks += 2) {
            const bf16x8 qf0 = *(const bf16x8*)(ql + (ks * 64 + lane) * 16);
            const bf16x8 qf1 = *(const bf16x8*)(ql + ((ks + 1) * 64 + lane) * 16);
            s = MFMA(kc[ks], qf0, s);
            s_b = MFMA(kc[ks + 1], qf1, s_b);
        }
#pragma unroll
        for (int i = 0; i < 16; ++i) s[i] += s_b[i];
#pragma unroll
        for (int i = 0; i < 16; ++i) { s[i] = fexp2((s[i] - m) * sc2); l += s[i]; }
        pf[tile][0] = pack8v<0>(s); pf[tile][1] = pack8v<8>(s);
#pragma unroll
        for (int ks = 0; ks < 16; ++ks) kc[ks] = kn[ks];
    }
    l += __shfl_xor(l, 32);
    const float il = 1.f / l;
    bf16_t* op = qb + token * D + head * 256 + 4 * h;
    const bf16_t* vp0 = VT + (((size_t)(b * 4 + head) * 8 * 8 * 2 * 64) + lane) * 8;
    bf16x8 vc[16], vn[16];
#pragma unroll
    for (int e = 0; e < 16; ++e) vc[e] = *(const bf16x8*)(vp0 + e * 512);
#pragma unroll 1
    for (int dt = 0; dt < 8; ++dt) {
        const int dn = dt < 7 ? dt + 1 : 7;
#pragma unroll
        for (int e = 0; e < 16; ++e) vn[e] = *(const bf16x8*)(vp0 + (size_t)dn * 16 * 512 + e * 512);
        f32x16 o, o_b;
#pragma unroll
        for (int i = 0; i < 16; ++i) { o[i] = 0.f; o_b[i] = 0.f; }
#pragma unroll
        for (int tile = 0; tile < 8; ++tile) { o = MFMA(vc[tile * 2], pf[tile][0], o); o_b = MFMA(vc[tile * 2 + 1], pf[tile][1], o_b); }
#pragma unroll
        for (int i = 0; i < 16; ++i) o[i] += o_b[i];
#pragma unroll
        for (int g = 0; g < 4; ++g)
            if (dry) { if (o[4 * g] == 12345.678f) qb[0] = 1; } else *(uint2*)(op + dt * 32 + 8 * g) = make_uint2(pk2(o[4 * g] * il, o[4 * g + 1] * il), pk2(o[4 * g + 2] * il, o[4 * g + 3] * il));
#pragma unroll
        for (int e = 0; e < 16; ++e) vc[e] = vn[e];
    }
}

DI void xattn_block(bf16_t* qb, const bf16_t* KF, const bf16_t* VF, const float* qg, float kmax2, int b, int head, int qblk, char* smem, int lane, int wid) {
    const int r = lane & 31, h = lane >> 5;
    const size_t token = (size_t)b * S + qblk * 256 + wid * 32 + r;
    bf16_t* qp = qb + token * D + head * 256 + h * 128;
    const bf16_t* kbase = KF + (size_t)(b * 4 + head) * 8 * 8192;
    const bf16_t* vbase = VF + (size_t)(b * 4 + head) * 8 * 8192;
    const int pc0 = (2 * wid) * 512 + lane * 8, pc1 = pc0 + 512;
    char* ld0 = smem + (2 * wid) * 1024 + lane * 16;
#define XA_ISSUE(u_) do { const int u__ = (u_); const bf16_t* src_ = (u__ < 8) ? kbase + (size_t)u__ * 8192 : vbase + (size_t)(u__ - 8) * 8192; \
        char* dst_ = ld0 + (u__ & 3) * 16384; glds16(src_ + pc0, dst_); glds16(src_ + pc1, dst_ + 1024); } while (0)
    __syncthreads();
    XA_ISSUE(0); XA_ISSUE(1); XA_ISSUE(2);
    uint4 qraw[16];
    float ss = 0.f;
#pragma unroll
    for (int ks = 0; ks < 16; ++ks) {
        qraw[ks] = *(const uint4*)(qp + ks * 8);
        const uint4 v = qraw[ks];
        ss += bflo(v.x) * bflo(v.x) + bfhi(v.x) * bfhi(v.x) + bflo(v.y) * bflo(v.y) + bfhi(v.y) * bfhi(v.y)
            + bflo(v.z) * bflo(v.z) + bfhi(v.z) * bfhi(v.z) + bflo(v.w) * bflo(v.w) + bfhi(v.w) * bfhi(v.w);
    }
    ss += __shfl_xor(ss, 32);
    const float inv = __builtin_amdgcn_rsqf(ss * (1.f / 256.f) + EPS);
    float qq2 = 0.f;
    bf16x8 qf[16];
#pragma unroll
    for (int ks = 0; ks < 16; ++ks) {
        const uint4 v = qraw[ks];
        const float4 g0 = *(const float4*)(qg + h * 128 + ks * 8), g1 = *(const float4*)(qg + h * 128 + ks * 8 + 4);
        uint4 o;
        o.x = pk2(bflo(v.x) * inv * g0.x, bfhi(v.x) * inv * g0.y); o.y = pk2(bflo(v.y) * inv * g0.z, bfhi(v.y) * inv * g0.w);
        o.z = pk2(bflo(v.z) * inv * g1.x, bfhi(v.z) * inv * g1.y); o.w = pk2(bflo(v.w) * inv * g1.z, bfhi(v.w) * inv * g1.w);
        qq2 += bflo(o.x) * bflo(o.x) + bfhi(o.x) * bfhi(o.x) + bflo(o.y) * bflo(o.y) + bfhi(o.y) * bfhi(o.y)
             + bflo(o.z) * bflo(o.z) + bfhi(o.z) * bfhi(o.z) + bflo(o.w) * bflo(o.w) + bfhi(o.w) * bfhi(o.w);
        qf[ks] = __builtin_bit_cast(bf16x8, o);
    }
    qq2 += __shfl_xor(qq2, 32);
    const float sc2 = 0.0625f * LOG2E;
    const float m = __builtin_amdgcn_sqrtf(qq2 * kmax2) * 1.001f;
    float l = 0.f;
    bf16x8 pf[8][2];
    const char* fr0 = smem + lane * 16;
#pragma unroll
    for (int u = 0; u < 8; ++u) {
        asm volatile("s_waitcnt vmcnt(4)" ::: "memory");
        __builtin_amdgcn_s_barrier();
        XA_ISSUE(u + 3);
        const char* sl = fr0 + (u & 3) * 16384;
        f32x16 s, s_b;
#pragma unroll
        for (int i = 0; i < 16; ++i) { s[i] = 0.f; s_b[i] = 0.f; }
#pragma unroll
        for (int ks = 0; ks < 16; ks += 2) {
            s = MFMA(*(const bf16x8*)(sl + ks * 1024), qf[ks], s);
            s_b = MFMA(*(const bf16x8*)(sl + (ks + 1) * 1024), qf[ks + 1], s_b);
        }
#pragma unroll
        for (int i = 0; i < 16; ++i) { s[i] = fexp2((s[i] + s_b[i] - m) * sc2); l += s[i]; }
        pf[u][0] = pack8v<0>(s); pf[u][1] = pack8v<8>(s);
    }
    l += __shfl_xor(l, 32);
    const float il = 1.f / l;
    bf16_t* op = qb + token * D + head * 256 + 4 * h;
#pragma unroll 1
    for (int dt = 0; dt < 8; ++dt) {
        if (dt < 6) asm volatile("s_waitcnt vmcnt(4)" ::: "memory");
        else if (dt == 6) asm volatile("s_waitcnt vmcnt(2)" ::: "memory");
        else asm volatile("s_waitcnt vmcnt(0)" ::: "memory");
        __builtin_amdgcn_s_barrier();
        if (dt < 5) XA_ISSUE(dt + 11);
        const char* sl = fr0 + (dt & 3) * 16384;
        f32x16 o, o_b;
#pragma unroll
        for (int i = 0; i < 16; ++i) { o[i] = 0.f; o_b[i] = 0.f; }
#pragma unroll
        for (int tile = 0; tile < 8; ++tile) {
            o = MFMA(*(const bf16x8*)(sl + (tile * 2) * 1024), pf[tile][0], o);
            o_b = MFMA(*(const bf16x8*)(sl + (tile * 2 + 1) * 1024), pf[tile][1], o_b);
        }
#pragma unroll
        for (int g = 0; g < 4; ++g)
            *(uint2*)(op + dt * 32 + 8 * g) = make_uint2(pk2((o[4 * g] + o_b[4 * g]) * il, (o[4 * g + 1] + o_b[4 * g + 1]) * il),
                                                        pk2((o[4 * g + 2] + o_b[4 * g + 2]) * il, (o[4 * g + 3] + o_b[4 * g + 3]) * il));
    }
#undef XA_ISSUE
}

DI void xattn_phase(const Params& P, int l, char* smem, bool dry) {
    const int tid_ = otid(); const int lane = tid_ & 63, wid = tid_ >> 6;
    bf16_t* qb = (bf16_t*)(P.ws + OFF_BIG);
    const bf16_t* KF = (const bf16_t*)(P.ws + OFF_KF + (size_t)l * SZ_MM);
    const bf16_t* VF = (const bf16_t*)(P.ws + OFF_VT + (size_t)l * SZ_MM);
    const float* qg = P.in[19] + l * 256;
    (void)dry;
    for (int it = blockIdx.x; it < 256; it += gridDim.x) {
        const int qblk = it & 15, head = (it >> 4) & 3, b = it >> 6;
        const float kmax2 = ((const float*)(P.ws + OFF_KMAX))[l * 16 + b * 4 + head];
        xattn_block(qb, KF, VF, qg, kmax2, b, head, qblk, smem, lane, wid);
    }
}

DI void knorm_phase(const Params& P) {
    const int tid_ = otid(); const int lane = tid_ & 63, wid = tid_ >> 6;
    for (int u = blockIdx.x * 8 + wid; u < 8192; u += gridDim.x * 8) {
        const int l = u >> 12, row = (u >> 2) & 1023, head = u & 3;
        const bf16_t* kp = (const bf16_t*)(P.ws + OFF_KN + (size_t)l * SZ_MM) + (size_t)row * D + head * 256 + lane * 4;
        const uint2 v = *(const uint2*)kp;
        const float a0 = bflo(v.x), a1 = bfhi(v.x), a2 = bflo(v.y), a3 = bfhi(v.y);
        float ss = a0 * a0 + a1 * a1 + a2 * a2 + a3 * a3;
        ss = wave_sum(ss);
        const float inv = __builtin_amdgcn_rsqf(ss * (1.f / 256.f) + EPS);
        const float4 g = *(const float4*)(P.in[20] + l * 256 + lane * 4);
        const int b = row >> 8, key = row & 255;
        const int h = lane >> 5, ks = (lane & 31) >> 1, j0 = (lane & 1) * 4;
        bf16_t* dp = (bf16_t*)(P.ws + OFF_KF + (size_t)l * SZ_MM) + ((((((size_t)(b * 4 + head) * 8 + (key >> 5)) * 16 + ks) * 64) + h * 32 + (key & 31)) << 3) + j0;
        const unsigned w0_ = pk2(a0 * inv * g.x, a1 * inv * g.y), w1_ = pk2(a2 * inv * g.z, a3 * inv * g.w);
        *(uint2*)dp = make_uint2(w0_, w1_);
        float kk2 = bflo(w0_) * bflo(w0_) + bfhi(w0_) * bfhi(w0_) + bflo(w1_) * bflo(w1_) + bfhi(w1_) * bfhi(w1_);
        kk2 = wave_sum(kk2);
        if (lane == 0) atomicMax((unsigned*)(P.ws + OFF_KMAX) + l * 16 + b * 4 + head, __float_as_uint(kk2));
    }
}

#define XB_TMO      128
#define XB_XCNT(j)  (256  + 64 * (j))
#define XB_XSUB(j)  (1280 + 64 * (j))
#define XB_XGEN(j)  (2304 + 64 * (j))
#define XB_TOP      3328
#define XB_TOPGEN   3392
#define XCD_BAR_WORDS 3456
#define XB_SPIN_CAP (1u << 18)
#define XB_LAS __attribute__((address_space(3)))

__device__ __forceinline__ unsigned xb_ld(unsigned* p)              { return __hip_atomic_load(p, __ATOMIC_RELAXED, __HIP_MEMORY_SCOPE_AGENT); }
__device__ __forceinline__ unsigned xb_add(unsigned* p, unsigned v) { return __hip_atomic_fetch_add(p, v, __ATOMIC_RELAXED, __HIP_MEMORY_SCOPE_AGENT); }
__device__ __forceinline__ unsigned xb_xcc_id() { return (unsigned)__builtin_amdgcn_s_getreg((3 << 11) | 20) & 0xFu; }
#define XB_SPIN(cond, bar) do { unsigned _sp = 0; while (cond) { __builtin_amdgcn_s_sleep(1); \
    if ((++_sp & 255u) == 0u) { if (xb_ld(&(bar)[XB_TMO])) break; if (_sp > XB_SPIN_CAP) { atomicAdd(&(bar)[XB_TMO], 1u); break; } } } } while (0)

struct XcdBarrier {
    unsigned* bar; unsigned x;
    volatile XB_LAS unsigned* st;
};

__device__ __forceinline__ XcdBarrier xcd_barrier_post(unsigned* bar, volatile XB_LAS unsigned* st) {
    XcdBarrier b; b.bar = bar; b.x = xb_xcc_id(); b.st = st;
    if (threadIdx.x == 0) (void)xb_add(&bar[XB_XCNT(b.x)], 1u);
    return b;
}
__device__ __forceinline__ void xcd_barrier_complete(unsigned* bar, unsigned x, unsigned& nloc, unsigned& nx) {
    const unsigned G = gridDim.x * gridDim.y * gridDim.z;
    unsigned sum, cnt, mine, sp = 0u;
    for (;;) {
        sum = 0u; cnt = 0u; mine = 0u;
#pragma unroll
        for (unsigned j = 0; j < 16; ++j) { const unsigned c = xb_ld(&bar[XB_XCNT(j)]); sum += c; cnt += (c > 0u) ? 1u : 0u; mine = (j == x) ? c : mine; }
        if (sum == G) break;
        __builtin_amdgcn_s_sleep(1);
        if ((++sp & 255u) == 0u) { if (xb_ld(&bar[XB_TMO])) break; if (sp > XB_SPIN_CAP) { atomicAdd(&bar[XB_TMO], 1u); break; } }
    }
    nloc = mine > 0u ? mine : 1u; nx = cnt > 0u ? cnt : 1u;
}

__device__ __forceinline__ void xcd_barrier(const XcdBarrier& b) {
    asm volatile("s_waitcnt vmcnt(0)" ::: "memory");
    __syncthreads();
    if (threadIdx.x == 0) {
        unsigned* bar = b.bar;
        __builtin_amdgcn_s_waitcnt(0);
        unsigned nloc = b.st[0], nx = b.st[1];
        if (nloc == 0u) { xcd_barrier_complete(bar, b.x, nloc, nx); b.st[0] = nloc; b.st[1] = nx; }
        const unsigned old = xb_add(&bar[XB_XSUB(b.x)], 1u);
        const unsigned gen = old / nloc;
        if (old + 1u == (gen + 1u) * nloc) {
            __builtin_amdgcn_fence(__ATOMIC_RELEASE, "agent");
            asm volatile("s_waitcnt vmcnt(0)" ::: "memory");
            const unsigned og = xb_add(&bar[XB_TOP], 1u);
            const unsigned tg = og / nx;
            if (og + 1u == (tg + 1u) * nx) xb_add(&bar[XB_TOPGEN], 1u);
            else XB_SPIN(xb_ld(&bar[XB_TOPGEN]) == tg, bar);
            __builtin_amdgcn_fence(__ATOMIC_ACQUIRE, "agent");
            xb_add(&bar[XB_XGEN(b.x)], 1u);
            asm volatile("s_waitcnt vmcnt(0)" ::: "memory");
        } else {
            XB_SPIN(xb_ld(&bar[XB_XGEN(b.x)]) == gen, bar);
            __builtin_amdgcn_fence(__ATOMIC_ACQUIRE, "agent");
            asm volatile("s_waitcnt vmcnt(0)" ::: "memory");
        }
    }
    __syncthreads();
}


DI void fast_grid_sync(unsigned* bar, unsigned target) {
    asm volatile("s_waitcnt vmcnt(0) lgkmcnt(0)" ::: "memory");
    __syncthreads();
    if (threadIdx.x == 0) {
        __builtin_amdgcn_fence(__ATOMIC_RELEASE, "agent");
        asm volatile("s_waitcnt vmcnt(0)" ::: "memory");
        __hip_atomic_fetch_add(bar, 1u, __ATOMIC_RELAXED, __HIP_MEMORY_SCOPE_AGENT);
        while (__hip_atomic_load(bar, __ATOMIC_RELAXED, __HIP_MEMORY_SCOPE_AGENT) < target) __builtin_amdgcn_s_sleep(2);
        __builtin_amdgcn_fence(__ATOMIC_ACQUIRE, "agent");
        asm volatile("s_waitcnt vmcnt(0)" ::: "memory");
    }
    __syncthreads();
}

__global__ void __launch_bounds__(512) fwd_megakernel(Params P) {
    extern __shared__ __attribute__((aligned(16))) char smem[];
    cg::grid_group grid = cg::this_grid();
    unsigned nbar = 0; (void)nbar;
    volatile XB_LAS unsigned* xst = (volatile XB_LAS unsigned*)(smem + LDS_BYTES - 16);
    if (threadIdx.x == 0) { xst[0] = 0u; xst[1] = 0u; }
    __syncthreads();
    const XcdBarrier xbar = xcd_barrier_post((unsigned*)(P.ws + OFF_BAR), xst);
#pragma unroll 1
    for (int ph = 0; ph < 21; ++ph) {
        float* ssq = (float*)(P.ws + OFF_SSQ);
        bf16_t* xb = (bf16_t*)(P.ws + OFF_XB);
        bf16_t* big = (bf16_t*)(P.ws + OFF_BIG);
        int nrep = 1;
        if (ph > 0) { const int s_ = (ph - 1) % 10; const int kind = (s_ == 3) ? 2 : (s_ == 6) ? 4 : 1; if (PROBE_MASK & kind) nrep = 2; }
        for (int rep = 0; rep < nrep; ++rep) {
        const bool dry = rep + 1 < nrep;
        if (ph == 0) {
            phase0(P, smem);
        } else {
            const int l = (ph - 1) / 10, s = (ph - 1) % 10;
            if (s == 3) {
                if (l == 0) attn_even_phase(P, smem, dry); else attn_odd_phase(P, smem, dry);
            } else if (s == 6) {
                xattn_phase(P, l, smem, dry);
            } else {
                pg8::Gemm g; pg8::Epi E;
                g.A = xb; g.lda = D; g.K = D; g.M = T; g.N = D; g.Bt = nullptr;
                E.mode = 1; E.rs = nullptr; E.O = big; E.ldo = D; E.xin = nullptr; E.xout = nullptr; E.xb = xb; E.ssq_out = ssq; E.alpha = 1.f;
                E.qg = nullptr; E.kg = nullptr; E.qn_end = 0; E.kn_beg = 0; E.kn_end = 0;
                if (s == 0 || s == 8) {
                    g.Bt = (const bf16_t*)(P.ws + (s == 0 ? OFF_GU1 : OFF_GU2) + (size_t)l * SZ_GU); g.N = NGU;
                    E.mode = 0; E.rs = ssq + (size_t)(4 * l + (s == 0 ? 0 : 3)) * T; E.ldo = DFF;
                } else if (s == 1 || s == 9) {
                    g.A = big; g.lda = DFF; g.K = DFF;
                    g.Bt = (const bf16_t*)(P.ws + (s == 1 ? OFF_DN1 : OFF_DN2) + (size_t)l * SZ_DN);
                    E.alpha = 0.5f; E.ssq_out = ssq + (size_t)(4 * l + (s == 1 ? 1 : 4)) * T;
                    if (ph == 2) E.xin = P.in[0];
                    if (ph == 20) { E.xout = P.out; E.ssq_out = nullptr; }
                } else if (s == 2) {
                    E.mode = 2; E.rs = ssq + (size_t)(4 * l + 1) * T;
                    if (l == 0) { g.Bt = (const bf16_t*)(P.ws + OFF_EVIN); g.N = 2304; E.ldo = 2304; E.qg = P.in[7]; E.kg = P.in[8]; E.qn_end = 512; E.kn_beg = 1024; E.kn_end = 1152; }
                    else { g.Bt = (const bf16_t*)(P.ws + OFF_ODIN); g.N = 3072; E.ldo = 3072; E.qg = P.in[12]; E.kg = P.in[13]; E.qn_end = 1024; E.kn_beg = 1024; E.kn_end = 2048; }
                } else if (s == 4) {
                    g.A = big;
                    if (l == 0) { g.Bt = (const bf16_t*)(P.ws + OFF_EVOUT); g.lda = 2304; }
                    else { g.Bt = (const bf16_t*)(P.ws + OFF_ODOUT); g.lda = 3072; }
                    E.ssq_out = ssq + (size_t)(4 * l + 2) * T;
                } else if (s == 5) {
                    g.Bt = (const bf16_t*)(P.ws + OFF_WQ + (size_t)l * SZ_MM); E.mode = 2; E.rs = ssq + (size_t)(4 * l + 2) * T; E.ldo = D;
                } else {
                    g.A = big; g.Bt = (const bf16_t*)(P.ws + OFF_WO + (size_t)l * SZ_MM); E.ssq_out = ssq + (size_t)(4 * l + 3) * T;
                }
                pg8::StaticOrder So; So.init(T, g.N, (int)gridDim.x, (int)blockIdx.x);
                E.dryrun = 0;
#if PROBE_GEMM
                for (int rep_ = 0; rep_ < 2; ++rep_) {
                pg8::Epi E2 = E;
                if (rep_ == 0) { if (PROBE_GEMM == 1) E2.dryrun = 1; else if (E.mode == 1) { E2.alpha = 0.f; } }
                __syncthreads();
                pg8::gemm_phase<pg8::Epi, pg8::StaticOrder, true, true>((PG8_LAS unsigned char*)smem, g, So, rep_ == 0 ? E2 : E);
                ++nbar; fast_grid_sync((unsigned*)(P.ws + OFF_BAR), nbar * gridDim.x);
                }
#else
                __syncthreads();
                pg8::gemm_phase<pg8::Epi, pg8::StaticOrder, true, true>((PG8_LAS unsigned char*)smem, g, So, E);
#endif
                if (ph == 1) {
                    GJob J;
                    J.A = xb; J.lda = D; J.ksplit = 1 << 30; J.kextra = 0; J.K = D; J.ntm = 4; J.mode = 3; J.rs = nullptr;
                    J.O = big; J.ldo = D; J.xin = P.out; J.xout = P.out; J.xb = xb; J.ssq_out = ssq; J.alpha = 1.f;
                    J.qg = nullptr; J.kg = nullptr; J.qn_end = 0; J.kn_end = 0; J.vt = nullptr; J.W = nullptr; J.ntn = 8;
                    gemm_phase(J, 0, 64, P, smem, false);
                }
                if (ph == 2 && !dry) knorm_phase(P);
            }
        }
        if (P.ws == nullptr) grid.sync();
        if (ph < 20) xcd_barrier(xbar);
        }
    }
}

extern "C" void kernel_launch(void* const* d_in, const int* in_sizes, int n_in, void* d_out, int out_size, void* d_ws, size_t ws_size,
                              hipStream_t stream) {
    static int grid_blocks = 0;
    if (!grid_blocks) {
        int dev = 0, cus = 0, per_cu = 0;
        hipGetDevice(&dev);
        hipDeviceGetAttribute(&cus, hipDeviceAttributeMultiprocessorCount, dev);
        hipFuncSetAttribute((const void*)fwd_megakernel, hipFuncAttributeMaxDynamicSharedMemorySize, LDS_BYTES);
        hipOccupancyMaxActiveBlocksPerMultiprocessor(&per_cu, fwd_megakernel, NTHR, LDS_BYTES);
        if (per_cu < 1) per_cu = 1;
        if (per_cu > 1) per_cu = 1;
        grid_blocks = cus * per_cu;
    }
    if (ws_size < WS_NEED) { fprintf(stderr, "workspace too small: %zu < %zu\n", ws_size, (size_t)WS_NEED); return; }
    Params p{};
    for (int i = 0; i < 25; ++i) p.in[i] = (const float*)d_in[i];
    p.out = (float*)d_out; p.ws = (char*)d_ws;
    hipMemsetAsync((char*)d_ws + OFF_BAR, 0, 16384, stream);
    void* args[] = {&p};
    hipError_t e = hipLaunchCooperativeKernel((void*)fwd_megakernel, dim3(grid_blocks), dim3(NTHR), args, LDS_BYTES, stream);
    if (e != hipSuccess) fprintf(stderr, "cooperative launch failed: %s (grid %d)\n", hipGetErrorString(e), grid_blocks);
}
```

```cpp
#include <hip/hip_runtime.h>
#include <hip/hip_cooperative_groups.h>
#include <cstdio>
#include <cstdint>
namespace cg = cooperative_groups;

#define DI __device__ __forceinline__
typedef unsigned short bf16_t;
typedef short bf16x8 __attribute__((ext_vector_type(8)));
typedef short s16x4 __attribute__((ext_vector_type(4)));
typedef float f32x16 __attribute__((ext_vector_type(16)));
typedef __bf16 bf2_t __attribute__((ext_vector_type(2)));
typedef float f2_t __attribute__((ext_vector_type(2)));
typedef short v4i16_t __attribute__((ext_vector_type(4)));
#define MFMA(a, b, c) __builtin_amdgcn_mfma_f32_32x32x16_bf16((a), (b), (c), 0, 0, 0)

constexpr int T = 16384, S = 4096, D = 1024, DFF = 2816, NGU = 5632;
constexpr float EPS = 1e-6f;
constexpr float LOG2E = 1.4426950408889634f;
constexpr float LN2 = 0.6931471805599453f;

constexpr size_t SZ_GU = (size_t)NGU * D * 2, SZ_DN = (size_t)D * DFF * 2, SZ_MM = (size_t)D * D * 2;
constexpr size_t OFF_GU1 = 0;
constexpr size_t OFF_DN1 = OFF_GU1 + 2 * SZ_GU;
constexpr size_t OFF_GU2 = OFF_DN1 + 2 * SZ_DN;
constexpr size_t OFF_DN2 = OFF_GU2 + 2 * SZ_GU;
constexpr size_t OFF_WQ = OFF_DN2 + 2 * SZ_DN;
constexpr size_t OFF_WKV = OFF_WQ + 2 * SZ_MM;
constexpr size_t OFF_WO = OFF_WKV + 4 * SZ_MM;
constexpr size_t OFF_EVIN = OFF_WO + 2 * SZ_MM;
constexpr size_t OFF_EVOUT = OFF_EVIN + (size_t)2304 * D * 2;
constexpr size_t OFF_ODIN = OFF_EVOUT + SZ_MM;
constexpr size_t OFF_ODOUT = OFF_ODIN + (size_t)3072 * D * 2;
constexpr size_t OFF_XB = OFF_ODOUT + SZ_MM;
constexpr size_t OFF_BIG = OFF_XB + (size_t)T * D * 2;
constexpr size_t OFF_MEMB = OFF_BIG + (size_t)T * 3072 * 2;
constexpr size_t OFF_KN = OFF_MEMB + SZ_MM;
constexpr size_t OFF_VT = OFF_KN + 2 * SZ_MM;
constexpr size_t OFF_SSQ = OFF_VT + 2 * SZ_MM;
constexpr size_t OFF_SSQM = OFF_SSQ + (size_t)9 * T * 4;
constexpr size_t OFF_KMAX = OFF_SSQM + 4096;
constexpr size_t OFF_BAR = OFF_KMAX + 256;
constexpr size_t OFF_KF = OFF_BAR + 16384;
constexpr size_t WS_NEED = OFF_KF + 2 * SZ_MM;

#ifndef PROBE_MASK
#define PROBE_MASK 0
#endif
#ifndef PROBE_GEMM
#define PROBE_GEMM 0
#endif
constexpr int NTHR = 512;
constexpr int NST = 4;
constexpr int STAGE_B = 32768;
constexpr int OPB = 16384;
constexpr int LDS_BYTES = 147712;

struct Params { const float* in[25]; float* out; char* ws; };

DI unsigned pk2(float a, float b) { f2_t v = {a, b}; bf2_t r = __builtin_convertvector(v, bf2_t); return __builtin_bit_cast(unsigned, r); }
typedef unsigned v4u_t __attribute__((ext_vector_type(4)));
DI __amdgpu_buffer_rsrc_t wt_rsrc(const void* base, size_t bytes) { return __builtin_amdgcn_make_buffer_rsrc((void*)base, (short)0, (int)bytes, 0x00020000); }
DI void st16_wt(__amdgpu_buffer_rsrc_t r, size_t byteoff, uint4 v) { const v4u_t x = {v.x, v.y, v.z, v.w}; __builtin_amdgcn_raw_buffer_store_b128(x, r, (unsigned)byteoff, 0, 16); }
DI void st16f_wt(__amdgpu_buffer_rsrc_t r, size_t byteoff, float4 v) { const v4u_t x = {__float_as_uint(v.x), __float_as_uint(v.y), __float_as_uint(v.z), __float_as_uint(v.w)}; __builtin_amdgcn_raw_buffer_store_b128(x, r, (unsigned)byteoff, 0, 16); }
DI float bflo(unsigned w) { return __uint_as_float(w << 16); }
DI float bfhi(unsigned w) { return __uint_as_float(w & 0xffff0000u); }
DI int otid() { int t = threadIdx.x; asm volatile("" : "+v"(t)); return t; }
DI int crow(int i, int h) { return (i & 3) + 8 * (i >> 2) + 4 * h; }
DI float fexp2(float x) { return __builtin_amdgcn_exp2f(x); }
DI float flog2(float x) { return __builtin_amdgcn_logf(x); }

struct WJob { const float* src; bf16_t* dst; const float* gain; int K, N, gu; };

DI int wjob_tiles(int j) {
    if (j < 14) {
        const int kind = j >> 1;
        switch (kind) {
            case 0: case 2: return 16 * 88;
            case 1: case 3: return 44 * 16;
            case 4: return 256;
            case 5: return 512;
            default: return 256;
        }
    }
    if (j == 14) return 16 * 36;
    if (j == 16) return 16 * 48;
    return 256;
}

DI WJob get_wjob(const Params& P, int j) {
    WJob w; w.gain = nullptr; w.gu = 0;
    bf16_t* wsb = (bf16_t*)P.ws;
    if (j < 14) {
        const int kind = j >> 1, l = j & 1;
        switch (kind) {
            case 0: w.src = P.in[3] + (size_t)l * D * NGU; w.dst = (bf16_t*)(P.ws + OFF_GU1 + l * SZ_GU); w.gain = P.in[2] + l * D; w.K = D; w.N = NGU; w.gu = 1; break;
            case 1: w.src = P.in[4] + (size_t)l * DFF * D; w.dst = (bf16_t*)(P.ws + OFF_DN1 + l * SZ_DN); w.K = DFF; w.N = D; w.gu = 2; break;
            case 2: w.src = P.in[23] + (size_t)l * D * NGU; w.dst = (bf16_t*)(P.ws + OFF_GU2 + l * SZ_GU); w.gain = P.in[22] + l * D; w.K = D; w.N = NGU; w.gu = 1; break;
            case 3: w.src = P.in[24] + (size_t)l * DFF * D; w.dst = (bf16_t*)(P.ws + OFF_DN2 + l * SZ_DN); w.K = DFF; w.N = D; w.gu = 2; break;
            case 4: w.src = P.in[17] + (size_t)l * D * D; w.dst = (bf16_t*)(P.ws + OFF_WQ + l * SZ_MM); w.gain = P.in[15] + l * D; w.K = D; w.N = D; w.gu = 2; break;
            case 5: w.src = P.in[18] + (size_t)l * D * 2048; w.dst = (bf16_t*)(P.ws + OFF_WKV + l * 2 * SZ_MM); w.gain = P.in[16] + l * D; w.K = D; w.N = 2048; break;
            default: w.src = P.in[21] + (size_t)l * D * D; w.dst = (bf16_t*)(P.ws + OFF_WO + l * SZ_MM); w.K = D; w.N = D; w.gu = 2; break;
        }
    } else if (j == 14) { w.src = P.in[6]; w.dst = (bf16_t*)(P.ws + OFF_EVIN); w.gain = P.in[5]; w.K = D; w.N = 2304; w.gu = 3; }
    else if (j == 15) { w.src = P.in[10]; w.dst = (bf16_t*)(P.ws + OFF_EVOUT); w.K = D; w.N = D; w.gu = 2; }
    else if (j == 16) { w.src = P.in[11]; w.dst = (bf16_t*)(P.ws + OFF_ODIN); w.gain = P.in[5] + D; w.K = D; w.N = 3072; w.gu = 2; }
    else { w.src = P.in[14]; w.dst = (bf16_t*)(P.ws + OFF_ODOUT); w.K = D; w.N = D; w.gu = 2; }
    (void)wsb;
    return w;
}

DI void wconv_tile(const WJob& w, int t, float* sm, int tid, bool act) {
    const int ntn = w.N >> 6; const int tk = t / ntn, tn = t - tk * ntn;
    if (act) {
#pragma unroll
        for (int p = 0; p < 4; ++p) {
            const int kr = p * 16 + (tid >> 4);
            typedef float f32x4nt __attribute__((ext_vector_type(4)));
            const f32x4nt v = __builtin_nontemporal_load((const f32x4nt*)(w.src + (size_t)(tk * 64 + kr) * w.N + tn * 64 + (tid & 15) * 4));
            const float g = w.gain ? w.gain[tk * 64 + kr] : 1.f;
            float* sp = sm + kr * 65 + (tid & 15) * 4;
            sp[0] = v[0] * g; sp[1] = v[1] * g; sp[2] = v[2] * g; sp[3] = v[3] * g;
        }
    }
    __syncthreads();
    if (act) {
        const int n = tid >> 2, kq = tid & 3; const int ng = tn * 64 + n;
        int drow = ng;
        if (w.gu == 1) drow = ng < DFF ? ((ng >> 7) * 256 + (ng & 127)) : (((ng - DFF) >> 7) * 256 + 128 + ((ng - DFF) & 127));
        else if (w.gu >= 2) {
            int a = ng;
            if (w.gu == 3) a = ng < 512 ? ng : ng < 768 ? ng + 512 : ng < 1280 ? ng - 256 : ng;
            drow = (a & ~255) + (((a >> 5) & 1) << 7) + (((a >> 6) & 3) << 5) + (a & 31);
        }
        unsigned o[8];
#pragma unroll
        for (int e = 0; e < 8; ++e) o[e] = pk2(sm[(kq * 16 + 2 * e) * 65 + n], sm[(kq * 16 + 2 * e + 1) * 65 + n]);
        uint4* dp = (uint4*)(w.dst + (size_t)drow * w.K + tk * 64 + kq * 16);
        dp[0] = make_uint4(o[0], o[1], o[2], o[3]); dp[1] = make_uint4(o[4], o[5], o[6], o[7]);
    }
    __syncthreads();
}

DI float wave_sum(float v) {
    v += __shfl_xor(v, 1); v += __shfl_xor(v, 2); v += __shfl_xor(v, 4); v += __shfl_xor(v, 8); v += __shfl_xor(v, 16); v += __shfl_xor(v, 32);
    return v;
}

DI void rowconv(const float* src, bf16_t* dst, float* ssq, int row, int lane) {
    const float* xr = src + (size_t)row * D;
    float ss = 0.f;
#pragma unroll
    for (int p = 0; p < 4; ++p) {
        const float4 v = *(const float4*)(xr + p * 256 + lane * 4);
        ss += v.x * v.x + v.y * v.y + v.z * v.z + v.w * v.w;
        *(uint2*)(dst + (size_t)row * D + p * 256 + lane * 4) = make_uint2(pk2(v.x, v.y), pk2(v.z, v.w));
    }
    ss = wave_sum(ss);
    if (lane == 0) ssq[row] = ss;
}

DI void phase0(const Params& P, char* smem) {
    const int tid = otid(), lane = tid & 63, wid = tid >> 6;
    float* ssq = (float*)(P.ws + OFF_SSQ);
    for (int i = blockIdx.x * NTHR + tid; i < 8 * T; i += gridDim.x * NTHR) ssq[T + i] = 0.f;
    if (blockIdx.x == 0 && tid < 32) ((unsigned*)(P.ws + OFF_KMAX))[tid] = 0u;
    constexpr int NW = 12352 / 2, NX = T / 8, NM = 1024 / 8;
    for (int u = blockIdx.x; u < NW + NX + NM; u += gridDim.x) {
        if (u < NW) {
            const int half = tid >> 8;
            int t = 2 * u + half, j = 0;
            for (; j < 17; ++j) { const int c = wjob_tiles(j); if (t < c) break; t -= c; }
            const WJob w = get_wjob(P, j);
            wconv_tile(w, t, (float*)smem + half * (64 * 65), tid & 255, true);
        } else if (u < NW + NX) {
            rowconv(P.in[0], (bf16_t*)(P.ws + OFF_XB), ssq, (u - NW) * 8 + wid, lane);
        } else {
            rowconv(P.in[1], (bf16_t*)(P.ws + OFF_MEMB), (float*)(P.ws + OFF_SSQM), (u - NW - NX) * 8 + wid, lane);
        }
    }
}

struct GJob {
    const bf16_t* A; const bf16_t* W;
    int lda, ksplit, kextra, K, ntm, ntn, mode;
    const float* rs;
    bf16_t* O; int ldo;
    const float* xin; float* xout; bf16_t* xb; float* ssq_out; float alpha;
    const float* qg; const float* kg; int qn_end, kn_end;
    bf16_t* vt;
};

typedef __attribute__((address_space(3))) unsigned* ldsu_t;
typedef const __attribute__((address_space(1))) unsigned* glbu_t;
DI void glds16(const bf16_t* g, char* l) { __builtin_amdgcn_global_load_lds((glbu_t)(const void*)g, (ldsu_t)(void*)l, 16, 0, 0); }

DI void gemm_tile(const GJob& J, int t, char* smem, bool dry) {
    const int tid = otid(), lane = tid & 63, wid = tid >> 6, wr = wid >> 2, wc = wid & 3;
    const int r = lane & 31, h = lane >> 5;
    int tm, tn;
    { const int gsz = 32 * J.ntn; const int g = t / gsz; const int rem = t - g * gsz; const int rows = min(32, J.ntm - g * 32); tn = rem / rows; tm = g * 32 + (rem - tn * rows); }
    const int lrow = wid * 16 + (lane >> 2);
    const int csw = ((lane & 3) ^ ((lane >> 4) & 3)) * 8;
    const bf16_t* Ag = J.A + (size_t)(tm * 256 + lrow) * J.lda + csw;
    const bf16_t* Wg = J.W + (size_t)(tn * 256 + lrow) * J.K + csw;
    const size_t astr = (size_t)128 * J.lda, wstr = (size_t)128 * J.K;
    char* lb = smem + tid * 16;
    const int nk = J.K >> 5;
#define GLDS(kt, buf) do { const int k0_ = (kt) * 32; const int ka_ = k0_ + (k0_ >= J.ksplit ? J.kextra : 0); char* l_ = lb + (buf) * STAGE_B; \
        glds16(Ag + ka_, l_); glds16(Ag + astr + ka_, l_ + 8192); glds16(Wg + k0_, l_ + OPB); glds16(Wg + wstr + k0_, l_ + OPB + 8192); } while (0)
    f32x16 acc[4][2];
#pragma unroll
    for (int a = 0; a < 4; ++a)
#pragma unroll
        for (int b = 0; b < 2; ++b)
#pragma unroll
            for (int i = 0; i < 16; ++i) acc[a][b][i] = 0.f;
    const int fr = (r >> 2) & 3;
    const int xrow = (wc * 64 + r) * 64, wrow = OPB + (wr * 128 + r) * 64;
    const int co0 = ((0 + h) ^ fr) * 16, co1 = ((2 + h) ^ fr) * 16;

    __syncthreads();
    GLDS(0, 0); GLDS(1, 1); GLDS(2, 2);
    asm volatile("s_waitcnt vmcnt(8)" ::: "memory");
    __builtin_amdgcn_s_barrier();
    bf16x8 w0[4], x0[2], w1[4], x1[2];
#define LOADF(W_, X_, sb_, co_) do { _Pragma("unroll") for (int ti = 0; ti < 2; ++ti) X_[ti] = *(const bf16x8*)((sb_) + xrow + ti * 2048 + (co_)); \
        _Pragma("unroll") for (int fi = 0; fi < 4; ++fi) W_[fi] = *(const bf16x8*)((sb_) + wrow + fi * 2048 + (co_)); } while (0)
#define MFMA8(W_, X_) do { __builtin_amdgcn_s_setprio(1); _Pragma("unroll") for (int fi = 0; fi < 4; ++fi) _Pragma("unroll") for (int ti = 0; ti < 2; ++ti) \
        acc[fi][ti] = MFMA(W_[fi], X_[ti], acc[fi][ti]); __builtin_amdgcn_s_setprio(0); } while (0)
    LOADF(w0, x0, smem, co0);
    __builtin_amdgcn_s_waitcnt(0xC07F);
    int buf = 0;
    for (int kt = 0; kt < nk; ++kt) {
        const char* sb = smem + buf * STAGE_B;
        LOADF(w1, x1, sb, co1);
        __builtin_amdgcn_sched_barrier(0);
        MFMA8(w0, x0);
        __builtin_amdgcn_s_waitcnt(0xC07F);
        __builtin_amdgcn_sched_barrier(0);
        const int nb = (buf + 1 == NST) ? 0 : buf + 1;
        if (kt + 1 < nk) {
            if (kt + 2 < nk) asm volatile("s_waitcnt vmcnt(4)" ::: "memory"); else asm volatile("s_waitcnt vmcnt(0)" ::: "memory");
            __builtin_amdgcn_s_barrier();
            if (kt + 3 < nk) { const int fb_ = (buf + 3 >= NST) ? buf + 3 - NST : buf + 3; GLDS(kt + 3, fb_); }
        }
        LOADF(w0, x0, smem + nb * STAGE_B, co0);
        __builtin_amdgcn_sched_barrier(0);
        MFMA8(w1, x1);
        __builtin_amdgcn_s_waitcnt(0xC07F);
        __builtin_amdgcn_sched_barrier(0);
        buf = nb;
    }
#undef LOADF
#undef MFMA8
#undef GLDS
    __syncthreads();

    if (dry) { if (acc[0][0][0] + acc[1][1][0] + acc[2][0][0] + acc[3][1][0] == 12345.678f) J.O[0] = 1; return; }
    const int tokb = tm * 256 + wc * 64;
    const int fb = tn * 256 + wr * 128;
    float rsc[2];
#pragma unroll
    for (int ti = 0; ti < 2; ++ti) rsc[ti] = J.rs ? __builtin_amdgcn_rsqf(J.rs[tokb + ti * 32 + r] * (1.f / 1024.f) + EPS) : 1.f;

    if (J.mode == 3 && fb >= 1024) {
#pragma unroll
        for (int ti = 0; ti < 2; ++ti) {
            const int tok = tokb + ti * 32 + r;
#pragma unroll
            for (int fi = 0; fi < 4; ++fi)
#pragma unroll
                for (int i = 0; i < 16; ++i) {
                    const int f = fb - 1024 + fi * 32 + crow(i, h);
                    const int bh_ = (tok >> 8) * 4 + (f >> 8), d_ = f & 255, key_ = tok & 255, k16 = key_ & 15;
                    const int ln_ = ((k16 >> 2) & 1) * 32 + (d_ & 31), e_ = ((k16 >> 3) << 2) | (k16 & 3);
                    J.vt[((((((size_t)bh_ * 8 + (d_ >> 5)) * 8 + (key_ >> 5)) * 2 + ((key_ >> 4) & 1)) * 64 + ln_) << 3) + e_] = (bf16_t)(pk2(acc[fi][ti][i] * rsc[ti], 0.f) & 0xffffu);
                }
        }
        return;
    }
    char* wl = smem + wid * 16384;
#pragma unroll
    for (int ti = 0; ti < 2; ++ti) {
#pragma unroll
        for (int fp = 0; fp < 2; ++fp) {
            const float sc = (J.mode == 1) ? J.alpha : rsc[ti];
#pragma unroll
            for (int fi2 = 0; fi2 < 2; ++fi2)
#pragma unroll
                for (int g = 0; g < 4; ++g) {
                    float4 v;
                    v.x = acc[2 * fp + fi2][ti][4 * g + 0] * sc; v.y = acc[2 * fp + fi2][ti][4 * g + 1] * sc;
                    v.z = acc[2 * fp + fi2][ti][4 * g + 2] * sc; v.w = acc[2 * fp + fi2][ti][4 * g + 3] * sc;
                    *(float4*)(wl + r * 272 + (fi2 * 32 + 8 * g + 4 * h) * 4) = v;
                }
            const int tok0 = tokb + ti * 32, f0 = fb + fp * 64;
            if (J.mode == 0) {
                const int c4 = (lane & 7) * 4;
#pragma unroll
                for (int p = 0; p < 4; ++p) {
                    const int row = p * 8 + (lane >> 3);
                    const float4 ga = *(const float4*)(wl + row * 272 + c4 * 4);
                    const float4 up = *(const float4*)(wl + row * 272 + (32 + c4) * 4);
                    float y0 = ga.x * up.x * __builtin_amdgcn_rcpf(1.f + fexp2(-ga.x * LOG2E));
                    float y1 = ga.y * up.y * __builtin_amdgcn_rcpf(1.f + fexp2(-ga.y * LOG2E));
                    float y2 = ga.z * up.z * __builtin_amdgcn_rcpf(1.f + fexp2(-ga.z * LOG2E));
                    float y3 = ga.w * up.w * __builtin_amdgcn_rcpf(1.f + fexp2(-ga.w * LOG2E));
                    *(uint2*)(J.O + (size_t)(tok0 + row) * J.ldo + (f0 >> 1) + c4) = make_uint2(pk2(y0, y1), pk2(y2, y3));
                }
            } else if (J.mode == 1) {
                const int c4 = (lane & 15) * 4;
#pragma unroll
                for (int p = 0; p < 8; ++p) {
                    const int row = p * 4 + (lane >> 4);
                    const size_t tok = tok0 + row;
                    const float4 v = *(const float4*)(wl + row * 272 + c4 * 4);
                    const float4 xo = *(const float4*)(J.xin + tok * D + f0 + c4);
                    float4 xn; xn.x = xo.x + v.x; xn.y = xo.y + v.y; xn.z = xo.z + v.z; xn.w = xo.w + v.w;
                    *(float4*)(J.xout + tok * D + f0 + c4) = xn;
                    if (J.xb) {
                        *(uint2*)(J.xb + tok * D + f0 + c4) = make_uint2(pk2(xn.x, xn.y), pk2(xn.z, xn.w));
                        float ss = xn.x * xn.x + xn.y * xn.y + xn.z * xn.z + xn.w * xn.w;
                        ss += __shfl_xor(ss, 1); ss += __shfl_xor(ss, 2); ss += __shfl_xor(ss, 4); ss += __shfl_xor(ss, 8);
                        if ((lane & 15) == 0) atomicAdd(J.ssq_out + tok, ss);
                    }
                }
            } else {
                const int nm = f0 < J.qn_end ? 1 : (f0 < J.kn_end ? 2 : 0);
                const float* gp = nm == 1 ? J.qg : J.kg;
                const int c4 = (lane & 15) * 4;
                float4 gn = make_float4(1.f, 1.f, 1.f, 1.f);
                if (nm) gn = *(const float4*)(gp + c4);
#pragma unroll
                for (int p = 0; p < 8; ++p) {
                    const int row = p * 4 + (lane >> 4);
                    float4 v = *(const float4*)(wl + row * 272 + c4 * 4);
                    if (nm) {
                        float ss = v.x * v.x + v.y * v.y + v.z * v.z + v.w * v.w;
                        ss += __shfl_xor(ss, 1); ss += __shfl_xor(ss, 2); ss += __shfl_xor(ss, 4); ss += __shfl_xor(ss, 8);
                        const float inv = __builtin_amdgcn_rsqf(ss * (1.f / 64.f) + EPS);
                        v.x *= inv * gn.x; v.y *= inv * gn.y; v.z *= inv * gn.z; v.w *= inv * gn.w;
                    }
                    *(uint2*)(J.O + (size_t)(tok0 + row) * J.ldo + f0 + c4) = make_uint2(pk2(v.x, v.y), pk2(v.z, v.w));
                }
            }
        }
    }
}

DI void gemm_phase(const GJob& JA, int nA, int nB, const Params& P, char* smem, bool dry) {
    for (int u = (int)gridDim.x - 1 - (int)blockIdx.x; u < nA + nB; u += gridDim.x) {
        GJob J = JA; int t = u;
        if (u >= nA) {
            const int v = u - nA; const int layer = v >> 5; t = v & 31;
            J.A = (const bf16_t*)(P.ws + OFF_MEMB); J.lda = D; J.ksplit = 1 << 30; J.kextra = 0;
            J.W = (const bf16_t*)(P.ws + OFF_WKV + (size_t)layer * 2 * SZ_MM); J.K = D; J.ntm = 4; J.ntn = 8; J.mode = 3;
            J.rs = (const float*)(P.ws + OFF_SSQM); J.O = (bf16_t*)(P.ws + OFF_KN + (size_t)layer * SZ_MM); J.ldo = D;
            J.qn_end = 0; J.kn_end = 0; J.vt = (bf16_t*)(P.ws + OFF_VT + (size_t)layer * SZ_MM);
        }
        gemm_tile(J, t, smem, dry);
    }
}

namespace pg8 {
#define PG8_LAS __attribute__((address_space(3)))
typedef float f32x4 __attribute__((ext_vector_type(4)));
typedef unsigned u32x4 __attribute__((ext_vector_type(4)));
constexpr int BM = 256, BK = 64, HALF = 128, HTB = HALF * BK * 2, STAGE_BYTES = 8 * HTB, NXCD = 8, WGM = 8;
DI int lds_byte(int r, int c) { const int st = (r >> 4) * 2 + (c >> 5), rr = r & 15, cc = c & 31, ob = rr * 64 + cc * 2; return st * 1024 + (ob ^ (((ob >> 9) & 1) << 5)); }
DI void stage_rc(int b, int& R, int& C) { const int st = b / 1024, sb = b % 1024, swz = sb ^ (((sb >> 9) & 1) << 5); R = (st >> 1) * 16 + swz / 64; C = (st & 1) * 32 + (swz % 64) / 2; }
DI int perm32(int rho) { const int n = rho >> 4, i = rho & 15; return 8 * (i >> 2) + 4 * n + (i & 3); }
struct Unit { int pm, pn; };
struct Gemm { const bf16_t* A; const bf16_t* Bt; int M, N, K, lda; };
struct StaticOrder {
    int nM, nN, nwg, G, c;
    DI void init(int M, int N, int G_, int c_) { nM = M / BM; nN = N / BM; nwg = nM * nN; G = G_; c = c_; }
    DI bool next(int i, Unit& u) const {
        const long L = (long)i * G + c; if (L >= nwg) return false;
        int wgid = (int)L; { const int q = nwg / NXCD, r = nwg % NXCD, xcd = wgid % NXCD, off = wgid / NXCD; wgid = (xcd < r ? xcd * (q + 1) : r * (q + 1) + (xcd - r) * q) + off; }
        const int nig = WGM * nN, gid = wgid / nig, fm = gid * WGM, gsz = (nM - fm) < WGM ? (nM - fm) : WGM;
        u.pm = fm + ((wgid % nig) % gsz); u.pn = (wgid % nig) / gsz; return true;
    }
    DI void a_ready(const Unit&) const {}
    DI void done(const Unit&) const {}
};

struct Epi {
    static constexpr bool PERM = true, AFTER_DRAIN = false;
    int mode;
    const float* rs;
    bf16_t* O; int ldo;
    const float* xin; float* xout; bf16_t* xb; float* ssq_out; float alpha;
    const float* qg; const float* kg; int qn_end, kn_beg, kn_end; int dryrun;
    template <bool SRC_F32, bool DST_F32>
    DI void res_path(const f32x4 (&acc)[2][2][4][2], int row0, int colb, int fq) const {
        const __amdgpu_buffer_rsrc_t r_xb = wt_rsrc(xb, (size_t)T * D * 2), r_out = wt_rsrc(DST_F32 ? (const void*)xout : (const void*)xb, (size_t)T * D * (DST_F32 ? 4 : 2));
#pragma unroll
        for (int ai = 0; ai < 2; ++ai) {
            float4 xf[4][2][2];
            uint4 xw[4][2];
#pragma unroll
            for (int m = 0; m < 4; ++m)
#pragma unroll
                for (int bj = 0; bj < 2; ++bj) {
                    const size_t off = (size_t)(row0 + ai * HALF + m * 16) * D + colb + bj * 32;
                    if (SRC_F32) { xf[m][bj][0] = *(const float4*)(xin + off); xf[m][bj][1] = *(const float4*)(xin + off + 4); }
                    else xw[m][bj] = *(const uint4*)(xb + off);
                }
#pragma unroll
            for (int m = 0; m < 4; ++m) {
                const size_t tok = row0 + ai * HALF + m * 16;
                float ss = 0.f;
#pragma unroll
                for (int bj = 0; bj < 2; ++bj) {
                    const size_t off = tok * D + colb + bj * 32;
                    float4 x0, x1;
                    if (SRC_F32) { x0 = xf[m][bj][0]; x1 = xf[m][bj][1]; }
                    else { const uint4 w = xw[m][bj]; x0 = make_float4(bflo(w.x), bfhi(w.x), bflo(w.y), bfhi(w.y)); x1 = make_float4(bflo(w.z), bfhi(w.z), bflo(w.w), bfhi(w.w)); }
                    float4 n0, n1;
                    n0.x = x0.x + alpha * acc[ai][bj][m][0][0]; n0.y = x0.y + alpha * acc[ai][bj][m][0][1]; n0.z = x0.z + alpha * acc[ai][bj][m][0][2]; n0.w = x0.w + alpha * acc[ai][bj][m][0][3];
                    n1.x = x1.x + alpha * acc[ai][bj][m][1][0]; n1.y = x1.y + alpha * acc[ai][bj][m][1][1]; n1.z = x1.z + alpha * acc[ai][bj][m][1][2]; n1.w = x1.w + alpha * acc[ai][bj][m][1][3];
                    if (DST_F32) { st16f_wt(r_out, off * 4, n0); st16f_wt(r_out, off * 4 + 16, n1); }
                    else {
                        const uint4 w = make_uint4(pk2(n0.x, n0.y), pk2(n0.z, n0.w), pk2(n1.x, n1.y), pk2(n1.z, n1.w));
                        st16_wt(r_xb, off * 2, w);
                        const float r0 = bflo(w.x), r1 = bfhi(w.x), r2 = bflo(w.y), r3 = bfhi(w.y), r4 = bflo(w.z), r5 = bfhi(w.z), r6 = bflo(w.w), r7 = bfhi(w.w);
                        ss += r0 * r0 + r1 * r1 + r2 * r2 + r3 * r3 + r4 * r4 + r5 * r5 + r6 * r6 + r7 * r7;
                    }
                }
                if (!DST_F32) {
                    ss += __shfl_xor(ss, 16); ss += __shfl_xor(ss, 32);
                    if (fq == 0) atomicAdd(ssq_out + tok, ss);
                }
            }
        }
    }
    template <bool NM>
    DI void qkv_path(const f32x4 (&acc)[2][2][4][2], int row0, int f0, int fq, const float* gp) const {
        const __amdgpu_buffer_rsrc_t r_o = wt_rsrc(O, (size_t)T * ldo * 2);
        float4 g4[2][2];
#pragma unroll
        for (int bj = 0; bj < 2; ++bj)
#pragma unroll
            for (int n = 0; n < 2; ++n) g4[bj][n] = NM ? *(const float4*)(gp + bj * 32 + 8 * fq + 4 * n) : make_float4(1.f, 1.f, 1.f, 1.f);
        float sc8[2][4];
#pragma unroll
        for (int ai = 0; ai < 2; ++ai)
#pragma unroll
            for (int m = 0; m < 4; ++m) sc8[ai][m] = rs[row0 + ai * HALF + m * 16];
#pragma unroll
        for (int ai = 0; ai < 2; ++ai)
#pragma unroll
            for (int m = 0; m < 4; ++m) {
                const size_t tok = row0 + ai * HALF + m * 16;
                float sc = __builtin_amdgcn_rsqf(sc8[ai][m] * (1.f / 1024.f) + EPS);
                if (NM) {
                    float ss = 0.f;
#pragma unroll
                    for (int bj = 0; bj < 2; ++bj)
#pragma unroll
                        for (int n = 0; n < 2; ++n)
#pragma unroll
                            for (int j = 0; j < 4; ++j) { const float v = acc[ai][bj][m][n][j] * sc; ss += v * v; }
                    ss += __shfl_xor(ss, 16); ss += __shfl_xor(ss, 32);
                    sc *= __builtin_amdgcn_rsqf(ss * (1.f / 64.f) + EPS);
                }
#pragma unroll
                for (int bj = 0; bj < 2; ++bj) {
                    const f32x4 a0 = acc[ai][bj][m][0], a1 = acc[ai][bj][m][1];
                    st16_wt(r_o, (tok * ldo + f0 + bj * 32 + 8 * fq) * 2,
                        make_uint4(pk2(a0[0] * sc * g4[bj][0].x, a0[1] * sc * g4[bj][0].y), pk2(a0[2] * sc * g4[bj][0].z, a0[3] * sc * g4[bj][0].w),
                                   pk2(a1[0] * sc * g4[bj][1].x, a1[1] * sc * g4[bj][1].y), pk2(a1[2] * sc * g4[bj][1].z, a1[3] * sc * g4[bj][1].w)));
                }
            }
    }
    DI void operator()(const f32x4 (&acc)[2][2][4][2], const Unit& u, int wr, int wc, int fr, int fq) const {
        if (dryrun) { if (acc[0][0][0][0][0] + acc[1][1][3][1][3] + acc[0][1][2][0][1] + acc[1][0][1][1][2] == 12345.678f) O[0] = 1; return; }
        const int row0 = u.pm * BM + wr * 64 + fr;
        if (mode == 0) {
            const int col = u.pn * 128 + wc * 32 + 8 * fq;
            const __amdgpu_buffer_rsrc_t r_o = wt_rsrc(O, (size_t)T * ldo * 2);
            float sc8[2][4];
#pragma unroll
            for (int ai = 0; ai < 2; ++ai)
#pragma unroll
                for (int m = 0; m < 4; ++m) sc8[ai][m] = rs[row0 + ai * HALF + m * 16];
#pragma unroll
            for (int ai = 0; ai < 2; ++ai)
#pragma unroll
                for (int m = 0; m < 4; ++m) {
                    const size_t tok = row0 + ai * HALF + m * 16;
                    const float sc = __builtin_amdgcn_rsqf(sc8[ai][m] * (1.f / 1024.f) + EPS);
                    float y[8];
#pragma unroll
                    for (int n = 0; n < 2; ++n)
#pragma unroll
                        for (int j = 0; j < 4; ++j) {
                            const float ga = acc[ai][0][m][n][j] * sc, up = acc[ai][1][m][n][j] * sc;
                            y[4 * n + j] = ga * up * __builtin_amdgcn_rcpf(1.f + fexp2(-ga * LOG2E));
                        }
                    st16_wt(r_o, (tok * ldo + col) * 2, make_uint4(pk2(y[0], y[1]), pk2(y[2], y[3]), pk2(y[4], y[5]), pk2(y[6], y[7])));
                }
        } else if (mode == 1) {
            const int colb = u.pn * BM + wc * 64 + 8 * fq;
            if (xin) res_path<true, false>(acc, row0, colb, fq);
            else if (xout) res_path<false, true>(acc, row0, colb, fq);
            else res_path<false, false>(acc, row0, colb, fq);
        } else {
            const int f0 = u.pn * BM + wc * 64;
            const int nm = f0 < qn_end ? 1 : ((f0 >= kn_beg && f0 < kn_end) ? 2 : 0);
            if (nm) qkv_path<true>(acc, row0, f0, fq, nm == 1 ? qg : kg);
            else qkv_path<false>(acc, row0, f0, fq, nullptr);
        }
    }
};

template <class Epi, class Sched, bool ALIGN_EPI = false, bool SP2 = false>
__device__ __forceinline__ void gemm_phase(PG8_LAS unsigned char* lds, const Gemm g, const Sched& S, const Epi& E) {
    const int tid = otid(), wid = __builtin_amdgcn_readfirstlane(tid >> 6), lane = tid & 63, wr = wid >> 2, wc = wid & 3, fr = lane & 15, fq = lane >> 4;
    const int K = g.K, nt = K / BK;
    unsigned voffA[2], voffB[2];
#pragma unroll
    for (int i = 0; i < 2; ++i) { int R, C; stage_rc(tid * 16 + i * 8192, R, C); const int Rb = Epi::PERM ? ((R & ~31) + perm32(R & 31)) : R;
        voffA[i] = (unsigned)(R * g.lda + C) * 2u; voffB[i] = (unsigned)(Rb * K + C) * 2u; }
    const size_t kstep = (size_t)(BK * 2);
    const size_t hstepA = (size_t)HALF * g.lda * 2, hstepB = (size_t)HALF * K * 2;
    const size_t tstepA = 2 * hstepA, tstepB = 2 * hstepB;
    const unsigned ldsw = (unsigned)wid * 1024u;
    const int aoff = lds_byte(wr * 64 + fr, fq * 8), boff = lds_byte(wc * 32 + fr, fq * 8);
#define PG8_SA(b, h) (((b) * 2 + (h)) * HTB)
#define PG8_SB(b, h) ((4 + (b) * 2 + (h)) * HTB)
#define PG8_STAGE(bufoff, gbase, voff) do { _Pragma("unroll") for (int _i = 0; _i < 2; ++_i) \
        __builtin_amdgcn_global_load_lds((const unsigned*)((const char*)(gbase) + (voff)[_i]), (PG8_LAS unsigned*)(lds + (bufoff) + ldsw + _i * 8192), 16, 0, 0); } while (0)
#define PG8_LDA(dst, b, h) do { _Pragma("unroll") for (int m = 0; m < 4; ++m) _Pragma("unroll") for (int k = 0; k < 2; ++k) dst[m][k] = *(const PG8_LAS bf16x8*)(lds + PG8_SA(b, h) + aoff + m * 2048 + k * 1024); } while (0)
#define PG8_LDB(dst, b, h) do { _Pragma("unroll") for (int n = 0; n < 2; ++n) _Pragma("unroll") for (int k = 0; k < 2; ++k) dst[n][k] = *(const PG8_LAS bf16x8*)(lds + PG8_SB(b, h) + boff + n * 2048 + k * 1024); } while (0)
#define PG8_MMA(ai, bj, At, Bt) do { __builtin_amdgcn_s_setprio(1); _Pragma("unroll") for (int m = 0; m < 4; ++m) _Pragma("unroll") for (int n = 0; n < 2; ++n) _Pragma("unroll") for (int k = 0; k < 2; ++k) \
        acc[ai][bj][m][n] = __builtin_amdgcn_mfma_f32_16x16x32_bf16(Bt[n][k], At[m][k], acc[ai][bj][m][n], 0, 0, 0); __builtin_amdgcn_s_setprio(0); } while (0)
#define PG8_WAIT_V(n) asm volatile("s_waitcnt vmcnt(" #n ")" ::: "memory")
#define PG8_WAIT_L(n) asm volatile("s_waitcnt lgkmcnt(" #n ")" ::: "memory")
#define PG8_BAR __builtin_amdgcn_s_barrier()
#define PG8_SCHED __builtin_amdgcn_sched_barrier(0)
    Unit cur, nxt; int ui = 0;
    if (!S.next(0, cur)) return;
    f32x4 acc[2][2][4][2];
#pragma unroll
    for (int a = 0; a < 2; ++a)
#pragma unroll
        for (int b = 0; b < 2; ++b)
#pragma unroll
            for (int m = 0; m < 4; ++m)
#pragma unroll
                for (int n = 0; n < 2; ++n) acc[a][b][m][n] = (f32x4){0.f, 0.f, 0.f, 0.f};
    bf16x8 At[4][2], B0[2][2], B1[2][2];
    const char* cA = (const char*)g.A + (size_t)cur.pm * tstepA; const char* cB = (const char*)g.Bt + (size_t)cur.pn * tstepB;
    S.a_ready(cur);
    if constexpr (SP2) {
        PG8_STAGE(PG8_SB(0, 0), cB, voffB); PG8_STAGE(PG8_SB(0, 1), cB + hstepB, voffB); PG8_STAGE(PG8_SA(0, 0), cA, voffA); PG8_STAGE(PG8_SA(0, 1), cA + hstepA, voffA);
        if (wr == 1) PG8_BAR;
        PG8_WAIT_V(2); PG8_BAR;
        PG8_STAGE(PG8_SB(1, 0), cB + kstep, voffB); PG8_STAGE(PG8_SA(1, 0), cA + kstep, voffA); PG8_STAGE(PG8_SB(1, 1), cB + hstepB + kstep, voffB);
        PG8_WAIT_V(6); PG8_BAR;
    } else {
        PG8_STAGE(PG8_SB(0, 0), cB, voffB); PG8_STAGE(PG8_SA(0, 0), cA, voffA); PG8_STAGE(PG8_SB(0, 1), cB + hstepB, voffB); PG8_STAGE(PG8_SA(0, 1), cA + hstepA, voffA);
        if (wr == 1) PG8_BAR;
        PG8_WAIT_V(4); PG8_BAR;
        PG8_STAGE(PG8_SB(1, 0), cB + kstep, voffB); PG8_STAGE(PG8_SA(1, 0), cA + kstep, voffA); PG8_STAGE(PG8_SB(1, 1), cB + hstepB + kstep, voffB);
        PG8_WAIT_V(6); PG8_BAR;
    }
    for (;;) {
        const bool has_next = S.next(ui + 1, nxt);
        const char* nA = has_next ? (const char*)g.A + (size_t)nxt.pm * tstepA : cA; const char* nB = has_next ? (const char*)g.Bt + (size_t)nxt.pn * tstepB : cB;
        for (int t = 0; t < nt; t += 2) {
            const bool last = (t == nt - 2);
            const char* a1 = cA + (size_t)(t + 1) * kstep;
            const char* a2 = last ? nA : cA + (size_t)(t + 2) * kstep; const char* b2 = last ? nB : cB + (size_t)(t + 2) * kstep;
            const char* a3 = a2 + kstep; const char* b3 = b2 + kstep;
            if (last && has_next) S.a_ready(nxt);
            if constexpr (SP2) {
            PG8_LDB(B0, 0, 0); PG8_LDB(B1, 0, 1); PG8_SCHED; PG8_LDA(At, 0, 0); PG8_STAGE(PG8_SA(1, 1), a1 + hstepA, voffA);
            PG8_WAIT_V(8); PG8_WAIT_L(0); PG8_BAR; PG8_MMA(0, 0, At, B0); PG8_MMA(0, 1, At, B1); PG8_BAR; PG8_SCHED;
            PG8_LDA(At, 0, 1); PG8_STAGE(PG8_SB(0, 0), b2, voffB); PG8_STAGE(PG8_SB(0, 1), b2 + hstepB, voffB); PG8_STAGE(PG8_SA(0, 0), a2, voffA);
            PG8_WAIT_V(8); PG8_WAIT_L(0); PG8_BAR; PG8_MMA(1, 0, At, B0); PG8_MMA(1, 1, At, B1); PG8_BAR; PG8_SCHED;
            PG8_LDB(B0, 1, 0); PG8_LDB(B1, 1, 1); PG8_SCHED; PG8_LDA(At, 1, 0); PG8_STAGE(PG8_SA(0, 1), a2 + hstepA, voffA);
            PG8_WAIT_V(8); PG8_WAIT_L(0); PG8_BAR; PG8_MMA(0, 0, At, B0); PG8_MMA(0, 1, At, B1); PG8_BAR; PG8_SCHED;
            PG8_LDA(At, 1, 1); PG8_STAGE(PG8_SB(1, 0), b3, voffB); PG8_STAGE(PG8_SB(1, 1), b3 + hstepB, voffB); PG8_STAGE(PG8_SA(1, 0), a3, voffA);
            PG8_WAIT_V(8); PG8_WAIT_L(0); PG8_BAR; PG8_MMA(1, 0, At, B0); PG8_MMA(1, 1, At, B1); PG8_BAR; PG8_SCHED;
            } else {
            PG8_LDB(B0, 0, 0); PG8_SCHED; PG8_LDA(At, 0, 0); PG8_STAGE(PG8_SA(1, 1), a1 + hstepA, voffA);
            PG8_WAIT_L(8); PG8_BAR; PG8_WAIT_L(0); PG8_MMA(0, 0, At, B0); PG8_BAR; PG8_SCHED;
            PG8_LDB(B1, 0, 1); PG8_STAGE(PG8_SB(0, 0), b2, voffB);
            PG8_BAR; PG8_WAIT_L(0); PG8_MMA(0, 1, At, B1); PG8_BAR;
            PG8_LDA(At, 0, 1); PG8_STAGE(PG8_SA(0, 0), a2, voffA);
            PG8_BAR; PG8_WAIT_L(0); PG8_MMA(1, 0, At, B0); PG8_BAR; PG8_SCHED;
            PG8_STAGE(PG8_SB(0, 1), b2 + hstepB, voffB);
            PG8_WAIT_V(6); PG8_BAR; PG8_MMA(1, 1, At, B1); PG8_BAR;
            PG8_LDB(B0, 1, 0); PG8_SCHED; PG8_LDA(At, 1, 0); PG8_STAGE(PG8_SA(0, 1), a2 + hstepA, voffA);
            PG8_WAIT_L(8); PG8_BAR; PG8_WAIT_L(0); PG8_MMA(0, 0, At, B0); PG8_BAR; PG8_SCHED;
            PG8_LDB(B1, 1, 1); PG8_STAGE(PG8_SB(1, 0), b3, voffB);
            PG8_BAR; PG8_WAIT_L(0); PG8_MMA(0, 1, At, B1); PG8_BAR;
            PG8_LDA(At, 1, 1); PG8_STAGE(PG8_SA(1, 0), a3, voffA);
            PG8_BAR; PG8_WAIT_L(0); PG8_MMA(1, 0, At, B0); PG8_BAR; PG8_SCHED;
            PG8_STAGE(PG8_SB(1, 1), b3 + hstepB, voffB);
            PG8_WAIT_V(6); PG8_BAR; PG8_MMA(1, 1, At, B1); PG8_BAR;
            }
        }
        if constexpr (ALIGN_EPI) { if (wr == 0) PG8_BAR; }
        if constexpr (!Epi::AFTER_DRAIN) { E(acc, cur, wr, wc, fr, fq); S.done(cur); }
        if (!has_next) break;
#pragma unroll
        for (int a = 0; a < 2; ++a)
#pragma unroll
            for (int b = 0; b < 2; ++b)
#pragma unroll
                for (int m = 0; m < 4; ++m)
#pragma unroll
                    for (int n = 0; n < 2; ++n) acc[a][b][m][n] = (f32x4){0.f, 0.f, 0.f, 0.f};
        cur = nxt; cA = nA; cB = nB; ++ui;
        if constexpr (ALIGN_EPI) { if (wr == 1) PG8_BAR; }
    }
    PG8_WAIT_V(0);
    if constexpr (!ALIGN_EPI) { if (wr == 0) PG8_BAR; }
    PG8_BAR;
    if constexpr (Epi::AFTER_DRAIN) { E.fused(acc, cur, wr, wc, fr, fq, lds, wid, lane); S.done(cur); }
#undef PG8_SA
#undef PG8_SB
#undef PG8_STAGE
#undef PG8_LDA
#undef PG8_LDB
#undef PG8_MMA
#undef PG8_WAIT_V
#undef PG8_WAIT_L
#undef PG8_BAR
#undef PG8_SCHED
}
}

#define KV_DECL uint4 rk0, rk1, rk2, rk3, rv0, rv1, rv2, rv3
#define KV_LOAD(kb_, dil_) do { const int kk_ = lane >> 3; \
    const bf16_t* p0_ = qkv + (rowb + min(max((kb_) + (dil_) * kk_, 0), S - 1)) * ld + (lane & 7) * 8; \
    const bf16_t* p1_ = qkv + (rowb + min(max((kb_) + (dil_) * (kk_ + 8), 0), S - 1)) * ld + (lane & 7) * 8; \
    const bf16_t* p2_ = qkv + (rowb + min(max((kb_) + (dil_) * (kk_ + 16), 0), S - 1)) * ld + (lane & 7) * 8; \
    const bf16_t* p3_ = qkv + (rowb + min(max((kb_) + (dil_) * (kk_ + 24), 0), S - 1)) * ld + (lane & 7) * 8; \
    rk0 = *(const uint4*)(p0_ + kcol); rk1 = *(const uint4*)(p1_ + kcol); rk2 = *(const uint4*)(p2_ + kcol); rk3 = *(const uint4*)(p3_ + kcol); \
    rv0 = *(const uint4*)(p0_ + vcol); rv1 = *(const uint4*)(p1_ + vcol); rv2 = *(const uint4*)(p2_ + vcol); rv3 = *(const uint4*)(p3_ + vcol); } while (0)
#define KV_STORE() do { char* wp_ = vl + (lane >> 3) * 144 + (lane & 7) * 16; \
    *(uint4*)(wp_) = rk0; *(uint4*)(wp_ + 8 * 144) = rk1; *(uint4*)(wp_ + 16 * 144) = rk2; *(uint4*)(wp_ + 24 * 144) = rk3; \
    *(uint4*)(wp_ + 4608) = rv0; *(uint4*)(wp_ + 4608 + 8 * 144) = rv1; *(uint4*)(wp_ + 4608 + 16 * 144) = rv2; *(uint4*)(wp_ + 4608 + 24 * 144) = rv3; } while (0)

DI bf16x8 v_frag(const char* vbase, int s, int dt) {
    typedef __attribute__((address_space(3))) v4i16_t* lp_t;
    const char* a = vbase + s * (16 * 144) + dt * 64;
    const s16x4 lo = __builtin_bit_cast(s16x4, __builtin_amdgcn_ds_read_tr16_b64_v4i16((lp_t)(a)));
    const s16x4 hi = __builtin_bit_cast(s16x4, __builtin_amdgcn_ds_read_tr16_b64_v4i16((lp_t)(a + 8 * 144)));
    return __builtin_shufflevector(lo, hi, 0, 1, 2, 3, 4, 5, 6, 7);
}

template <int OFF> DI bf16x8 pack8v(const f32x16& p) {
    typedef unsigned u32x4 __attribute__((ext_vector_type(4)));
    u32x4 w; w[0] = pk2(p[OFF + 0], p[OFF + 1]); w[1] = pk2(p[OFF + 2], p[OFF + 3]); w[2] = pk2(p[OFF + 4], p[OFF + 5]); w[3] = pk2(p[OFF + 6], p[OFF + 7]);
    return __builtin_bit_cast(bf16x8, w);
}

DI void win_attn_wave(bf16_t* qkv, int ld, int b, int qcol, int kcol, int vcol, int tq0, int qstride,
                      float slope2, float m_init, float l_init, int pat, char* vl, int lane, bool dry,
                      int nq = 32, float* st = nullptr, int tloc0 = 0, int tlstride = 0, int stage = 0) {
    const int r = lane & 31, h = lane >> 5;
    const size_t rowb = (size_t)b * S;
    const int tq = tq0 + qstride * r;
    bf16x8 qf[4];
    {
        const bf16_t* qp = qkv + (rowb + min(tq, S - 1)) * ld + qcol + h * 32;
#pragma unroll
        for (int ks = 0; ks < 4; ++ks) qf[ks] = *(const bf16x8*)(qp + ks * 8);
    }
    f32x16 o0, o1;
#pragma unroll
    for (int i = 0; i < 16; ++i) { o0[i] = 0.f; o1[i] = 0.f; }
    float m = m_init, l = (h == 0) ? l_init : 0.f;
    const float sc2 = 0.125f * LOG2E;
    const int i16 = lane & 15;
    const char* vbase = vl + 4608 + (4 * h + (i16 >> 2)) * 144 + (16 * ((lane >> 4) & 1) + 4 * (i16 & 3)) * 2;
    const char* kfp = vl + r * 144 + h * 64;
    KV_DECL;
    for (int pi = 0; pi < 1; ++pi) {
        int dil, W, kfirst; const int nt = 5;
        if (pat < 0) { dil = 1; W = 127; kfirst = tq0 - 128; }
        else if (pat == 0) { dil = 1; W = 128; kfirst = tq0 - 128; }
        else if (pat == 1) { dil = 4; W = 512; kfirst = tq0 - 512; }
        else { dil = 16; W = 2048; kfirst = tq0 - 2048; }
        const int step = 32 * dil;
        int t0 = 0;
        { const int need = -kfirst - 31 * dil; if (need > 0) t0 = (need + step - 1) / step; }
        if (t0 >= nt) continue;
        KV_LOAD(kfirst + t0 * step, dil);
        for (int tile = t0; tile < nt; ++tile) {
            const int kb = kfirst + tile * step;
            KV_STORE();
            asm volatile("" ::: "memory");
            if (tile + 1 < nt) KV_LOAD(kb + step, dil);
            f32x16 s;
#pragma unroll
            for (int i = 0; i < 16; ++i) s[i] = 0.f;
#pragma unroll
            for (int ks = 0; ks < 4; ++ks) s = MFMA(*(const bf16x8*)(kfp + ks * 16), qf[ks], s);
            f32x16 sv; float mloc = -INFINITY;
            const int d0 = tq - kb - 4 * h * dil;
            const float b0 = -slope2 * (float)d0, b1 = slope2 * (float)dil;
            if (tile >= 1 && tile <= 3 && kb >= 0) {
#pragma unroll
                for (int i = 0; i < 16; ++i) {
                    sv[i] = __builtin_fmaf(s[i], sc2, __builtin_fmaf(b1, (float)crow(i, 0), b0));
                    mloc = fmaxf(mloc, sv[i]);
                }
            } else {
                const unsigned wlim = (unsigned)min(W, tq);
#pragma unroll
                for (int i = 0; i < 16; ++i) {
                    const int diff = d0 - dil * crow(i, 0);
                    const float sb = __builtin_fmaf(s[i], sc2, __builtin_fmaf(b1, (float)crow(i, 0), b0));
                    sv[i] = ((unsigned)diff <= wlim) ? sb : -INFINITY;
                    mloc = fmaxf(mloc, sv[i]);
                }
            }
            mloc = fmaxf(mloc, __shfl_xor(mloc, 32));
            const float mn = fmaxf(m, mloc);
            if (__builtin_amdgcn_ballot_w64(mn > m + 8.f) != 0) {
                const float alpha = fexp2(m - mn);
                l *= alpha;
#pragma unroll
                for (int i = 0; i < 16; ++i) { o0[i] *= alpha; o1[i] *= alpha; }
                m = mn;
            }
            float ps = 0.f;
#pragma unroll
            for (int i = 0; i < 16; ++i) { sv[i] = fexp2(sv[i] - m); ps += sv[i]; }
            l += ps;
            const bf16x8 p0 = pack8v<0>(sv), p1 = pack8v<8>(sv);
            o0 = MFMA(v_frag(vbase, 0, 0), p0, o0);
            o0 = MFMA(v_frag(vbase, 1, 0), p1, o0);
            o1 = MFMA(v_frag(vbase, 0, 1), p0, o1);
            o1 = MFMA(v_frag(vbase, 1, 1), p1, o1);
            asm volatile("" ::: "memory");
        }
    }
    float lt = l + __shfl_xor(l, 32);
    if (st) {
        const bool act = r < nq;
        char* sp = (char*)st + (tloc0 + tlstride * r) * 144;
        if (act) {
            if (stage > 0) {
                const float ms = *(const float*)(sp + 128), ls = *(const float*)(sp + 132);
                const float mn = fmaxf(ms, m);
                const float as = fexp2(ms - mn), aw = fexp2(m - mn);
                lt = ls * as + lt * aw; m = mn;
#pragma unroll
                for (int g = 0; g < 4; ++g) {
                    const uint2 a = *(const uint2*)(sp + (8 * g + 4 * h) * 2), c = *(const uint2*)(sp + (32 + 8 * g + 4 * h) * 2);
                    o0[4 * g] = bflo(a.x) * as + o0[4 * g] * aw; o0[4 * g + 1] = bfhi(a.x) * as + o0[4 * g + 1] * aw; o0[4 * g + 2] = bflo(a.y) * as + o0[4 * g + 2] * aw; o0[4 * g + 3] = bfhi(a.y) * as + o0[4 * g + 3] * aw;
                    o1[4 * g] = bflo(c.x) * as + o1[4 * g] * aw; o1[4 * g + 1] = bfhi(c.x) * as + o1[4 * g + 1] * aw; o1[4 * g + 2] = bflo(c.y) * as + o1[4 * g + 2] * aw; o1[4 * g + 3] = bfhi(c.y) * as + o1[4 * g + 3] * aw;
                }
            }
            if (stage < 2) {
                if (h == 0) { *(float*)(sp + 128) = m; *(float*)(sp + 132) = lt; }
#pragma unroll
                for (int g = 0; g < 4; ++g) {
                    *(uint2*)(sp + (8 * g + 4 * h) * 2) = make_uint2(pk2(o0[4 * g], o0[4 * g + 1]), pk2(o0[4 * g + 2], o0[4 * g + 3]));
                    *(uint2*)(sp + (32 + 8 * g + 4 * h) * 2) = make_uint2(pk2(o1[4 * g], o1[4 * g + 1]), pk2(o1[4 * g + 2], o1[4 * g + 3]));
                }
            }
        }
        if (stage < 2 || !act) return;
    }
    const float inv = 1.f / lt;
    if (dry) { if (o0[0] + o1[0] + lt == 12345.678f) qkv[0] = 1; return; }
    bf16_t* op = qkv + (rowb + tq) * ld + qcol + 4 * h;
#pragma unroll
    for (int g = 0; g < 4; ++g) {
        *(uint2*)(op + 8 * g) = make_uint2(pk2(o0[4 * g] * inv, o0[4 * g + 1] * inv), pk2(o0[4 * g + 2] * inv, o0[4 * g + 3] * inv));
        *(uint2*)(op + 32 + 8 * g) = make_uint2(pk2(o1[4 * g] * inv, o1[4 * g + 1] * inv), pk2(o1[4 * g + 2] * inv, o1[4 * g + 3] * inv));
    }
}

DI void stick_wave(bf16_t* qkv, int ld, int b, int qcol, int kcol, int vcol, int qt, char* vl, int lane, bool dry) {
    const int r = lane & 31, h = lane >> 5;
    const size_t rowb = (size_t)b * S;
    const int tq = qt * 32 + r;
    bf16x8 qf[4];
    {
        const bf16_t* qp = qkv + (rowb + tq) * ld + qcol + h * 32;
#pragma unroll
        for (int ks = 0; ks < 4; ++ks) qf[ks] = *(const bf16x8*)(qp + ks * 8);
    }
    f32x16 o0, o1;
#pragma unroll
    for (int i = 0; i < 16; ++i) { o0[i] = 0.f; o1[i] = 0.f; }
    float R = 1.f;
    const int i16 = lane & 15;
    const char* vbase = vl + 4608 + (4 * h + (i16 >> 2)) * 144 + (16 * ((lane >> 4) & 1) + 4 * (i16 & 3)) * 2;
    const char* kfp = vl + r * 144 + h * 64;
    KV_DECL;
    KV_LOAD(qt * 32, 1);
    for (int tile = qt; tile >= 0; --tile) {
        KV_STORE();
        asm volatile("" ::: "memory");
        if (tile > 0) KV_LOAD((tile - 1) * 32, 1);
        f32x16 s;
#pragma unroll
        for (int i = 0; i < 16; ++i) s[i] = 0.f;
#pragma unroll
        for (int ks = 0; ks < 4; ++ks) s = MFMA(*(const bf16x8*)(kfp + ks * 16), qf[ks], s);
        const bool diag = (tile == qt);
        f32x16 sg, kp;
#pragma unroll
        for (int i = 0; i < 16; ++i) {
            const float z2 = fminf(s[i] * (0.125f * LOG2E), 80.f);
            const float t = fexp2(z2);
            const float k = __builtin_amdgcn_rcpf(1.f + t);
            kp[i] = k; sg[i] = t * k;
        }
        if (diag) {
#pragma unroll
            for (int i = 0; i < 16; ++i) { const bool strict = crow(i, h) < r; kp[i] = strict ? kp[i] : 1.f; sg[i] = strict ? sg[i] : 0.f; }
        }
        float G[4], PG[4], both[4];
#pragma unroll
        for (int g = 0; g < 4; ++g) { G[g] = (kp[4 * g] * kp[4 * g + 1]) * (kp[4 * g + 2] * kp[4 * g + 3]); PG[g] = __shfl_xor(G[g], 32); both[g] = G[g] * PG[g]; }
        float Sx[4];
        Sx[3] = 1.f; Sx[2] = both[3]; Sx[1] = both[3] * both[2]; Sx[0] = Sx[1] * both[1];
        f32x16 a;
#pragma unroll
        for (int g = 0; g < 4; ++g) {
            float la = R * Sx[g] * (h == 0 ? PG[g] : 1.f);
#pragma unroll
            for (int j = 3; j >= 0; --j) {
                a[4 * g + j] = sg[4 * g + j] * la;
                la *= kp[4 * g + j];
            }
        }
        R *= Sx[0] * both[0];
        const bf16x8 p0 = pack8v<0>(a), p1 = pack8v<8>(a);
        o0 = MFMA(v_frag(vbase, 0, 0), p0, o0);
        o0 = MFMA(v_frag(vbase, 1, 0), p1, o0);
        o1 = MFMA(v_frag(vbase, 0, 1), p0, o1);
        o1 = MFMA(v_frag(vbase, 1, 1), p1, o1);
        asm volatile("" ::: "memory");
        if (__builtin_amdgcn_ballot_w64(R >= 1.17549435e-38f) == 0) break;
    }
    if (dry) { if (o0[0] + o1[0] == 12345.678f) qkv[0] = 1; return; }
    bf16_t* op = qkv + (rowb + tq) * ld + qcol + 4 * h;
#pragma unroll
    for (int g = 0; g < 4; ++g) {
        *(uint2*)(op + 8 * g) = make_uint2(pk2(o0[4 * g], o0[4 * g + 1]), pk2(o0[4 * g + 2], o0[4 * g + 3]));
        *(uint2*)(op + 32 + 8 * g) = make_uint2(pk2(o1[4 * g], o1[4 * g + 1]), pk2(o1[4 * g + 2], o1[4 * g + 3]));
    }
}

DI void attn_even_phase(const Params& P, char* smem, bool dry) {
    const int tid_ = otid(); const int lane = tid_ & 63, wid = tid_ >> 6;
    bf16_t* qkv = (bf16_t*)(P.ws + OFF_BIG);
    char* vl = smem + wid * 9216;
    for (int it = blockIdx.x * 8 + wid; it < 2048 + 4096; it += gridDim.x * 8) {
        if (it < 2048) {
            const int bh = it >> 6, p = it & 63; const int b = bh >> 3, head = bh & 7;
            stick_wave(qkv, 2304, b, 512 + head * 64, 1280 + head * 64, 1792 + head * 64, 127 - p, vl, lane, dry);
            stick_wave(qkv, 2304, b, 512 + head * 64, 1280 + head * 64, 1792 + head * 64, p, vl, lane, dry);
        } else {
            const int v = it - 2048; const int g = v & 3; const int qt = (v >> 2) & 127; const int rest = v >> 9; const int b = rest >> 1, kvh = rest & 1;
            const int head = kvh * 4 + g;
            const float slope = exp2f(-(float)(head + 1));
            const float sink = P.in[9][head];
            win_attn_wave(qkv, 2304, b, head * 64, 1024 + kvh * 64, 1152 + kvh * 64, qt * 32, 1, slope * LOG2E, sink * LOG2E, 1.f, -1, vl, lane, dry);
        }
    }
}

DI void attn_odd_phase(const Params& P, char* smem, bool dry) {
    const int tid_ = otid(); const int lane = tid_ & 63, wid = tid_ >> 6;
    bf16_t* qkv = (bf16_t*)(P.ws + OFF_BIG);
    char* vl = smem + wid * 9216;
    float* st = (float*)(smem + 8 * 9216);
    for (int it = blockIdx.x; it < 512; it += gridDim.x) {
        const int span = it & 7, head = (it >> 3) & 15, b = it >> 7; const int t0 = span * 512;
        const float slope2 = exp2f(-0.5f * (float)(head + 1)) * LOG2E;
        const int qc = head * 64, kc = 1024 + head * 64, vc = 2048 + head * 64;
        __syncthreads();
#pragma unroll 1
        for (int k = 0; k < 2; ++k) {
            const int j = wid + 8 * k;
            win_attn_wave(qkv, 3072, b, qc, kc, vc, t0 + 32 * j, 1, slope2, -1e30f, 0.f, 0, vl, lane, dry, 32, st, 32 * j, 1, 0);
        }
        __syncthreads();
#pragma unroll 1
        for (int k = 0; k < 2; ++k) {
            const int j = wid + 8 * k; const int r4 = j >> 2, q = j & 3;
            win_attn_wave(qkv, 3072, b, qc, kc, vc, t0 + r4 + 128 * q, 4, slope2, -1e30f, 0.f, 1, vl, lane, dry, 32, st, r4 + 128 * q, 4, 1);
        }
        __syncthreads();
#pragma unroll 1
        for (int k = 0; k < 2; ++k) {
            const int r16 = wid + 8 * k;
            win_attn_wave(qkv, 3072, b, qc, kc, vc, t0 + r16, 16, slope2, -1e30f, 0.f, 2, vl, lane, dry, 32, st, r16, 16, 2);
        }
    }
}

DI void xattn_wave(bf16_t* qb, const bf16_t* Kn, const bf16_t* VT, const float* qg, float kmax2, int b, int head, int tok0, char* ql, int lane, bool dry) {
    const int r = lane & 31, h = lane >> 5;
    const size_t token = (size_t)b * S + tok0 + r;
    bf16_t* qp = qb + token * D + head * 256 + h * 128;
    float ss = 0.f;
#pragma unroll
    for (int ks = 0; ks < 16; ++ks) {
        const uint4 v = *(const uint4*)(qp + ks * 8);
        const unsigned w[4] = {v.x, v.y, v.z, v.w};
#pragma unroll
        for (int e = 0; e < 4; ++e) { const float a = bflo(w[e]), c = bfhi(w[e]); ss += a * a + c * c; }
    }
    ss += __shfl_xor(ss, 32);
    const float inv = __builtin_amdgcn_rsqf(ss * (1.f / 256.f) + EPS);
    float qq2 = 0.f;
#pragma unroll
    for (int ks = 0; ks < 16; ++ks) {
        const uint4 v = *(const uint4*)(qp + ks * 8);
        const float4 g0 = *(const float4*)(qg + h * 128 + ks * 8), g1 = *(const float4*)(qg + h * 128 + ks * 8 + 4);
        uint4 o;
        o.x = pk2(bflo(v.x) * inv * g0.x, bfhi(v.x) * inv * g0.y); o.y = pk2(bflo(v.y) * inv * g0.z, bfhi(v.y) * inv * g0.w);
        o.z = pk2(bflo(v.z) * inv * g1.x, bfhi(v.z) * inv * g1.y); o.w = pk2(bflo(v.w) * inv * g1.z, bfhi(v.w) * inv * g1.w);
        qq2 += bflo(o.x) * bflo(o.x) + bfhi(o.x) * bfhi(o.x) + bflo(o.y) * bflo(o.y) + bfhi(o.y) * bfhi(o.y)
             + bflo(o.z) * bflo(o.z) + bfhi(o.z) * bfhi(o.z) + bflo(o.w) * bflo(o.w) + bfhi(o.w) * bfhi(o.w);
        *(uint4*)(ql + (ks * 64 + lane) * 16) = o;
    }
    qq2 += __shfl_xor(qq2, 32);
    asm volatile("" ::: "memory");
    const float sc2 = 0.0625f * LOG2E;
    const bf16_t* kp0 = Kn + ((size_t)(b * 4 + head) * 8 * 16 * 64 + lane) * 8;
    const float m = __builtin_amdgcn_sqrtf(qq2 * kmax2) * 1.001f;
    float l = 0.f;
    bf16x8 pf[8][2];
    bf16x8 kc[16], kn[16];
#pragma unroll
    for (int ks = 0; ks < 16; ++ks) kc[ks] = *(const bf16x8*)(kp0 + ks * 512);
#pragma unroll
    for (int tile = 0; tile < 8; ++tile) {
        if (tile < 7) {
#pragma unroll
            for (int ks = 0; ks < 16; ++ks) kn[ks] = *(const bf16x8*)(kp0 + (size_t)(tile + 1) * 16 * 512 + ks * 512);
        }
        f32x16 s, s_b;
#pragma unroll
        for (int i = 0; i < 16; ++i) { s[i] = 0.f; s_b[i] = 0.f; }
#pragma unroll
        for (int ks = 0; ks < 16; ks += 2) {
            const bf16x8 qf0 = *(const bf16x8*)(ql + (ks * 64 + lane) * 16);
            const bf16x8 qf1 = *(const bf16x8*)(ql + ((ks + 1) * 64 + lane) * 16);
            s = MFMA(kc[ks], qf0, s);
            s_b = MFMA(kc[ks + 1], qf1, s_b);
        }
#pragma unroll
        for (int i = 0; i < 16; ++i) s[i] += s_b[i];
#pragma unroll
        for (int i = 0; i < 16; ++i) { s[i] = fexp2((s[i] - m) * sc2); l += s[i]; }
        pf[tile][0] = pack8v<0>(s); pf[tile][1] = pack8v<8>(s);
#pragma unroll
        for (int ks = 0; ks < 16; ++ks) kc[ks] = kn[ks];
    }
    l += __shfl_xor(l, 32);
    const float il = 1.f / l;
    bf16_t* op = qb + token * D + head * 256 + 4 * h;
    const bf16_t* vp0 = VT + (((size_t)(b * 4 + head) * 8 * 8 * 2 * 64) + lane) * 8;
    bf16x8 vc[16], vn[16];
#pragma unroll
    for (int e = 0; e < 16; ++e) vc[e] = *(const bf16x8*)(vp0 + e * 512);
#pragma unroll 1
    for (int dt = 0; dt < 8; ++dt) {
        const int dn = dt < 7 ? dt + 1 : 7;
#pragma unroll
        for (int e = 0; e < 16; ++e) vn[e] = *(const bf16x8*)(vp0 + (size_t)dn * 16 * 512 + e * 512);
        f32x16 o, o_b;
#pragma unroll
        for (int i = 0; i < 16; ++i) { o[i] = 0.f; o_b[i] = 0.f; }
#pragma unroll
        for (int tile = 0; tile < 8; ++tile) { o = MFMA(vc[tile * 2], pf[tile][0], o); o_b = MFMA(vc[tile * 2 + 1], pf[tile][1], o_b); }
#pragma unroll
        for (int i = 0; i < 16; ++i) o[i] += o_b[i];
#pragma unroll
        for (int g = 0; g < 4; ++g)
            if (dry) { if (o[4 * g] == 12345.678f) qb[0] = 1; } else *(uint2*)(op + dt * 32 + 8 * g) = make_uint2(pk2(o[4 * g] * il, o[4 * g + 1] * il), pk2(o[4 * g + 2] * il, o[4 * g + 3] * il));
#pragma unroll
        for (int e = 0; e < 16; ++e) vc[e] = vn[e];
    }
}

DI void xattn_block(bf16_t* qb, const bf16_t* KF, const bf16_t* VF, const float* qg, float kmax2, int b, int head, int qblk, char* smem, int lane, int wid) {
    const int r = lane & 31, h = lane >> 5;
    const size_t token = (size_t)b * S + qblk * 256 + wid * 32 + r;
    bf16_t* qp = qb + token * D + head * 256 + h * 128;
    const bf16_t* kbase = KF + (size_t)(b * 4 + head) * 8 * 8192;
    const bf16_t* vbase = VF + (size_t)(b * 4 + head) * 8 * 8192;
    const int pc0 = (2 * wid) * 512 + lane * 8, pc1 = pc0 + 512;
    char* ld0 = smem + (2 * wid) * 1024 + lane * 16;
#define XA_ISSUE(u_) do { const int u__ = (u_); const bf16_t* src_ = (u__ < 8) ? kbase + (size_t)u__ * 8192 : vbase + (size_t)(u__ - 8) * 8192; \
        char* dst_ = ld0 + (u__ & 3) * 16384; glds16(src_ + pc0, dst_); glds16(src_ + pc1, dst_ + 1024); } while (0)
    __syncthreads();
    XA_ISSUE(0); XA_ISSUE(1); XA_ISSUE(2);
    uint4 qraw[16];
    float ss = 0.f;
#pragma unroll
    for (int ks = 0; ks < 16; ++ks) {
        qraw[ks] = *(const uint4*)(qp + ks * 8);
        const uint4 v = qraw[ks];
        ss += bflo(v.x) * bflo(v.x) + bfhi(v.x) * bfhi(v.x) + bflo(v.y) * bflo(v.y) + bfhi(v.y) * bfhi(v.y)
            + bflo(v.z) * bflo(v.z) + bfhi(v.z) * bfhi(v.z) + bflo(v.w) * bflo(v.w) + bfhi(v.w) * bfhi(v.w);
    }
    ss += __shfl_xor(ss, 32);
    const float inv = __builtin_amdgcn_rsqf(ss * (1.f / 256.f) + EPS);
    float qq2 = 0.f;
    bf16x8 qf[16];
#pragma unroll
    for (int ks = 0; ks < 16; ++ks) {
        const uint4 v = qraw[ks];
        const float4 g0 = *(const float4*)(qg + h * 128 + ks * 8), g1 = *(const float4*)(qg + h * 128 + ks * 8 + 4);
        uint4 o;
        o.x = pk2(bflo(v.x) * inv * g0.x, bfhi(v.x) * inv * g0.y); o.y = pk2(bflo(v.y) * inv * g0.z, bfhi(v.y) * inv * g0.w);
        o.z = pk2(bflo(v.z) * inv * g1.x, bfhi(v.z) * inv * g1.y); o.w = pk2(bflo(v.w) * inv * g1.z, bfhi(v.w) * inv * g1.w);
        qq2 += bflo(o.x) * bflo(o.x) + bfhi(o.x) * bfhi(o.x) + bflo(o.y) * bflo(o.y) + bfhi(o.y) * bfhi(o.y)
             + bflo(o.z) * bflo(o.z) + bfhi(o.z) * bfhi(o.z) + bflo(o.w) * bflo(o.w) + bfhi(o.w) * bfhi(o.w);
        qf[ks] = __builtin_bit_cast(bf16x8, o);
    }
    qq2 += __shfl_xor(qq2, 32);
    const float sc2 = 0.0625f * LOG2E;
    const float m = __builtin_amdgcn_sqrtf(qq2 * kmax2) * 1.001f;
    float l = 0.f;
    bf16x8 pf[8][2];
    const char* fr0 = smem + lane * 16;
#pragma unroll
    for (int u = 0; u < 8; ++u) {
        asm volatile("s_waitcnt vmcnt(4)" ::: "memory");
        __builtin_amdgcn_s_barrier();
        XA_ISSUE(u + 3);
        const char* sl = fr0 + (u & 3) * 16384;
        f32x16 s, s_b;
#pragma unroll
        for (int i = 0; i < 16; ++i) { s[i] = 0.f; s_b[i] = 0.f; }
#pragma unroll
        for (int ks = 0; ks < 16; ks += 2) {
            s = MFMA(*(const bf16x8*)(sl + ks * 1024), qf[ks], s);
            s_b = MFMA(*(const bf16x8*)(sl + (ks + 1) * 1024), qf[ks + 1], s_b);
        }
#pragma unroll
        for (int i = 0; i < 16; ++i) { s[i] = fexp2((s[i] + s_b[i] - m) * sc2); l += s[i]; }
        pf[u][0] = pack8v<0>(s); pf[u][1] = pack8v<8>(s);
    }
    l += __shfl_xor(l, 32);
    const float il = 1.f / l;
    bf16_t* op = qb + token * D + head * 256 + 4 * h;
#pragma unroll 1
    for (int dt = 0; dt < 8; ++dt) {
        if (dt < 6) asm volatile("s_waitcnt vmcnt(4)" ::: "memory");
        else if (dt == 6) asm volatile("s_waitcnt vmcnt(2)" ::: "memory");
        else asm volatile("s_waitcnt vmcnt(0)" ::: "memory");
        __builtin_amdgcn_s_barrier();
        if (dt < 5) XA_ISSUE(dt + 11);
        const char* sl = fr0 + (dt & 3) * 16384;
        f32x16 o, o_b;
#pragma unroll
        for (int i = 0; i < 16; ++i) { o[i] = 0.f; o_b[i] = 0.f; }
#pragma unroll
        for (int tile = 0; tile < 8; ++tile) {
            o = MFMA(*(const bf16x8*)(sl + (tile * 2) * 1024), pf[tile][0], o);
            o_b = MFMA(*(const bf16x8*)(sl + (tile * 2 + 1) * 1024), pf[tile][1], o_b);
        }
#pragma unroll
        for (int g = 0; g < 4; ++g)
            *(uint2*)(op + dt * 32 + 8 * g) = make_uint2(pk2((o[4 * g] + o_b[4 * g]) * il, (o[4 * g + 1] + o_b[4 * g + 1]) * il),
                                                        pk2((o[4 * g + 2] + o_b[4 * g + 2]) * il, (o[4 * g + 3] + o_b[4 * g + 3]) * il));
    }
#undef XA_ISSUE
}

DI void xattn_phase(const Params& P, int l, char* smem, bool dry) {
    const int tid_ = otid(); const int lane = tid_ & 63, wid = tid_ >> 6;
    bf16_t* qb = (bf16_t*)(P.ws + OFF_BIG);
    const bf16_t* KF = (const bf16_t*)(P.ws + OFF_KF + (size_t)l * SZ_MM);
    const bf16_t* VF = (const bf16_t*)(P.ws + OFF_VT + (size_t)l * SZ_MM);
    const float* qg = P.in[19] + l * 256;
    (void)dry;
    for (int it = blockIdx.x; it < 256; it += gridDim.x) {
        const int qblk = it & 15, head = (it >> 4) & 3, b = it >> 6;
        const float kmax2 = ((const float*)(P.ws + OFF_KMAX))[l * 16 + b * 4 + head];
        xattn_block(qb, KF, VF, qg, kmax2, b, head, qblk, smem, lane, wid);
    }
}

DI void knorm_phase(const Params& P) {
    const int tid_ = otid(); const int lane = tid_ & 63, wid = tid_ >> 6;
    for (int u = blockIdx.x * 8 + wid; u < 8192; u += gridDim.x * 8) {
        const int l = u >> 12, row = (u >> 2) & 1023, head = u & 3;
        const bf16_t* kp = (const bf16_t*)(P.ws + OFF_KN + (size_t)l * SZ_MM) + (size_t)row * D + head * 256 + lane * 4;
        const uint2 v = *(const uint2*)kp;
        const float a0 = bflo(v.x), a1 = bfhi(v.x), a2 = bflo(v.y), a3 = bfhi(v.y);
        float ss = a0 * a0 + a1 * a1 + a2 * a2 + a3 * a3;
        ss = wave_sum(ss);
        const float inv = __builtin_amdgcn_rsqf(ss * (1.f / 256.f) + EPS);
        const float4 g = *(const float4*)(P.in[20] + l * 256 + lane * 4);
        const int b = row >> 8, key = row & 255;
        const int h = lane >> 5, ks = (lane & 31) >> 1, j0 = (lane & 1) * 4;
        bf16_t* dp = (bf16_t*)(P.ws + OFF_KF + (size_t)l * SZ_MM) + ((((((size_t)(b * 4 + head) * 8 + (key >> 5)) * 16 + ks) * 64) + h * 32 + (key & 31)) << 3) + j0;
        const unsigned w0_ = pk2(a0 * inv * g.x, a1 * inv * g.y), w1_ = pk2(a2 * inv * g.z, a3 * inv * g.w);
        *(uint2*)dp = make_uint2(w0_, w1_);
        float kk2 = bflo(w0_) * bflo(w0_) + bfhi(w0_) * bfhi(w0_) + bflo(w1_) * bflo(w1_) + bfhi(w1_) * bfhi(w1_);
        kk2 = wave_sum(kk2);
        if (lane == 0) atomicMax((unsigned*)(P.ws + OFF_KMAX) + l * 16 + b * 4 + head, __float_as_uint(kk2));
    }
}

#define XB_TMO      128
#define XB_XCNT(j)  (256  + 64 * (j))
#define XB_XSUB(j)  (1280 + 64 * (j))
#define XB_XGEN(j)  (2304 + 64 * (j))
#define XB_TOP      3328
#define XB_TOPGEN   3392
#define XCD_BAR_WORDS 3456
#define XB_SPIN_CAP (1u << 18)
#define XB_LAS __attribute__((address_space(3)))

__device__ __forceinline__ unsigned xb_ld(unsigned* p)              { return __hip_atomic_load(p, __ATOMIC_RELAXED, __HIP_MEMORY_SCOPE_AGENT); }
__device__ __forceinline__ unsigned xb_add(unsigned* p, unsigned v) { return __hip_atomic_fetch_add(p, v, __ATOMIC_RELAXED, __HIP_MEMORY_SCOPE_AGENT); }
__device__ __forceinline__ unsigned xb_xcc_id() { return (unsigned)__builtin_amdgcn_s_getreg((3 << 11) | 20) & 0xFu; }
#define XB_SPIN(cond, bar) do { unsigned _sp = 0; while (cond) { __builtin_amdgcn_s_sleep(1); \
    if ((++_sp & 255u) == 0u) { if (xb_ld(&(bar)[XB_TMO])) break; if (_sp > XB_SPIN_CAP) { atomicAdd(&(bar)[XB_TMO], 1u); break; } } } } while (0)

struct XcdBarrier {
    unsigned* bar; unsigned x;
    volatile XB_LAS unsigned* st;
};

__device__ __forceinline__ XcdBarrier xcd_barrier_post(unsigned* bar, volatile XB_LAS unsigned* st) {
    XcdBarrier b; b.bar = bar; b.x = xb_xcc_id(); b.st = st;
    if (threadIdx.x == 0) (void)xb_add(&bar[XB_XCNT(b.x)], 1u);
    return b;
}
__device__ __forceinline__ void xcd_barrier_complete(unsigned* bar, unsigned x, unsigned& nloc, unsigned& nx) {
    const unsigned G = gridDim.x * gridDim.y * gridDim.z;
    unsigned sum, cnt, mine, sp = 0u;
    for (;;) {
        sum = 0u; cnt = 0u; mine = 0u;
#pragma unroll
        for (unsigned j = 0; j < 16; ++j) { const unsigned c = xb_ld(&bar[XB_XCNT(j)]); sum += c; cnt += (c > 0u) ? 1u : 0u; mine = (j == x) ? c : mine; }
        if (sum == G) break;
        __builtin_amdgcn_s_sleep(1);
        if ((++sp & 255u) == 0u) { if (xb_ld(&bar[XB_TMO])) break; if (sp > XB_SPIN_CAP) { atomicAdd(&bar[XB_TMO], 1u); break; } }
    }
    nloc = mine > 0u ? mine : 1u; nx = cnt > 0u ? cnt : 1u;
}

__device__ __forceinline__ void xcd_barrier(const XcdBarrier& b) {
    asm volatile("s_waitcnt vmcnt(0)" ::: "memory");
    __syncthreads();
    if (threadIdx.x == 0) {
        unsigned* bar = b.bar;
        __builtin_amdgcn_s_waitcnt(0);
        unsigned nloc = b.st[0], nx = b.st[1];
        if (nloc == 0u) { xcd_barrier_complete(bar, b.x, nloc, nx); b.st[0] = nloc; b.st[1] = nx; }
        const unsigned old = xb_add(&bar[XB_XSUB(b.x)], 1u);
        const unsigned gen = old / nloc;
        if (old + 1u == (gen + 1u) * nloc) {
            __builtin_amdgcn_fence(__ATOMIC_RELEASE, "agent");
            asm volatile("s_waitcnt vmcnt(0)" ::: "memory");
            const unsigned og = xb_add(&bar[XB_TOP], 1u);
            const unsigned tg = og / nx;
            if (og + 1u == (tg + 1u) * nx) xb_add(&bar[XB_TOPGEN], 1u);
            else XB_SPIN(xb_ld(&bar[XB_TOPGEN]) == tg, bar);
            __builtin_amdgcn_fence(__ATOMIC_ACQUIRE, "agent");
            xb_add(&bar[XB_XGEN(b.x)], 1u);
            asm volatile("s_waitcnt vmcnt(0)" ::: "memory");
        } else {
            XB_SPIN(xb_ld(&bar[XB_XGEN(b.x)]) == gen, bar);
            __builtin_amdgcn_fence(__ATOMIC_ACQUIRE, "agent");
            asm volatile("s_waitcnt vmcnt(0)" ::: "memory");
        }
    }
    __syncthreads();
}


DI void fast_grid_sync(unsigned* bar, unsigned target) {
    asm volatile("s_waitcnt vmcnt(0) lgkmcnt(0)" ::: "memory");
    __syncthreads();
    if (threadIdx.x == 0) {
        __builtin_amdgcn_fence(__ATOMIC_RELEASE, "agent");
        asm volatile("s_waitcnt vmcnt(0)" ::: "memory");
        __hip_atomic_fetch_add(bar, 1u, __ATOMIC_RELAXED, __HIP_MEMORY_SCOPE_AGENT);
        while (__hip_atomic_load(bar, __ATOMIC_RELAXED, __HIP_MEMORY_SCOPE_AGENT) < target) __builtin_amdgcn_s_sleep(2);
        __builtin_amdgcn_fence(__ATOMIC_ACQUIRE, "agent");
        asm volatile("s_waitcnt vmcnt(0)" ::: "memory");
    }
    __syncthreads();
}

__global__ void __launch_bounds__(512) fwd_megakernel(Params P) {
    extern __shared__ __attribute__((aligned(16))) char smem[];
    cg::grid_group grid = cg::this_grid();
    unsigned nbar = 0; (void)nbar;
    volatile XB_LAS unsigned* xst = (volatile XB_LAS unsigned*)(smem + LDS_BYTES - 16);
    if (threadIdx.x == 0) { xst[0] = 0u; xst[1] = 0u; }
    __syncthreads();
    const XcdBarrier xbar = xcd_barrier_post((unsigned*)(P.ws + OFF_BAR), xst);
#pragma unroll 1
    for (int ph = 0; ph < 21; ++ph) {
        float* ssq = (float*)(P.ws + OFF_SSQ);
        bf16_t* xb = (bf16_t*)(P.ws + OFF_XB);
        bf16_t* big = (bf16_t*)(P.ws + OFF_BIG);
        int nrep = 1;
        if (ph > 0) { const int s_ = (ph - 1) % 10; const int kind = (s_ == 3) ? 2 : (s_ == 6) ? 4 : 1; if (PROBE_MASK & kind) nrep = 2; }
        for (int rep = 0; rep < nrep; ++rep) {
        const bool dry = rep + 1 < nrep;
        if (ph == 0) {
            phase0(P, smem);
        } else {
            const int l = (ph - 1) / 10, s = (ph - 1) % 10;
            if (s == 3) {
                if (l == 0) attn_even_phase(P, smem, dry); else attn_odd_phase(P, smem, dry);
            } else if (s == 6) {
                xattn_phase(P, l, smem, dry);
            } else {
                pg8::Gemm g; pg8::Epi E;
                g.A = xb; g.lda = D; g.K = D; g.M = T; g.N = D; g.Bt = nullptr;
                E.mode = 1; E.rs = nullptr; E.O = big; E.ldo = D; E.xin = nullptr; E.xout = nullptr; E.xb = xb; E.ssq_out = ssq; E.alpha = 1.f;
                E.qg = nullptr; E.kg = nullptr; E.qn_end = 0; E.kn_beg = 0; E.kn_end = 0;
                if (s == 0 || s == 8) {
                    g.Bt = (const bf16_t*)(P.ws + (s == 0 ? OFF_GU1 : OFF_GU2) + (size_t)l * SZ_GU); g.N = NGU;
                    E.mode = 0; E.rs = ssq + (size_t)(4 * l + (s == 0 ? 0 : 3)) * T; E.ldo = DFF;
                } else if (s == 1 || s == 9) {
                    g.A = big; g.lda = DFF; g.K = DFF;
                    g.Bt = (const bf16_t*)(P.ws + (s == 1 ? OFF_DN1 : OFF_DN2) + (size_t)l * SZ_DN);
                    E.alpha = 0.5f; E.ssq_out = ssq + (size_t)(4 * l + (s == 1 ? 1 : 4)) * T;
                    if (ph == 2) E.xin = P.in[0];
                    if (ph == 20) { E.xout = P.out; E.ssq_out = nullptr; }
                } else if (s == 2) {
                    E.mode = 2; E.rs = ssq + (size_t)(4 * l + 1) * T;
                    if (l == 0) { g.Bt = (const bf16_t*)(P.ws + OFF_EVIN); g.N = 2304; E.ldo = 2304; E.qg = P.in[7]; E.kg = P.in[8]; E.qn_end = 512; E.kn_beg = 1024; E.kn_end = 1152; }
                    else { g.Bt = (const bf16_t*)(P.ws + OFF_ODIN); g.N = 3072; E.ldo = 3072; E.qg = P.in[12]; E.kg = P.in[13]; E.qn_end = 1024; E.kn_beg = 1024; E.kn_end = 2048; }
                } else if (s == 4) {
                    g.A = big;
                    if (l == 0) { g.Bt = (const bf16_t*)(P.ws + OFF_EVOUT); g.lda = 2304; }
                    else { g.Bt = (const bf16_t*)(P.ws + OFF_ODOUT); g.lda = 3072; }
                    E.ssq_out = ssq + (size_t)(4 * l + 2) * T;
                } else if (s == 5) {
                    g.Bt = (const bf16_t*)(P.ws + OFF_WQ + (size_t)l * SZ_MM); E.mode = 2; E.rs = ssq + (size_t)(4 * l + 2) * T; E.ldo = D;
                } else {
                    g.A = big; g.Bt = (const bf16_t*)(P.ws + OFF_WO + (size_t)l * SZ_MM); E.ssq_out = ssq + (size_t)(4 * l + 3) * T;
                }
                pg8::StaticOrder So; So.init(T, g.N, (int)gridDim.x, (int)blockIdx.x);
                E.dryrun = 0;
#if PROBE_GEMM
                for (int rep_ = 0; rep_ < 2; ++rep_) {
                pg8::Epi E2 = E;
                if (rep_ == 0) { if (PROBE_GEMM == 1) E2.dryrun = 1; else if (E.mode == 1) { E2.alpha = 0.f; } }
                __syncthreads();
                pg8::gemm_phase<pg8::Epi, pg8::StaticOrder, true, true>((PG8_LAS unsigned char*)smem, g, So, rep_ == 0 ? E2 : E);
                ++nbar; fast_grid_sync((unsigned*)(P.ws + OFF_BAR), nbar * gridDim.x);
                }
#else
                __syncthreads();
                pg8::gemm_phase<pg8::Epi, pg8::StaticOrder, true, true>((PG8_LAS unsigned char*)smem, g, So, E);
#endif
                if (ph == 1) {
                    GJob J;
                    J.A = xb; J.lda = D; J.ksplit = 1 << 30; J.kextra = 0; J.K = D; J.ntm = 4; J.mode = 3; J.rs = nullptr;
                    J.O = big; J.ldo = D; J.xin = P.out; J.xout = P.out; J.xb = xb; J.ssq_out = ssq; J.alpha = 1.f;
                    J.qg = nullptr; J.kg = nullptr; J.qn_end = 0; J.kn_end = 0; J.vt = nullptr; J.W = nullptr; J.ntn = 8;
                    gemm_phase(J, 0, 64, P, smem, false);
                }
                if (ph == 2 && !dry) knorm_phase(P);
            }
        }
        if (P.ws == nullptr) grid.sync();
        if (ph < 20) xcd_barrier(xbar);
        }
    }
}

extern "C" void kernel_launch(void* const* d_in, const int* in_sizes, int n_in, void* d_out, int out_size, void* d_ws, size_t ws_size,
                              hipStream_t stream) {
    static int grid_blocks = 0;
    if (!grid_blocks) {
        int dev = 0, cus = 0, per_cu = 0;
        hipGetDevice(&dev);
        hipDeviceGetAttribute(&cus, hipDeviceAttributeMultiprocessorCount, dev);
        hipFuncSetAttribute((const void*)fwd_megakernel, hipFuncAttributeMaxDynamicSharedMemorySize, LDS_BYTES);
        hipOccupancyMaxActiveBlocksPerMultiprocessor(&per_cu, fwd_megakernel, NTHR, LDS_BYTES);
        if (per_cu < 1) per_cu = 1;
        if (per_cu > 1) per_cu = 1;
        grid_blocks = cus * per_cu;
    }
    if (ws_size < WS_NEED) { fprintf(stderr, "workspace too small: %zu < %zu\n", ws_size, (size_t)WS_NEED); return; }
    Params p{};
    for (int i = 0; i < 25; ++i) p.in[i] = (const float*)d_in[i];
    p.out = (float*)d_out; p.ws = (char*)d_ws;
    hipMemsetAsync((char*)d_ws + OFF_BAR, 0, 16384, stream);
    void* args[] = {&p};
    hipError_t e = hipLaunchCooperativeKernel((void*)fwd_megakernel, dim3(grid_blocks), dim3(NTHR), args, LDS_BYTES, stream);
    if (e != hipSuccess) fprintf(stderr, "cooperative launch failed: %s (grid %d)\n", hipGetErrorString(e), grid_blocks);
}
```

```cpp
#include <hip/hip_runtime.h>
#include <hip/hip_cooperative_groups.h>
#include <cstdio>
#include <cstdint>
namespace cg = cooperative_groups;

#define DI __device__ __forceinline__
typedef unsigned short bf16_t;
typedef short bf16x8 __attribute__((ext_vector_type(8)));
typedef short s16x4 __attribute__((ext_vector_type(4)));
typedef float f32x16 __attribute__((ext_vector_type(16)));
typedef __bf16 bf2_t __attribute__((ext_vector_type(2)));
typedef float f2_t __attribute__((ext_vector_type(2)));
typedef short v4i16_t __attribute__((ext_vector_type(4)));
#define MFMA(a, b, c) __builtin_amdgcn_mfma_f32_32x32x16_bf16((a), (b), (c), 0, 0, 0)

constexpr int T = 16384, S = 4096, D = 1024, DFF = 2816, NGU = 5632;
constexpr float EPS = 1e-6f;
constexpr float LOG2E = 1.4426950408889634f;
constexpr float LN2 = 0.6931471805599453f;

constexpr size_t SZ_GU = (size_t)NGU * D * 2, SZ_DN = (size_t)D * DFF * 2, SZ_MM = (size_t)D * D * 2;
constexpr size_t OFF_GU1 = 0;
constexpr size_t OFF_DN1 = OFF_GU1 + 2 * SZ_GU;
constexpr size_t OFF_GU2 = OFF_DN1 + 2 * SZ_DN;
constexpr size_t OFF_DN2 = OFF_GU2 + 2 * SZ_GU;
constexpr size_t OFF_WQ = OFF_DN2 + 2 * SZ_DN;
constexpr size_t OFF_WKV = OFF_WQ + 2 * SZ_MM;
constexpr size_t OFF_WO = OFF_WKV + 4 * SZ_MM;
constexpr size_t OFF_EVIN = OFF_WO + 2 * SZ_MM;
constexpr size_t OFF_EVOUT = OFF_EVIN + (size_t)2304 * D * 2;
constexpr size_t OFF_ODIN = OFF_EVOUT + SZ_MM;
constexpr size_t OFF_ODOUT = OFF_ODIN + (size_t)3072 * D * 2;
constexpr size_t OFF_XB = OFF_ODOUT + SZ_MM;
constexpr size_t OFF_BIG = OFF_XB + (size_t)T * D * 2;
constexpr size_t OFF_MEMB = OFF_BIG + (size_t)T * 3072 * 2;
constexpr size_t OFF_KN = OFF_MEMB + SZ_MM;
constexpr size_t OFF_VT = OFF_KN + 2 * SZ_MM;
constexpr size_t OFF_SSQ = OFF_VT + 2 * SZ_MM;
constexpr size_t OFF_SSQM = OFF_SSQ + (size_t)9 * T * 4;
constexpr size_t OFF_KMAX = OFF_SSQM + 4096;
constexpr size_t OFF_BAR = OFF_KMAX + 256;
constexpr size_t OFF_KF = OFF_BAR + 16384;
constexpr size_t WS_NEED = OFF_KF + 2 * SZ_MM;

#ifndef PROBE_MASK
#define PROBE_MASK 0
#endif
#ifndef PROBE_GEMM
#define PROBE_GEMM 0
#endif
constexpr int NTHR = 512;
constexpr int NST = 4;
constexpr int STAGE_B = 32768;
constexpr int OPB = 16384;
constexpr int LDS_BYTES = 147712;

struct Params { const float* in[25]; float* out; char* ws; };

DI unsigned pk2(float a, float b) { f2_t v = {a, b}; bf2_t r = __builtin_convertvector(v, bf2_t); return __builtin_bit_cast(unsigned, r); }
typedef unsigned v4u_t __attribute__((ext_vector_type(4)));
DI __amdgpu_buffer_rsrc_t wt_rsrc(const void* base, size_t bytes) { return __builtin_amdgcn_make_buffer_rsrc((void*)base, (short)0, (int)bytes, 0x00020000); }
DI void st16_wt(__amdgpu_buffer_rsrc_t r, size_t byteoff, uint4 v) { const v4u_t x = {v.x, v.y, v.z, v.w}; __builtin_amdgcn_raw_buffer_store_b128(x, r, (unsigned)byteoff, 0, 16); }
DI void st16f_wt(__amdgpu_buffer_rsrc_t r, size_t byteoff, float4 v) { const v4u_t x = {__float_as_uint(v.x), __float_as_uint(v.y), __float_as_uint(v.z), __float_as_uint(v.w)}; __builtin_amdgcn_raw_buffer_store_b128(x, r, (unsigned)byteoff, 0, 16); }
DI float bflo(unsigned w) { return __uint_as_float(w << 16); }
DI float bfhi(unsigned w) { return __uint_as_float(w & 0xffff0000u); }
DI int otid() { int t = threadIdx.x; asm volatile("" : "+v"(t)); return t; }
DI int crow(int i, int h) { return (i & 3) + 8 * (i >> 2) + 4 * h; }
DI float fexp2(float x) { return __builtin_amdgcn_exp2f(x); }
DI float flog2(float x) { return __builtin_amdgcn_logf(x); }

struct WJob { const float* src; bf16_t* dst; const float* gain; int K, N, gu; };

DI int wjob_tiles(int j) {
    if (j < 14) {
        const int kind = j >> 1;
        switch (kind) {
            case 0: case 2: return 16 * 88;
            case 1: case 3: return 44 * 16;
            case 4: return 256;
            case 5: return 512;
            default: return 256;
        }
    }
    if (j == 14) return 16 * 36;
    if (j == 16) return 16 * 48;
    return 256;
}

DI WJob get_wjob(const Params& P, int j) {
    WJob w; w.gain = nullptr; w.gu = 0;
    bf16_t* wsb = (bf16_t*)P.ws;
    if (j < 14) {
        const int kind = j >> 1, l = j & 1;
        switch (kind) {
            case 0: w.src = P.in[3] + (size_t)l * D * NGU; w.dst = (bf16_t*)(P.ws + OFF_GU1 + l * SZ_GU); w.gain = P.in[2] + l * D; w.K = D; w.N = NGU; w.gu = 1; break;
            case 1: w.src = P.in[4] + (size_t)l * DFF * D; w.dst = (bf16_t*)(P.ws + OFF_DN1 + l * SZ_DN); w.K = DFF; w.N = D; w.gu = 2; break;
            case 2: w.src = P.in[23] + (size_t)l * D * NGU; w.dst = (bf16_t*)(P.ws + OFF_GU2 + l * SZ_GU); w.gain = P.in[22] + l * D; w.K = D; w.N = NGU; w.gu = 1; break;
            case 3: w.src = P.in[24] + (size_t)l * DFF * D; w.dst = (bf16_t*)(P.ws + OFF_DN2 + l * SZ_DN); w.K = DFF; w.N = D; w.gu = 2; break;
            case 4: w.src = P.in[17] + (size_t)l * D * D; w.dst = (bf16_t*)(P.ws + OFF_WQ + l * SZ_MM); w.gain = P.in[15] + l * D; w.K = D; w.N = D; w.gu = 2; break;
            case 5: w.src = P.in[18] + (size_t)l * D * 2048; w.dst = (bf16_t*)(P.ws + OFF_WKV + l * 2 * SZ_MM); w.gain = P.in[16] + l * D; w.K = D; w.N = 2048; break;
            default: w.src = P.in[21] + (size_t)l * D * D; w.dst = (bf16_t*)(P.ws + OFF_WO + l * SZ_MM); w.K = D; w.N = D; w.gu = 2; break;
        }
    } else if (j == 14) { w.src = P.in[6]; w.dst = (bf16_t*)(P.ws + OFF_EVIN); w.gain = P.in[5]; w.K = D; w.N = 2304; w.gu = 3; }
    else if (j == 15) { w.src = P.in[10]; w.dst = (bf16_t*)(P.ws + OFF_EVOUT); w.K = D; w.N = D; w.gu = 2; }
    else if (j == 16) { w.src = P.in[11]; w.dst = (bf16_t*)(P.ws + OFF_ODIN); w.gain = P.in[5] + D; w.K = D; w.N = 3072; w.gu = 2; }
    else { w.src = P.in[14]; w.dst = (bf16_t*)(P.ws + OFF_ODOUT); w.K = D; w.N = D; w.gu = 2; }
    (void)wsb;
    return w;
}

DI void wconv_tile(const WJob& w, int t, float* sm, int tid, bool act) {
    const int ntn = w.N >> 6; const int tk = t / ntn, tn = t - tk * ntn;
    if (act) {
#pragma unroll
        for (int p = 0; p < 4; ++p) {
            const int kr = p * 16 + (tid >> 4);
            typedef float f32x4nt __attribute__((ext_vector_type(4)));
            const f32x4nt v = __builtin_nontemporal_load((const f32x4nt*)(w.src + (size_t)(tk * 64 + kr) * w.N + tn * 64 + (tid & 15) * 4));
            const float g = w.gain ? w.gain[tk * 64 + kr] : 1.f;
            float* sp = sm + kr * 65 + (tid & 15) * 4;
            sp[0] = v[0] * g; sp[1] = v[1] * g; sp[2] = v[2] * g; sp[3] = v[3] * g;
        }
    }
    __syncthreads();
    if (act) {
        const int n = tid >> 2, kq = tid & 3; const int ng = tn * 64 + n;
        int drow = ng;
        if (w.gu == 1) drow = ng < DFF ? ((ng >> 7) * 256 + (ng & 127)) : (((ng - DFF) >> 7) * 256 + 128 + ((ng - DFF) & 127));
        else if (w.gu >= 2) {
            int a = ng;
            if (w.gu == 3) a = ng < 512 ? ng : ng < 768 ? ng + 512 : ng < 1280 ? ng - 256 : ng;
            drow = (a & ~255) + (((a >> 5) & 1) << 7) + (((a >> 6) & 3) << 5) + (a & 31);
        }
        unsigned o[8];
#pragma unroll
        for (int e = 0; e < 8; ++e) o[e] = pk2(sm[(kq * 16 + 2 * e) * 65 + n], sm[(kq * 16 + 2 * e + 1) * 65 + n]);
        uint4* dp = (uint4*)(w.dst + (size_t)drow * w.K + tk * 64 + kq * 16);
        dp[0] = make_uint4(o[0], o[1], o[2], o[3]); dp[1] = make_uint4(o[4], o[5], o[6], o[7]);
    }
    __syncthreads();
}

DI float wave_sum(float v) {
    v += __shfl_xor(v, 1); v += __shfl_xor(v, 2); v += __shfl_xor(v, 4); v += __shfl_xor(v, 8); v += __shfl_xor(v, 16); v += __shfl_xor(v, 32);
    return v;
}

DI void rowconv(const float* src, bf16_t* dst, float* ssq, int row, int lane) {
    const float* xr = src + (size_t)row * D;
    float ss = 0.f;
#pragma unroll
    for (int p = 0; p < 4; ++p) {
        const float4 v = *(const float4*)(xr + p * 256 + lane * 4);
        ss += v.x * v.x + v.y * v.y + v.z * v.z + v.w * v.w;
        *(uint2*)(dst + (size_t)row * D + p * 256 + lane * 4) = make_uint2(pk2(v.x, v.y), pk2(v.z, v.w));
    }
    ss = wave_sum(ss);
    if (lane == 0) ssq[row] = ss;
}

DI void phase0(const Params& P, char* smem) {
    const int tid = otid(), lane = tid & 63, wid = tid >> 6;
    float* ssq = (float*)(P.ws + OFF_SSQ);
    for (int i = blockIdx.x * NTHR + tid; i < 8 * T; i += gridDim.x * NTHR) ssq[T + i] = 0.f;
    if (blockIdx.x == 0 && tid < 32) ((unsigned*)(P.ws + OFF_KMAX))[tid] = 0u;
    constexpr int NW = 12352 / 2, NX = T / 8, NM = 1024 / 8;
    for (int u = blockIdx.x; u < NW + NX + NM; u += gridDim.x) {
        if (u < NW) {
            const int half = tid >> 8;
            int t = 2 * u + half, j = 0;
            for (; j < 17; ++j) { const int c = wjob_tiles(j); if (t < c) break; t -= c; }
            const WJob w = get_wjob(P, j);
            wconv_tile(w, t, (float*)smem + half * (64 * 65), tid & 255, true);
        } else if (u < NW + NX) {
            rowconv(P.in[0], (bf16_t*)(P.ws + OFF_XB), ssq, (u - NW) * 8 + wid, lane);
        } else {
            rowconv(P.in[1], (bf16_t*)(P.ws + OFF_MEMB), (float*)(P.ws + OFF_SSQM), (u - NW - NX) * 8 + wid, lane);
        }
    }
}

struct GJob {
    const bf16_t* A; const bf16_t* W;
    int lda, ksplit, kextra, K, ntm, ntn, mode;
    const float* rs;
    bf16_t* O; int ldo;
    const float* xin; float* xout; bf16_t* xb; float* ssq_out; float alpha;
    const float* qg; const float* kg; int qn_end, kn_end;
    bf16_t* vt;
};

typedef __attribute__((address_space(3))) unsigned* ldsu_t;
typedef const __attribute__((address_space(1))) unsigned* glbu_t;
DI void glds16(const bf16_t* g, char* l) { __builtin_amdgcn_global_load_lds((glbu_t)(const void*)g, (ldsu_t)(void*)l, 16, 0, 0); }

DI void gemm_tile(const GJob& J, int t, char* smem, bool dry) {
    const int tid = otid(), lane = tid & 63, wid = tid >> 6, wr = wid >> 2, wc = wid & 3;
    const int r = lane & 31, h = lane >> 5;
    int tm, tn;
    { const int gsz = 32 * J.ntn; const int g = t / gsz; const int rem = t - g * gsz; const int rows = min(32, J.ntm - g * 32); tn = rem / rows; tm = g * 32 + (rem - tn * rows); }
    const int lrow = wid * 16 + (lane >> 2);
    const int csw = ((lane & 3) ^ ((lane >> 4) & 3)) * 8;
    const bf16_t* Ag = J.A + (size_t)(tm * 256 + lrow) * J.lda + csw;
    const bf16_t* Wg = J.W + (size_t)(tn * 256 + lrow) * J.K + csw;
    const size_t astr = (size_t)128 * J.lda, wstr = (size_t)128 * J.K;
    char* lb = smem + tid * 16;
    const int nk = J.K >> 5;
#define GLDS(kt, buf) do { const int k0_ = (kt) * 32; const int ka_ = k0_ + (k0_ >= J.ksplit ? J.kextra : 0); char* l_ = lb + (buf) * STAGE_B; \
        glds16(Ag + ka_, l_); glds16(Ag + astr + ka_, l_ + 8192); glds16(Wg + k0_, l_ + OPB); glds16(Wg + wstr + k0_, l_ + OPB + 8192); } while (0)
    f32x16 acc[4][2];
#pragma unroll
    for (int a = 0; a < 4; ++a)
#pragma unroll
        for (int b = 0; b < 2; ++b)
#pragma unroll
            for (int i = 0; i < 16; ++i) acc[a][b][i] = 0.f;
    const int fr = (r >> 2) & 3;
    const int xrow = (wc * 64 + r) * 64, wrow = OPB + (wr * 128 + r) * 64;
    const int co0 = ((0 + h) ^ fr) * 16, co1 = ((2 + h) ^ fr) * 16;

    __syncthreads();
    GLDS(0, 0); GLDS(1, 1); GLDS(2, 2);
    asm volatile("s_waitcnt vmcnt(8)" ::: "memory");
    __builtin_amdgcn_s_barrier();
    bf16x8 w0[4], x0[2], w1[4], x1[2];
#define LOADF(W_, X_, sb_, co_) do { _Pragma("unroll") for (int ti = 0; ti < 2; ++ti) X_[ti] = *(const bf16x8*)((sb_) + xrow + ti * 2048 + (co_)); \
        _Pragma("unroll") for (int fi = 0; fi < 4; ++fi) W_[fi] = *(const bf16x8*)((sb_) + wrow + fi * 2048 + (co_)); } while (0)
#define MFMA8(W_, X_) do { __builtin_amdgcn_s_setprio(1); _Pragma("unroll") for (int fi = 0; fi < 4; ++fi) _Pragma("unroll") for (int ti = 0; ti < 2; ++ti) \
        acc[fi][ti] = MFMA(W_[fi], X_[ti], acc[fi][ti]); __builtin_amdgcn_s_setprio(0); } while (0)
    LOADF(w0, x0, smem, co0);
    __builtin_amdgcn_s_waitcnt(0xC07F);
    int buf = 0;
    for (int kt = 0; kt < nk; ++kt) {
        const char* sb = smem + buf * STAGE_B;
        LOADF(w1, x1, sb, co1);
        __builtin_amdgcn_sched_barrier(0);
        MFMA8(w0, x0);
        __builtin_amdgcn_s_waitcnt(0xC07F);
        __builtin_amdgcn_sched_barrier(0);
        const int nb = (buf + 1 == NST) ? 0 : buf + 1;
        if (kt + 1 < nk) {
            if (kt + 2 < nk) asm volatile("s_waitcnt vmcnt(4)" ::: "memory"); else asm volatile("s_waitcnt vmcnt(0)" ::: "memory");
            __builtin_amdgcn_s_barrier();
            if (kt + 3 < nk) { const int fb_ = (buf + 3 >= NST) ? buf + 3 - NST : buf + 3; GLDS(kt + 3, fb_); }
        }
        LOADF(w0, x0, smem + nb * STAGE_B, co0);
        __builtin_amdgcn_sched_barrier(0);
        MFMA8(w1, x1);
        __builtin_amdgcn_s_waitcnt(0xC07F);
        __builtin_amdgcn_sched_barrier(0);
        buf = nb;
    }
#undef LOADF
#undef MFMA8
#undef GLDS
    __syncthreads();

    if (dry) { if (acc[0][0][0] + acc[1][1][0] + acc[2][0][0] + acc[3][1][0] == 12345.678f) J.O[0] = 1; return; }
    const int tokb = tm * 256 + wc * 64;
    const int fb = tn * 256 + wr * 128;
    float rsc[2];
#pragma unroll
    for (int ti = 0; ti < 2; ++ti) rsc[ti] = J.rs ? __builtin_amdgcn_rsqf(J.rs[tokb + ti * 32 + r] * (1.f / 1024.f) + EPS) : 1.f;

    if (J.mode == 3 && fb >= 1024) {
#pragma unroll
        for (int ti = 0; ti < 2; ++ti) {
            const int tok = tokb + ti * 32 + r;
#pragma unroll
            for (int fi = 0; fi < 4; ++fi)
#pragma unroll
                for (int i = 0; i < 16; ++i) {
                    const int f = fb - 1024 + fi * 32 + crow(i, h);
                    const int bh_ = (tok >> 8) * 4 + (f >> 8), d_ = f & 255, key_ = tok & 255, k16 = key_ & 15;
                    const int ln_ = ((k16 >> 2) & 1) * 32 + (d_ & 31), e_ = ((k16 >> 3) << 2) | (k16 & 3);
                    J.vt[((((((size_t)bh_ * 8 + (d_ >> 5)) * 8 + (key_ >> 5)) * 2 + ((key_ >> 4) & 1)) * 64 + ln_) << 3) + e_] = (bf16_t)(pk2(acc[fi][ti][i] * rsc[ti], 0.f) & 0xffffu);
                }
        }
        return;
    }
    char* wl = smem + wid * 16384;
#pragma unroll
    for (int ti = 0; ti < 2; ++ti) {
#pragma unroll
        for (int fp = 0; fp < 2; ++fp) {
            const float sc = (J.mode == 1) ? J.alpha : rsc[ti];
#pragma unroll
            for (int fi2 = 0; fi2 < 2; ++fi2)
#pragma unroll
                for (int g = 0; g < 4; ++g) {
                    float4 v;
                    v.x = acc[2 * fp + fi2][ti][4 * g + 0] * sc; v.y = acc[2 * fp + fi2][ti][4 * g + 1] * sc;
                    v.z = acc[2 * fp + fi2][ti][4 * g + 2] * sc; v.w = acc[2 * fp + fi2][ti][4 * g + 3] * sc;
                    *(float4*)(wl + r * 272 + (fi2 * 32 + 8 * g + 4 * h) * 4) = v;
                }
            const int tok0 = tokb + ti * 32, f0 = fb + fp * 64;
            if (J.mode == 0) {
                const int c4 = (lane & 7) * 4;
#pragma unroll
                for (int p = 0; p < 4; ++p) {
                    const int row = p * 8 + (lane >> 3);
                    const float4 ga = *(const float4*)(wl + row * 272 + c4 * 4);
                    const float4 up = *(const float4*)(wl + row * 272 + (32 + c4) * 4);
                    float y0 = ga.x * up.x * __builtin_amdgcn_rcpf(1.f + fexp2(-ga.x * LOG2E));
                    float y1 = ga.y * up.y * __builtin_amdgcn_rcpf(1.f + fexp2(-ga.y * LOG2E));
                    float y2 = ga.z * up.z * __builtin_amdgcn_rcpf(1.f + fexp2(-ga.z * LOG2E));
                    float y3 = ga.w * up.w * __builtin_amdgcn_rcpf(1.f + fexp2(-ga.w * LOG2E));
                    *(uint2*)(J.O + (size_t)(tok0 + row) * J.ldo + (f0 >> 1) + c4) = make_uint2(pk2(y0, y1), pk2(y2, y3));
                }
            } else if (J.mode == 1) {
                const int c4 = (lane & 15) * 4;
#pragma unroll
                for (int p = 0; p < 8; ++p) {
                    const int row = p * 4 + (lane >> 4);
                    const size_t tok = tok0 + row;
                    const float4 v = *(const float4*)(wl + row * 272 + c4 * 4);
                    const float4 xo = *(const float4*)(J.xin + tok * D + f0 + c4);
                    float4 xn; xn.x = xo.x + v.x; xn.y = xo.y + v.y; xn.z = xo.z + v.z; xn.w = xo.w + v.w;
                    *(float4*)(J.xout + tok * D + f0 + c4) = xn;
                    if (J.xb) {
                        *(uint2*)(J.xb + tok * D + f0 + c4) = make_uint2(pk2(xn.x, xn.y), pk2(xn.z, xn.w));
                        float ss = xn.x * xn.x + xn.y * xn.y + xn.z * xn.z + xn.w * xn.w;
                        ss += __shfl_xor(ss, 1); ss += __shfl_xor(ss, 2); ss += __shfl_xor(ss, 4); ss += __shfl_xor(ss, 8);
                        if ((lane & 15) == 0) atomicAdd(J.ssq_out + tok, ss);
                    }
                }
            } else {
                const int nm = f0 < J.qn_end ? 1 : (f0 < J.kn_end ? 2 : 0);
                const float* gp = nm == 1 ? J.qg : J.kg;
                const int c4 = (lane & 15) * 4;
                float4 gn = make_float4(1.f, 1.f, 1.f, 1.f);
                if (nm) gn = *(const float4*)(gp + c4);
#pragma unroll
                for (int p = 0; p < 8; ++p) {
                    const int row = p * 4 + (lane >> 4);
                    float4 v = *(const float4*)(wl + row * 272 + c4 * 4);
                    if (nm) {
                        float ss = v.x * v.x + v.y * v.y + v.z * v.z + v.w * v.w;
                        ss += __shfl_xor(ss, 1); ss += __shfl_xor(ss, 2); ss += __shfl_xor(ss, 4); ss += __shfl_xor(ss, 8);
                        const float inv = __builtin_amdgcn_rsqf(ss * (1.f / 64.f) + EPS);
                        v.x *= inv * gn.x; v.y *= inv * gn.y; v.z *= inv * gn.z; v.w *= inv * gn.w;
                    }
                    *(uint2*)(J.O + (size_t)(tok0 + row) * J.ldo + f0 + c4) = make_uint2(pk2(v.x, v.y), pk2(v.z, v.w));
                }
            }
        }
    }
}

DI void gemm_phase(const GJob& JA, int nA, int nB, const Params& P, char* smem, bool dry) {
    for (int u = (int)gridDim.x - 1 - (int)blockIdx.x; u < nA + nB; u += gridDim.x) {
        GJob J = JA; int t = u;
        if (u >= nA) {
            const int v = u - nA; const int layer = v >> 5; t = v & 31;
            J.A = (const bf16_t*)(P.ws + OFF_MEMB); J.lda = D; J.ksplit = 1 << 30; J.kextra = 0;
            J.W = (const bf16_t*)(P.ws + OFF_WKV + (size_t)layer * 2 * SZ_MM); J.K = D; J.ntm = 4; J.ntn = 8; J.mode = 3;
            J.rs = (const float*)(P.ws + OFF_SSQM); J.O = (bf16_t*)(P.ws + OFF_KN + (size_t)layer * SZ_MM); J.ldo = D;
            J.qn_end = 0; J.kn_end = 0; J.vt = (bf16_t*)(P.ws + OFF_VT + (size_t)layer * SZ_MM);
        }
        gemm_tile(J, t, smem, dry);
    }
}

namespace pg8 {
#define PG8_LAS __attribute__((address_space(3)))
typedef float f32x4 __attribute__((ext_vector_type(4)));
typedef unsigned u32x4 __attribute__((ext_vector_type(4)));
constexpr int BM = 256, BK = 64, HALF = 128, HTB = HALF * BK * 2, STAGE_BYTES = 8 * HTB, NXCD = 8, WGM = 8;
DI int lds_byte(int r, int c) { const int st = (r >> 4) * 2 + (c >> 5), rr = r & 15, cc = c & 31, ob = rr * 64 + cc * 2; return st * 1024 + (ob ^ (((ob >> 9) & 1) << 5)); }
DI void stage_rc(int b, int& R, int& C) { const int st = b / 1024, sb = b % 1024, swz = sb ^ (((sb >> 9) & 1) << 5); R = (st >> 1) * 16 + swz / 64; C = (st & 1) * 32 + (swz % 64) / 2; }
DI int perm32(int rho) { const int n = rho >> 4, i = rho & 15; return 8 * (i >> 2) + 4 * n + (i & 3); }
struct Unit { int pm, pn; };
struct Gemm { const bf16_t* A; const bf16_t* Bt; int M, N, K, lda; };
struct StaticOrder {
    int nM, nN, nwg, G, c;
    DI void init(int M, int N, int G_, int c_) { nM = M / BM; nN = N / BM; nwg = nM * nN; G = G_; c = c_; }
    DI bool next(int i, Unit& u) const {
        const long L = (long)i * G + c; if (L >= nwg) return false;
        int wgid = (int)L; { const int q = nwg / NXCD, r = nwg % NXCD, xcd = wgid % NXCD, off = wgid / NXCD; wgid = (xcd < r ? xcd * (q + 1) : r * (q + 1) + (xcd - r) * q) + off; }
        const int nig = WGM * nN, gid = wgid / nig, fm = gid * WGM, gsz = (nM - fm) < WGM ? (nM - fm) : WGM;
        u.pm = fm + ((wgid % nig) % gsz); u.pn = (wgid % nig) / gsz; return true;
    }
    DI void a_ready(const Unit&) const {}
    DI void done(const Unit&) const {}
};

struct Epi {
    static constexpr bool PERM = true, AFTER_DRAIN = false;
    int mode;
    const float* rs;
    bf16_t* O; int ldo;
    const float* xin; float* xout; bf16_t* xb; float* ssq_out; float alpha;
    const float* qg; const float* kg; int qn_end, kn_beg, kn_end; int dryrun;
    template <bool SRC_F32, bool DST_F32>
    DI void res_path(const f32x4 (&acc)[2][2][4][2], int row0, int colb, int fq) const {
        const __amdgpu_buffer_rsrc_t r_xb = wt_rsrc(xb, (size_t)T * D * 2), r_out = wt_rsrc(DST_F32 ? (const void*)xout : (const void*)xb, (size_t)T * D * (DST_F32 ? 4 : 2));
#pragma unroll
        for (int ai = 0; ai < 2; ++ai) {
            float4 xf[4][2][2];
            uint4 xw[4][2];
#pragma unroll
            for (int m = 0; m < 4; ++m)
#pragma unroll
                for (int bj = 0; bj < 2; ++bj) {
                    const size_t off = (size_t)(row0 + ai * HALF + m * 16) * D + colb + bj * 32;
                    if (SRC_F32) { xf[m][bj][0] = *(const float4*)(xin + off); xf[m][bj][1] = *(const float4*)(xin + off + 4); }
                    else xw[m][bj] = *(const uint4*)(xb + off);
                }
#pragma unroll
            for (int m = 0; m < 4; ++m) {
                const size_t tok = row0 + ai * HALF + m * 16;
                float ss = 0.f;
#pragma unroll
                for (int bj = 0; bj < 2; ++bj) {
                    const size_t off = tok * D + colb + bj * 32;
                    float4 x0, x1;
                    if (SRC_F32) { x0 = xf[m][bj][0]; x1 = xf[m][bj][1]; }
                    else { const uint4 w = xw[m][bj]; x0 = make_float4(bflo(w.x), bfhi(w.x), bflo(w.y), bfhi(w.y)); x1 = make_float4(bflo(w.z), bfhi(w.z), bflo(w.w), bfhi(w.w)); }
                    float4 n0, n1;
                    n0.x = x0.x + alpha * acc[ai][bj][m][0][0]; n0.y = x0.y + alpha * acc[ai][bj][m][0][1]; n0.z = x0.z + alpha * acc[ai][bj][m][0][2]; n0.w = x0.w + alpha * acc[ai][bj][m][0][3];
                    n1.x = x1.x + alpha * acc[ai][bj][m][1][0]; n1.y = x1.y + alpha * acc[ai][bj][m][1][1]; n1.z = x1.z + alpha * acc[ai][bj][m][1][2]; n1.w = x1.w + alpha * acc[ai][bj][m][1][3];
                    if (DST_F32) { st16f_wt(r_out, off * 4, n0); st16f_wt(r_out, off * 4 + 16, n1); }
                    else {
                        const uint4 w = make_uint4(pk2(n0.x, n0.y), pk2(n0.z, n0.w), pk2(n1.x, n1.y), pk2(n1.z, n1.w));
                        st16_wt(r_xb, off * 2, w);
                        const float r0 = bflo(w.x), r1 = bfhi(w.x), r2 = bflo(w.y), r3 = bfhi(w.y), r4 = bflo(w.z), r5 = bfhi(w.z), r6 = bflo(w.w), r7 = bfhi(w.w);
                        ss += r0 * r0 + r1 * r1 + r2 * r2 + r3 * r3 + r4 * r4 + r5 * r5 + r6 * r6 + r7 * r7;
                    }
                }
                if (!DST_F32) {
                    ss += __shfl_xor(ss, 16); ss += __shfl_xor(ss, 32);
                    if (fq == 0) atomicAdd(ssq_out + tok, ss);
                }
            }
        }
    }
    template <bool NM>
    DI void qkv_path(const f32x4 (&acc)[2][2][4][2], int row0, int f0, int fq, const float* gp) const {
        const __amdgpu_buffer_rsrc_t r_o = wt_rsrc(O, (size_t)T * ldo * 2);
        float4 g4[2][2];
#pragma unroll
        for (int bj = 0; bj < 2; ++bj)
#pragma unroll
            for (int n = 0; n < 2; ++n) g4[bj][n] = NM ? *(const float4*)(gp + bj * 32 + 8 * fq + 4 * n) : make_float4(1.f, 1.f, 1.f, 1.f);
        float sc8[2][4];
#pragma unroll
        for (int ai = 0; ai < 2; ++ai)
#pragma unroll
            for (int m = 0; m < 4; ++m) sc8[ai][m] = rs[row0 + ai * HALF + m * 16];
#pragma unroll
        for (int ai = 0; ai < 2; ++ai)
#pragma unroll
            for (int m = 0; m < 4; ++m) {
                const size_t tok = row0 + ai * HALF + m * 16;
                float sc = __builtin_amdgcn_rsqf(sc8[ai][m] * (1.f / 1024.f) + EPS);
                if (NM) {
                    float ss = 0.f;
#pragma unroll
                    for (int bj = 0; bj < 2; ++bj)
#pragma unroll
                        for (int n = 0; n < 2; ++n)
#pragma unroll
                            for (int j = 0; j < 4; ++j) { const float v = acc[ai][bj][m][n][j] * sc; ss += v * v; }
                    ss += __shfl_xor(ss, 16); ss += __shfl_xor(ss, 32);
                    sc *= __builtin_amdgcn_rsqf(ss * (1.f / 64.f) + EPS);
                }
#pragma unroll
                for (int bj = 0; bj < 2; ++bj) {
                    const f32x4 a0 = acc[ai][bj][m][0], a1 = acc[ai][bj][m][1];
                    st16_wt(r_o, (tok * ldo + f0 + bj * 32 + 8 * fq) * 2,
                        make_uint4(pk2(a0[0] * sc * g4[bj][0].x, a0[1] * sc * g4[bj][0].y), pk2(a0[2] * sc * g4[bj][0].z, a0[3] * sc * g4[bj][0].w),
                                   pk2(a1[0] * sc * g4[bj][1].x, a1[1] * sc * g4[bj][1].y), pk2(a1[2] * sc * g4[bj][1].z, a1[3] * sc * g4[bj][1].w)));
                }
            }
    }
    DI void operator()(const f32x4 (&acc)[2][2][4][2], const Unit& u, int wr, int wc, int fr, int fq) const {
        if (dryrun) { if (acc[0][0][0][0][0] + acc[1][1][3][1][3] + acc[0][1][2][0][1] + acc[1][0][1][1][2] == 12345.678f) O[0] = 1; return; }
        const int row0 = u.pm * BM + wr * 64 + fr;
        if (mode == 0) {
            const int col = u.pn * 128 + wc * 32 + 8 * fq;
            const __amdgpu_buffer_rsrc_t r_o = wt_rsrc(O, (size_t)T * ldo * 2);
            float sc8[2][4];
#pragma unroll
            for (int ai = 0; ai < 2; ++ai)
#pragma unroll
                for (int m = 0; m < 4; ++m) sc8[ai][m] = rs[row0 + ai * HALF + m * 16];
#pragma unroll
            for (int ai = 0; ai < 2; ++ai)
#pragma unroll
                for (int m = 0; m < 4; ++m) {
                    const size_t tok = row0 + ai * HALF + m * 16;
                    const float sc = __builtin_amdgcn_rsqf(sc8[ai][m] * (1.f / 1024.f) + EPS);
                    float y[8];
#pragma unroll
                    for (int n = 0; n < 2; ++n)
#pragma unroll
                        for (int j = 0; j < 4; ++j) {
                            const float ga = acc[ai][0][m][n][j] * sc, up = acc[ai][1][m][n][j] * sc;
                            y[4 * n + j] = ga * up * __builtin_amdgcn_rcpf(1.f + fexp2(-ga * LOG2E));
                        }
                    st16_wt(r_o, (tok * ldo + col) * 2, make_uint4(pk2(y[0], y[1]), pk2(y[2], y[3]), pk2(y[4], y[5]), pk2(y[6], y[7])));
                }
        } else if (mode == 1) {
            const int colb = u.pn * BM + wc * 64 + 8 * fq;
            if (xin) res_path<true, false>(acc, row0, colb, fq);
            else if (xout) res_path<false, true>(acc, row0, colb, fq);
            else res_path<false, false>(acc, row0, colb, fq);
        } else {
            const int f0 = u.pn * BM + wc * 64;
            const int nm = f0 < qn_end ? 1 : ((f0 >= kn_beg && f0 < kn_end) ? 2 : 0);
            if (nm) qkv_path<true>(acc, row0, f0, fq, nm == 1 ? qg : kg);
            else qkv_path<false>(acc, row0, f0, fq, nullptr);
        }
    }
};

template <class Epi, class Sched, bool ALIGN_EPI = false, bool SP2 = false>
__device__ __forceinline__ void gemm_phase(PG8_LAS unsigned char* lds, const Gemm g, const Sched& S, const Epi& E) {
    const int tid = otid(), wid = __builtin_amdgcn_readfirstlane(tid >> 6), lane = tid & 63, wr = wid >> 2, wc = wid & 3, fr = lane & 15, fq = lane >> 4;
    const int K = g.K, nt = K / BK;
    unsigned voffA[2], voffB[2];
#pragma unroll
    for (int i = 0; i < 2; ++i) { int R, C; stage_rc(tid * 16 + i * 8192, R, C); const int Rb = Epi::PERM ? ((R & ~31) + perm32(R & 31)) : R;
        voffA[i] = (unsigned)(R * g.lda + C) * 2u; voffB[i] = (unsigned)(Rb * K + C) * 2u; }
    const size_t kstep = (size_t)(BK * 2);
    const size_t hstepA = (size_t)HALF * g.lda * 2, hstepB = (size_t)HALF * K * 2;
    const size_t tstepA = 2 * hstepA, tstepB = 2 * hstepB;
    const unsigned ldsw = (unsigned)wid * 1024u;
    const int aoff = lds_byte(wr * 64 + fr, fq * 8), boff = lds_byte(wc * 32 + fr, fq * 8);
#define PG8_SA(b, h) (((b) * 2 + (h)) * HTB)
#define PG8_SB(b, h) ((4 + (b) * 2 + (h)) * HTB)
#define PG8_STAGE(bufoff, gbase, voff) do { _Pragma("unroll") for (int _i = 0; _i < 2; ++_i) \
        __builtin_amdgcn_global_load_lds((const unsigned*)((const char*)(gbase) + (voff)[_i]), (PG8_LAS unsigned*)(lds + (bufoff) + ldsw + _i * 8192), 16, 0, 0); } while (0)
#define PG8_LDA(dst, b, h) do { _Pragma("unroll") for (int m = 0; m < 4; ++m) _Pragma("unroll") for (int k = 0; k < 2; ++k) dst[m][k] = *(const PG8_LAS bf16x8*)(lds + PG8_SA(b, h) + aoff + m * 2048 + k * 1024); } while (0)
#define PG8_LDB(dst, b, h) do { _Pragma("unroll") for (int n = 0; n < 2; ++n) _Pragma("unroll") for (int k = 0; k < 2; ++k) dst[n][k] = *(const PG8_LAS bf16x8*)(lds + PG8_SB(b, h) + boff + n * 2048 + k * 1024); } while (0)
#define PG8_MMA(ai, bj, At, Bt) do { __builtin_amdgcn_s_setprio(1); _Pragma("unroll") for (int m = 0; m < 4; ++m) _Pragma("unroll") for (int n = 0; n < 2; ++n) _Pragma("unroll") for (int k = 0; k < 2; ++k) \
        acc[ai][bj][m][n] = __builtin_amdgcn_mfma_f32_16x16x32_bf16(Bt[n][k], At[m][k], acc[ai][bj][m][n], 0, 0, 0); __builtin_amdgcn_s_setprio(0); } while (0)
#define PG8_WAIT_V(n) asm volatile("s_waitcnt vmcnt(" #n ")" ::: "memory")
#define PG8_WAIT_L(n) asm volatile("s_waitcnt lgkmcnt(" #n ")" ::: "memory")
#define PG8_BAR __builtin_amdgcn_s_barrier()
#define PG8_SCHED __builtin_amdgcn_sched_barrier(0)
    Unit cur, nxt; int ui = 0;
    if (!S.next(0, cur)) return;
    f32x4 acc[2][2][4][2];
#pragma unroll
    for (int a = 0; a < 2; ++a)
#pragma unroll
        for (int b = 0; b < 2; ++b)
#pragma unroll
            for (int m = 0; m < 4; ++m)
#pragma unroll
                for (int n = 0; n < 2; ++n) acc[a][b][m][n] = (f32x4){0.f, 0.f, 0.f, 0.f};
    bf16x8 At[4][2], B0[2][2], B1[2][2];
    const char* cA = (const char*)g.A + (size_t)cur.pm * tstepA; const char* cB = (const char*)g.Bt + (size_t)cur.pn * tstepB;
    S.a_ready(cur);
    if constexpr (SP2) {
        PG8_STAGE(PG8_SB(0, 0), cB, voffB); PG8_STAGE(PG8_SB(0, 1), cB + hstepB, voffB); PG8_STAGE(PG8_SA(0, 0), cA, voffA); PG8_STAGE(PG8_SA(0, 1), cA + hstepA, voffA);
        if (wr == 1) PG8_BAR;
        PG8_WAIT_V(2); PG8_BAR;
        PG8_STAGE(PG8_SB(1, 0), cB + kstep, voffB); PG8_STAGE(PG8_SA(1, 0), cA + kstep, voffA); PG8_STAGE(PG8_SB(1, 1), cB + hstepB + kstep, voffB);
        PG8_WAIT_V(6); PG8_BAR;
    } else {
        PG8_STAGE(PG8_SB(0, 0), cB, voffB); PG8_STAGE(PG8_SA(0, 0), cA, voffA); PG8_STAGE(PG8_SB(0, 1), cB + hstepB, voffB); PG8_STAGE(PG8_SA(0, 1), cA + hstepA, voffA);
        if (wr == 1) PG8_BAR;
        PG8_WAIT_V(4); PG8_BAR;
        PG8_STAGE(PG8_SB(1, 0), cB + kstep, voffB); PG8_STAGE(PG8_SA(1, 0), cA + kstep, voffA); PG8_STAGE(PG8_SB(1, 1), cB + hstepB + kstep, voffB);
        PG8_WAIT_V(6); PG8_BAR;
    }
    for (;;) {
        const bool has_next = S.next(ui + 1, nxt);
        const char* nA = has_next ? (const char*)g.A + (size_t)nxt.pm * tstepA : cA; const char* nB = has_next ? (const char*)g.Bt + (size_t)nxt.pn * tstepB : cB;
        for (int t = 0; t < nt; t += 2) {
            const bool last = (t == nt - 2);
            const char* a1 = cA + (size_t)(t + 1) * kstep;
            const char* a2 = last ? nA : cA + (size_t)(t + 2) * kstep; const char* b2 = last ? nB : cB + (size_t)(t + 2) * kstep;
            const char* a3 = a2 + kstep; const char* b3 = b2 + kstep;
            if (last && has_next) S.a_ready(nxt);
            if constexpr (SP2) {
            PG8_LDB(B0, 0, 0); PG8_LDB(B1, 0, 1); PG8_SCHED; PG8_LDA(At, 0, 0); PG8_STAGE(PG8_SA(1, 1), a1 + hstepA, voffA);
            PG8_WAIT_V(8); PG8_WAIT_L(0); PG8_BAR; PG8_MMA(0, 0, At, B0); PG8_MMA(0, 1, At, B1); PG8_BAR; PG8_SCHED;
            PG8_LDA(At, 0, 1); PG8_STAGE(PG8_SB(0, 0), b2, voffB); PG8_STAGE(PG8_SB(0, 1), b2 + hstepB, voffB); PG8_STAGE(PG8_SA(0, 0), a2, voffA);
            PG8_WAIT_V(8); PG8_WAIT_L(0); PG8_BAR; PG8_MMA(1, 0, At, B0); PG8_MMA(1, 1, At, B1); PG8_BAR; PG8_SCHED;
            PG8_LDB(B0, 1, 0); PG8_LDB(B1, 1, 1); PG8_SCHED; PG8_LDA(At, 1, 0); PG8_STAGE(PG8_SA(0, 1), a2 + hstepA, voffA);
            PG8_WAIT_V(8); PG8_WAIT_L(0); PG8_BAR; PG8_MMA(0, 0, At, B0); PG8_MMA(0, 1, At, B1); PG8_BAR; PG8_SCHED;
            PG8_LDA(At, 1, 1); PG8_STAGE(PG8_SB(1, 0), b3, voffB); PG8_STAGE(PG8_SB(1, 1), b3 + hstepB, voffB); PG8_STAGE(PG8_SA(1, 0), a3, voffA);
            PG8_WAIT_V(8); PG8_WAIT_L(0); PG8_BAR; PG8_MMA(1, 0, At, B0); PG8_MMA(1, 1, At, B1); PG8_BAR; PG8_SCHED;
            } else {
            PG8_LDB(B0, 0, 0); PG8_SCHED; PG8_LDA(At, 0, 0); PG8_STAGE(PG8_SA(1, 1), a1 + hstepA, voffA);
            PG8_WAIT_L(8); PG8_BAR; PG8_WAIT_L(0); PG8_MMA(0, 0, At, B0); PG8_BAR; PG8_SCHED;
            PG8_LDB(B1, 0, 1); PG8_STAGE(PG8_SB(0, 0), b2, voffB);
            PG8_BAR; PG8_WAIT_L(0); PG8_MMA(0, 1, At, B1); PG8_BAR;
            PG8_LDA(At, 0, 1); PG8_STAGE(PG8_SA(0, 0), a2, voffA);
            PG8_BAR; PG8_WAIT_L(0); PG8_MMA(1, 0, At, B0); PG8_BAR; PG8_SCHED;
            PG8_STAGE(PG8_SB(0, 1), b2 + hstepB, voffB);
            PG8_WAIT_V(6); PG8_BAR; PG8_MMA(1, 1, At, B1); PG8_BAR;
            PG8_LDB(B0, 1, 0); PG8_SCHED; PG8_LDA(At, 1, 0); PG8_STAGE(PG8_SA(0, 1), a2 + hstepA, voffA);
            PG8_WAIT_L(8); PG8_BAR; PG8_WAIT_L(0); PG8_MMA(0, 0, At, B0); PG8_BAR; PG8_SCHED;
            PG8_LDB(B1, 1, 1); PG8_STAGE(PG8_SB(1, 0), b3, voffB);
            PG8_BAR; PG8_WAIT_L(0); PG8_MMA(0, 1, At, B1); PG8_BAR;
            PG8_LDA(At, 1, 1); PG8_STAGE(PG8_SA(1, 0), a3, voffA);
            PG8_BAR; PG8_WAIT_L(0); PG8_MMA(1, 0, At, B0); PG8_BAR; PG8_SCHED;
            PG8_STAGE(PG8_SB(1, 1), b3 + hstepB, voffB);
            PG8_WAIT_V(6); PG8_BAR; PG8_MMA(1, 1, At, B1); PG8_BAR;
            }
        }
        if constexpr (ALIGN_EPI) { if (wr == 0) PG8_BAR; }
        if constexpr (!Epi::AFTER_DRAIN) { E(acc, cur, wr, wc, fr, fq); S.done(cur); }
        if (!has_next) break;
#pragma unroll
        for (int a = 0; a < 2; ++a)
#pragma unroll
            for (int b = 0; b < 2; ++b)
#pragma unroll
                for (int m = 0; m < 4; ++m)
#pragma unroll
                    for (int n = 0; n < 2; ++n) acc[a][b][m][n] = (f32x4){0.f, 0.f, 0.f, 0.f};
        cur = nxt; cA = nA; cB = nB; ++ui;
        if constexpr (ALIGN_EPI) { if (wr == 1) PG8_BAR; }
    }
    PG8_WAIT_V(0);
    if constexpr (!ALIGN_EPI) { if (wr == 0) PG8_BAR; }
    PG8_BAR;
    if constexpr (Epi::AFTER_DRAIN) { E.fused(acc, cur, wr, wc, fr, fq, lds, wid, lane); S.done(cur); }
#undef PG8_SA
#undef PG8_SB
#undef PG8_STAGE
#undef PG8_LDA
#undef PG8_LDB
#undef PG8_MMA
#undef PG8_WAIT_V
#undef PG8_WAIT_L
#undef PG8_BAR
#undef PG8_SCHED
}
}

#define KV_DECL uint4 rk0, rk1, rk2, rk3, rv0, rv1, rv2, rv3
#define KV_LOAD(kb_, dil_) do { const int kk_ = lane >> 3; \
    const bf16_t* p0_ = qkv + (rowb + min(max((kb_) + (dil_) * kk_, 0), S - 1)) * ld + (lane & 7) * 8; \
    const bf16_t* p1_ = qkv + (rowb + min(max((kb_) + (dil_) * (kk_ + 8), 0), S - 1)) * ld + (lane & 7) * 8; \
    const bf16_t* p2_ = qkv + (rowb + min(max((kb_) + (dil_) * (kk_ + 16), 0), S - 1)) * ld + (lane & 7) * 8; \
    const bf16_t* p3_ = qkv + (rowb + min(max((kb_) + (dil_) * (kk_ + 24), 0), S - 1)) * ld + (lane & 7) * 8; \
    rk0 = *(const uint4*)(p0_ + kcol); rk1 = *(const uint4*)(p1_ + kcol); rk2 = *(const uint4*)(p2_ + kcol); rk3 = *(const uint4*)(p3_ + kcol); \
    rv0 = *(const uint4*)(p0_ + vcol); rv1 = *(const uint4*)(p1_ + vcol); rv2 = *(const uint4*)(p2_ + vcol); rv3 = *(const uint4*)(p3_ + vcol); } while (0)
#define KV_STORE() do { char* wp_ = vl + (lane >> 3) * 144 + (lane & 7) * 16; \
    *(uint4*)(wp_) = rk0; *(uint4*)(wp_ + 8 * 144) = rk1; *(uint4*)(wp_ + 16 * 144) = rk2; *(uint4*)(wp_ + 24 * 144) = rk3; \
    *(uint4*)(wp_ + 4608) = rv0; *(uint4*)(wp_ + 4608 + 8 * 144) = rv1; *(uint4*)(wp_ + 4608 + 16 * 144) = rv2; *(uint4*)(wp_ + 4608 + 24 * 144) = rv3; } while (0)

DI bf16x8 v_frag(const char* vbase, int s, int dt) {
    typedef __attribute__((address_space(3))) v4i16_t* lp_t;
    const char* a = vbase + s * (16 * 144) + dt * 64;
    const s16x4 lo = __builtin_bit_cast(s16x4, __builtin_amdgcn_ds_read_tr16_b64_v4i16((lp_t)(a)));
    const s16x4 hi = __builtin_bit_cast(s16x4, __builtin_amdgcn_ds_read_tr16_b64_v4i16((lp_t)(a + 8 * 144)));
    return __builtin_shufflevector(lo, hi, 0, 1, 2, 3, 4, 5, 6, 7);
}

template <int OFF> DI bf16x8 pack8v(const f32x16& p) {
    typedef unsigned u32x4 __attribute__((ext_vector_type(4)));
    u32x4 w; w[0] = pk2(p[OFF + 0], p[OFF + 1]); w[1] = pk2(p[OFF + 2], p[OFF + 3]); w[2] = pk2(p[OFF + 4], p[OFF + 5]); w[3] = pk2(p[OFF + 6], p[OFF + 7]);
    return __builtin_bit_cast(bf16x8, w);
}

DI void win_attn_wave(bf16_t* qkv, int ld, int b, int qcol, int kcol, int vcol, int tq0, int qstride,
                      float slope2, float m_init, float l_init, int pat, char* vl, int lane, bool dry,
                      int nq = 32, float* st = nullptr, int tloc0 = 0, int tlstride = 0, int stage = 0) {
    const int r = lane & 31, h = lane >> 5;
    const size_t rowb = (size_t)b * S;
    const int tq = tq0 + qstride * r;
    bf16x8 qf[4];
    {
        const bf16_t* qp = qkv + (rowb + min(tq, S - 1)) * ld + qcol + h * 32;
#pragma unroll
        for (int ks = 0; ks < 4; ++ks) qf[ks] = *(const bf16x8*)(qp + ks * 8);
    }
    f32x16 o0, o1;
#pragma unroll
    for (int i = 0; i < 16; ++i) { o0[i] = 0.f; o1[i] = 0.f; }
    float m = m_init, l = (h == 0) ? l_init : 0.f;
    const float sc2 = 0.125f * LOG2E;
    const int i16 = lane & 15;
    const char* vbase = vl + 4608 + (4 * h + (i16 >> 2)) * 144 + (16 * ((lane >> 4) & 1) + 4 * (i16 & 3)) * 2;
    const char* kfp = vl + r * 144 + h * 64;
    KV_DECL;
    for (int pi = 0; pi < 1; ++pi) {
        int dil, W, kfirst; const int nt = 5;
        if (pat < 0) { dil = 1; W = 127; kfirst = tq0 - 128; }
        else if (pat == 0) { dil = 1; W = 128; kfirst = tq0 - 128; }
        else if (pat == 1) { dil = 4; W = 512; kfirst = tq0 - 512; }
        else { dil = 16; W = 2048; kfirst = tq0 - 2048; }
        const int step = 32 * dil;
        int t0 = 0;
        { const int need = -kfirst - 31 * dil; if (need > 0) t0 = (need + step - 1) / step; }
        if (t0 >= nt) continue;
        KV_LOAD(kfirst + t0 * step, dil);
        for (int tile = t0; tile < nt; ++tile) {
            const int kb = kfirst + tile * step;
            KV_STORE();
            asm volatile("" ::: "memory");
            if (tile + 1 < nt) KV_LOAD(kb + step, dil);
            f32x16 s = MFMA(*(const bf16x8*)(kfp), qf[0], f32x16{});
#pragma unroll
            for (int ks = 1; ks < 4; ++ks) s = MFMA(*(const bf16x8*)(kfp + ks * 16), qf[ks], s);
            f32x16 sv; float mloc = -INFINITY;
            const int d0 = tq - kb - 4 * h * dil;
            const float b0 = -slope2 * (float)d0, b1 = slope2 * (float)dil;
            if (tile >= 1 && tile <= 3 && kb >= 0) {
#pragma unroll
                for (int i = 0; i < 16; ++i) {
                    sv[i] = __builtin_fmaf(s[i], sc2, __builtin_fmaf(b1, (float)crow(i, 0), b0));
                    mloc = fmaxf(mloc, sv[i]);
                }
            } else {
                const unsigned wlim = (unsigned)min(W, tq);
#pragma unroll
                for (int i = 0; i < 16; ++i) {
                    const int diff = d0 - dil * crow(i, 0);
                    const float sb = __builtin_fmaf(s[i], sc2, __builtin_fmaf(b1, (float)crow(i, 0), b0));
                    sv[i] = ((unsigned)diff <= wlim) ? sb : -INFINITY;
                    mloc = fmaxf(mloc, sv[i]);
                }
            }
            mloc = fmaxf(mloc, __shfl_xor(mloc, 32));
            const float mn = fmaxf(m, mloc);
            if (__builtin_amdgcn_ballot_w64(mn > m + 8.f) != 0) {
                const float alpha = fexp2(m - mn);
                l *= alpha;
#pragma unroll
                for (int i = 0; i < 16; ++i) { o0[i] *= alpha; o1[i] *= alpha; }
                m = mn;
            }
            float ps = 0.f;
#pragma unroll
            for (int i = 0; i < 16; ++i) { sv[i] = fexp2(sv[i] - m); ps += sv[i]; }
            l += ps;
            const bf16x8 p0 = pack8v<0>(sv), p1 = pack8v<8>(sv);
            o0 = MFMA(v_frag(vbase, 0, 0), p0, o0);
            o0 = MFMA(v_frag(vbase, 1, 0), p1, o0);
            o1 = MFMA(v_frag(vbase, 0, 1), p0, o1);
            o1 = MFMA(v_frag(vbase, 1, 1), p1, o1);
            asm volatile("" ::: "memory");
        }
    }
    float lt = l + __shfl_xor(l, 32);
    if (st) {
        const bool act = r < nq;
        char* sp = (char*)st + (tloc0 + tlstride * r) * 144;
        if (act) {
            if (stage > 0) {
                const float ms = *(const float*)(sp + 128), ls = *(const float*)(sp + 132);
                const float mn = fmaxf(ms, m);
                const float as = fexp2(ms - mn), aw = fexp2(m - mn);
                lt = ls * as + lt * aw; m = mn;
#pragma unroll
                for (int g = 0; g < 4; ++g) {
                    const uint2 a = *(const uint2*)(sp + (8 * g + 4 * h) * 2), c = *(const uint2*)(sp + (32 + 8 * g + 4 * h) * 2);
                    o0[4 * g] = bflo(a.x) * as + o0[4 * g] * aw; o0[4 * g + 1] = bfhi(a.x) * as + o0[4 * g + 1] * aw; o0[4 * g + 2] = bflo(a.y) * as + o0[4 * g + 2] * aw; o0[4 * g + 3] = bfhi(a.y) * as + o0[4 * g + 3] * aw;
                    o1[4 * g] = bflo(c.x) * as + o1[4 * g] * aw; o1[4 * g + 1] = bfhi(c.x) * as + o1[4 * g + 1] * aw; o1[4 * g + 2] = bflo(c.y) * as + o1[4 * g + 2] * aw; o1[4 * g + 3] = bfhi(c.y) * as + o1[4 * g + 3] * aw;
                }
            }
            if (stage < 2) {
                if (h == 0) { *(float*)(sp + 128) = m; *(float*)(sp + 132) = lt; }
#pragma unroll
                for (int g = 0; g < 4; ++g) {
                    *(uint2*)(sp + (8 * g + 4 * h) * 2) = make_uint2(pk2(o0[4 * g], o0[4 * g + 1]), pk2(o0[4 * g + 2], o0[4 * g + 3]));
                    *(uint2*)(sp + (32 + 8 * g + 4 * h) * 2) = make_uint2(pk2(o1[4 * g], o1[4 * g + 1]), pk2(o1[4 * g + 2], o1[4 * g + 3]));
                }
            }
        }
        if (stage < 2 || !act) return;
    }
    const float inv = 1.f / lt;
    if (dry) { if (o0[0] + o1[0] + lt == 12345.678f) qkv[0] = 1; return; }
    bf16_t* op = qkv + (rowb + tq) * ld + qcol + 4 * h;
#pragma unroll
    for (int g = 0; g < 4; ++g) {
        *(uint2*)(op + 8 * g) = make_uint2(pk2(o0[4 * g] * inv, o0[4 * g + 1] * inv), pk2(o0[4 * g + 2] * inv, o0[4 * g + 3] * inv));
        *(uint2*)(op + 32 + 8 * g) = make_uint2(pk2(o1[4 * g] * inv, o1[4 * g + 1] * inv), pk2(o1[4 * g + 2] * inv, o1[4 * g + 3] * inv));
    }
}

DI void stick_wave(bf16_t* qkv, int ld, int b, int qcol, int kcol, int vcol, int qt, char* vl, int lane, bool dry) {
    const int r = lane & 31, h = lane >> 5;
    const size_t rowb = (size_t)b * S;
    const int tq = qt * 32 + r;
    bf16x8 qf[4];
    {
        const bf16_t* qp = qkv + (rowb + tq) * ld + qcol + h * 32;
#pragma unroll
        for (int ks = 0; ks < 4; ++ks) qf[ks] = *(const bf16x8*)(qp + ks * 8);
    }
    f32x16 o0, o1;
#pragma unroll
    for (int i = 0; i < 16; ++i) { o0[i] = 0.f; o1[i] = 0.f; }
    float R = 1.f;
    const int i16 = lane & 15;
    const char* vbase = vl + 4608 + (4 * h + (i16 >> 2)) * 144 + (16 * ((lane >> 4) & 1) + 4 * (i16 & 3)) * 2;
    const char* kfp = vl + r * 144 + h * 64;
    KV_DECL;
    KV_LOAD(qt * 32, 1);
    for (int tile = qt; tile >= 0; --tile) {
        KV_STORE();
        asm volatile("" ::: "memory");
        if (tile > 0) KV_LOAD((tile - 1) * 32, 1);
        f32x16 s = MFMA(*(const bf16x8*)(kfp), qf[0], f32x16{});
#pragma unroll
        for (int ks = 1; ks < 4; ++ks) s = MFMA(*(const bf16x8*)(kfp + ks * 16), qf[ks], s);
        const bool diag = (tile == qt);
        f32x16 sg, kp;
#pragma unroll
        for (int i = 0; i < 16; ++i) {
            const float z2 = fminf(s[i] * (0.125f * LOG2E), 80.f);
            const float t = fexp2(z2);
            const float k = __builtin_amdgcn_rcpf(1.f + t);
            kp[i] = k; sg[i] = t * k;
        }
        if (diag) {
#pragma unroll
            for (int i = 0; i < 16; ++i) { const bool strict = crow(i, h) < r; kp[i] = strict ? kp[i] : 1.f; sg[i] = strict ? sg[i] : 0.f; }
        }
        float G[4], PG[4], both[4];
#pragma unroll
        for (int g = 0; g < 4; ++g) { G[g] = (kp[4 * g] * kp[4 * g + 1]) * (kp[4 * g + 2] * kp[4 * g + 3]); PG[g] = __shfl_xor(G[g], 32); both[g] = G[g] * PG[g]; }
        float Sx[4];
        Sx[3] = 1.f; Sx[2] = both[3]; Sx[1] = both[3] * both[2]; Sx[0] = Sx[1] * both[1];
        f32x16 a;
#pragma unroll
        for (int g = 0; g < 4; ++g) {
            float la = R * Sx[g] * (h == 0 ? PG[g] : 1.f);
#pragma unroll
            for (int j = 3; j >= 0; --j) {
                a[4 * g + j] = sg[4 * g + j] * la;
                la *= kp[4 * g + j];
            }
        }
        R *= Sx[0] * both[0];
        const bf16x8 p0 = pack8v<0>(a), p1 = pack8v<8>(a);
        o0 = MFMA(v_frag(vbase, 0, 0), p0, o0);
        o0 = MFMA(v_frag(vbase, 1, 0), p1, o0);
        o1 = MFMA(v_frag(vbase, 0, 1), p0, o1);
        o1 = MFMA(v_frag(vbase, 1, 1), p1, o1);
        asm volatile("" ::: "memory");
        if (__builtin_amdgcn_ballot_w64(R >= 1.17549435e-38f) == 0) break;
    }
    if (dry) { if (o0[0] + o1[0] == 12345.678f) qkv[0] = 1; return; }
    bf16_t* op = qkv + (rowb + tq) * ld + qcol + 4 * h;
#pragma unroll
    for (int g = 0; g < 4; ++g) {
        *(uint2*)(op + 8 * g) = make_uint2(pk2(o0[4 * g], o0[4 * g + 1]), pk2(o0[4 * g + 2], o0[4 * g + 3]));
        *(uint2*)(op + 32 + 8 * g) = make_uint2(pk2(o1[4 * g], o1[4 * g + 1]), pk2(o1[4 * g + 2], o1[4 * g + 3]));
    }
}

DI void attn_even_phase(const Params& P, char* smem, bool dry) {
    const int tid_ = otid(); const int lane = tid_ & 63, wid = tid_ >> 6;
    bf16_t* qkv = (bf16_t*)(P.ws + OFF_BIG);
    char* vl = smem + wid * 9216;
    for (int it = blockIdx.x * 8 + wid; it < 2048 + 4096; it += gridDim.x * 8) {
        if (it < 2048) {
            const int bh = it >> 6, p = it & 63; const int b = bh >> 3, head = bh & 7;
            stick_wave(qkv, 2304, b, 512 + head * 64, 1280 + head * 64, 1792 + head * 64, 127 - p, vl, lane, dry);
            stick_wave(qkv, 2304, b, 512 + head * 64, 1280 + head * 64, 1792 + head * 64, p, vl, lane, dry);
        } else {
            const int v = it - 2048; const int g = v & 3; const int qt = (v >> 2) & 127; const int rest = v >> 9; const int b = rest >> 1, kvh = rest & 1;
            const int head = kvh * 4 + g;
            const float slope = exp2f(-(float)(head + 1));
            const float sink = P.in[9][head];
            win_attn_wave(qkv, 2304, b, head * 64, 1024 + kvh * 64, 1152 + kvh * 64, qt * 32, 1, slope * LOG2E, sink * LOG2E, 1.f, -1, vl, lane, dry);
        }
    }
}

DI void attn_odd_phase(const Params& P, char* smem, bool dry) {
    const int tid_ = otid(); const int lane = tid_ & 63, wid = tid_ >> 6;
    bf16_t* qkv = (bf16_t*)(P.ws + OFF_BIG);
    char* vl = smem + wid * 9216;
    float* st = (float*)(smem + 8 * 9216);
    for (int it = blockIdx.x; it < 512; it += gridDim.x) {
        const int span = it & 7, head = (it >> 3) & 15, b = it >> 7; const int t0 = span * 512;
        const float slope2 = exp2f(-0.5f * (float)(head + 1)) * LOG2E;
        const int qc = head * 64, kc = 1024 + head * 64, vc = 2048 + head * 64;
        __syncthreads();
#pragma unroll 1
        for (int k = 0; k < 2; ++k) {
            const int j = wid + 8 * k;
            win_attn_wave(qkv, 3072, b, qc, kc, vc, t0 + 32 * j, 1, slope2, -1e30f, 0.f, 0, vl, lane, dry, 32, st, 32 * j, 1, 0);
        }
        __syncthreads();
#pragma unroll 1
        for (int k = 0; k < 2; ++k) {
            const int j = wid + 8 * k; const int r4 = j >> 2, q = j & 3;
            win_attn_wave(qkv, 3072, b, qc, kc, vc, t0 + r4 + 128 * q, 4, slope2, -1e30f, 0.f, 1, vl, lane, dry, 32, st, r4 + 128 * q, 4, 1);
        }
        __syncthreads();
#pragma unroll 1
        for (int k = 0; k < 2; ++k) {
            const int r16 = wid + 8 * k;
            win_attn_wave(qkv, 3072, b, qc, kc, vc, t0 + r16, 16, slope2, -1e30f, 0.f, 2, vl, lane, dry, 32, st, r16, 16, 2);
        }
    }
}

DI void xattn_wave(bf16_t* qb, const bf16_t* Kn, const bf16_t* VT, const float* qg, float kmax2, int b, int head, int tok0, char* ql, int lane, bool dry) {
    const int r = lane & 31, h = lane >> 5;
    const size_t token = (size_t)b * S + tok0 + r;
    bf16_t* qp = qb + token * D + head * 256 + h * 128;
    float ss = 0.f;
#pragma unroll
    for (int ks = 0; ks < 16; ++ks) {
        const uint4 v = *(const uint4*)(qp + ks * 8);
        const unsigned w[4] = {v.x, v.y, v.z, v.w};
#pragma unroll
        for (int e = 0; e < 4; ++e) { const float a = bflo(w[e]), c = bfhi(w[e]); ss += a * a + c * c; }
    }
    ss += __shfl_xor(ss, 32);
    const float inv = __builtin_amdgcn_rsqf(ss * (1.f / 256.f) + EPS);
    float qq2 = 0.f;
#pragma unroll
    for (int ks = 0; ks < 16; ++ks) {
        const uint4 v = *(const uint4*)(qp + ks * 8);
        const float4 g0 = *(const float4*)(qg + h * 128 + ks * 8), g1 = *(const float4*)(qg + h * 128 + ks * 8 + 4);
        uint4 o;
        o.x = pk2(bflo(v.x) * inv * g0.x, bfhi(v.x) * inv * g0.y); o.y = pk2(bflo(v.y) * inv * g0.z, bfhi(v.y) * inv * g0.w);
        o.z = pk2(bflo(v.z) * inv * g1.x, bfhi(v.z) * inv * g1.y); o.w = pk2(bflo(v.w) * inv * g1.z, bfhi(v.w) * inv * g1.w);
        qq2 += bflo(o.x) * bflo(o.x) + bfhi(o.x) * bfhi(o.x) + bflo(o.y) * bflo(o.y) + bfhi(o.y) * bfhi(o.y)
             + bflo(o.z) * bflo(o.z) + bfhi(o.z) * bfhi(o.z) + bflo(o.w) * bflo(o.w) + bfhi(o.w) * bfhi(o.w);
        *(uint4*)(ql + (ks * 64 + lane) * 16) = o;
    }
    qq2 += __shfl_xor(qq2, 32);
    asm volatile("" ::: "memory");
    const float sc2 = 0.0625f * LOG2E;
    const bf16_t* kp0 = Kn + ((size_t)(b * 4 + head) * 8 * 16 * 64 + lane) * 8;
    const float m = __builtin_amdgcn_sqrtf(qq2 * kmax2) * 1.001f;
    float l = 0.f;
    bf16x8 pf[8][2];
    bf16x8 kc[16], kn[16];
#pragma unroll
    for (int ks = 0; ks < 16; ++ks) kc[ks] = *(const bf16x8*)(kp0 + ks * 512);
#pragma unroll
    for (int tile = 0; tile < 8; ++tile) {
        if (tile < 7) {
#pragma unroll
            for (int ks = 0; ks < 16; ++ks) kn[ks] = *(const bf16x8*)(kp0 + (size_t)(tile + 1) * 16 * 512 + ks * 512);
        }
        f32x16 s, s_b;
#pragma unroll
        for (int i = 0; i < 16; ++i) { s[i] = 0.f; s_b[i] = 0.f; }
#pragma unroll
        for (int ks = 0; ks < 16; ks += 2) {
            const bf16x8 qf0 = *(const bf16x8*)(ql + (ks * 64 + lane) * 16);
            const bf16x8 qf1 = *(const bf16x8*)(ql + ((ks + 1) * 64 + lane) * 16);
            s = MFMA(kc[ks], qf0, s);
            s_b = MFMA(kc[ks + 1], qf1, s_b);
        }
#pragma unroll
        for (int i = 0; i < 16; ++i) s[i] += s_b[i];
#pragma unroll
        for (int i = 0; i < 16; ++i) { s[i] = fexp2((s[i] - m) * sc2); l += s[i]; }
        pf[tile][0] = pack8v<0>(s); pf[tile][1] = pack8v<8>(s);
#pragma unroll
        for (int ks = 0; ks < 16; ++ks) kc[ks] = kn[ks];
    }
    l += __shfl_xor(l, 32);
    const float il = 1.f / l;
    bf16_t* op = qb + token * D + head * 256 + 4 * h;
    const bf16_t* vp0 = VT + (((size_t)(b * 4 + head) * 8 * 8 * 2 * 64) + lane) * 8;
    bf16x8 vc[16], vn[16];
#pragma unroll
    for (int e = 0; e < 16; ++e) vc[e] = *(const bf16x8*)(vp0 + e * 512);
#pragma unroll 1
    for (int dt = 0; dt < 8; ++dt) {
        const int dn = dt < 7 ? dt + 1 : 7;
#pragma unroll
        for (int e = 0; e < 16; ++e) vn[e] = *(const bf16x8*)(vp0 + (size_t)dn * 16 * 512 + e * 512);
        f32x16 o, o_b;
#pragma unroll
        for (int i = 0; i < 16; ++i) { o[i] = 0.f; o_b[i] = 0.f; }
#pragma unroll
        for (int tile = 0; tile < 8; ++tile) { o = MFMA(vc[tile * 2], pf[tile][0], o); o_b = MFMA(vc[tile * 2 + 1], pf[tile][1], o_b); }
#pragma unroll
        for (int i = 0; i < 16; ++i) o[i] += o_b[i];
#pragma unroll
        for (int g = 0; g < 4; ++g)
            if (dry) { if (o[4 * g] == 12345.678f) qb[0] = 1; } else *(uint2*)(op + dt * 32 + 8 * g) = make_uint2(pk2(o[4 * g] * il, o[4 * g + 1] * il), pk2(o[4 * g + 2] * il, o[4 * g + 3] * il));
#pragma unroll
        for (int e = 0; e < 16; ++e) vc[e] = vn[e];
    }
}

DI void xattn_block(bf16_t* qb, const bf16_t* KF, const bf16_t* VF, const float* qg, float kmax2, int b, int head, int qblk, char* smem, int lane, int wid) {
    const int r = lane & 31, h = lane >> 5;
    const size_t token = (size_t)b * S + qblk * 256 + wid * 32 + r;
    bf16_t* qp = qb + token * D + head * 256 + h * 128;
    const bf16_t* kbase = KF + (size_t)(b * 4 + head) * 8 * 8192;
    const bf16_t* vbase = VF + (size_t)(b * 4 + head) * 8 * 8192;
    const int pc0 = (2 * wid) * 512 + lane * 8, pc1 = pc0 + 512;
    char* ld0 = smem + (2 * wid) * 1024 + lane * 16;
#define XA_ISSUE(u_) do { const int u__ = (u_); const bf16_t* src_ = (u__ < 8) ? kbase + (size_t)u__ * 8192 : vbase + (size_t)(u__ - 8) * 8192; \
        char* dst_ = ld0 + (u__ & 3) * 16384; glds16(src_ + pc0, dst_); glds16(src_ + pc1, dst_ + 1024); } while (0)
    __syncthreads();
    XA_ISSUE(0); XA_ISSUE(1); XA_ISSUE(2);
    uint4 qraw[16];
    float ss = 0.f;
#pragma unroll
    for (int ks = 0; ks < 16; ++ks) {
        qraw[ks] = *(const uint4*)(qp + ks * 8);
        const uint4 v = qraw[ks];
        ss += bflo(v.x) * bflo(v.x) + bfhi(v.x) * bfhi(v.x) + bflo(v.y) * bflo(v.y) + bfhi(v.y) * bfhi(v.y)
            + bflo(v.z) * bflo(v.z) + bfhi(v.z) * bfhi(v.z) + bflo(v.w) * bflo(v.w) + bfhi(v.w) * bfhi(v.w);
    }
    ss += __shfl_xor(ss, 32);
    const float inv = __builtin_amdgcn_rsqf(ss * (1.f / 256.f) + EPS);
    float qq2 = 0.f;
    bf16x8 qf[16];
#pragma unroll
    for (int ks = 0; ks < 16; ++ks) {
        const uint4 v = qraw[ks];
        const float4 g0 = *(const float4*)(qg + h * 128 + ks * 8), g1 = *(const float4*)(qg + h * 128 + ks * 8 + 4);
        uint4 o;
        o.x = pk2(bflo(v.x) * inv * g0.x, bfhi(v.x) * inv * g0.y); o.y = pk2(bflo(v.y) * inv * g0.z, bfhi(v.y) * inv * g0.w);
        o.z = pk2(bflo(v.z) * inv * g1.x, bfhi(v.z) * inv * g1.y); o.w = pk2(bflo(v.w) * inv * g1.z, bfhi(v.w) * inv * g1.w);
        qq2 += bflo(o.x) * bflo(o.x) + bfhi(o.x) * bfhi(o.x) + bflo(o.y) * bflo(o.y) + bfhi(o.y) * bfhi(o.y)
             + bflo(o.z) * bflo(o.z) + bfhi(o.z) * bfhi(o.z) + bflo(o.w) * bflo(o.w) + bfhi(o.w) * bfhi(o.w);
        qf[ks] = __builtin_bit_cast(bf16x8, o);
    }
    qq2 += __shfl_xor(qq2, 32);
    const float sc2 = 0.0625f * LOG2E;
    const float m = __builtin_amdgcn_sqrtf(qq2 * kmax2) * 1.001f;
    float l = 0.f;
    bf16x8 pf[8][2];
    const char* fr0 = smem + lane * 16;
#pragma unroll
    for (int u = 0; u < 8; ++u) {
        asm volatile("s_waitcnt vmcnt(4)" ::: "memory");
        __builtin_amdgcn_s_barrier();
        XA_ISSUE(u + 3);
        const char* sl = fr0 + (u & 3) * 16384;
        f32x16 s, s_b;
#pragma unroll
        for (int i = 0; i < 16; ++i) { s[i] = 0.f; s_b[i] = 0.f; }
#pragma unroll
        for (int ks = 0; ks < 16; ks += 2) {
            s = MFMA(*(const bf16x8*)(sl + ks * 1024), qf[ks], s);
            s_b = MFMA(*(const bf16x8*)(sl + (ks + 1) * 1024), qf[ks + 1], s_b);
        }
#pragma unroll
        for (int i = 0; i < 16; ++i) { s[i] = fexp2((s[i] + s_b[i] - m) * sc2); l += s[i]; }
        pf[u][0] = pack8v<0>(s); pf[u][1] = pack8v<8>(s);
    }
    l += __shfl_xor(l, 32);
    const float il = 1.f / l;
    bf16_t* op = qb + token * D + head * 256 + 4 * h;
#pragma unroll 1
    for (int dt = 0; dt < 8; ++dt) {
        if (dt < 6) asm volatile("s_waitcnt vmcnt(4)" ::: "memory");
        else if (dt == 6) asm volatile("s_waitcnt vmcnt(2)" ::: "memory");
        else asm volatile("s_waitcnt vmcnt(0)" ::: "memory");
        __builtin_amdgcn_s_barrier();
        if (dt < 5) XA_ISSUE(dt + 11);
        const char* sl = fr0 + (dt & 3) * 16384;
        f32x16 o, o_b;
#pragma unroll
        for (int i = 0; i < 16; ++i) { o[i] = 0.f; o_b[i] = 0.f; }
#pragma unroll
        for (int tile = 0; tile < 8; ++tile) {
            o = MFMA(*(const bf16x8*)(sl + (tile * 2) * 1024), pf[tile][0], o);
            o_b = MFMA(*(const bf16x8*)(sl + (tile * 2 + 1) * 1024), pf[tile][1], o_b);
        }
#pragma unroll
        for (int g = 0; g < 4; ++g)
            *(uint2*)(op + dt * 32 + 8 * g) = make_uint2(pk2((o[4 * g] + o_b[4 * g]) * il, (o[4 * g + 1] + o_b[4 * g + 1]) * il),
                                                        pk2((o[4 * g + 2] + o_b[4 * g + 2]) * il, (o[4 * g + 3] + o_b[4 * g + 3]) * il));
    }
#undef XA_ISSUE
}

DI void xattn_phase(const Params& P, int l, char* smem, bool dry) {
    const int tid_ = otid(); const int lane = tid_ & 63, wid = tid_ >> 6;
    bf16_t* qb = (bf16_t*)(P.ws + OFF_BIG);
    const bf16_t* KF = (const bf16_t*)(P.ws + OFF_KF + (size_t)l * SZ_MM);
    const bf16_t* VF = (const bf16_t*)(P.ws + OFF_VT + (size_t)l * SZ_MM);
    const float* qg = P.in[19] + l * 256;
    (void)dry;
    for (int it = blockIdx.x; it < 256; it += gridDim.x) {
        const int qblk = it & 15, head = (it >> 4) & 3, b = it >> 6;
        const float kmax2 = ((const float*)(P.ws + OFF_KMAX))[l * 16 + b * 4 + head];
        xattn_block(qb, KF, VF, qg, kmax2, b, head, qblk, smem, lane, wid);
    }
}

DI void knorm_phase(const Params& P) {
    const int tid_ = otid(); const int lane = tid_ & 63, wid = tid_ >> 6;
    for (int u = blockIdx.x * 8 + wid; u < 8192; u += gridDim.x * 8) {
        const int l = u >> 12, row = (u >> 2) & 1023, head = u & 3;
        const bf16_t* kp = (const bf16_t*)(P.ws + OFF_KN + (size_t)l * SZ_MM) + (size_t)row * D + head * 256 + lane * 4;
        const uint2 v = *(const uint2*)kp;
        const float a0 = bflo(v.x), a1 = bfhi(v.x), a2 = bflo(v.y), a3 = bfhi(v.y);
        float ss = a0 * a0 + a1 * a1 + a2 * a2 + a3 * a3;
        ss = wave_sum(ss);
        const float inv = __builtin_amdgcn_rsqf(ss * (1.f / 256.f) + EPS);
        const float4 g = *(const float4*)(P.in[20] + l * 256 + lane * 4);
        const int b = row >> 8, key = row & 255;
        const int h = lane >> 5, ks = (lane & 31) >> 1, j0 = (lane & 1) * 4;
        bf16_t* dp = (bf16_t*)(P.ws + OFF_KF + (size_t)l * SZ_MM) + ((((((size_t)(b * 4 + head) * 8 + (key >> 5)) * 16 + ks) * 64) + h * 32 + (key & 31)) << 3) + j0;
        const unsigned w0_ = pk2(a0 * inv * g.x, a1 * inv * g.y), w1_ = pk2(a2 * inv * g.z, a3 * inv * g.w);
        *(uint2*)dp = make_uint2(w0_, w1_);
        float kk2 = bflo(w0_) * bflo(w0_) + bfhi(w0_) * bfhi(w0_) + bflo(w1_) * bflo(w1_) + bfhi(w1_) * bfhi(w1_);
        kk2 = wave_sum(kk2);
        if (lane == 0) atomicMax((unsigned*)(P.ws + OFF_KMAX) + l * 16 + b * 4 + head, __float_as_uint(kk2));
    }
}

#define XB_TMO      128
#define XB_XCNT(j)  (256  + 64 * (j))
#define XB_XSUB(j)  (1280 + 64 * (j))
#define XB_XGEN(j)  (2304 + 64 * (j))
#define XB_TOP      3328
#define XB_TOPGEN   3392
#define XCD_BAR_WORDS 3456
#define XB_SPIN_CAP (1u << 18)
#define XB_LAS __attribute__((address_space(3)))

__device__ __forceinline__ unsigned xb_ld(unsigned* p)              { return __hip_atomic_load(p, __ATOMIC_RELAXED, __HIP_MEMORY_SCOPE_AGENT); }
__device__ __forceinline__ unsigned xb_add(unsigned* p, unsigned v) { return __hip_atomic_fetch_add(p, v, __ATOMIC_RELAXED, __HIP_MEMORY_SCOPE_AGENT); }
__device__ __forceinline__ unsigned xb_xcc_id() { return (unsigned)__builtin_amdgcn_s_getreg((3 << 11) | 20) & 0xFu; }
#define XB_SPIN(cond, bar) do { unsigned _sp = 0; while (cond) { __builtin_amdgcn_s_sleep(1); \
    if ((++_sp & 255u) == 0u) { if (xb_ld(&(bar)[XB_TMO])) break; if (_sp > XB_SPIN_CAP) { atomicAdd(&(bar)[XB_TMO], 1u); break; } } } } while (0)

struct XcdBarrier {
    unsigned* bar; unsigned x;
    volatile XB_LAS unsigned* st;
};

__device__ __forceinline__ XcdBarrier xcd_barrier_post(unsigned* bar, volatile XB_LAS unsigned* st) {
    XcdBarrier b; b.bar = bar; b.x = xb_xcc_id(); b.st = st;
    if (threadIdx.x == 0) (void)xb_add(&bar[XB_XCNT(b.x)], 1u);
    return b;
}
__device__ __forceinline__ void xcd_barrier_complete(unsigned* bar, unsigned x, unsigned& nloc, unsigned& nx) {
    const unsigned G = gridDim.x * gridDim.y * gridDim.z;
    unsigned sum, cnt, mine, sp = 0u;
    for (;;) {
        sum = 0u; cnt = 0u; mine = 0u;
#pragma unroll
        for (unsigned j = 0; j < 16; ++j) { const unsigned c = xb_ld(&bar[XB_XCNT(j)]); sum += c; cnt += (c > 0u) ? 1u : 0u; mine = (j == x) ? c : mine; }
        if (sum == G) break;
        __builtin_amdgcn_s_sleep(1);
        if ((++sp & 255u) == 0u) { if (xb_ld(&bar[XB_TMO])) break; if (sp > XB_SPIN_CAP) { atomicAdd(&bar[XB_TMO], 1u); break; } }
    }
    nloc = mine > 0u ? mine : 1u; nx = cnt > 0u ? cnt : 1u;
}

__device__ __forceinline__ void xcd_barrier(const XcdBarrier& b) {
    asm volatile("s_waitcnt vmcnt(0)" ::: "memory");
    __syncthreads();
    if (threadIdx.x == 0) {
        unsigned* bar = b.bar;
        __builtin_amdgcn_s_waitcnt(0);
        unsigned nloc = b.st[0], nx = b.st[1];
        if (nloc == 0u) { xcd_barrier_complete(bar, b.x, nloc, nx); b.st[0] = nloc; b.st[1] = nx; }
        const unsigned old = xb_add(&bar[XB_XSUB(b.x)], 1u);
        const unsigned gen = old / nloc;
        if (old + 1u == (gen + 1u) * nloc) {
            __builtin_amdgcn_fence(__ATOMIC_RELEASE, "agent");
            asm volatile("s_waitcnt vmcnt(0)" ::: "memory");
            const unsigned og = xb_add(&bar[XB_TOP], 1u);
            const unsigned tg = og / nx;
            if (og + 1u == (tg + 1u) * nx) xb_add(&bar[XB_TOPGEN], 1u);
            else XB_SPIN(xb_ld(&bar[XB_TOPGEN]) == tg, bar);
            __builtin_amdgcn_fence(__ATOMIC_ACQUIRE, "agent");
            xb_add(&bar[XB_XGEN(b.x)], 1u);
            asm volatile("s_waitcnt vmcnt(0)" ::: "memory");
        } else {
            XB_SPIN(xb_ld(&bar[XB_XGEN(b.x)]) == gen, bar);
            __builtin_amdgcn_fence(__ATOMIC_ACQUIRE, "agent");
            asm volatile("s_waitcnt vmcnt(0)" ::: "memory");
        }
    }
    __syncthreads();
}


DI void fast_grid_sync(unsigned* bar, unsigned target) {
    asm volatile("s_waitcnt vmcnt(0) lgkmcnt(0)" ::: "memory");
    __syncthreads();
    if (threadIdx.x == 0) {
        __builtin_amdgcn_fence(__ATOMIC_RELEASE, "agent");
        asm volatile("s_waitcnt vmcnt(0)" ::: "memory");
        __hip_atomic_fetch_add(bar, 1u, __ATOMIC_RELAXED, __HIP_MEMORY_SCOPE_AGENT);
        while (__hip_atomic_load(bar, __ATOMIC_RELAXED, __HIP_MEMORY_SCOPE_AGENT) < target) __builtin_amdgcn_s_sleep(2);
        __builtin_amdgcn_fence(__ATOMIC_ACQUIRE, "agent");
        asm volatile("s_waitcnt vmcnt(0)" ::: "memory");
    }
    __syncthreads();
}

__global__ void __launch_bounds__(512) fwd_megakernel(Params P) {
    extern __shared__ __attribute__((aligned(16))) char smem[];
    cg::grid_group grid = cg::this_grid();
    unsigned nbar = 0; (void)nbar;
    volatile XB_LAS unsigned* xst = (volatile XB_LAS unsigned*)(smem + LDS_BYTES - 16);
    if (threadIdx.x == 0) { xst[0] = 0u; xst[1] = 0u; }
    __syncthreads();
    const XcdBarrier xbar = xcd_barrier_post((unsigned*)(P.ws + OFF_BAR), xst);
#pragma unroll 1
    for (int ph = 0; ph < 21; ++ph) {
        float* ssq = (float*)(P.ws + OFF_SSQ);
        bf16_t* xb = (bf16_t*)(P.ws + OFF_XB);
        bf16_t* big = (bf16_t*)(P.ws + OFF_BIG);
        int nrep = 1;
        if (ph > 0) { const int s_ = (ph - 1) % 10; const int kind = (s_ == 3) ? 2 : (s_ == 6) ? 4 : 1; if (PROBE_MASK & kind) nrep = 2; }
        for (int rep = 0; rep < nrep; ++rep) {
        const bool dry = rep + 1 < nrep;
        if (ph == 0) {
            phase0(P, smem);
        } else {
            const int l = (ph - 1) / 10, s = (ph - 1) % 10;
            if (s == 3) {
                if (l == 0) attn_even_phase(P, smem, dry); else attn_odd_phase(P, smem, dry);
            } else if (s == 6) {
                xattn_phase(P, l, smem, dry);
            } else {
                pg8::Gemm g; pg8::Epi E;
                g.A = xb; g.lda = D; g.K = D; g.M = T; g.N = D; g.Bt = nullptr;
                E.mode = 1; E.rs = nullptr; E.O = big; E.ldo = D; E.xin = nullptr; E.xout = nullptr; E.xb = xb; E.ssq_out = ssq; E.alpha = 1.f;
                E.qg = nullptr; E.kg = nullptr; E.qn_end = 0; E.kn_beg = 0; E.kn_end = 0;
                if (s == 0 || s == 8) {
                    g.Bt = (const bf16_t*)(P.ws + (s == 0 ? OFF_GU1 : OFF_GU2) + (size_t)l * SZ_GU); g.N = NGU;
                    E.mode = 0; E.rs = ssq + (size_t)(4 * l + (s == 0 ? 0 : 3)) * T; E.ldo = DFF;
                } else if (s == 1 || s == 9) {
                    g.A = big; g.lda = DFF; g.K = DFF;
                    g.Bt = (const bf16_t*)(P.ws + (s == 1 ? OFF_DN1 : OFF_DN2) + (size_t)l * SZ_DN);
                    E.alpha = 0.5f; E.ssq_out = ssq + (size_t)(4 * l + (s == 1 ? 1 : 4)) * T;
                    if (ph == 2) E.xin = P.in[0];
                    if (ph == 20) { E.xout = P.out; E.ssq_out = nullptr; }
                } else if (s == 2) {
                    E.mode = 2; E.rs = ssq + (size_t)(4 * l + 1) * T;
                    if (l == 0) { g.Bt = (const bf16_t*)(P.ws + OFF_EVIN); g.N = 2304; E.ldo = 2304; E.qg = P.in[7]; E.kg = P.in[8]; E.qn_end = 512; E.kn_beg = 1024; E.kn_end = 1152; }
                    else { g.Bt = (const bf16_t*)(P.ws + OFF_ODIN); g.N = 3072; E.ldo = 3072; E.qg = P.in[12]; E.kg = P.in[13]; E.qn_end = 1024; E.kn_beg = 1024; E.kn_end = 2048; }
                } else if (s == 4) {
                    g.A = big;
                    if (l == 0) { g.Bt = (const bf16_t*)(P.ws + OFF_EVOUT); g.lda = 2304; }
                    else { g.Bt = (const bf16_t*)(P.ws + OFF_ODOUT); g.lda = 3072; }
                    E.ssq_out = ssq + (size_t)(4 * l + 2) * T;
                } else if (s == 5) {
                    g.Bt = (const bf16_t*)(P.ws + OFF_WQ + (size_t)l * SZ_MM); E.mode = 2; E.rs = ssq + (size_t)(4 * l + 2) * T; E.ldo = D;
                } else {
                    g.A = big; g.Bt = (const bf16_t*)(P.ws + OFF_WO + (size_t)l * SZ_MM); E.ssq_out = ssq + (size_t)(4 * l + 3) * T;
                }
                pg8::StaticOrder So; So.init(T, g.N, (int)gridDim.x, (int)blockIdx.x);
                E.dryrun = 0;
#if PROBE_GEMM
                for (int rep_ = 0; rep_ < 2; ++rep_) {
                pg8::Epi E2 = E;
                if (rep_ == 0) { if (PROBE_GEMM == 1) E2.dryrun = 1; else if (E.mode == 1) { E2.alpha = 0.f; } }
                __syncthreads();
                pg8::gemm_phase<pg8::Epi, pg8::StaticOrder, true, true>((PG8_LAS unsigned char*)smem, g, So, rep_ == 0 ? E2 : E);
                ++nbar; fast_grid_sync((unsigned*)(P.ws + OFF_BAR), nbar * gridDim.x);
                }
#else
                __syncthreads();
                pg8::gemm_phase<pg8::Epi, pg8::StaticOrder, true, true>((PG8_LAS unsigned char*)smem, g, So, E);
#endif
                if (ph == 1) {
                    GJob J;
                    J.A = xb; J.lda = D; J.ksplit = 1 << 30; J.kextra = 0; J.K = D; J.ntm = 4; J.mode = 3; J.rs = nullptr;
                    J.O = big; J.ldo = D; J.xin = P.out; J.xout = P.out; J.xb = xb; J.ssq_out = ssq; J.alpha = 1.f;
                    J.qg = nullptr; J.kg = nullptr; J.qn_end = 0; J.kn_end = 0; J.vt = nullptr; J.W = nullptr; J.ntn = 8;
                    gemm_phase(J, 0, 64, P, smem, false);
                }
                if (ph == 2 && !dry) knorm_phase(P);
            }
        }
        if (P.ws == nullptr) grid.sync();
        if (ph < 20) xcd_barrier(xbar);
        }
    }
}

extern "C" void kernel_launch(void* const* d_in, const int* in_sizes, int n_in, void* d_out, int out_size, void* d_ws, size_t ws_size,
                              hipStream_t stream) {
    static int grid_blocks = 0;
    if (!grid_blocks) {
        int dev = 0, cus = 0, per_cu = 0;
        hipGetDevice(&dev);
        hipDeviceGetAttribute(&cus, hipDeviceAttributeMultiprocessorCount, dev);
        hipFuncSetAttribute((const void*)fwd_megakernel, hipFuncAttributeMaxDynamicSharedMemorySize, LDS_BYTES);
        hipOccupancyMaxActiveBlocksPerMultiprocessor(&per_cu, fwd_megakernel, NTHR, LDS_BYTES);
        if (per_cu < 1) per_cu = 1;
        if (per_cu > 1) per_cu = 1;
        grid_blocks = cus * per_cu;
    }
    if (ws_size < WS_NEED) { fprintf(stderr, "workspace too small: %zu < %zu\n", ws_size, (size_t)WS_NEED); return; }
    Params p{};
    for (int i = 0; i < 25; ++i) p.in[i] = (const float*)d_in[i];
    p.out = (float*)d_out; p.ws = (char*)d_ws;
    hipMemsetAsync((char*)d_ws + OFF_BAR, 0, 16384, stream);
    void* args[] = {&p};
    hipError_t e = hipLaunchCooperativeKernel((void*)fwd_megakernel, dim3(grid_blocks), dim3(NTHR), args, LDS_BYTES, stream);
    if (e != hipSuccess) fprintf(stderr, "cooperative launch failed: %s (grid %d)\n", hipGetErrorString(e), grid_blocks);
}
```

```cpp
#include <hip/hip_runtime.h>
#include <hip/hip_cooperative_groups.h>
#include <cstdio>
#include <cstdint>
namespace cg = cooperative_groups;

#define DI __device__ __forceinline__
typedef unsigned short bf16_t;
typedef short bf16x8 __attribute__((ext_vector_type(8)));
typedef short s16x4 __attribute__((ext_vector_type(4)));
typedef float f32x16 __attribute__((ext_vector_type(16)));
typedef __bf16 bf2_t __attribute__((ext_vector_type(2)));
typedef float f2_t __attribute__((ext_vector_type(2)));
typedef short v4i16_t __attribute__((ext_vector_type(4)));
#define MFMA(a, b, c) __builtin_amdgcn_mfma_f32_32x32x16_bf16((a), (b), (c), 0, 0, 0)

constexpr int T = 16384, S = 4096, D = 1024, DFF = 2816, NGU = 5632;
constexpr float EPS = 1e-6f;
constexpr float LOG2E = 1.4426950408889634f;
constexpr float LN2 = 0.6931471805599453f;

constexpr size_t SZ_GU = (size_t)NGU * D * 2, SZ_DN = (size_t)D * DFF * 2, SZ_MM = (size_t)D * D * 2;
constexpr size_t OFF_GU1 = 0;
constexpr size_t OFF_DN1 = OFF_GU1 + 2 * SZ_GU;
constexpr size_t OFF_GU2 = OFF_DN1 + 2 * SZ_DN;
constexpr size_t OFF_DN2 = OFF_GU2 + 2 * SZ_GU;
constexpr size_t OFF_WQ = OFF_DN2 + 2 * SZ_DN;
constexpr size_t OFF_WKV = OFF_WQ + 2 * SZ_MM;
constexpr size_t OFF_WO = OFF_WKV + 4 * SZ_MM;
constexpr size_t OFF_EVIN = OFF_WO + 2 * SZ_MM;
constexpr size_t OFF_EVOUT = OFF_EVIN + (size_t)2304 * D * 2;
constexpr size_t OFF_ODIN = OFF_EVOUT + SZ_MM;
constexpr size_t OFF_ODOUT = OFF_ODIN + (size_t)3072 * D * 2;
constexpr size_t OFF_XB = OFF_ODOUT + SZ_MM;
constexpr size_t OFF_BIG = OFF_XB + (size_t)T * D * 2;
constexpr size_t OFF_MEMB = OFF_BIG + (size_t)T * 3072 * 2;
constexpr size_t OFF_KN = OFF_MEMB + SZ_MM;
constexpr size_t OFF_VT = OFF_KN + 2 * SZ_MM;
constexpr size_t OFF_SSQ = OFF_VT + 2 * SZ_MM;
constexpr size_t OFF_SSQM = OFF_SSQ + (size_t)9 * T * 4;
constexpr size_t OFF_KMAX = OFF_SSQM + 4096;
constexpr size_t OFF_BAR = OFF_KMAX + 256;
constexpr size_t OFF_KF = OFF_BAR + 16384;
constexpr size_t WS_NEED = OFF_KF + 2 * SZ_MM;

#ifndef PROBE_MASK
#define PROBE_MASK 0
#endif
#ifndef PROBE_GEMM
#define PROBE_GEMM 0
#endif
constexpr int NTHR = 512;
constexpr int NST = 4;
constexpr int STAGE_B = 32768;
constexpr int OPB = 16384;
constexpr int LDS_BYTES = 147712;

struct Params { const float* in[25]; float* out; char* ws; };

DI unsigned pk2(float a, float b) { f2_t v = {a, b}; bf2_t r = __builtin_convertvector(v, bf2_t); return __builtin_bit_cast(unsigned, r); }
typedef unsigned v4u_t __attribute__((ext_vector_type(4)));
DI __amdgpu_buffer_rsrc_t wt_rsrc(const void* base, size_t bytes) { return __builtin_amdgcn_make_buffer_rsrc((void*)base, (short)0, (int)bytes, 0x00020000); }
DI void st16_wt(__amdgpu_buffer_rsrc_t r, size_t byteoff, uint4 v) { const v4u_t x = {v.x, v.y, v.z, v.w}; __builtin_amdgcn_raw_buffer_store_b128(x, r, (unsigned)byteoff, 0, 16); }
DI void st16f_wt(__amdgpu_buffer_rsrc_t r, size_t byteoff, float4 v) { const v4u_t x = {__float_as_uint(v.x), __float_as_uint(v.y), __float_as_uint(v.z), __float_as_uint(v.w)}; __builtin_amdgcn_raw_buffer_store_b128(x, r, (unsigned)byteoff, 0, 16); }
DI float bflo(unsigned w) { return __uint_as_float(w << 16); }
DI float bfhi(unsigned w) { return __uint_as_float(w & 0xffff0000u); }
DI int otid() { int t = threadIdx.x; asm volatile("" : "+v"(t)); return t; }
DI int crow(int i, int h) { return (i & 3) + 8 * (i >> 2) + 4 * h; }
DI float fexp2(float x) { return __builtin_amdgcn_exp2f(x); }
DI float flog2(float x) { return __builtin_amdgcn_logf(x); }

struct WJob { const float* src; bf16_t* dst; const float* gain; int K, N, gu; };

DI int wjob_tiles(int j) {
    if (j < 14) {
        const int kind = j >> 1;
        switch (kind) {
            case 0: case 2: return 16 * 88;
            case 1: case 3: return 44 * 16;
            case 4: return 256;
            case 5: return 512;
            default: return 256;
        }
    }
    if (j == 14) return 16 * 36;
    if (j == 16) return 16 * 48;
    return 256;
}

DI WJob get_wjob(const Params& P, int j) {
    WJob w; w.gain = nullptr; w.gu = 0;
    bf16_t* wsb = (bf16_t*)P.ws;
    if (j < 14) {
        const int kind = j >> 1, l = j & 1;
        switch (kind) {
            case 0: w.src = P.in[3] + (size_t)l * D * NGU; w.dst = (bf16_t*)(P.ws + OFF_GU1 + l * SZ_GU); w.gain = P.in[2] + l * D; w.K = D; w.N = NGU; w.gu = 1; break;
            case 1: w.src = P.in[4] + (size_t)l * DFF * D; w.dst = (bf16_t*)(P.ws + OFF_DN1 + l * SZ_DN); w.K = DFF; w.N = D; w.gu = 2; break;
            case 2: w.src = P.in[23] + (size_t)l * D * NGU; w.dst = (bf16_t*)(P.ws + OFF_GU2 + l * SZ_GU); w.gain = P.in[22] + l * D; w.K = D; w.N = NGU; w.gu = 1; break;
            case 3: w.src = P.in[24] + (size_t)l * DFF * D; w.dst = (bf16_t*)(P.ws + OFF_DN2 + l * SZ_DN); w.K = DFF; w.N = D; w.gu = 2; break;
            case 4: w.src = P.in[17] + (size_t)l * D * D; w.dst = (bf16_t*)(P.ws + OFF_WQ + l * SZ_MM); w.gain = P.in[15] + l * D; w.K = D; w.N = D; w.gu = 2; break;
            case 5: w.src = P.in[18] + (size_t)l * D * 2048; w.dst = (bf16_t*)(P.ws + OFF_WKV + l * 2 * SZ_MM); w.gain = P.in[16] + l * D; w.K = D; w.N = 2048; break;
            default: w.src = P.in[21] + (size_t)l * D * D; w.dst = (bf16_t*)(P.ws + OFF_WO + l * SZ_MM); w.K = D; w.N = D; w.gu = 2; break;
        }
    } else if (j == 14) { w.src = P.in[6]; w.dst = (bf16_t*)(P.ws + OFF_EVIN); w.gain = P.in[5]; w.K = D; w.N = 2304; w.gu = 3; }
    else if (j == 15) { w.src = P.in[10]; w.dst = (bf16_t*)(P.ws + OFF_EVOUT); w.K = D; w.N = D; w.gu = 2; }
    else if (j == 16) { w.src = P.in[11]; w.dst = (bf16_t*)(P.ws + OFF_ODIN); w.gain = P.in[5] + D; w.K = D; w.N = 3072; w.gu = 2; }
    else { w.src = P.in[14]; w.dst = (bf16_t*)(P.ws + OFF_ODOUT); w.K = D; w.N = D; w.gu = 2; }
    (void)wsb;
    return w;
}

DI void wconv_tile(const WJob& w, int t, float* sm, int tid, bool act) {
    const int ntn = w.N >> 6; const int tk = t / ntn, tn = t - tk * ntn;
    if (act) {
#pragma unroll
        for (int p = 0; p < 4; ++p) {
            const int kr = p * 16 + (tid >> 4);
            typedef float f32x4nt __attribute__((ext_vector_type(4)));
            const f32x4nt v = __builtin_nontemporal_load((const f32x4nt*)(w.src + (size_t)(tk * 64 + kr) * w.N + tn * 64 + (tid & 15) * 4));
            const float g = w.gain ? w.gain[tk * 64 + kr] : 1.f;
            float* sp = sm + kr * 65 + (tid & 15) * 4;
            sp[0] = v[0] * g; sp[1] = v[1] * g; sp[2] = v[2] * g; sp[3] = v[3] * g;
        }
    }
    __syncthreads();
    if (act) {
        const int n = tid >> 2, kq = tid & 3; const int ng = tn * 64 + n;
        int drow = ng;
        if (w.gu == 1) drow = ng < DFF ? ((ng >> 7) * 256 + (ng & 127)) : (((ng - DFF) >> 7) * 256 + 128 + ((ng - DFF) & 127));
        else if (w.gu >= 2) {
            int a = ng;
            if (w.gu == 3) a = ng < 512 ? ng : ng < 768 ? ng + 512 : ng < 1280 ? ng - 256 : ng;
            drow = (a & ~255) + (((a >> 5) & 1) << 7) + (((a >> 6) & 3) << 5) + (a & 31);
        }
        unsigned o[8];
#pragma unroll
        for (int e = 0; e < 8; ++e) o[e] = pk2(sm[(kq * 16 + 2 * e) * 65 + n], sm[(kq * 16 + 2 * e + 1) * 65 + n]);
        uint4* dp = (uint4*)(w.dst + (size_t)drow * w.K + tk * 64 + kq * 16);
        dp[0] = make_uint4(o[0], o[1], o[2], o[3]); dp[1] = make_uint4(o[4], o[5], o[6], o[7]);
    }
    __syncthreads();
}

DI float wave_sum(float v) {
    v += __shfl_xor(v, 1); v += __shfl_xor(v, 2); v += __shfl_xor(v, 4); v += __shfl_xor(v, 8); v += __shfl_xor(v, 16); v += __shfl_xor(v, 32);
    return v;
}

DI void rowconv(const float* src, bf16_t* dst, float* ssq, int row, int lane) {
    const float* xr = src + (size_t)row * D;
    float ss = 0.f;
#pragma unroll
    for (int p = 0; p < 4; ++p) {
        const float4 v = *(const float4*)(xr + p * 256 + lane * 4);
        ss += v.x * v.x + v.y * v.y + v.z * v.z + v.w * v.w;
        *(uint2*)(dst + (size_t)row * D + p * 256 + lane * 4) = make_uint2(pk2(v.x, v.y), pk2(v.z, v.w));
    }
    ss = wave_sum(ss);
    if (lane == 0) ssq[row] = ss;
}

DI void phase0(const Params& P, char* smem) {
    const int tid = otid(), lane = tid & 63, wid = tid >> 6;
    float* ssq = (float*)(P.ws + OFF_SSQ);
    for (int i = blockIdx.x * NTHR + tid; i < 8 * T; i += gridDim.x * NTHR) ssq[T + i] = 0.f;
    if (blockIdx.x == 0 && tid < 32) ((unsigned*)(P.ws + OFF_KMAX))[tid] = 0u;
    constexpr int NW = 12352 / 2, NX = T / 8, NM = 1024 / 8;
    for (int u = blockIdx.x; u < NW + NX + NM; u += gridDim.x) {
        if (u < NW) {
            const int half = tid >> 8;
            int t = 2 * u + half, j = 0;
            for (; j < 17; ++j) { const int c = wjob_tiles(j); if (t < c) break; t -= c; }
            const WJob w = get_wjob(P, j);
            wconv_tile(w, t, (float*)smem + half * (64 * 65), tid & 255, true);
        } else if (u < NW + NX) {
            rowconv(P.in[0], (bf16_t*)(P.ws + OFF_XB), ssq, (u - NW) * 8 + wid, lane);
        } else {
            rowconv(P.in[1], (bf16_t*)(P.ws + OFF_MEMB), (float*)(P.ws + OFF_SSQM), (u - NW - NX) * 8 + wid, lane);
        }
    }
}

struct GJob {
    const bf16_t* A; const bf16_t* W;
    int lda, ksplit, kextra, K, ntm, ntn, mode;
    const float* rs;
    bf16_t* O; int ldo;
    const float* xin; float* xout; bf16_t* xb; float* ssq_out; float alpha;
    const float* qg; const float* kg; int qn_end, kn_end;
    bf16_t* vt;
};

typedef __attribute__((address_space(3))) unsigned* ldsu_t;
typedef const __attribute__((address_space(1))) unsigned* glbu_t;
DI void glds16(const bf16_t* g, char* l) { __builtin_amdgcn_global_load_lds((glbu_t)(const void*)g, (ldsu_t)(void*)l, 16, 0, 0); }

DI void gemm_tile(const GJob& J, int t, char* smem, bool dry) {
    const int tid = otid(), lane = tid & 63, wid = tid >> 6, wr = wid >> 2, wc = wid & 3;
    const int r = lane & 31, h = lane >> 5;
    int tm, tn;
    { const int gsz = 32 * J.ntn; const int g = t / gsz; const int rem = t - g * gsz; const int rows = min(32, J.ntm - g * 32); tn = rem / rows; tm = g * 32 + (rem - tn * rows); }
    const int lrow = wid * 16 + (lane >> 2);
    const int csw = ((lane & 3) ^ ((lane >> 4) & 3)) * 8;
    const bf16_t* Ag = J.A + (size_t)(tm * 256 + lrow) * J.lda + csw;
    const bf16_t* Wg = J.W + (size_t)(tn * 256 + lrow) * J.K + csw;
    const size_t astr = (size_t)128 * J.lda, wstr = (size_t)128 * J.K;
    char* lb = smem + tid * 16;
    const int nk = J.K >> 5;
#define GLDS(kt, buf) do { const int k0_ = (kt) * 32; const int ka_ = k0_ + (k0_ >= J.ksplit ? J.kextra : 0); char* l_ = lb + (buf) * STAGE_B; \
        glds16(Ag + ka_, l_); glds16(Ag + astr + ka_, l_ + 8192); glds16(Wg + k0_, l_ + OPB); glds16(Wg + wstr + k0_, l_ + OPB + 8192); } while (0)
    f32x16 acc[4][2];
#pragma unroll
    for (int a = 0; a < 4; ++a)
#pragma unroll
        for (int b = 0; b < 2; ++b)
#pragma unroll
            for (int i = 0; i < 16; ++i) acc[a][b][i] = 0.f;
    const int fr = (r >> 2) & 3;
    const int xrow = (wc * 64 + r) * 64, wrow = OPB + (wr * 128 + r) * 64;
    const int co0 = ((0 + h) ^ fr) * 16, co1 = ((2 + h) ^ fr) * 16;

    __syncthreads();
    GLDS(0, 0); GLDS(1, 1); GLDS(2, 2);
    asm volatile("s_waitcnt vmcnt(8)" ::: "memory");
    __builtin_amdgcn_s_barrier();
    bf16x8 w0[4], x0[2], w1[4], x1[2];
#define LOADF(W_, X_, sb_, co_) do { _Pragma("unroll") for (int ti = 0; ti < 2; ++ti) X_[ti] = *(const bf16x8*)((sb_) + xrow + ti * 2048 + (co_)); \
        _Pragma("unroll") for (int fi = 0; fi < 4; ++fi) W_[fi] = *(const bf16x8*)((sb_) + wrow + fi * 2048 + (co_)); } while (0)
#define MFMA8(W_, X_) do { __builtin_amdgcn_s_setprio(1); _Pragma("unroll") for (int fi = 0; fi < 4; ++fi) _Pragma("unroll") for (int ti = 0; ti < 2; ++ti) \
        acc[fi][ti] = MFMA(W_[fi], X_[ti], acc[fi][ti]); __builtin_amdgcn_s_setprio(0); } while (0)
    LOADF(w0, x0, smem, co0);
    __builtin_amdgcn_s_waitcnt(0xC07F);
    int buf = 0;
    for (int kt = 0; kt < nk; ++kt) {
        const char* sb = smem + buf * STAGE_B;
        LOADF(w1, x1, sb, co1);
        __builtin_amdgcn_sched_barrier(0);
        MFMA8(w0, x0);
        __builtin_amdgcn_s_waitcnt(0xC07F);
        __builtin_amdgcn_sched_barrier(0);
        const int nb = (buf + 1 == NST) ? 0 : buf + 1;
        if (kt + 1 < nk) {
            if (kt + 2 < nk) asm volatile("s_waitcnt vmcnt(4)" ::: "memory"); else asm volatile("s_waitcnt vmcnt(0)" ::: "memory");
            __builtin_amdgcn_s_barrier();
            if (kt + 3 < nk) { const int fb_ = (buf + 3 >= NST) ? buf + 3 - NST : buf + 3; GLDS(kt + 3, fb_); }
        }
        LOADF(w0, x0, smem + nb * STAGE_B, co0);
        __builtin_amdgcn_sched_barrier(0);
        MFMA8(w1, x1);
        __builtin_amdgcn_s_waitcnt(0xC07F);
        __builtin_amdgcn_sched_barrier(0);
        buf = nb;
    }
#undef LOADF
#undef MFMA8
#undef GLDS
    __syncthreads();

    if (dry) { if (acc[0][0][0] + acc[1][1][0] + acc[2][0][0] + acc[3][1][0] == 12345.678f) J.O[0] = 1; return; }
    const int tokb = tm * 256 + wc * 64;
    const int fb = tn * 256 + wr * 128;
    float rsc[2];
#pragma unroll
    for (int ti = 0; ti < 2; ++ti) rsc[ti] = J.rs ? __builtin_amdgcn_rsqf(J.rs[tokb + ti * 32 + r] * (1.f / 1024.f) + EPS) : 1.f;

    if (J.mode == 3 && fb >= 1024) {
#pragma unroll
        for (int ti = 0; ti < 2; ++ti) {
            const int tok = tokb + ti * 32 + r;
#pragma unroll
            for (int fi = 0; fi < 4; ++fi)
#pragma unroll
                for (int i = 0; i < 16; ++i) {
                    const int f = fb - 1024 + fi * 32 + crow(i, h);
                    const int bh_ = (tok >> 8) * 4 + (f >> 8), d_ = f & 255, key_ = tok & 255, k16 = key_ & 15;
                    const int ln_ = ((k16 >> 2) & 1) * 32 + (d_ & 31), e_ = ((k16 >> 3) << 2) | (k16 & 3);
                    J.vt[((((((size_t)bh_ * 8 + (d_ >> 5)) * 8 + (key_ >> 5)) * 2 + ((key_ >> 4) & 1)) * 64 + ln_) << 3) + e_] = (bf16_t)(pk2(acc[fi][ti][i] * rsc[ti], 0.f) & 0xffffu);
                }
        }
        return;
    }
    char* wl = smem + wid * 16384;
#pragma unroll
    for (int ti = 0; ti < 2; ++ti) {
#pragma unroll
        for (int fp = 0; fp < 2; ++fp) {
            const float sc = (J.mode == 1) ? J.alpha : rsc[ti];
#pragma unroll
            for (int fi2 = 0; fi2 < 2; ++fi2)
#pragma unroll
                for (int g = 0; g < 4; ++g) {
                    float4 v;
                    v.x = acc[2 * fp + fi2][ti][4 * g + 0] * sc; v.y = acc[2 * fp + fi2][ti][4 * g + 1] * sc;
                    v.z = acc[2 * fp + fi2][ti][4 * g + 2] * sc; v.w = acc[2 * fp + fi2][ti][4 * g + 3] * sc;
                    *(float4*)(wl + r * 272 + (fi2 * 32 + 8 * g + 4 * h) * 4) = v;
                }
            const int tok0 = tokb + ti * 32, f0 = fb + fp * 64;
            if (J.mode == 0) {
                const int c4 = (lane & 7) * 4;
#pragma unroll
                for (int p = 0; p < 4; ++p) {
                    const int row = p * 8 + (lane >> 3);
                    const float4 ga = *(const float4*)(wl + row * 272 + c4 * 4);
                    const float4 up = *(const float4*)(wl + row * 272 + (32 + c4) * 4);
                    float y0 = ga.x * up.x * __builtin_amdgcn_rcpf(1.f + fexp2(-ga.x * LOG2E));
                    float y1 = ga.y * up.y * __builtin_amdgcn_rcpf(1.f + fexp2(-ga.y * LOG2E));
                    float y2 = ga.z * up.z * __builtin_amdgcn_rcpf(1.f + fexp2(-ga.z * LOG2E));
                    float y3 = ga.w * up.w * __builtin_amdgcn_rcpf(1.f + fexp2(-ga.w * LOG2E));
                    *(uint2*)(J.O + (size_t)(tok0 + row) * J.ldo + (f0 >> 1) + c4) = make_uint2(pk2(y0, y1), pk2(y2, y3));
                }
            } else if (J.mode == 1) {
                const int c4 = (lane & 15) * 4;
#pragma unroll
                for (int p = 0; p < 8; ++p) {
                    const int row = p * 4 + (lane >> 4);
                    const size_t tok = tok0 + row;
                    const float4 v = *(const float4*)(wl + row * 272 + c4 * 4);
                    const float4 xo = *(const float4*)(J.xin + tok * D + f0 + c4);
                    float4 xn; xn.x = xo.x + v.x; xn.y = xo.y + v.y; xn.z = xo.z + v.z; xn.w = xo.w + v.w;
                    *(float4*)(J.xout + tok * D + f0 + c4) = xn;
                    if (J.xb) {
                        *(uint2*)(J.xb + tok * D + f0 + c4) = make_uint2(pk2(xn.x, xn.y), pk2(xn.z, xn.w));
                        float ss = xn.x * xn.x + xn.y * xn.y + xn.z * xn.z + xn.w * xn.w;
                        ss += __shfl_xor(ss, 1); ss += __shfl_xor(ss, 2); ss += __shfl_xor(ss, 4); ss += __shfl_xor(ss, 8);
                        if ((lane & 15) == 0) atomicAdd(J.ssq_out + tok, ss);
                    }
                }
            } else {
                const int nm = f0 < J.qn_end ? 1 : (f0 < J.kn_end ? 2 : 0);
                const float* gp = nm == 1 ? J.qg : J.kg;
                const int c4 = (lane & 15) * 4;
                float4 gn = make_float4(1.f, 1.f, 1.f, 1.f);
                if (nm) gn = *(const float4*)(gp + c4);
#pragma unroll
                for (int p = 0; p < 8; ++p) {
                    const int row = p * 4 + (lane >> 4);
                    float4 v = *(const float4*)(wl + row * 272 + c4 * 4);
                    if (nm) {
                        float ss = v.x * v.x + v.y * v.y + v.z * v.z + v.w * v.w;
                        ss += __shfl_xor(ss, 1); ss += __shfl_xor(ss, 2); ss += __shfl_xor(ss, 4); ss += __shfl_xor(ss, 8);
                        const float inv = __builtin_amdgcn_rsqf(ss * (1.f / 64.f) + EPS);
                        v.x *= inv * gn.x; v.y *= inv * gn.y; v.z *= inv * gn.z; v.w *= inv * gn.w;
                    }
                    *(uint2*)(J.O + (size_t)(tok0 + row) * J.ldo + f0 + c4) = make_uint2(pk2(v.x, v.y), pk2(v.z, v.w));
                }
            }
        }
    }
}

DI void gemm_phase(const GJob& JA, int nA, int nB, const Params& P, char* smem, bool dry) {
    for (int u = (int)gridDim.x - 1 - (int)blockIdx.x; u < nA + nB; u += gridDim.x) {
        GJob J = JA; int t = u;
        if (u >= nA) {
            const int v = u - nA; const int layer = v >> 5; t = v & 31;
            J.A = (const bf16_t*)(P.ws + OFF_MEMB); J.lda = D; J.ksplit = 1 << 30; J.kextra = 0;
            J.W = (const bf16_t*)(P.ws + OFF_WKV + (size_t)layer * 2 * SZ_MM); J.K = D; J.ntm = 4; J.ntn = 8; J.mode = 3;
            J.rs = (const float*)(P.ws + OFF_SSQM); J.O = (bf16_t*)(P.ws + OFF_KN + (size_t)layer * SZ_MM); J.ldo = D;
            J.qn_end = 0; J.kn_end = 0; J.vt = (bf16_t*)(P.ws + OFF_VT + (size_t)layer * SZ_MM);
        }
        gemm_tile(J, t, smem, dry);
    }
}

namespace pg8 {
#define PG8_LAS __attribute__((address_space(3)))
typedef float f32x4 __attribute__((ext_vector_type(4)));
typedef unsigned u32x4 __attribute__((ext_vector_type(4)));
constexpr int BM = 256, BK = 64, HALF = 128, HTB = HALF * BK * 2, STAGE_BYTES = 8 * HTB, NXCD = 8, WGM = 8;
DI int lds_byte(int r, int c) { const int st = (r >> 4) * 2 + (c >> 5), rr = r & 15, cc = c & 31, ob = rr * 64 + cc * 2; return st * 1024 + (ob ^ (((ob >> 9) & 1) << 5)); }
DI void stage_rc(int b, int& R, int& C) { const int st = b / 1024, sb = b % 1024, swz = sb ^ (((sb >> 9) & 1) << 5); R = (st >> 1) * 16 + swz / 64; C = (st & 1) * 32 + (swz % 64) / 2; }
DI int perm32(int rho) { const int n = rho >> 4, i = rho & 15; return 8 * (i >> 2) + 4 * n + (i & 3); }
struct Unit { int pm, pn; };
struct Gemm { const bf16_t* A; const bf16_t* Bt; int M, N, K, lda; };
struct StaticOrder {
    int nM, nN, nwg, G, c;
    DI void init(int M, int N, int G_, int c_) { nM = M / BM; nN = N / BM; nwg = nM * nN; G = G_; c = c_; }
    DI bool next(int i, Unit& u) const {
        const long L = (long)i * G + c; if (L >= nwg) return false;
        int wgid = (int)L; { const int q = nwg / NXCD, r = nwg % NXCD, xcd = wgid % NXCD, off = wgid / NXCD; wgid = (xcd < r ? xcd * (q + 1) : r * (q + 1) + (xcd - r) * q) + off; }
        const int nig = WGM * nN, gid = wgid / nig, fm = gid * WGM, gsz = (nM - fm) < WGM ? (nM - fm) : WGM;
        u.pm = fm + ((wgid % nig) % gsz); u.pn = (wgid % nig) / gsz; return true;
    }
    DI void a_ready(const Unit&) const {}
    DI void done(const Unit&) const {}
};

struct Epi {
    static constexpr bool PERM = true, AFTER_DRAIN = false;
    int mode;
    const float* rs;
    bf16_t* O; int ldo;
    const float* xin; float* xout; bf16_t* xb; float* ssq_out; float alpha;
    const float* qg; const float* kg; int qn_end, kn_beg, kn_end; int dryrun;
    template <bool SRC_F32, bool DST_F32>
    DI void res_path(const f32x4 (&acc)[2][2][4][2], int row0, int colb, int fq) const {
        const __amdgpu_buffer_rsrc_t r_xb = wt_rsrc(xb, (size_t)T * D * 2), r_out = wt_rsrc(DST_F32 ? (const void*)xout : (const void*)xb, (size_t)T * D * (DST_F32 ? 4 : 2));
#pragma unroll
        for (int ai = 0; ai < 2; ++ai) {
            float4 xf[4][2][2];
            uint4 xw[4][2];
#pragma unroll
            for (int m = 0; m < 4; ++m)
#pragma unroll
                for (int bj = 0; bj < 2; ++bj) {
                    const size_t off = (size_t)(row0 + ai * HALF + m * 16) * D + colb + bj * 32;
                    if (SRC_F32) { xf[m][bj][0] = *(const float4*)(xin + off); xf[m][bj][1] = *(const float4*)(xin + off + 4); }
                    else xw[m][bj] = *(const uint4*)(xb + off);
                }
#pragma unroll
            for (int m = 0; m < 4; ++m) {
                const size_t tok = row0 + ai * HALF + m * 16;
                float ss = 0.f;
#pragma unroll
                for (int bj = 0; bj < 2; ++bj) {
                    const size_t off = tok * D + colb + bj * 32;
                    float4 x0, x1;
                    if (SRC_F32) { x0 = xf[m][bj][0]; x1 = xf[m][bj][1]; }
                    else { const uint4 w = xw[m][bj]; x0 = make_float4(bflo(w.x), bfhi(w.x), bflo(w.y), bfhi(w.y)); x1 = make_float4(bflo(w.z), bfhi(w.z), bflo(w.w), bfhi(w.w)); }
                    float4 n0, n1;
                    n0.x = x0.x + alpha * acc[ai][bj][m][0][0]; n0.y = x0.y + alpha * acc[ai][bj][m][0][1]; n0.z = x0.z + alpha * acc[ai][bj][m][0][2]; n0.w = x0.w + alpha * acc[ai][bj][m][0][3];
                    n1.x = x1.x + alpha * acc[ai][bj][m][1][0]; n1.y = x1.y + alpha * acc[ai][bj][m][1][1]; n1.z = x1.z + alpha * acc[ai][bj][m][1][2]; n1.w = x1.w + alpha * acc[ai][bj][m][1][3];
                    if (DST_F32) { st16f_wt(r_out, off * 4, n0); st16f_wt(r_out, off * 4 + 16, n1); }
                    else {
                        const uint4 w = make_uint4(pk2(n0.x, n0.y), pk2(n0.z, n0.w), pk2(n1.x, n1.y), pk2(n1.z, n1.w));
                        st16_wt(r_xb, off * 2, w);
                        const float r0 = bflo(w.x), r1 = bfhi(w.x), r2 = bflo(w.y), r3 = bfhi(w.y), r4 = bflo(w.z), r5 = bfhi(w.z), r6 = bflo(w.w), r7 = bfhi(w.w);
                        ss += r0 * r0 + r1 * r1 + r2 * r2 + r3 * r3 + r4 * r4 + r5 * r5 + r6 * r6 + r7 * r7;
                    }
                }
                if (!DST_F32) {
                    ss += __shfl_xor(ss, 16); ss += __shfl_xor(ss, 32);
                    if (fq == 0) atomicAdd(ssq_out + tok, ss);
                }
            }
        }
    }
    template <bool NM>
    DI void qkv_path(const f32x4 (&acc)[2][2][4][2], int row0, int f0, int fq, const float* gp) const {
        const __amdgpu_buffer_rsrc_t r_o = wt_rsrc(O, (size_t)T * ldo * 2);
        float4 g4[2][2];
#pragma unroll
        for (int bj = 0; bj < 2; ++bj)
#pragma unroll
            for (int n = 0; n < 2; ++n) g4[bj][n] = NM ? *(const float4*)(gp + bj * 32 + 8 * fq + 4 * n) : make_float4(1.f, 1.f, 1.f, 1.f);
        float sc8[2][4];
#pragma unroll
        for (int ai = 0; ai < 2; ++ai)
#pragma unroll
            for (int m = 0; m < 4; ++m) sc8[ai][m] = rs[row0 + ai * HALF + m * 16];
#pragma unroll
        for (int ai = 0; ai < 2; ++ai)
#pragma unroll
            for (int m = 0; m < 4; ++m) {
                const size_t tok = row0 + ai * HALF + m * 16;
                float sc = __builtin_amdgcn_rsqf(sc8[ai][m] * (1.f / 1024.f) + EPS);
                if (NM) {
                    float ss = 0.f;
#pragma unroll
                    for (int bj = 0; bj < 2; ++bj)
#pragma unroll
                        for (int n = 0; n < 2; ++n)
#pragma unroll
                            for (int j = 0; j < 4; ++j) { const float v = acc[ai][bj][m][n][j] * sc; ss += v * v; }
                    ss += __shfl_xor(ss, 16); ss += __shfl_xor(ss, 32);
                    sc *= __builtin_amdgcn_rsqf(ss * (1.f / 64.f) + EPS);
                }
#pragma unroll
                for (int bj = 0; bj < 2; ++bj) {
                    const f32x4 a0 = acc[ai][bj][m][0], a1 = acc[ai][bj][m][1];
                    st16_wt(r_o, (tok * ldo + f0 + bj * 32 + 8 * fq) * 2,
                        make_uint4(pk2(a0[0] * sc * g4[bj][0].x, a0[1] * sc * g4[bj][0].y), pk2(a0[2] * sc * g4[bj][0].z, a0[3] * sc * g4[bj][0].w),
                                   pk2(a1[0] * sc * g4[bj][1].x, a1[1] * sc * g4[bj][1].y), pk2(a1[2] * sc * g4[bj][1].z, a1[3] * sc * g4[bj][1].w)));
                }
            }
    }
    DI void operator()(const f32x4 (&acc)[2][2][4][2], const Unit& u, int wr, int wc, int fr, int fq) const {
        if (dryrun) { if (acc[0][0][0][0][0] + acc[1][1][3][1][3] + acc[0][1][2][0][1] + acc[1][0][1][1][2] == 12345.678f) O[0] = 1; return; }
        const int row0 = u.pm * BM + wr * 64 + fr;
        if (mode == 0) {
            const int col = u.pn * 128 + wc * 32 + 8 * fq;
            const __amdgpu_buffer_rsrc_t r_o = wt_rsrc(O, (size_t)T * ldo * 2);
            float sc8[2][4];
#pragma unroll
            for (int ai = 0; ai < 2; ++ai)
#pragma unroll
                for (int m = 0; m < 4; ++m) sc8[ai][m] = rs[row0 + ai * HALF + m * 16];
#pragma unroll
            for (int ai = 0; ai < 2; ++ai)
#pragma unroll
                for (int m = 0; m < 4; ++m) {
                    const size_t tok = row0 + ai * HALF + m * 16;
                    const float sc = __builtin_amdgcn_rsqf(sc8[ai][m] * (1.f / 1024.f) + EPS);
                    float y[8];
#pragma unroll
                    for (int n = 0; n < 2; ++n)
#pragma unroll
                        for (int j = 0; j < 4; ++j) {
                            const float ga = acc[ai][0][m][n][j] * sc, up = acc[ai][1][m][n][j] * sc;
                            y[4 * n + j] = ga * up * __builtin_amdgcn_rcpf(1.f + fexp2(-ga * LOG2E));
                        }
                    st16_wt(r_o, (tok * ldo + col) * 2, make_uint4(pk2(y[0], y[1]), pk2(y[2], y[3]), pk2(y[4], y[5]), pk2(y[6], y[7])));
                }
        } else if (mode == 1) {
            const int colb = u.pn * BM + wc * 64 + 8 * fq;
            if (xin) res_path<true, false>(acc, row0, colb, fq);
            else if (xout) res_path<false, true>(acc, row0, colb, fq);
            else res_path<false, false>(acc, row0, colb, fq);
        } else {
            const int f0 = u.pn * BM + wc * 64;
            const int nm = f0 < qn_end ? 1 : ((f0 >= kn_beg && f0 < kn_end) ? 2 : 0);
            if (nm) qkv_path<true>(acc, row0, f0, fq, nm == 1 ? qg : kg);
            else qkv_path<false>(acc, row0, f0, fq, nullptr);
        }
    }
};

template <class Epi, class Sched, bool ALIGN_EPI = false, bool SP2 = false>
__device__ __forceinline__ void gemm_phase(PG8_LAS unsigned char* lds, const Gemm g, const Sched& S, const Epi& E) {
    const int tid = otid(), wid = __builtin_amdgcn_readfirstlane(tid >> 6), lane = tid & 63, wr = wid >> 2, wc = wid & 3, fr = lane & 15, fq = lane >> 4;
    const int K = g.K, nt = K / BK;
    unsigned voffA[2], voffB[2];
#pragma unroll
    for (int i = 0; i < 2; ++i) { int R, C; stage_rc(tid * 16 + i * 8192, R, C); const int Rb = Epi::PERM ? ((R & ~31) + perm32(R & 31)) : R;
        voffA[i] = (unsigned)(R * g.lda + C) * 2u; voffB[i] = (unsigned)(Rb * K + C) * 2u; }
    const size_t kstep = (size_t)(BK * 2);
    const size_t hstepA = (size_t)HALF * g.lda * 2, hstepB = (size_t)HALF * K * 2;
    const size_t tstepA = 2 * hstepA, tstepB = 2 * hstepB;
    const unsigned ldsw = (unsigned)wid * 1024u;
    const int aoff = lds_byte(wr * 64 + fr, fq * 8), boff = lds_byte(wc * 32 + fr, fq * 8);
#define PG8_SA(b, h) (((b) * 2 + (h)) * HTB)
#define PG8_SB(b, h) ((4 + (b) * 2 + (h)) * HTB)
#define PG8_STAGE(bufoff, gbase, voff) do { _Pragma("unroll") for (int _i = 0; _i < 2; ++_i) \
        __builtin_amdgcn_global_load_lds((const unsigned*)((const char*)(gbase) + (voff)[_i]), (PG8_LAS unsigned*)(lds + (bufoff) + ldsw + _i * 8192), 16, 0, 0); } while (0)
#define PG8_LDA(dst, b, h) do { _Pragma("unroll") for (int m = 0; m < 4; ++m) _Pragma("unroll") for (int k = 0; k < 2; ++k) dst[m][k] = *(const PG8_LAS bf16x8*)(lds + PG8_SA(b, h) + aoff + m * 2048 + k * 1024); } while (0)
#define PG8_LDB(dst, b, h) do { _Pragma("unroll") for (int n = 0; n < 2; ++n) _Pragma("unroll") for (int k = 0; k < 2; ++k) dst[n][k] = *(const PG8_LAS bf16x8*)(lds + PG8_SB(b, h) + boff + n * 2048 + k * 1024); } while (0)
#define PG8_MMA(ai, bj, At, Bt) do { __builtin_amdgcn_s_setprio(1); _Pragma("unroll") for (int m = 0; m < 4; ++m) _Pragma("unroll") for (int n = 0; n < 2; ++n) _Pragma("unroll") for (int k = 0; k < 2; ++k) \
        acc[ai][bj][m][n] = __builtin_amdgcn_mfma_f32_16x16x32_bf16(Bt[n][k], At[m][k], acc[ai][bj][m][n], 0, 0, 0); __builtin_amdgcn_s_setprio(0); } while (0)
#define PG8_WAIT_V(n) asm volatile("s_waitcnt vmcnt(" #n ")" ::: "memory")
#define PG8_WAIT_L(n) asm volatile("s_waitcnt lgkmcnt(" #n ")" ::: "memory")
#define PG8_BAR __builtin_amdgcn_s_barrier()
#define PG8_SCHED __builtin_amdgcn_sched_barrier(0)
    Unit cur, nxt; int ui = 0;
    if (!S.next(0, cur)) return;
    f32x4 acc[2][2][4][2];
#pragma unroll
    for (int a = 0; a < 2; ++a)
#pragma unroll
        for (int b = 0; b < 2; ++b)
#pragma unroll
            for (int m = 0; m < 4; ++m)
#pragma unroll
                for (int n = 0; n < 2; ++n) acc[a][b][m][n] = (f32x4){0.f, 0.f, 0.f, 0.f};
    bf16x8 At[4][2], B0[2][2], B1[2][2];
    const char* cA = (const char*)g.A + (size_t)cur.pm * tstepA; const char* cB = (const char*)g.Bt + (size_t)cur.pn * tstepB;
    S.a_ready(cur);
    if constexpr (SP2) {
        PG8_STAGE(PG8_SB(0, 0), cB, voffB); PG8_STAGE(PG8_SB(0, 1), cB + hstepB, voffB); PG8_STAGE(PG8_SA(0, 0), cA, voffA); PG8_STAGE(PG8_SA(0, 1), cA + hstepA, voffA);
        if (wr == 1) PG8_BAR;
        PG8_WAIT_V(2); PG8_BAR;
        PG8_STAGE(PG8_SB(1, 0), cB + kstep, voffB); PG8_STAGE(PG8_SA(1, 0), cA + kstep, voffA); PG8_STAGE(PG8_SB(1, 1), cB + hstepB + kstep, voffB);
        PG8_WAIT_V(6); PG8_BAR;
    } else {
        PG8_STAGE(PG8_SB(0, 0), cB, voffB); PG8_STAGE(PG8_SA(0, 0), cA, voffA); PG8_STAGE(PG8_SB(0, 1), cB + hstepB, voffB); PG8_STAGE(PG8_SA(0, 1), cA + hstepA, voffA);
        if (wr == 1) PG8_BAR;
        PG8_WAIT_V(4); PG8_BAR;
        PG8_STAGE(PG8_SB(1, 0), cB + kstep, voffB); PG8_STAGE(PG8_SA(1, 0), cA + kstep, voffA); PG8_STAGE(PG8_SB(1, 1), cB + hstepB + kstep, voffB);
        PG8_WAIT_V(6); PG8_BAR;
    }
    for (;;) {
        const bool has_next = S.next(ui + 1, nxt);
        const char* nA = has_next ? (const char*)g.A + (size_t)nxt.pm * tstepA : cA; const char* nB = has_next ? (const char*)g.Bt + (size_t)nxt.pn * tstepB : cB;
        for (int t = 0; t < nt; t += 2) {
            const bool last = (t == nt - 2);
            const char* a1 = cA + (size_t)(t + 1) * kstep;
            const char* a2 = last ? nA : cA + (size_t)(t + 2) * kstep; const char* b2 = last ? nB : cB + (size_t)(t + 2) * kstep;
            const char* a3 = a2 + kstep; const char* b3 = b2 + kstep;
            if (last && has_next) S.a_ready(nxt);
            if constexpr (SP2) {
            PG8_LDB(B0, 0, 0); PG8_LDB(B1, 0, 1); PG8_SCHED; PG8_LDA(At, 0, 0); PG8_STAGE(PG8_SA(1, 1), a1 + hstepA, voffA);
            PG8_WAIT_V(8); PG8_WAIT_L(0); PG8_BAR; PG8_MMA(0, 0, At, B0); PG8_MMA(0, 1, At, B1); PG8_BAR; PG8_SCHED;
            PG8_LDA(At, 0, 1); PG8_STAGE(PG8_SB(0, 0), b2, voffB); PG8_STAGE(PG8_SB(0, 1), b2 + hstepB, voffB); PG8_STAGE(PG8_SA(0, 0), a2, voffA);
            PG8_WAIT_V(8); PG8_WAIT_L(0); PG8_BAR; PG8_MMA(1, 0, At, B0); PG8_MMA(1, 1, At, B1); PG8_BAR; PG8_SCHED;
            PG8_LDB(B0, 1, 0); PG8_LDB(B1, 1, 1); PG8_SCHED; PG8_LDA(At, 1, 0); PG8_STAGE(PG8_SA(0, 1), a2 + hstepA, voffA);
            PG8_WAIT_V(8); PG8_WAIT_L(0); PG8_BAR; PG8_MMA(0, 0, At, B0); PG8_MMA(0, 1, At, B1); PG8_BAR; PG8_SCHED;
            PG8_LDA(At, 1, 1); PG8_STAGE(PG8_SB(1, 0), b3, voffB); PG8_STAGE(PG8_SB(1, 1), b3 + hstepB, voffB); PG8_STAGE(PG8_SA(1, 0), a3, voffA);
            PG8_WAIT_V(8); PG8_WAIT_L(0); PG8_BAR; PG8_MMA(1, 0, At, B0); PG8_MMA(1, 1, At, B1); PG8_BAR; PG8_SCHED;
            } else {
            PG8_LDB(B0, 0, 0); PG8_SCHED; PG8_LDA(At, 0, 0); PG8_STAGE(PG8_SA(1, 1), a1 + hstepA, voffA);
            PG8_WAIT_L(8); PG8_BAR; PG8_WAIT_L(0); PG8_MMA(0, 0, At, B0); PG8_BAR; PG8_SCHED;
            PG8_LDB(B1, 0, 1); PG8_STAGE(PG8_SB(0, 0), b2, voffB);
            PG8_BAR; PG8_WAIT_L(0); PG8_MMA(0, 1, At, B1); PG8_BAR;
            PG8_LDA(At, 0, 1); PG8_STAGE(PG8_SA(0, 0), a2, voffA);
            PG8_BAR; PG8_WAIT_L(0); PG8_MMA(1, 0, At, B0); PG8_BAR; PG8_SCHED;
            PG8_STAGE(PG8_SB(0, 1), b2 + hstepB, voffB);
            PG8_WAIT_V(6); PG8_BAR; PG8_MMA(1, 1, At, B1); PG8_BAR;
            PG8_LDB(B0, 1, 0); PG8_SCHED; PG8_LDA(At, 1, 0); PG8_STAGE(PG8_SA(0, 1), a2 + hstepA, voffA);
            PG8_WAIT_L(8); PG8_BAR; PG8_WAIT_L(0); PG8_MMA(0, 0, At, B0); PG8_BAR; PG8_SCHED;
            PG8_LDB(B1, 1, 1); PG8_STAGE(PG8_SB(1, 0), b3, voffB);
            PG8_BAR; PG8_WAIT_L(0); PG8_MMA(0, 1, At, B1); PG8_BAR;
            PG8_LDA(At, 1, 1); PG8_STAGE(PG8_SA(1, 0), a3, voffA);
            PG8_BAR; PG8_WAIT_L(0); PG8_MMA(1, 0, At, B0); PG8_BAR; PG8_SCHED;
            PG8_STAGE(PG8_SB(1, 1), b3 + hstepB, voffB);
            PG8_WAIT_V(6); PG8_BAR; PG8_MMA(1, 1, At, B1); PG8_BAR;
            }
        }
        if constexpr (ALIGN_EPI) { if (wr == 0) PG8_BAR; }
        if constexpr (!Epi::AFTER_DRAIN) { E(acc, cur, wr, wc, fr, fq); S.done(cur); }
        if (!has_next) break;
#pragma unroll
        for (int a = 0; a < 2; ++a)
#pragma unroll
            for (int b = 0; b < 2; ++b)
#pragma unroll
                for (int m = 0; m < 4; ++m)
#pragma unroll
                    for (int n = 0; n < 2; ++n) acc[a][b][m][n] = (f32x4){0.f, 0.f, 0.f, 0.f};
        cur = nxt; cA = nA; cB = nB; ++ui;
        if constexpr (ALIGN_EPI) { if (wr == 1) PG8_BAR; }
    }
    PG8_WAIT_V(0);
    if constexpr (!ALIGN_EPI) { if (wr == 0) PG8_BAR; }
    PG8_BAR;
    if constexpr (Epi::AFTER_DRAIN) { E.fused(acc, cur, wr, wc, fr, fq, lds, wid, lane); S.done(cur); }
#undef PG8_SA
#undef PG8_SB
#undef PG8_STAGE
#undef PG8_LDA
#undef PG8_LDB
#undef PG8_MMA
#undef PG8_WAIT_V
#undef PG8_WAIT_L
#undef PG8_BAR
#undef PG8_SCHED
}
}

#define KV_DECL uint4 rk0, rk1, rk2, rk3, rv0, rv1, rv2, rv3
#define KV_LOAD(kb_, dil_) do { const int kk_ = lane >> 3; \
    const bf16_t* p0_ = qkv + (rowb + min(max((kb_) + (dil_) * kk_, 0), S - 1)) * ld + (lane & 7) * 8; \
    const bf16_t* p1_ = qkv + (rowb + min(max((kb_) + (dil_) * (kk_ + 8), 0), S - 1)) * ld + (lane & 7) * 8; \
    const bf16_t* p2_ = qkv + (rowb + min(max((kb_) + (dil_) * (kk_ + 16), 0), S - 1)) * ld + (lane & 7) * 8; \
    const bf16_t* p3_ = qkv + (rowb + min(max((kb_) + (dil_) * (kk_ + 24), 0), S - 1)) * ld + (lane & 7) * 8; \
    rk0 = *(const uint4*)(p0_ + kcol); rk1 = *(const uint4*)(p1_ + kcol); rk2 = *(const uint4*)(p2_ + kcol); rk3 = *(const uint4*)(p3_ + kcol); \
    rv0 = *(const uint4*)(p0_ + vcol); rv1 = *(const uint4*)(p1_ + vcol); rv2 = *(const uint4*)(p2_ + vcol); rv3 = *(const uint4*)(p3_ + vcol); } while (0)
#define KV_STORE() do { char* wp_ = vl + (lane >> 3) * 144 + (lane & 7) * 16; \
    *(uint4*)(wp_) = rk0; *(uint4*)(wp_ + 8 * 144) = rk1; *(uint4*)(wp_ + 16 * 144) = rk2; *(uint4*)(wp_ + 24 * 144) = rk3; \
    *(uint4*)(wp_ + 4608) = rv0; *(uint4*)(wp_ + 4608 + 8 * 144) = rv1; *(uint4*)(wp_ + 4608 + 16 * 144) = rv2; *(uint4*)(wp_ + 4608 + 24 * 144) = rv3; } while (0)

DI bf16x8 v_frag(const char* vbase, int s, int dt) {
    typedef __attribute__((address_space(3))) v4i16_t* lp_t;
    const char* a = vbase + s * (16 * 144) + dt * 64;
    const s16x4 lo = __builtin_bit_cast(s16x4, __builtin_amdgcn_ds_read_tr16_b64_v4i16((lp_t)(a)));
    const s16x4 hi = __builtin_bit_cast(s16x4, __builtin_amdgcn_ds_read_tr16_b64_v4i16((lp_t)(a + 8 * 144)));
    return __builtin_shufflevector(lo, hi, 0, 1, 2, 3, 4, 5, 6, 7);
}

template <int OFF> DI bf16x8 pack8v(const f32x16& p) {
    typedef unsigned u32x4 __attribute__((ext_vector_type(4)));
    u32x4 w; w[0] = pk2(p[OFF + 0], p[OFF + 1]); w[1] = pk2(p[OFF + 2], p[OFF + 3]); w[2] = pk2(p[OFF + 4], p[OFF + 5]); w[3] = pk2(p[OFF + 6], p[OFF + 7]);
    return __builtin_bit_cast(bf16x8, w);
}

DI void win_attn_wave(bf16_t* qkv, int ld, int b, int qcol, int kcol, int vcol, int tq0, int qstride,
                      float slope2, float m_init, float l_init, int pat, char* vl, int lane, bool dry,
                      int nq = 32, float* st = nullptr, int tloc0 = 0, int tlstride = 0, int stage = 0) {
    const int r = lane & 31, h = lane >> 5;
    const size_t rowb = (size_t)b * S;
    const int tq = tq0 + qstride * r;
    bf16x8 qf[4];
    {
        const bf16_t* qp = qkv + (rowb + min(tq, S - 1)) * ld + qcol + h * 32;
#pragma unroll
        for (int ks = 0; ks < 4; ++ks) qf[ks] = *(const bf16x8*)(qp + ks * 8);
    }
    f32x16 o0, o1;
#pragma unroll
    for (int i = 0; i < 16; ++i) { o0[i] = 0.f; o1[i] = 0.f; }
    float m = m_init, l = (h == 0) ? l_init : 0.f;
    const float sc2 = 0.125f * LOG2E;
    const int i16 = lane & 15;
    const char* vbase = vl + 4608 + (4 * h + (i16 >> 2)) * 144 + (16 * ((lane >> 4) & 1) + 4 * (i16 & 3)) * 2;
    const char* kfp = vl + r * 144 + h * 64;
    KV_DECL;
    for (int pi = 0; pi < 1; ++pi) {
        int dil, W, kfirst; const int nt = 5;
        if (pat < 0) { dil = 1; W = 127; kfirst = tq0 - 128; }
        else if (pat == 0) { dil = 1; W = 128; kfirst = tq0 - 128; }
        else if (pat == 1) { dil = 4; W = 512; kfirst = tq0 - 512; }
        else { dil = 16; W = 2048; kfirst = tq0 - 2048; }
        const int step = 32 * dil;
        int t0 = 0;
        { const int need = -kfirst - 31 * dil; if (need > 0) t0 = (need + step - 1) / step; }
        if (t0 >= nt) continue;
        KV_LOAD(kfirst + t0 * step, dil);
        for (int tile = t0; tile < nt; ++tile) {
            const int kb = kfirst + tile * step;
            KV_STORE();
            asm volatile("" ::: "memory");
            if (tile + 1 < nt) KV_LOAD(kb + step, dil);
            f32x16 s = MFMA(*(const bf16x8*)(kfp), qf[0], f32x16{});
#pragma unroll
            for (int ks = 1; ks < 4; ++ks) s = MFMA(*(const bf16x8*)(kfp + ks * 16), qf[ks], s);
            f32x16 sv; float mloc = -INFINITY;
            const int d0 = tq - kb - 4 * h * dil;
            const float b0 = -slope2 * (float)d0, b1 = slope2 * (float)dil;
            if (tile >= 1 && tile <= 3 && kb >= 0) {
#pragma unroll
                for (int i = 0; i < 16; ++i) {
                    sv[i] = __builtin_fmaf(s[i], sc2, __builtin_fmaf(b1, (float)crow(i, 0), b0));
                    mloc = fmaxf(mloc, sv[i]);
                }
            } else {
                const unsigned wlim = (unsigned)min(W, tq);
#pragma unroll
                for (int i = 0; i < 16; ++i) {
                    const int diff = d0 - dil * crow(i, 0);
                    const float sb = __builtin_fmaf(s[i], sc2, __builtin_fmaf(b1, (float)crow(i, 0), b0));
                    sv[i] = ((unsigned)diff <= wlim) ? sb : -INFINITY;
                    mloc = fmaxf(mloc, sv[i]);
                }
            }
            mloc = fmaxf(mloc, __shfl_xor(mloc, 32));
            const float mn = fmaxf(m, mloc);
            if (__builtin_amdgcn_ballot_w64(mn > m + 8.f) != 0) {
                const float alpha = fexp2(m - mn);
                l *= alpha;
#pragma unroll
                for (int i = 0; i < 16; ++i) { o0[i] *= alpha; o1[i] *= alpha; }
                m = mn;
            }
            float ps = 0.f;
#pragma unroll
            for (int i = 0; i < 16; ++i) { sv[i] = fexp2(sv[i] - m); ps += sv[i]; }
            l += ps;
            const bf16x8 p0 = pack8v<0>(sv), p1 = pack8v<8>(sv);
            o0 = MFMA(v_frag(vbase, 0, 0), p0, o0);
            o0 = MFMA(v_frag(vbase, 1, 0), p1, o0);
            o1 = MFMA(v_frag(vbase, 0, 1), p0, o1);
            o1 = MFMA(v_frag(vbase, 1, 1), p1, o1);
            asm volatile("" ::: "memory");
        }
    }
    float lt = l + __shfl_xor(l, 32);
    if (st) {
        const bool act = r < nq;
        char* sp = (char*)st + (tloc0 + tlstride * r) * 144;
        if (act) {
            if (stage > 0) {
                const float ms = *(const float*)(sp + 128), ls = *(const float*)(sp + 132);
                const float mn = fmaxf(ms, m);
                const float as = fexp2(ms - mn), aw = fexp2(m - mn);
                lt = ls * as + lt * aw; m = mn;
#pragma unroll
                for (int g = 0; g < 4; ++g) {
                    const uint2 a = *(const uint2*)(sp + (8 * g + 4 * h) * 2), c = *(const uint2*)(sp + (32 + 8 * g + 4 * h) * 2);
                    o0[4 * g] = bflo(a.x) * as + o0[4 * g] * aw; o0[4 * g + 1] = bfhi(a.x) * as + o0[4 * g + 1] * aw; o0[4 * g + 2] = bflo(a.y) * as + o0[4 * g + 2] * aw; o0[4 * g + 3] = bfhi(a.y) * as + o0[4 * g + 3] * aw;
                    o1[4 * g] = bflo(c.x) * as + o1[4 * g] * aw; o1[4 * g + 1] = bfhi(c.x) * as + o1[4 * g + 1] * aw; o1[4 * g + 2] = bflo(c.y) * as + o1[4 * g + 2] * aw; o1[4 * g + 3] = bfhi(c.y) * as + o1[4 * g + 3] * aw;
                }
            }
            if (stage < 2) {
                if (h == 0) { *(float*)(sp + 128) = m; *(float*)(sp + 132) = lt; }
#pragma unroll
                for (int g = 0; g < 4; ++g) {
                    *(uint2*)(sp + (8 * g + 4 * h) * 2) = make_uint2(pk2(o0[4 * g], o0[4 * g + 1]), pk2(o0[4 * g + 2], o0[4 * g + 3]));
                    *(uint2*)(sp + (32 + 8 * g + 4 * h) * 2) = make_uint2(pk2(o1[4 * g], o1[4 * g + 1]), pk2(o1[4 * g + 2], o1[4 * g + 3]));
                }
            }
        }
        if (stage < 2 || !act) return;
    }
    const float inv = 1.f / lt;
    if (dry) { if (o0[0] + o1[0] + lt == 12345.678f) qkv[0] = 1; return; }
    bf16_t* op = qkv + (rowb + tq) * ld + qcol + 4 * h;
#pragma unroll
    for (int g = 0; g < 4; ++g) {
        *(uint2*)(op + 8 * g) = make_uint2(pk2(o0[4 * g] * inv, o0[4 * g + 1] * inv), pk2(o0[4 * g + 2] * inv, o0[4 * g + 3] * inv));
        *(uint2*)(op + 32 + 8 * g) = make_uint2(pk2(o1[4 * g] * inv, o1[4 * g + 1] * inv), pk2(o1[4 * g + 2] * inv, o1[4 * g + 3] * inv));
    }
}

DI void stick_wave(bf16_t* qkv, int ld, int b, int qcol, int kcol, int vcol, int qt, char* vl, int lane, bool dry) {
    const int r = lane & 31, h = lane >> 5;
    const size_t rowb = (size_t)b * S;
    const int tq = qt * 32 + r;
    bf16x8 qf[4];
    {
        const bf16_t* qp = qkv + (rowb + tq) * ld + qcol + h * 32;
#pragma unroll
        for (int ks = 0; ks < 4; ++ks) qf[ks] = *(const bf16x8*)(qp + ks * 8);
    }
    f32x16 o0, o1;
#pragma unroll
    for (int i = 0; i < 16; ++i) { o0[i] = 0.f; o1[i] = 0.f; }
    float R = 1.f;
    const int i16 = lane & 15;
    const char* vbase = vl + 4608 + (4 * h + (i16 >> 2)) * 144 + (16 * ((lane >> 4) & 1) + 4 * (i16 & 3)) * 2;
    const char* kfp = vl + r * 144 + h * 64;
    KV_DECL;
    KV_LOAD(qt * 32, 1);
    for (int tile = qt; tile >= 0; --tile) {
        KV_STORE();
        asm volatile("" ::: "memory");
        if (tile > 0) KV_LOAD((tile - 1) * 32, 1);
        f32x16 s = MFMA(*(const bf16x8*)(kfp), qf[0], f32x16{});
#pragma unroll
        for (int ks = 1; ks < 4; ++ks) s = MFMA(*(const bf16x8*)(kfp + ks * 16), qf[ks], s);
        const bool diag = (tile == qt);
        f32x16 sg, kp;
#pragma unroll
        for (int i = 0; i < 16; ++i) {
            const float z2 = fminf(s[i] * (0.125f * LOG2E), 80.f);
            const float t = fexp2(z2);
            const float k = __builtin_amdgcn_rcpf(1.f + t);
            kp[i] = k; sg[i] = t * k;
        }
        if (diag) {
#pragma unroll
            for (int i = 0; i < 16; ++i) { const bool strict = crow(i, h) < r; kp[i] = strict ? kp[i] : 1.f; sg[i] = strict ? sg[i] : 0.f; }
        }
        float G[4], PG[4], both[4];
#pragma unroll
        for (int g = 0; g < 4; ++g) { G[g] = (kp[4 * g] * kp[4 * g + 1]) * (kp[4 * g + 2] * kp[4 * g + 3]); PG[g] = __shfl_xor(G[g], 32); both[g] = G[g] * PG[g]; }
        float Sx[4];
        Sx[3] = 1.f; Sx[2] = both[3]; Sx[1] = both[3] * both[2]; Sx[0] = Sx[1] * both[1];
        f32x16 a;
#pragma unroll
        for (int g = 0; g < 4; ++g) {
            float la = R * Sx[g] * (h == 0 ? PG[g] : 1.f);
#pragma unroll
            for (int j = 3; j >= 0; --j) {
                a[4 * g + j] = sg[4 * g + j] * la;
                la *= kp[4 * g + j];
            }
        }
        R *= Sx[0] * both[0];
        const bf16x8 p0 = pack8v<0>(a), p1 = pack8v<8>(a);
        o0 = MFMA(v_frag(vbase, 0, 0), p0, o0);
        o0 = MFMA(v_frag(vbase, 1, 0), p1, o0);
        o1 = MFMA(v_frag(vbase, 0, 1), p0, o1);
        o1 = MFMA(v_frag(vbase, 1, 1), p1, o1);
        asm volatile("" ::: "memory");
        if (__builtin_amdgcn_ballot_w64(R >= 1.17549435e-38f) == 0) break;
    }
    if (dry) { if (o0[0] + o1[0] == 12345.678f) qkv[0] = 1; return; }
    bf16_t* op = qkv + (rowb + tq) * ld + qcol + 4 * h;
#pragma unroll
    for (int g = 0; g < 4; ++g) {
        *(uint2*)(op + 8 * g) = make_uint2(pk2(o0[4 * g], o0[4 * g + 1]), pk2(o0[4 * g + 2], o0[4 * g + 3]));
        *(uint2*)(op + 32 + 8 * g) = make_uint2(pk2(o1[4 * g], o1[4 * g + 1]), pk2(o1[4 * g + 2], o1[4 * g + 3]));
    }
}

DI void attn_even_phase(const Params& P, char* smem, bool dry) {
    const int tid_ = otid(); const int lane = tid_ & 63, wid = tid_ >> 6;
    bf16_t* qkv = (bf16_t*)(P.ws + OFF_BIG);
    char* vl = smem + wid * 9216;
    for (int it = blockIdx.x * 8 + wid; it < 2048 + 4096; it += gridDim.x * 8) {
        if (it < 2048) {
            const int bh = it >> 6, p = it & 63; const int b = bh >> 3, head = bh & 7;
            stick_wave(qkv, 2304, b, 512 + head * 64, 1280 + head * 64, 1792 + head * 64, 127 - p, vl, lane, dry);
            stick_wave(qkv, 2304, b, 512 + head * 64, 1280 + head * 64, 1792 + head * 64, p, vl, lane, dry);
        } else {
            const int v = it - 2048; const int g = v & 3; const int qt = (v >> 2) & 127; const int rest = v >> 9; const int b = rest >> 1, kvh = rest & 1;
            const int head = kvh * 4 + g;
            const float slope = exp2f(-(float)(head + 1));
            const float sink = P.in[9][head];
            win_attn_wave(qkv, 2304, b, head * 64, 1024 + kvh * 64, 1152 + kvh * 64, qt * 32, 1, slope * LOG2E, sink * LOG2E, 1.f, -1, vl, lane, dry);
        }
    }
}

DI void attn_odd_phase(const Params& P, char* smem, bool dry) {
    const int tid_ = otid(); const int lane = tid_ & 63, wid = tid_ >> 6;
    bf16_t* qkv = (bf16_t*)(P.ws + OFF_BIG);
    char* vl = smem + wid * 9216;
    float* st = (float*)(smem + 8 * 9216);
    for (int it = blockIdx.x; it < 512; it += gridDim.x) {
        const int span = it & 7, head = (it >> 3) & 15, b = it >> 7; const int t0 = span * 512;
        const float slope2 = exp2f(-0.5f * (float)(head + 1)) * LOG2E;
        const int qc = head * 64, kc = 1024 + head * 64, vc = 2048 + head * 64;
        __syncthreads();
#pragma unroll 1
        for (int k = 0; k < 2; ++k) {
            const int j = wid + 8 * k;
            win_attn_wave(qkv, 3072, b, qc, kc, vc, t0 + 32 * j, 1, slope2, -1e30f, 0.f, 0, vl, lane, dry, 32, st, 32 * j, 1, 0);
        }
        __syncthreads();
#pragma unroll 1
        for (int k = 0; k < 2; ++k) {
            const int j = wid + 8 * k; const int r4 = j >> 2, q = j & 3;
            win_attn_wave(qkv, 3072, b, qc, kc, vc, t0 + r4 + 128 * q, 4, slope2, -1e30f, 0.f, 1, vl, lane, dry, 32, st, r4 + 128 * q, 4, 1);
        }
        __syncthreads();
#pragma unroll 1
        for (int k = 0; k < 2; ++k) {
            const int r16 = wid + 8 * k;
            win_attn_wave(qkv, 3072, b, qc, kc, vc, t0 + r16, 16, slope2, -1e30f, 0.f, 2, vl, lane, dry, 32, st, r16, 16, 2);
        }
    }
}

DI void xattn_wave(bf16_t* qb, const bf16_t* Kn, const bf16_t* VT, const float* qg, float kmax2, int b, int head, int tok0, char* ql, int lane, bool dry) {
    const int r = lane & 31, h = lane >> 5;
    const size_t token = (size_t)b * S + tok0 + r;
    bf16_t* qp = qb + token * D + head * 256 + h * 128;
    float ss = 0.f;
#pragma unroll
    for (int ks = 0; ks < 16; ++ks) {
        const uint4 v = *(const uint4*)(qp + ks * 8);
        const unsigned w[4] = {v.x, v.y, v.z, v.w};
#pragma unroll
        for (int e = 0; e < 4; ++e) { const float a = bflo(w[e]), c = bfhi(w[e]); ss += a * a + c * c; }
    }
    ss += __shfl_xor(ss, 32);
    const float inv = __builtin_amdgcn_rsqf(ss * (1.f / 256.f) + EPS);
    float qq2 = 0.f;
#pragma unroll
    for (int ks = 0; ks < 16; ++ks) {
        const uint4 v = *(const uint4*)(qp + ks * 8);
        const float4 g0 = *(const float4*)(qg + h * 128 + ks * 8), g1 = *(const float4*)(qg + h * 128 + ks * 8 + 4);
        uint4 o;
        o.x = pk2(bflo(v.x) * inv * g0.x, bfhi(v.x) * inv * g0.y); o.y = pk2(bflo(v.y) * inv * g0.z, bfhi(v.y) * inv * g0.w);
        o.z = pk2(bflo(v.z) * inv * g1.x, bfhi(v.z) * inv * g1.y); o.w = pk2(bflo(v.w) * inv * g1.z, bfhi(v.w) * inv * g1.w);
        qq2 += bflo(o.x) * bflo(o.x) + bfhi(o.x) * bfhi(o.x) + bflo(o.y) * bflo(o.y) + bfhi(o.y) * bfhi(o.y)
             + bflo(o.z) * bflo(o.z) + bfhi(o.z) * bfhi(o.z) + bflo(o.w) * bflo(o.w) + bfhi(o.w) * bfhi(o.w);
        *(uint4*)(ql + (ks * 64 + lane) * 16) = o;
    }
    qq2 += __shfl_xor(qq2, 32);
    asm volatile("" ::: "memory");
    const float sc2 = 0.0625f * LOG2E;
    const bf16_t* kp0 = Kn + ((size_t)(b * 4 + head) * 8 * 16 * 64 + lane) * 8;
    const float m = __builtin_amdgcn_sqrtf(qq2 * kmax2) * 1.001f;
    float l = 0.f;
    bf16x8 pf[8][2];
    bf16x8 kc[16], kn[16];
#pragma unroll
    for (int ks = 0; ks < 16; ++ks) kc[ks] = *(const bf16x8*)(kp0 + ks * 512);
#pragma unroll
    for (int tile = 0; tile < 8; ++tile) {
        if (tile < 7) {
#pragma unroll
            for (int ks = 0; ks < 16; ++ks) kn[ks] = *(const bf16x8*)(kp0 + (size_t)(tile + 1) * 16 * 512 + ks * 512);
        }
        f32x16 s, s_b;
#pragma unroll
        for (int i = 0; i < 16; ++i) { s[i] = 0.f; s_b[i] = 0.f; }
#pragma unroll
        for (int ks = 0; ks < 16; ks += 2) {
            const bf16x8 qf0 = *(const bf16x8*)(ql + (ks * 64 + lane) * 16);
            const bf16x8 qf1 = *(const bf16x8*)(ql + ((ks + 1) * 64 + lane) * 16);
            s = MFMA(kc[ks], qf0, s);
            s_b = MFMA(kc[ks + 1], qf1, s_b);
        }
#pragma unroll
        for (int i = 0; i < 16; ++i) s[i] += s_b[i];
#pragma unroll
        for (int i = 0; i < 16; ++i) { s[i] = fexp2((s[i] - m) * sc2); l += s[i]; }
        pf[tile][0] = pack8v<0>(s); pf[tile][1] = pack8v<8>(s);
#pragma unroll
        for (int ks = 0; ks < 16; ++ks) kc[ks] = kn[ks];
    }
    l += __shfl_xor(l, 32);
    const float il = 1.f / l;
    bf16_t* op = qb + token * D + head * 256 + 4 * h;
    const bf16_t* vp0 = VT + (((size_t)(b * 4 + head) * 8 * 8 * 2 * 64) + lane) * 8;
    bf16x8 vc[16], vn[16];
#pragma unroll
    for (int e = 0; e < 16; ++e) vc[e] = *(const bf16x8*)(vp0 + e * 512);
#pragma unroll 1
    for (int dt = 0; dt < 8; ++dt) {
        const int dn = dt < 7 ? dt + 1 : 7;
#pragma unroll
        for (int e = 0; e < 16; ++e) vn[e] = *(const bf16x8*)(vp0 + (size_t)dn * 16 * 512 + e * 512);
        f32x16 o, o_b;
#pragma unroll
        for (int i = 0; i < 16; ++i) { o[i] = 0.f; o_b[i] = 0.f; }
#pragma unroll
        for (int tile = 0; tile < 8; ++tile) { o = MFMA(vc[tile * 2], pf[tile][0], o); o_b = MFMA(vc[tile * 2 + 1], pf[tile][1], o_b); }
#pragma unroll
        for (int i = 0; i < 16; ++i) o[i] += o_b[i];
#pragma unroll
        for (int g = 0; g < 4; ++g)
            if (dry) { if (o[4 * g] == 12345.678f) qb[0] = 1; } else *(uint2*)(op + dt * 32 + 8 * g) = make_uint2(pk2(o[4 * g] * il, o[4 * g + 1] * il), pk2(o[4 * g + 2] * il, o[4 * g + 3] * il));
#pragma unroll
        for (int e = 0; e < 16; ++e) vc[e] = vn[e];
    }
}

DI void xattn_block(bf16_t* qb, const bf16_t* KF, const bf16_t* VF, const float* qg, float kmax2, int b, int head, int qblk, char* smem, int lane, int wid) {
    const int r = lane & 31, h = lane >> 5;
    const size_t token = (size_t)b * S + qblk * 256 + wid * 32 + r;
    bf16_t* qp = qb + token * D + head * 256 + h * 128;
    const bf16_t* kbase = KF + (size_t)(b * 4 + head) * 8 * 8192;
    const bf16_t* vbase = VF + (size_t)(b * 4 + head) * 8 * 8192;
    const int pc0 = (2 * wid) * 512 + lane * 8, pc1 = pc0 + 512;
    char* ld0 = smem + (2 * wid) * 1024 + lane * 16;
#define XA_ISSUE(u_) do { const int u__ = (u_); const bf16_t* src_ = (u__ < 8) ? kbase + (size_t)u__ * 8192 : vbase + (size_t)(u__ - 8) * 8192; \
        char* dst_ = ld0 + (u__ & 3) * 16384; glds16(src_ + pc0, dst_); glds16(src_ + pc1, dst_ + 1024); } while (0)
    __syncthreads();
    XA_ISSUE(0); XA_ISSUE(1); XA_ISSUE(2);
    uint4 qraw[16];
    float ss = 0.f;
#pragma unroll
    for (int ks = 0; ks < 16; ++ks) {
        qraw[ks] = *(const uint4*)(qp + ks * 8);
        const uint4 v = qraw[ks];
        ss += bflo(v.x) * bflo(v.x) + bfhi(v.x) * bfhi(v.x) + bflo(v.y) * bflo(v.y) + bfhi(v.y) * bfhi(v.y)
            + bflo(v.z) * bflo(v.z) + bfhi(v.z) * bfhi(v.z) + bflo(v.w) * bflo(v.w) + bfhi(v.w) * bfhi(v.w);
    }
    ss += __shfl_xor(ss, 32);
    const float inv = __builtin_amdgcn_rsqf(ss * (1.f / 256.f) + EPS);
    float qq2 = 0.f;
    bf16x8 qf[16];
#pragma unroll
    for (int ks = 0; ks < 16; ++ks) {
        const uint4 v = qraw[ks];
        const float4 g0 = *(const float4*)(qg + h * 128 + ks * 8), g1 = *(const float4*)(qg + h * 128 + ks * 8 + 4);
        uint4 o;
        o.x = pk2(bflo(v.x) * inv * g0.x, bfhi(v.x) * inv * g0.y); o.y = pk2(bflo(v.y) * inv * g0.z, bfhi(v.y) * inv * g0.w);
        o.z = pk2(bflo(v.z) * inv * g1.x, bfhi(v.z) * inv * g1.y); o.w = pk2(bflo(v.w) * inv * g1.z, bfhi(v.w) * inv * g1.w);
        qq2 += bflo(o.x) * bflo(o.x) + bfhi(o.x) * bfhi(o.x) + bflo(o.y) * bflo(o.y) + bfhi(o.y) * bfhi(o.y)
             + bflo(o.z) * bflo(o.z) + bfhi(o.z) * bfhi(o.z) + bflo(o.w) * bflo(o.w) + bfhi(o.w) * bfhi(o.w);
        qf[ks] = __builtin_bit_cast(bf16x8, o);
    }
    qq2 += __shfl_xor(qq2, 32);
    const float sc2 = 0.0625f * LOG2E;
    const float m = __builtin_amdgcn_sqrtf(qq2 * kmax2) * 1.001f;
    float l = 0.f;
    bf16x8 pf[8][2];
    const char* fr0 = smem + lane * 16;
#pragma unroll
    for (int u = 0; u < 8; ++u) {
        asm volatile("s_waitcnt vmcnt(4)" ::: "memory");
        __builtin_amdgcn_s_barrier();
        XA_ISSUE(u + 3);
        const char* sl = fr0 + (u & 3) * 16384;
        f32x16 s, s_b;
#pragma unroll
        for (int i = 0; i < 16; ++i) { s[i] = 0.f; s_b[i] = 0.f; }
#pragma unroll
        for (int ks = 0; ks < 16; ks += 2) {
            s = MFMA(*(const bf16x8*)(sl + ks * 1024), qf[ks], s);
            s_b = MFMA(*(const bf16x8*)(sl + (ks + 1) * 1024), qf[ks + 1], s_b);
        }
#pragma unroll
        for (int i = 0; i < 16; ++i) { s[i] = fexp2((s[i] + s_b[i] - m) * sc2); l += s[i]; }
        pf[u][0] = pack8v<0>(s); pf[u][1] = pack8v<8>(s);
    }
    l += __shfl_xor(l, 32);
    const float il = 1.f / l;
    bf16_t* op = qb + token * D + head * 256 + 4 * h;
#pragma unroll 1
    for (int dt = 0; dt < 8; ++dt) {
        if (dt < 6) asm volatile("s_waitcnt vmcnt(4)" ::: "memory");
        else if (dt == 6) asm volatile("s_waitcnt vmcnt(2)" ::: "memory");
        else asm volatile("s_waitcnt vmcnt(0)" ::: "memory");
        __builtin_amdgcn_s_barrier();
        if (dt < 5) XA_ISSUE(dt + 11);
        const char* sl = fr0 + (dt & 3) * 16384;
        f32x16 o, o_b;
#pragma unroll
        for (int i = 0; i < 16; ++i) { o[i] = 0.f; o_b[i] = 0.f; }
#pragma unroll
        for (int tile = 0; tile < 8; ++tile) {
            o = MFMA(*(const bf16x8*)(sl + (tile * 2) * 1024), pf[tile][0], o);
            o_b = MFMA(*(const bf16x8*)(sl + (tile * 2 + 1) * 1024), pf[tile][1], o_b);
        }
#pragma unroll
        for (int g = 0; g < 4; ++g)
            *(uint2*)(op + dt * 32 + 8 * g) = make_uint2(pk2((o[4 * g] + o_b[4 * g]) * il, (o[4 * g + 1] + o_b[4 * g + 1]) * il),
                                                        pk2((o[4 * g + 2] + o_b[4 * g + 2]) * il, (o[4 * g + 3] + o_b[4 * g + 3]) * il));
    }
#undef XA_ISSUE
}

DI void xattn_phase(const Params& P, int l, char* smem, bool dry) {
    const int tid_ = otid(); const int lane = tid_ & 63, wid = tid_ >> 6;
    bf16_t* qb = (bf16_t*)(P.ws + OFF_BIG);
    const bf16_t* KF = (const bf16_t*)(P.ws + OFF_KF + (size_t)l * SZ_MM);
    const bf16_t* VF = (const bf16_t*)(P.ws + OFF_VT + (size_t)l * SZ_MM);
    const float* qg = P.in[19] + l * 256;
    (void)dry;
    for (int it = blockIdx.x; it < 256; it += gridDim.x) {
        const int qblk = it & 15, head = (it >> 4) & 3, b = it >> 6;
        const float kmax2 = ((const float*)(P.ws + OFF_KMAX))[l * 16 + b * 4 + head];
        xattn_block(qb, KF, VF, qg, kmax2, b, head, qblk, smem, lane, wid);
    }
}

DI void knorm_phase(const Params& P) {
    const int tid_ = otid(); const int lane = tid_ & 63, wid = tid_ >> 6;
    for (int u = blockIdx.x * 8 + wid; u < 8192; u += gridDim.x * 8) {
        const int l = u >> 12, row = (u >> 2) & 1023, head = u & 3;
        const bf16_t* kp = (const bf16_t*)(P.ws + OFF_KN + (size_t)l * SZ_MM) + (size_t)row * D + head * 256 + lane * 4;
        const uint2 v = *(const uint2*)kp;
        const float a0 = bflo(v.x), a1 = bfhi(v.x), a2 = bflo(v.y), a3 = bfhi(v.y);
        float ss = a0 * a0 + a1 * a1 + a2 * a2 + a3 * a3;
        ss = wave_sum(ss);
        const float inv = __builtin_amdgcn_rsqf(ss * (1.f / 256.f) + EPS);
        const float4 g = *(const float4*)(P.in[20] + l * 256 + lane * 4);
        const int b = row >> 8, key = row & 255;
        const int h = lane >> 5, ks = (lane & 31) >> 1, j0 = (lane & 1) * 4;
        bf16_t* dp = (bf16_t*)(P.ws + OFF_KF + (size_t)l * SZ_MM) + ((((((size_t)(b * 4 + head) * 8 + (key >> 5)) * 16 + ks) * 64) + h * 32 + (key & 31)) << 3) + j0;
        const unsigned w0_ = pk2(a0 * inv * g.x, a1 * inv * g.y), w1_ = pk2(a2 * inv * g.z, a3 * inv * g.w);
        *(uint2*)dp = make_uint2(w0_, w1_);
        float kk2 = bflo(w0_) * bflo(w0_) + bfhi(w0_) * bfhi(w0_) + bflo(w1_) * bflo(w1_) + bfhi(w1_) * bfhi(w1_);
        kk2 = wave_sum(kk2);
        if (lane == 0) atomicMax((unsigned*)(P.ws + OFF_KMAX) + l * 16 + b * 4 + head, __float_as_uint(kk2));
    }
}

#define XB_TMO      128
#define XB_XCNT(j)  (256  + 64 * (j))
#define XB_XSUB(j)  (1280 + 64 * (j))
#define XB_XGEN(j)  (2304 + 64 * (j))
#define XB_TOP      3328
#define XB_TOPGEN   3392
#define XCD_BAR_WORDS 3456
#define XB_SPIN_CAP (1u << 18)
#define XB_LAS __attribute__((address_space(3)))

__device__ __forceinline__ unsigned xb_ld(unsigned* p)              { return __hip_atomic_load(p, __ATOMIC_RELAXED, __HIP_MEMORY_SCOPE_AGENT); }
__device__ __forceinline__ unsigned xb_add(unsigned* p, unsigned v) { return __hip_atomic_fetch_add(p, v, __ATOMIC_RELAXED, __HIP_MEMORY_SCOPE_AGENT); }
__device__ __forceinline__ unsigned xb_xcc_id() { return (unsigned)__builtin_amdgcn_s_getreg((3 << 11) | 20) & 0xFu; }
#define XB_SPIN(cond, bar) do { unsigned _sp = 0; while (cond) { __builtin_amdgcn_s_sleep(1); \
    if ((++_sp & 255u) == 0u) { if (xb_ld(&(bar)[XB_TMO])) break; if (_sp > XB_SPIN_CAP) { atomicAdd(&(bar)[XB_TMO], 1u); break; } } } } while (0)

struct XcdBarrier {
    unsigned* bar; unsigned x;
    volatile XB_LAS unsigned* st;
};

__device__ __forceinline__ XcdBarrier xcd_barrier_post(unsigned* bar, volatile XB_LAS unsigned* st) {
    XcdBarrier b; b.bar = bar; b.x = xb_xcc_id(); b.st = st;
    if (threadIdx.x == 0) (void)xb_add(&bar[XB_XCNT(b.x)], 1u);
    return b;
}
__device__ __forceinline__ void xcd_barrier_complete(unsigned* bar, unsigned x, unsigned& nloc, unsigned& nx) {
    const unsigned G = gridDim.x * gridDim.y * gridDim.z;
    unsigned sum, cnt, mine, sp = 0u;
    for (;;) {
        sum = 0u; cnt = 0u; mine = 0u;
#pragma unroll
        for (unsigned j = 0; j < 16; ++j) { const unsigned c = xb_ld(&bar[XB_XCNT(j)]); sum += c; cnt += (c > 0u) ? 1u : 0u; mine = (j == x) ? c : mine; }
        if (sum == G) break;
        __builtin_amdgcn_s_sleep(1);
        if ((++sp & 255u) == 0u) { if (xb_ld(&bar[XB_TMO])) break; if (sp > XB_SPIN_CAP) { atomicAdd(&bar[XB_TMO], 1u); break; } }
    }
    nloc = mine > 0u ? mine : 1u; nx = cnt > 0u ? cnt : 1u;
}

__device__ __forceinline__ void xcd_barrier(const XcdBarrier& b) {
    asm volatile("s_waitcnt vmcnt(0)" ::: "memory");
    __syncthreads();
    if (threadIdx.x == 0) {
        unsigned* bar = b.bar;
        __builtin_amdgcn_s_waitcnt(0);
        unsigned nloc = b.st[0], nx = b.st[1];
        if (nloc == 0u) { xcd_barrier_complete(bar, b.x, nloc, nx); b.st[0] = nloc; b.st[1] = nx; }
        const unsigned old = xb_add(&bar[XB_XSUB(b.x)], 1u);
        const unsigned gen = old / nloc;
        if (old + 1u == (gen + 1u) * nloc) {
            __builtin_amdgcn_fence(__ATOMIC_RELEASE, "agent");
            asm volatile("s_waitcnt vmcnt(0)" ::: "memory");
            const unsigned og = xb_add(&bar[XB_TOP], 1u);
            const unsigned tg = og / nx;
            if (og + 1u == (tg + 1u) * nx) xb_add(&bar[XB_TOPGEN], 1u);
            else XB_SPIN(xb_ld(&bar[XB_TOPGEN]) == tg, bar);
            __builtin_amdgcn_fence(__ATOMIC_ACQUIRE, "agent");
            xb_add(&bar[XB_XGEN(b.x)], 1u);
            asm volatile("s_waitcnt vmcnt(0)" ::: "memory");
        } else {
            XB_SPIN(xb_ld(&bar[XB_XGEN(b.x)]) == gen, bar);
            __builtin_amdgcn_fence(__ATOMIC_ACQUIRE, "agent");
            asm volatile("s_waitcnt vmcnt(0)" ::: "memory");
        }
    }
    __syncthreads();
}


DI void fast_grid_sync(unsigned* bar, unsigned target) {
    asm volatile("s_waitcnt vmcnt(0) lgkmcnt(0)" ::: "memory");
    __syncthreads();
    if (threadIdx.x == 0) {
        __builtin_amdgcn_fence(__ATOMIC_RELEASE, "agent");
        asm volatile("s_waitcnt vmcnt(0)" ::: "memory");
        __hip_atomic_fetch_add(bar, 1u, __ATOMIC_RELAXED, __HIP_MEMORY_SCOPE_AGENT);
        while (__hip_atomic_load(bar, __ATOMIC_RELAXED, __HIP_MEMORY_SCOPE_AGENT) < target) __builtin_amdgcn_s_sleep(2);
        __builtin_amdgcn_fence(__ATOMIC_ACQUIRE, "agent");
        asm volatile("s_waitcnt vmcnt(0)" ::: "memory");
    }
    __syncthreads();
}

__global__ void __launch_bounds__(512) fwd_megakernel(Params P) {
    extern __shared__ __attribute__((aligned(16))) char smem[];
    cg::grid_group grid = cg::this_grid();
    unsigned nbar = 0; (void)nbar;
    volatile XB_LAS unsigned* xst = (volatile XB_LAS unsigned*)(smem + LDS_BYTES - 16);
    if (threadIdx.x == 0) { xst[0] = 0u; xst[1] = 0u; }
    __syncthreads();
    const XcdBarrier xbar = xcd_barrier_post((unsigned*)(P.ws + OFF_BAR), xst);
#pragma unroll 1
    for (int ph = 0; ph < 21; ++ph) {
        float* ssq = (float*)(P.ws + OFF_SSQ);
        bf16_t* xb = (bf16_t*)(P.ws + OFF_XB);
        bf16_t* big = (bf16_t*)(P.ws + OFF_BIG);
        int nrep = 1;
        if (ph > 0) { const int s_ = (ph - 1) % 10; const int kind = (s_ == 3) ? 2 : (s_ == 6) ? 4 : 1; if (PROBE_MASK & kind) nrep = 2; }
        for (int rep = 0; rep < nrep; ++rep) {
        const bool dry = rep + 1 < nrep;
        if (ph == 0) {
            phase0(P, smem);
        } else {
            const int l = (ph - 1) / 10, s = (ph - 1) % 10;
            if (s == 3) {
                if (l == 0) attn_even_phase(P, smem, dry); else attn_odd_phase(P, smem, dry);
            } else if (s == 6) {
            } else {
                pg8::Gemm g; pg8::Epi E;
                g.A = xb; g.lda = D; g.K = D; g.M = T; g.N = D; g.Bt = nullptr;
                E.mode = 1; E.rs = nullptr; E.O = big; E.ldo = D; E.xin = nullptr; E.xout = nullptr; E.xb = xb; E.ssq_out = ssq; E.alpha = 1.f;
                E.qg = nullptr; E.kg = nullptr; E.qn_end = 0; E.kn_beg = 0; E.kn_end = 0;
                if (s == 0 || s == 8) {
                    g.Bt = (const bf16_t*)(P.ws + (s == 0 ? OFF_GU1 : OFF_GU2) + (size_t)l * SZ_GU); g.N = NGU;
                    E.mode = 0; E.rs = ssq + (size_t)(4 * l + (s == 0 ? 0 : 3)) * T; E.ldo = DFF;
                } else if (s == 1 || s == 9) {
                    g.A = big; g.lda = DFF; g.K = DFF;
                    g.Bt = (const bf16_t*)(P.ws + (s == 1 ? OFF_DN1 : OFF_DN2) + (size_t)l * SZ_DN);
                    E.alpha = 0.5f; E.ssq_out = ssq + (size_t)(4 * l + (s == 1 ? 1 : 4)) * T;
                    if (ph == 2) E.xin = P.in[0];
                    if (ph == 20) { E.xout = P.out; E.ssq_out = nullptr; }
                } else if (s == 2) {
                    E.mode = 2; E.rs = ssq + (size_t)(4 * l + 1) * T;
                    if (l == 0) { g.Bt = (const bf16_t*)(P.ws + OFF_EVIN); g.N = 2304; E.ldo = 2304; E.qg = P.in[7]; E.kg = P.in[8]; E.qn_end = 512; E.kn_beg = 1024; E.kn_end = 1152; }
                    else { g.Bt = (const bf16_t*)(P.ws + OFF_ODIN); g.N = 3072; E.ldo = 3072; E.qg = P.in[12]; E.kg = P.in[13]; E.qn_end = 1024; E.kn_beg = 1024; E.kn_end = 2048; }
                } else if (s == 4) {
                    g.A = big;
                    if (l == 0) { g.Bt = (const bf16_t*)(P.ws + OFF_EVOUT); g.lda = 2304; }
                    else { g.Bt = (const bf16_t*)(P.ws + OFF_ODOUT); g.lda = 3072; }
                    E.ssq_out = ssq + (size_t)(4 * l + 2) * T;
                } else if (s == 5) {
                    g.Bt = (const bf16_t*)(P.ws + OFF_WQ + (size_t)l * SZ_MM); E.mode = 2; E.rs = ssq + (size_t)(4 * l + 2) * T; E.ldo = D;
                } else {
                    g.A = big; g.Bt = (const bf16_t*)(P.ws + OFF_WO + (size_t)l * SZ_MM); E.ssq_out = ssq + (size_t)(4 * l + 3) * T;
                }
                pg8::StaticOrder So; So.init(T, g.N, (int)gridDim.x, (int)blockIdx.x);
                E.dryrun = 0;
#if PROBE_GEMM
                for (int rep_ = 0; rep_ < 2; ++rep_) {
                pg8::Epi E2 = E;
                if (rep_ == 0) { if (PROBE_GEMM == 1) E2.dryrun = 1; else if (E.mode == 1) { E2.alpha = 0.f; } }
                __syncthreads();
                pg8::gemm_phase<pg8::Epi, pg8::StaticOrder, true, true>((PG8_LAS unsigned char*)smem, g, So, rep_ == 0 ? E2 : E);
                ++nbar; fast_grid_sync((unsigned*)(P.ws + OFF_BAR), nbar * gridDim.x);
                }
#else
                __syncthreads();
                pg8::gemm_phase<pg8::Epi, pg8::StaticOrder, true, true>((PG8_LAS unsigned char*)smem, g, So, E);
#endif
                if (ph == 1) {
                    GJob J;
                    J.A = xb; J.lda = D; J.ksplit = 1 << 30; J.kextra = 0; J.K = D; J.ntm = 4; J.mode = 3; J.rs = nullptr;
                    J.O = big; J.ldo = D; J.xin = P.out; J.xout = P.out; J.xb = xb; J.ssq_out = ssq; J.alpha = 1.f;
                    J.qg = nullptr; J.kg = nullptr; J.qn_end = 0; J.kn_end = 0; J.vt = nullptr; J.W = nullptr; J.ntn = 8;
                    gemm_phase(J, 0, 64, P, smem, false);
                }
                if (ph == 2 && !dry) knorm_phase(P);
                if (s == 5) {
                    asm volatile("s_waitcnt vmcnt(0)" ::: "memory");
                    __syncthreads();
                    const int tid_ = otid(); const int lane = tid_ & 63, wid = tid_ >> 6;
                    const bf16_t* KF = (const bf16_t*)(P.ws + OFF_KF + (size_t)l * SZ_MM);
                    const bf16_t* VF = (const bf16_t*)(P.ws + OFF_VT + (size_t)l * SZ_MM);
                    pg8::Unit uu;
                    for (int i = 0; So.next(i, uu); ++i) {
                        const int b = uu.pm >> 4, qblk = uu.pm & 15, head = uu.pn;
                        const float kmax2 = ((const float*)(P.ws + OFF_KMAX))[l * 16 + b * 4 + head];
                        xattn_block(big, KF, VF, P.in[19] + l * 256, kmax2, b, head, qblk, smem, lane, wid);
                    }
                }
            }
        }
        if (P.ws == nullptr) grid.sync();
        if (ph < 20 && !(ph > 0 && (ph - 1) % 10 == 6)) xcd_barrier(xbar);
        }
    }
}

extern "C" void kernel_launch(void* const* d_in, const int* in_sizes, int n_in, void* d_out, int out_size, void* d_ws, size_t ws_size,
                              hipStream_t stream) {
    static int grid_blocks = 0;
    if (!grid_blocks) {
        int dev = 0, cus = 0, per_cu = 0;
        hipGetDevice(&dev);
        hipDeviceGetAttribute(&cus, hipDeviceAttributeMultiprocessorCount, dev);
        hipFuncSetAttribute((const void*)fwd_megakernel, hipFuncAttributeMaxDynamicSharedMemorySize, LDS_BYTES);
        hipOccupancyMaxActiveBlocksPerMultiprocessor(&per_cu, fwd_megakernel, NTHR, LDS_BYTES);
        if (per_cu < 1) per_cu = 1;
        if (per_cu > 1) per_cu = 1;
        grid_blocks = cus * per_cu;
    }
    if (ws_size < WS_NEED) { fprintf(stderr, "workspace too small: %zu < %zu\n", ws_size, (size_t)WS_NEED); return; }
    Params p{};
    for (int i = 0; i < 25; ++i) p.in[i] = (const float*)d_in[i];
    p.out = (float*)d_out; p.ws = (char*)d_ws;
    hipMemsetAsync((char*)d_ws + OFF_BAR, 0, 16384, stream);
    void* args[] = {&p};
    hipError_t e = hipLaunchCooperativeKernel((void*)fwd_megakernel, dim3(grid_blocks), dim3(NTHR), args, LDS_BYTES, stream);
    if (e != hipSuccess) fprintf(stderr, "cooperative launch failed: %s (grid %d)\n", hipGetErrorString(e), grid_blocks);
}
```

```cpp
#include <hip/hip_runtime.h>
#include <hip/hip_cooperative_groups.h>
#include <cstdio>
#include <cstdint>
namespace cg = cooperative_groups;

#define DI __device__ __forceinline__
typedef unsigned short bf16_t;
typedef short bf16x8 __attribute__((ext_vector_type(8)));
typedef short s16x4 __attribute__((ext_vector_type(4)));
typedef float f32x16 __attribute__((ext_vector_type(16)));
typedef __bf16 bf2_t __attribute__((ext_vector_type(2)));
typedef float f2_t __attribute__((ext_vector_type(2)));
typedef short v4i16_t __attribute__((ext_vector_type(4)));
#define MFMA(a, b, c) __builtin_amdgcn_mfma_f32_32x32x16_bf16((a), (b), (c), 0, 0, 0)

constexpr int T = 16384, S = 4096, D = 1024, DFF = 2816, NGU = 5632;
constexpr float EPS = 1e-6f;
constexpr float LOG2E = 1.4426950408889634f;
constexpr float LN2 = 0.6931471805599453f;

constexpr size_t SZ_GU = (size_t)NGU * D * 2, SZ_DN = (size_t)D * DFF * 2, SZ_MM = (size_t)D * D * 2;
constexpr size_t OFF_GU1 = 0;
constexpr size_t OFF_DN1 = OFF_GU1 + 2 * SZ_GU;
constexpr size_t OFF_GU2 = OFF_DN1 + 2 * SZ_DN;
constexpr size_t OFF_DN2 = OFF_GU2 + 2 * SZ_GU;
constexpr size_t OFF_WQ = OFF_DN2 + 2 * SZ_DN;
constexpr size_t OFF_WKV = OFF_WQ + 2 * SZ_MM;
constexpr size_t OFF_WO = OFF_WKV + 4 * SZ_MM;
constexpr size_t OFF_EVIN = OFF_WO + 2 * SZ_MM;
constexpr size_t OFF_EVOUT = OFF_EVIN + (size_t)2304 * D * 2;
constexpr size_t OFF_ODIN = OFF_EVOUT + SZ_MM;
constexpr size_t OFF_ODOUT = OFF_ODIN + (size_t)3072 * D * 2;
constexpr size_t OFF_XB = OFF_ODOUT + SZ_MM;
constexpr size_t OFF_BIG = OFF_XB + (size_t)T * D * 2;
constexpr size_t OFF_MEMB = OFF_BIG + (size_t)T * 3072 * 2;
constexpr size_t OFF_KN = OFF_MEMB + SZ_MM;
constexpr size_t OFF_VT = OFF_KN + 2 * SZ_MM;
constexpr size_t OFF_SSQ = OFF_VT + 2 * SZ_MM;
constexpr size_t OFF_SSQM = OFF_SSQ + (size_t)9 * T * 4;
constexpr size_t OFF_KMAX = OFF_SSQM + 4096;
constexpr size_t OFF_BAR = OFF_KMAX + 256;
constexpr size_t OFF_KF = OFF_BAR + 16384;
constexpr size_t WS_NEED = OFF_KF + 2 * SZ_MM;

#ifndef PROBE_MASK
#define PROBE_MASK 0
#endif
#ifndef PROBE_GEMM
#define PROBE_GEMM 0
#endif
constexpr int NTHR = 512;
constexpr int NST = 4;
constexpr int STAGE_B = 32768;
constexpr int OPB = 16384;
constexpr int LDS_BYTES = 147712;

struct Params { const float* in[25]; float* out; char* ws; };

DI unsigned pk2(float a, float b) { f2_t v = {a, b}; bf2_t r = __builtin_convertvector(v, bf2_t); return __builtin_bit_cast(unsigned, r); }
typedef unsigned v4u_t __attribute__((ext_vector_type(4)));
DI __amdgpu_buffer_rsrc_t wt_rsrc(const void* base, size_t bytes) { return __builtin_amdgcn_make_buffer_rsrc((void*)base, (short)0, (int)bytes, 0x00020000); }
DI void st16_wt(__amdgpu_buffer_rsrc_t r, size_t byteoff, uint4 v) { const v4u_t x = {v.x, v.y, v.z, v.w}; __builtin_amdgcn_raw_buffer_store_b128(x, r, (unsigned)byteoff, 0, 16); }
DI void st16f_wt(__amdgpu_buffer_rsrc_t r, size_t byteoff, float4 v) { const v4u_t x = {__float_as_uint(v.x), __float_as_uint(v.y), __float_as_uint(v.z), __float_as_uint(v.w)}; __builtin_amdgcn_raw_buffer_store_b128(x, r, (unsigned)byteoff, 0, 16); }
DI float bflo(unsigned w) { return __uint_as_float(w << 16); }
DI float bfhi(unsigned w) { return __uint_as_float(w & 0xffff0000u); }
DI int otid() { int t = threadIdx.x; asm volatile("" : "+v"(t)); return t; }
DI int crow(int i, int h) { return (i & 3) + 8 * (i >> 2) + 4 * h; }
DI float fexp2(float x) { return __builtin_amdgcn_exp2f(x); }
DI float flog2(float x) { return __builtin_amdgcn_logf(x); }

struct WJob { const float* src; bf16_t* dst; const float* gain; int K, N, gu; };

DI int wjob_tiles(int j) {
    if (j < 14) {
        const int kind = j >> 1;
        switch (kind) {
            case 0: case 2: return 16 * 88;
            case 1: case 3: return 44 * 16;
            case 4: return 256;
            case 5: return 512;
            default: return 256;
        }
    }
    if (j == 14) return 16 * 36;
    if (j == 16) return 16 * 48;
    return 256;
}

DI WJob get_wjob(const Params& P, int j) {
    WJob w; w.gain = nullptr; w.gu = 0;
    bf16_t* wsb = (bf16_t*)P.ws;
    if (j < 14) {
        const int kind = j >> 1, l = j & 1;
        switch (kind) {
            case 0: w.src = P.in[3] + (size_t)l * D * NGU; w.dst = (bf16_t*)(P.ws + OFF_GU1 + l * SZ_GU); w.gain = P.in[2] + l * D; w.K = D; w.N = NGU; w.gu = 1; break;
            case 1: w.src = P.in[4] + (size_t)l * DFF * D; w.dst = (bf16_t*)(P.ws + OFF_DN1 + l * SZ_DN); w.K = DFF; w.N = D; w.gu = 2; break;
            case 2: w.src = P.in[23] + (size_t)l * D * NGU; w.dst = (bf16_t*)(P.ws + OFF_GU2 + l * SZ_GU); w.gain = P.in[22] + l * D; w.K = D; w.N = NGU; w.gu = 1; break;
            case 3: w.src = P.in[24] + (size_t)l * DFF * D; w.dst = (bf16_t*)(P.ws + OFF_DN2 + l * SZ_DN); w.K = DFF; w.N = D; w.gu = 2; break;
            case 4: w.src = P.in[17] + (size_t)l * D * D; w.dst = (bf16_t*)(P.ws + OFF_WQ + l * SZ_MM); w.gain = P.in[15] + l * D; w.K = D; w.N = D; w.gu = 2; break;
            case 5: w.src = P.in[18] + (size_t)l * D * 2048; w.dst = (bf16_t*)(P.ws + OFF_WKV + l * 2 * SZ_MM); w.gain = P.in[16] + l * D; w.K = D; w.N = 2048; break;
            default: w.src = P.in[21] + (size_t)l * D * D; w.dst = (bf16_t*)(P.ws + OFF_WO + l * SZ_MM); w.K = D; w.N = D; w.gu = 2; break;
        }
    } else if (j == 14) { w.src = P.in[6]; w.dst = (bf16_t*)(P.ws + OFF_EVIN); w.gain = P.in[5]; w.K = D; w.N = 2304; w.gu = 3; }
    else if (j == 15) { w.src = P.in[10]; w.dst = (bf16_t*)(P.ws + OFF_EVOUT); w.K = D; w.N = D; w.gu = 2; }
    else if (j == 16) { w.src = P.in[11]; w.dst = (bf16_t*)(P.ws + OFF_ODIN); w.gain = P.in[5] + D; w.K = D; w.N = 3072; w.gu = 2; }
    else { w.src = P.in[14]; w.dst = (bf16_t*)(P.ws + OFF_ODOUT); w.K = D; w.N = D; w.gu = 2; }
    (void)wsb;
    return w;
}

DI void wconv_tile(const WJob& w, int t, float* sm, int tid, bool act) {
    const int ntn = w.N >> 6; const int tk = t / ntn, tn = t - tk * ntn;
    if (act) {
#pragma unroll
        for (int p = 0; p < 4; ++p) {
            const int kr = p * 16 + (tid >> 4);
            typedef float f32x4nt __attribute__((ext_vector_type(4)));
            const f32x4nt v = __builtin_nontemporal_load((const f32x4nt*)(w.src + (size_t)(tk * 64 + kr) * w.N + tn * 64 + (tid & 15) * 4));
            const float g = w.gain ? w.gain[tk * 64 + kr] : 1.f;
            float* sp = sm + kr * 65 + (tid & 15) * 4;
            sp[0] = v[0] * g; sp[1] = v[1] * g; sp[2] = v[2] * g; sp[3] = v[3] * g;
        }
    }
    __syncthreads();
    if (act) {
        const int n = tid >> 2, kq = tid & 3; const int ng = tn * 64 + n;
        int drow = ng;
        if (w.gu == 1) drow = ng < DFF ? ((ng >> 7) * 256 + (ng & 127)) : (((ng - DFF) >> 7) * 256 + 128 + ((ng - DFF) & 127));
        else if (w.gu >= 2) {
            int a = ng;
            if (w.gu == 3) a = ng < 512 ? ng : ng < 768 ? ng + 512 : ng < 1280 ? ng - 256 : ng;
            drow = (a & ~255) + (((a >> 5) & 1) << 7) + (((a >> 6) & 3) << 5) + (a & 31);
        }
        unsigned o[8];
#pragma unroll
        for (int e = 0; e < 8; ++e) o[e] = pk2(sm[(kq * 16 + 2 * e) * 65 + n], sm[(kq * 16 + 2 * e + 1) * 65 + n]);
        uint4* dp = (uint4*)(w.dst + (size_t)drow * w.K + tk * 64 + kq * 16);
        dp[0] = make_uint4(o[0], o[1], o[2], o[3]); dp[1] = make_uint4(o[4], o[5], o[6], o[7]);
    }
    __syncthreads();
}

DI float wave_sum(float v) {
    v += __shfl_xor(v, 1); v += __shfl_xor(v, 2); v += __shfl_xor(v, 4); v += __shfl_xor(v, 8); v += __shfl_xor(v, 16); v += __shfl_xor(v, 32);
    return v;
}

DI void rowconv(const float* src, bf16_t* dst, float* ssq, int row, int lane) {
    const float* xr = src + (size_t)row * D;
    float ss = 0.f;
#pragma unroll
    for (int p = 0; p < 4; ++p) {
        const float4 v = *(const float4*)(xr + p * 256 + lane * 4);
        ss += v.x * v.x + v.y * v.y + v.z * v.z + v.w * v.w;
        *(uint2*)(dst + (size_t)row * D + p * 256 + lane * 4) = make_uint2(pk2(v.x, v.y), pk2(v.z, v.w));
    }
    ss = wave_sum(ss);
    if (lane == 0) ssq[row] = ss;
}

DI void phase0(const Params& P, char* smem) {
    const int tid = otid(), lane = tid & 63, wid = tid >> 6;
    float* ssq = (float*)(P.ws + OFF_SSQ);
    for (int i = blockIdx.x * NTHR + tid; i < 8 * T; i += gridDim.x * NTHR) ssq[T + i] = 0.f;
    if (blockIdx.x == 0 && tid < 32) ((unsigned*)(P.ws + OFF_KMAX))[tid] = 0u;
    constexpr int NW = 12352 / 2, NX = T / 8, NM = 1024 / 8;
    for (int u = blockIdx.x; u < NW + NX + NM; u += gridDim.x) {
        if (u < NW) {
            const int half = tid >> 8;
            int t = 2 * u + half, j = 0;
            for (; j < 17; ++j) { const int c = wjob_tiles(j); if (t < c) break; t -= c; }
            const WJob w = get_wjob(P, j);
            wconv_tile(w, t, (float*)smem + half * (64 * 65), tid & 255, true);
        } else if (u < NW + NX) {
            rowconv(P.in[0], (bf16_t*)(P.ws + OFF_XB), ssq, (u - NW) * 8 + wid, lane);
        } else {
            rowconv(P.in[1], (bf16_t*)(P.ws + OFF_MEMB), (float*)(P.ws + OFF_SSQM), (u - NW - NX) * 8 + wid, lane);
        }
    }
}

struct GJob {
    const bf16_t* A; const bf16_t* W;
    int lda, ksplit, kextra, K, ntm, ntn, mode;
    const float* rs;
    bf16_t* O; int ldo;
    const float* xin; float* xout; bf16_t* xb; float* ssq_out; float alpha;
    const float* qg; const float* kg; int qn_end, kn_end;
    bf16_t* vt;
};

typedef __attribute__((address_space(3))) unsigned* ldsu_t;
typedef const __attribute__((address_space(1))) unsigned* glbu_t;
DI void glds16(const bf16_t* g, char* l) { __builtin_amdgcn_global_load_lds((glbu_t)(const void*)g, (ldsu_t)(void*)l, 16, 0, 0); }

DI void gemm_tile(const GJob& J, int t, char* smem, bool dry) {
    const int tid = otid(), lane = tid & 63, wid = tid >> 6, wr = wid >> 2, wc = wid & 3;
    const int r = lane & 31, h = lane >> 5;
    int tm, tn;
    { const int gsz = 32 * J.ntn; const int g = t / gsz; const int rem = t - g * gsz; const int rows = min(32, J.ntm - g * 32); tn = rem / rows; tm = g * 32 + (rem - tn * rows); }
    const int lrow = wid * 16 + (lane >> 2);
    const int csw = ((lane & 3) ^ ((lane >> 4) & 3)) * 8;
    const bf16_t* Ag = J.A + (size_t)(tm * 256 + lrow) * J.lda + csw;
    const bf16_t* Wg = J.W + (size_t)(tn * 256 + lrow) * J.K + csw;
    const size_t astr = (size_t)128 * J.lda, wstr = (size_t)128 * J.K;
    char* lb = smem + tid * 16;
    const int nk = J.K >> 5;
#define GLDS(kt, buf) do { const int k0_ = (kt) * 32; const int ka_ = k0_ + (k0_ >= J.ksplit ? J.kextra : 0); char* l_ = lb + (buf) * STAGE_B; \
        glds16(Ag + ka_, l_); glds16(Ag + astr + ka_, l_ + 8192); glds16(Wg + k0_, l_ + OPB); glds16(Wg + wstr + k0_, l_ + OPB + 8192); } while (0)
    f32x16 acc[4][2];
#pragma unroll
    for (int a = 0; a < 4; ++a)
#pragma unroll
        for (int b = 0; b < 2; ++b)
#pragma unroll
            for (int i = 0; i < 16; ++i) acc[a][b][i] = 0.f;
    const int fr = (r >> 2) & 3;
    const int xrow = (wc * 64 + r) * 64, wrow = OPB + (wr * 128 + r) * 64;
    const int co0 = ((0 + h) ^ fr) * 16, co1 = ((2 + h) ^ fr) * 16;

    __syncthreads();
    GLDS(0, 0); GLDS(1, 1); GLDS(2, 2);
    asm volatile("s_waitcnt vmcnt(8)" ::: "memory");
    __builtin_amdgcn_s_barrier();
    bf16x8 w0[4], x0[2], w1[4], x1[2];
#define LOADF(W_, X_, sb_, co_) do { _Pragma("unroll") for (int ti = 0; ti < 2; ++ti) X_[ti] = *(const bf16x8*)((sb_) + xrow + ti * 2048 + (co_)); \
        _Pragma("unroll") for (int fi = 0; fi < 4; ++fi) W_[fi] = *(const bf16x8*)((sb_) + wrow + fi * 2048 + (co_)); } while (0)
#define MFMA8(W_, X_) do { __builtin_amdgcn_s_setprio(1); _Pragma("unroll") for (int fi = 0; fi < 4; ++fi) _Pragma("unroll") for (int ti = 0; ti < 2; ++ti) \
        acc[fi][ti] = MFMA(W_[fi], X_[ti], acc[fi][ti]); __builtin_amdgcn_s_setprio(0); } while (0)
    LOADF(w0, x0, smem, co0);
    __builtin_amdgcn_s_waitcnt(0xC07F);
    int buf = 0;
    for (int kt = 0; kt < nk; ++kt) {
        const char* sb = smem + buf * STAGE_B;
        LOADF(w1, x1, sb, co1);
        __builtin_amdgcn_sched_barrier(0);
        MFMA8(w0, x0);
        __builtin_amdgcn_s_waitcnt(0xC07F);
        __builtin_amdgcn_sched_barrier(0);
        const int nb = (buf + 1 == NST) ? 0 : buf + 1;
        if (kt + 1 < nk) {
            if (kt + 2 < nk) asm volatile("s_waitcnt vmcnt(4)" ::: "memory"); else asm volatile("s_waitcnt vmcnt(0)" ::: "memory");
            __builtin_amdgcn_s_barrier();
            if (kt + 3 < nk) { const int fb_ = (buf + 3 >= NST) ? buf + 3 - NST : buf + 3; GLDS(kt + 3, fb_); }
        }
        LOADF(w0, x0, smem + nb * STAGE_B, co0);
        __builtin_amdgcn_sched_barrier(0);
        MFMA8(w1, x1);
        __builtin_amdgcn_s_waitcnt(0xC07F);
        __builtin_amdgcn_sched_barrier(0);
        buf = nb;
    }
#undef LOADF
#undef MFMA8
#undef GLDS
    __syncthreads();

    if (dry) { if (acc[0][0][0] + acc[1][1][0] + acc[2][0][0] + acc[3][1][0] == 12345.678f) J.O[0] = 1; return; }
    const int tokb = tm * 256 + wc * 64;
    const int fb = tn * 256 + wr * 128;
    float rsc[2];
#pragma unroll
    for (int ti = 0; ti < 2; ++ti) rsc[ti] = J.rs ? __builtin_amdgcn_rsqf(J.rs[tokb + ti * 32 + r] * (1.f / 1024.f) + EPS) : 1.f;

    if (J.mode == 3 && fb >= 1024) {
#pragma unroll
        for (int ti = 0; ti < 2; ++ti) {
            const int tok = tokb + ti * 32 + r;
#pragma unroll
            for (int fi = 0; fi < 4; ++fi)
#pragma unroll
                for (int i = 0; i < 16; ++i) {
                    const int f = fb - 1024 + fi * 32 + crow(i, h);
                    const int bh_ = (tok >> 8) * 4 + (f >> 8), d_ = f & 255, key_ = tok & 255, k16 = key_ & 15;
                    const int ln_ = ((k16 >> 2) & 1) * 32 + (d_ & 31), e_ = ((k16 >> 3) << 2) | (k16 & 3);
                    J.vt[((((((size_t)bh_ * 8 + (d_ >> 5)) * 8 + (key_ >> 5)) * 2 + ((key_ >> 4) & 1)) * 64 + ln_) << 3) + e_] = (bf16_t)(pk2(acc[fi][ti][i] * rsc[ti], 0.f) & 0xffffu);
                }
        }
        return;
    }
    char* wl = smem + wid * 16384;
#pragma unroll
    for (int ti = 0; ti < 2; ++ti) {
#pragma unroll
        for (int fp = 0; fp < 2; ++fp) {
            const float sc = (J.mode == 1) ? J.alpha : rsc[ti];
#pragma unroll
            for (int fi2 = 0; fi2 < 2; ++fi2)
#pragma unroll
                for (int g = 0; g < 4; ++g) {
                    float4 v;
                    v.x = acc[2 * fp + fi2][ti][4 * g + 0] * sc; v.y = acc[2 * fp + fi2][ti][4 * g + 1] * sc;
                    v.z = acc[2 * fp + fi2][ti][4 * g + 2] * sc; v.w = acc[2 * fp + fi2][ti][4 * g + 3] * sc;
                    *(float4*)(wl + r * 272 + (fi2 * 32 + 8 * g + 4 * h) * 4) = v;
                }
            const int tok0 = tokb + ti * 32, f0 = fb + fp * 64;
            if (J.mode == 0) {
                const int c4 = (lane & 7) * 4;
#pragma unroll
                for (int p = 0; p < 4; ++p) {
                    const int row = p * 8 + (lane >> 3);
                    const float4 ga = *(const float4*)(wl + row * 272 + c4 * 4);
                    const float4 up = *(const float4*)(wl + row * 272 + (32 + c4) * 4);
                    float y0 = ga.x * up.x * __builtin_amdgcn_rcpf(1.f + fexp2(-ga.x * LOG2E));
                    float y1 = ga.y * up.y * __builtin_amdgcn_rcpf(1.f + fexp2(-ga.y * LOG2E));
                    float y2 = ga.z * up.z * __builtin_amdgcn_rcpf(1.f + fexp2(-ga.z * LOG2E));
                    float y3 = ga.w * up.w * __builtin_amdgcn_rcpf(1.f + fexp2(-ga.w * LOG2E));
                    *(uint2*)(J.O + (size_t)(tok0 + row) * J.ldo + (f0 >> 1) + c4) = make_uint2(pk2(y0, y1), pk2(y2, y3));
                }
            } else if (J.mode == 1) {
                const int c4 = (lane & 15) * 4;
#pragma unroll
                for (int p = 0; p < 8; ++p) {
                    const int row = p * 4 + (lane >> 4);
                    const size_t tok = tok0 + row;
                    const float4 v = *(const float4*)(wl + row * 272 + c4 * 4);
                    const float4 xo = *(const float4*)(J.xin + tok * D + f0 + c4);
                    float4 xn; xn.x = xo.x + v.x; xn.y = xo.y + v.y; xn.z = xo.z + v.z; xn.w = xo.w + v.w;
                    *(float4*)(J.xout + tok * D + f0 + c4) = xn;
                    if (J.xb) {
                        *(uint2*)(J.xb + tok * D + f0 + c4) = make_uint2(pk2(xn.x, xn.y), pk2(xn.z, xn.w));
                        float ss = xn.x * xn.x + xn.y * xn.y + xn.z * xn.z + xn.w * xn.w;
                        ss += __shfl_xor(ss, 1); ss += __shfl_xor(ss, 2); ss += __shfl_xor(ss, 4); ss += __shfl_xor(ss, 8);
                        if ((lane & 15) == 0) atomicAdd(J.ssq_out + tok, ss);
                    }
                }
            } else {
                const int nm = f0 < J.qn_end ? 1 : (f0 < J.kn_end ? 2 : 0);
                const float* gp = nm == 1 ? J.qg : J.kg;
                const int c4 = (lane & 15) * 4;
                float4 gn = make_float4(1.f, 1.f, 1.f, 1.f);
                if (nm) gn = *(const float4*)(gp + c4);
#pragma unroll
                for (int p = 0; p < 8; ++p) {
                    const int row = p * 4 + (lane >> 4);
                    float4 v = *(const float4*)(wl + row * 272 + c4 * 4);
                    if (nm) {
                        float ss = v.x * v.x + v.y * v.y + v.z * v.z + v.w * v.w;
                        ss += __shfl_xor(ss, 1); ss += __shfl_xor(ss, 2); ss += __shfl_xor(ss, 4); ss += __shfl_xor(ss, 8);
                        const float inv = __builtin_amdgcn_rsqf(ss * (1.f / 64.f) + EPS);
                        v.x *= inv * gn.x; v.y *= inv * gn.y; v.z *= inv * gn.z; v.w *= inv * gn.w;
                    }
                    *(uint2*)(J.O + (size_t)(tok0 + row) * J.ldo + f0 + c4) = make_uint2(pk2(v.x, v.y), pk2(v.z, v.w));
                }
            }
        }
    }
}

DI void gemm_phase(const GJob& JA, int nA, int nB, const Params& P, char* smem, bool dry) {
    for (int u = (int)gridDim.x - 1 - (int)blockIdx.x; u < nA + nB; u += gridDim.x) {
        GJob J = JA; int t = u;
        if (u >= nA) {
            const int v = u - nA; const int layer = v >> 5; t = v & 31;
            J.A = (const bf16_t*)(P.ws + OFF_MEMB); J.lda = D; J.ksplit = 1 << 30; J.kextra = 0;
            J.W = (const bf16_t*)(P.ws + OFF_WKV + (size_t)layer * 2 * SZ_MM); J.K = D; J.ntm = 4; J.ntn = 8; J.mode = 3;
            J.rs = (const float*)(P.ws + OFF_SSQM); J.O = (bf16_t*)(P.ws + OFF_KN + (size_t)layer * SZ_MM); J.ldo = D;
            J.qn_end = 0; J.kn_end = 0; J.vt = (bf16_t*)(P.ws + OFF_VT + (size_t)layer * SZ_MM);
        }
        gemm_tile(J, t, smem, dry);
    }
}

namespace pg8 {
#define PG8_LAS __attribute__((address_space(3)))
typedef float f32x4 __attribute__((ext_vector_type(4)));
typedef unsigned u32x4 __attribute__((ext_vector_type(4)));
constexpr int BM = 256, BK = 64, HALF = 128, HTB = HALF * BK * 2, STAGE_BYTES = 8 * HTB, NXCD = 8, WGM = 8;
DI int lds_byte(int r, int c) { const int st = (r >> 4) * 2 + (c >> 5), rr = r & 15, cc = c & 31, ob = rr * 64 + cc * 2; return st * 1024 + (ob ^ (((ob >> 9) & 1) << 5)); }
DI void stage_rc(int b, int& R, int& C) { const int st = b / 1024, sb = b % 1024, swz = sb ^ (((sb >> 9) & 1) << 5); R = (st >> 1) * 16 + swz / 64; C = (st & 1) * 32 + (swz % 64) / 2; }
DI int perm32(int rho) { const int n = rho >> 4, i = rho & 15; return 8 * (i >> 2) + 4 * n + (i & 3); }
struct Unit { int pm, pn; };
struct Gemm { const bf16_t* A; const bf16_t* Bt; int M, N, K, lda; };
struct StaticOrder {
    int nM, nN, nwg, G, c;
    DI void init(int M, int N, int G_, int c_) { nM = M / BM; nN = N / BM; nwg = nM * nN; G = G_; c = c_; }
    DI bool next(int i, Unit& u) const {
        const long L = (long)i * G + c; if (L >= nwg) return false;
        int wgid = (int)L; { const int q = nwg / NXCD, r = nwg % NXCD, xcd = wgid % NXCD, off = wgid / NXCD; wgid = (xcd < r ? xcd * (q + 1) : r * (q + 1) + (xcd - r) * q) + off; }
        const int nig = WGM * nN, gid = wgid / nig, fm = gid * WGM, gsz = (nM - fm) < WGM ? (nM - fm) : WGM;
        u.pm = fm + ((wgid % nig) % gsz); u.pn = (wgid % nig) / gsz; return true;
    }
    DI void a_ready(const Unit&) const {}
    DI void done(const Unit&) const {}
};

struct Epi {
    static constexpr bool PERM = true, AFTER_DRAIN = false;
    int mode;
    const float* rs;
    bf16_t* O; int ldo;
    const float* xin; float* xout; bf16_t* xb; float* ssq_out; float alpha;
    const float* qg; const float* kg; int qn_end, kn_beg, kn_end; int dryrun;
    template <bool SRC_F32, bool DST_F32>
    DI void res_path(const f32x4 (&acc)[2][2][4][2], int row0, int colb, int fq) const {
        const __amdgpu_buffer_rsrc_t r_xb = wt_rsrc(xb, (size_t)T * D * 2), r_out = wt_rsrc(DST_F32 ? (const void*)xout : (const void*)xb, (size_t)T * D * (DST_F32 ? 4 : 2));
#pragma unroll
        for (int ai = 0; ai < 2; ++ai) {
            float4 xf[4][2][2];
            uint4 xw[4][2];
#pragma unroll
            for (int m = 0; m < 4; ++m)
#pragma unroll
                for (int bj = 0; bj < 2; ++bj) {
                    const size_t off = (size_t)(row0 + ai * HALF + m * 16) * D + colb + bj * 32;
                    if (SRC_F32) { xf[m][bj][0] = *(const float4*)(xin + off); xf[m][bj][1] = *(const float4*)(xin + off + 4); }
                    else xw[m][bj] = *(const uint4*)(xb + off);
                }
#pragma unroll
            for (int m = 0; m < 4; ++m) {
                const size_t tok = row0 + ai * HALF + m * 16;
                float ss = 0.f;
#pragma unroll
                for (int bj = 0; bj < 2; ++bj) {
                    const size_t off = tok * D + colb + bj * 32;
                    float4 x0, x1;
                    if (SRC_F32) { x0 = xf[m][bj][0]; x1 = xf[m][bj][1]; }
                    else { const uint4 w = xw[m][bj]; x0 = make_float4(bflo(w.x), bfhi(w.x), bflo(w.y), bfhi(w.y)); x1 = make_float4(bflo(w.z), bfhi(w.z), bflo(w.w), bfhi(w.w)); }
                    float4 n0, n1;
                    n0.x = x0.x + alpha * acc[ai][bj][m][0][0]; n0.y = x0.y + alpha * acc[ai][bj][m][0][1]; n0.z = x0.z + alpha * acc[ai][bj][m][0][2]; n0.w = x0.w + alpha * acc[ai][bj][m][0][3];
                    n1.x = x1.x + alpha * acc[ai][bj][m][1][0]; n1.y = x1.y + alpha * acc[ai][bj][m][1][1]; n1.z = x1.z + alpha * acc[ai][bj][m][1][2]; n1.w = x1.w + alpha * acc[ai][bj][m][1][3];
                    if (DST_F32) { st16f_wt(r_out, off * 4, n0); st16f_wt(r_out, off * 4 + 16, n1); }
                    else {
                        const uint4 w = make_uint4(pk2(n0.x, n0.y), pk2(n0.z, n0.w), pk2(n1.x, n1.y), pk2(n1.z, n1.w));
                        st16_wt(r_xb, off * 2, w);
                        const float r0 = bflo(w.x), r1 = bfhi(w.x), r2 = bflo(w.y), r3 = bfhi(w.y), r4 = bflo(w.z), r5 = bfhi(w.z), r6 = bflo(w.w), r7 = bfhi(w.w);
                        ss += r0 * r0 + r1 * r1 + r2 * r2 + r3 * r3 + r4 * r4 + r5 * r5 + r6 * r6 + r7 * r7;
                    }
                }
                if (!DST_F32) {
                    ss += __shfl_xor(ss, 16); ss += __shfl_xor(ss, 32);
                    if (fq == 0) atomicAdd(ssq_out + tok, ss);
                }
            }
        }
    }
    template <bool NM>
    DI void qkv_path(const f32x4 (&acc)[2][2][4][2], int row0, int f0, int fq, const float* gp) const {
        const __amdgpu_buffer_rsrc_t r_o = wt_rsrc(O, (size_t)T * ldo * 2);
        float4 g4[2][2];
#pragma unroll
        for (int bj = 0; bj < 2; ++bj)
#pragma unroll
            for (int n = 0; n < 2; ++n) g4[bj][n] = NM ? *(const float4*)(gp + bj * 32 + 8 * fq + 4 * n) : make_float4(1.f, 1.f, 1.f, 1.f);
        float sc8[2][4];
#pragma unroll
        for (int ai = 0; ai < 2; ++ai)
#pragma unroll
            for (int m = 0; m < 4; ++m) sc8[ai][m] = rs[row0 + ai * HALF + m * 16];
#pragma unroll
        for (int ai = 0; ai < 2; ++ai)
#pragma unroll
            for (int m = 0; m < 4; ++m) {
                const size_t tok = row0 + ai * HALF + m * 16;
                float sc = __builtin_amdgcn_rsqf(sc8[ai][m] * (1.f / 1024.f) + EPS);
                if (NM) {
                    float ss = 0.f;
#pragma unroll
                    for (int bj = 0; bj < 2; ++bj)
#pragma unroll
                        for (int n = 0; n < 2; ++n)
#pragma unroll
                            for (int j = 0; j < 4; ++j) { const float v = acc[ai][bj][m][n][j] * sc; ss += v * v; }
                    ss += __shfl_xor(ss, 16); ss += __shfl_xor(ss, 32);
                    sc *= __builtin_amdgcn_rsqf(ss * (1.f / 64.f) + EPS);
                }
#pragma unroll
                for (int bj = 0; bj < 2; ++bj) {
                    const f32x4 a0 = acc[ai][bj][m][0], a1 = acc[ai][bj][m][1];
                    st16_wt(r_o, (tok * ldo + f0 + bj * 32 + 8 * fq) * 2,
                        make_uint4(pk2(a0[0] * sc * g4[bj][0].x, a0[1] * sc * g4[bj][0].y), pk2(a0[2] * sc * g4[bj][0].z, a0[3] * sc * g4[bj][0].w),
                                   pk2(a1[0] * sc * g4[bj][1].x, a1[1] * sc * g4[bj][1].y), pk2(a1[2] * sc * g4[bj][1].z, a1[3] * sc * g4[bj][1].w)));
                }
            }
    }
    DI void operator()(const f32x4 (&acc)[2][2][4][2], const Unit& u, int wr, int wc, int fr, int fq) const {
        if (dryrun) { if (acc[0][0][0][0][0] + acc[1][1][3][1][3] + acc[0][1][2][0][1] + acc[1][0][1][1][2] == 12345.678f) O[0] = 1; return; }
        const int row0 = u.pm * BM + wr * 64 + fr;
        if (mode == 0) {
            const int col = u.pn * 128 + wc * 32 + 8 * fq;
            const __amdgpu_buffer_rsrc_t r_o = wt_rsrc(O, (size_t)T * ldo * 2);
            float sc8[2][4];
#pragma unroll
            for (int ai = 0; ai < 2; ++ai)
#pragma unroll
                for (int m = 0; m < 4; ++m) sc8[ai][m] = rs[row0 + ai * HALF + m * 16];
#pragma unroll
            for (int ai = 0; ai < 2; ++ai)
#pragma unroll
                for (int m = 0; m < 4; ++m) {
                    const size_t tok = row0 + ai * HALF + m * 16;
                    const float sc = __builtin_amdgcn_rsqf(sc8[ai][m] * (1.f / 1024.f) + EPS);
                    float y[8];
#pragma unroll
                    for (int n = 0; n < 2; ++n)
#pragma unroll
                        for (int j = 0; j < 4; ++j) {
                            const float ga = acc[ai][0][m][n][j] * sc, up = acc[ai][1][m][n][j] * sc;
                            y[4 * n + j] = ga * up * __builtin_amdgcn_rcpf(1.f + fexp2(-ga * LOG2E));
                        }
                    st16_wt(r_o, (tok * ldo + col) * 2, make_uint4(pk2(y[0], y[1]), pk2(y[2], y[3]), pk2(y[4], y[5]), pk2(y[6], y[7])));
                }
        } else if (mode == 1) {
            const int colb = u.pn * BM + wc * 64 + 8 * fq;
            if (xin) res_path<true, false>(acc, row0, colb, fq);
            else if (xout) res_path<false, true>(acc, row0, colb, fq);
            else res_path<false, false>(acc, row0, colb, fq);
        } else {
            const int f0 = u.pn * BM + wc * 64;
            const int nm = f0 < qn_end ? 1 : ((f0 >= kn_beg && f0 < kn_end) ? 2 : 0);
            if (nm) qkv_path<true>(acc, row0, f0, fq, nm == 1 ? qg : kg);
            else qkv_path<false>(acc, row0, f0, fq, nullptr);
        }
    }
};

template <class Epi, class Sched, bool ALIGN_EPI = false, bool SP2 = false>
__device__ __forceinline__ void gemm_phase(PG8_LAS unsigned char* lds, const Gemm g, const Sched& S, const Epi& E) {
    const int tid = otid(), wid = __builtin_amdgcn_readfirstlane(tid >> 6), lane = tid & 63, wr = wid >> 2, wc = wid & 3, fr = lane & 15, fq = lane >> 4;
    const int K = g.K, nt = K / BK;
    unsigned voffA[2], voffB[2];
#pragma unroll
    for (int i = 0; i < 2; ++i) { int R, C; stage_rc(tid * 16 + i * 8192, R, C); const int Rb = Epi::PERM ? ((R & ~31) + perm32(R & 31)) : R;
        voffA[i] = (unsigned)(R * g.lda + C) * 2u; voffB[i] = (unsigned)(Rb * K + C) * 2u; }
    const size_t kstep = (size_t)(BK * 2);
    const size_t hstepA = (size_t)HALF * g.lda * 2, hstepB = (size_t)HALF * K * 2;
    const size_t tstepA = 2 * hstepA, tstepB = 2 * hstepB;
    const unsigned ldsw = (unsigned)wid * 1024u;
    const int aoff = lds_byte(wr * 64 + fr, fq * 8), boff = lds_byte(wc * 32 + fr, fq * 8);
#define PG8_SA(b, h) (((b) * 2 + (h)) * HTB)
#define PG8_SB(b, h) ((4 + (b) * 2 + (h)) * HTB)
#define PG8_STAGE(bufoff, gbase, voff) do { _Pragma("unroll") for (int _i = 0; _i < 2; ++_i) \
        __builtin_amdgcn_global_load_lds((const unsigned*)((const char*)(gbase) + (voff)[_i]), (PG8_LAS unsigned*)(lds + (bufoff) + ldsw + _i * 8192), 16, 0, 0); } while (0)
#define PG8_LDA(dst, b, h) do { _Pragma("unroll") for (int m = 0; m < 4; ++m) _Pragma("unroll") for (int k = 0; k < 2; ++k) dst[m][k] = *(const PG8_LAS bf16x8*)(lds + PG8_SA(b, h) + aoff + m * 2048 + k * 1024); } while (0)
#define PG8_LDB(dst, b, h) do { _Pragma("unroll") for (int n = 0; n < 2; ++n) _Pragma("unroll") for (int k = 0; k < 2; ++k) dst[n][k] = *(const PG8_LAS bf16x8*)(lds + PG8_SB(b, h) + boff + n * 2048 + k * 1024); } while (0)
#define PG8_MMA(ai, bj, At, Bt) do { __builtin_amdgcn_s_setprio(1); _Pragma("unroll") for (int m = 0; m < 4; ++m) _Pragma("unroll") for (int n = 0; n < 2; ++n) _Pragma("unroll") for (int k = 0; k < 2; ++k) \
        acc[ai][bj][m][n] = __builtin_amdgcn_mfma_f32_16x16x32_bf16(Bt[n][k], At[m][k], acc[ai][bj][m][n], 0, 0, 0); __builtin_amdgcn_s_setprio(0); } while (0)
#define PG8_WAIT_V(n) asm volatile("s_waitcnt vmcnt(" #n ")" ::: "memory")
#define PG8_WAIT_L(n) asm volatile("s_waitcnt lgkmcnt(" #n ")" ::: "memory")
#define PG8_BAR __builtin_amdgcn_s_barrier()
#define PG8_SCHED __builtin_amdgcn_sched_barrier(0)
    Unit cur, nxt; int ui = 0;
    if (!S.next(0, cur)) return;
    f32x4 acc[2][2][4][2];
#pragma unroll
    for (int a = 0; a < 2; ++a)
#pragma unroll
        for (int b = 0; b < 2; ++b)
#pragma unroll
            for (int m = 0; m < 4; ++m)
#pragma unroll
                for (int n = 0; n < 2; ++n) acc[a][b][m][n] = (f32x4){0.f, 0.f, 0.f, 0.f};
    bf16x8 At[4][2], B0[2][2], B1[2][2];
    const char* cA = (const char*)g.A + (size_t)cur.pm * tstepA; const char* cB = (const char*)g.Bt + (size_t)cur.pn * tstepB;
    S.a_ready(cur);
    if constexpr (SP2) {
        PG8_STAGE(PG8_SB(0, 0), cB, voffB); PG8_STAGE(PG8_SB(0, 1), cB + hstepB, voffB); PG8_STAGE(PG8_SA(0, 0), cA, voffA); PG8_STAGE(PG8_SA(0, 1), cA + hstepA, voffA);
        if (wr == 1) PG8_BAR;
        PG8_WAIT_V(2); PG8_BAR;
        PG8_STAGE(PG8_SB(1, 0), cB + kstep, voffB); PG8_STAGE(PG8_SA(1, 0), cA + kstep, voffA); PG8_STAGE(PG8_SB(1, 1), cB + hstepB + kstep, voffB);
        PG8_WAIT_V(6); PG8_BAR;
    } else {
        PG8_STAGE(PG8_SB(0, 0), cB, voffB); PG8_STAGE(PG8_SA(0, 0), cA, voffA); PG8_STAGE(PG8_SB(0, 1), cB + hstepB, voffB); PG8_STAGE(PG8_SA(0, 1), cA + hstepA, voffA);
        if (wr == 1) PG8_BAR;
        PG8_WAIT_V(4); PG8_BAR;
        PG8_STAGE(PG8_SB(1, 0), cB + kstep, voffB); PG8_STAGE(PG8_SA(1, 0), cA + kstep, voffA); PG8_STAGE(PG8_SB(1, 1), cB + hstepB + kstep, voffB);
        PG8_WAIT_V(6); PG8_BAR;
    }
    for (;;) {
        const bool has_next = S.next(ui + 1, nxt);
        const char* nA = has_next ? (const char*)g.A + (size_t)nxt.pm * tstepA : cA; const char* nB = has_next ? (const char*)g.Bt + (size_t)nxt.pn * tstepB : cB;
        for (int t = 0; t < nt; t += 2) {
            const bool last = (t == nt - 2);
            const char* a1 = cA + (size_t)(t + 1) * kstep;
            const char* a2 = last ? nA : cA + (size_t)(t + 2) * kstep; const char* b2 = last ? nB : cB + (size_t)(t + 2) * kstep;
            const char* a3 = a2 + kstep; const char* b3 = b2 + kstep;
            if (last && has_next) S.a_ready(nxt);
            if constexpr (SP2) {
            PG8_LDB(B0, 0, 0); PG8_LDB(B1, 0, 1); PG8_SCHED; PG8_LDA(At, 0, 0); PG8_STAGE(PG8_SA(1, 1), a1 + hstepA, voffA);
            PG8_WAIT_V(8); PG8_WAIT_L(0); PG8_BAR; PG8_MMA(0, 0, At, B0); PG8_MMA(0, 1, At, B1); PG8_BAR; PG8_SCHED;
            PG8_LDA(At, 0, 1); PG8_STAGE(PG8_SB(0, 0), b2, voffB); PG8_STAGE(PG8_SB(0, 1), b2 + hstepB, voffB); PG8_STAGE(PG8_SA(0, 0), a2, voffA);
            PG8_WAIT_V(8); PG8_WAIT_L(0); PG8_BAR; PG8_MMA(1, 0, At, B0); PG8_MMA(1, 1, At, B1); PG8_BAR; PG8_SCHED;
            PG8_LDB(B0, 1, 0); PG8_LDB(B1, 1, 1); PG8_SCHED; PG8_LDA(At, 1, 0); PG8_STAGE(PG8_SA(0, 1), a2 + hstepA, voffA);
            PG8_WAIT_V(8); PG8_WAIT_L(0); PG8_BAR; PG8_MMA(0, 0, At, B0); PG8_MMA(0, 1, At, B1); PG8_BAR; PG8_SCHED;
            PG8_LDA(At, 1, 1); PG8_STAGE(PG8_SB(1, 0), b3, voffB); PG8_STAGE(PG8_SB(1, 1), b3 + hstepB, voffB); PG8_STAGE(PG8_SA(1, 0), a3, voffA);
            PG8_WAIT_V(8); PG8_WAIT_L(0); PG8_BAR; PG8_MMA(1, 0, At, B0); PG8_MMA(1, 1, At, B1); PG8_BAR; PG8_SCHED;
            } else {
            PG8_LDB(B0, 0, 0); PG8_SCHED; PG8_LDA(At, 0, 0); PG8_STAGE(PG8_SA(1, 1), a1 + hstepA, voffA);
            PG8_WAIT_L(8); PG8_BAR; PG8_WAIT_L(0); PG8_MMA(0, 0, At, B0); PG8_BAR; PG8_SCHED;
            PG8_LDB(B1, 0, 1); PG8_STAGE(PG8_SB(0, 0), b2, voffB);
            PG8_BAR; PG8_WAIT_L(0); PG8_MMA(0, 1, At, B1); PG8_BAR;
            PG8_LDA(At, 0, 1); PG8_STAGE(PG8_SA(0, 0), a2, voffA);
            PG8_BAR; PG8_WAIT_L(0); PG8_MMA(1, 0, At, B0); PG8_BAR; PG8_SCHED;
            PG8_STAGE(PG8_SB(0, 1), b2 + hstepB, voffB);
            PG8_WAIT_V(6); PG8_BAR; PG8_MMA(1, 1, At, B1); PG8_BAR;
            PG8_LDB(B0, 1, 0); PG8_SCHED; PG8_LDA(At, 1, 0); PG8_STAGE(PG8_SA(0, 1), a2 + hstepA, voffA);
            PG8_WAIT_L(8); PG8_BAR; PG8_WAIT_L(0); PG8_MMA(0, 0, At, B0); PG8_BAR; PG8_SCHED;
            PG8_LDB(B1, 1, 1); PG8_STAGE(PG8_SB(1, 0), b3, voffB);
            PG8_BAR; PG8_WAIT_L(0); PG8_MMA(0, 1, At, B1); PG8_BAR;
            PG8_LDA(At, 1, 1); PG8_STAGE(PG8_SA(1, 0), a3, voffA);
            PG8_BAR; PG8_WAIT_L(0); PG8_MMA(1, 0, At, B0); PG8_BAR; PG8_SCHED;
            PG8_STAGE(PG8_SB(1, 1), b3 + hstepB, voffB);
            PG8_WAIT_V(6); PG8_BAR; PG8_MMA(1, 1, At, B1); PG8_BAR;
            }
        }
        if constexpr (ALIGN_EPI) { if (wr == 0) PG8_BAR; }
        if constexpr (!Epi::AFTER_DRAIN) { E(acc, cur, wr, wc, fr, fq); S.done(cur); }
        if (!has_next) break;
#pragma unroll
        for (int a = 0; a < 2; ++a)
#pragma unroll
            for (int b = 0; b < 2; ++b)
#pragma unroll
                for (int m = 0; m < 4; ++m)
#pragma unroll
                    for (int n = 0; n < 2; ++n) acc[a][b][m][n] = (f32x4){0.f, 0.f, 0.f, 0.f};
        cur = nxt; cA = nA; cB = nB; ++ui;
        if constexpr (ALIGN_EPI) { if (wr == 1) PG8_BAR; }
    }
    PG8_WAIT_V(0);
    if constexpr (!ALIGN_EPI) { if (wr == 0) PG8_BAR; }
    PG8_BAR;
    if constexpr (Epi::AFTER_DRAIN) { E.fused(acc, cur, wr, wc, fr, fq, lds, wid, lane); S.done(cur); }
#undef PG8_SA
#undef PG8_SB
#undef PG8_STAGE
#undef PG8_LDA
#undef PG8_LDB
#undef PG8_MMA
#undef PG8_WAIT_V
#undef PG8_WAIT_L
#undef PG8_BAR
#undef PG8_SCHED
}
}

#define KV_DECL uint4 rk0, rk1, rk2, rk3, rv0, rv1, rv2, rv3
#define KV_LOAD(kb_, dil_) do { const int kk_ = lane >> 3; \
    const bf16_t* p0_ = qkv + (rowb + min(max((kb_) + (dil_) * kk_, 0), S - 1)) * ld + (lane & 7) * 8; \
    const bf16_t* p1_ = qkv + (rowb + min(max((kb_) + (dil_) * (kk_ + 8), 0), S - 1)) * ld + (lane & 7) * 8; \
    const bf16_t* p2_ = qkv + (rowb + min(max((kb_) + (dil_) * (kk_ + 16), 0), S - 1)) * ld + (lane & 7) * 8; \
    const bf16_t* p3_ = qkv + (rowb + min(max((kb_) + (dil_) * (kk_ + 24), 0), S - 1)) * ld + (lane & 7) * 8; \
    rk0 = *(const uint4*)(p0_ + kcol); rk1 = *(const uint4*)(p1_ + kcol); rk2 = *(const uint4*)(p2_ + kcol); rk3 = *(const uint4*)(p3_ + kcol); \
    rv0 = *(const uint4*)(p0_ + vcol); rv1 = *(const uint4*)(p1_ + vcol); rv2 = *(const uint4*)(p2_ + vcol); rv3 = *(const uint4*)(p3_ + vcol); } while (0)
#define KV_STORE() do { char* wp_ = vl + (lane >> 3) * 144 + (lane & 7) * 16; \
    *(uint4*)(wp_) = rk0; *(uint4*)(wp_ + 8 * 144) = rk1; *(uint4*)(wp_ + 16 * 144) = rk2; *(uint4*)(wp_ + 24 * 144) = rk3; \
    *(uint4*)(wp_ + 4608) = rv0; *(uint4*)(wp_ + 4608 + 8 * 144) = rv1; *(uint4*)(wp_ + 4608 + 16 * 144) = rv2; *(uint4*)(wp_ + 4608 + 24 * 144) = rv3; } while (0)

DI bf16x8 v_frag(const char* vbase, int s, int dt) {
    typedef __attribute__((address_space(3))) v4i16_t* lp_t;
    const char* a = vbase + s * (16 * 144) + dt * 64;
    const s16x4 lo = __builtin_bit_cast(s16x4, __builtin_amdgcn_ds_read_tr16_b64_v4i16((lp_t)(a)));
    const s16x4 hi = __builtin_bit_cast(s16x4, __builtin_amdgcn_ds_read_tr16_b64_v4i16((lp_t)(a + 8 * 144)));
    return __builtin_shufflevector(lo, hi, 0, 1, 2, 3, 4, 5, 6, 7);
}

template <int OFF> DI bf16x8 pack8v(const f32x16& p) {
    typedef unsigned u32x4 __attribute__((ext_vector_type(4)));
    u32x4 w; w[0] = pk2(p[OFF + 0], p[OFF + 1]); w[1] = pk2(p[OFF + 2], p[OFF + 3]); w[2] = pk2(p[OFF + 4], p[OFF + 5]); w[3] = pk2(p[OFF + 6], p[OFF + 7]);
    return __builtin_bit_cast(bf16x8, w);
}

DI void win_attn_wave(bf16_t* qkv, int ld, int b, int qcol, int kcol, int vcol, int tq0, int qstride,
                      float slope2, float m_init, float l_init, int pat, char* vl, int lane, bool dry,
                      int nq = 32, float* st = nullptr, int tloc0 = 0, int tlstride = 0, int stage = 0) {
    const int r = lane & 31, h = lane >> 5;
    const size_t rowb = (size_t)b * S;
    const int tq = tq0 + qstride * r;
    bf16x8 qf[4];
    {
        const bf16_t* qp = qkv + (rowb + min(tq, S - 1)) * ld + qcol + h * 32;
#pragma unroll
        for (int ks = 0; ks < 4; ++ks) qf[ks] = *(const bf16x8*)(qp + ks * 8);
    }
    f32x16 o0, o1;
#pragma unroll
    for (int i = 0; i < 16; ++i) { o0[i] = 0.f; o1[i] = 0.f; }
    float m = m_init, l = (h == 0) ? l_init : 0.f;
    const float sc2 = 0.125f * LOG2E;
    const int i16 = lane & 15;
    const char* vbase = vl + 4608 + (4 * h + (i16 >> 2)) * 144 + (16 * ((lane >> 4) & 1) + 4 * (i16 & 3)) * 2;
    const char* kfp = vl + r * 144 + h * 64;
    KV_DECL;
    for (int pi = 0; pi < 1; ++pi) {
        int dil, W, kfirst; const int nt = 5;
        if (pat < 0) { dil = 1; W = 127; kfirst = tq0 - 128; }
        else if (pat == 0) { dil = 1; W = 128; kfirst = tq0 - 128; }
        else if (pat == 1) { dil = 4; W = 512; kfirst = tq0 - 512; }
        else { dil = 16; W = 2048; kfirst = tq0 - 2048; }
        const int step = 32 * dil;
        int t0 = 0;
        { const int need = -kfirst - 31 * dil; if (need > 0) t0 = (need + step - 1) / step; }
        if (t0 >= nt) continue;
        KV_LOAD(kfirst + t0 * step, dil);
        for (int tile = t0; tile < nt; ++tile) {
            const int kb = kfirst + tile * step;
            KV_STORE();
            asm volatile("" ::: "memory");
            if (tile + 1 < nt) KV_LOAD(kb + step, dil);
            f32x16 s = MFMA(*(const bf16x8*)(kfp), qf[0], f32x16{});
#pragma unroll
            for (int ks = 1; ks < 4; ++ks) s = MFMA(*(const bf16x8*)(kfp + ks * 16), qf[ks], s);
            f32x16 sv; float mloc = -INFINITY;
            const int d0 = tq - kb - 4 * h * dil;
            const float b0 = -slope2 * (float)d0, b1 = slope2 * (float)dil;
            if (tile >= 1 && tile <= 3 && kb >= 0) {
#pragma unroll
                for (int i = 0; i < 16; ++i) {
                    sv[i] = __builtin_fmaf(s[i], sc2, __builtin_fmaf(b1, (float)crow(i, 0), b0));
                    mloc = fmaxf(mloc, sv[i]);
                }
            } else {
                const unsigned wlim = (unsigned)min(W, tq);
#pragma unroll
                for (int i = 0; i < 16; ++i) {
                    const int diff = d0 - dil * crow(i, 0);
                    const float sb = __builtin_fmaf(s[i], sc2, __builtin_fmaf(b1, (float)crow(i, 0), b0));
                    sv[i] = ((unsigned)diff <= wlim) ? sb : -INFINITY;
                    mloc = fmaxf(mloc, sv[i]);
                }
            }
            mloc = fmaxf(mloc, __shfl_xor(mloc, 32));
            const float mn = fmaxf(m, mloc);
            if (__builtin_amdgcn_ballot_w64(mn > m + 8.f) != 0) {
                const float alpha = fexp2(m - mn);
                l *= alpha;
#pragma unroll
                for (int i = 0; i < 16; ++i) { o0[i] *= alpha; o1[i] *= alpha; }
                m = mn;
            }
            float ps = 0.f;
#pragma unroll
            for (int i = 0; i < 16; ++i) { sv[i] = fexp2(sv[i] - m); ps += sv[i]; }
            l += ps;
            const bf16x8 p0 = pack8v<0>(sv), p1 = pack8v<8>(sv);
            o0 = MFMA(v_frag(vbase, 0, 0), p0, o0);
            o0 = MFMA(v_frag(vbase, 1, 0), p1, o0);
            o1 = MFMA(v_frag(vbase, 0, 1), p0, o1);
            o1 = MFMA(v_frag(vbase, 1, 1), p1, o1);
            asm volatile("" ::: "memory");
        }
    }
    float lt = l + __shfl_xor(l, 32);
    if (st) {
        const bool act = r < nq;
        char* sp = (char*)st + (tloc0 + tlstride * r) * 144;
        if (act) {
            if (stage > 0) {
                const float ms = *(const float*)(sp + 128), ls = *(const float*)(sp + 132);
                const float mn = fmaxf(ms, m);
                const float as = fexp2(ms - mn), aw = fexp2(m - mn);
                lt = ls * as + lt * aw; m = mn;
#pragma unroll
                for (int g = 0; g < 4; ++g) {
                    const uint2 a = *(const uint2*)(sp + (8 * g + 4 * h) * 2), c = *(const uint2*)(sp + (32 + 8 * g + 4 * h) * 2);
                    o0[4 * g] = bflo(a.x) * as + o0[4 * g] * aw; o0[4 * g + 1] = bfhi(a.x) * as + o0[4 * g + 1] * aw; o0[4 * g + 2] = bflo(a.y) * as + o0[4 * g + 2] * aw; o0[4 * g + 3] = bfhi(a.y) * as + o0[4 * g + 3] * aw;
                    o1[4 * g] = bflo(c.x) * as + o1[4 * g] * aw; o1[4 * g + 1] = bfhi(c.x) * as + o1[4 * g + 1] * aw; o1[4 * g + 2] = bflo(c.y) * as + o1[4 * g + 2] * aw; o1[4 * g + 3] = bfhi(c.y) * as + o1[4 * g + 3] * aw;
                }
            }
            if (stage < 2) {
                if (h == 0) { *(float*)(sp + 128) = m; *(float*)(sp + 132) = lt; }
#pragma unroll
                for (int g = 0; g < 4; ++g) {
                    *(uint2*)(sp + (8 * g + 4 * h) * 2) = make_uint2(pk2(o0[4 * g], o0[4 * g + 1]), pk2(o0[4 * g + 2], o0[4 * g + 3]));
                    *(uint2*)(sp + (32 + 8 * g + 4 * h) * 2) = make_uint2(pk2(o1[4 * g], o1[4 * g + 1]), pk2(o1[4 * g + 2], o1[4 * g + 3]));
                }
            }
        }
        if (stage < 2 || !act) return;
    }
    const float inv = 1.f / lt;
    if (dry) { if (o0[0] + o1[0] + lt == 12345.678f) qkv[0] = 1; return; }
    bf16_t* op = qkv + (rowb + tq) * ld + qcol + 4 * h;
#pragma unroll
    for (int g = 0; g < 4; ++g) {
        *(uint2*)(op + 8 * g) = make_uint2(pk2(o0[4 * g] * inv, o0[4 * g + 1] * inv), pk2(o0[4 * g + 2] * inv, o0[4 * g + 3] * inv));
        *(uint2*)(op + 32 + 8 * g) = make_uint2(pk2(o1[4 * g] * inv, o1[4 * g + 1] * inv), pk2(o1[4 * g + 2] * inv, o1[4 * g + 3] * inv));
    }
}

DI void stick_wave(bf16_t* qkv, int ld, int b, int qcol, int kcol, int vcol, int qt, char* vl, int lane, bool dry) {
    const int r = lane & 31, h = lane >> 5;
    const size_t rowb = (size_t)b * S;
    const int tq = qt * 32 + r;
    bf16x8 qf[4];
    {
        const bf16_t* qp = qkv + (rowb + tq) * ld + qcol + h * 32;
#pragma unroll
        for (int ks = 0; ks < 4; ++ks) qf[ks] = *(const bf16x8*)(qp + ks * 8);
    }
    f32x16 o0, o1;
#pragma unroll
    for (int i = 0; i < 16; ++i) { o0[i] = 0.f; o1[i] = 0.f; }
    float R = 1.f;
    const int i16 = lane & 15;
    const char* vbase = vl + 4608 + (4 * h + (i16 >> 2)) * 144 + (16 * ((lane >> 4) & 1) + 4 * (i16 & 3)) * 2;
    const char* kfp = vl + r * 144 + h * 64;
    KV_DECL;
    KV_LOAD(qt * 32, 1);
    for (int tile = qt; tile >= 0; --tile) {
        KV_STORE();
        asm volatile("" ::: "memory");
        if (tile > 0) KV_LOAD((tile - 1) * 32, 1);
        f32x16 s = MFMA(*(const bf16x8*)(kfp), qf[0], f32x16{});
#pragma unroll
        for (int ks = 1; ks < 4; ++ks) s = MFMA(*(const bf16x8*)(kfp + ks * 16), qf[ks], s);
        const bool diag = (tile == qt);
        f32x16 sg, kp;
#pragma unroll
        for (int i = 0; i < 16; ++i) {
            const float z2 = fminf(s[i] * (0.125f * LOG2E), 80.f);
            const float t = fexp2(z2);
            const float k = __builtin_amdgcn_rcpf(1.f + t);
            kp[i] = k; sg[i] = t * k;
        }
        if (diag) {
#pragma unroll
            for (int i = 0; i < 16; ++i) { const bool strict = crow(i, h) < r; kp[i] = strict ? kp[i] : 1.f; sg[i] = strict ? sg[i] : 0.f; }
        }
        float G[4], PG[4], both[4];
#pragma unroll
        for (int g = 0; g < 4; ++g) { G[g] = (kp[4 * g] * kp[4 * g + 1]) * (kp[4 * g + 2] * kp[4 * g + 3]); PG[g] = __shfl_xor(G[g], 32); both[g] = G[g] * PG[g]; }
        float Sx[4];
        Sx[3] = 1.f; Sx[2] = both[3]; Sx[1] = both[3] * both[2]; Sx[0] = Sx[1] * both[1];
        f32x16 a;
#pragma unroll
        for (int g = 0; g < 4; ++g) {
            float la = R * Sx[g] * (h == 0 ? PG[g] : 1.f);
#pragma unroll
            for (int j = 3; j >= 0; --j) {
                a[4 * g + j] = sg[4 * g + j] * la;
                la *= kp[4 * g + j];
            }
        }
        R *= Sx[0] * both[0];
        const bf16x8 p0 = pack8v<0>(a), p1 = pack8v<8>(a);
        o0 = MFMA(v_frag(vbase, 0, 0), p0, o0);
        o0 = MFMA(v_frag(vbase, 1, 0), p1, o0);
        o1 = MFMA(v_frag(vbase, 0, 1), p0, o1);
        o1 = MFMA(v_frag(vbase, 1, 1), p1, o1);
        asm volatile("" ::: "memory");
        if (__builtin_amdgcn_ballot_w64(R >= 1.17549435e-38f) == 0) break;
    }
    if (dry) { if (o0[0] + o1[0] == 12345.678f) qkv[0] = 1; return; }
    bf16_t* op = qkv + (rowb + tq) * ld + qcol + 4 * h;
#pragma unroll
    for (int g = 0; g < 4; ++g) {
        *(uint2*)(op + 8 * g) = make_uint2(pk2(o0[4 * g], o0[4 * g + 1]), pk2(o0[4 * g + 2], o0[4 * g + 3]));
        *(uint2*)(op + 32 + 8 * g) = make_uint2(pk2(o1[4 * g], o1[4 * g + 1]), pk2(o1[4 * g + 2], o1[4 * g + 3]));
    }
}

DI void attn_even_phase(const Params& P, char* smem, bool dry) {
    const int tid_ = otid(); const int lane = tid_ & 63, wid = tid_ >> 6;
    bf16_t* qkv = (bf16_t*)(P.ws + OFF_BIG);
    char* vl = smem + wid * 9216;
    for (int it = blockIdx.x * 8 + wid; it < 2048 + 4096; it += gridDim.x * 8) {
        if (it < 2048) {
            const int bh = it >> 6, p = it & 63; const int b = bh >> 3, head = bh & 7;
            stick_wave(qkv, 2304, b, 512 + head * 64, 1280 + head * 64, 1792 + head * 64, 127 - p, vl, lane, dry);
            stick_wave(qkv, 2304, b, 512 + head * 64, 1280 + head * 64, 1792 + head * 64, p, vl, lane, dry);
        } else {
            const int v = it - 2048; const int g = v & 3; const int qt = (v >> 2) & 127; const int rest = v >> 9; const int b = rest >> 1, kvh = rest & 1;
            const int head = kvh * 4 + g;
            const float slope = exp2f(-(float)(head + 1));
            const float sink = P.in[9][head];
            win_attn_wave(qkv, 2304, b, head * 64, 1024 + kvh * 64, 1152 + kvh * 64, qt * 32, 1, slope * LOG2E, sink * LOG2E, 1.f, -1, vl, lane, dry);
        }
    }
}

DI void attn_odd_phase(const Params& P, char* smem, bool dry) {
    const int tid_ = otid(); const int lane = tid_ & 63, wid = tid_ >> 6;
    bf16_t* qkv = (bf16_t*)(P.ws + OFF_BIG);
    char* vl = smem + wid * 9216;
    float* st = (float*)(smem + 8 * 9216);
    for (int it = blockIdx.x, rd = 0; it < 512; it += gridDim.x, ++rd) {
        int span = it & 7, bh = it >> 3;
        if (gridDim.x == 256) { const int c = (int)blockIdx.x, j = c >> 3; span = j & 7; bh = (c & 7) + 8 * ((j >> 3) + 4 * rd); }
        const int head = bh & 15, b = bh >> 4; const int t0 = span * 512;
        const float slope2 = exp2f(-0.5f * (float)(head + 1)) * LOG2E;
        const int qc = head * 64, kc = 1024 + head * 64, vc = 2048 + head * 64;
        __syncthreads();
#pragma unroll 1
        for (int k = 0; k < 2; ++k) {
            const int j = wid + 8 * k;
            win_attn_wave(qkv, 3072, b, qc, kc, vc, t0 + 32 * j, 1, slope2, -1e30f, 0.f, 0, vl, lane, dry, 32, st, 32 * j, 1, 0);
        }
        __syncthreads();
#pragma unroll 1
        for (int k = 0; k < 2; ++k) {
            const int j = wid + 8 * k; const int r4 = j >> 2, q = j & 3;
            win_attn_wave(qkv, 3072, b, qc, kc, vc, t0 + r4 + 128 * q, 4, slope2, -1e30f, 0.f, 1, vl, lane, dry, 32, st, r4 + 128 * q, 4, 1);
        }
        __syncthreads();
#pragma unroll 1
        for (int k = 0; k < 2; ++k) {
            const int r16 = wid + 8 * k;
            win_attn_wave(qkv, 3072, b, qc, kc, vc, t0 + r16, 16, slope2, -1e30f, 0.f, 2, vl, lane, dry, 32, st, r16, 16, 2);
        }
    }
}

DI void xattn_wave(bf16_t* qb, const bf16_t* Kn, const bf16_t* VT, const float* qg, float kmax2, int b, int head, int tok0, char* ql, int lane, bool dry) {
    const int r = lane & 31, h = lane >> 5;
    const size_t token = (size_t)b * S + tok0 + r;
    bf16_t* qp = qb + token * D + head * 256 + h * 128;
    float ss = 0.f;
#pragma unroll
    for (int ks = 0; ks < 16; ++ks) {
        const uint4 v = *(const uint4*)(qp + ks * 8);
        const unsigned w[4] = {v.x, v.y, v.z, v.w};
#pragma unroll
        for (int e = 0; e < 4; ++e) { const float a = bflo(w[e]), c = bfhi(w[e]); ss += a * a + c * c; }
    }
    ss += __shfl_xor(ss, 32);
    const float inv = __builtin_amdgcn_rsqf(ss * (1.f / 256.f) + EPS);
    float qq2 = 0.f;
#pragma unroll
    for (int ks = 0; ks < 16; ++ks) {
        const uint4 v = *(const uint4*)(qp + ks * 8);
        const float4 g0 = *(const float4*)(qg + h * 128 + ks * 8), g1 = *(const float4*)(qg + h * 128 + ks * 8 + 4);
        uint4 o;
        o.x = pk2(bflo(v.x) * inv * g0.x, bfhi(v.x) * inv * g0.y); o.y = pk2(bflo(v.y) * inv * g0.z, bfhi(v.y) * inv * g0.w);
        o.z = pk2(bflo(v.z) * inv * g1.x, bfhi(v.z) * inv * g1.y); o.w = pk2(bflo(v.w) * inv * g1.z, bfhi(v.w) * inv * g1.w);
        qq2 += bflo(o.x) * bflo(o.x) + bfhi(o.x) * bfhi(o.x) + bflo(o.y) * bflo(o.y) + bfhi(o.y) * bfhi(o.y)
             + bflo(o.z) * bflo(o.z) + bfhi(o.z) * bfhi(o.z) + bflo(o.w) * bflo(o.w) + bfhi(o.w) * bfhi(o.w);
        *(uint4*)(ql + (ks * 64 + lane) * 16) = o;
    }
    qq2 += __shfl_xor(qq2, 32);
    asm volatile("" ::: "memory");
    const float sc2 = 0.0625f * LOG2E;
    const bf16_t* kp0 = Kn + ((size_t)(b * 4 + head) * 8 * 16 * 64 + lane) * 8;
    const float m = __builtin_amdgcn_sqrtf(qq2 * kmax2) * 1.001f;
    float l = 0.f;
    bf16x8 pf[8][2];
    bf16x8 kc[16], kn[16];
#pragma unroll
    for (int ks = 0; ks < 16; ++ks) kc[ks] = *(const bf16x8*)(kp0 + ks * 512);
#pragma unroll
    for (int tile = 0; tile < 8; ++tile) {
        if (tile < 7) {
#pragma unroll
            for (int ks = 0; ks < 16; ++ks) kn[ks] = *(const bf16x8*)(kp0 + (size_t)(tile + 1) * 16 * 512 + ks * 512);
        }
        f32x16 s, s_b;
#pragma unroll
        for (int i = 0; i < 16; ++i) { s[i] = 0.f; s_b[i] = 0.f; }
#pragma unroll
        for (int ks = 0; ks < 16; ks += 2) {
            const bf16x8 qf0 = *(const bf16x8*)(ql + (ks * 64 + lane) * 16);
            const bf16x8 qf1 = *(const bf16x8*)(ql + ((ks + 1) * 64 + lane) * 16);
            s = MFMA(kc[ks], qf0, s);
            s_b = MFMA(kc[ks + 1], qf1, s_b);
        }
#pragma unroll
        for (int i = 0; i < 16; ++i) s[i] += s_b[i];
#pragma unroll
        for (int i = 0; i < 16; ++i) { s[i] = fexp2((s[i] - m) * sc2); l += s[i]; }
        pf[tile][0] = pack8v<0>(s); pf[tile][1] = pack8v<8>(s);
#pragma unroll
        for (int ks = 0; ks < 16; ++ks) kc[ks] = kn[ks];
    }
    l += __shfl_xor(l, 32);
    const float il = 1.f / l;
    bf16_t* op = qb + token * D + head * 256 + 4 * h;
    const bf16_t* vp0 = VT + (((size_t)(b * 4 + head) * 8 * 8 * 2 * 64) + lane) * 8;
    bf16x8 vc[16], vn[16];
#pragma unroll
    for (int e = 0; e < 16; ++e) vc[e] = *(const bf16x8*)(vp0 + e * 512);
#pragma unroll 1
    for (int dt = 0; dt < 8; ++dt) {
        const int dn = dt < 7 ? dt + 1 : 7;
#pragma unroll
        for (int e = 0; e < 16; ++e) vn[e] = *(const bf16x8*)(vp0 + (size_t)dn * 16 * 512 + e * 512);
        f32x16 o, o_b;
#pragma unroll
        for (int i = 0; i < 16; ++i) { o[i] = 0.f; o_b[i] = 0.f; }
#pragma unroll
        for (int tile = 0; tile < 8; ++tile) { o = MFMA(vc[tile * 2], pf[tile][0], o); o_b = MFMA(vc[tile * 2 + 1], pf[tile][1], o_b); }
#pragma unroll
        for (int i = 0; i < 16; ++i) o[i] += o_b[i];
#pragma unroll
        for (int g = 0; g < 4; ++g)
            if (dry) { if (o[4 * g] == 12345.678f) qb[0] = 1; } else *(uint2*)(op + dt * 32 + 8 * g) = make_uint2(pk2(o[4 * g] * il, o[4 * g + 1] * il), pk2(o[4 * g + 2] * il, o[4 * g + 3] * il));
#pragma unroll
        for (int e = 0; e < 16; ++e) vc[e] = vn[e];
    }
}

DI void xattn_block(bf16_t* qb, const bf16_t* KF, const bf16_t* VF, const float* qg, float kmax2, int b, int head, int qblk, char* smem, int lane, int wid) {
    const int r = lane & 31, h = lane >> 5;
    const size_t token = (size_t)b * S + qblk * 256 + wid * 32 + r;
    bf16_t* qp = qb + token * D + head * 256 + h * 128;
    const bf16_t* kbase = KF + (size_t)(b * 4 + head) * 8 * 8192;
    const bf16_t* vbase = VF + (size_t)(b * 4 + head) * 8 * 8192;
    const int pc0 = (2 * wid) * 512 + lane * 8, pc1 = pc0 + 512;
    char* ld0 = smem + (2 * wid) * 1024 + lane * 16;
#define XA_ISSUE(u_) do { const int u__ = (u_); const bf16_t* src_ = (u__ < 8) ? kbase + (size_t)u__ * 8192 : vbase + (size_t)(u__ - 8) * 8192; \
        char* dst_ = ld0 + (u__ & 3) * 16384; glds16(src_ + pc0, dst_); glds16(src_ + pc1, dst_ + 1024); } while (0)
    __syncthreads();
    XA_ISSUE(0); XA_ISSUE(1); XA_ISSUE(2);
    uint4 qraw[16];
    float ss = 0.f;
#pragma unroll
    for (int ks = 0; ks < 16; ++ks) {
        qraw[ks] = *(const uint4*)(qp + ks * 8);
        const uint4 v = qraw[ks];
        ss += bflo(v.x) * bflo(v.x) + bfhi(v.x) * bfhi(v.x) + bflo(v.y) * bflo(v.y) + bfhi(v.y) * bfhi(v.y)
            + bflo(v.z) * bflo(v.z) + bfhi(v.z) * bfhi(v.z) + bflo(v.w) * bflo(v.w) + bfhi(v.w) * bfhi(v.w);
    }
    ss += __shfl_xor(ss, 32);
    const float inv = __builtin_amdgcn_rsqf(ss * (1.f / 256.f) + EPS);
    float qq2 = 0.f;
    bf16x8 qf[16];
#pragma unroll
    for (int ks = 0; ks < 16; ++ks) {
        const uint4 v = qraw[ks];
        const float4 g0 = *(const float4*)(qg + h * 128 + ks * 8), g1 = *(const float4*)(qg + h * 128 + ks * 8 + 4);
        uint4 o;
        o.x = pk2(bflo(v.x) * inv * g0.x, bfhi(v.x) * inv * g0.y); o.y = pk2(bflo(v.y) * inv * g0.z, bfhi(v.y) * inv * g0.w);
        o.z = pk2(bflo(v.z) * inv * g1.x, bfhi(v.z) * inv * g1.y); o.w = pk2(bflo(v.w) * inv * g1.z, bfhi(v.w) * inv * g1.w);
        qq2 += bflo(o.x) * bflo(o.x) + bfhi(o.x) * bfhi(o.x) + bflo(o.y) * bflo(o.y) + bfhi(o.y) * bfhi(o.y)
             + bflo(o.z) * bflo(o.z) + bfhi(o.z) * bfhi(o.z) + bflo(o.w) * bflo(o.w) + bfhi(o.w) * bfhi(o.w);
        qf[ks] = __builtin_bit_cast(bf16x8, o);
    }
    qq2 += __shfl_xor(qq2, 32);
    const float sc2 = 0.0625f * LOG2E;
    const float m = __builtin_amdgcn_sqrtf(qq2 * kmax2) * 1.001f;
    float l = 0.f;
    bf16x8 pf[8][2];
    const char* fr0 = smem + lane * 16;
#pragma unroll
    for (int u = 0; u < 8; ++u) {
        asm volatile("s_waitcnt vmcnt(4)" ::: "memory");
        __builtin_amdgcn_s_barrier();
        XA_ISSUE(u + 3);
        const char* sl = fr0 + (u & 3) * 16384;
        f32x16 s, s_b;
#pragma unroll
        for (int i = 0; i < 16; ++i) { s[i] = 0.f; s_b[i] = 0.f; }
#pragma unroll
        for (int ks = 0; ks < 16; ks += 2) {
            s = MFMA(*(const bf16x8*)(sl + ks * 1024), qf[ks], s);
            s_b = MFMA(*(const bf16x8*)(sl + (ks + 1) * 1024), qf[ks + 1], s_b);
        }
#pragma unroll
        for (int i = 0; i < 16; ++i) { s[i] = fexp2((s[i] + s_b[i] - m) * sc2); l += s[i]; }
        pf[u][0] = pack8v<0>(s); pf[u][1] = pack8v<8>(s);
    }
    l += __shfl_xor(l, 32);
    const float il = 1.f / l;
    bf16_t* op = qb + token * D + head * 256 + 4 * h;
#pragma unroll 1
    for (int dt = 0; dt < 8; ++dt) {
        if (dt < 6) asm volatile("s_waitcnt vmcnt(4)" ::: "memory");
        else if (dt == 6) asm volatile("s_waitcnt vmcnt(2)" ::: "memory");
        else asm volatile("s_waitcnt vmcnt(0)" ::: "memory");
        __builtin_amdgcn_s_barrier();
        if (dt < 5) XA_ISSUE(dt + 11);
        const char* sl = fr0 + (dt & 3) * 16384;
        f32x16 o, o_b;
#pragma unroll
        for (int i = 0; i < 16; ++i) { o[i] = 0.f; o_b[i] = 0.f; }
#pragma unroll
        for (int tile = 0; tile < 8; ++tile) {
            o = MFMA(*(const bf16x8*)(sl + (tile * 2) * 1024), pf[tile][0], o);
            o_b = MFMA(*(const bf16x8*)(sl + (tile * 2 + 1) * 1024), pf[tile][1], o_b);
        }
#pragma unroll
        for (int g = 0; g < 4; ++g)
            *(uint2*)(op + dt * 32 + 8 * g) = make_uint2(pk2((o[4 * g] + o_b[4 * g]) * il, (o[4 * g + 1] + o_b[4 * g + 1]) * il),
                                                        pk2((o[4 * g + 2] + o_b[4 * g + 2]) * il, (o[4 * g + 3] + o_b[4 * g + 3]) * il));
    }
#undef XA_ISSUE
}

DI void xattn_phase(const Params& P, int l, char* smem, bool dry) {
    const int tid_ = otid(); const int lane = tid_ & 63, wid = tid_ >> 6;
    bf16_t* qb = (bf16_t*)(P.ws + OFF_BIG);
    const bf16_t* KF = (const bf16_t*)(P.ws + OFF_KF + (size_t)l * SZ_MM);
    const bf16_t* VF = (const bf16_t*)(P.ws + OFF_VT + (size_t)l * SZ_MM);
    const float* qg = P.in[19] + l * 256;
    (void)dry;
    for (int it = blockIdx.x; it < 256; it += gridDim.x) {
        const int qblk = it & 15, head = (it >> 4) & 3, b = it >> 6;
        const float kmax2 = ((const float*)(P.ws + OFF_KMAX))[l * 16 + b * 4 + head];
        xattn_block(qb, KF, VF, qg, kmax2, b, head, qblk, smem, lane, wid);
    }
}

DI void knorm_phase(const Params& P) {
    const int tid_ = otid(); const int lane = tid_ & 63, wid = tid_ >> 6;
    for (int u = blockIdx.x * 8 + wid; u < 8192; u += gridDim.x * 8) {
        const int l = u >> 12, row = (u >> 2) & 1023, head = u & 3;
        const bf16_t* kp = (const bf16_t*)(P.ws + OFF_KN + (size_t)l * SZ_MM) + (size_t)row * D + head * 256 + lane * 4;
        const uint2 v = *(const uint2*)kp;
        const float a0 = bflo(v.x), a1 = bfhi(v.x), a2 = bflo(v.y), a3 = bfhi(v.y);
        float ss = a0 * a0 + a1 * a1 + a2 * a2 + a3 * a3;
        ss = wave_sum(ss);
        const float inv = __builtin_amdgcn_rsqf(ss * (1.f / 256.f) + EPS);
        const float4 g = *(const float4*)(P.in[20] + l * 256 + lane * 4);
        const int b = row >> 8, key = row & 255;
        const int h = lane >> 5, ks = (lane & 31) >> 1, j0 = (lane & 1) * 4;
        bf16_t* dp = (bf16_t*)(P.ws + OFF_KF + (size_t)l * SZ_MM) + ((((((size_t)(b * 4 + head) * 8 + (key >> 5)) * 16 + ks) * 64) + h * 32 + (key & 31)) << 3) + j0;
        const unsigned w0_ = pk2(a0 * inv * g.x, a1 * inv * g.y), w1_ = pk2(a2 * inv * g.z, a3 * inv * g.w);
        *(uint2*)dp = make_uint2(w0_, w1_);
        float kk2 = bflo(w0_) * bflo(w0_) + bfhi(w0_) * bfhi(w0_) + bflo(w1_) * bflo(w1_) + bfhi(w1_) * bfhi(w1_);
        kk2 = wave_sum(kk2);
        if (lane == 0) atomicMax((unsigned*)(P.ws + OFF_KMAX) + l * 16 + b * 4 + head, __float_as_uint(kk2));
    }
}

#define XB_TMO      128
#define XB_XCNT(j)  (256  + 64 * (j))
#define XB_XSUB(j)  (1280 + 64 * (j))
#define XB_XGEN(j)  (2304 + 64 * (j))
#define XB_TOP      3328
#define XB_TOPGEN   3392
#define XCD_BAR_WORDS 3456
#define XB_SPIN_CAP (1u << 18)
#define XB_LAS __attribute__((address_space(3)))

__device__ __forceinline__ unsigned xb_ld(unsigned* p)              { return __hip_atomic_load(p, __ATOMIC_RELAXED, __HIP_MEMORY_SCOPE_AGENT); }
__device__ __forceinline__ unsigned xb_add(unsigned* p, unsigned v) { return __hip_atomic_fetch_add(p, v, __ATOMIC_RELAXED, __HIP_MEMORY_SCOPE_AGENT); }
__device__ __forceinline__ unsigned xb_xcc_id() { return (unsigned)__builtin_amdgcn_s_getreg((3 << 11) | 20) & 0xFu; }
#define XB_SPIN(cond, bar) do { unsigned _sp = 0; while (cond) { __builtin_amdgcn_s_sleep(1); \
    if ((++_sp & 255u) == 0u) { if (xb_ld(&(bar)[XB_TMO])) break; if (_sp > XB_SPIN_CAP) { atomicAdd(&(bar)[XB_TMO], 1u); break; } } } } while (0)

struct XcdBarrier {
    unsigned* bar; unsigned x;
    volatile XB_LAS unsigned* st;
};

__device__ __forceinline__ XcdBarrier xcd_barrier_post(unsigned* bar, volatile XB_LAS unsigned* st) {
    XcdBarrier b; b.bar = bar; b.x = xb_xcc_id(); b.st = st;
    if (threadIdx.x == 0) (void)xb_add(&bar[XB_XCNT(b.x)], 1u);
    return b;
}
__device__ __forceinline__ void xcd_barrier_complete(unsigned* bar, unsigned x, unsigned& nloc, unsigned& nx) {
    const unsigned G = gridDim.x * gridDim.y * gridDim.z;
    unsigned sum, cnt, mine, sp = 0u;
    for (;;) {
        sum = 0u; cnt = 0u; mine = 0u;
#pragma unroll
        for (unsigned j = 0; j < 16; ++j) { const unsigned c = xb_ld(&bar[XB_XCNT(j)]); sum += c; cnt += (c > 0u) ? 1u : 0u; mine = (j == x) ? c : mine; }
        if (sum == G) break;
        __builtin_amdgcn_s_sleep(1);
        if ((++sp & 255u) == 0u) { if (xb_ld(&bar[XB_TMO])) break; if (sp > XB_SPIN_CAP) { atomicAdd(&bar[XB_TMO], 1u); break; } }
    }
    nloc = mine > 0u ? mine : 1u; nx = cnt > 0u ? cnt : 1u;
}

__device__ __forceinline__ void xcd_barrier(const XcdBarrier& b) {
    asm volatile("s_waitcnt vmcnt(0)" ::: "memory");
    __syncthreads();
    if (threadIdx.x == 0) {
        unsigned* bar = b.bar;
        __builtin_amdgcn_s_waitcnt(0);
        unsigned nloc = b.st[0], nx = b.st[1];
        if (nloc == 0u) { xcd_barrier_complete(bar, b.x, nloc, nx); b.st[0] = nloc; b.st[1] = nx; }
        const unsigned old = xb_add(&bar[XB_XSUB(b.x)], 1u);
        const unsigned gen = old / nloc;
        if (old + 1u == (gen + 1u) * nloc) {
            __builtin_amdgcn_fence(__ATOMIC_RELEASE, "agent");
            asm volatile("s_waitcnt vmcnt(0)" ::: "memory");
            const unsigned og = xb_add(&bar[XB_TOP], 1u);
            const unsigned tg = og / nx;
            if (og + 1u == (tg + 1u) * nx) xb_add(&bar[XB_TOPGEN], 1u);
            else XB_SPIN(xb_ld(&bar[XB_TOPGEN]) == tg, bar);
            __builtin_amdgcn_fence(__ATOMIC_ACQUIRE, "agent");
            xb_add(&bar[XB_XGEN(b.x)], 1u);
            asm volatile("s_waitcnt vmcnt(0)" ::: "memory");
        } else {
            XB_SPIN(xb_ld(&bar[XB_XGEN(b.x)]) == gen, bar);
            __builtin_amdgcn_fence(__ATOMIC_ACQUIRE, "agent");
            asm volatile("s_waitcnt vmcnt(0)" ::: "memory");
        }
    }
    __syncthreads();
}


DI void fast_grid_sync(unsigned* bar, unsigned target) {
    asm volatile("s_waitcnt vmcnt(0) lgkmcnt(0)" ::: "memory");
    __syncthreads();
    if (threadIdx.x == 0) {
        __builtin_amdgcn_fence(__ATOMIC_RELEASE, "agent");
        asm volatile("s_waitcnt vmcnt(0)" ::: "memory");
        __hip_atomic_fetch_add(bar, 1u, __ATOMIC_RELAXED, __HIP_MEMORY_SCOPE_AGENT);
        while (__hip_atomic_load(bar, __ATOMIC_RELAXED, __HIP_MEMORY_SCOPE_AGENT) < target) __builtin_amdgcn_s_sleep(2);
        __builtin_amdgcn_fence(__ATOMIC_ACQUIRE, "agent");
        asm volatile("s_waitcnt vmcnt(0)" ::: "memory");
    }
    __syncthreads();
}

__global__ void __launch_bounds__(512) fwd_megakernel(Params P) {
    extern __shared__ __attribute__((aligned(16))) char smem[];
    cg::grid_group grid = cg::this_grid();
    unsigned nbar = 0; (void)nbar;
    volatile XB_LAS unsigned* xst = (volatile XB_LAS unsigned*)(smem + LDS_BYTES - 16);
    if (threadIdx.x == 0) { xst[0] = 0u; xst[1] = 0u; }
    __syncthreads();
    const XcdBarrier xbar = xcd_barrier_post((unsigned*)(P.ws + OFF_BAR), xst);
#pragma unroll 1
    for (int ph = 0; ph < 21; ++ph) {
        float* ssq = (float*)(P.ws + OFF_SSQ);
        bf16_t* xb = (bf16_t*)(P.ws + OFF_XB);
        bf16_t* big = (bf16_t*)(P.ws + OFF_BIG);
        int nrep = 1;
        if (ph > 0) { const int s_ = (ph - 1) % 10; const int kind = (s_ == 3) ? 2 : (s_ == 6) ? 4 : 1; if (PROBE_MASK & kind) nrep = 2; }
        for (int rep = 0; rep < nrep; ++rep) {
        const bool dry = rep + 1 < nrep;
        if (ph == 0) {
            phase0(P, smem);
        } else {
            const int l = (ph - 1) / 10, s = (ph - 1) % 10;
            if (s == 3) {
                if (l == 0) attn_even_phase(P, smem, dry); else attn_odd_phase(P, smem, dry);
            } else if (s == 6) {
            } else {
                pg8::Gemm g; pg8::Epi E;
                g.A = xb; g.lda = D; g.K = D; g.M = T; g.N = D; g.Bt = nullptr;
                E.mode = 1; E.rs = nullptr; E.O = big; E.ldo = D; E.xin = nullptr; E.xout = nullptr; E.xb = xb; E.ssq_out = ssq; E.alpha = 1.f;
                E.qg = nullptr; E.kg = nullptr; E.qn_end = 0; E.kn_beg = 0; E.kn_end = 0;
                if (s == 0 || s == 8) {
                    g.Bt = (const bf16_t*)(P.ws + (s == 0 ? OFF_GU1 : OFF_GU2) + (size_t)l * SZ_GU); g.N = NGU;
                    E.mode = 0; E.rs = ssq + (size_t)(4 * l + (s == 0 ? 0 : 3)) * T; E.ldo = DFF;
                } else if (s == 1 || s == 9) {
                    g.A = big; g.lda = DFF; g.K = DFF;
                    g.Bt = (const bf16_t*)(P.ws + (s == 1 ? OFF_DN1 : OFF_DN2) + (size_t)l * SZ_DN);
                    E.alpha = 0.5f; E.ssq_out = ssq + (size_t)(4 * l + (s == 1 ? 1 : 4)) * T;
                    if (ph == 2) E.xin = P.in[0];
                    if (ph == 20) { E.xout = P.out; E.ssq_out = nullptr; }
                } else if (s == 2) {
                    E.mode = 2; E.rs = ssq + (size_t)(4 * l + 1) * T;
                    if (l == 0) { g.Bt = (const bf16_t*)(P.ws + OFF_EVIN); g.N = 2304; E.ldo = 2304; E.qg = P.in[7]; E.kg = P.in[8]; E.qn_end = 512; E.kn_beg = 1024; E.kn_end = 1152; }
                    else { g.Bt = (const bf16_t*)(P.ws + OFF_ODIN); g.N = 3072; E.ldo = 3072; E.qg = P.in[12]; E.kg = P.in[13]; E.qn_end = 1024; E.kn_beg = 1024; E.kn_end = 2048; }
                } else if (s == 4) {
                    g.A = big;
                    if (l == 0) { g.Bt = (const bf16_t*)(P.ws + OFF_EVOUT); g.lda = 2304; }
                    else { g.Bt = (const bf16_t*)(P.ws + OFF_ODOUT); g.lda = 3072; }
                    E.ssq_out = ssq + (size_t)(4 * l + 2) * T;
                } else if (s == 5) {
                    g.Bt = (const bf16_t*)(P.ws + OFF_WQ + (size_t)l * SZ_MM); E.mode = 2; E.rs = ssq + (size_t)(4 * l + 2) * T; E.ldo = D;
                } else {
                    g.A = big; g.Bt = (const bf16_t*)(P.ws + OFF_WO + (size_t)l * SZ_MM); E.ssq_out = ssq + (size_t)(4 * l + 3) * T;
                }
                pg8::StaticOrder So; So.init(T, g.N, (int)gridDim.x, (int)blockIdx.x);
                E.dryrun = 0;
#if PROBE_GEMM
                for (int rep_ = 0; rep_ < 2; ++rep_) {
                pg8::Epi E2 = E;
                if (rep_ == 0) { if (PROBE_GEMM == 1) E2.dryrun = 1; else if (E.mode == 1) { E2.alpha = 0.f; } }
                __syncthreads();
                pg8::gemm_phase<pg8::Epi, pg8::StaticOrder, true, true>((PG8_LAS unsigned char*)smem, g, So, rep_ == 0 ? E2 : E);
                ++nbar; fast_grid_sync((unsigned*)(P.ws + OFF_BAR), nbar * gridDim.x);
                }
#else
                __syncthreads();
                pg8::gemm_phase<pg8::Epi, pg8::StaticOrder, true, true>((PG8_LAS unsigned char*)smem, g, So, E);
#endif
                if (ph == 1) {
                    GJob J;
                    J.A = xb; J.lda = D; J.ksplit = 1 << 30; J.kextra = 0; J.K = D; J.ntm = 4; J.mode = 3; J.rs = nullptr;
                    J.O = big; J.ldo = D; J.xin = P.out; J.xout = P.out; J.xb = xb; J.ssq_out = ssq; J.alpha = 1.f;
                    J.qg = nullptr; J.kg = nullptr; J.qn_end = 0; J.kn_end = 0; J.vt = nullptr; J.W = nullptr; J.ntn = 8;
                    gemm_phase(J, 0, 64, P, smem, false);
                }
                if (ph == 2 && !dry) knorm_phase(P);
                if (s == 5) {
                    asm volatile("s_waitcnt vmcnt(0)" ::: "memory");
                    __syncthreads();
                    const int tid_ = otid(); const int lane = tid_ & 63, wid = tid_ >> 6;
                    const bf16_t* KF = (const bf16_t*)(P.ws + OFF_KF + (size_t)l * SZ_MM);
                    const bf16_t* VF = (const bf16_t*)(P.ws + OFF_VT + (size_t)l * SZ_MM);
                    pg8::Unit uu;
                    for (int i = 0; So.next(i, uu); ++i) {
                        const int b = uu.pm >> 4, qblk = uu.pm & 15, head = uu.pn;
                        const float kmax2 = ((const float*)(P.ws + OFF_KMAX))[l * 16 + b * 4 + head];
                        xattn_block(big, KF, VF, P.in[19] + l * 256, kmax2, b, head, qblk, smem, lane, wid);
                    }
                }
            }
        }
        if (P.ws == nullptr) grid.sync();
        if (ph < 20 && !(ph > 0 && (ph - 1) % 10 == 6)) xcd_barrier(xbar);
        }
    }
}

extern "C" void kernel_launch(void* const* d_in, const int* in_sizes, int n_in, void* d_out, int out_size, void* d_ws, size_t ws_size,
                              hipStream_t stream) {
    static int grid_blocks = 0;
    if (!grid_blocks) {
        int dev = 0, cus = 0, per_cu = 0;
        hipGetDevice(&dev);
        hipDeviceGetAttribute(&cus, hipDeviceAttributeMultiprocessorCount, dev);
        hipFuncSetAttribute((const void*)fwd_megakernel, hipFuncAttributeMaxDynamicSharedMemorySize, LDS_BYTES);
        hipOccupancyMaxActiveBlocksPerMultiprocessor(&per_cu, fwd_megakernel, NTHR, LDS_BYTES);
        if (per_cu < 1) per_cu = 1;
        if (per_cu > 1) per_cu = 1;
        grid_blocks = cus * per_cu;
    }
    if (ws_size < WS_NEED) { fprintf(stderr, "workspace too small: %zu < %zu\n", ws_size, (size_t)WS_NEED); return; }
    Params p{};
    for (int i = 0; i < 25; ++i) p.in[i] = (const float*)d_in[i];
    p.out = (float*)d_out; p.ws = (char*)d_ws;
    hipMemsetAsync((char*)d_ws + OFF_BAR, 0, 16384, stream);
    void* args[] = {&p};
    hipError_t e = hipLaunchCooperativeKernel((void*)fwd_megakernel, dim3(grid_blocks), dim3(NTHR), args, LDS_BYTES, stream);
    if (e != hipSuccess) fprintf(stderr, "cooperative launch failed: %s (grid %d)\n", hipGetErrorString(e), grid_blocks);
}
```
